# Optimizing an MI355X kernel written in HIP

```python
import math, functools
import jax, jax.numpy as jnp
from jax import lax
import numpy as np

D_MODEL = 2048
BATCH = 1
SEQ = 8192
DEPTH = 2
DEC_BATCH = 16
DEC_SEQ = 16
PAST_LEN = 2048

CHUNK = 64
Q_BLOCK = 128
D_RWKV = 1024
D_DIFF = D_MODEL - D_RWKV
RWKV_HEAD = 64
N_RWKV_HEADS = D_RWKV // RWKV_HEAD
DIFF_HEAD = 64
N_DIFF_HEADS = D_DIFF // (2 * DIFF_HEAD)
DECAY_LORA = 96
AAA_LORA = 96
GATE_LORA = 256
N_RWKV_COLS = 3 * D_RWKV + DECAY_LORA + AAA_LORA + GATE_LORA
N_DIFF_COLS = 3 * D_DIFF
N_IN_COLS = N_RWKV_COLS + N_DIFF_COLS
RWKV_SPLITS = (D_RWKV, 2 * D_RWKV, 3 * D_RWKV, 3 * D_RWKV + DECAY_LORA, 3 * D_RWKV + DECAY_LORA + AAA_LORA)
D_FF = 5632
CONV_W = 3
N_BUCKETS = 32
MAX_DISTANCE = 128
NORM_EPS = 1e-6
GN_EPS = 64e-5
SUBLN_EPS = 1e-5

kernel_name = 'hybrid_rwkv7_diffattn_stream_step'


def rms_norm(x, g, eps=NORM_EPS):
    xf = x.astype(jnp.float32)
    y = xf * lax.rsqrt(jnp.mean(xf * xf, axis=-1, keepdims=True) + eps)
    return (y * g.astype(jnp.float32)).astype(x.dtype)


def t5_bucket(rel):
    nb = N_BUCKETS // 2
    max_exact = nb // 2
    n = jnp.abs(rel)
    nf = jnp.maximum(n, 1).astype(jnp.float32)
    large = max_exact + (jnp.log(nf / max_exact) / math.log(MAX_DISTANCE / max_exact) * (nb - max_exact)).astype(jnp.int32)
    large = jnp.minimum(large, nb - 1)
    return jnp.where(rel > 0, nb, 0) + jnp.where(n < max_exact, n, large)


def rel_bias(q_pos, k_pos, table):
    bucket = t5_bucket(k_pos[None, :] - q_pos[:, None])
    return jnp.transpose(table.astype(jnp.float32)[bucket], (2, 0, 1))


def diff_attn_core(q, k, v, bias, mask, lam):
    s = jnp.einsum('bqhmd,bkhmd->bhmqk', q, k).astype(jnp.float32) * DIFF_HEAD ** -0.5
    s = s + bias[None, :, None]
    if mask is not None:
        s = jnp.where(mask, s, -jnp.inf)
    p = jax.nn.softmax(s, axis=-1)
    p = p[:, :, 0] - lam * p[:, :, 1]
    return jnp.einsum('bhqk,bkhe->bqhe', p.astype(v.dtype), v)


def diff_attn_prompt(q, k, v, lam, table):
    B, T = q.shape[:2]
    n_blk = T // Q_BLOCK
    k = k.reshape(B, T, N_DIFF_HEADS, 2, DIFF_HEAD)
    k_pos = jnp.arange(T)
    q_blocks = jnp.swapaxes(q.reshape(B, n_blk, Q_BLOCK, N_DIFF_HEADS, 2, DIFF_HEAD), 0, 1)

    def one_block(args):
        i, qb = args
        q_pos = i * Q_BLOCK + jnp.arange(Q_BLOCK)
        mask = (k_pos[None, :] // CHUNK) <= (q_pos[:, None] // CHUNK)
        return diff_attn_core(qb, k, v, rel_bias(q_pos, k_pos, table), mask, lam)

    out = lax.map(one_block, (jnp.arange(n_blk), q_blocks))
    return jnp.swapaxes(out, 0, 1).reshape(B, T, N_DIFF_HEADS, 2 * DIFF_HEAD)


def diff_attn_sample(q, k, v, lam, k_cache, v_cache, table):
    B, T = q.shape[:2]
    P = k_cache.shape[1]
    k_all = jnp.concatenate([k_cache.astype(k.dtype), k], axis=1).reshape(B, P + T, N_DIFF_HEADS, 2, DIFF_HEAD)
    v_all = jnp.concatenate([v_cache.astype(v.dtype), v], axis=1)
    q_pos = P + jnp.arange(T)
    k_pos = jnp.arange(P + T)
    return diff_attn_core(q, k_all, v_all, rel_bias(q_pos, k_pos, table), None, lam)


def wkv_scan(r, w, k, v, kk, a, S0):
    def step(S, inp):
        rt, wt, kt, vt, kkt, at = inp
        sa = jnp.einsum('bhvk,bhk->bhv', S, -kkt)
        S = S * wt[:, :, None, :] + sa[..., None] * (kkt * at)[:, :, None, :] + vt[..., None] * kt[:, :, None, :]
        return S, jnp.einsum('bhvk,bhk->bhv', S, rt)

    xs = tuple(jnp.moveaxis(t, 1, 0) for t in (r, w, k, v, kk, a))
    S, y = lax.scan(step, S0.astype(jnp.float32), xs)
    return jnp.moveaxis(y, 0, 1), S


def rwkv_group(p, shift0, wkv0, mu, w0, w2, a0, a2, g2, k_k, k_a, r_k, ln_w, ln_b):
    f32 = jnp.float32
    B, T, _ = p.shape
    prev = jnp.concatenate([shift0.astype(p.dtype), p[:, :-1]], axis=1)
    xm = p + (prev - p) * mu
    r, k, v, xw, xa, xg = jnp.split(xm, RWKV_SPLITS, axis=-1)
    w_log = -jax.nn.softplus(-(w0 + jnp.tanh(xw) @ w2).astype(f32)) - 0.5
    decay = jnp.exp(-jnp.exp(w_log))
    a = jax.nn.sigmoid((a0 + xa @ a2).astype(f32))
    g = jax.nn.sigmoid(xg) @ g2
    hs = (B, T, N_RWKV_HEADS, RWKV_HEAD)
    r, k, v, decay, a = (t.astype(f32).reshape(hs) for t in (r, k, v, decay, a))
    kk = k * k_k.astype(f32).reshape(N_RWKV_HEADS, RWKV_HEAD)
    kk = kk * lax.rsqrt(jnp.maximum(jnp.sum(kk * kk, axis=-1, keepdims=True), 1e-24))
    k = k * (1.0 + (a - 1.0) * k_a.astype(f32).reshape(N_RWKV_HEADS, RWKV_HEAD))
    y, S = wkv_scan(r, decay, k, v, kk, a, wkv0)
    y_mu = jnp.mean(y, axis=-1, keepdims=True)
    y_var = jnp.mean(jnp.square(y - y_mu), axis=-1, keepdims=True)
    y = ((y - y_mu) * lax.rsqrt(y_var + GN_EPS)).reshape(B, T, D_RWKV) * ln_w.astype(f32) + ln_b.astype(f32)
    bonus = jnp.sum(r * k * r_k.astype(f32), axis=-1, keepdims=True) * v
    y = (y + bonus.reshape(B, T, D_RWKV)) * g.astype(f32)
    return y.astype(p.dtype), S, p[:, -1:]


def conv_ffn(h, conv0, w_up, conv_w, conv_b, w_down):
    u = h @ w_up
    ug, uv = jnp.split(u, 2, axis=-1)
    T = ug.shape[1]
    ext = jnp.concatenate([conv0.astype(ug.dtype), ug], axis=1)
    z = conv_b + sum(ext[:, j:j + T] * conv_w[j] for j in range(CONV_W))
    y = (jax.nn.gelu(z, approximate=False) * uv) @ w_down
    return y, ext[:, T:]


def hybrid_layer(x, c, l, lp, shift0, wkv0, conv0, attend):
    B, T = x.shape[:2]
    mod = jax.nn.silu(c) @ lp['w_ada'] + lp['b_ada']
    sh1, sc1, gt1, sh2, sc2, gt2 = jnp.split(mod[:, None, :], 6, axis=-1)
    h = rms_norm(x, lp['g_mix']) * (1.0 + sc1) + sh1
    p = h @ lp['w_in']
    y_r, wkv, shift = rwkv_group(p[..., :N_RWKV_COLS], shift0, wkv0, lp['mu'], lp['w0'], lp['w2'], lp['a0'], lp['a2'], lp['g2'], lp['k_k'], lp['k_a'], lp['r_k'], lp['ln_w'], lp['ln_b'])
    pd = p[..., N_RWKV_COLS:]
    q = pd[..., :D_DIFF].reshape(B, T, N_DIFF_HEADS, 2, DIFF_HEAD)
    k = pd[..., D_DIFF:2 * D_DIFF].reshape(B, T, N_DIFF_HEADS, 2 * DIFF_HEAD)
    v = pd[..., 2 * D_DIFF:].reshape(B, T, N_DIFF_HEADS, 2 * DIFF_HEAD)
    lam_init = 0.8 - 0.6 * math.exp(-0.3 * l)
    f32 = jnp.float32
    lam = (jnp.exp(jnp.sum(lp['lq1'].astype(f32) * lp['lk1'].astype(f32)))
           - jnp.exp(jnp.sum(lp['lq2'].astype(f32) * lp['lk2'].astype(f32))) + lam_init)
    o = attend(q, k, v, lam)
    y_d = (rms_norm(o, lp['subln'], SUBLN_EPS) * (1.0 - lam_init)).reshape(B, T, D_DIFF)
    mixed = jnp.concatenate([y_r.astype(x.dtype), y_d.astype(x.dtype)], axis=-1) @ lp['w_out']
    x = x + gt1 * mixed
    h2 = rms_norm(x, lp['g_ffn']) * (1.0 + sc2) + sh2
    f, conv = conv_ffn(h2, conv0, lp['ffn_up'], lp['conv_w'], lp['conv_b'], lp['ffn_down'])
    x = x + gt2 * f
    return x, k, v, wkv, shift, conv


def setup_inputs(seed: int = 0) -> dict:
    key = jax.random.key(seed)
    ks = jax.random.split(key, 40)

    def nrm(i, shape, scale):
        return scale * jax.random.normal(ks[i], shape, jnp.float32)

    d_scale = D_MODEL ** -0.5
    kv_shape = (DEPTH, DEC_BATCH, PAST_LEN, N_DIFF_HEADS, 2 * DIFF_HEAD)
    return {
        'x_prompt': nrm(0, (BATCH, SEQ, D_MODEL), 1.0),
        'x_sample': nrm(1, (DEC_BATCH, DEC_SEQ, D_MODEL), 1.0),
        'c_prompt': nrm(2, (BATCH, D_MODEL), 1.0),
        'c_sample': nrm(3, (DEC_BATCH, D_MODEL), 1.0),
        'cache_k': nrm(4, kv_shape, 1.0),
        'cache_v': nrm(5, kv_shape, 1.0),
        'state_wkv': nrm(6, (DEPTH, DEC_BATCH, N_RWKV_HEADS, RWKV_HEAD, RWKV_HEAD), 1.0),
        'state_shift': nrm(7, (DEPTH, DEC_BATCH, 1, N_RWKV_COLS), 1.0),
        'state_conv': nrm(8, (DEPTH, DEC_BATCH, CONV_W - 1, D_FF), 1.0),
        'w_ada': nrm(9, (DEPTH, D_MODEL, 6 * D_MODEL), 0.5 * d_scale),
        'b_ada': nrm(10, (DEPTH, 6 * D_MODEL), 0.02),
        'g_mix': 1.0 + nrm(11, (DEPTH, D_MODEL), 0.02),
        'g_ffn': 1.0 + nrm(12, (DEPTH, D_MODEL), 0.02),
        'w_in': nrm(13, (DEPTH, D_MODEL, N_IN_COLS), d_scale),
        'w_out': nrm(14, (DEPTH, D_MODEL, D_MODEL), d_scale),
        'rwkv_mu': jax.random.uniform(ks[15], (DEPTH, N_RWKV_COLS), jnp.float32),
        'rwkv_w0': jnp.linspace(-6.0, -1.0, D_RWKV, dtype=jnp.float32)[None, :] + nrm(16, (DEPTH, D_RWKV), 0.1),
        'rwkv_w2': nrm(17, (DEPTH, DECAY_LORA, D_RWKV), 0.5 * DECAY_LORA ** -0.5),
        'rwkv_a0': nrm(18, (DEPTH, D_RWKV), 0.1),
        'rwkv_a2': nrm(19, (DEPTH, AAA_LORA, D_RWKV), 0.5 * AAA_LORA ** -0.5),
        'rwkv_g2': nrm(20, (DEPTH, GATE_LORA, D_RWKV), GATE_LORA ** -0.5),
        'rwkv_kk': 0.85 + nrm(21, (DEPTH, D_RWKV), 0.02),
        'rwkv_ka': 1.0 + nrm(22, (DEPTH, D_RWKV), 0.02),
        'rwkv_rk': nrm(23, (DEPTH, N_RWKV_HEADS, RWKV_HEAD), 0.1),
        'rwkv_ln_w': 1.0 + nrm(24, (DEPTH, D_RWKV), 0.02),
        'rwkv_ln_b': nrm(25, (DEPTH, D_RWKV), 0.02),
        'diff_lq1': nrm(26, (DEPTH, DIFF_HEAD), 0.1),
        'diff_lk1': nrm(27, (DEPTH, DIFF_HEAD), 0.1),
        'diff_lq2': nrm(28, (DEPTH, DIFF_HEAD), 0.1),
        'diff_lk2': nrm(29, (DEPTH, DIFF_HEAD), 0.1),
        'diff_subln': 1.0 + nrm(30, (DEPTH, 2 * DIFF_HEAD), 0.02),
        'rel_table': nrm(31, (N_BUCKETS, N_DIFF_HEADS), 0.5),
        'ffn_up': nrm(32, (DEPTH, D_MODEL, 2 * D_FF), d_scale),
        'ffn_conv_w': nrm(33, (DEPTH, CONV_W, D_FF), CONV_W ** -0.5),
        'ffn_conv_b': nrm(34, (DEPTH, D_FF), 0.02),
        'ffn_down': nrm(35, (DEPTH, D_FF, D_MODEL), D_FF ** -0.5),
        'g_final': 1.0 + nrm(36, (D_MODEL,), 0.02),
    }


def reference(x_prompt, x_sample, c_prompt, c_sample, cache_k, cache_v, state_wkv, state_shift, state_conv,
              w_ada, b_ada, g_mix, g_ffn, w_in, w_out, rwkv_mu, rwkv_w0, rwkv_w2, rwkv_a0, rwkv_a2, rwkv_g2,
              rwkv_kk, rwkv_ka, rwkv_rk, rwkv_ln_w, rwkv_ln_b, diff_lq1, diff_lk1, diff_lq2, diff_lk2, diff_subln,
              rel_table, ffn_up, ffn_conv_w, ffn_conv_b, ffn_down, g_final):
    def layer_params(l):
        return {'w_ada': w_ada[l], 'b_ada': b_ada[l], 'g_mix': g_mix[l], 'g_ffn': g_ffn[l],
                'w_in': w_in[l], 'w_out': w_out[l], 'mu': rwkv_mu[l], 'w0': rwkv_w0[l], 'w2': rwkv_w2[l],
                'a0': rwkv_a0[l], 'a2': rwkv_a2[l], 'g2': rwkv_g2[l], 'k_k': rwkv_kk[l], 'k_a': rwkv_ka[l],
                'r_k': rwkv_rk[l], 'ln_w': rwkv_ln_w[l], 'ln_b': rwkv_ln_b[l], 'lq1': diff_lq1[l],
                'lk1': diff_lk1[l], 'lq2': diff_lq2[l], 'lk2': diff_lk2[l], 'subln': diff_subln[l],
                'ffn_up': ffn_up[l], 'conv_w': ffn_conv_w[l], 'conv_b': ffn_conv_b[l], 'ffn_down': ffn_down[l]}

    B = x_prompt.shape[0]
    xp, xs = x_prompt, x_sample
    kp, vp, wp, sp, cp = [], [], [], [], []
    ksm, vsm, wsm, ssm, csm = [], [], [], [], []
    for l in range(DEPTH):
        lp = layer_params(l)
        shift0 = jnp.zeros((B, 1, N_RWKV_COLS), x_prompt.dtype)
        wkv0 = jnp.zeros((B, N_RWKV_HEADS, RWKV_HEAD, RWKV_HEAD), jnp.float32)
        conv0 = jnp.zeros((B, CONV_W - 1, D_FF), x_prompt.dtype)
        attend_p = functools.partial(diff_attn_prompt, table=rel_table)
        xp, k_l, v_l, w_l, s_l, c_l = hybrid_layer(xp, c_prompt, l, lp, shift0, wkv0, conv0, attend_p)
        kp.append(k_l); vp.append(v_l); wp.append(w_l); sp.append(s_l); cp.append(c_l)
        attend_s = functools.partial(diff_attn_sample, k_cache=cache_k[l], v_cache=cache_v[l], table=rel_table)
        xs, k_l, v_l, w_l, s_l, c_l = hybrid_layer(xs, c_sample, l, lp, state_shift[l], state_wkv[l], state_conv[l], attend_s)
        ksm.append(k_l); vsm.append(v_l); wsm.append(w_l); ssm.append(s_l); csm.append(c_l)

    y_prompt = rms_norm(xp, g_final)
    y_sample = rms_norm(xs, g_final)
    k_prompt, v_prompt = jnp.stack(kp), jnp.stack(vp)
    wkv_prompt, shift_prompt, conv_prompt = jnp.stack(wp), jnp.stack(sp), jnp.stack(cp)
    k_sample, v_sample = jnp.stack(ksm), jnp.stack(vsm)
    wkv_sample, shift_sample, conv_sample = jnp.stack(wsm), jnp.stack(ssm), jnp.stack(csm)
    return (y_prompt, y_sample, k_prompt, v_prompt, wkv_prompt, shift_prompt, conv_prompt,
            k_sample, v_sample, wkv_sample, shift_sample, conv_sample)
```

```cpp
#include <hip/hip_runtime.h>
#include <hip/hip_bf16.h>
#include <cstdio>
#include <cstdint>
#include <cmath>
constexpr int NWAVES = 8;
constexpr int DMOD = 2048, MP = 8192, NSB = 16, TS = 16, MT = MP + NSB * TS  , PAST = 2048;
constexpr int NRC = 3520, NRC_PAD = 3584, NIN = 6592, NIN_PAD = 6656, DFF = 5632, NUP = 2 * DFF;
constexpr int NLAYER = 2, NMODB = 17, MODW = 6 * DMOD;
constexpr int RW_UNITS = 128 * 16 + NSB * 16;
constexpr size_t O_YP = 0, O_YS = O_YP + (size_t)MP * DMOD, O_KP = O_YS + (size_t)NSB * TS * DMOD, O_VP = O_KP + (size_t)NLAYER * MP * 1024, O_WP = O_VP + (size_t)NLAYER * MP * 1024,
                 O_SP = O_WP + (size_t)NLAYER * 16 * 4096, O_CP = O_SP + (size_t)NLAYER * NRC, O_KS = O_CP + (size_t)NLAYER * 2 * DFF, O_VS = O_KS + (size_t)NLAYER * 256 * 1024,
                 O_WS = O_VS + (size_t)NLAYER * 256 * 1024, O_SS = O_WS + (size_t)NLAYER * NSB * 16 * 4096, O_CS = O_SS + (size_t)NLAYER * NSB * NRC, O_END = O_CS + (size_t)NLAYER * NSB * 2 * DFF;
constexpr size_t MiB = 1u << 20;
constexpr size_t WS_CTL = 0, CTL_ZERO_BYTES = 1 * MiB;
constexpr size_t WS_MOD = 1 * MiB;
constexpr size_t WS_LORA = 3 * MiB, LORA_LAYER = (size_t)1024 * 448 * 2;
constexpr size_t WS_WIN = 5 * MiB, WS_WOUT = 57 * MiB, WS_WUP = 73 * MiB, WS_WDN = 161 * MiB;
constexpr size_t WS_H = 205 * MiB, WS_PR = 238 * MiB, WS_QB = 354 * MiB, WS_KB = 371 * MiB, WS_VB = 388 * MiB, WS_OATT = 405 * MiB, WS_YCAT = 471 * MiB, WS_X = 504 * MiB, WS_ACT = 570 * MiB;
constexpr size_t WS_PT = 661 * MiB, WS_QQ = 679 * MiB, WS_RP = 715 * MiB, WS_YV = 733 * MiB, WS_SC = 769 * MiB, WS_G1 = 787 * MiB, WS_G2 = 820 * MiB, WS_HALO = 853 * MiB, WS_WL = 858 * MiB, WS_PT32 = 859 * MiB, WS_LSCR = 895 * MiB, WS_SLAB = 911 * MiB, WS_END = 935 * MiB;
static_assert(WS_WIN + (size_t)2 * NIN_PAD * DMOD * 2 <= WS_WOUT && WS_WOUT + (size_t)2 * DMOD * DMOD * 2 <= WS_WUP && WS_WUP + (size_t)2 * NUP * DMOD * 2 <= WS_WDN && WS_WDN + (size_t)2 * DMOD * DFF * 2 <= WS_H, "weights map");
static_assert(WS_H + (size_t)MT * DMOD * 2 <= WS_PR && WS_PR + (size_t)MT * NRC_PAD * 4 <= WS_QB && WS_QB + (size_t)MT * 1024 * 2 <= WS_KB && WS_VB + (size_t)MT * 1024 * 2 <= WS_OATT && WS_OATT + (size_t)MT * DMOD * 4 <= WS_YCAT, "act map 1");
static_assert(WS_YCAT + (size_t)MT * DMOD * 2 <= WS_X && WS_X + (size_t)MT * DMOD * 4 <= WS_ACT && WS_ACT + (size_t)MT * DFF * 2 <= WS_PT, "act map 2");
static_assert(WS_PT + (size_t)RW_UNITS * 8192 <= WS_QQ && WS_QQ + (size_t)RW_UNITS * 16384 <= WS_RP && WS_RP + (size_t)RW_UNITS * 8192 <= WS_YV && WS_YV + (size_t)RW_UNITS * 16384 <= WS_SC && WS_SC + (size_t)RW_UNITS * 8192 <= WS_G1, "rwkv map");
static_assert(WS_G1 + (size_t)MT * 1024 * 4 <= WS_G2 && WS_G2 + (size_t)MT * 1024 * 4 <= WS_HALO && WS_HALO + (size_t)3 * 32 * 2 * DFF * 4 <= WS_WL && WS_WL + (size_t)RW_UNITS * 256 <= WS_PT32 && WS_PT32 + (size_t)RW_UNITS * 16384 <= WS_LSCR && WS_LSCR + (size_t)256 * 61440 <= WS_SLAB && WS_SLAB + (size_t)11 * 256 * 2048 * 4 <= WS_END && WS_LORA + 2 * LORA_LAYER <= WS_WIN && WS_MOD + (size_t)NLAYER * NMODB * MODW * 4 <= WS_LORA, "map 3");
constexpr int CW_BAR = 4096, CW_QUEUE = 8192;
constexpr int LDS_BYTES = 163840;
constexpr int MISC_OFF = LDS_BYTES - 256;
constexpr int LUT_OFF = 131072;
constexpr int HALO_OFF = 131072;
constexpr int RW_SLOT = 9216, RW_STRIDE = 72;
constexpr int RW_SCR = 154624;
static_assert(RW_SCR + 4096 <= MISC_OFF && HALO_OFF + 4096 <= MISC_OFF, "LDS map");

#define GAS __attribute__((address_space(1)))
#define LAS __attribute__((address_space(3)))
typedef unsigned short bf16;
typedef unsigned v4u __attribute__((ext_vector_type(4)));
typedef unsigned v2u __attribute__((ext_vector_type(2)));
typedef float f32x4 __attribute__((ext_vector_type(4)));
typedef float f32x2 __attribute__((ext_vector_type(2)));
typedef short bf16x8 __attribute__((ext_vector_type(8)));
typedef GAS unsigned gu32;
#define RLX_AGENT __ATOMIC_RELAXED, __HIP_MEMORY_SCOPE_AGENT
#define LDS_WAIT() asm volatile("s_waitcnt lgkmcnt(0)" ::: "memory")
#define VM_WAIT() asm volatile("s_waitcnt vmcnt(0)" ::: "memory")
typedef float cvt_f32x2 __attribute__((ext_vector_type(2))); typedef __bf16 cvt_bf16x2 __attribute__((ext_vector_type(2)));
__device__ __forceinline__ unsigned pk2(float lo, float hi) { const cvt_f32x2 v = {lo, hi}; return __builtin_bit_cast(unsigned, __builtin_convertvector(v, cvt_bf16x2)); }
__device__ __forceinline__ unsigned f2bf(float f) { return pk2(f, 0.f) & 0xffffu; }
__device__ __forceinline__ float bf2f(unsigned short b) { return __builtin_bit_cast(float, (unsigned)b << 16); }
template <int K> __device__ __forceinline__ float swz_xor(float v) { static_assert(K >= 1 && K <= 16, "");
    return __builtin_bit_cast(float, __builtin_amdgcn_ds_swizzle(__builtin_bit_cast(int, v), (K << 10) | 0x1f)); }
struct PL32 { float a, b; };
__device__ __forceinline__ PL32 pl32(float v) { const int ln = (int)(threadIdx.x & 63);
    const float p = __builtin_bit_cast(float, __builtin_amdgcn_ds_bpermute((ln ^ 32) << 2, __builtin_bit_cast(int, v))); PL32 o; o.a = v; o.b = p; return o; }
__device__ __forceinline__ float xor32(float v) { return pl32(v).b; }
template <int CTRL> __device__ __forceinline__ float dpp_f(float v) { return __builtin_bit_cast(float, __builtin_amdgcn_update_dpp(__builtin_bit_cast(int, v), __builtin_bit_cast(int, v), CTRL, 0xF, 0xF, false)); }
__device__ __forceinline__ float wave_sum(float v) {
    v += dpp_f<0xB1>(v); v += dpp_f<0x4E>(v); v += dpp_f<0x141>(v); v += dpp_f<0x128>(v); v += swz_xor<16>(v);
    const PL32 r = pl32(v); return r.a + r.b;
}
__device__ __forceinline__ float wave_max(float v) {
    v = fmaxf(v, dpp_f<0xB1>(v)); v = fmaxf(v, dpp_f<0x4E>(v)); v = fmaxf(v, dpp_f<0x141>(v)); v = fmaxf(v, dpp_f<0x128>(v)); v = fmaxf(v, swz_xor<16>(v));
    const PL32 r = pl32(v); return fmaxf(r.a, r.b);
}
__device__ __forceinline__ float sigmoidf_(float x) { return __builtin_amdgcn_rcpf(1.f + __expf(-x)); }
namespace pg8 {
#define PG8_LAS __attribute__((address_space(3)))
typedef unsigned short bf16_t;
typedef short bf16x8 __attribute__((ext_vector_type(8)));
typedef float f32x4 __attribute__((ext_vector_type(4)));
typedef unsigned u32x4 __attribute__((ext_vector_type(4)));
constexpr int BM = 256, BK = 64, HALF = 128, HTB = HALF * BK * 2  , STAGE_BYTES = 8 * HTB, NXCD = 8, WGM = 8;

__host__ __device__ __forceinline__ int lds_byte(int r, int c) { const int st = (r >> 4) * 2 + (c >> 5), rr = r & 15, cc = c & 31, ob = rr * 64 + cc * 2; return st * 1024 + (ob ^ (((ob >> 9) & 1) << 5)); }
__host__ __device__ __forceinline__ void stage_rc(int b, int& R, int& C) { const int st = b / 1024, sb = b % 1024, swz = sb ^ (((sb >> 9) & 1) << 5); R = (st >> 1) * 16 + swz / 64; C = (st & 1) * 32 + (swz % 64) / 2; }
__host__ __device__ __forceinline__ int perm32(int rho) { const int n = rho >> 4, i = rho & 15; return 8 * (i >> 2) + 4 * n + (i & 3); }

struct Unit { int pm, pn, ks, tag; };
struct Gemm { const bf16_t* A; const bf16_t* Bt; int M, N, K, ld; };

struct StaticOrder {
    static constexpr bool HANDOFF = false;
    int nM, nN, nwg, G, c;
    __host__ __device__ void init(int M, int N, int G_, int c_) { nM = M / BM; nN = N / BM; nwg = nM * nN; G = G_; c = c_; }
    __host__ __device__ bool next(int i, Unit& u) const {
        const long L = (long)i * G + c; if (L >= nwg) return false;
        int wgid = (int)L; { const int q = nwg / NXCD, r = nwg % NXCD, xcd = wgid % NXCD, off = wgid / NXCD; wgid = (xcd < r ? xcd * (q + 1) : r * (q + 1) + (xcd - r) * q) + off; }
        const int nig = WGM * nN, gid = wgid / nig, fm = gid * WGM, gsz = (nM - fm) < WGM ? (nM - fm) : WGM;
        u.pm = fm + ((wgid % nig) % gsz); u.pn = (wgid % nig) / gsz; u.ks = 0; u.tag = 0; return true;
    }
    __device__ __forceinline__ void a_ready(const Unit&) const {}
    __device__ __forceinline__ void done(const Unit&) const {}
};

struct TwoPartOrder {
    static constexpr bool HANDOFF = true;
    int nM, nA, nB, G, c; unsigned* cnt; int nsig;
    __device__ __forceinline__ void mid(const Unit& u, int t, int nt, int wid, int lane) const {
        if (cnt == nullptr || u.tag != 2) return;
        if (t == nt / 2) asm volatile("s_waitcnt vmcnt(0)" ::: "memory");
        if (t == nt / 2 + 2 && wid == 0) { __builtin_amdgcn_fence(__ATOMIC_RELEASE, "agent"); asm volatile("s_waitcnt vmcnt(0)" ::: "memory");
            if (lane == 0) (void)__hip_atomic_fetch_add(cnt, (unsigned)nsig, __ATOMIC_RELAXED, __HIP_MEMORY_SCOPE_AGENT); }
    }
    __host__ __device__ void init(int M, int NA, int NB, int G_, int c_, unsigned* cnt_, int nsig_) { nM = M / BM; nA = NA; nB = NB; G = G_; c = c_; cnt = cnt_; nsig = nsig_; }
    __host__ __device__ static void map(int wgid, int nM, int nN, Unit& u) {
        const int nwg = nM * nN; { const int q = nwg / NXCD, r = nwg % NXCD, xcd = wgid % NXCD, off = wgid / NXCD; wgid = (xcd < r ? xcd * (q + 1) : r * (q + 1) + (xcd - r) * q) + off; }
        const int nig = WGM * nN, gid = wgid / nig, fm = gid * WGM, gsz = (nM - fm) < WGM ? (nM - fm) : WGM;
        u.pm = fm + ((wgid % nig) % gsz); u.pn = (wgid % nig) / gsz; u.ks = 0;
    }
    __host__ __device__ bool next(int i, Unit& u) const {
        const long L = (long)i * G + c; const int na = nM * nA, nb = nM * nB; if (L >= na + nb) return false;
        if (L < na) map((int)L, nM, nA, u); else { map((int)L - na, nM, nB, u); u.pn += nA; }
        u.tag = i; return true;
    }
    __device__ __forceinline__ void a_ready(const Unit&) const {}
    __device__ __forceinline__ void done(const Unit&) const {}
};

struct PmFirstOrder {
    static constexpr bool HANDOFF = true;
    int nM, nN, G, c; unsigned* cnt;
    __host__ __device__ void init(int M, int N, int G_, int c_, unsigned* cnt_) { nM = M / BM; nN = N / BM; G = G_; c = c_; cnt = cnt_; }
    __host__ __device__ __forceinline__ bool next(int i, Unit& u) const {
        const long L = (long)i * G + c; if (L >= (long)nM * nN) return false;
        if (L < nN) { u.pm = nM - 1; u.pn = (int)L; u.ks = 0; } else TwoPartOrder::map((int)L - nN, nM - 1, nN, u);
        u.tag = i; return true;
    }
    __device__ __forceinline__ void a_ready(const Unit&) const {}
    __device__ __forceinline__ void done(const Unit&) const {}
    __device__ __forceinline__ void mid(const Unit& u, int t, int nt, int wid, int lane) const {
        if (cnt == nullptr || u.tag != 1 || c >= nN) return;
        if (t == nt / 2) asm volatile("s_waitcnt vmcnt(0)" ::: "memory");
        if (t == nt / 2 + 2 && wid == 0) { __builtin_amdgcn_fence(__ATOMIC_RELEASE, "agent"); asm volatile("s_waitcnt vmcnt(0)" ::: "memory");
            if (lane == 0) (void)__hip_atomic_fetch_add(cnt, 1u, __ATOMIC_RELAXED, __HIP_MEMORY_SCOPE_AGENT); }
    }
};
struct TailSplitOrder {
    static constexpr bool HANDOFF = false;
    int n, KS, k, nw;
    __host__ __device__ void init(int N, int KS_, int c_, int first, int nw_) { n = (N / BM) * KS_; KS = KS_; k = c_ - first; nw = nw_; }
    __host__ __device__ __forceinline__ bool next(int i, Unit& u) const { const int L = k + i * nw; if (k < 0 || L >= n) return false; u.pm = 0; u.pn = L / KS; u.ks = L % KS; u.tag = 0; return true; }
    __device__ __forceinline__ void a_ready(const Unit&) const {}
    __device__ __forceinline__ void done(const Unit&) const {}
};

struct SplitOrder {
    static constexpr bool HANDOFF = false;
    int n, KS, c;
    __host__ __device__ void init(int N, int KS_, int c_) { n = (N / BM) * KS_; KS = KS_; c = c_; }
    __host__ __device__ bool next(int i, Unit& u) const { if (i > 0 || c >= n) return false; u.pm = 0; u.pn = c / KS; u.ks = c % KS; u.tag = 0; return true; }
    __device__ __forceinline__ void a_ready(const Unit&) const {}
    __device__ __forceinline__ void done(const Unit&) const {}
};
__device__ __forceinline__ unsigned cvt_pk_bf16(float lo, float hi) { unsigned r; asm volatile("v_cvt_pk_bf16_f32 %0, %1, %2" : "=v"(r) : "v"(lo), "v"(hi)); return r; }
typedef float f32x2 __attribute__((ext_vector_type(2)));
__device__ __forceinline__ f32x2 gelu_pk(f32x2 v) {
    const f32x2 av = __builtin_elementwise_abs(v), d = av * 0.2316418882f + 1.0f;
    f32x2 t; t.x = __builtin_amdgcn_rcpf(d.x); t.y = __builtin_amdgcn_rcpf(d.y);
    f32x2 q = t * 0.5307027145f + (-0.7265760135f); q = q * t + 0.7107068705f; q = q * t + (-0.142248368f); q = q * t + 0.127414796f; q = q * t;
    const f32x2 s = (v * v) * (-0.72134752044f);
    f32x2 e; e.x = __builtin_amdgcn_exp2f(s.x); e.y = __builtin_amdgcn_exp2f(s.y);
    const f32x2 m = v * (q * e), r = v - m;
    f32x2 o; o.x = v.x < 0.f ? m.x : r.x; o.y = v.y < 0.f ? m.y : r.y; return o;
}

template <class Epi, class Sched, bool ALIGN_EPI = false, bool SP2 = false>
__device__ __forceinline__ void gemm_phase(PG8_LAS unsigned char* lds, const Gemm g, const Sched& S, const Epi& E) {
    int tid_ = threadIdx.x; asm volatile("" : "+v"(tid_));
    const int tid = tid_, wid = __builtin_amdgcn_readfirstlane(tid >> 6), lane = tid & 63, wr = wid >> 2, wc = wid & 3, fr = lane & 15, fq = lane >> 4;
    const int K = g.ld, nt = g.K / BK;
    unsigned voffA[2], voffB[2];
#pragma unroll
    for (int i = 0; i < 2; ++i) { int R, C; stage_rc(tid * 16 + i * 8192, R, C); const int Rb = Epi::PERM ? ((R & ~31) + perm32(R & 31)) : R;
        voffA[i] = (unsigned)(R * K + C) * 2u; voffB[i] = (unsigned)(Rb * K + C) * 2u; }
    const size_t kstep = (size_t)(BK * 2);
    const size_t hstep = (size_t)HALF * K * 2;
    const size_t tstep = 2 * hstep;
    const unsigned ldsw = (unsigned)wid * 1024u;
    const int aoff = lds_byte(wr * 64 + fr, fq * 8), boff = lds_byte(wc * 32 + fr, fq * 8);
#define PG8_SA(b, h) (((b) * 2 + (h)) * HTB)
#define PG8_SB(b, h) ((4 + (b) * 2 + (h)) * HTB)
#define PG8_STAGE(bufoff, gbase, voff) do { _Pragma("unroll") for (int _i = 0; _i < 2; ++_i) \
        __builtin_amdgcn_global_load_lds((const unsigned*)((const char*)(gbase) + (voff)[_i]), (PG8_LAS unsigned*)(lds + (bufoff) + ldsw + _i * 8192), 16, 0, 0); } while (0)
#define PG8_LDA(dst, b, h) do { _Pragma("unroll") for (int m = 0; m < 4; ++m) _Pragma("unroll") for (int k = 0; k < 2; ++k) dst[m][k] = *(const PG8_LAS bf16x8*)(lds + PG8_SA(b, h) + aoff + m * 2048 + k * 1024); } while (0)
#define PG8_LDB(dst, b, h) do { _Pragma("unroll") for (int n = 0; n < 2; ++n) _Pragma("unroll") for (int k = 0; k < 2; ++k) dst[n][k] = *(const PG8_LAS bf16x8*)(lds + PG8_SB(b, h) + boff + n * 2048 + k * 1024); } while (0)
#define PG8_MMA(ai, bj, At, Bt) do { __builtin_amdgcn_s_setprio(1); _Pragma("unroll") for (int m = 0; m < 4; ++m) _Pragma("unroll") for (int n = 0; n < 2; ++n) _Pragma("unroll") for (int k = 0; k < 2; ++k) \
        acc[ai][bj][m][n] = __builtin_amdgcn_mfma_f32_16x16x32_bf16(Bt[n][k], At[m][k], acc[ai][bj][m][n], 0, 0, 0); __builtin_amdgcn_s_setprio(0); } while (0)
#define PG8_WAIT_V(n) asm volatile("s_waitcnt vmcnt(" #n ")" ::: "memory")
#define PG8_WAIT_L(n) asm volatile("s_waitcnt lgkmcnt(" #n ")" ::: "memory")
#define PG8_BAR __builtin_amdgcn_s_barrier()
#define PG8_SCHED __builtin_amdgcn_sched_barrier(0)
    Unit cur, nxt; int ui = 0;
    if (!S.next(0, cur)) return;
    f32x4 acc[2][2][4][2];
#pragma unroll
    for (int a = 0; a < 2; ++a)
#pragma unroll
        for (int b = 0; b < 2; ++b)
#pragma unroll
            for (int m = 0; m < 4; ++m)
#pragma unroll
                for (int n = 0; n < 2; ++n) acc[a][b][m][n] = (f32x4){0.f, 0.f, 0.f, 0.f};
    bf16x8 At[4][2], B0[2][2], B1[2][2];
    const size_t sstep = (size_t)g.K * 2;
    const char* cA = (const char*)g.A + (size_t)cur.pm * tstep + (size_t)cur.ks * sstep; const char* cB = (const char*)g.Bt + (size_t)cur.pn * tstep + (size_t)cur.ks * sstep;
    S.a_ready(cur);
    if constexpr (SP2) {
        PG8_STAGE(PG8_SB(0, 0), cB, voffB); PG8_STAGE(PG8_SB(0, 1), cB + hstep, voffB); PG8_STAGE(PG8_SA(0, 0), cA, voffA); PG8_STAGE(PG8_SA(0, 1), cA + hstep, voffA);
        if (wr == 1) PG8_BAR;
        PG8_WAIT_V(2); PG8_BAR;
        PG8_STAGE(PG8_SB(1, 0), cB + kstep, voffB); PG8_STAGE(PG8_SA(1, 0), cA + kstep, voffA); PG8_STAGE(PG8_SB(1, 1), cB + hstep + kstep, voffB);
        PG8_WAIT_V(6); PG8_BAR;
    } else {
        PG8_STAGE(PG8_SB(0, 0), cB, voffB); PG8_STAGE(PG8_SA(0, 0), cA, voffA); PG8_STAGE(PG8_SB(0, 1), cB + hstep, voffB); PG8_STAGE(PG8_SA(0, 1), cA + hstep, voffA);
        if (wr == 1) PG8_BAR;
        PG8_WAIT_V(4); PG8_BAR;
        PG8_STAGE(PG8_SB(1, 0), cB + kstep, voffB); PG8_STAGE(PG8_SA(1, 0), cA + kstep, voffA); PG8_STAGE(PG8_SB(1, 1), cB + hstep + kstep, voffB);
        PG8_WAIT_V(6); PG8_BAR;
    }
    for (;;) {
        const bool has_next = S.next(ui + 1, nxt);
        const char* nA = has_next ? (const char*)g.A + (size_t)nxt.pm * tstep + (size_t)nxt.ks * sstep : cA; const char* nB = has_next ? (const char*)g.Bt + (size_t)nxt.pn * tstep + (size_t)nxt.ks * sstep : cB;
        for (int t = 0; t < nt; t += 2) {
            const bool last = (t == nt - 2);
            const char* a1 = cA + (size_t)(t + 1) * kstep;
            const char* a2 = last ? nA : cA + (size_t)(t + 2) * kstep; const char* b2 = last ? nB : cB + (size_t)(t + 2) * kstep;
            const char* a3 = a2 + kstep; const char* b3 = b2 + kstep;
            if (last && has_next) S.a_ready(nxt);
            if constexpr (Sched::HANDOFF) S.mid(cur, t, nt, wid, lane);
            if constexpr (SP2) {
            PG8_LDB(B0, 0, 0); PG8_LDB(B1, 0, 1); PG8_SCHED; PG8_LDA(At, 0, 0); PG8_STAGE(PG8_SA(1, 1), a1 + hstep, voffA);
            PG8_WAIT_V(8); PG8_WAIT_L(0); PG8_BAR; PG8_MMA(0, 0, At, B0); PG8_MMA(0, 1, At, B1); PG8_BAR; PG8_SCHED;
            PG8_LDA(At, 0, 1); PG8_STAGE(PG8_SB(0, 0), b2, voffB); PG8_STAGE(PG8_SB(0, 1), b2 + hstep, voffB); PG8_STAGE(PG8_SA(0, 0), a2, voffA);
            PG8_WAIT_V(8); PG8_WAIT_L(0); PG8_BAR; PG8_MMA(1, 0, At, B0); PG8_MMA(1, 1, At, B1); PG8_BAR; PG8_SCHED;
            PG8_LDB(B0, 1, 0); PG8_LDB(B1, 1, 1); PG8_SCHED; PG8_LDA(At, 1, 0); PG8_STAGE(PG8_SA(0, 1), a2 + hstep, voffA);
            PG8_WAIT_V(8); PG8_WAIT_L(0); PG8_BAR; PG8_MMA(0, 0, At, B0); PG8_MMA(0, 1, At, B1); PG8_BAR; PG8_SCHED;
            PG8_LDA(At, 1, 1); PG8_STAGE(PG8_SB(1, 0), b3, voffB); PG8_STAGE(PG8_SB(1, 1), b3 + hstep, voffB); PG8_STAGE(PG8_SA(1, 0), a3, voffA);
            PG8_WAIT_V(8); PG8_WAIT_L(0); PG8_BAR; PG8_MMA(1, 0, At, B0); PG8_MMA(1, 1, At, B1); PG8_BAR; PG8_SCHED;
            } else {
            PG8_LDB(B0, 0, 0); PG8_SCHED; PG8_LDA(At, 0, 0); PG8_STAGE(PG8_SA(1, 1), a1 + hstep, voffA);
            PG8_WAIT_L(8); PG8_BAR; PG8_WAIT_L(0); PG8_MMA(0, 0, At, B0); PG8_BAR; PG8_SCHED;
            PG8_LDB(B1, 0, 1); PG8_STAGE(PG8_SB(0, 0), b2, voffB);
            PG8_BAR; PG8_WAIT_L(0); PG8_MMA(0, 1, At, B1); PG8_BAR;
            PG8_LDA(At, 0, 1); PG8_STAGE(PG8_SA(0, 0), a2, voffA);
            PG8_BAR; PG8_WAIT_L(0); PG8_MMA(1, 0, At, B0); PG8_BAR; PG8_SCHED;
            PG8_STAGE(PG8_SB(0, 1), b2 + hstep, voffB);
            PG8_WAIT_V(6); PG8_BAR; PG8_MMA(1, 1, At, B1); PG8_BAR;
            PG8_LDB(B0, 1, 0); PG8_SCHED; PG8_LDA(At, 1, 0); PG8_STAGE(PG8_SA(0, 1), a2 + hstep, voffA);
            PG8_WAIT_L(8); PG8_BAR; PG8_WAIT_L(0); PG8_MMA(0, 0, At, B0); PG8_BAR; PG8_SCHED;
            PG8_LDB(B1, 1, 1); PG8_STAGE(PG8_SB(1, 0), b3, voffB);
            PG8_BAR; PG8_WAIT_L(0); PG8_MMA(0, 1, At, B1); PG8_BAR;
            PG8_LDA(At, 1, 1); PG8_STAGE(PG8_SA(1, 0), a3, voffA);
            PG8_BAR; PG8_WAIT_L(0); PG8_MMA(1, 0, At, B0); PG8_BAR; PG8_SCHED;
            PG8_STAGE(PG8_SB(1, 1), b3 + hstep, voffB);
            PG8_WAIT_V(6); PG8_BAR; PG8_MMA(1, 1, At, B1); PG8_BAR;
            }
        }
        if constexpr (ALIGN_EPI) { if (wr == 0) PG8_BAR; }
        if constexpr (!Epi::AFTER_DRAIN) { E(acc, cur, wr, wc, fr, fq); S.done(cur); }
        if (!has_next) break;
#pragma unroll
        for (int a = 0; a < 2; ++a)
#pragma unroll
            for (int b = 0; b < 2; ++b)
#pragma unroll
                for (int m = 0; m < 4; ++m)
#pragma unroll
                    for (int n = 0; n < 2; ++n) acc[a][b][m][n] = (f32x4){0.f, 0.f, 0.f, 0.f};
        cur = nxt; cA = nA; cB = nB; ++ui;
        if constexpr (ALIGN_EPI) { if (wr == 1) PG8_BAR; }
    }
    PG8_WAIT_V(0);
    if constexpr (!ALIGN_EPI) { if (wr == 0) PG8_BAR; }
    PG8_BAR;
    if constexpr (Epi::AFTER_DRAIN) { E.fused(acc, cur, wr, wc, fr, fq, lds, wid, lane); S.done(cur); }
#undef PG8_SA
#undef PG8_SB
#undef PG8_STAGE
#undef PG8_LDA
#undef PG8_LDB
#undef PG8_MMA
#undef PG8_WAIT_V
#undef PG8_WAIT_L
#undef PG8_BAR
#undef PG8_SCHED
}
}
namespace pg8 {
typedef unsigned u32x2v __attribute__((ext_vector_type(2)));
constexpr int E_MP = 8192;
struct EpiIn {
    static constexpr bool PERM = true, AFTER_DRAIN = false;
    unsigned char* ws; float* out; int l; float qscale;
    __device__ __forceinline__ void operator()(const f32x4 (&acc)[2][2][4][2], const Unit& u, int wr, int wc, int fr, int fq) const {
        asm volatile("" : "+v"(fr), "+v"(fq));
        const int row0 = u.pm * BM + wr * 64 + fr, colt = u.pn * BM + wc * 32 + 8 * fq;
        if (u.pn < 14) {
            float* PR = (float*)(ws + WS_PR); float* sh_p = out + O_SP + (size_t)l * 3520; float* sh_s = out + O_SS + (size_t)l * 16 * 3520;
#pragma unroll
            for (int ai = 0; ai < 2; ++ai)
#pragma unroll
                for (int m = 0; m < 4; ++m) { const int r = row0 + ai * HALF + m * 16;
#pragma unroll
                    for (int bj = 0; bj < 2; ++bj) { const int c = colt + bj * HALF; float* p = PR + (size_t)r * 3584 + c;
                        *(f32x4*)p = acc[ai][bj][m][0]; *(f32x4*)(p + 4) = acc[ai][bj][m][1];
                        if (c < 3520) {
                            if (r == E_MP - 1) { *(f32x4*)(sh_p + c) = acc[ai][bj][m][0]; *(f32x4*)(sh_p + c + 4) = acc[ai][bj][m][1]; }
                            if (r >= E_MP && (r & 15) == 15) { float* q = sh_s + (size_t)((r - E_MP) >> 4) * 3520 + c; *(f32x4*)q = acc[ai][bj][m][0]; *(f32x4*)(q + 4) = acc[ai][bj][m][1]; }
                        } } }
        } else {
            const int region = (u.pn - 14) >> 2, cl0 = colt - 3584 - region * 1024;
            static_assert(WS_KB - WS_QB == WS_VB - WS_KB && O_VP - O_KP == (size_t)2 * 8192 * 1024 && O_VS - O_KS == (size_t)2 * 256 * 1024, "equal spacing");
            bf16_t* B16 = (bf16_t*)(ws + WS_QB + (size_t)region * (WS_KB - WS_QB));
            const float sc = region == 0 ? qscale : 1.f;
            float* fp = out + O_KP + (size_t)(region == 2 ? 1 : 0) * (O_VP - O_KP) + (size_t)l * E_MP * 1024; float* fs = out + O_KS + (size_t)(region == 2 ? 1 : 0) * (O_VS - O_KS) + (size_t)l * 256 * 1024;
#pragma unroll
            for (int ai = 0; ai < 2; ++ai)
#pragma unroll
                for (int m = 0; m < 4; ++m) { const int r = row0 + ai * HALF + m * 16;
                    float* fo = (r < E_MP) ? fp + (size_t)r * 1024 : fs + (size_t)(r - E_MP) * 1024;
#pragma unroll
                    for (int bj = 0; bj < 2; ++bj) { const int c = cl0 + bj * HALF; const f32x4 v0 = acc[ai][bj][m][0] * sc, v1 = acc[ai][bj][m][1] * sc;
                        u32x4 w; w.x = cvt_pk_bf16(v0[0], v0[1]); w.y = cvt_pk_bf16(v0[2], v0[3]); w.z = cvt_pk_bf16(v1[0], v1[1]); w.w = cvt_pk_bf16(v1[2], v1[3]);
                        *(u32x4*)(B16 + (size_t)r * 1024 + c) = w;
                        if (region != 0) { __builtin_nontemporal_store(v0, (f32x4*)(fo + c)); __builtin_nontemporal_store(v1, (f32x4*)(fo + c + 4)); } } }
        }
    }
};
struct EpiRes {
    static constexpr bool PERM = true, AFTER_DRAIN = false;
    const float* src_p; const float* src_s; float* dst; const float* gate;
    __device__ __forceinline__ void operator()(const f32x4 (&acc)[2][2][4][2], const Unit& u, int wr, int wc, int fr, int fq) const {
        asm volatile("" : "+v"(fr), "+v"(fq));
        const int row0 = u.pm * BM + wr * 64 + fr, colt = u.pn * BM + wc * 32 + 8 * fq;
#pragma unroll
        for (int ai = 0; ai < 2; ++ai)
#pragma unroll
            for (int m = 0; m < 4; ++m) { const int r = row0 + ai * HALF + m * 16;
                const int bidx = r < E_MP ? 0 : 1 + ((r - E_MP) >> 4);
                const float* s = (r < E_MP ? src_p + (size_t)r * 2048 : src_s + (size_t)(r - E_MP) * 2048) + colt;
                const float* g = gate + (size_t)bidx * 12288 + colt; float* d = dst + (size_t)r * 2048 + colt;
#pragma unroll
                for (int bj = 0; bj < 2; ++bj)
#pragma unroll
                    for (int n = 0; n < 2; ++n) { const int o = bj * HALF + 4 * n; const f32x4 x = *(const f32x4*)(s + o), gt = *(const f32x4*)(g + o); *(f32x4*)(d + o) = x + gt * acc[ai][bj][m][n]; } }
    }
};
struct EpiResSlab {
    static constexpr bool PERM = true, AFTER_DRAIN = false;
    float* slab; const float* gate;
    __device__ __forceinline__ void operator()(const f32x4 (&acc)[2][2][4][2], const Unit& u, int wr, int wc, int fr, int fq) const {
        asm volatile("" : "+v"(fr), "+v"(fq));
        const int row0 = wr * 64 + fr, colt = u.pn * BM + wc * 32 + 8 * fq;
#pragma unroll
        for (int ai = 0; ai < 2; ++ai)
#pragma unroll
            for (int m = 0; m < 4; ++m) { const int r = row0 + ai * HALF + m * 16;
                const float* g = gate + (size_t)(1 + (r >> 4)) * 12288 + colt; float* d = slab + ((size_t)u.ks * 256 + r) * 2048 + colt;
#pragma unroll
                for (int bj = 0; bj < 2; ++bj)
#pragma unroll
                    for (int n = 0; n < 2; ++n) { const int o = bj * HALF + 4 * n; const f32x4 gt = *(const f32x4*)(g + o); *(f32x4*)(d + o) = gt * acc[ai][bj][m][n]; } }
    }
};
template <int CTRL> __device__ __forceinline__ float dppf(float old, float src) { return __builtin_bit_cast(float, __builtin_amdgcn_update_dpp(__builtin_bit_cast(int, old), __builtin_bit_cast(int, src), CTRL, 0xF, 0xF, false)); }
struct EpiUp {
    static constexpr bool PERM = true, AFTER_DRAIN = false;
    bf16_t* ACT; const float* cw; const float* cb; const float* sconv; float* halo; float* conv_p; float* conv_s; PG8_LAS float* hb;
    template <bool SAMP> __device__ __forceinline__ void run(const f32x4 (&acc)[2][2][4][2], const Unit& u, int wr, int wc, int fr, int fq) const {
        asm volatile("" : "+v"(fr), "+v"(fq));
        const int jl = wc * 32 + 8 * fq, j0 = u.pn * HALF + jl;
#pragma unroll
        for (int ai = 0; ai < 2; ++ai) { const int blk = 2 * ai + wr;
            if (!SAMP && fr >= 14) {
                if (blk < 3) { PG8_LAS float* h = hb + ((blk + 1) * 2 + (fr - 14)) * HALF + jl; *(PG8_LAS f32x4*)h = acc[ai][0][3][0]; *(PG8_LAS f32x4*)(h + 4) = acc[ai][0][3][1]; }
                else { float* t = halo + ((size_t)u.pm * 2 + (fr - 14)) * 5632 + j0; *(f32x4*)t = acc[ai][0][3][0]; *(f32x4*)(t + 4) = acc[ai][0][3][1];
                    if (u.pm == 31) { float* c = conv_p + (size_t)(fr - 14) * 5632 + j0; *(f32x4*)c = acc[ai][0][3][0]; *(f32x4*)(c + 4) = acc[ai][0][3][1]; } }
            }
            if (SAMP && fr >= 14) {
#pragma unroll
                for (int m = 0; m < 4; ++m) { const int sb = 8 * ai + 4 * wr + m; float* c = conv_s + ((size_t)sb * 2 + (fr - 14)) * 5632 + j0; *(f32x4*)c = acc[ai][0][m][0]; *(f32x4*)(c + 4) = acc[ai][0][m][1]; }
            }
        }
        asm volatile("s_waitcnt lgkmcnt(0)\n\ts_barrier" ::: "memory");
#pragma unroll
        for (int ai = 0; ai < 2; ++ai) { const int blk = 2 * ai + wr;
#pragma unroll
            for (int m = 0; m < 4; ++m) { const int r = u.pm * BM + ai * HALF + wr * 64 + m * 16 + fr;
                u32x4 w;
#pragma unroll
                for (int n = 0; n < 2; ++n) {
                    f32x4 pv = (f32x4){0.f, 0.f, 0.f, 0.f};
                    if (SAMP) { if (fr >= 14) { const int sb = 8 * ai + 4 * wr + m; pv = *(const f32x4*)(sconv + ((size_t)sb * 2 + (fr - 14)) * 5632 + j0 + 4 * n); } asm volatile("" : "+v"(pv)); }
                    else if (m == 0) { if (blk > 0 && fr >= 14) pv = *(const PG8_LAS f32x4*)(hb + (blk * 2 + (fr - 14)) * HALF + jl + 4 * n); asm volatile("" : "+v"(pv)); }
                    else pv = acc[ai][0][m > 0 ? m - 1 : 0][n];
                    const f32x4 w0 = *(const f32x4*)(cw + j0 + 4 * n), w1 = *(const f32x4*)(cw + 5632 + j0 + 4 * n), w2 = *(const f32x4*)(cw + 2 * 5632 + j0 + 4 * n), bb = *(const f32x4*)(cb + j0 + 4 * n);
                    f32x4 o;
#pragma unroll
                    for (int i = 0; i < 4; ++i) { const float cur = acc[ai][0][m][n][i], pr = pv[i];
                        const float t1 = dppf<0x121>(pr, pr), p1 = dppf<0x111>(t1, cur);
                        const float t2 = dppf<0x122>(pr, pr), p2 = dppf<0x112>(t2, cur);
                        o[i] = bb[i] + w0[i] * p2 + w1[i] * p1 + w2[i] * cur; }
                    const f32x2 g0 = gelu_pk((f32x2){o[0], o[1]}), g1 = gelu_pk((f32x2){o[2], o[3]});
                    const f32x4 uv = acc[ai][1][m][n];
                    const unsigned lo = cvt_pk_bf16(g0.x * uv[0], g0.y * uv[1]), hi = cvt_pk_bf16(g1.x * uv[2], g1.y * uv[3]);
                    if (n == 0) { w.x = lo; w.y = hi; } else { w.z = lo; w.w = hi; }
                }
                const bool head = (!SAMP && u.pm > 0 && blk == 0 && m == 0 && fr < 2);
                if (!head) *(u32x4*)(ACT + (size_t)r * 5632 + j0) = w;
                else { float* hg = halo + (size_t)32 * 2 * 5632 + ((size_t)u.pm * 2 + fr) * 5632 + j0; float* hv = hg + (size_t)32 * 2 * 5632;
                    *(f32x4*)hg = acc[ai][0][m][0]; *(f32x4*)(hg + 4) = acc[ai][0][m][1]; *(f32x4*)hv = acc[ai][1][m][0]; *(f32x4*)(hv + 4) = acc[ai][1][m][1]; }
                asm volatile("" ::: "memory");
            } }
    }
    __device__ __forceinline__ void operator()(const f32x4 (&acc)[2][2][4][2], const Unit& u, int wr, int wc, int fr, int fq) const {
        if (u.pm == 32) run<true>(acc, u, wr, wc, fr, fq); else run<false>(acc, u, wr, wc, fr, fq);
    }
};
}
#include <hip/hip_bf16.h>
#include <cmath>
namespace attn_body {
using bf16=__hip_bfloat16;
using bf16x8=__attribute__((ext_vector_type(8)))short;
using s16x4=__attribute__((ext_vector_type(4)))short;
using f32x16=__attribute__((ext_vector_type(16)))float;
using u32x4=__attribute__((ext_vector_type(4)))unsigned;
constexpr int BATCH=1,NHEAD=16,SEQ=8192,D=64,DM=NHEAD*D;
constexpr int NW=8,QBLK=32,QB=QBLK*NW,KVBLK=64,NQB=SEQ/QB;
constexpr int ATTN_PITCH=DM, ATTN_UNIT_ROWS=QB, OPITCH=2048;
__device__ __forceinline__ int crow(int r,int hi){return (r&3)+8*(r>>2)+4*hi;}
#define SBAR() __builtin_amdgcn_sched_barrier(0)
__device__ __forceinline__ void bmask(f32x16&p0,f32x16&p1,int t,int cq,int qabs,int hi,const __attribute__((address_space(3))) float*lut){
  if(t>cq){
    #pragma unroll
    for(int r=0;r<16;++r){p0[r]=-INFINITY;p1[r]=-INFINITY;}
  } else {
    const int d0=64*t+4*hi-qabs+128;
    #pragma unroll
    for(int r=0;r<16;++r){int i0=d0+(r&3)+8*(r>>2); int i1=i0+32; i0=i0<0?0:i0; i1=i1<0?0:i1; p0[r]+=lut[i0]; p1[r]+=lut[i1];}
  }
}

constexpr int NSLOT=3, SLOTB=8192;
constexpr int LDS_K=0, LDS_V=NSLOT*SLOTB, LDS_WS=2*NSLOT*SLOTB, LDS_OST=LDS_WS+NW*64*4, LDS_BYTES=LDS_OST+NW*4096;
constexpr float C2=0.125f*1.4426950408889634f;
__device__ __forceinline__ void glds16(const void*gsrc,unsigned lds_dst){unsigned keep;
  asm volatile("s_mov_b32 %0, m0\n\ts_mov_b32 m0, %2\n\ts_nop 0\n\tglobal_load_lds_dwordx4 %1, off\n\ts_mov_b32 m0, %0":"=&s"(keep):"v"(gsrc),"s"(lds_dst):"memory");}
__device__ __forceinline__ float max3f(float a,float b,float c){float r;asm("v_max3_f32 %0, %1, %2, %3":"=v"(r):"v"(a),"v"(b),"v"(c));return r;}
__device__ __forceinline__ float max2f(float a,float b){float r;asm("v_max_f32_e32 %0, %1, %2":"=v"(r):"v"(a),"v"(b));return r;}
__device__ __forceinline__ float fadd_s(float a,float b){float r;asm("v_add_f32_e32 %0, %1, %2":"=v"(r):"v"(a),"v"(b));return r;}
__device__ __forceinline__ float fsub_s(float a,float b){float r;asm("v_sub_f32_e32 %0, %1, %2":"=v"(r):"v"(a),"v"(b));return r;}
typedef float f32x2_t __attribute__((ext_vector_type(2))); typedef __bf16 bf16x2_t __attribute__((ext_vector_type(2)));
__device__ __forceinline__ unsigned cvtpk_s(float lo,float hi){f32x2_t v={lo,hi};bf16x2_t b=__builtin_convertvector(v,bf16x2_t);return __builtin_bit_cast(unsigned,b);}
#define WAIT_BAR(N) asm volatile("s_waitcnt vmcnt(" #N ") lgkmcnt(0)\n\ts_barrier":::"memory")

__device__ __forceinline__ void qkt(f32x16&p0,f32x16&p1,const char*Kslot,const bf16x8*qr,const f32x16&negm,int r32,int hi){
  const char*kb=Kslot+hi*1024+r32*16;
  #pragma unroll
  for(int d0=0;d0<4;++d0){
    const bf16x8 b0=*reinterpret_cast<const bf16x8*>(kb+d0*2048);
    const bf16x8 b1=*reinterpret_cast<const bf16x8*>(kb+d0*2048+512);
    if(d0==0){p0=__builtin_amdgcn_mfma_f32_32x32x16_bf16(b0,qr[0],negm,0,0,0);p1=__builtin_amdgcn_mfma_f32_32x32x16_bf16(b1,qr[0],negm,0,0,0);}
    else{p0=__builtin_amdgcn_mfma_f32_32x32x16_bf16(b0,qr[d0],p0,0,0,0);p1=__builtin_amdgcn_mfma_f32_32x32x16_bf16(b1,qr[d0],p1,0,0,0);}}
}
typedef __attribute__((address_space(3))) const char* lds_cptr;
typedef short v4i16_t __attribute__((ext_vector_type(4)));
__device__ __forceinline__ void kload8(bf16x8*kf,lds_cptr kp){
  kf[0]=*(const __attribute__((address_space(3))) bf16x8*)(kp);      kf[1]=*(const __attribute__((address_space(3))) bf16x8*)(kp+512);
  kf[2]=*(const __attribute__((address_space(3))) bf16x8*)(kp+2048); kf[3]=*(const __attribute__((address_space(3))) bf16x8*)(kp+2560);
  kf[4]=*(const __attribute__((address_space(3))) bf16x8*)(kp+4096); kf[5]=*(const __attribute__((address_space(3))) bf16x8*)(kp+4608);
  kf[6]=*(const __attribute__((address_space(3))) bf16x8*)(kp+6144); kf[7]=*(const __attribute__((address_space(3))) bf16x8*)(kp+6656);
}
__device__ __forceinline__ void kload2(bf16x8*kf,lds_cptr kp,int j){ kf[2*j]=*(const __attribute__((address_space(3))) bf16x8*)(kp+j*2048); kf[2*j+1]=*(const __attribute__((address_space(3))) bf16x8*)(kp+j*2048+512); }
__device__ __forceinline__ s16x4 vtr(lds_cptr p){ return __builtin_bit_cast(s16x4,__builtin_amdgcn_ds_read_tr16_b64_v4i16((__attribute__((address_space(3))) v4i16_t*)p)); }
__device__ __forceinline__ float rowmax(const f32x16&p0,const f32x16&p1){
  float a=max3f(p0[0],p0[1],p1[0]),b=max3f(p0[2],p0[3],p1[1]);a=max3f(a,p1[2],p1[3]);
  #pragma unroll
  for(int r=4;r<16;r+=4){a=max3f(a,p0[r],p0[r+1]);b=max3f(b,p0[r+2],p0[r+3]);a=max3f(a,p1[r],p1[r+1]);b=max3f(b,p1[r+2],p1[r+3]);}
  const float m=max2f(a,b);
  const PL32 rr=pl32(m);
  return max2f(rr.a,rr.b);
}
__device__ __forceinline__ void pv(f32x16*o,int vb,bf16x8 pa0,bf16x8 pa1,bf16x8 pa2,bf16x8 pa3){
  #pragma unroll
  for(int d0=0;d0<2;++d0){s16x4 lo[4],hi[4];
    #pragma unroll
    for(int ks=0;ks<4;++ks){
      asm volatile("ds_read_b64_tr_b16 %0,%1 offset:%c2":"=&v"(lo[ks]):"v"(vb),"i"(d0*4096+ks*1024):"memory");
      asm volatile("ds_read_b64_tr_b16 %0,%1 offset:%c2":"=&v"(hi[ks]):"v"(vb),"i"(d0*4096+ks*1024+512):"memory");}
    asm volatile("s_waitcnt lgkmcnt(0)":::"memory");SBAR();
    #define PK(k) (bf16x8){lo[k][0],lo[k][1],lo[k][2],lo[k][3],hi[k][0],hi[k][1],hi[k][2],hi[k][3]}
    o[d0]=__builtin_amdgcn_mfma_f32_32x32x16_bf16(pa0,PK(0),o[d0],0,0,0);
    o[d0]=__builtin_amdgcn_mfma_f32_32x32x16_bf16(pa1,PK(1),o[d0],0,0,0);
    o[d0]=__builtin_amdgcn_mfma_f32_32x32x16_bf16(pa2,PK(2),o[d0],0,0,0);
    o[d0]=__builtin_amdgcn_mfma_f32_32x32x16_bf16(pa3,PK(3),o[d0],0,0,0);
    #undef PK
  }
}

#ifndef ATTN_STORE16
#define ATTN_STORE16(p,v) (*(u32x4*)(p)=(v))
#endif
template<int THRL> __device__ __forceinline__ void attn_unit(int qb,int qkcol,int vcol,int ocol,int hh,const float*__restrict__ reltab,const bf16*Q,const bf16*__restrict__ K,const bf16*__restrict__ V,bf16*O,char*shm,const __attribute__((address_space(3))) float*lut){
  const int b=0;
  int tid_=threadIdx.x; asm volatile("":"+v"(tid_));
  const int tid=tid_,lane=tid&63,r32=lane&31,hi=lane>>5; const int wid=__builtin_amdgcn_readfirstlane(tid>>6);
  const long rowbase=(long)b*SEQ; const int q0=qb*QB;
  const bf16*Qw=Q+(rowbase+q0+wid*QBLK)*DM+qkcol;
  const bf16*Kh=K+rowbase*DM+qkcol,*Vh=V+rowbase*DM+vcol;
  const unsigned lds0=(unsigned)(uintptr_t)shm;
  float*wsf=(float*)(shm+LDS_WS)+wid*64;
  const bf16*ksrc=Kh+(long)lane*DM+wid*8;
  const bf16*vsrc=Vh+(long)(16*(wid&3)+(lane>>2))*DM+(wid>>2)*32+(lane&3)*8;
  const unsigned kdst=lds0+LDS_K+wid*1024, vdst=lds0+LDS_V+wid*1024;
  #define DMA_K(t,slot) glds16(ksrc+(long)(t)*KVBLK*DM,(unsigned)__builtin_amdgcn_readfirstlane(kdst+(slot)))
  #define DMA_V(t,slot) glds16(vsrc+(long)(t)*KVBLK*DM,(unsigned)__builtin_amdgcn_readfirstlane(vdst+(slot)))
  const int vb0=(int)(lds0+LDS_V)+((lane>>4)&1)*32+(lane&3)*8+(4*hi+((lane&15)>>2))*64;
  const char*Kbase=shm+LDS_K; bf16x8 kf[8];
  const lds_cptr shm3=(lds_cptr)shm; const lds_cptr kp0=shm3+LDS_K+hi*1024+r32*16; const lds_cptr vp0=shm3+LDS_V+((lane>>4)&1)*32+(lane&3)*8+(4*hi+((lane&15)>>2))*64;
  const int NT=(q0+QB)/KVBLK;
  const int cq=(q0>>6)+(wid>>1), cqm2=cq-2, qabs=q0+wid*QBLK+r32;
  DMA_K(0,0);DMA_V(0,0);DMA_K(1,SLOTB);
  bf16x8 qr[4];
  #pragma unroll
  for(int d0=0;d0<4;++d0)qr[d0]=*reinterpret_cast<const bf16x8*>(&Qw[(long)r32*DM+d0*16+hi*8]);
  float mhat=0.f,l_reg=0.f;f32x16 o[2];o[0]=f32x16{};o[1]=f32x16{};f32x16 negm=f32x16{};asm volatile("":"+v"(negm));
  const int qrel=wid*QBLK+r32;
  #define CMASK(P0,P1,t) do{ if((t)>=cqm2)bmask(P0,P1,(t),cq,qabs,hi,lut);}while(0)
  bool resc=false;
  #define START(P0,P1) do{ const float rm=rowmax(P0,P1); resc=false; \
    { const float dl=rm; mhat=fadd_s(mhat,dl); \
      _Pragma("unroll") for(int r=0;r<16;++r){P0[r]=fsub_s(P0[r],dl);P1[r]=fsub_s(P1[r],dl);} \
      _Pragma("unroll") for(int r=0;r<16;++r)negm[r]=-mhat; asm volatile("":"+v"(negm)); } \
    _Pragma("unroll") for(int r=0;r<16;++r)P0[r]=__builtin_amdgcn_exp2f(P0[r]); }while(0)
  #define RESC() do{ if(resc){ asm volatile("s_waitcnt lgkmcnt(0)":::"memory"); \
      _Pragma("unroll") for(int d_=0;d_<2;++d_) _Pragma("unroll") for(int r=0;r<16;++r)o[d_][r]*=wsf[crow(r,hi)]; } }while(0)
  f32x16 pA0,pA1,pB0,pB1;
  int sl_prev=0,sl_cur=0,sl_next=SLOTB;
  #define ROT() do{sl_prev=sl_cur;sl_cur=sl_next;sl_next=(sl_next==(NSLOT-1)*SLOTB)?0:sl_next+SLOTB;}while(0)
  DMA_K(2,2*SLOTB);
  WAIT_BAR(3);
  qkt(pA0,pA1,Kbase,qr,negm,r32,hi);asm volatile("s_nop 15\n\ts_nop 7":"+v"(pA0),"+v"(pA1));CMASK(pA0,pA1,0);
  START(pA0,pA1);
  _Pragma("unroll") for(int r=0;r<16;++r)pA1[r]=__builtin_amdgcn_exp2f(pA1[r]);
  WAIT_BAR(0);
  DMA_K(3,0);DMA_V(1,SLOTB);
  ROT();
  kload8(kf,kp0+sl_cur);
  WAIT_BAR(2);
  s16x4 vlo[8],vhi[8]; u32x4 pw0,pw1,pw2,pw3;
  #define PKW(P,B) cvtpk_s(P[B],P[B+1])
  #define PAF(k) __builtin_bit_cast(bf16x8,pw##k)
  #define VFR(i) (bf16x8){vlo[i][0],vlo[i][1],vlo[i][2],vlo[i][3],vhi[i][0],vhi[i][1],vhi[i][2],vhi[i][3]}
  #define PIN(x) asm volatile("":"+v"(x))
  #define MX3(a,b,c) __builtin_fmaxf(__builtin_fmaxf((a),(b)),(c))
  #define GAPA(MF,A0,A1,A2,A3,W0,W1,PW) do{ MF; sacc+=A0; sacc+=A1; sacc+=A2; sacc+=A3; PIN(sacc); W0; W1; PIN(PW); SBAR(); }while(0)
  #define EX(v) __builtin_amdgcn_exp2f(v)
  #define GAPB(MF,X,B) do{ MF; X[B]=EX(X[B]); X[B+1]=EX(X[B+1]); X[B+2]=EX(X[B+2]); X[B+3]=EX(X[B+3]); PIN(X); SBAR(); }while(0)
  #define VRD(i) do{ vlo[i]=vtr(vp_+(((i)>>2)*4096+((i)&3)*1024)); vhi[i]=vtr(vp_+(((i)>>2)*4096+((i)&3)*1024+512)); }while(0)
  #define KRD(G,j) do{ if(G){ kload2(kf,kp0+sl_next,j); SBAR(); } }while(0)
  #define STEP(C0,C1,P0,P1,t,GK,GV,GL) do{ SBAR(); \
    const lds_cptr vp_=vp0+sl_prev; \
    VRD(0); SBAR(); float sacc=(P0[0]+P0[1]); \
    GAPA(C0=__builtin_amdgcn_mfma_f32_32x32x16_bf16(kf[0],qr[0],negm,0,0,0), P0[2],P0[3],P0[4],P0[5],     pw0[0]=PKW(P0,0), pw0[1]=PKW(P0,2), pw0); \
    VRD(4); SBAR(); GAPA(C1=__builtin_amdgcn_mfma_f32_32x32x16_bf16(kf[1],qr[0],negm,0,0,0), P0[6],P0[7],P0[8],P0[9],     pw0[2]=PKW(P0,4), pw0[3]=PKW(P0,6), pw0); \
    VRD(1); SBAR(); GAPA(C0=__builtin_amdgcn_mfma_f32_32x32x16_bf16(kf[2],qr[1],C0,0,0,0),   P0[10],P0[11],P0[12],P0[13], pw1[0]=PKW(P0,8), pw1[1]=PKW(P0,10), pw1); \
    VRD(5); SBAR(); GAPA(C1=__builtin_amdgcn_mfma_f32_32x32x16_bf16(kf[3],qr[1],C1,0,0,0),   P0[14],P0[15],P1[0],P1[1],   pw1[2]=PKW(P0,12),pw1[3]=PKW(P0,14), pw1); \
    VRD(2); SBAR(); GAPA(C0=__builtin_amdgcn_mfma_f32_32x32x16_bf16(kf[4],qr[2],C0,0,0,0),   P1[2],P1[3],P1[4],P1[5],     pw2[0]=PKW(P1,0), pw2[1]=PKW(P1,2), pw2); \
    VRD(6); SBAR(); GAPA(C1=__builtin_amdgcn_mfma_f32_32x32x16_bf16(kf[5],qr[2],C1,0,0,0),   P1[6],P1[7],P1[8],P1[9],     pw2[2]=PKW(P1,4), pw2[3]=PKW(P1,6), pw2); \
    VRD(3); SBAR(); GAPA(C0=__builtin_amdgcn_mfma_f32_32x32x16_bf16(kf[6],qr[3],C0,0,0,0),   P1[10],P1[11],P1[12],P1[13], pw3[0]=PKW(P1,8), pw3[1]=PKW(P1,10), pw3); \
    VRD(7); SBAR(); GAPA(C1=__builtin_amdgcn_mfma_f32_32x32x16_bf16(kf[7],qr[3],C1,0,0,0),   P1[14],P1[15],0.f,0.f,       pw3[2]=PKW(P1,12),pw3[3]=PKW(P1,14), pw3); \
    l_reg+=sacc; \
    if(GK){DMA_K((t)+3,sl_cur);} if(GV){DMA_V((t)+1,sl_next);} \
    CMASK(C0,C1,t); \
    { float a=MX3(C0[0],C0[1],C1[0]),b=MX3(C0[2],C0[3],C1[1]); a=MX3(a,C1[2],C1[3]); \
      _Pragma("unroll") for(int r=4;r<16;r+=4){a=MX3(a,C0[r],C0[r+1]);b=MX3(b,C0[r+2],C0[r+3]);a=MX3(a,C1[r],C1[r+1]);b=MX3(b,C1[r+2],C1[r+3]);} \
      float rm=__builtin_fmaxf(a,b); { const PL32 rr=pl32(rm); rm=__builtin_fmaxf(rr.a,rr.b); } \
      resc=false; \
      if(__builtin_expect(__any(rm>(float)THRL),0)){ const float dl=__builtin_fmaxf(rm,0.f); mhat+=dl; \
        _Pragma("unroll") for(int r=0;r<16;++r){C0[r]-=dl;C1[r]-=dl;} \
        _Pragma("unroll") for(int r=0;r<16;++r)negm[r]=-mhat; asm volatile("":"+v"(negm)); \
        const float f=__builtin_amdgcn_exp2f(-dl); l_reg*=f; if(hi==0)wsf[r32]=f; resc=true; } } \
    SBAR(); \
    GAPB(o[0]=__builtin_amdgcn_mfma_f32_32x32x16_bf16(PAF(0),VFR(0),o[0],0,0,0), C0,0); \
    GAPB(o[1]=__builtin_amdgcn_mfma_f32_32x32x16_bf16(PAF(0),VFR(4),o[1],0,0,0), C0,4); \
    KRD(GL,0); GAPB(o[0]=__builtin_amdgcn_mfma_f32_32x32x16_bf16(PAF(1),VFR(1),o[0],0,0,0), C0,8); \
    KRD(GL,1); GAPB(o[1]=__builtin_amdgcn_mfma_f32_32x32x16_bf16(PAF(1),VFR(5),o[1],0,0,0), C0,12); \
    KRD(GL,2); GAPB(o[0]=__builtin_amdgcn_mfma_f32_32x32x16_bf16(PAF(2),VFR(2),o[0],0,0,0), C1,0); \
    KRD(GL,3); GAPB(o[1]=__builtin_amdgcn_mfma_f32_32x32x16_bf16(PAF(2),VFR(6),o[1],0,0,0), C1,4); \
    GAPB(o[0]=__builtin_amdgcn_mfma_f32_32x32x16_bf16(PAF(3),VFR(3),o[0],0,0,0), C1,8); \
    GAPB(o[1]=__builtin_amdgcn_mfma_f32_32x32x16_bf16(PAF(3),VFR(7),o[1],0,0,0), C1,12); \
    }while(0)
  int t=1;
  #undef CMASK
  #define CMASK(P0,P1,t) do{}while(0)
  for(;t+7<NT;t+=2){
    STEP(pB0,pB1,pA0,pA1,t,true,true,true);     WAIT_BAR(2); RESC(); ROT();
    STEP(pA0,pA1,pB0,pB1,t+1,true,true,true);   WAIT_BAR(2); RESC(); ROT();
  }
  #undef CMASK
  #define CMASK(P0,P1,t) do{ if((t)>=cqm2)bmask(P0,P1,(t),cq,qabs,hi,lut);}while(0)
  #define ENDW(tt) do{ if((tt)+3<NT){WAIT_BAR(2);} else if((tt)+2<NT){WAIT_BAR(1);} else {WAIT_BAR(0);} }while(0)
  for(;t+1<NT;t+=2){
    STEP(pB0,pB1,pA0,pA1,t,(t+3<NT),(t+1<NT),(t+1<NT));       ENDW(t);   RESC(); ROT();
    STEP(pA0,pA1,pB0,pB1,t+1,(t+4<NT),(t+2<NT),(t+2<NT));     ENDW(t+1); RESC(); ROT();
  }
  STEP(pB0,pB1,pA0,pA1,NT-1,false,false,false); RESC();
  { float sacc=pB0[0]+pB0[1]; _Pragma("unroll") for(int r=2;r<16;++r)sacc+=pB0[r]; _Pragma("unroll") for(int r=0;r<16;++r)sacc+=pB1[r]; l_reg+=sacc;
    pw0=(u32x4){PKW(pB0,0),PKW(pB0,2),PKW(pB0,4),PKW(pB0,6)};pw1=(u32x4){PKW(pB0,8),PKW(pB0,10),PKW(pB0,12),PKW(pB0,14)};pw2=(u32x4){PKW(pB1,0),PKW(pB1,2),PKW(pB1,4),PKW(pB1,6)};pw3=(u32x4){PKW(pB1,8),PKW(pB1,10),PKW(pB1,12),PKW(pB1,14)};
    SBAR(); pv(o,vb0+sl_cur,PAF(0),PAF(1),PAF(2),PAF(3)); }
  #undef PKW
  #undef PAF
  #undef VFR
  #undef PIN
  #undef MX3
  #undef GAPA
  #undef GAPB
  #undef EX
  #undef VRD
  #undef KRD
  #undef STEP
  #undef ENDW
  {const PL32 rr=pl32(l_reg);l_reg=rr.a+rr.b;}
  if(hi==0)wsf[32+r32]=l_reg;asm volatile("s_waitcnt lgkmcnt(0)":::"memory");
  float rli[16];
  #pragma unroll
  for(int r=0;r<16;++r)rli[r]=__builtin_amdgcn_rcpf(wsf[32+crow(r,hi)]);
  bf16*Ow=O+(rowbase+q0+wid*QBLK)*(long)OPITCH+ocol;
  { bf16*stg=(bf16*)(shm+LDS_OST)+wid*2048;
    #pragma unroll
    for(int r=0;r<16;++r){const int orow=crow(r,hi);
      #pragma unroll
      for(int d0=0;d0<2;++d0)stg[orow*64+d0*32+r32]=__float2bfloat16(o[d0][r]*rli[r]);}
    asm volatile("s_waitcnt lgkmcnt(0)":::"memory");
    #pragma unroll
    for(int i=0;i<4;++i){const int row=i*8+(lane>>3),ch=lane&7; const u32x4 v=*(const u32x4*)(stg+row*64+ch*8); ATTN_STORE16(Ow+(long)row*OPITCH+ch*8,v);} }
  asm volatile("s_waitcnt lgkmcnt(0)\n\ts_barrier":::"memory");
  #undef DMA_K
  #undef DMA_V
  #undef CMASK
  #undef START
  #undef RESC
  #undef ROT
}
typedef __attribute__((address_space(3))) const char* lds_cp;
__device__ __forceinline__ void qkt_half(f32x16&p,lds_cp Kslot,const bf16x8*qr,const f32x16&negm,int r32,int hi,int kh){
  lds_cp kb=Kslot+hi*1024+(r32+32*kh)*16;
  #pragma unroll
  for(int d0=0;d0<4;++d0){ const bf16x8 b=*(const __attribute__((address_space(3))) bf16x8*)(kb+d0*2048);
    if(d0==0)p=__builtin_amdgcn_mfma_f32_32x32x16_bf16(b,qr[0],negm,0,0,0); else p=__builtin_amdgcn_mfma_f32_32x32x16_bf16(b,qr[d0],p,0,0,0);}
}
__device__ __forceinline__ void pv_half(f32x16*o,int vb,bf16x8 pa0,bf16x8 pa1){
  #pragma unroll
  for(int d0=0;d0<2;++d0){s16x4 lo[2],hi[2];
    #pragma unroll
    for(int ks=0;ks<2;++ks){
      asm volatile("ds_read_b64_tr_b16 %0,%1 offset:%c2":"=&v"(lo[ks]):"v"(vb),"i"(d0*4096+ks*1024):"memory");
      asm volatile("ds_read_b64_tr_b16 %0,%1 offset:%c2":"=&v"(hi[ks]):"v"(vb),"i"(d0*4096+ks*1024+512):"memory");}
    asm volatile("s_waitcnt lgkmcnt(0)":::"memory");SBAR();
    #define PK(k) (bf16x8){lo[k][0],lo[k][1],lo[k][2],lo[k][3],hi[k][0],hi[k][1],hi[k][2],hi[k][3]}
    o[d0]=__builtin_amdgcn_mfma_f32_32x32x16_bf16(pa0,PK(0),o[d0],0,0,0);
    o[d0]=__builtin_amdgcn_mfma_f32_32x32x16_bf16(pa1,PK(1),o[d0],0,0,0);
    #undef PK
  }
}
constexpr int F_SLOTV=2*SLOTB, F_LDS_K=0, F_LDS_V=NSLOT*SLOTB, F_LDS_WS=F_LDS_V+NSLOT*F_SLOTV, F_LDS_OST=F_LDS_WS+NW*64*4, F_LDS_BYTES=F_LDS_OST+4*8192;
__device__ __forceinline__ void bmask1(f32x16&p,int t,int cq,int qabs,int hi,int kh,const __attribute__((address_space(3))) float*lut){
  if(t>cq){
    #pragma unroll
    for(int r=0;r<16;++r)p[r]=-INFINITY;
  } else {
    const int d0=64*t+32*kh+4*hi-qabs+128;
    #pragma unroll
    for(int r=0;r<16;++r){int i0=d0+(r&3)+8*(r>>2); i0=i0<0?0:i0; p[r]+=lut[i0];}
  }
}
template<int THRL> __device__ __forceinline__ void attn_unit_f(int qb,int qkcol,int vcol,int ocol,const bf16*Q,const bf16*__restrict__ K,const bf16*__restrict__ V,bf16*O,char*shm,const __attribute__((address_space(3))) float*lut){
  int tid_=threadIdx.x; asm volatile("":"+v"(tid_));
  const int tid=tid_,lane=tid&63,r32=lane&31,hi=lane>>5; const int wid=__builtin_amdgcn_readfirstlane(tid>>6); const int pr=wid&3,kh=wid>>2;
  const int q0=qb*128;
  const bf16*Qw=Q+(long)(q0+pr*QBLK)*DM+qkcol;
  const bf16*Kh=K+qkcol,*Vh=V+vcol;
  const unsigned lds0=(unsigned)(uintptr_t)shm;
  float*wsf=(float*)(shm+F_LDS_WS)+wid*64;
  const bf16*ksrc=Kh+(long)lane*DM+wid*8;
  const bf16*vsrc=Vh+(long)(16*(wid&3)+(lane>>2))*DM+(wid>>2)*32+(lane&3)*8;
  const unsigned kdst=lds0+F_LDS_K+wid*1024, vdst=lds0+F_LDS_V+wid*1024;
  #define DMA_K(t,slot) glds16(ksrc+(long)(t)*KVBLK*DM,(unsigned)__builtin_amdgcn_readfirstlane(kdst+(slot)))
  #define DMA_V(t,slot) do{ glds16(vsrc+(long)(t)*KVBLK*DM,(unsigned)__builtin_amdgcn_readfirstlane(vdst+2*(slot))); glds16(vsrc+(long)(t)*KVBLK*DM+64,(unsigned)__builtin_amdgcn_readfirstlane(vdst+2*(slot)+8192)); }while(0)
  const int vb0=(int)(lds0+F_LDS_V)+((lane>>4)&1)*32+(lane&3)*8+(4*hi+((lane&15)>>2))*64+kh*2048;
  bf16x8 kf[4];
  const lds_cptr shm3=(lds_cptr)shm; const lds_cptr kp0=shm3+F_LDS_K+hi*1024+r32*16+kh*512; const lds_cptr vp0=shm3+F_LDS_V+((lane>>4)&1)*32+(lane&3)*8+(4*hi+((lane&15)>>2))*64+kh*2048;
  const int NT_=(q0+128)/KVBLK; const int NT=NT_<4?4:NT_;
  const int cq=(q0>>6)+(pr>>1), cqm2=cq-2, qabs=q0+pr*QBLK+r32;
  DMA_K(0,0);DMA_V(0,0);DMA_K(1,SLOTB);
  bf16x8 qr[4];
  #pragma unroll
  for(int d0=0;d0<4;++d0)qr[d0]=*reinterpret_cast<const bf16x8*>(&Qw[(long)r32*DM+d0*16+hi*8]);
  float mhat=0.f,l_reg=0.f;f32x16 o[4];o[0]=f32x16{};o[1]=f32x16{};o[2]=f32x16{};o[3]=f32x16{};f32x16 negm=f32x16{};asm volatile("":"+v"(negm));
  #define CMASK(P,t) do{ if((t)>=cqm2)bmask1(P,(t),cq,qabs,hi,kh,lut);}while(0)
  bool resc=false;
  #define RESC() do{ if(resc){ asm volatile("s_waitcnt lgkmcnt(0)":::"memory"); \
      _Pragma("unroll") for(int d_=0;d_<4;++d_) _Pragma("unroll") for(int r=0;r<16;++r)o[d_][r]*=wsf[crow(r,hi)]; } }while(0)
  f32x16 pA,pB;
  int sl_prev=0,sl_cur=0,sl_next=SLOTB;
  #define ROT() do{sl_prev=sl_cur;sl_cur=sl_next;sl_next=(sl_next==(NSLOT-1)*SLOTB)?0:sl_next+SLOTB;}while(0)
  DMA_K(2,2*SLOTB);
  WAIT_BAR(4);
  qkt_half(pA,(lds_cp)(shm3+F_LDS_K),qr,negm,r32,hi,kh);asm volatile("s_nop 15\n\ts_nop 7":"+v"(pA));CMASK(pA,0);
  { float a=max3f(pA[0],pA[1],pA[2]),b=max3f(pA[3],pA[4],pA[5]);a=max3f(a,pA[6],pA[7]);b=max3f(b,pA[8],pA[9]);a=max3f(a,pA[10],pA[11]);b=max3f(b,pA[12],pA[13]);a=max3f(a,pA[14],pA[15]);
    const float m=max2f(a,b); const PL32 rr=pl32(m); const float dl=max2f(rr.a,rr.b); mhat=fadd_s(mhat,dl);
    _Pragma("unroll") for(int r=0;r<16;++r)pA[r]=fsub_s(pA[r],dl);
    _Pragma("unroll") for(int r=0;r<16;++r)negm[r]=-mhat; asm volatile("":"+v"(negm));
    _Pragma("unroll") for(int r=0;r<16;++r)pA[r]=__builtin_amdgcn_exp2f(pA[r]); }
  WAIT_BAR(0);
  DMA_K(3,0);DMA_V(1,SLOTB);
  ROT();
  _Pragma("unroll") for(int j=0;j<4;++j)kf[j]=*(const __attribute__((address_space(3))) bf16x8*)(kp0+sl_cur+j*2048);
  WAIT_BAR(3);
  s16x4 vlo[8],vhi[8]; u32x4 pwa,pwb;
  #define PKW(P,B) cvtpk_s(P[B],P[B+1])
  #define PAFA __builtin_bit_cast(bf16x8,pwa)
  #define PAFB __builtin_bit_cast(bf16x8,pwb)
  #define VFR(i) (bf16x8){vlo[i][0],vlo[i][1],vlo[i][2],vlo[i][3],vhi[i][0],vhi[i][1],vhi[i][2],vhi[i][3]}
  #define PIN(x) asm volatile("":"+v"(x))
  #define MX3(a,b,c) __builtin_fmaxf(__builtin_fmaxf((a),(b)),(c))
  #define GAPA(MF,A0,A1,A2,A3,W0,W1,PW) do{ MF; sacc+=A0; sacc+=A1; sacc+=A2; sacc+=A3; PIN(sacc); W0; W1; PIN(PW); SBAR(); }while(0)
  #define EX(v) __builtin_amdgcn_exp2f(v)
  #define GAPB(MF,X,B) do{ MF; X[B]=EX(X[B]); X[B+1]=EX(X[B+1]); PIN(X); SBAR(); }while(0)
  #define VRD(i) do{ vlo[i]=vtr(vp_+(((i)>>1)*4096+((i)&1)*1024)); vhi[i]=vtr(vp_+(((i)>>1)*4096+((i)&1)*1024+512)); }while(0)
  #define KRD(G,j) do{ if(G){ kf[j]=*(const __attribute__((address_space(3))) bf16x8*)(kp0+sl_next+(j)*2048); SBAR(); } }while(0)
  #define STEPF(C,P,t,GK,GV,GL) do{ SBAR(); \
    const lds_cptr vp_=vp0+2*sl_prev; \
    VRD(0); VRD(2); SBAR(); float sacc=(P[0]+P[1]); \
    GAPA(C=__builtin_amdgcn_mfma_f32_32x32x16_bf16(kf[0],qr[0],negm,0,0,0), P[2],P[3],P[4],P[5],     pwa[0]=PKW(P,0), pwa[1]=PKW(P,2), pwa); \
    VRD(4); VRD(6); SBAR(); GAPA(C=__builtin_amdgcn_mfma_f32_32x32x16_bf16(kf[1],qr[1],C,0,0,0), P[6],P[7],P[8],P[9],     pwa[2]=PKW(P,4), pwa[3]=PKW(P,6), pwa); \
    VRD(1); VRD(3); SBAR(); GAPA(C=__builtin_amdgcn_mfma_f32_32x32x16_bf16(kf[2],qr[2],C,0,0,0), P[10],P[11],P[12],P[13], pwb[0]=PKW(P,8), pwb[1]=PKW(P,10), pwb); \
    VRD(5); VRD(7); SBAR(); GAPA(C=__builtin_amdgcn_mfma_f32_32x32x16_bf16(kf[3],qr[3],C,0,0,0), P[14],P[15],0.f,0.f,     pwb[2]=PKW(P,12),pwb[3]=PKW(P,14), pwb); \
    l_reg+=sacc; \
    if(GK){DMA_K((t)+3,sl_cur);} if(GV){DMA_V((t)+1,sl_next);} \
    CMASK(C,t); \
    { float a=MX3(C[0],C[1],C[2]),b=MX3(C[3],C[4],C[5]); a=MX3(a,C[6],C[7]); b=MX3(b,C[8],C[9]); a=MX3(a,C[10],C[11]); b=MX3(b,C[12],C[13]); a=MX3(a,C[14],C[15]); \
      float rm=__builtin_fmaxf(a,b); { const PL32 rr=pl32(rm); rm=__builtin_fmaxf(rr.a,rr.b); } \
      resc=false; \
      if(__builtin_expect(__any(rm>(float)THRL),0)){ const float dl=__builtin_fmaxf(rm,0.f); mhat+=dl; \
        _Pragma("unroll") for(int r=0;r<16;++r)C[r]-=dl; \
        _Pragma("unroll") for(int r=0;r<16;++r)negm[r]=-mhat; asm volatile("":"+v"(negm)); \
        const float f=__builtin_amdgcn_exp2f(-dl); l_reg*=f; if(hi==0)wsf[r32]=f; resc=true; } } \
    SBAR(); \
    GAPB(o[0]=__builtin_amdgcn_mfma_f32_32x32x16_bf16(PAFA,VFR(0),o[0],0,0,0), C,0); \
    GAPB(o[1]=__builtin_amdgcn_mfma_f32_32x32x16_bf16(PAFA,VFR(2),o[1],0,0,0), C,2); \
    KRD(GL,0); GAPB(o[2]=__builtin_amdgcn_mfma_f32_32x32x16_bf16(PAFA,VFR(4),o[2],0,0,0), C,4); \
    KRD(GL,1); GAPB(o[3]=__builtin_amdgcn_mfma_f32_32x32x16_bf16(PAFA,VFR(6),o[3],0,0,0), C,6); \
    KRD(GL,2); GAPB(o[0]=__builtin_amdgcn_mfma_f32_32x32x16_bf16(PAFB,VFR(1),o[0],0,0,0), C,8); \
    KRD(GL,3); GAPB(o[1]=__builtin_amdgcn_mfma_f32_32x32x16_bf16(PAFB,VFR(3),o[1],0,0,0), C,10); \
    GAPB(o[2]=__builtin_amdgcn_mfma_f32_32x32x16_bf16(PAFB,VFR(5),o[2],0,0,0), C,12); \
    GAPB(o[3]=__builtin_amdgcn_mfma_f32_32x32x16_bf16(PAFB,VFR(7),o[3],0,0,0), C,14); \
    }while(0)
  int t=1;
  #undef CMASK
  #define CMASK(P,t) do{}while(0)
  for(;t+7<NT;t+=2){
    STEPF(pB,pA,t,true,true,true);     WAIT_BAR(3); RESC(); ROT();
    STEPF(pA,pB,t+1,true,true,true);   WAIT_BAR(3); RESC(); ROT();
  }
  #undef CMASK
  #define CMASK(P,t) do{ if((t)>=cqm2)bmask1(P,(t),cq,qabs,hi,kh,lut);}while(0)
  #define ENDW(tt) do{ if((tt)+3<NT){WAIT_BAR(3);} else if((tt)+2<NT){WAIT_BAR(2);} else {WAIT_BAR(0);} }while(0)
  for(;t+1<NT;t+=2){
    STEPF(pB,pA,t,(t+3<NT),(t+1<NT),(t+1<NT));       ENDW(t);   RESC(); ROT();
    STEPF(pA,pB,t+1,(t+4<NT),(t+2<NT),(t+2<NT));     ENDW(t+1); RESC(); ROT();
  }
  STEPF(pB,pA,NT-1,false,false,false); RESC();
  { float sacc=pB[0]+pB[1]; _Pragma("unroll") for(int r=2;r<16;++r)sacc+=pB[r]; l_reg+=sacc;
    pwa=(u32x4){PKW(pB,0),PKW(pB,2),PKW(pB,4),PKW(pB,6)};pwb=(u32x4){PKW(pB,8),PKW(pB,10),PKW(pB,12),PKW(pB,14)};
    SBAR();
    const int vb=vb0+2*sl_cur;
    #pragma unroll
    for(int d0=0;d0<4;++d0){s16x4 lo[2],hi_[2];
      #pragma unroll
      for(int ks=0;ks<2;++ks){
        asm volatile("ds_read_b64_tr_b16 %0,%1 offset:%c2":"=&v"(lo[ks]):"v"(vb),"i"(d0*4096+ks*1024):"memory");
        asm volatile("ds_read_b64_tr_b16 %0,%1 offset:%c2":"=&v"(hi_[ks]):"v"(vb),"i"(d0*4096+ks*1024+512):"memory");}
      asm volatile("s_waitcnt lgkmcnt(0)":::"memory");SBAR();
      #define PK(k) (bf16x8){lo[k][0],lo[k][1],lo[k][2],lo[k][3],hi_[k][0],hi_[k][1],hi_[k][2],hi_[k][3]}
      o[d0]=__builtin_amdgcn_mfma_f32_32x32x16_bf16(PAFA,PK(0),o[d0],0,0,0);
      o[d0]=__builtin_amdgcn_mfma_f32_32x32x16_bf16(PAFB,PK(1),o[d0],0,0,0);
      #undef PK
    } }
  #undef PKW
  #undef PAFA
  #undef PAFB
  #undef VFR
  #undef PIN
  #undef MX3
  #undef GAPA
  #undef GAPB
  #undef EX
  #undef VRD
  #undef KRD
  #undef STEPF
  #undef ENDW
  {const PL32 rr=pl32(l_reg);l_reg=rr.a+rr.b;}
  asm volatile("s_waitcnt lgkmcnt(0)\n\ts_barrier":::"memory");
  float*OG=(float*)shm+pr*4096;
  if(kh==1){ if(hi==0){wsf[r32]=mhat;wsf[32+r32]=l_reg;}
    #pragma unroll
    for(int d_=0;d_<4;++d_)
      #pragma unroll
      for(int r=0;r<16;++r)OG[(d_*16+r)*64+lane]=o[d_][r]; }
  asm volatile("s_waitcnt lgkmcnt(0)\n\ts_barrier":::"memory");
  if(kh==0){ const float*w1=(const float*)(shm+F_LDS_WS)+(wid+4)*64; const float m2=w1[r32],l2=w1[32+r32]; const float M=__builtin_fmaxf(mhat,m2);
    const float f1=__builtin_amdgcn_exp2f(mhat-M),f2=__builtin_amdgcn_exp2f(m2-M); const float inv=__builtin_amdgcn_rcpf(l_reg*f1+l2*f2);
    if(hi==0){wsf[r32]=f1*inv;wsf[32+r32]=f2*inv;}
    asm volatile("s_waitcnt lgkmcnt(0)":::"memory");
    bf16*stg=(bf16*)(shm+F_LDS_OST)+pr*4096;
    #pragma unroll
    for(int r=0;r<16;++r){const int orow=crow(r,hi); const float g1=wsf[orow],g2=wsf[32+orow];
      #pragma unroll
      for(int d_=0;d_<4;++d_)stg[orow*128+d_*32+r32]=__float2bfloat16(o[d_][r]*g1+OG[(d_*16+r)*64+lane]*g2);}
    asm volatile("s_waitcnt lgkmcnt(0)":::"memory");
    bf16*Ow=O+(long)(q0+pr*QBLK)*(long)OPITCH+ocol;
    #pragma unroll
    for(int i=0;i<8;++i){const int row=i*4+(lane>>4),ch=lane&15; const u32x4 v=*(const u32x4*)(stg+row*128+ch*8); ATTN_STORE16(Ow+(long)row*OPITCH+ch*8,v);} }
  asm volatile("s_waitcnt lgkmcnt(0)\n\ts_barrier":::"memory");
  #undef DMA_K
  #undef DMA_V
  #undef CMASK
  #undef RESC
  #undef ROT
}
constexpr int ATTN_LDS_BYTES=LDS_BYTES;
#undef SBAR
#undef WAIT_BAR
}
#define XB_TMO      128
#define XB_XCNT(j)  (256  + 64 * (j))
#define XB_XSUB(j)  (1280 + 64 * (j))
#define XB_XGEN(j)  (2304 + 64 * (j))
#define XB_TOP      3328
#define XB_TOPGEN   3392
#define XCD_BAR_WORDS 3456
#define XB_SPIN_CAP (1u << 18)

__device__ __forceinline__ unsigned xb_ld(unsigned* p)              { return __hip_atomic_load(p, __ATOMIC_RELAXED, __HIP_MEMORY_SCOPE_AGENT); }
__device__ __forceinline__ unsigned xb_add(unsigned* p, unsigned v) { return __hip_atomic_fetch_add(p, v, __ATOMIC_RELAXED, __HIP_MEMORY_SCOPE_AGENT); }
__device__ __forceinline__ unsigned xb_xcc_id() { return (unsigned)__builtin_amdgcn_s_getreg((3 << 11) | 20) & 0xFu; }
#define XB_SPIN(cond, bar) do { unsigned _sp = 0; while (cond) { __builtin_amdgcn_s_sleep(1); \
    if ((++_sp & 255u) == 0u) { if (xb_ld(&(bar)[XB_TMO])) break; if (_sp > XB_SPIN_CAP) { atomicAdd(&(bar)[XB_TMO], 1u); break; } } } } while (0)

struct XcdBarrier {
    unsigned* bar; unsigned x;
    volatile LAS unsigned* st;
};

__device__ __forceinline__ XcdBarrier xcd_barrier_post(unsigned* bar, volatile LAS unsigned* st) {
    XcdBarrier b; b.bar = bar; b.x = xb_xcc_id(); b.st = st;
    if (threadIdx.x == 0) (void)xb_add(&bar[XB_XCNT(b.x)], 1u);
    return b;
}
__device__ __forceinline__ void xcd_barrier_complete(unsigned* bar, unsigned x, unsigned& nloc, unsigned& nx) {
    const unsigned G = gridDim.x * gridDim.y * gridDim.z;
    unsigned sum, cnt, mine, sp = 0u;
    for (;;) {
        sum = 0u; cnt = 0u; mine = 0u;
#pragma unroll
        for (unsigned j = 0; j < 16; ++j) { const unsigned c = xb_ld(&bar[XB_XCNT(j)]); sum += c; cnt += (c > 0u) ? 1u : 0u; mine = (j == x) ? c : mine; }
        if (sum == G) break;
        __builtin_amdgcn_s_sleep(1);
        if ((++sp & 255u) == 0u) { if (xb_ld(&bar[XB_TMO])) break; if (sp > XB_SPIN_CAP) { atomicAdd(&bar[XB_TMO], 1u); break; } }
    }
    nloc = mine > 0u ? mine : 1u; nx = cnt > 0u ? cnt : 1u;
}

__device__ __forceinline__ void xcd_barrier(const XcdBarrier& b) {
    asm volatile("s_waitcnt vmcnt(0)" ::: "memory");
    __syncthreads();
    if (threadIdx.x == 0) {
        unsigned* bar = b.bar;
        __builtin_amdgcn_s_waitcnt(0);
        unsigned nloc = b.st[0], nx = b.st[1];
        if (nloc == 0u) { xcd_barrier_complete(bar, b.x, nloc, nx); b.st[0] = nloc; b.st[1] = nx; }
        const unsigned old = xb_add(&bar[XB_XSUB(b.x)], 1u);
        const unsigned gen = old / nloc;
        if (old + 1u == (gen + 1u) * nloc) {
            __builtin_amdgcn_fence(__ATOMIC_RELEASE, "agent");
            asm volatile("s_waitcnt vmcnt(0)" ::: "memory");
            const unsigned og = xb_add(&bar[XB_TOP], 1u);
            const unsigned tg = og / nx;
            if (og + 1u == (tg + 1u) * nx) xb_add(&bar[XB_TOPGEN], 1u);
            else XB_SPIN(xb_ld(&bar[XB_TOPGEN]) == tg, bar);
            __builtin_amdgcn_fence(__ATOMIC_ACQUIRE, "agent");
            xb_add(&bar[XB_XGEN(b.x)], 1u);
            asm volatile("s_waitcnt vmcnt(0)" ::: "memory");
        } else {
            XB_SPIN(xb_ld(&bar[XB_XGEN(b.x)]) == gen, bar);
            __builtin_amdgcn_fence(__ATOMIC_ACQUIRE, "agent");
            asm volatile("s_waitcnt vmcnt(0)" ::: "memory");
        }
    }
    __syncthreads();
}
struct Args { const float* in[37]; float* out; unsigned char* ws; int ph_lo, ph_hi; };
struct Frame { LAS unsigned char* lds; volatile LAS unsigned* MISC; gu32* ctl; int tid, lane, wave, G, bid; };
typedef __attribute__((address_space(4))) const Args* ArgsP;
__device__ __forceinline__ ArgsP get_args() { ArgsP p = (ArgsP)__builtin_amdgcn_kernarg_segment_ptr(); asm volatile("" : "+s"(p)); return p; }
#define PHASE_ENTRY() ArgsP A = get_args(); { int t_ = threadIdx.x; asm volatile("" : "+v"(t_)); F.tid = t_; F.lane = t_ & 63; F.wave = __builtin_amdgcn_readfirstlane(t_ >> 6); F.ctl = (gu32*)(A->ws + WS_CTL); }
enum InIdx { I_XP = 0, I_XS, I_CP, I_CS, I_CK, I_CV, I_SWKV, I_SSHIFT, I_SCONV, I_WADA, I_BADA, I_GMIX, I_GFFN, I_WIN, I_WOUT, I_MU, I_W0, I_W2, I_A0, I_A2, I_G2, I_KK, I_KA, I_RK, I_LNW, I_LNB,
             I_LQ1, I_LK1, I_LQ2, I_LK2, I_SUBLN, I_REL, I_FUP, I_CONVW, I_CONVB, I_FDN, I_GFIN };

__device__ __forceinline__ void transpose_item(const float* W, int K, int N, bf16* WT, int dest_row0, LAS float* scr, int kb, int n0, int lane) {
    const int k0 = 64 * kb;
    { f32x4 t[8];
#pragma unroll
      for (int i = 0; i < 8; ++i) t[i] = __builtin_nontemporal_load((const GAS f32x4*)(W + (size_t)(k0 + 8 * i + (lane >> 3)) * N + n0 + 4 * (lane & 7)));
#pragma unroll
      for (int i = 0; i < 8; ++i) { LAS float* d = scr + (8 * i + (lane >> 3)) * 33 + 4 * (lane & 7); d[0] = t[i][0]; d[1] = t[i][1]; d[2] = t[i][2]; d[3] = t[i][3]; } }
    LDS_WAIT(); asm volatile("" ::: "memory");
    const int c = lane & 7;
#pragma unroll
    for (int j = 0; j < 4; ++j) { const int n = (lane >> 3) + 8 * j; const LAS float* s = scr + (8 * c) * 33 + n;
        v4u o; o.x = pk2(s[0 * 33], s[1 * 33]); o.y = pk2(s[2 * 33], s[3 * 33]); o.z = pk2(s[4 * 33], s[5 * 33]); o.w = pk2(s[6 * 33], s[7 * 33]);
        *(GAS v4u*)(WT + (size_t)(dest_row0 + n) * K + k0 + 8 * c) = o; }
    LDS_WAIT(); asm volatile("" ::: "memory");
}
__device__ __forceinline__ void ph_prologue(Frame& F) {
    PHASE_ENTRY();
    unsigned char* ws = A->ws;
    if (F.bid < 192) {
        const int l = F.bid / 96, j0 = (F.bid % 96) * 128;
        LAS float* ST = (LAS float*)F.lds;
        const float* Wl = A->in[I_WADA] + (size_t)l * DMOD * MODW;
        float acc[NMODB][2];
#pragma unroll
        for (int b = 0; b < NMODB; ++b) { acc[b][0] = 0.f; acc[b][1] = 0.f; }
        for (int kh = 0; kh < 2; ++kh) {
            __syncthreads();
            for (int idx = F.tid; idx < 1024 * NMODB; idx += NWAVES * 64) { const int kk = idx / NMODB, b = idx % NMODB;
                const float c = (b == 0) ? A->in[I_CP][kh * 1024 + kk] : A->in[I_CS][(size_t)(b - 1) * DMOD + kh * 1024 + kk];
                ST[kk * 20 + b] = c / (1.f + __expf(-c)); }
            __syncthreads();
#pragma unroll 4
            for (int k = 0; k < 128; ++k) { const int kk = F.wave * 128 + k;
                const f32x2 w = __builtin_nontemporal_load((const GAS f32x2*)(Wl + (size_t)(kh * 1024 + kk) * MODW + j0 + 2 * F.lane));
                const LAS f32x4* sp = (const LAS f32x4*)(ST + kk * 20);
                const f32x4 s0 = sp[0], s1 = sp[1], s2 = sp[2], s3 = sp[3]; const float s16 = ST[kk * 20 + 16];
#pragma unroll
                for (int b = 0; b < 4; ++b) { acc[b][0] += s0[b] * w.x; acc[b][1] += s0[b] * w.y; acc[4 + b][0] += s1[b] * w.x; acc[4 + b][1] += s1[b] * w.y;
                    acc[8 + b][0] += s2[b] * w.x; acc[8 + b][1] += s2[b] * w.y; acc[12 + b][0] += s3[b] * w.x; acc[12 + b][1] += s3[b] * w.y; }
                acc[16][0] += s16 * w.x; acc[16][1] += s16 * w.y; }
        }
        __syncthreads();
        LAS float* RED = (LAS float*)F.lds;
#pragma unroll
        for (int b = 0; b < NMODB; ++b) { RED[(F.wave * NMODB + b) * 128 + 2 * F.lane] = acc[b][0]; RED[(F.wave * NMODB + b) * 128 + 2 * F.lane + 1] = acc[b][1]; }
        __syncthreads();
        float* MOD = (float*)(ws + WS_MOD);
        for (int idx = F.tid; idx < NMODB * 128; idx += NWAVES * 64) { const int b = idx >> 7, j = idx & 127; float s = 0.f;
#pragma unroll
            for (int w = 0; w < 8; ++w) s += RED[(w * NMODB + b) * 128 + j];
            MOD[(size_t)(l * NMODB + b) * MODW + j0 + j] = s + A->in[I_BADA][(size_t)l * MODW + j0 + j]; }
        __syncthreads();
    }
    { const int gt = F.bid * (NWAVES * 64) + F.tid, ngt = F.G * NWAVES * 64;
      for (int idx = gt; idx < NLAYER * 56 * 1024; idx += ngt) { const int l = idx / (56 * 1024), rem = idx % (56 * 1024), ch = rem >> 10, j = rem & 1023;
          const float* src; bf16* dst; int k0;
          bf16* LB = (bf16*)(ws + WS_LORA + (size_t)l * LORA_LAYER);
          if (ch < 12) { k0 = 8 * ch; src = A->in[I_W2] + ((size_t)l * 96 + k0) * 1024 + j; dst = LB + (size_t)j * 96 + k0; }
          else if (ch < 24) { k0 = 8 * (ch - 12); src = A->in[I_A2] + ((size_t)l * 96 + k0) * 1024 + j; dst = LB + (size_t)1024 * 96 + (size_t)j * 96 + k0; }
          else { k0 = 8 * (ch - 24); src = A->in[I_G2] + ((size_t)l * 256 + k0) * 1024 + j; dst = LB + (size_t)2 * 1024 * 96 + (size_t)j * 256 + k0; }
          v4u o; o.x = pk2(src[0], src[1024]); o.y = pk2(src[2048], src[3072]); o.z = pk2(src[4096], src[5120]); o.w = pk2(src[6144], src[7168]);
          *(GAS v4u*)dst = o; }
      for (int idx = gt; idx < NLAYER * 64 * DMOD / 8; idx += ngt) { const int l = idx / (64 * DMOD / 8), rem = idx % (64 * DMOD / 8);
          *(GAS v4u*)((bf16*)(ws + WS_WIN) + (size_t)l * NIN_PAD * DMOD + (size_t)NRC * DMOD + (size_t)rem * 8) = (v4u){0u, 0u, 0u, 0u}; }
    }
    __syncthreads();
    LAS float* scr = (LAS float*)(F.lds + F.wave * 16384);
    const int gw = F.bid * NWAVES + F.wave, NGW = F.G * NWAVES;
    constexpr int IT_IN = 32 * (NIN / 32), IT_OUT = 32 * 64, IT_UP = 32 * (NUP / 32), IT_DN = (DFF / 64) * 64, IT_L = IT_IN + IT_OUT + IT_UP + IT_DN;
    for (int it = gw; it < NLAYER * IT_L; it += NGW) {
        const int l = it / IT_L; int r = it % IT_L;
        if (r < IT_IN) { const int nb = r % (NIN / 32), kb = r / (NIN / 32), n0 = 32 * nb;
            transpose_item(A->in[I_WIN] + (size_t)l * DMOD * NIN, DMOD, NIN, (bf16*)(ws + WS_WIN) + (size_t)l * NIN_PAD * DMOD, n0 < NRC ? n0 : n0 + 64, scr, kb, n0, F.lane); continue; }
        r -= IT_IN;
        if (r < IT_OUT) { const int nb = r % 64, kb = r / 64;
            transpose_item(A->in[I_WOUT] + (size_t)l * DMOD * DMOD, DMOD, DMOD, (bf16*)(ws + WS_WOUT) + (size_t)l * DMOD * DMOD, 32 * nb, scr, kb, 32 * nb, F.lane); continue; }
        r -= IT_OUT;
        if (r < IT_UP) { const int nb = r % (NUP / 32), kb = r / (NUP / 32), n0 = 32 * nb; const int j = n0 < DFF ? n0 : n0 - DFF;
            const int dr = (j >> 7) * 256 + (n0 < DFF ? 0 : 128) + (j & 127);
            transpose_item(A->in[I_FUP] + (size_t)l * DMOD * NUP, DMOD, NUP, (bf16*)(ws + WS_WUP) + (size_t)l * NUP * DMOD, dr, scr, kb, n0, F.lane); continue; }
        r -= IT_UP;
        { const int nb = r % 64, kb = r / 64;
            transpose_item(A->in[I_FDN] + (size_t)l * DFF * DMOD, DFF, DMOD, (bf16*)(ws + WS_WDN) + (size_t)l * DMOD * DFF, 32 * nb, scr, kb, 32 * nb, F.lane); }
    }
}

__device__ __forceinline__ void ph_norm(Frame& F, int l, int mode, int nslab) {
    PHASE_ENTRY();
    const int gw = F.bid * NWAVES + F.wave, NGW = F.G * NWAVES;
    const float* X = (const float*)(A->ws + WS_X); bf16* H = (bf16*)(A->ws + WS_H);
    const float* g = (mode == 0 ? A->in[I_GMIX] + (size_t)l * DMOD : mode == 1 ? A->in[I_GFFN] + (size_t)l * DMOD : A->in[I_GFIN]);
    f32x4 gv[8];
#pragma unroll
    for (int j = 0; j < 8; ++j) gv[j] = *(const GAS f32x4*)(g + 4 * F.lane + 256 * j);
    for (int m = gw; m < MT; m += NGW) {
        const float* xr = (mode == 0 && l == 0) ? (m < MP ? A->in[I_XP] + (size_t)m * DMOD : A->in[I_XS] + (size_t)(m - MP) * DMOD) : X + (size_t)m * DMOD;
        f32x4 v[8]; float ss = 0.f;
#pragma unroll
        for (int j = 0; j < 8; ++j) v[j] = *(const GAS f32x4*)(xr + 4 * F.lane + 256 * j);
        if (m >= MP && nslab > 0) { const float* sl = (const float*)(A->ws + WS_SLAB) + (size_t)(m - MP) * DMOD;
            for (int s = 0; s < nslab; ++s)
#pragma unroll
                for (int j = 0; j < 8; ++j) v[j] += *(const GAS f32x4*)(sl + (size_t)s * 256 * DMOD + 4 * F.lane + 256 * j);
            if (mode < 2) { float* xw = (float*)(A->ws + WS_X) + (size_t)m * DMOD;
#pragma unroll
                for (int j = 0; j < 8; ++j) *(GAS f32x4*)(xw + 4 * F.lane + 256 * j) = v[j]; } }
#pragma unroll
        for (int j = 0; j < 8; ++j) ss += (v[j].x * v[j].x + v[j].y * v[j].y) + (v[j].z * v[j].z + v[j].w * v[j].w);
        const float rstd = 1.f / sqrtf(wave_sum(ss) * (1.f / DMOD) + 1e-6f);
        if (mode < 2) {
            const int bidx = m < MP ? 0 : 1 + ((m - MP) >> 4);
            const float* mod = (const float*)(A->ws + WS_MOD) + (size_t)(l * NMODB + bidx) * MODW + (mode == 0 ? 0 : 3 * DMOD);
            GAS unsigned long long* o8 = (GAS unsigned long long*)(H + (size_t)m * DMOD) + F.lane;
#pragma unroll
            for (int j = 0; j < 8; ++j) { const f32x4 sh = *(const GAS f32x4*)(mod + 4 * F.lane + 256 * j), sc = *(const GAS f32x4*)(mod + DMOD + 4 * F.lane + 256 * j);
                const f32x4 y = (v[j] * rstd * gv[j]) * (sc + 1.0f) + sh;
                o8[64 * j] = (unsigned long long)pk2(y.x, y.y) | ((unsigned long long)pk2(y.z, y.w) << 32); }
        } else {
            float* o = (m < MP) ? A->out + O_YP + (size_t)m * DMOD : A->out + O_YS + (size_t)(m - MP) * DMOD;
#pragma unroll
            for (int j = 0; j < 8; ++j) __builtin_nontemporal_store(v[j] * rstd * gv[j], (GAS f32x4*)(o + 4 * F.lane + 256 * j));
        }
    }
}
typedef float f32x4m __attribute__((ext_vector_type(4)));
__device__ __forceinline__ void mm_tiles(f32x4 (&acc)[2], const LAS unsigned char* X, const LAS unsigned char* Y, int wave, int lane) {
    const int mt = wave >> 1, nt0 = 2 * (wave & 1), c = lane & 15, q = lane >> 4;
    const LAS unsigned char* xp = X + (16 * mt + c) * 144 + q * 16;
    const bf16x8 x0 = *(const LAS bf16x8*)xp, x1 = *(const LAS bf16x8*)(xp + 64);
#pragma unroll
    for (int t = 0; t < 2; ++t) { const LAS unsigned char* yp = Y + (16 * (nt0 + t) + c) * 144 + q * 16;
        const bf16x8 y0 = *(const LAS bf16x8*)yp, y1 = *(const LAS bf16x8*)(yp + 64);
        acc[t] = __builtin_amdgcn_mfma_f32_16x16x32_bf16(y0, x0, acc[t], 0, 0, 0);
        acc[t] = __builtin_amdgcn_mfma_f32_16x16x32_bf16(y1, x1, acc[t], 0, 0, 0); }
}
__device__ __forceinline__ void st_tiles(LAS unsigned char* D, const f32x4 (&acc)[2], int wave, int lane) {
    const int mt = wave >> 1, nt0 = 2 * (wave & 1), c = lane & 15, q = lane >> 4;
#pragma unroll
    for (int t = 0; t < 2; ++t) { v2u w; w.x = pk2(acc[t][0], acc[t][1]); w.y = pk2(acc[t][2], acc[t][3]); *(LAS v2u*)(D + (16 * mt + c) * 144 + (16 * (nt0 + t) + 4 * q) * 2) = w; }
}
#define RW_ZERO(a) do { a[0] = (f32x4){0.f, 0.f, 0.f, 0.f}; a[1] = a[0]; } while (0)
template <int MODE> __device__ __forceinline__ void mask_tiles(f32x4 (&acc)[2], int wave, int lane) {
    const int m = 16 * (wave >> 1) + (lane & 15), nb = 32 * (wave & 1) + 4 * (lane >> 4);
#pragma unroll
    for (int t = 0; t < 2; ++t)
#pragma unroll
        for (int i = 0; i < 4; ++i) { const int n = nb + 16 * t + i; const bool keep = MODE == 0 ? (n < m) : MODE == 1 ? (n > m) : (n <= m); if (!keep) acc[t][i] = 0.f; }
}

__device__ __forceinline__ void rwkv_passA_unit(ArgsP A, Frame& F, int l, int u, bool reuse) {
    unsigned char* ws = A->ws;
    const int tid = F.tid, lane = F.lane, wave = F.wave;
    const float* PR = (const float*)(ws + WS_PR);
    int h, row0, nvalid; const float* prev0;
    if (u < 2048) { h = u >> 7; const int c = u & 127; row0 = 64 * c; nvalid = 64; prev0 = c > 0 ? PR + (size_t)(row0 - 1) * NRC_PAD : nullptr; }
    else { const int su = u - 2048, sb = su >> 4; h = su & 15; row0 = MP + sb * TS; nvalid = TS; prev0 = A->in[I_SSHIFT] + (size_t)(l * NSB + sb) * NRC; }
    const float* mu = A->in[I_MU] + (size_t)l * NRC;
    LAS unsigned char* L = F.lds;
#define SL(i) (L + (i) * RW_SLOT)
    LAS unsigned short* TW = (LAS unsigned short*)(L), *XA = (LAS unsigned short*)(L + 13312), *SG = (LAS unsigned short*)(L + 26624);
    LAS float* WLf = (LAS float*)(L + 64512), *ALf = (LAS float*)(L + 81920), *GLf = (LAS float*)(L + 99328);
    LAS float* AT32 = (LAS float*)(L + 92160), *A32 = (LAS float*)(L + 109568), *AKV32 = (LAS float*)(L);
    LAS unsigned char* sAAK = L + 126976, *sARB = L + 136192, *sARK = L + 145408;
    LAS float* SEG = (LAS float*)(L + 154624), *WLV = SEG + 512;
    bf16x8 yg_[8][2];
    { const int nt0 = 2 * (wave & 1), c = lane & 15, q = lane >> 4; const bf16* LB = (const bf16*)(ws + WS_LORA + (size_t)l * LORA_LAYER);
#pragma unroll
      for (int t = 0; t < 2; ++t) { const int j = h * 64 + 16 * (nt0 + t) + c;
#pragma unroll
          for (int s = 0; s < 8; ++s) yg_[s][t] = *(const GAS bf16x8*)(LB + (size_t)2 * 1024 * 96 + (size_t)j * 256 + 8 * q + 32 * s); } }
    { unsigned char* lscr = ws + WS_LSCR + (size_t)F.bid * 61440;
      if (reuse) { v4u tmp[8];
#pragma unroll
          for (int b = 0; b < 8; ++b) { const int i = tid + b * (NWAVES * 64); if (i < 60416 / 16) tmp[b] = *(const GAS v4u*)(lscr + i * 16); }
#pragma unroll
          for (int b = 0; b < 8; ++b) { const int i = tid + b * (NWAVES * 64); if (i < 60416 / 16) *(LAS v4u*)(L + i * 16) = tmp[b]; } }
      else {
        for (int it = 0; it < 56; it += 8) { float cur[8], prv[8], mm_[8];
#pragma unroll
            for (int b = 0; b < 8; ++b) { const int idx = tid + (it + b) * (NWAVES * 64), t = idx / 448, col = 3072 + idx % 448; cur[b] = 0.f; prv[b] = 0.f; mm_[b] = mu[col];
                if (t < nvalid) { cur[b] = PR[(size_t)(row0 + t) * NRC_PAD + col]; prv[b] = t > 0 ? PR[(size_t)(row0 + t - 1) * NRC_PAD + col] : (prev0 ? prev0[col] : 0.f); } }
#pragma unroll
            for (int b = 0; b < 8; ++b) { const int idx = tid + (it + b) * (NWAVES * 64), t = idx / 448, cc = idx % 448; const float xm = cur[b] + (prv[b] - cur[b]) * mm_[b];
                if (cc < 96) { const float e = __expf(2.f * xm); TW[t * 104 + cc] = (unsigned short)f2bf(1.f - 2.f * __builtin_amdgcn_rcpf(e + 1.f)); }
                else if (cc < 192) XA[t * 104 + cc - 96] = (unsigned short)f2bf(xm);
                else SG[t * 264 + cc - 192] = (unsigned short)f2bf(sigmoidf_(xm)); } }
        if (u < 2048) { __syncthreads(); for (int i = tid; i < 60416 / 16; i += NWAVES * 64) *(GAS v4u*)(lscr + i * 16) = *(const LAS v4u*)(L + i * 16); }
      } }
    __syncthreads();
    { const int mt = wave >> 1, nt0 = 2 * (wave & 1), c = lane & 15, q = lane >> 4;
      const bf16* LB = (const bf16*)(ws + WS_LORA + (size_t)l * LORA_LAYER);
      f32x4 aw[2], aa[2], ag[2]; RW_ZERO(aw); RW_ZERO(aa); RW_ZERO(ag);
#pragma unroll
      for (int s = 0; s < 3; ++s) { const bf16x8 xw = *(const LAS bf16x8*)((LAS unsigned char*)TW + (16 * mt + c) * 208 + (8 * q + 32 * s) * 2), xa = *(const LAS bf16x8*)((LAS unsigned char*)XA + (16 * mt + c) * 208 + (8 * q + 32 * s) * 2);
#pragma unroll
          for (int t = 0; t < 2; ++t) { const int j = h * 64 + 16 * (nt0 + t) + c;
              const bf16x8 yw = *(const GAS bf16x8*)(LB + (size_t)j * 96 + 8 * q + 32 * s), ya = *(const GAS bf16x8*)(LB + (size_t)1024 * 96 + (size_t)j * 96 + 8 * q + 32 * s);
              aw[t] = __builtin_amdgcn_mfma_f32_16x16x32_bf16(yw, xw, aw[t], 0, 0, 0); aa[t] = __builtin_amdgcn_mfma_f32_16x16x32_bf16(ya, xa, aa[t], 0, 0, 0); } }
#pragma unroll
      for (int s = 0; s < 8; ++s) { const bf16x8 xg = *(const LAS bf16x8*)((LAS unsigned char*)SG + (16 * mt + c) * 528 + (8 * q + 32 * s) * 2);
#pragma unroll
          for (int t = 0; t < 2; ++t) { const int j = h * 64 + 16 * (nt0 + t) + c; const bf16x8 yg = yg_[s][t];
              ag[t] = __builtin_amdgcn_mfma_f32_16x16x32_bf16(yg, xg, ag[t], 0, 0, 0); } }
#pragma unroll
      for (int t = 0; t < 2; ++t) { const int o = (16 * mt + c) * 68 + 16 * (nt0 + t) + 4 * q; *(LAS f32x4*)(WLf + o) = aw[t]; *(LAS f32x4*)(ALf + o) = aa[t]; *(LAS f32x4*)(GLf + o) = ag[t]; }
    }
    __syncthreads();
    {
        const int j = lane, hj = h * 64 + j, seg = wave;
        const float mu_r = mu[hj], mu_k = mu[1024 + hj], mu_v = mu[2048 + hj];
        const float w0 = A->in[I_W0][l * 1024 + hj], a0 = A->in[I_A0][l * 1024 + hj], kkw = A->in[I_KK][l * 1024 + hj], kaw = A->in[I_KA][l * 1024 + hj], rkw = A->in[I_RK][l * 1024 + hj];
        const float lnw = A->in[I_LNW][l * 1024 + hj], lnb = A->in[I_LNB][l * 1024 + hj];
        float logw[8], xr[8], xv[8], kk[8], bb[8], km[8], cs[8];
        float* G1 = (float*)(ws + WS_G1); float* G2 = (float*)(ws + WS_G2);
        float run = 0.f;
#pragma unroll
        for (int i = 0; i < 8; ++i) { const int t = 8 * seg + i; const bool valid = t < nvalid;
            float r_ = 0.f, k_ = 0.f, v_ = 0.f;
            if (valid) { const float* pc = PR + (size_t)(row0 + t) * NRC_PAD; const float* pp = t > 0 ? pc - NRC_PAD : prev0;
                const float cr = pc[hj], ck = pc[1024 + hj], cv = pc[2048 + hj];
                const float qr = pp ? pp[hj] : 0.f, qk = pp ? pp[1024 + hj] : 0.f, qv = pp ? pp[2048 + hj] : 0.f;
                r_ = cr + (qr - cr) * mu_r; k_ = ck + (qk - ck) * mu_k; v_ = cv + (qv - cv) * mu_v; }
            const float wl = WLf[t * 68 + j], al = ALf[t * 68 + j], gl = GLf[t * 68 + j];
            const float lw = valid ? -0.6065306597126334f * sigmoidf_(w0 + wl) : 0.f;
            const float a_ = sigmoidf_(a0 + al);
            const float kkr = k_ * kkw; const float nrm = wave_sum(kkr * kkr); const float kk_ = kkr * __builtin_amdgcn_rsqf(fmaxf(nrm, 1e-24f));
            const float km_ = k_ * (1.f + (a_ - 1.f) * kaw);
            const float ct = wave_sum(r_ * km_ * rkw);
            if (valid) { const size_t go = (size_t)(row0 + t) * 1024 + hj; G1[go] = lnw * gl; G2[go] = (lnb + ct * v_) * gl; }
            run += lw; logw[i] = lw; cs[i] = run; xr[i] = r_; xv[i] = v_; kk[i] = kk_; bb[i] = kk_ * a_; km[i] = km_; }
        SEG[seg * 64 + j] = run;
        __syncthreads();
        float off = 0.f, tot = 0.f;
#pragma unroll
        for (int s = 0; s < 8; ++s) { const float v = SEG[s * 64 + j]; tot += v; if (s < seg) off += v; }
        if (seg == 0) WLV[j] = __expf(tot);
        LAS unsigned short* AT = (LAS unsigned short*)SL(0), *ATL = (LAS unsigned short*)SL(1), *BH = (LAS unsigned short*)SL(2), *BHL = (LAS unsigned short*)SL(3), *KH = (LAS unsigned short*)SL(4), *RT = (LAS unsigned short*)SL(5);
        unsigned pvt[4], pbt[4], pbl[4], pkt[4];
#pragma unroll
        for (int i = 0; i < 8; i += 2) { float v2[2], bt2[2], bl2[2], kt2[2];
#pragma unroll
            for (int e = 0; e < 2; ++e) { const int ii = i + e, t = 8 * seg + ii; const float ci = off + cs[ii], ce = ci - logw[ii];
                const float winc = __expf(ci), wexc = __expf(ce), winv = __expf(-ci), wrem = __expf(tot - ci);
                const float at = -kk[ii] * wexc, rt = xr[ii] * winc, bh = bb[ii] * winv, kh = km[ii] * winv, bt = bb[ii] * wrem, kt = km[ii] * wrem;
                const unsigned ath = f2bf(at), bhh = f2bf(bh), bth = f2bf(bt);
                AT[t * RW_STRIDE + j] = (unsigned short)ath; ATL[t * RW_STRIDE + j] = (unsigned short)f2bf(at - bf2f((unsigned short)ath)); AT32[t * 68 + j] = at;
                BH[t * RW_STRIDE + j] = (unsigned short)bhh; BHL[t * RW_STRIDE + j] = (unsigned short)f2bf(bh - bf2f((unsigned short)bhh));
                KH[t * RW_STRIDE + j] = (unsigned short)f2bf(kh); RT[t * RW_STRIDE + j] = (unsigned short)f2bf(rt);
                v2[e] = xv[ii]; bt2[e] = bf2f((unsigned short)bth); bl2[e] = bt - bf2f((unsigned short)bth); kt2[e] = kt; }
            pvt[i >> 1] = pk2(v2[0], v2[1]); pbt[i >> 1] = pk2(bt2[0], bt2[1]); pbl[i >> 1] = pk2(bl2[0], bl2[1]); pkt[i >> 1] = pk2(kt2[0], kt2[1]); }
        *(LAS v4u*)(SL(6) + j * 144 + seg * 16) = (v4u){pvt[0], pvt[1], pvt[2], pvt[3]};
        *(LAS v4u*)(SL(7) + j * 144 + seg * 16) = (v4u){pbt[0], pbt[1], pbt[2], pbt[3]};
        *(LAS v4u*)(SL(8) + j * 144 + seg * 16) = (v4u){pbl[0], pbl[1], pbl[2], pbl[3]};
        *(LAS v4u*)(SL(9) + j * 144 + seg * 16) = (v4u){pkt[0], pkt[1], pkt[2], pkt[3]};
    }
    __syncthreads();
    { f32x4 a[2]; const int mt = wave >> 1, nt0 = 2 * (wave & 1), c = lane & 15, q = lane >> 4, m = 16 * mt + c;
      RW_ZERO(a); mm_tiles(a, SL(0), SL(2), wave, lane); mm_tiles(a, SL(1), SL(2), wave, lane); mm_tiles(a, SL(0), SL(3), wave, lane); mask_tiles<0>(a, wave, lane);
#pragma unroll
      for (int t = 0; t < 2; ++t) *(LAS f32x4*)(A32 + m * 68 + 16 * (nt0 + t) + 4 * q) = a[t];
      RW_ZERO(a); mm_tiles(a, SL(0), SL(4), wave, lane); mask_tiles<0>(a, wave, lane); st_tiles(sAAK, a, wave, lane);
      RW_ZERO(a); mm_tiles(a, SL(5), SL(2), wave, lane); mask_tiles<2>(a, wave, lane); st_tiles(sARB, a, wave, lane);
      RW_ZERO(a); mm_tiles(a, SL(5), SL(4), wave, lane); mask_tiles<2>(a, wave, lane); st_tiles(sARK, a, wave, lane); }
    __syncthreads();
    { f32x4 a[2]; const int mt = wave >> 1, nt0 = 2 * (wave & 1), c = lane & 15, q = lane >> 4, m = 16 * mt + c;
      RW_ZERO(a); mm_tiles(a, sAAK, SL(6), wave, lane);
#pragma unroll
      for (int t = 0; t < 2; ++t) *(LAS f32x4*)(AKV32 + m * 68 + 16 * (nt0 + t) + 4 * q) = a[t]; }
    __syncthreads();
    { const int c = lane & 15, q = lane >> 4;
      LAS float* R = (wave < 4) ? AT32 + 16 * wave : AKV32 + 16 * (wave - 4);
      LAS float* Rc = (wave == 0 ? AT32 : AKV32) + lane;
#pragma unroll
      for (int i = 0; i < 4; ++i) {
          if (i > 0) {
              f32x4 acc;
#pragma unroll
              for (int g = 0; g < 4; ++g) acc[g] = R[(16 * i + 4 * q + g) * 68 + c];
#pragma unroll
              for (int j = 0; j < i; ++j)
#pragma unroll
                  for (int s = 0; s < 4; ++s) { const float a = A32[(16 * i + c) * 68 + 16 * j + 4 * s + q], b = R[(16 * j + 4 * s + q) * 68 + c];
                      acc = __builtin_amdgcn_mfma_f32_16x16x4f32(a, b, acc, 0, 0, 0); }
#pragma unroll
              for (int g = 0; g < 4; ++g) R[(16 * i + 4 * q + g) * 68 + c] = acc[g];
              __syncthreads();
          }
          if (wave < 2) {
              const LAS float* a32 = A32 + (16 * i) * 68 + 16 * i; asm volatile("" : "+v"(a32));
              float x[16];
#pragma unroll
              for (int rr = 0; rr < 16; ++rr) x[rr] = Rc[(16 * i + rr) * 68];
#pragma unroll
              for (int rg = 0; rg < 4; ++rg) {
                  f32x4 cf[4][4];
#pragma unroll
                  for (int r4 = 0; r4 < 4; ++r4)
#pragma unroll
                      for (int g = 0; g <= rg; ++g) if (4 * g < 4 * rg + r4) cf[r4][g] = *(const LAS f32x4*)(a32 + (4 * rg + r4) * 68 + 4 * g);
#pragma unroll
                  for (int r4 = 0; r4 < 4; ++r4) { const int rr = 4 * rg + r4; if (rr == 0) continue; float s0 = x[rr], s1 = 0.f;
#pragma unroll
                      for (int g = 0; g <= rg; ++g) if (4 * g < rr) { s0 += cf[r4][g][0] * x[4 * g]; if (4 * g + 1 < rr) s1 += cf[r4][g][1] * x[4 * g + 1]; if (4 * g + 2 < rr) s0 += cf[r4][g][2] * x[4 * g + 2]; if (4 * g + 3 < rr) s1 += cf[r4][g][3] * x[4 * g + 3]; }
                      x[rr] = s0 + s1; }
                  asm volatile("" ::: "memory");
              }
#pragma unroll
              for (int rr = 1; rr < 16; ++rr) Rc[(16 * i + rr) * 68] = x[rr];
          }
          __syncthreads();
      }
      { const int cc = tid & 127, g16 = tid >> 7; const LAS float* src = (cc < 64 ? AT32 + cc : AKV32 + (cc - 64)) + (16 * g16) * 68;
        unsigned hh[16]; float lo[16];
#pragma unroll
        for (int rr = 0; rr < 16; ++rr) { const float v = src[rr * 68]; hh[rr] = f2bf(v); lo[rr] = v - bf2f((unsigned short)hh[rr]); }
        LAS unsigned char* dh = (cc < 64 ? SL(2) + cc * 144 : SL(4) + (cc - 64) * 144) + g16 * 32;
        *(LAS v4u*)dh = (v4u){hh[0] | (hh[1] << 16), hh[2] | (hh[3] << 16), hh[4] | (hh[5] << 16), hh[6] | (hh[7] << 16)};
        *(LAS v4u*)(dh + 16) = (v4u){hh[8] | (hh[9] << 16), hh[10] | (hh[11] << 16), hh[12] | (hh[13] << 16), hh[14] | (hh[15] << 16)};
        if (cc < 64) { LAS unsigned char* dl = SL(3) + cc * 144 + g16 * 32;
            *(LAS v4u*)dl = (v4u){pk2(lo[0], lo[1]), pk2(lo[2], lo[3]), pk2(lo[4], lo[5]), pk2(lo[6], lo[7])};
            *(LAS v4u*)(dl + 16) = (v4u){pk2(lo[8], lo[9]), pk2(lo[10], lo[11]), pk2(lo[12], lo[13]), pk2(lo[14], lo[15])}; } }
    }
    __syncthreads();
    { const int mt = wave >> 1, nt0 = 2 * (wave & 1), c = lane & 15, q = lane >> 4, m = 16 * mt + c;
      float* PTg = (float*)(ws + WS_PT32) + (size_t)u * 4096; float* QQg = (float*)(ws + WS_QQ) + (size_t)u * 4096; bf16* RPg = (bf16*)(ws + WS_RP) + (size_t)u * 4096; float* YVg = (float*)(ws + WS_YV) + (size_t)u * 4096;
      f32x4 a[2];
      RW_ZERO(a); mm_tiles(a, sARB, SL(2), wave, lane); mm_tiles(a, sARB, SL(3), wave, lane);
#pragma unroll
      for (int t = 0; t < 2; ++t) { const int n = 16 * (nt0 + t) + 4 * q; const v2u rr = *(const LAS v2u*)(SL(5) + m * 144 + n * 2);
          v2u w; w.x = pk2(a[t][0] + bf2f((unsigned short)(rr.x & 0xffffu)), a[t][1] + bf2f((unsigned short)(rr.x >> 16))); w.y = pk2(a[t][2] + bf2f((unsigned short)(rr.y & 0xffffu)), a[t][3] + bf2f((unsigned short)(rr.y >> 16)));
          *(GAS v2u*)(RPg + m * 64 + n) = w; }
      RW_ZERO(a); mm_tiles(a, sARB, SL(4), wave, lane); mm_tiles(a, sARK, SL(6), wave, lane);
#pragma unroll
      for (int t = 0; t < 2; ++t) *(GAS f32x4*)(YVg + m * 64 + 16 * (nt0 + t) + 4 * q) = a[t];
      if (tid < 64) ((float*)(ws + WS_WL))[(size_t)u * 64 + tid] = WLV[tid];
      RW_ZERO(a); mm_tiles(a, SL(7), SL(2), wave, lane); mm_tiles(a, SL(8), SL(2), wave, lane); mm_tiles(a, SL(7), SL(3), wave, lane);
#pragma unroll
      for (int t = 0; t < 2; ++t) *(GAS f32x4*)(PTg + m * 64 + 16 * (nt0 + t) + 4 * q) = a[t];
      RW_ZERO(a); mm_tiles(a, SL(4), SL(7), wave, lane); mm_tiles(a, SL(6), SL(9), wave, lane);
#pragma unroll
      for (int t = 0; t < 2; ++t) *(GAS f32x4*)(QQg + m * 64 + 16 * (nt0 + t) + 4 * q) = a[t];
    }
    __syncthreads();
#undef SL
}
__device__ __forceinline__ void wait_count(Frame& F, unsigned* cnt, unsigned target) {
    if (F.tid == 0) { unsigned* bar = (unsigned*)(F.ctl + CW_BAR);
        XB_SPIN(xb_ld(cnt) < target, bar);
        __builtin_amdgcn_fence(__ATOMIC_ACQUIRE, "agent"); asm volatile("s_waitcnt vmcnt(0)" ::: "memory"); }
    __syncthreads();
}
__device__ __forceinline__ void ph_rwkv_passA(Frame& F, int l) {
    PHASE_ENTRY();
    if (F.G == 256) wait_count(F, (unsigned*)(F.ctl + CW_QUEUE + 1024 + 64 * l), (unsigned)((MT / 256) * (NRC_PAD / 256)));
    int pu = -1;
    int u0 = F.bid, ustep = F.G, uend = RW_UNITS;
    if (F.G == 256) {
        const int r = F.bid & 127, sec = F.bid >> 7, nf = (r < (MT / 256) * (NIN_PAD / 256) - 768) ? 8 : 9;
        u0 = r + 128 * (sec ? nf : 0); ustep = 128; uend = r + 128 * (sec ? 18 : nf); }
    for (int u = u0; u < uend; u += ustep) { const bool reuse = (pu >= 0 && u < 2048 && (u & 127) == (pu & 127)); rwkv_passA_unit(A, F, l, u, reuse); pu = u; }
}

struct ChainOps { f32x4 pt[4]; f32x4 qq[2]; f32x4 wl; };
__device__ __forceinline__ void rwkv_chain_load(ChainOps& o, const float* PTg, const float* QQg, const float* WLg, int wave, int lane) {
    const int tk = wave & 3, tv0 = 2 * (wave >> 2), c = lane & 15, q = lane >> 4;
#pragma unroll
    for (int s = 0; s < 2; ++s) { o.pt[2 * s] = *(const GAS f32x4*)(PTg + (16 * tk + c) * 64 + 8 * q + 32 * s); o.pt[2 * s + 1] = *(const GAS f32x4*)(PTg + (16 * tk + c) * 64 + 8 * q + 32 * s + 4); }
#pragma unroll
    for (int t = 0; t < 2; ++t) o.qq[t] = *(const GAS f32x4*)(QQg + (16 * (tv0 + t) + c) * 64 + 16 * tk + 4 * q);
    o.wl = *(const GAS f32x4*)(WLg + 16 * tk + 4 * q);
}
__device__ __forceinline__ void rwkv_chain_step(f32x4 (&acc)[2], const ChainOps& o, const LAS unsigned char* Shi, const LAS unsigned char* Slo, int wave, int lane) {
    const int tv0 = 2 * (wave >> 2), c = lane & 15, q = lane >> 4;
    bf16x8 ph[2], pl[2];
#pragma unroll
    for (int s = 0; s < 2; ++s) { const f32x4 x0 = o.pt[2 * s], x1 = o.pt[2 * s + 1];
        unsigned h[8]; float lo[8];
#pragma unroll
        for (int i = 0; i < 4; ++i) { h[i] = f2bf(x0[i]); lo[i] = x0[i] - bf2f((unsigned short)h[i]); h[4 + i] = f2bf(x1[i]); lo[4 + i] = x1[i] - bf2f((unsigned short)h[4 + i]); }
        ph[s] = __builtin_bit_cast(bf16x8, (v4u){h[0] | (h[1] << 16), h[2] | (h[3] << 16), h[4] | (h[5] << 16), h[6] | (h[7] << 16)});
        pl[s] = __builtin_bit_cast(bf16x8, (v4u){pk2(lo[0], lo[1]), pk2(lo[2], lo[3]), pk2(lo[4], lo[5]), pk2(lo[6], lo[7])}); }
#pragma unroll
    for (int t = 0; t < 2; ++t) { const int v = 16 * (tv0 + t) + c;
        f32x4 a = o.qq[t] + acc[t] * o.wl;
        const bf16x8 s0 = *(const LAS bf16x8*)(Shi + v * 144 + q * 16), s1 = *(const LAS bf16x8*)(Shi + v * 144 + q * 16 + 64);
        const bf16x8 l0 = *(const LAS bf16x8*)(Slo + v * 144 + q * 16), l1 = *(const LAS bf16x8*)(Slo + v * 144 + q * 16 + 64);
        a = __builtin_amdgcn_mfma_f32_16x16x32_bf16(ph[0], s0, a, 0, 0, 0); a = __builtin_amdgcn_mfma_f32_16x16x32_bf16(ph[1], s1, a, 0, 0, 0);
        a = __builtin_amdgcn_mfma_f32_16x16x32_bf16(ph[0], l0, a, 0, 0, 0); a = __builtin_amdgcn_mfma_f32_16x16x32_bf16(ph[1], l1, a, 0, 0, 0);
        a = __builtin_amdgcn_mfma_f32_16x16x32_bf16(pl[0], s0, a, 0, 0, 0); a = __builtin_amdgcn_mfma_f32_16x16x32_bf16(pl[1], s1, a, 0, 0, 0);
        acc[t] = a; }
}
__device__ __forceinline__ void rwkv_state_to_lds(const f32x4 (&acc)[2], LAS unsigned char* Shi, LAS unsigned char* Slo, int wave, int lane) {
    const int tk = wave & 3, tv0 = 2 * (wave >> 2), c = lane & 15, q = lane >> 4;
#pragma unroll
    for (int t = 0; t < 2; ++t) { unsigned h[4]; float lo[4];
#pragma unroll
        for (int i = 0; i < 4; ++i) { h[i] = f2bf(acc[t][i]); lo[i] = acc[t][i] - bf2f((unsigned short)h[i]); }
        const int o = (16 * (tv0 + t) + c) * 144 + (16 * tk + 4 * q) * 2;
        *(LAS v2u*)(Shi + o) = (v2u){h[0] | (h[1] << 16), h[2] | (h[3] << 16)}; *(LAS v2u*)(Slo + o) = (v2u){pk2(lo[0], lo[1]), pk2(lo[2], lo[3])}; }
}
__device__ __forceinline__ void ph_rwkv_chain(Frame& F, int l) {
    PHASE_ENTRY();
    unsigned char* ws = A->ws; const int tid = F.tid, lane = F.lane, wave = F.wave;
    const int tk = wave & 3, tv0 = 2 * (wave >> 2), c = lane & 15, q = lane >> 4;
    LAS unsigned char* HI0 = F.lds, *LO0 = F.lds + RW_SLOT, *HI1 = F.lds + 2 * RW_SLOT, *LO1 = F.lds + 3 * RW_SLOT;
    const float* PT = (const float*)(ws + WS_PT32); const float* QQ = (const float*)(ws + WS_QQ); const float* WL = (const float*)(ws + WS_WL); bf16* SC = (bf16*)(ws + WS_SC);
    if (F.bid < 16) {
        const int h = F.bid;
        f32x4 acc[2]; RW_ZERO(acc);
        rwkv_state_to_lds(acc, HI0, LO0, wave, lane);
        __syncthreads();
        ChainOps ops; rwkv_chain_load(ops, PT + (size_t)(h * 128) * 4096, QQ + (size_t)(h * 128) * 4096, WL + (size_t)(h * 128) * 64, wave, lane);
        for (int cc = 0; cc < 128; ++cc) { const int u = h * 128 + cc; LAS unsigned char* chi = (cc & 1) ? HI1 : HI0, *clo = (cc & 1) ? LO1 : LO0, *nhi = (cc & 1) ? HI0 : HI1, *nlo = (cc & 1) ? LO0 : LO1;
            { const int row = tid >> 3, ch = tid & 7; *(GAS v4u*)((unsigned char*)(SC + (size_t)u * 4096) + tid * 16) = *(const LAS v4u*)(chi + row * 144 + ch * 16); }
            const ChainOps cur = ops;
            if (cc + 1 < 128) rwkv_chain_load(ops, PT + (size_t)(u + 1) * 4096, QQ + (size_t)(u + 1) * 4096, WL + (size_t)(u + 1) * 64, wave, lane);
            rwkv_chain_step(acc, cur, chi, clo, wave, lane);
            rwkv_state_to_lds(acc, nhi, nlo, wave, lane);
            __syncthreads(); }
#ifndef PROBE_SEQ
        float* wo = A->out + O_WP + (size_t)(l * 16 + h) * 4096;
#else
        float* wo = (float*)(A->ws + WS_HALO) + (size_t)h * 4096;
#endif
#pragma unroll
        for (int t = 0; t < 2; ++t) *(GAS f32x4*)(wo + (16 * (tv0 + t) + c) * 64 + 16 * tk + 4 * q) = acc[t];
    } else {
        for (int su = F.bid - 16; su < NSB * 16; su += F.G - 16) { const int u = 2048 + su, sb = su >> 4, h = su & 15;
            const float* S0 = A->in[I_SWKV] + (size_t)((l * NSB + sb) * 16 + h) * 4096;
            f32x4 acc[2];
#pragma unroll
            for (int t = 0; t < 2; ++t) acc[t] = *(const GAS f32x4*)(S0 + (16 * (tv0 + t) + c) * 64 + 16 * tk + 4 * q);
            rwkv_state_to_lds(acc, HI0, LO0, wave, lane);
            __syncthreads();
            { const int row = tid >> 3, ch = tid & 7; *(GAS v4u*)((unsigned char*)(SC + (size_t)u * 4096) + tid * 16) = *(const LAS v4u*)(HI0 + row * 144 + ch * 16); }
            { ChainOps o1; rwkv_chain_load(o1, PT + (size_t)u * 4096, QQ + (size_t)u * 4096, WL + (size_t)u * 64, wave, lane); rwkv_chain_step(acc, o1, HI0, LO0, wave, lane); }
            float* wo = A->out + O_WS + (size_t)((l * NSB + sb) * 16 + h) * 4096;
#pragma unroll
            for (int t = 0; t < 2; ++t) *(GAS f32x4*)(wo + (16 * (tv0 + t) + c) * 64 + 16 * tk + 4 * q) = acc[t];
            __syncthreads(); }
    }
}
__device__ __forceinline__ void ph_rwkv_passC(Frame& F, int l) {
    PHASE_ENTRY();
    unsigned char* ws = A->ws; const int lane = F.lane, wave = F.wave, c = lane & 15, q = lane >> 4, mt = wave & 3;
    const bf16* RP = (const bf16*)(ws + WS_RP); const float* YV = (const float*)(ws + WS_YV); const bf16* SC = (const bf16*)(ws + WS_SC);
    const float* G1 = (const float*)(ws + WS_G1); const float* G2 = (const float*)(ws + WS_G2); bf16* YC = (bf16*)(ws + WS_YCAT);
    for (int u = 2 * F.bid + (wave >> 2); u < RW_UNITS; u += 2 * F.G) {
        int h, row0; bool samp = u >= 2048;
        if (!samp) { h = u >> 7; row0 = 64 * (u & 127); } else { const int su = u - 2048; h = su & 15; row0 = MP + (su >> 4) * TS; }
        if (samp && mt > 0) continue;
        const bf16* RPu = RP + (size_t)u * 4096; const float* YVu = YV + (size_t)u * 4096; const bf16* SCu = SC + (size_t)u * 4096;
        const int t = 16 * mt + c;
        const bf16x8 r0 = *(const GAS bf16x8*)(RPu + t * 64 + 8 * q), r1 = *(const GAS bf16x8*)(RPu + t * 64 + 8 * q + 32);
        f32x4 y[4]; float s1 = 0.f;
#pragma unroll
        for (int nt = 0; nt < 4; ++nt) { y[nt] = *(const GAS f32x4*)(YVu + t * 64 + 16 * nt + 4 * q);
            const bf16x8 s0 = *(const GAS bf16x8*)(SCu + (16 * nt + c) * 64 + 8 * q), s1v = *(const GAS bf16x8*)(SCu + (16 * nt + c) * 64 + 8 * q + 32);
            y[nt] = __builtin_amdgcn_mfma_f32_16x16x32_bf16(s0, r0, y[nt], 0, 0, 0); y[nt] = __builtin_amdgcn_mfma_f32_16x16x32_bf16(s1v, r1, y[nt], 0, 0, 0);
            s1 += (y[nt][0] + y[nt][1]) + (y[nt][2] + y[nt][3]); }
        s1 += swz_xor<16>(s1); s1 += xor32(s1);
        const float mean = s1 * (1.f / 64.f); float s2 = 0.f;
#pragma unroll
        for (int nt = 0; nt < 4; ++nt) { y[nt] = y[nt] - mean; s2 += (y[nt][0] * y[nt][0] + y[nt][1] * y[nt][1]) + (y[nt][2] * y[nt][2] + y[nt][3] * y[nt][3]); }
        s2 += swz_xor<16>(s2); s2 += xor32(s2);
        const float rstd = __builtin_amdgcn_rsqf(s2 * (1.f / 64.f) + 64e-5f);
        const size_t ro = (size_t)(row0 + t);
#pragma unroll
        for (int nt = 0; nt < 4; ++nt) { const int v = h * 64 + 16 * nt + 4 * q; const f32x4 g1 = *(const GAS f32x4*)(G1 + ro * 1024 + v), g2 = *(const GAS f32x4*)(G2 + ro * 1024 + v);
            const f32x4 o = y[nt] * rstd * g1 + g2; v2u w; w.x = pk2(o[0], o[1]); w.y = pk2(o[2], o[3]); *(GAS v2u*)(YC + ro * DMOD + v) = w; }
    }
}
__device__ __forceinline__ void attn_sample_unit(ArgsP A, Frame& F, int l, int sb, int h) {
    unsigned char* ws = A->ws; const int tid = F.tid, lane = F.lane, wave = F.wave;
    LAS float* QS = (LAS float*)F.lds;
    LAS float* LUT = QS + 2048;
    LAS float* PB = QS + 4096 + wave * 1024;
    LAS float* MLW = QS + 4096 + 8192;
    LAS float* OACC = MLW + 128;
    LAS float* LACC = OACC + 4096;
    const bf16* QB = (const bf16*)(ws + WS_QB); const bf16* KB = (const bf16*)(ws + WS_KB); const bf16* VB = (const bf16*)(ws + WS_VB);
    const float* reltab = A->in[I_REL];
    for (int i = tid; i < 2048; i += NWAVES * 64) { const int t = i >> 7, d = i & 127; QS[i] = bf2f(QB[(size_t)(MP + sb * TS + t) * 1024 + h * 128 + d]); }
    if (tid < 192) { const int rel = tid - 128; const int n = rel < 0 ? -rel : rel;
        const int lg = n < 12 ? 8 : n < 16 ? 9 : n < 23 ? 10 : n < 32 ? 11 : n < 46 ? 12 : n < 64 ? 13 : n < 91 ? 14 : 15;
        const int bucket = (rel > 0 ? 16 : 0) + (n < 8 ? n : lg);
        LUT[tid] = (reltab[bucket * 8 + h] - reltab[15 * 8 + h]) * 1.4426950408889634f; }
    for (int i = tid; i < 4096 + 32; i += NWAVES * 64) OACC[i] = 0.f;
    __syncthreads();
    const int map = wave & 1, kg = wave >> 1;
    float mrun[16], lrun[16], o[16][2];
#pragma unroll
    for (int t = 0; t < 16; ++t) { mrun[t] = -INFINITY; lrun[t] = 0.f; o[t][0] = 0.f; o[t][1] = 0.f; }
    const float* CK = A->in[I_CK] + (size_t)(l * NSB + sb) * PAST * 1024; const float* CV = A->in[I_CV] + (size_t)(l * NSB + sb) * PAST * 1024;
    for (int kb = kg; kb < 33; kb += 4) {
        const int pos = 64 * kb + lane; const bool kvalid = pos < PAST + TS;
        float s[16];
#pragma unroll
        for (int t = 0; t < 16; ++t) s[t] = 0.f;
        if (kb < 32) { const float* kp = CK + (size_t)pos * 1024 + h * 128 + map * 64;
#pragma unroll 4
            for (int d = 0; d < 64; d += 4) { const f32x4 kv = *(const GAS f32x4*)(kp + d);
#pragma unroll
                for (int t = 0; t < 16; ++t) { const f32x4 qv = *(const LAS f32x4*)(QS + t * 128 + map * 64 + d); s[t] += (kv[0] * qv[0] + kv[1] * qv[1]) + (kv[2] * qv[2] + kv[3] * qv[3]); } }
        } else { const int rr = MP + sb * TS + (lane & 15); const bf16* kp = KB + (size_t)rr * 1024 + h * 128 + map * 64;
#pragma unroll 4
            for (int d = 0; d < 64; d += 4) { const v2u kw = *(const GAS v2u*)(kp + d);
                const f32x4 kv = (f32x4){bf2f((unsigned short)(kw.x & 0xffffu)), bf2f((unsigned short)(kw.x >> 16)), bf2f((unsigned short)(kw.y & 0xffffu)), bf2f((unsigned short)(kw.y >> 16))};
#pragma unroll
                for (int t = 0; t < 16; ++t) { const f32x4 qv = *(const LAS f32x4*)(QS + t * 128 + map * 64 + d); s[t] += (kv[0] * qv[0] + kv[1] * qv[1]) + (kv[2] * qv[2] + kv[3] * qv[3]); } }
        }
        float al[16];
#pragma unroll
        for (int t = 0; t < 16; ++t) { int idx = pos - (PAST + t) + 128; idx = idx < 0 ? 0 : idx; idx = idx > 191 ? 191 : idx;
            float sv = kvalid ? s[t] + LUT[idx] : -INFINITY;
            const float bm = wave_max(sv);
            const float mn = fmaxf(mrun[t], bm); al[t] = __builtin_amdgcn_exp2f(mrun[t] - mn); mrun[t] = mn;
            const float p = __builtin_amdgcn_exp2f(sv - mn); PB[lane * 16 + t] = p;
            lrun[t] = lrun[t] * al[t] + wave_sum(p);
            o[t][0] *= al[t]; o[t][1] *= al[t]; }
        LDS_WAIT(); asm volatile("" ::: "memory");
        const int nk = (kb < 32) ? 64 : TS;
        for (int k0 = 0; k0 < nk; k0 += 4) { f32x2 vv[4];
            if (kb < 32) {
#pragma unroll
                for (int b = 0; b < 4; ++b) vv[b] = *(const GAS f32x2*)(CV + (size_t)(64 * kb + k0 + b) * 1024 + h * 128 + 2 * lane);
            } else {
#pragma unroll
                for (int b = 0; b < 4; ++b) { const unsigned w = *(const GAS unsigned*)(VB + (size_t)(MP + sb * TS + k0 + b) * 1024 + h * 128 + 2 * lane); vv[b].x = bf2f((unsigned short)(w & 0xffffu)); vv[b].y = bf2f((unsigned short)(w >> 16)); }
            }
#pragma unroll
            for (int b = 0; b < 4; ++b) { const LAS f32x4* pp = (const LAS f32x4*)(PB + (k0 + b) * 16);
                const f32x4 p0 = pp[0], p1 = pp[1], p2 = pp[2], p3 = pp[3];
#pragma unroll
                for (int t = 0; t < 4; ++t) { o[t][0] += p0[t] * vv[b].x; o[t][1] += p0[t] * vv[b].y; o[4 + t][0] += p1[t] * vv[b].x; o[4 + t][1] += p1[t] * vv[b].y;
                    o[8 + t][0] += p2[t] * vv[b].x; o[8 + t][1] += p2[t] * vv[b].y; o[12 + t][0] += p3[t] * vv[b].x; o[12 + t][1] += p3[t] * vv[b].y; }
                asm volatile("" ::: "memory"); } }
        LDS_WAIT(); asm volatile("" ::: "memory");
    }
    if (lane < 16) { float mv = mrun[0];
#pragma unroll
        for (int t = 1; t < 16; ++t) mv = (lane == t) ? mrun[t] : mv;
        MLW[wave * 16 + lane] = mv; }
    __syncthreads();
#pragma unroll
    for (int t = 0; t < 16; ++t) { float M = fmaxf(fmaxf(MLW[(map) * 16 + t], MLW[(2 + map) * 16 + t]), fmaxf(MLW[(4 + map) * 16 + t], MLW[(6 + map) * 16 + t]));
        const float sc = __builtin_amdgcn_exp2f(mrun[t] - M);
        __hip_atomic_fetch_add(OACC + (t * 2 + map) * 128 + 2 * lane, o[t][0] * sc, __ATOMIC_RELAXED, __HIP_MEMORY_SCOPE_WORKGROUP); __hip_atomic_fetch_add(OACC + (t * 2 + map) * 128 + 2 * lane + 1, o[t][1] * sc, __ATOMIC_RELAXED, __HIP_MEMORY_SCOPE_WORKGROUP);
        if (lane == 0) __hip_atomic_fetch_add(LACC + map * 16 + t, lrun[t] * sc, __ATOMIC_RELAXED, __HIP_MEMORY_SCOPE_WORKGROUP); }
    __syncthreads();
    float* OA = (float*)(ws + WS_OATT);
    for (int i = tid; i < 4096; i += NWAVES * 64) { const int t = i >> 8, mp = (i >> 7) & 1, e = i & 127;
        OA[(size_t)(MP + sb * TS + t) * DMOD + h * 256 + mp * 128 + e] = OACC[i] / LACC[mp * 16 + t]; }
    __syncthreads();
}


__device__ __forceinline__ void attn_sample_unit2(ArgsP A, Frame& F, int l, int sb, int h) {
    using attn_body::f32x16;
    unsigned char* ws = A->ws; int tid_ = F.tid; asm volatile("" : "+v"(tid_));
    const int tid = tid_, lane = tid & 63, wid = __builtin_amdgcn_readfirstlane(tid >> 6), r32 = lane & 31, hi = lane >> 5, map = wid & 1, vh = (wid >> 1) & 1, KH = wid >> 2;
    LAS unsigned char* L = F.lds;
    LAS float* wsf = (LAS float*)(L + 65536) + wid * 64;
    const LAS float* LUT = (const LAS float*)(L + LUT_OFF) + h * 192;
    LAS float* MG = (LAS float*)(L + 68608);
    const bf16* QB = (const bf16*)(ws + WS_QB); const bf16* KB = (const bf16*)(ws + WS_KB); const bf16* VB = (const bf16*)(ws + WS_VB);
    const float* CK = A->in[I_CK] + (size_t)(l * NSB + sb) * PAST * 1024 + h * 128; const float* CV = A->in[I_CV] + (size_t)(l * NSB + sb) * PAST * 1024 + h * 128;
    bf16x8 qr[4];
    { const bf16* Qw = QB + (size_t)(MP + sb * TS + (r32 & 15)) * 1024 + h * 128 + map * 64;
#pragma unroll
      for (int d0 = 0; d0 < 4; ++d0) qr[d0] = *(const GAS bf16x8*)(Qw + d0 * 16 + hi * 8); }
    f32x4 st[8];
    auto stage_load = [&](int tile) {
        if (tile < 32) {
#pragma unroll
            for (int k = 0; k < 4; ++k) { const int idx = tid + 512 * k, row = idx >> 5, pp = idx & 31; const size_t off = (size_t)(64 * tile + row) * 1024 + 4 * pp;
                st[k] = __builtin_nontemporal_load((const GAS f32x4*)(CK + off)); st[4 + k] = __builtin_nontemporal_load((const GAS f32x4*)(CV + off)); }
        } else {
#pragma unroll
            for (int i = 0; i < 8; ++i) st[i] = (f32x4){0.f, 0.f, 0.f, 0.f};
            { const int row = tid >> 5, pp = tid & 31; const size_t off = (size_t)(MP + sb * TS + row) * 1024 + h * 128 + 4 * pp;
              const v2u wk = *(const GAS v2u*)(KB + off), wv = *(const GAS v2u*)(VB + off);
              st[0] = (f32x4){bf2f((unsigned short)(wk.x & 0xffffu)), bf2f((unsigned short)(wk.x >> 16)), bf2f((unsigned short)(wk.y & 0xffffu)), bf2f((unsigned short)(wk.y >> 16))};
              st[4] = (f32x4){bf2f((unsigned short)(wv.x & 0xffffu)), bf2f((unsigned short)(wv.x >> 16)), bf2f((unsigned short)(wv.y & 0xffffu)), bf2f((unsigned short)(wv.y >> 16))}; }
        } };
    auto stage_write = [&](int buf) { LAS unsigned char* B = L + buf * 32768;
#pragma unroll
        for (int k = 0; k < 4; ++k) { const int idx = tid + 512 * k, row = idx >> 5, pp = idx & 31, c = 4 * (pp & 15); const f32x4 x = st[k], y = st[4 + k];
            *(LAS v2u*)(B + (pp >> 4) * 8192 + ((pp & 15) >> 1) * 1024 + row * 16 + (pp & 1) * 8) = (v2u){pk2(x[0], x[1]), pk2(x[2], x[3])};
            *(LAS v2u*)(B + 16384 + (pp >> 4) * 8192 + ((c >> 5) * 4 + (row >> 4)) * 1024 + ((row & 15) * 4 + ((c & 31) >> 3)) * 16 + ((c >> 2) & 1) * 8) = (v2u){pk2(y[0], y[1]), pk2(y[2], y[3])}; } };
    stage_load(0);
    float mhat = 0.f, l_reg = 0.f; f32x16 o[2]; o[0] = f32x16{}; o[1] = f32x16{};
    stage_write(0);
    __syncthreads();
    for (int tile = 0; tile < 33; ++tile) {
        if (tile + 1 < 33) stage_load(tile + 1);
        const LAS unsigned char* B = L + (tile & 1) * 32768;
        f32x16 p;
        attn_body::qkt_half(p, (attn_body::lds_cp)(B + map * 8192), qr, f32x16{}, r32, hi, KH);
        asm volatile("s_nop 15\n\ts_nop 7" : "+v"(p));
#pragma unroll
        for (int r = 0; r < 16; ++r) p[r] -= mhat;
        if (tile >= 30) {
            const int rel0 = 64 * tile + 32 * KH + 4 * hi - (PAST + (r32 & 15)) + 128;
#pragma unroll
            for (int r = 0; r < 16; ++r) { const int kin = 32 * KH + 4 * hi + (r & 3) + 8 * (r >> 2); int idx = rel0 + (r & 3) + 8 * (r >> 2); idx = idx < 0 ? 0 : (idx > 191 ? 191 : idx);
                p[r] = (tile == 32 && kin >= TS) ? -INFINITY : p[r] + LUT[idx]; } }
        float rm = p[0];
#pragma unroll
        for (int r = 1; r < 16; ++r) rm = fmaxf(rm, p[r]);
        { const PL32 rr = pl32(rm); rm = fmaxf(rr.a, rr.b); }
        if (__any(rm > 0.f)) { const float dl = fmaxf(rm, 0.f); mhat += dl;
#pragma unroll
            for (int r = 0; r < 16; ++r) p[r] -= dl;
            const float f = __builtin_amdgcn_exp2f(-dl); l_reg *= f; if (hi == 0) wsf[r32] = f;
            asm volatile("s_waitcnt lgkmcnt(0)" ::: "memory");
#pragma unroll
            for (int d_ = 0; d_ < 2; ++d_)
#pragma unroll
                for (int r = 0; r < 16; ++r) o[d_][r] *= wsf[attn_body::crow(r, hi)]; }
        float sacc = 0.f;
#pragma unroll
        for (int r = 0; r < 16; ++r) { p[r] = __builtin_amdgcn_exp2f(p[r]); sacc += p[r]; }
        l_reg += sacc;
        const v4u pw0 = (v4u){attn_body::cvtpk_s(p[0], p[1]), attn_body::cvtpk_s(p[2], p[3]), attn_body::cvtpk_s(p[4], p[5]), attn_body::cvtpk_s(p[6], p[7])};
        const v4u pw1 = (v4u){attn_body::cvtpk_s(p[8], p[9]), attn_body::cvtpk_s(p[10], p[11]), attn_body::cvtpk_s(p[12], p[13]), attn_body::cvtpk_s(p[14], p[15])};
        const int vb = (int)(unsigned)(size_t)(B + 16384 + vh * 8192) + KH * 2048 + ((lane >> 4) & 1) * 32 + (lane & 3) * 8 + (4 * hi + ((lane & 15) >> 2)) * 64;
        attn_body::pv_half(o, vb, __builtin_bit_cast(bf16x8, pw0), __builtin_bit_cast(bf16x8, pw1));
        if (tile + 1 < 33) stage_write((tile + 1) & 1);
        __syncthreads();
    }
    { const PL32 rr = pl32(l_reg); l_reg = rr.a + rr.b; }
    LAS float* OG = (LAS float*)L + (wid & 3) * 2048;
    if (KH == 1) { if (hi == 0) { MG[(wid & 3) * 64 + r32] = mhat; MG[(wid & 3) * 64 + 32 + r32] = l_reg; }
#pragma unroll
        for (int d_ = 0; d_ < 2; ++d_)
#pragma unroll
            for (int r = 0; r < 16; ++r) OG[(d_ * 16 + r) * 64 + lane] = o[d_][r]; }
    __syncthreads();
    if (KH == 0) { const float m2 = MG[wid * 64 + r32], l2 = MG[wid * 64 + 32 + r32]; const float M = fmaxf(mhat, m2);
        const float f1 = __builtin_amdgcn_exp2f(mhat - M), f2 = __builtin_amdgcn_exp2f(m2 - M); const float inv = 1.f / (l_reg * f1 + l2 * f2);
        if (hi == 0) { wsf[r32] = f1 * inv; wsf[32 + r32] = f2 * inv; }
        asm volatile("s_waitcnt lgkmcnt(0)" ::: "memory");
        bf16* OA = (bf16*)(ws + WS_OATT) + (size_t)(MP + sb * TS) * DMOD + h * 256 + map * 128 + vh * 64;
#pragma unroll
        for (int r = 0; r < 8; ++r) { const int q = attn_body::crow(r, hi); const float g1 = wsf[q], g2 = wsf[32 + q];
#pragma unroll
            for (int d_ = 0; d_ < 2; ++d_) OA[(size_t)q * DMOD + d_ * 32 + r32] = (bf16)f2bf(o[d_][r] * g1 + OG[(d_ * 16 + r) * 64 + lane] * g2); } }
    __syncthreads();
}
__device__ __forceinline__ void attn_build_lut(ArgsP A, Frame& F) {
    LAS float* T = (LAS float*)(F.lds + LUT_OFF); const float* reltab = A->in[I_REL];
    for (int i = F.tid; i < 8 * 192; i += NWAVES * 64) { const int hh = i / 192, rel = i % 192 - 128; const int n = rel < 0 ? -rel : rel;
        const int lg = n < 12 ? 8 : n < 16 ? 9 : n < 23 ? 10 : n < 32 ? 11 : n < 46 ? 12 : n < 64 ? 13 : n < 91 ? 14 : 15;
        const int bucket = (rel > 0 ? 16 : 0) + (n < 8 ? n : lg);
        T[i] = (reltab[bucket * 8 + hh] - reltab[15 * 8 + hh]) * 1.4426950408889634f; }
    __syncthreads();
}
__device__ __forceinline__ void ph_attn_sample(Frame& F, int l) {
    PHASE_ENTRY();
    attn_build_lut(A, F);
    gu32* head = F.ctl + CW_QUEUE + 128 * l;
    for (;;) {
        if (F.tid == 0) F.MISC[16] = __hip_atomic_fetch_add(head, 1u, RLX_AGENT);
        __syncthreads();
        const unsigned qi = F.MISC[16];
        __syncthreads();
        if (qi >= 128u) break;
#ifdef SAMPLE_VALU
        attn_sample_unit(A, F, l, (int)(qi >> 3), (int)(qi & 7u));
#else
        attn_sample_unit2(A, F, l, (int)(qi >> 3), (int)(qi & 7u));
#endif
    }
}
__device__ __forceinline__ void ph_attn_prompt(Frame& F, int l) {
    PHASE_ENTRY();
    unsigned char* ws = A->ws;
    gu32* head = F.ctl + CW_QUEUE + 128 * l + 64;
    for (;;) {
        if (F.tid == 0) F.MISC[17] = __hip_atomic_fetch_add(head, 1u, RLX_AGENT);
        __syncthreads();
        const unsigned qi = F.MISC[17];
        __syncthreads();
        if (qi >= 1024u) break;
        const int qb = 63 - (int)(qi >> 4), hm = (int)(qi & 15u);
        const int hh = hm >> 1, mp = hm & 1;
        attn_body::attn_unit_f<8>(qb, hh * 128 + mp * 64, hh * 128, hh * 256 + mp * 128,
                                (const attn_body::bf16*)(ws + WS_QB), (const attn_body::bf16*)(ws + WS_KB), (const attn_body::bf16*)(ws + WS_VB), (attn_body::bf16*)(ws + WS_OATT), (char*)F.lds, (const LAS float*)(F.lds + LUT_OFF) + hh * 192);
    }
}
__device__ __forceinline__ void ph_attn_final(Frame& F, int l) {
    PHASE_ENTRY();
    const int lane = F.lane; const int gw = F.bid * NWAVES + F.wave, NGW = F.G * NWAVES;
    float d1 = A->in[I_LQ1][l * 64 + lane] * A->in[I_LK1][l * 64 + lane], d2 = A->in[I_LQ2][l * 64 + lane] * A->in[I_LK2][l * 64 + lane];
    d1 = wave_sum(d1); d2 = wave_sum(d2);
    const float lam_init = (l == 0) ? 0.2f : (0.8f - 0.6f * 0.7408182206817179f);
    const float lam = expf(d1) - expf(d2) + lam_init, osc = 1.f - lam_init;
    const int hh = lane >> 3, e0 = (lane & 7) * 16;
    const bf16* OA = (const bf16*)(A->ws + WS_OATT); bf16* YC = (bf16*)(A->ws + WS_YCAT);
    f32x4 sl[4];
#pragma unroll
    for (int j = 0; j < 4; ++j) sl[j] = *(const GAS f32x4*)(A->in[I_SUBLN] + l * 128 + e0 + 4 * j);
    for (int m = gw; m < MT; m += NGW) {
        if (l == 0 && m >= MP) { const float* xs = A->in[I_XS] + (size_t)(m - MP) * DMOD; float* xd = (float*)(A->ws + WS_X) + (size_t)m * DMOD;
#pragma unroll
            for (int j = 0; j < 8; ++j) *(GAS f32x4*)(xd + 4 * lane + 256 * j) = *(const GAS f32x4*)(xs + 4 * lane + 256 * j); }
        const bf16* o1 = OA + (size_t)m * DMOD + hh * 256 + e0; f32x4 o[4]; float ss = 0.f;
        { const v4u a0 = *(const GAS v4u*)o1, a1 = *(const GAS v4u*)(o1 + 8), b0 = *(const GAS v4u*)(o1 + 128), b1 = *(const GAS v4u*)(o1 + 136);
          const unsigned aw[8] = {a0.x, a0.y, a0.z, a0.w, a1.x, a1.y, a1.z, a1.w}, bw[8] = {b0.x, b0.y, b0.z, b0.w, b1.x, b1.y, b1.z, b1.w};
#pragma unroll
          for (int j = 0; j < 4; ++j) { o[j][0] = bf2f((unsigned short)(aw[2 * j] & 0xffffu)) - lam * bf2f((unsigned short)(bw[2 * j] & 0xffffu)); o[j][1] = bf2f((unsigned short)(aw[2 * j] >> 16)) - lam * bf2f((unsigned short)(bw[2 * j] >> 16));
              o[j][2] = bf2f((unsigned short)(aw[2 * j + 1] & 0xffffu)) - lam * bf2f((unsigned short)(bw[2 * j + 1] & 0xffffu)); o[j][3] = bf2f((unsigned short)(aw[2 * j + 1] >> 16)) - lam * bf2f((unsigned short)(bw[2 * j + 1] >> 16));
              ss += (o[j][0] * o[j][0] + o[j][1] * o[j][1]) + (o[j][2] * o[j][2] + o[j][3] * o[j][3]); } }
        ss += swz_xor<1>(ss); ss += swz_xor<2>(ss); ss += swz_xor<4>(ss);
        const float rs = osc * __builtin_amdgcn_rsqf(ss * (1.f / 128.f) + 1e-5f);
        v4u w0, w1; f32x4 y0 = o[0] * rs * sl[0], y1 = o[1] * rs * sl[1], y2 = o[2] * rs * sl[2], y3 = o[3] * rs * sl[3];
        w0 = (v4u){pk2(y0[0], y0[1]), pk2(y0[2], y0[3]), pk2(y1[0], y1[1]), pk2(y1[2], y1[3])}; w1 = (v4u){pk2(y2[0], y2[1]), pk2(y2[2], y2[3]), pk2(y3[0], y3[1]), pk2(y3[2], y3[3])};
        bf16* yo = YC + (size_t)m * DMOD + 1024 + hh * 128 + e0; *(GAS v4u*)yo = w0; *(GAS v4u*)(yo + 8) = w1;
    }
}
__device__ __forceinline__ void ph_fixup(Frame& F, int l) {
    PHASE_ENTRY();
    const float* tail = (const float*)(A->ws + WS_HALO), *hg = tail + 32 * 2 * DFF, *hv = hg + 32 * 2 * DFF;
    const float* cw = A->in[I_CONVW] + (size_t)l * 3 * DFF, *cb = A->in[I_CONVB] + (size_t)l * DFF; bf16* ACT = (bf16*)(A->ws + WS_ACT);
    const int gt = F.bid * (NWAVES * 64) + F.tid, ngt = F.G * NWAVES * 64;
    for (int idx = gt; idx < 31 * DFF; idx += ngt) { const int pm = 1 + idx / DFF, j = idx % DFF;
        const float um2 = tail[((size_t)(pm - 1) * 2 + 0) * DFF + j], um1 = tail[((size_t)(pm - 1) * 2 + 1) * DFF + j], u0 = hg[((size_t)pm * 2 + 0) * DFF + j], u1 = hg[((size_t)pm * 2 + 1) * DFF + j];
        const float v0 = hv[((size_t)pm * 2 + 0) * DFF + j], v1 = hv[((size_t)pm * 2 + 1) * DFF + j];
        const float w0 = cw[j], w1 = cw[DFF + j], w2 = cw[2 * DFF + j], b = cb[j];
        const pg8::f32x2 g = pg8::gelu_pk((pg8::f32x2){b + w0 * um2 + w1 * um1 + w2 * u0, b + w0 * um1 + w1 * u0 + w2 * u1});
        ACT[(size_t)(256 * pm) * DFF + j] = (bf16)f2bf(g.x * v0); ACT[(size_t)(256 * pm + 1) * DFF + j] = (bf16)f2bf(g.y * v1); }
}
#ifdef PROBE_SEQ
__device__ __forceinline__ void probe_seq_scan(Frame& F, int l) {
    PHASE_ENTRY();
    const int gw = F.bid * NWAVES + F.wave, lane = F.lane;
    if (gw >= 16) return;
    const int h = gw, hj = h * 64 + lane;
    const float* PR = (const float*)(A->ws + WS_PR); const float* mu = A->in[I_MU] + (size_t)l * NRC;
    LAS float* sc = (LAS float*)(F.lds + F.wave * 4096);
    const float* w2 = A->in[I_W2] + (size_t)l * 96 * 1024; const float* a2 = A->in[I_A2] + (size_t)l * 96 * 1024;
    const float w0 = A->in[I_W0][l * 1024 + hj], a0 = A->in[I_A0][l * 1024 + hj], kkw = A->in[I_KK][l * 1024 + hj], kaw = A->in[I_KA][l * 1024 + hj];
    float S[64];
#pragma unroll
    for (int k = 0; k < 64; ++k) S[k] = 0.f;
    for (int t = 0; t < MP; ++t) {
        const float* pc = PR + (size_t)t * NRC_PAD; const float* pp = pc - NRC_PAD;
        auto lerp = [&](int col) { const float cur = pc[col]; const float prv = t > 0 ? pp[col] : 0.f; return cur + (prv - cur) * mu[col]; };
        sc[lane] = tanhf(lerp(3072 + lane)); if (lane < 32) sc[64 + lane] = tanhf(lerp(3072 + 64 + lane));
        sc[96 + lane] = lerp(3168 + lane); if (lane < 32) sc[96 + 64 + lane] = lerp(3168 + 64 + lane);
        LDS_WAIT(); asm volatile("" ::: "memory");
        float wl = 0.f, al = 0.f;
        for (int k = 0; k < 96; ++k) { wl += sc[k] * w2[(size_t)k * 1024 + hj]; al += sc[96 + k] * a2[(size_t)k * 1024 + hj]; }
        const float xk = lerp(1024 + hj), xv = lerp(2048 + hj);
        const float z = w0 + wl; const float wlog = -log1pf(expf(-z)) - 0.5f; const float w = expf(-expf(wlog));
        const float a = 1.f / (1.f + expf(-(a0 + al)));
        const float kkr = xk * kkw; const float nrm = wave_sum(kkr * kkr); const float kk = kkr / sqrtf(fmaxf(nrm, 1e-24f));
        const float km = xk * (1.f + (a - 1.f) * kaw);
        LDS_WAIT(); asm volatile("" ::: "memory");
        sc[192 + lane] = w; sc[256 + lane] = kk; sc[320 + lane] = kk * a; sc[384 + lane] = km;
        LDS_WAIT(); asm volatile("" ::: "memory");
        float sa = 0.f;
#pragma unroll
        for (int k = 0; k < 64; ++k) sa -= S[k] * sc[256 + k];
#pragma unroll
        for (int k = 0; k < 64; ++k) S[k] = S[k] * sc[192 + k] + sa * sc[320 + k] + xv * sc[384 + k];
        LDS_WAIT(); asm volatile("" ::: "memory");
    }
    float* wo = A->out + O_WP + (size_t)(l * 16 + h) * 4096 + lane * 64;
#pragma unroll
    for (int k = 0; k < 64; ++k) wo[k] = S[k];
}
#endif
#ifdef PROBE_GEMM
__device__ __forceinline__ void probe_gemm_check(Frame& F) {
    PHASE_ENTRY();
    if (F.bid != 0) return;
    float* scr = (float*)(A->ws + WS_OATT);
    const int tid = F.tid, lane = F.lane, wave = F.wave;
    for (int j = tid; j < 2 * DMOD; j += NWAVES * 64) { float s = A->in[I_BADA][j];
        for (int k = 0; k < DMOD; ++k) { const float c = A->in[I_CP][k]; s += (c / (1.f + expf(-c))) * A->in[I_WADA][(size_t)k * MODW + j]; }
        scr[j] = s; }
    __threadfence(); __syncthreads();
    float num = 0.f, den = 0.f;
#if PROBE_GEMM == 3
    for (int j = tid; j < 2 * DMOD; j += NWAVES * 64) { const float mine = ((const float*)(A->ws + WS_MOD))[j], ref = scr[j]; num += (mine - ref) * (mine - ref); den += ref * ref; }
    num = wave_sum(num); den = wave_sum(den);
#elif PROBE_GEMM == 5
    { const float sgot = wave_sum((float)(lane + 1)); num = (sgot - 2080.f) * (sgot - 2080.f); den = 2080.f * 2080.f; }
#elif PROBE_GEMM == 6
    { float v = (float)(lane + 1); for (int o = 1; o < 64; o <<= 1) v += __shfl_xor(v, o); num = (v - 2080.f) * (v - 2080.f); den = 2080.f * 2080.f; }
#elif PROBE_GEMM == 4
    for (int smp = wave; smp < 64; smp += NWAVES) { const int m = (smp * 2654435761u >> 7) % MP; const float* xr = A->in[I_XP] + (size_t)m * DMOD; float ss = 0.f;
        for (int k = lane; k < DMOD; k += 64) ss += xr[k] * xr[k];
        const float rstd = 1.f / sqrtf(wave_sum(ss) / DMOD + 1e-6f);
        for (int k = lane; k < DMOD; k += 64) { const float hh = xr[k] * rstd * A->in[I_GMIX][k] * (1.f + scr[DMOD + k]) + scr[k]; const float mine = bf2f(((const bf16*)(A->ws + WS_H))[(size_t)m * DMOD + k]); num += (mine - hh) * (mine - hh); den += hh * hh; } }
    num = wave_sum(num); den = wave_sum(den);
#else
    for (int smp = wave; smp < 256; smp += NWAVES) {
        const int m = (smp * 2654435761u >> 7) % MP; const int cc = (smp * 40503u + 17u) % (PROBE_GEMM == 1 ? 3072 : 1024);
        const int col = PROBE_GEMM == 1 ? cc : NRC + 1024 + cc;
        const float* xr = A->in[I_XP] + (size_t)m * DMOD; float ss = 0.f;
        for (int k = lane; k < DMOD; k += 64) ss += xr[k] * xr[k];
        const float rstd = 1.f / sqrtf(wave_sum(ss) / DMOD + 1e-6f); float acc = 0.f;
        for (int k = lane; k < DMOD; k += 64) { const float hh = xr[k] * rstd * A->in[I_GMIX][k] * (1.f + scr[DMOD + k]) + scr[k]; acc += hh * A->in[I_WIN][(size_t)k * NIN + col]; }
        acc = wave_sum(acc);
        const float mine = PROBE_GEMM == 1 ? ((const float*)(A->ws + WS_PR))[(size_t)m * NRC_PAD + cc] : A->out[O_KP + (size_t)m * 1024 + cc];
        num += (mine - acc) * (mine - acc); den += acc * acc; }
#endif
    LAS float* red = (LAS float*)F.lds;
    if (lane == 0) { red[wave] = num; red[8 + wave] = den; }
    __syncthreads();
    if (tid == 0) { float n = 0.f, d = 0.f; for (int w = 0; w < 8; ++w) { n += red[w]; d += red[8 + w]; } ((float*)(A->ws + WS_CTL))[16384] = sqrtf(n / d); }
}
#endif
#ifndef MK_SPLIT
#define MK_SPLIT 0
#endif
constexpr int N_PHASES = 22;
__global__ void __launch_bounds__(NWAVES * 64, 2) hybrid_fwd(Args args) {
    extern __shared__ __attribute__((aligned(16))) unsigned char lds[];
    Frame F;
    F.lds = (LAS unsigned char*)lds; F.MISC = (volatile LAS unsigned*)(F.lds + MISC_OFF);
    F.tid = threadIdx.x; F.lane = F.tid & 63; F.wave = __builtin_amdgcn_readfirstlane(F.tid >> 6); F.G = gridDim.x; F.bid = blockIdx.x;
    F.ctl = (gu32*)(args.ws + WS_CTL);
    if (F.tid < 64) F.MISC[F.tid] = 0u;
    __syncthreads();
    XcdBarrier bar; bar.bar = (unsigned*)(F.ctl + CW_BAR); bar.x = 0; bar.st = nullptr;
    if (!MK_SPLIT) bar = xcd_barrier_post((unsigned*)(F.ctl + CW_BAR), F.MISC + 8);
    const int lo = args.ph_lo, hi = args.ph_hi;
#ifndef ONLY_PT
#define ONLY_PT -1
#endif
#define PT_ON(t) (ONLY_PT < 0 || ONLY_PT == (t))
#define IN(k) (lo <= (k) && (k) < hi)
#define SEAM(k) do { if (IN(k) && IN((k) + 1)) xcd_barrier(bar); } while (0)
    if (PT_ON(0) && IN(0)) { ph_prologue(F); }
    SEAM(0);
    for (int l = 0; l < NLAYER; ++l) {
        const int pb = 1 + 10 * l;
        if (PT_ON(1) && IN(pb + 0)) ph_norm(F, l, 0, l == 0 ? 0 : 11);
        SEAM(pb + 0);
        if (PT_ON(2) && IN(pb + 1)) { PHASE_ENTRY(); unsigned char* ws = A->ws;
            pg8::Gemm g{(const pg8::bf16_t*)(ws + WS_H), (const pg8::bf16_t*)(ws + WS_WIN) + (size_t)l * NIN_PAD * DMOD, MT, NIN_PAD, DMOD, DMOD}; pg8::TwoPartOrder S; S.init(MT, NRC_PAD / 256, (NIN_PAD - NRC_PAD) / 256, F.G, F.bid, F.G == 256 ? (unsigned*)(F.ctl + CW_QUEUE + 1024 + 64 * l) : nullptr, 1 + (F.bid + 256 < (MT / 256) * (NRC_PAD / 256) ? 1 : 0));
            pg8::EpiIn E{ws, A->out, l, 0.125f * 1.4426950408889634f};
            pg8::gemm_phase<pg8::EpiIn, pg8::TwoPartOrder, true, true>(F.lds, g, S, E);
        }
        if (F.G != 256) SEAM(pb + 1);
#ifdef PROBE_GEMM
        if (l == 0 && IN(pb + 2)) { probe_gemm_check(F); __syncthreads(); }
#endif
        if (PT_ON(3) && IN(pb + 2)) ph_rwkv_passA(F, l);
        SEAM(pb + 2);
#ifdef PROBE_SEQ
        if (IN(pb + 3)) { probe_seq_scan(F, l); __syncthreads(); }
#endif
        if (PT_ON(4) && IN(pb + 3)) { ph_rwkv_chain(F, l); ph_attn_sample(F, l); ph_attn_prompt(F, l); }
        SEAM(pb + 3);
#ifdef PROBE_SEQ
        if (IN(pb + 4) && F.bid == 0) { PHASE_ENTRY();
            for (int h = F.wave; h < 16; h += NWAVES) { const float* a = (const float*)(A->ws + WS_HALO) + (size_t)h * 4096; const float* b = A->out + O_WP + (size_t)(l * 16 + h) * 4096; float n = 0.f, d = 0.f;
                for (int i = F.lane; i < 4096; i += 64) { n += (a[i] - b[i]) * (a[i] - b[i]); d += b[i] * b[i]; }
                n = wave_sum(n); d = wave_sum(d); if (F.lane == 0) { ((float*)(A->ws + WS_CTL))[16400 + 16 * l + h] = sqrtf(n / d); ((float*)(A->ws + WS_CTL))[16440 + 16 * l + h] = d; } } }
#endif
        if (PT_ON(5) && IN(pb + 4)) { ph_rwkv_passC(F, l); ph_attn_final(F, l); }
        SEAM(pb + 4);
        if (PT_ON(6) && IN(pb + 5)) { PHASE_ENTRY(); unsigned char* ws = A->ws;
            const float* X = (const float*)(ws + WS_X); const float* MODl = (const float*)(ws + WS_MOD) + (size_t)l * NMODB * MODW;
            { pg8::Gemm g{(const pg8::bf16_t*)(ws + WS_YCAT), (const pg8::bf16_t*)(ws + WS_WOUT) + (size_t)l * DMOD * DMOD, MP, DMOD, DMOD, DMOD}; pg8::StaticOrder S; S.init(MP, DMOD, F.G, F.bid);
              pg8::EpiRes E{l == 0 ? A->in[I_XP] : X, X + (size_t)MP * DMOD, (float*)(ws + WS_X), MODl + 2 * DMOD};
              pg8::gemm_phase<pg8::EpiRes, pg8::StaticOrder, true, true>(F.lds, g, S, E); }
            { pg8::Gemm g{(const pg8::bf16_t*)(ws + WS_YCAT) + (size_t)MP * DMOD, (const pg8::bf16_t*)(ws + WS_WOUT) + (size_t)l * DMOD * DMOD, 256, DMOD, DMOD / 8, DMOD}; pg8::SplitOrder S; S.init(DMOD, 8, F.bid);
              pg8::EpiResSlab E{(float*)(ws + WS_SLAB), MODl + 2 * DMOD};
              pg8::gemm_phase<pg8::EpiResSlab, pg8::SplitOrder, true, true>(F.lds, g, S, E); }
        }
        SEAM(pb + 5);
        if (PT_ON(7) && IN(pb + 6)) ph_norm(F, l, 1, 8);
        SEAM(pb + 6);
        if (PT_ON(8) && IN(pb + 7)) { PHASE_ENTRY(); unsigned char* ws = A->ws;
            pg8::Gemm g{(const pg8::bf16_t*)(ws + WS_H), (const pg8::bf16_t*)(ws + WS_WUP) + (size_t)l * NUP * DMOD, MT, NUP, DMOD, DMOD}; pg8::PmFirstOrder S; S.init(MT, NUP, F.G, F.bid, F.G == 256 ? (unsigned*)(F.ctl + CW_QUEUE + 1536 + 64 * l) : nullptr);
            pg8::EpiUp E{(pg8::bf16_t*)(ws + WS_ACT), A->in[I_CONVW] + (size_t)l * 3 * DFF, A->in[I_CONVB] + (size_t)l * DFF, A->in[I_SCONV] + (size_t)l * NSB * 2 * DFF,
                         (float*)(ws + WS_HALO), A->out + O_CP + (size_t)l * 2 * DFF, A->out + O_CS + (size_t)l * NSB * 2 * DFF, (PG8_LAS float*)(F.lds + HALO_OFF)};
            pg8::gemm_phase<pg8::EpiUp, pg8::PmFirstOrder, true, true>(F.lds, g, S, E);
            { int first = 0, nw = F.G;
              if (F.G == 256) { first = 256 - ((256 * 6) - (MT / 256) * (NUP / 256)); nw = 256 - first; if (F.bid >= first) wait_count(F, (unsigned*)(F.ctl + CW_QUEUE + 1536 + 64 * l), (unsigned)(NUP / 256)); }
              else if (!MK_SPLIT) xcd_barrier(bar);
              const float* MODl = (const float*)(ws + WS_MOD) + (size_t)l * NMODB * MODW;
              pg8::Gemm g2{(const pg8::bf16_t*)(ws + WS_ACT) + (size_t)MP * DFF, (const pg8::bf16_t*)(ws + WS_WDN) + (size_t)l * DMOD * DFF, 256, DMOD, DFF / 11, DFF}; pg8::TailSplitOrder S2; S2.init(DMOD, 11, F.bid, first, nw);
              pg8::EpiResSlab E2{(float*)(ws + WS_SLAB), MODl + 5 * DMOD};
              pg8::gemm_phase<pg8::EpiResSlab, pg8::TailSplitOrder, true, true>(F.lds, g2, S2, E2); }
        }
        SEAM(pb + 7);
        if (PT_ON(9) && IN(pb + 8)) ph_fixup(F, l);
        SEAM(pb + 8);
        if (PT_ON(10) && IN(pb + 9)) { PHASE_ENTRY(); unsigned char* ws = A->ws;
            const float* X = (const float*)(ws + WS_X); const float* MODl = (const float*)(ws + WS_MOD) + (size_t)l * NMODB * MODW;
            { pg8::Gemm g{(const pg8::bf16_t*)(ws + WS_ACT), (const pg8::bf16_t*)(ws + WS_WDN) + (size_t)l * DMOD * DFF, MP, DMOD, DFF, DFF}; pg8::StaticOrder S; S.init(MP, DMOD, F.G, F.bid);
              pg8::EpiRes E{X, X + (size_t)MP * DMOD, (float*)(ws + WS_X), MODl + 5 * DMOD};
              pg8::gemm_phase<pg8::EpiRes, pg8::StaticOrder, true, true>(F.lds, g, S, E); }
        }
        SEAM(pb + 9);
    }
    if (PT_ON(11) && IN(21)) ph_norm(F, 0, 2, 11);
#ifdef PROBE_MASK
    if (IN(22)) { PHASE_ENTRY();
        const size_t offs[13] = {O_YP, O_YS, O_KP, O_VP, O_WP, O_SP, O_CP, O_KS, O_VS, O_WS, O_SS, O_CS, O_END};
        const size_t gt = (size_t)F.bid * (NWAVES * 64) + F.tid, ngt = (size_t)F.G * NWAVES * 64;
#ifndef PROBE_SCALE
#define PROBE_SCALE 1.2f
#endif
#ifndef PROBE_HALF
#define PROBE_HALF 2
#endif
#ifdef PROBE_HEADS
        { const float* dh = (const float*)(A->ws + WS_CTL) + 16400; float best = -1.f; int bi = 0;
#if PROBE_HEADS == 3
          bi = 0; best = dh[PROBE_IDX] * 20.f;
#elif PROBE_HEADS == 1
          for (int i = 0; i < 32; ++i) if (dh[i] > best) { best = dh[i]; bi = i; }
#else
          for (int i = 0; i < 32; ++i) if (dh[i] * dh[i] * dh[40 + i] > best) { best = dh[i] * dh[i] * dh[40 + i]; bi = i; } best = dh[bi];
#endif
          const float val = (PROBE_HEADS == 3) ? best : 0.05f * bi + fminf(best, 0.049f); const float fsc = 1.f + val; for (size_t i = O_YP + gt; i < O_YS; i += ngt) A->out[i] *= fsc; }
#endif
#ifdef PROBE_GEMM
        { const float dd = ((const float*)(A->ws + WS_CTL))[16384]; const float fsc = 1.f + PROBE_AMP * dd; for (size_t i = O_YP + gt; i < O_YS; i += ngt) A->out[i] *= fsc; }
#endif
        for (int o = 0; o < 12; ++o) if ((PROBE_MASK >> o) & 1) { size_t b = offs[o], e = offs[o + 1]; const size_t mid = b + (e - b) / 2;
            if (PROBE_HALF == 0) e = mid; if (PROBE_HALF == 1) b = mid;
            for (size_t i = b + gt; i < e; i += ngt) A->out[i] *= PROBE_SCALE; } }
#endif
#undef IN
#undef SEAM
}

extern "C" void kernel_launch(void* const* d_in, const int* in_sizes, int n_in, void* d_out, int out_size, void* d_ws, size_t ws_size, hipStream_t stream) {
    static int grid = 0;
    if (grid == 0) {
        if (n_in != 37 || (size_t)out_size != O_END || ws_size < WS_END) { fprintf(stderr, "kernel_launch: built for 37 inputs, %zu outputs, >= %zu bytes of workspace; got n_in %d, out %d, ws %zu; nothing launched\n", (size_t)O_END, (size_t)WS_END, n_in, out_size, ws_size); grid = -1; return; }
        int dev = 0, cus = 0, per_cu = 0;
        if (hipGetDevice(&dev) != hipSuccess || hipDeviceGetAttribute(&cus, hipDeviceAttributeMultiprocessorCount, dev) != hipSuccess) { fprintf(stderr, "kernel_launch: device query failed\n"); grid = -1; return; }
        if (hipFuncSetAttribute((const void*)hybrid_fwd, hipFuncAttributeMaxDynamicSharedMemorySize, LDS_BYTES) != hipSuccess) { fprintf(stderr, "kernel_launch: hipFuncSetAttribute failed\n"); grid = -1; return; }
        if (hipOccupancyMaxActiveBlocksPerMultiprocessor(&per_cu, (const void*)hybrid_fwd, NWAVES * 64, LDS_BYTES) != hipSuccess || per_cu < 1) fprintf(stderr, "kernel_launch: note: occupancy query reports %d workgroups per CU\n", per_cu);
        (void)hipGetLastError();
        grid = cus;
    }
    if (grid < 0) return;
    if (hipMemsetAsync((char*)d_ws + WS_CTL, 0, CTL_ZERO_BYTES, stream) != hipSuccess) { fprintf(stderr, "kernel_launch: memset failed\n"); return; }
    Args a{};
    for (int i = 0; i < 37; ++i) a.in[i] = (const float*)d_in[i];
    a.out = (float*)d_out; a.ws = (unsigned char*)d_ws;
#if MK_SPLIT
#ifdef PROBE_MASK
    const int n_launch = N_PHASES + 1;
#else
    const int n_launch = N_PHASES;
#endif
    for (int p = 0; p < n_launch; ++p) { a.ph_lo = p; a.ph_hi = p + 1; hipLaunchKernelGGL(hybrid_fwd, dim3(grid), dim3(NWAVES * 64), LDS_BYTES, stream, a); }
#else
    a.ph_lo = 0; a.ph_hi = N_PHASES; hipLaunchKernelGGL(hybrid_fwd, dim3(grid), dim3(NWAVES * 64), LDS_BYTES, stream, a);
#endif
    const hipError_t le = hipPeekAtLastError();
    if (le != hipSuccess) fprintf(stderr, "kernel_launch: launch failed: %s\n", hipGetErrorName(le));
}
```

```cpp
#include <hip/hip_runtime.h>
#include <hip/hip_bf16.h>
#include <cstdio>
#include <cstdint>
#include <cmath>
constexpr int NWAVES = 8;
constexpr int DMOD = 2048, MP = 8192, NSB = 16, TS = 16, MT = MP + NSB * TS  , PAST = 2048;
constexpr int NRC = 3520, NRC_PAD = 3584, NIN = 6592, NIN_PAD = 6656, DFF = 5632, NUP = 2 * DFF;
constexpr int NLAYER = 2, NMODB = 17, MODW = 6 * DMOD;
constexpr int RW_UNITS = 128 * 16 + NSB * 16;
constexpr size_t O_YP = 0, O_YS = O_YP + (size_t)MP * DMOD, O_KP = O_YS + (size_t)NSB * TS * DMOD, O_VP = O_KP + (size_t)NLAYER * MP * 1024, O_WP = O_VP + (size_t)NLAYER * MP * 1024,
                 O_SP = O_WP + (size_t)NLAYER * 16 * 4096, O_CP = O_SP + (size_t)NLAYER * NRC, O_KS = O_CP + (size_t)NLAYER * 2 * DFF, O_VS = O_KS + (size_t)NLAYER * 256 * 1024,
                 O_WS = O_VS + (size_t)NLAYER * 256 * 1024, O_SS = O_WS + (size_t)NLAYER * NSB * 16 * 4096, O_CS = O_SS + (size_t)NLAYER * NSB * NRC, O_END = O_CS + (size_t)NLAYER * NSB * 2 * DFF;
constexpr size_t MiB = 1u << 20;
constexpr size_t WS_CTL = 0, CTL_ZERO_BYTES = 1 * MiB;
constexpr size_t WS_MOD = 1 * MiB;
constexpr size_t WS_LORA = 3 * MiB, LORA_LAYER = (size_t)1024 * 448 * 2;
constexpr size_t WS_WIN = 5 * MiB, WS_WOUT = 57 * MiB, WS_WUP = 73 * MiB, WS_WDN = 161 * MiB;
constexpr size_t WS_H = 205 * MiB, WS_PR = 238 * MiB, WS_QB = 354 * MiB, WS_KB = 371 * MiB, WS_VB = 388 * MiB, WS_OATT = 405 * MiB, WS_YCAT = 471 * MiB, WS_X = 504 * MiB, WS_ACT = 570 * MiB;
constexpr size_t WS_PT = 661 * MiB, WS_QQ = 679 * MiB, WS_RP = 715 * MiB, WS_YV = 733 * MiB, WS_SC = 769 * MiB, WS_G1 = 787 * MiB, WS_G2 = 820 * MiB, WS_HALO = 853 * MiB, WS_WL = 858 * MiB, WS_PT32 = 859 * MiB, WS_LSCR = 895 * MiB, WS_SLAB = 911 * MiB, WS_END = 935 * MiB;
static_assert(WS_WIN + (size_t)2 * NIN_PAD * DMOD * 2 <= WS_WOUT && WS_WOUT + (size_t)2 * DMOD * DMOD * 2 <= WS_WUP && WS_WUP + (size_t)2 * NUP * DMOD * 2 <= WS_WDN && WS_WDN + (size_t)2 * DMOD * DFF * 2 <= WS_H, "weights map");
static_assert(WS_H + (size_t)MT * DMOD * 2 <= WS_PR && WS_PR + (size_t)MT * NRC_PAD * 4 <= WS_QB && WS_QB + (size_t)MT * 1024 * 2 <= WS_KB && WS_VB + (size_t)MT * 1024 * 2 <= WS_OATT && WS_OATT + (size_t)MT * DMOD * 4 <= WS_YCAT, "act map 1");
static_assert(WS_YCAT + (size_t)MT * DMOD * 2 <= WS_X && WS_X + (size_t)MT * DMOD * 4 <= WS_ACT && WS_ACT + (size_t)MT * DFF * 2 <= WS_PT, "act map 2");
static_assert(WS_PT + (size_t)RW_UNITS * 8192 <= WS_QQ && WS_QQ + (size_t)RW_UNITS * 16384 <= WS_RP && WS_RP + (size_t)RW_UNITS * 8192 <= WS_YV && WS_YV + (size_t)RW_UNITS * 16384 <= WS_SC && WS_SC + (size_t)RW_UNITS * 8192 <= WS_G1, "rwkv map");
static_assert(WS_G1 + (size_t)MT * 1024 * 4 <= WS_G2 && WS_G2 + (size_t)MT * 1024 * 4 <= WS_HALO && WS_HALO + (size_t)3 * 32 * 2 * DFF * 4 <= WS_WL && WS_WL + (size_t)RW_UNITS * 256 <= WS_PT32 && WS_PT32 + (size_t)RW_UNITS * 16384 <= WS_LSCR && WS_LSCR + (size_t)256 * 61440 <= WS_SLAB && WS_SLAB + (size_t)11 * 256 * 2048 * 4 <= WS_END && WS_LORA + 2 * LORA_LAYER <= WS_WIN && WS_MOD + (size_t)NLAYER * NMODB * MODW * 4 <= WS_LORA, "map 3");
constexpr int CW_BAR = 4096, CW_QUEUE = 8192;
constexpr int LDS_BYTES = 163840;
constexpr int MISC_OFF = LDS_BYTES - 256;
constexpr int LUT_OFF = 131072;
constexpr int HALO_OFF = 131072;
constexpr int RW_SLOT = 9216, RW_STRIDE = 72;
constexpr int RW_SCR = 154624;
static_assert(RW_SCR + 4096 <= MISC_OFF && HALO_OFF + 4096 <= MISC_OFF, "LDS map");

#define GAS __attribute__((address_space(1)))
#define LAS __attribute__((address_space(3)))
typedef unsigned short bf16;
typedef unsigned v4u __attribute__((ext_vector_type(4)));
typedef unsigned v2u __attribute__((ext_vector_type(2)));
typedef float f32x4 __attribute__((ext_vector_type(4)));
typedef float f32x2 __attribute__((ext_vector_type(2)));
typedef short bf16x8 __attribute__((ext_vector_type(8)));
typedef GAS unsigned gu32;
#define RLX_AGENT __ATOMIC_RELAXED, __HIP_MEMORY_SCOPE_AGENT
#define LDS_WAIT() asm volatile("s_waitcnt lgkmcnt(0)" ::: "memory")
#define VM_WAIT() asm volatile("s_waitcnt vmcnt(0)" ::: "memory")
typedef float cvt_f32x2 __attribute__((ext_vector_type(2))); typedef __bf16 cvt_bf16x2 __attribute__((ext_vector_type(2)));
__device__ __forceinline__ unsigned pk2(float lo, float hi) { const cvt_f32x2 v = {lo, hi}; return __builtin_bit_cast(unsigned, __builtin_convertvector(v, cvt_bf16x2)); }
__device__ __forceinline__ unsigned f2bf(float f) { return pk2(f, 0.f) & 0xffffu; }
__device__ __forceinline__ float bf2f(unsigned short b) { return __builtin_bit_cast(float, (unsigned)b << 16); }
template <int K> __device__ __forceinline__ float swz_xor(float v) { static_assert(K >= 1 && K <= 16, "");
    return __builtin_bit_cast(float, __builtin_amdgcn_ds_swizzle(__builtin_bit_cast(int, v), (K << 10) | 0x1f)); }
struct PL32 { float a, b; };
__device__ __forceinline__ PL32 pl32(float v) { const int ln = (int)(threadIdx.x & 63);
    const float p = __builtin_bit_cast(float, __builtin_amdgcn_ds_bpermute((ln ^ 32) << 2, __builtin_bit_cast(int, v))); PL32 o; o.a = v; o.b = p; return o; }
__device__ __forceinline__ float xor32(float v) { return pl32(v).b; }
template <int CTRL> __device__ __forceinline__ float dpp_f(float v) { return __builtin_bit_cast(float, __builtin_amdgcn_update_dpp(__builtin_bit_cast(int, v), __builtin_bit_cast(int, v), CTRL, 0xF, 0xF, false)); }
__device__ __forceinline__ float wave_sum(float v) {
    v += dpp_f<0xB1>(v); v += dpp_f<0x4E>(v); v += dpp_f<0x141>(v); v += dpp_f<0x128>(v); v += swz_xor<16>(v);
    const PL32 r = pl32(v); return r.a + r.b;
}
__device__ __forceinline__ float wave_max(float v) {
    v = fmaxf(v, dpp_f<0xB1>(v)); v = fmaxf(v, dpp_f<0x4E>(v)); v = fmaxf(v, dpp_f<0x141>(v)); v = fmaxf(v, dpp_f<0x128>(v)); v = fmaxf(v, swz_xor<16>(v));
    const PL32 r = pl32(v); return fmaxf(r.a, r.b);
}
__device__ __forceinline__ float sigmoidf_(float x) { return __builtin_amdgcn_rcpf(1.f + __expf(-x)); }
namespace pg8 {
#define PG8_LAS __attribute__((address_space(3)))
typedef unsigned short bf16_t;
typedef short bf16x8 __attribute__((ext_vector_type(8)));
typedef float f32x4 __attribute__((ext_vector_type(4)));
typedef unsigned u32x4 __attribute__((ext_vector_type(4)));
constexpr int BM = 256, BK = 64, HALF = 128, HTB = HALF * BK * 2  , STAGE_BYTES = 8 * HTB, NXCD = 8, WGM = 8;

__host__ __device__ __forceinline__ int lds_byte(int r, int c) { const int st = (r >> 4) * 2 + (c >> 5), rr = r & 15, cc = c & 31, ob = rr * 64 + cc * 2; return st * 1024 + (ob ^ (((ob >> 9) & 1) << 5)); }
__host__ __device__ __forceinline__ void stage_rc(int b, int& R, int& C) { const int st = b / 1024, sb = b % 1024, swz = sb ^ (((sb >> 9) & 1) << 5); R = (st >> 1) * 16 + swz / 64; C = (st & 1) * 32 + (swz % 64) / 2; }
__host__ __device__ __forceinline__ int perm32(int rho) { const int n = rho >> 4, i = rho & 15; return 8 * (i >> 2) + 4 * n + (i & 3); }

struct Unit { int pm, pn, ks, tag; };
struct Gemm { const bf16_t* A; const bf16_t* Bt; int M, N, K, ld; };

struct StaticOrder {
    static constexpr bool HANDOFF = false;
    int nM, nN, nwg, G, c;
    __host__ __device__ void init(int M, int N, int G_, int c_) { nM = M / BM; nN = N / BM; nwg = nM * nN; G = G_; c = c_; }
    __host__ __device__ bool next(int i, Unit& u) const {
        const long L = (long)i * G + c; if (L >= nwg) return false;
        int wgid = (int)L; { const int q = nwg / NXCD, r = nwg % NXCD, xcd = wgid % NXCD, off = wgid / NXCD; wgid = (xcd < r ? xcd * (q + 1) : r * (q + 1) + (xcd - r) * q) + off; }
        const int nig = WGM * nN, gid = wgid / nig, fm = gid * WGM, gsz = (nM - fm) < WGM ? (nM - fm) : WGM;
        u.pm = fm + ((wgid % nig) % gsz); u.pn = (wgid % nig) / gsz; u.ks = 0; u.tag = 0; return true;
    }
    __device__ __forceinline__ void a_ready(const Unit&) const {}
    __device__ __forceinline__ void done(const Unit&) const {}
};

struct TwoPartOrder {
    static constexpr bool HANDOFF = true;
    int nM, nA, nB, G, c; unsigned* cnt; int nsig;
    __device__ __forceinline__ void mid(const Unit& u, int t, int nt, int wid, int lane) const {
        if (cnt == nullptr || u.tag != 2) return;
        if (t == nt / 2) asm volatile("s_waitcnt vmcnt(0)" ::: "memory");
        if (t == nt / 2 + 2 && wid == 0) { __builtin_amdgcn_fence(__ATOMIC_RELEASE, "agent"); asm volatile("s_waitcnt vmcnt(0)" ::: "memory");
            if (lane == 0) (void)__hip_atomic_fetch_add(cnt, (unsigned)nsig, __ATOMIC_RELAXED, __HIP_MEMORY_SCOPE_AGENT); }
    }
    __host__ __device__ void init(int M, int NA, int NB, int G_, int c_, unsigned* cnt_, int nsig_) { nM = M / BM; nA = NA; nB = NB; G = G_; c = c_; cnt = cnt_; nsig = nsig_; }
    __host__ __device__ static void map(int wgid, int nM, int nN, Unit& u) {
        const int nwg = nM * nN; { const int q = nwg / NXCD, r = nwg % NXCD, xcd = wgid % NXCD, off = wgid / NXCD; wgid = (xcd < r ? xcd * (q + 1) : r * (q + 1) + (xcd - r) * q) + off; }
        const int nig = WGM * nN, gid = wgid / nig, fm = gid * WGM, gsz = (nM - fm) < WGM ? (nM - fm) : WGM;
        u.pm = fm + ((wgid % nig) % gsz); u.pn = (wgid % nig) / gsz; u.ks = 0;
    }
    __host__ __device__ bool next(int i, Unit& u) const {
        const long L = (long)i * G + c; const int na = nM * nA, nb = nM * nB; if (L >= na + nb) return false;
        if (L < na) map((int)L, nM, nA, u); else { map((int)L - na, nM, nB, u); u.pn += nA; }
        u.tag = i; return true;
    }
    __device__ __forceinline__ void a_ready(const Unit&) const {}
    __device__ __forceinline__ void done(const Unit&) const {}
};

struct PmFirstOrder {
    static constexpr bool HANDOFF = true;
    int nM, nN, G, c; unsigned* cnt;
    __host__ __device__ void init(int M, int N, int G_, int c_, unsigned* cnt_) { nM = M / BM; nN = N / BM; G = G_; c = c_; cnt = cnt_; }
    __host__ __device__ __forceinline__ bool next(int i, Unit& u) const {
        const long L = (long)i * G + c; if (L >= (long)nM * nN) return false;
        if (L < nN) { u.pm = nM - 1; u.pn = (int)L; u.ks = 0; } else TwoPartOrder::map((int)L - nN, nM - 1, nN, u);
        u.tag = i; return true;
    }
    __device__ __forceinline__ void a_ready(const Unit&) const {}
    __device__ __forceinline__ void done(const Unit&) const {}
    __device__ __forceinline__ void mid(const Unit& u, int t, int nt, int wid, int lane) const {
        if (cnt == nullptr || u.tag != 1 || c >= nN) return;
        if (t == nt / 2) asm volatile("s_waitcnt vmcnt(0)" ::: "memory");
        if (t == nt / 2 + 2 && wid == 0) { __builtin_amdgcn_fence(__ATOMIC_RELEASE, "agent"); asm volatile("s_waitcnt vmcnt(0)" ::: "memory");
            if (lane == 0) (void)__hip_atomic_fetch_add(cnt, 1u, __ATOMIC_RELAXED, __HIP_MEMORY_SCOPE_AGENT); }
    }
};
struct TailSplitOrder {
    static constexpr bool HANDOFF = false;
    int n, KS, k, nw;
    __host__ __device__ void init(int N, int KS_, int c_, int first, int nw_) { n = (N / BM) * KS_; KS = KS_; k = c_ - first; nw = nw_; }
    __host__ __device__ __forceinline__ bool next(int i, Unit& u) const { const int L = k + i * nw; if (k < 0 || L >= n) return false; u.pm = 0; u.pn = L / KS; u.ks = L % KS; u.tag = 0; return true; }
    __device__ __forceinline__ void a_ready(const Unit&) const {}
    __device__ __forceinline__ void done(const Unit&) const {}
};

struct SplitOrder {
    static constexpr bool HANDOFF = false;
    int n, KS, c;
    __host__ __device__ void init(int N, int KS_, int c_) { n = (N / BM) * KS_; KS = KS_; c = c_; }
    __host__ __device__ bool next(int i, Unit& u) const { if (i > 0 || c >= n) return false; u.pm = 0; u.pn = c / KS; u.ks = c % KS; u.tag = 0; return true; }
    __device__ __forceinline__ void a_ready(const Unit&) const {}
    __device__ __forceinline__ void done(const Unit&) const {}
};
__device__ __forceinline__ unsigned cvt_pk_bf16(float lo, float hi) { unsigned r; asm volatile("v_cvt_pk_bf16_f32 %0, %1, %2" : "=v"(r) : "v"(lo), "v"(hi)); return r; }
typedef float f32x2 __attribute__((ext_vector_type(2)));
__device__ __forceinline__ f32x2 gelu_pk(f32x2 v) {
    const f32x2 av = __builtin_elementwise_abs(v), d = av * 0.2316418882f + 1.0f;
    f32x2 t; t.x = __builtin_amdgcn_rcpf(d.x); t.y = __builtin_amdgcn_rcpf(d.y);
    f32x2 q = t * 0.5307027145f + (-0.7265760135f); q = q * t + 0.7107068705f; q = q * t + (-0.142248368f); q = q * t + 0.127414796f; q = q * t;
    const f32x2 s = (v * v) * (-0.72134752044f);
    f32x2 e; e.x = __builtin_amdgcn_exp2f(s.x); e.y = __builtin_amdgcn_exp2f(s.y);
    const f32x2 m = v * (q * e), r = v - m;
    f32x2 o; o.x = v.x < 0.f ? m.x : r.x; o.y = v.y < 0.f ? m.y : r.y; return o;
}

template <class Epi, class Sched, bool ALIGN_EPI = false, bool SP2 = false>
__device__ __forceinline__ void gemm_phase(PG8_LAS unsigned char* lds, const Gemm g, const Sched& S, const Epi& E) {
    int tid_ = threadIdx.x; asm volatile("" : "+v"(tid_));
    const int tid = tid_, wid = __builtin_amdgcn_readfirstlane(tid >> 6), lane = tid & 63, wr = wid >> 2, wc = wid & 3, fr = lane & 15, fq = lane >> 4;
    const int K = g.ld, nt = g.K / BK;
    unsigned voffA[2], voffB[2];
#pragma unroll
    for (int i = 0; i < 2; ++i) { int R, C; stage_rc(tid * 16 + i * 8192, R, C); const int Rb = Epi::PERM ? ((R & ~31) + perm32(R & 31)) : R;
        voffA[i] = (unsigned)(R * K + C) * 2u; voffB[i] = (unsigned)(Rb * K + C) * 2u; }
    const size_t kstep = (size_t)(BK * 2);
    const size_t hstep = (size_t)HALF * K * 2;
    const size_t tstep = 2 * hstep;
    const unsigned ldsw = (unsigned)wid * 1024u;
    const int aoff = lds_byte(wr * 64 + fr, fq * 8), boff = lds_byte(wc * 32 + fr, fq * 8);
#define PG8_SA(b, h) (((b) * 2 + (h)) * HTB)
#define PG8_SB(b, h) ((4 + (b) * 2 + (h)) * HTB)
#define PG8_STAGE(bufoff, gbase, voff) do { _Pragma("unroll") for (int _i = 0; _i < 2; ++_i) \
        __builtin_amdgcn_global_load_lds((const unsigned*)((const char*)(gbase) + (voff)[_i]), (PG8_LAS unsigned*)(lds + (bufoff) + ldsw + _i * 8192), 16, 0, 0); } while (0)
#define PG8_LDA(dst, b, h) do { _Pragma("unroll") for (int m = 0; m < 4; ++m) _Pragma("unroll") for (int k = 0; k < 2; ++k) dst[m][k] = *(const PG8_LAS bf16x8*)(lds + PG8_SA(b, h) + aoff + m * 2048 + k * 1024); } while (0)
#define PG8_LDB(dst, b, h) do { _Pragma("unroll") for (int n = 0; n < 2; ++n) _Pragma("unroll") for (int k = 0; k < 2; ++k) dst[n][k] = *(const PG8_LAS bf16x8*)(lds + PG8_SB(b, h) + boff + n * 2048 + k * 1024); } while (0)
#define PG8_MMA(ai, bj, At, Bt) do { __builtin_amdgcn_s_setprio(1); _Pragma("unroll") for (int m = 0; m < 4; ++m) _Pragma("unroll") for (int n = 0; n < 2; ++n) _Pragma("unroll") for (int k = 0; k < 2; ++k) \
        acc[ai][bj][m][n] = __builtin_amdgcn_mfma_f32_16x16x32_bf16(Bt[n][k], At[m][k], acc[ai][bj][m][n], 0, 0, 0); __builtin_amdgcn_s_setprio(0); } while (0)
#define PG8_WAIT_V(n) asm volatile("s_waitcnt vmcnt(" #n ")" ::: "memory")
#define PG8_WAIT_L(n) asm volatile("s_waitcnt lgkmcnt(" #n ")" ::: "memory")
#define PG8_BAR __builtin_amdgcn_s_barrier()
#define PG8_SCHED __builtin_amdgcn_sched_barrier(0)
    Unit cur, nxt; int ui = 0;
    if (!S.next(0, cur)) return;
    f32x4 acc[2][2][4][2];
#pragma unroll
    for (int a = 0; a < 2; ++a)
#pragma unroll
        for (int b = 0; b < 2; ++b)
#pragma unroll
            for (int m = 0; m < 4; ++m)
#pragma unroll
                for (int n = 0; n < 2; ++n) acc[a][b][m][n] = (f32x4){0.f, 0.f, 0.f, 0.f};
    bf16x8 At[4][2], B0[2][2], B1[2][2];
    const size_t sstep = (size_t)g.K * 2;
    const char* cA = (const char*)g.A + (size_t)cur.pm * tstep + (size_t)cur.ks * sstep; const char* cB = (const char*)g.Bt + (size_t)cur.pn * tstep + (size_t)cur.ks * sstep;
    S.a_ready(cur);
    if constexpr (SP2) {
        PG8_STAGE(PG8_SB(0, 0), cB, voffB); PG8_STAGE(PG8_SB(0, 1), cB + hstep, voffB); PG8_STAGE(PG8_SA(0, 0), cA, voffA); PG8_STAGE(PG8_SA(0, 1), cA + hstep, voffA);
        if (wr == 1) PG8_BAR;
        PG8_WAIT_V(2); PG8_BAR;
        PG8_STAGE(PG8_SB(1, 0), cB + kstep, voffB); PG8_STAGE(PG8_SA(1, 0), cA + kstep, voffA); PG8_STAGE(PG8_SB(1, 1), cB + hstep + kstep, voffB);
        PG8_WAIT_V(6); PG8_BAR;
    } else {
        PG8_STAGE(PG8_SB(0, 0), cB, voffB); PG8_STAGE(PG8_SA(0, 0), cA, voffA); PG8_STAGE(PG8_SB(0, 1), cB + hstep, voffB); PG8_STAGE(PG8_SA(0, 1), cA + hstep, voffA);
        if (wr == 1) PG8_BAR;
        PG8_WAIT_V(4); PG8_BAR;
        PG8_STAGE(PG8_SB(1, 0), cB + kstep, voffB); PG8_STAGE(PG8_SA(1, 0), cA + kstep, voffA); PG8_STAGE(PG8_SB(1, 1), cB + hstep + kstep, voffB);
        PG8_WAIT_V(6); PG8_BAR;
    }
    for (;;) {
        const bool has_next = S.next(ui + 1, nxt);
        const char* nA = has_next ? (const char*)g.A + (size_t)nxt.pm * tstep + (size_t)nxt.ks * sstep : cA; const char* nB = has_next ? (const char*)g.Bt + (size_t)nxt.pn * tstep + (size_t)nxt.ks * sstep : cB;
        for (int t = 0; t < nt; t += 2) {
            const bool last = (t == nt - 2);
            const char* a1 = cA + (size_t)(t + 1) * kstep;
            const char* a2 = last ? nA : cA + (size_t)(t + 2) * kstep; const char* b2 = last ? nB : cB + (size_t)(t + 2) * kstep;
            const char* a3 = a2 + kstep; const char* b3 = b2 + kstep;
            if (last && has_next) S.a_ready(nxt);
            if constexpr (Sched::HANDOFF) S.mid(cur, t, nt, wid, lane);
            if constexpr (SP2) {
            PG8_LDB(B0, 0, 0); PG8_LDB(B1, 0, 1); PG8_SCHED; PG8_LDA(At, 0, 0); PG8_STAGE(PG8_SA(1, 1), a1 + hstep, voffA);
            PG8_WAIT_V(8); PG8_WAIT_L(0); PG8_BAR; PG8_MMA(0, 0, At, B0); PG8_MMA(0, 1, At, B1); PG8_BAR; PG8_SCHED;
            PG8_LDA(At, 0, 1); PG8_STAGE(PG8_SB(0, 0), b2, voffB); PG8_STAGE(PG8_SB(0, 1), b2 + hstep, voffB); PG8_STAGE(PG8_SA(0, 0), a2, voffA);
            PG8_WAIT_V(8); PG8_WAIT_L(0); PG8_BAR; PG8_MMA(1, 0, At, B0); PG8_MMA(1, 1, At, B1); PG8_BAR; PG8_SCHED;
            PG8_LDB(B0, 1, 0); PG8_LDB(B1, 1, 1); PG8_SCHED; PG8_LDA(At, 1, 0); PG8_STAGE(PG8_SA(0, 1), a2 + hstep, voffA);
            PG8_WAIT_V(8); PG8_WAIT_L(0); PG8_BAR; PG8_MMA(0, 0, At, B0); PG8_MMA(0, 1, At, B1); PG8_BAR; PG8_SCHED;
            PG8_LDA(At, 1, 1); PG8_STAGE(PG8_SB(1, 0), b3, voffB); PG8_STAGE(PG8_SB(1, 1), b3 + hstep, voffB); PG8_STAGE(PG8_SA(1, 0), a3, voffA);
            PG8_WAIT_V(8); PG8_WAIT_L(0); PG8_BAR; PG8_MMA(1, 0, At, B0); PG8_MMA(1, 1, At, B1); PG8_BAR; PG8_SCHED;
            } else {
            PG8_LDB(B0, 0, 0); PG8_SCHED; PG8_LDA(At, 0, 0); PG8_STAGE(PG8_SA(1, 1), a1 + hstep, voffA);
            PG8_WAIT_L(8); PG8_BAR; PG8_WAIT_L(0); PG8_MMA(0, 0, At, B0); PG8_BAR; PG8_SCHED;
            PG8_LDB(B1, 0, 1); PG8_STAGE(PG8_SB(0, 0), b2, voffB);
            PG8_BAR; PG8_WAIT_L(0); PG8_MMA(0, 1, At, B1); PG8_BAR;
            PG8_LDA(At, 0, 1); PG8_STAGE(PG8_SA(0, 0), a2, voffA);
            PG8_BAR; PG8_WAIT_L(0); PG8_MMA(1, 0, At, B0); PG8_BAR; PG8_SCHED;
            PG8_STAGE(PG8_SB(0, 1), b2 + hstep, voffB);
            PG8_WAIT_V(6); PG8_BAR; PG8_MMA(1, 1, At, B1); PG8_BAR;
            PG8_LDB(B0, 1, 0); PG8_SCHED; PG8_LDA(At, 1, 0); PG8_STAGE(PG8_SA(0, 1), a2 + hstep, voffA);
            PG8_WAIT_L(8); PG8_BAR; PG8_WAIT_L(0); PG8_MMA(0, 0, At, B0); PG8_BAR; PG8_SCHED;
            PG8_LDB(B1, 1, 1); PG8_STAGE(PG8_SB(1, 0), b3, voffB);
            PG8_BAR; PG8_WAIT_L(0); PG8_MMA(0, 1, At, B1); PG8_BAR;
            PG8_LDA(At, 1, 1); PG8_STAGE(PG8_SA(1, 0), a3, voffA);
            PG8_BAR; PG8_WAIT_L(0); PG8_MMA(1, 0, At, B0); PG8_BAR; PG8_SCHED;
            PG8_STAGE(PG8_SB(1, 1), b3 + hstep, voffB);
            PG8_WAIT_V(6); PG8_BAR; PG8_MMA(1, 1, At, B1); PG8_BAR;
            }
        }
        if constexpr (ALIGN_EPI) { if (wr == 0) PG8_BAR; }
        if constexpr (!Epi::AFTER_DRAIN) { E(acc, cur, wr, wc, fr, fq); S.done(cur); }
        if (!has_next) break;
#pragma unroll
        for (int a = 0; a < 2; ++a)
#pragma unroll
            for (int b = 0; b < 2; ++b)
#pragma unroll
                for (int m = 0; m < 4; ++m)
#pragma unroll
                    for (int n = 0; n < 2; ++n) acc[a][b][m][n] = (f32x4){0.f, 0.f, 0.f, 0.f};
        cur = nxt; cA = nA; cB = nB; ++ui;
        if constexpr (ALIGN_EPI) { if (wr == 1) PG8_BAR; }
    }
    PG8_WAIT_V(0);
    if constexpr (!ALIGN_EPI) { if (wr == 0) PG8_BAR; }
    PG8_BAR;
    if constexpr (Epi::AFTER_DRAIN) { E.fused(acc, cur, wr, wc, fr, fq, lds, wid, lane); S.done(cur); }
#undef PG8_SA
#undef PG8_SB
#undef PG8_STAGE
#undef PG8_LDA
#undef PG8_LDB
#undef PG8_MMA
#undef PG8_WAIT_V
#undef PG8_WAIT_L
#undef PG8_BAR
#undef PG8_SCHED
}
}
namespace pg8 {
typedef unsigned u32x2v __attribute__((ext_vector_type(2)));
constexpr int E_MP = 8192;
struct EpiIn {
    static constexpr bool PERM = true, AFTER_DRAIN = false;
    unsigned char* ws; float* out; int l; float qscale;
    __device__ __forceinline__ void operator()(const f32x4 (&acc)[2][2][4][2], const Unit& u, int wr, int wc, int fr, int fq) const {
        asm volatile("" : "+v"(fr), "+v"(fq));
        const int row0 = u.pm * BM + wr * 64 + fr, colt = u.pn * BM + wc * 32 + 8 * fq;
        if (u.pn < 14) {
            float* PR = (float*)(ws + WS_PR); float* sh_p = out + O_SP + (size_t)l * 3520; float* sh_s = out + O_SS + (size_t)l * 16 * 3520;
#pragma unroll
            for (int ai = 0; ai < 2; ++ai)
#pragma unroll
                for (int m = 0; m < 4; ++m) { const int r = row0 + ai * HALF + m * 16;
#pragma unroll
                    for (int bj = 0; bj < 2; ++bj) { const int c = colt + bj * HALF; float* p = PR + (size_t)r * 3584 + c;
                        *(f32x4*)p = acc[ai][bj][m][0]; *(f32x4*)(p + 4) = acc[ai][bj][m][1];
                        if (c < 3520) {
                            if (r == E_MP - 1) { *(f32x4*)(sh_p + c) = acc[ai][bj][m][0]; *(f32x4*)(sh_p + c + 4) = acc[ai][bj][m][1]; }
                            if (r >= E_MP && (r & 15) == 15) { float* q = sh_s + (size_t)((r - E_MP) >> 4) * 3520 + c; *(f32x4*)q = acc[ai][bj][m][0]; *(f32x4*)(q + 4) = acc[ai][bj][m][1]; }
                        } } }
        } else {
            const int region = (u.pn - 14) >> 2, cl0 = colt - 3584 - region * 1024;
            static_assert(WS_KB - WS_QB == WS_VB - WS_KB && O_VP - O_KP == (size_t)2 * 8192 * 1024 && O_VS - O_KS == (size_t)2 * 256 * 1024, "equal spacing");
            bf16_t* B16 = (bf16_t*)(ws + WS_QB + (size_t)region * (WS_KB - WS_QB));
            const float sc = region == 0 ? qscale : 1.f;
            float* fp = out + O_KP + (size_t)(region == 2 ? 1 : 0) * (O_VP - O_KP) + (size_t)l * E_MP * 1024; float* fs = out + O_KS + (size_t)(region == 2 ? 1 : 0) * (O_VS - O_KS) + (size_t)l * 256 * 1024;
#pragma unroll
            for (int ai = 0; ai < 2; ++ai)
#pragma unroll
                for (int m = 0; m < 4; ++m) { const int r = row0 + ai * HALF + m * 16;
                    float* fo = (r < E_MP) ? fp + (size_t)r * 1024 : fs + (size_t)(r - E_MP) * 1024;
#pragma unroll
                    for (int bj = 0; bj < 2; ++bj) { const int c = cl0 + bj * HALF; const f32x4 v0 = acc[ai][bj][m][0] * sc, v1 = acc[ai][bj][m][1] * sc;
                        u32x4 w; w.x = cvt_pk_bf16(v0[0], v0[1]); w.y = cvt_pk_bf16(v0[2], v0[3]); w.z = cvt_pk_bf16(v1[0], v1[1]); w.w = cvt_pk_bf16(v1[2], v1[3]);
                        *(u32x4*)(B16 + (size_t)r * 1024 + c) = w;
                        if (region != 0) { __builtin_nontemporal_store(v0, (f32x4*)(fo + c)); __builtin_nontemporal_store(v1, (f32x4*)(fo + c + 4)); } } }
        }
    }
};
struct EpiRes {
    static constexpr bool PERM = true, AFTER_DRAIN = false;
    const float* src_p; const float* src_s; float* dst; const float* gate;
    __device__ __forceinline__ void operator()(const f32x4 (&acc)[2][2][4][2], const Unit& u, int wr, int wc, int fr, int fq) const {
        asm volatile("" : "+v"(fr), "+v"(fq));
        const int row0 = u.pm * BM + wr * 64 + fr, colt = u.pn * BM + wc * 32 + 8 * fq;
#pragma unroll
        for (int ai = 0; ai < 2; ++ai)
#pragma unroll
            for (int m = 0; m < 4; ++m) { const int r = row0 + ai * HALF + m * 16;
                const int bidx = r < E_MP ? 0 : 1 + ((r - E_MP) >> 4);
                const float* s = (r < E_MP ? src_p + (size_t)r * 2048 : src_s + (size_t)(r - E_MP) * 2048) + colt;
                const float* g = gate + (size_t)bidx * 12288 + colt; float* d = dst + (size_t)r * 2048 + colt;
#pragma unroll
                for (int bj = 0; bj < 2; ++bj)
#pragma unroll
                    for (int n = 0; n < 2; ++n) { const int o = bj * HALF + 4 * n; const f32x4 x = *(const f32x4*)(s + o), gt = *(const f32x4*)(g + o); *(f32x4*)(d + o) = x + gt * acc[ai][bj][m][n]; } }
    }
};
struct EpiResSlab {
    static constexpr bool PERM = true, AFTER_DRAIN = false;
    float* slab; const float* gate;
    __device__ __forceinline__ void operator()(const f32x4 (&acc)[2][2][4][2], const Unit& u, int wr, int wc, int fr, int fq) const {
        asm volatile("" : "+v"(fr), "+v"(fq));
        const int row0 = wr * 64 + fr, colt = u.pn * BM + wc * 32 + 8 * fq;
#pragma unroll
        for (int ai = 0; ai < 2; ++ai)
#pragma unroll
            for (int m = 0; m < 4; ++m) { const int r = row0 + ai * HALF + m * 16;
                const float* g = gate + (size_t)(1 + (r >> 4)) * 12288 + colt; float* d = slab + ((size_t)u.ks * 256 + r) * 2048 + colt;
#pragma unroll
                for (int bj = 0; bj < 2; ++bj)
#pragma unroll
                    for (int n = 0; n < 2; ++n) { const int o = bj * HALF + 4 * n; const f32x4 gt = *(const f32x4*)(g + o); *(f32x4*)(d + o) = gt * acc[ai][bj][m][n]; } }
    }
};
template <int CTRL> __device__ __forceinline__ float dppf(float old, float src) { return __builtin_bit_cast(float, __builtin_amdgcn_update_dpp(__builtin_bit_cast(int, old), __builtin_bit_cast(int, src), CTRL, 0xF, 0xF, false)); }
struct EpiUp {
    static constexpr bool PERM = true, AFTER_DRAIN = false;
    bf16_t* ACT; const float* cw; const float* cb; const float* sconv; float* halo; float* conv_p; float* conv_s; PG8_LAS float* hb;
    template <bool SAMP> __device__ __forceinline__ void run(const f32x4 (&acc)[2][2][4][2], const Unit& u, int wr, int wc, int fr, int fq) const {
        asm volatile("" : "+v"(fr), "+v"(fq));
        const int jl = wc * 32 + 8 * fq, j0 = u.pn * HALF + jl;
#pragma unroll
        for (int ai = 0; ai < 2; ++ai) { const int blk = 2 * ai + wr;
            if (!SAMP && fr >= 14) {
                if (blk < 3) { PG8_LAS float* h = hb + ((blk + 1) * 2 + (fr - 14)) * HALF + jl; *(PG8_LAS f32x4*)h = acc[ai][0][3][0]; *(PG8_LAS f32x4*)(h + 4) = acc[ai][0][3][1]; }
                else { float* t = halo + ((size_t)u.pm * 2 + (fr - 14)) * 5632 + j0; *(f32x4*)t = acc[ai][0][3][0]; *(f32x4*)(t + 4) = acc[ai][0][3][1];
                    if (u.pm == 31) { float* c = conv_p + (size_t)(fr - 14) * 5632 + j0; *(f32x4*)c = acc[ai][0][3][0]; *(f32x4*)(c + 4) = acc[ai][0][3][1]; } }
            }
            if (SAMP && fr >= 14) {
#pragma unroll
                for (int m = 0; m < 4; ++m) { const int sb = 8 * ai + 4 * wr + m; float* c = conv_s + ((size_t)sb * 2 + (fr - 14)) * 5632 + j0; *(f32x4*)c = acc[ai][0][m][0]; *(f32x4*)(c + 4) = acc[ai][0][m][1]; }
            }
        }
        asm volatile("s_waitcnt lgkmcnt(0)\n\ts_barrier" ::: "memory");
#pragma unroll
        for (int ai = 0; ai < 2; ++ai) { const int blk = 2 * ai + wr;
#pragma unroll
            for (int m = 0; m < 4; ++m) { const int r = u.pm * BM + ai * HALF + wr * 64 + m * 16 + fr;
                u32x4 w;
#pragma unroll
                for (int n = 0; n < 2; ++n) {
                    f32x4 pv = (f32x4){0.f, 0.f, 0.f, 0.f};
                    if (SAMP) { if (fr >= 14) { const int sb = 8 * ai + 4 * wr + m; pv = *(const f32x4*)(sconv + ((size_t)sb * 2 + (fr - 14)) * 5632 + j0 + 4 * n); } asm volatile("" : "+v"(pv)); }
                    else if (m == 0) { if (blk > 0 && fr >= 14) pv = *(const PG8_LAS f32x4*)(hb + (blk * 2 + (fr - 14)) * HALF + jl + 4 * n); asm volatile("" : "+v"(pv)); }
                    else pv = acc[ai][0][m > 0 ? m - 1 : 0][n];
                    const f32x4 w0 = *(const f32x4*)(cw + j0 + 4 * n), w1 = *(const f32x4*)(cw + 5632 + j0 + 4 * n), w2 = *(const f32x4*)(cw + 2 * 5632 + j0 + 4 * n), bb = *(const f32x4*)(cb + j0 + 4 * n);
                    f32x4 o;
#pragma unroll
                    for (int i = 0; i < 4; ++i) { const float cur = acc[ai][0][m][n][i], pr = pv[i];
                        const float t1 = dppf<0x121>(pr, pr), p1 = dppf<0x111>(t1, cur);
                        const float t2 = dppf<0x122>(pr, pr), p2 = dppf<0x112>(t2, cur);
                        o[i] = bb[i] + w0[i] * p2 + w1[i] * p1 + w2[i] * cur; }
                    const f32x2 g0 = gelu_pk((f32x2){o[0], o[1]}), g1 = gelu_pk((f32x2){o[2], o[3]});
                    const f32x4 uv = acc[ai][1][m][n];
                    const unsigned lo = cvt_pk_bf16(g0.x * uv[0], g0.y * uv[1]), hi = cvt_pk_bf16(g1.x * uv[2], g1.y * uv[3]);
                    if (n == 0) { w.x = lo; w.y = hi; } else { w.z = lo; w.w = hi; }
                }
                const bool head = (!SAMP && u.pm > 0 && blk == 0 && m == 0 && fr < 2);
                if (!head) *(u32x4*)(ACT + (size_t)r * 5632 + j0) = w;
                else { float* hg = halo + (size_t)32 * 2 * 5632 + ((size_t)u.pm * 2 + fr) * 5632 + j0; float* hv = hg + (size_t)32 * 2 * 5632;
                    *(f32x4*)hg = acc[ai][0][m][0]; *(f32x4*)(hg + 4) = acc[ai][0][m][1]; *(f32x4*)hv = acc[ai][1][m][0]; *(f32x4*)(hv + 4) = acc[ai][1][m][1]; }
                asm volatile("" ::: "memory");
            } }
    }
    __device__ __forceinline__ void operator()(const f32x4 (&acc)[2][2][4][2], const Unit& u, int wr, int wc, int fr, int fq) const {
        if (u.pm == 32) run<true>(acc, u, wr, wc, fr, fq); else run<false>(acc, u, wr, wc, fr, fq);
    }
};
}
#include <hip/hip_bf16.h>
#include <cmath>
namespace attn_body {
using bf16=__hip_bfloat16;
using bf16x8=__attribute__((ext_vector_type(8)))short;
using s16x4=__attribute__((ext_vector_type(4)))short;
using f32x16=__attribute__((ext_vector_type(16)))float;
using u32x4=__attribute__((ext_vector_type(4)))unsigned;
constexpr int BATCH=1,NHEAD=16,SEQ=8192,D=64,DM=NHEAD*D;
constexpr int NW=8,QBLK=32,QB=QBLK*NW,KVBLK=64,NQB=SEQ/QB;
constexpr int ATTN_PITCH=DM, ATTN_UNIT_ROWS=QB, OPITCH=2048;
__device__ __forceinline__ int crow(int r,int hi){return (r&3)+8*(r>>2)+4*hi;}
#define SBAR() __builtin_amdgcn_sched_barrier(0)
__device__ __forceinline__ void bmask(f32x16&p0,f32x16&p1,int t,int cq,int qabs,int hi,const __attribute__((address_space(3))) float*lut){
  if(t>cq){
    #pragma unroll
    for(int r=0;r<16;++r){p0[r]=-INFINITY;p1[r]=-INFINITY;}
  } else {
    const int d0=64*t+4*hi-qabs+128;
    #pragma unroll
    for(int r=0;r<16;++r){int i0=d0+(r&3)+8*(r>>2); int i1=i0+32; i0=i0<0?0:i0; i1=i1<0?0:i1; p0[r]+=lut[i0]; p1[r]+=lut[i1];}
  }
}

constexpr int NSLOT=3, SLOTB=8192;
constexpr int LDS_K=0, LDS_V=NSLOT*SLOTB, LDS_WS=2*NSLOT*SLOTB, LDS_OST=LDS_WS+NW*64*4, LDS_BYTES=LDS_OST+NW*4096;
constexpr float C2=0.125f*1.4426950408889634f;
__device__ __forceinline__ void glds16(const void*gsrc,unsigned lds_dst){unsigned keep;
  asm volatile("s_mov_b32 %0, m0\n\ts_mov_b32 m0, %2\n\ts_nop 0\n\tglobal_load_lds_dwordx4 %1, off\n\ts_mov_b32 m0, %0":"=&s"(keep):"v"(gsrc),"s"(lds_dst):"memory");}
__device__ __forceinline__ float max3f(float a,float b,float c){float r;asm("v_max3_f32 %0, %1, %2, %3":"=v"(r):"v"(a),"v"(b),"v"(c));return r;}
__device__ __forceinline__ float max2f(float a,float b){float r;asm("v_max_f32_e32 %0, %1, %2":"=v"(r):"v"(a),"v"(b));return r;}
__device__ __forceinline__ float fadd_s(float a,float b){float r;asm("v_add_f32_e32 %0, %1, %2":"=v"(r):"v"(a),"v"(b));return r;}
__device__ __forceinline__ float fsub_s(float a,float b){float r;asm("v_sub_f32_e32 %0, %1, %2":"=v"(r):"v"(a),"v"(b));return r;}
typedef float f32x2_t __attribute__((ext_vector_type(2))); typedef __bf16 bf16x2_t __attribute__((ext_vector_type(2)));
__device__ __forceinline__ unsigned cvtpk_s(float lo,float hi){f32x2_t v={lo,hi};bf16x2_t b=__builtin_convertvector(v,bf16x2_t);return __builtin_bit_cast(unsigned,b);}
#define WAIT_BAR(N) asm volatile("s_waitcnt vmcnt(" #N ") lgkmcnt(0)\n\ts_barrier":::"memory")

__device__ __forceinline__ void qkt(f32x16&p0,f32x16&p1,const char*Kslot,const bf16x8*qr,const f32x16&negm,int r32,int hi){
  const char*kb=Kslot+hi*1024+r32*16;
  #pragma unroll
  for(int d0=0;d0<4;++d0){
    const bf16x8 b0=*reinterpret_cast<const bf16x8*>(kb+d0*2048);
    const bf16x8 b1=*reinterpret_cast<const bf16x8*>(kb+d0*2048+512);
    if(d0==0){p0=__builtin_amdgcn_mfma_f32_32x32x16_bf16(b0,qr[0],negm,0,0,0);p1=__builtin_amdgcn_mfma_f32_32x32x16_bf16(b1,qr[0],negm,0,0,0);}
    else{p0=__builtin_amdgcn_mfma_f32_32x32x16_bf16(b0,qr[d0],p0,0,0,0);p1=__builtin_amdgcn_mfma_f32_32x32x16_bf16(b1,qr[d0],p1,0,0,0);}}
}
typedef __attribute__((address_space(3))) const char* lds_cptr;
typedef short v4i16_t __attribute__((ext_vector_type(4)));
__device__ __forceinline__ void kload8(bf16x8*kf,lds_cptr kp){
  kf[0]=*(const __attribute__((address_space(3))) bf16x8*)(kp);      kf[1]=*(const __attribute__((address_space(3))) bf16x8*)(kp+512);
  kf[2]=*(const __attribute__((address_space(3))) bf16x8*)(kp+2048); kf[3]=*(const __attribute__((address_space(3))) bf16x8*)(kp+2560);
  kf[4]=*(const __attribute__((address_space(3))) bf16x8*)(kp+4096); kf[5]=*(const __attribute__((address_space(3))) bf16x8*)(kp+4608);
  kf[6]=*(const __attribute__((address_space(3))) bf16x8*)(kp+6144); kf[7]=*(const __attribute__((address_space(3))) bf16x8*)(kp+6656);
}
__device__ __forceinline__ void kload2(bf16x8*kf,lds_cptr kp,int j){ kf[2*j]=*(const __attribute__((address_space(3))) bf16x8*)(kp+j*2048); kf[2*j+1]=*(const __attribute__((address_space(3))) bf16x8*)(kp+j*2048+512); }
__device__ __forceinline__ s16x4 vtr(lds_cptr p){ return __builtin_bit_cast(s16x4,__builtin_amdgcn_ds_read_tr16_b64_v4i16((__attribute__((address_space(3))) v4i16_t*)p)); }
__device__ __forceinline__ float rowmax(const f32x16&p0,const f32x16&p1){
  float a=max3f(p0[0],p0[1],p1[0]),b=max3f(p0[2],p0[3],p1[1]);a=max3f(a,p1[2],p1[3]);
  #pragma unroll
  for(int r=4;r<16;r+=4){a=max3f(a,p0[r],p0[r+1]);b=max3f(b,p0[r+2],p0[r+3]);a=max3f(a,p1[r],p1[r+1]);b=max3f(b,p1[r+2],p1[r+3]);}
  const float m=max2f(a,b);
  const PL32 rr=pl32(m);
  return max2f(rr.a,rr.b);
}
__device__ __forceinline__ void pv(f32x16*o,int vb,bf16x8 pa0,bf16x8 pa1,bf16x8 pa2,bf16x8 pa3){
  #pragma unroll
  for(int d0=0;d0<2;++d0){s16x4 lo[4],hi[4];
    #pragma unroll
    for(int ks=0;ks<4;++ks){
      asm volatile("ds_read_b64_tr_b16 %0,%1 offset:%c2":"=&v"(lo[ks]):"v"(vb),"i"(d0*4096+ks*1024):"memory");
      asm volatile("ds_read_b64_tr_b16 %0,%1 offset:%c2":"=&v"(hi[ks]):"v"(vb),"i"(d0*4096+ks*1024+512):"memory");}
    asm volatile("s_waitcnt lgkmcnt(0)":::"memory");SBAR();
    #define PK(k) (bf16x8){lo[k][0],lo[k][1],lo[k][2],lo[k][3],hi[k][0],hi[k][1],hi[k][2],hi[k][3]}
    o[d0]=__builtin_amdgcn_mfma_f32_32x32x16_bf16(pa0,PK(0),o[d0],0,0,0);
    o[d0]=__builtin_amdgcn_mfma_f32_32x32x16_bf16(pa1,PK(1),o[d0],0,0,0);
    o[d0]=__builtin_amdgcn_mfma_f32_32x32x16_bf16(pa2,PK(2),o[d0],0,0,0);
    o[d0]=__builtin_amdgcn_mfma_f32_32x32x16_bf16(pa3,PK(3),o[d0],0,0,0);
    #undef PK
  }
}

#ifndef ATTN_STORE16
#define ATTN_STORE16(p,v) (*(u32x4*)(p)=(v))
#endif
template<int THRL> __device__ __forceinline__ void attn_unit(int qb,int qkcol,int vcol,int ocol,int hh,const float*__restrict__ reltab,const bf16*Q,const bf16*__restrict__ K,const bf16*__restrict__ V,bf16*O,char*shm,const __attribute__((address_space(3))) float*lut){
  const int b=0;
  int tid_=threadIdx.x; asm volatile("":"+v"(tid_));
  const int tid=tid_,lane=tid&63,r32=lane&31,hi=lane>>5; const int wid=__builtin_amdgcn_readfirstlane(tid>>6);
  const long rowbase=(long)b*SEQ; const int q0=qb*QB;
  const bf16*Qw=Q+(rowbase+q0+wid*QBLK)*DM+qkcol;
  const bf16*Kh=K+rowbase*DM+qkcol,*Vh=V+rowbase*DM+vcol;
  const unsigned lds0=(unsigned)(uintptr_t)shm;
  float*wsf=(float*)(shm+LDS_WS)+wid*64;
  const bf16*ksrc=Kh+(long)lane*DM+wid*8;
  const bf16*vsrc=Vh+(long)(16*(wid&3)+(lane>>2))*DM+(wid>>2)*32+(lane&3)*8;
  const unsigned kdst=lds0+LDS_K+wid*1024, vdst=lds0+LDS_V+wid*1024;
  #define DMA_K(t,slot) glds16(ksrc+(long)(t)*KVBLK*DM,(unsigned)__builtin_amdgcn_readfirstlane(kdst+(slot)))
  #define DMA_V(t,slot) glds16(vsrc+(long)(t)*KVBLK*DM,(unsigned)__builtin_amdgcn_readfirstlane(vdst+(slot)))
  const int vb0=(int)(lds0+LDS_V)+((lane>>4)&1)*32+(lane&3)*8+(4*hi+((lane&15)>>2))*64;
  const char*Kbase=shm+LDS_K; bf16x8 kf[8];
  const lds_cptr shm3=(lds_cptr)shm; const lds_cptr kp0=shm3+LDS_K+hi*1024+r32*16; const lds_cptr vp0=shm3+LDS_V+((lane>>4)&1)*32+(lane&3)*8+(4*hi+((lane&15)>>2))*64;
  const int NT=(q0+QB)/KVBLK;
  const int cq=(q0>>6)+(wid>>1), cqm2=cq-2, qabs=q0+wid*QBLK+r32;
  DMA_K(0,0);DMA_V(0,0);DMA_K(1,SLOTB);
  bf16x8 qr[4];
  #pragma unroll
  for(int d0=0;d0<4;++d0)qr[d0]=*reinterpret_cast<const bf16x8*>(&Qw[(long)r32*DM+d0*16+hi*8]);
  float mhat=0.f,l_reg=0.f;f32x16 o[2];o[0]=f32x16{};o[1]=f32x16{};f32x16 negm=f32x16{};asm volatile("":"+v"(negm));
  const int qrel=wid*QBLK+r32;
  #define CMASK(P0,P1,t) do{ if((t)>=cqm2)bmask(P0,P1,(t),cq,qabs,hi,lut);}while(0)
  bool resc=false;
  #define START(P0,P1) do{ const float rm=rowmax(P0,P1); resc=false; \
    { const float dl=rm; mhat=fadd_s(mhat,dl); \
      _Pragma("unroll") for(int r=0;r<16;++r){P0[r]=fsub_s(P0[r],dl);P1[r]=fsub_s(P1[r],dl);} \
      _Pragma("unroll") for(int r=0;r<16;++r)negm[r]=-mhat; asm volatile("":"+v"(negm)); } \
    _Pragma("unroll") for(int r=0;r<16;++r)P0[r]=__builtin_amdgcn_exp2f(P0[r]); }while(0)
  #define RESC() do{ if(resc){ asm volatile("s_waitcnt lgkmcnt(0)":::"memory"); \
      _Pragma("unroll") for(int d_=0;d_<2;++d_) _Pragma("unroll") for(int r=0;r<16;++r)o[d_][r]*=wsf[crow(r,hi)]; } }while(0)
  f32x16 pA0,pA1,pB0,pB1;
  int sl_prev=0,sl_cur=0,sl_next=SLOTB;
  #define ROT() do{sl_prev=sl_cur;sl_cur=sl_next;sl_next=(sl_next==(NSLOT-1)*SLOTB)?0:sl_next+SLOTB;}while(0)
  DMA_K(2,2*SLOTB);
  WAIT_BAR(3);
  qkt(pA0,pA1,Kbase,qr,negm,r32,hi);asm volatile("s_nop 15\n\ts_nop 7":"+v"(pA0),"+v"(pA1));CMASK(pA0,pA1,0);
  START(pA0,pA1);
  _Pragma("unroll") for(int r=0;r<16;++r)pA1[r]=__builtin_amdgcn_exp2f(pA1[r]);
  WAIT_BAR(0);
  DMA_K(3,0);DMA_V(1,SLOTB);
  ROT();
  kload8(kf,kp0+sl_cur);
  WAIT_BAR(2);
  s16x4 vlo[8],vhi[8]; u32x4 pw0,pw1,pw2,pw3;
  #define PKW(P,B) cvtpk_s(P[B],P[B+1])
  #define PAF(k) __builtin_bit_cast(bf16x8,pw##k)
  #define VFR(i) (bf16x8){vlo[i][0],vlo[i][1],vlo[i][2],vlo[i][3],vhi[i][0],vhi[i][1],vhi[i][2],vhi[i][3]}
  #define PIN(x) asm volatile("":"+v"(x))
  #define MX3(a,b,c) __builtin_fmaxf(__builtin_fmaxf((a),(b)),(c))
  #define GAPA(MF,A0,A1,A2,A3,W0,W1,PW) do{ MF; sacc+=A0; sacc+=A1; sacc+=A2; sacc+=A3; PIN(sacc); W0; W1; PIN(PW); SBAR(); }while(0)
  #define EX(v) __builtin_amdgcn_exp2f(v)
  #define GAPB(MF,X,B) do{ MF; X[B]=EX(X[B]); X[B+1]=EX(X[B+1]); X[B+2]=EX(X[B+2]); X[B+3]=EX(X[B+3]); PIN(X); SBAR(); }while(0)
  #define VRD(i) do{ vlo[i]=vtr(vp_+(((i)>>2)*4096+((i)&3)*1024)); vhi[i]=vtr(vp_+(((i)>>2)*4096+((i)&3)*1024+512)); }while(0)
  #define KRD(G,j) do{ if(G){ kload2(kf,kp0+sl_next,j); SBAR(); } }while(0)
  #define STEP(C0,C1,P0,P1,t,GK,GV,GL) do{ SBAR(); \
    const lds_cptr vp_=vp0+sl_prev; \
    VRD(0); SBAR(); float sacc=(P0[0]+P0[1]); \
    GAPA(C0=__builtin_amdgcn_mfma_f32_32x32x16_bf16(kf[0],qr[0],negm,0,0,0), P0[2],P0[3],P0[4],P0[5],     pw0[0]=PKW(P0,0), pw0[1]=PKW(P0,2), pw0); \
    VRD(4); SBAR(); GAPA(C1=__builtin_amdgcn_mfma_f32_32x32x16_bf16(kf[1],qr[0],negm,0,0,0), P0[6],P0[7],P0[8],P0[9],     pw0[2]=PKW(P0,4), pw0[3]=PKW(P0,6), pw0); \
    VRD(1); SBAR(); GAPA(C0=__builtin_amdgcn_mfma_f32_32x32x16_bf16(kf[2],qr[1],C0,0,0,0),   P0[10],P0[11],P0[12],P0[13], pw1[0]=PKW(P0,8), pw1[1]=PKW(P0,10), pw1); \
    VRD(5); SBAR(); GAPA(C1=__builtin_amdgcn_mfma_f32_32x32x16_bf16(kf[3],qr[1],C1,0,0,0),   P0[14],P0[15],P1[0],P1[1],   pw1[2]=PKW(P0,12),pw1[3]=PKW(P0,14), pw1); \
    VRD(2); SBAR(); GAPA(C0=__builtin_amdgcn_mfma_f32_32x32x16_bf16(kf[4],qr[2],C0,0,0,0),   P1[2],P1[3],P1[4],P1[5],     pw2[0]=PKW(P1,0), pw2[1]=PKW(P1,2), pw2); \
    VRD(6); SBAR(); GAPA(C1=__builtin_amdgcn_mfma_f32_32x32x16_bf16(kf[5],qr[2],C1,0,0,0),   P1[6],P1[7],P1[8],P1[9],     pw2[2]=PKW(P1,4), pw2[3]=PKW(P1,6), pw2); \
    VRD(3); SBAR(); GAPA(C0=__builtin_amdgcn_mfma_f32_32x32x16_bf16(kf[6],qr[3],C0,0,0,0),   P1[10],P1[11],P1[12],P1[13], pw3[0]=PKW(P1,8), pw3[1]=PKW(P1,10), pw3); \
    VRD(7); SBAR(); GAPA(C1=__builtin_amdgcn_mfma_f32_32x32x16_bf16(kf[7],qr[3],C1,0,0,0),   P1[14],P1[15],0.f,0.f,       pw3[2]=PKW(P1,12),pw3[3]=PKW(P1,14), pw3); \
    l_reg+=sacc; \
    if(GK){DMA_K((t)+3,sl_cur);} if(GV){DMA_V((t)+1,sl_next);} \
    CMASK(C0,C1,t); \
    { float a=MX3(C0[0],C0[1],C1[0]),b=MX3(C0[2],C0[3],C1[1]); a=MX3(a,C1[2],C1[3]); \
      _Pragma("unroll") for(int r=4;r<16;r+=4){a=MX3(a,C0[r],C0[r+1]);b=MX3(b,C0[r+2],C0[r+3]);a=MX3(a,C1[r],C1[r+1]);b=MX3(b,C1[r+2],C1[r+3]);} \
      float rm=__builtin_fmaxf(a,b); { const PL32 rr=pl32(rm); rm=__builtin_fmaxf(rr.a,rr.b); } \
      resc=false; \
      if(__builtin_expect(__any(rm>(float)THRL),0)){ const float dl=__builtin_fmaxf(rm,0.f); mhat+=dl; \
        _Pragma("unroll") for(int r=0;r<16;++r){C0[r]-=dl;C1[r]-=dl;} \
        _Pragma("unroll") for(int r=0;r<16;++r)negm[r]=-mhat; asm volatile("":"+v"(negm)); \
        const float f=__builtin_amdgcn_exp2f(-dl); l_reg*=f; if(hi==0)wsf[r32]=f; resc=true; } } \
    SBAR(); \
    GAPB(o[0]=__builtin_amdgcn_mfma_f32_32x32x16_bf16(PAF(0),VFR(0),o[0],0,0,0), C0,0); \
    GAPB(o[1]=__builtin_amdgcn_mfma_f32_32x32x16_bf16(PAF(0),VFR(4),o[1],0,0,0), C0,4); \
    KRD(GL,0); GAPB(o[0]=__builtin_amdgcn_mfma_f32_32x32x16_bf16(PAF(1),VFR(1),o[0],0,0,0), C0,8); \
    KRD(GL,1); GAPB(o[1]=__builtin_amdgcn_mfma_f32_32x32x16_bf16(PAF(1),VFR(5),o[1],0,0,0), C0,12); \
    KRD(GL,2); GAPB(o[0]=__builtin_amdgcn_mfma_f32_32x32x16_bf16(PAF(2),VFR(2),o[0],0,0,0), C1,0); \
    KRD(GL,3); GAPB(o[1]=__builtin_amdgcn_mfma_f32_32x32x16_bf16(PAF(2),VFR(6),o[1],0,0,0), C1,4); \
    GAPB(o[0]=__builtin_amdgcn_mfma_f32_32x32x16_bf16(PAF(3),VFR(3),o[0],0,0,0), C1,8); \
    GAPB(o[1]=__builtin_amdgcn_mfma_f32_32x32x16_bf16(PAF(3),VFR(7),o[1],0,0,0), C1,12); \
    }while(0)
  int t=1;
  #undef CMASK
  #define CMASK(P0,P1,t) do{}while(0)
  for(;t+7<NT;t+=2){
    STEP(pB0,pB1,pA0,pA1,t,true,true,true);     WAIT_BAR(2); RESC(); ROT();
    STEP(pA0,pA1,pB0,pB1,t+1,true,true,true);   WAIT_BAR(2); RESC(); ROT();
  }
  #undef CMASK
  #define CMASK(P0,P1,t) do{ if((t)>=cqm2)bmask(P0,P1,(t),cq,qabs,hi,lut);}while(0)
  #define ENDW(tt) do{ if((tt)+3<NT){WAIT_BAR(2);} else if((tt)+2<NT){WAIT_BAR(1);} else {WAIT_BAR(0);} }while(0)
  for(;t+1<NT;t+=2){
    STEP(pB0,pB1,pA0,pA1,t,(t+3<NT),(t+1<NT),(t+1<NT));       ENDW(t);   RESC(); ROT();
    STEP(pA0,pA1,pB0,pB1,t+1,(t+4<NT),(t+2<NT),(t+2<NT));     ENDW(t+1); RESC(); ROT();
  }
  STEP(pB0,pB1,pA0,pA1,NT-1,false,false,false); RESC();
  { float sacc=pB0[0]+pB0[1]; _Pragma("unroll") for(int r=2;r<16;++r)sacc+=pB0[r]; _Pragma("unroll") for(int r=0;r<16;++r)sacc+=pB1[r]; l_reg+=sacc;
    pw0=(u32x4){PKW(pB0,0),PKW(pB0,2),PKW(pB0,4),PKW(pB0,6)};pw1=(u32x4){PKW(pB0,8),PKW(pB0,10),PKW(pB0,12),PKW(pB0,14)};pw2=(u32x4){PKW(pB1,0),PKW(pB1,2),PKW(pB1,4),PKW(pB1,6)};pw3=(u32x4){PKW(pB1,8),PKW(pB1,10),PKW(pB1,12),PKW(pB1,14)};
    SBAR(); pv(o,vb0+sl_cur,PAF(0),PAF(1),PAF(2),PAF(3)); }
  #undef PKW
  #undef PAF
  #undef VFR
  #undef PIN
  #undef MX3
  #undef GAPA
  #undef GAPB
  #undef EX
  #undef VRD
  #undef KRD
  #undef STEP
  #undef ENDW
  {const PL32 rr=pl32(l_reg);l_reg=rr.a+rr.b;}
  if(hi==0)wsf[32+r32]=l_reg;asm volatile("s_waitcnt lgkmcnt(0)":::"memory");
  float rli[16];
  #pragma unroll
  for(int r=0;r<16;++r)rli[r]=__builtin_amdgcn_rcpf(wsf[32+crow(r,hi)]);
  bf16*Ow=O+(rowbase+q0+wid*QBLK)*(long)OPITCH+ocol;
  { bf16*stg=(bf16*)(shm+LDS_OST)+wid*2048;
    #pragma unroll
    for(int r=0;r<16;++r){const int orow=crow(r,hi);
      #pragma unroll
      for(int d0=0;d0<2;++d0)stg[orow*64+d0*32+r32]=__float2bfloat16(o[d0][r]*rli[r]);}
    asm volatile("s_waitcnt lgkmcnt(0)":::"memory");
    #pragma unroll
    for(int i=0;i<4;++i){const int row=i*8+(lane>>3),ch=lane&7; const u32x4 v=*(const u32x4*)(stg+row*64+ch*8); ATTN_STORE16(Ow+(long)row*OPITCH+ch*8,v);} }
  asm volatile("s_waitcnt lgkmcnt(0)\n\ts_barrier":::"memory");
  #undef DMA_K
  #undef DMA_V
  #undef CMASK
  #undef START
  #undef RESC
  #undef ROT
}
typedef __attribute__((address_space(3))) const char* lds_cp;
__device__ __forceinline__ void qkt_half(f32x16&p,lds_cp Kslot,const bf16x8*qr,const f32x16&negm,int r32,int hi,int kh){
  lds_cp kb=Kslot+hi*1024+(r32+32*kh)*16;
  #pragma unroll
  for(int d0=0;d0<4;++d0){ const bf16x8 b=*(const __attribute__((address_space(3))) bf16x8*)(kb+d0*2048);
    if(d0==0)p=__builtin_amdgcn_mfma_f32_32x32x16_bf16(b,qr[0],negm,0,0,0); else p=__builtin_amdgcn_mfma_f32_32x32x16_bf16(b,qr[d0],p,0,0,0);}
}
__device__ __forceinline__ void pv_half(f32x16*o,int vb,bf16x8 pa0,bf16x8 pa1){
  #pragma unroll
  for(int d0=0;d0<2;++d0){s16x4 lo[2],hi[2];
    #pragma unroll
    for(int ks=0;ks<2;++ks){
      asm volatile("ds_read_b64_tr_b16 %0,%1 offset:%c2":"=&v"(lo[ks]):"v"(vb),"i"(d0*4096+ks*1024):"memory");
      asm volatile("ds_read_b64_tr_b16 %0,%1 offset:%c2":"=&v"(hi[ks]):"v"(vb),"i"(d0*4096+ks*1024+512):"memory");}
    asm volatile("s_waitcnt lgkmcnt(0)":::"memory");SBAR();
    #define PK(k) (bf16x8){lo[k][0],lo[k][1],lo[k][2],lo[k][3],hi[k][0],hi[k][1],hi[k][2],hi[k][3]}
    o[d0]=__builtin_amdgcn_mfma_f32_32x32x16_bf16(pa0,PK(0),o[d0],0,0,0);
    o[d0]=__builtin_amdgcn_mfma_f32_32x32x16_bf16(pa1,PK(1),o[d0],0,0,0);
    #undef PK
  }
}
constexpr int F_SLOTV=2*SLOTB, F_LDS_K=0, F_LDS_V=NSLOT*SLOTB, F_LDS_WS=F_LDS_V+NSLOT*F_SLOTV, F_LDS_OST=F_LDS_WS+NW*64*4, F_LDS_BYTES=F_LDS_OST+4*8192;
__device__ __forceinline__ void bmask1(f32x16&p,int t,int cq,int qabs,int hi,int kh,const __attribute__((address_space(3))) float*lut){
  if(t>cq){
    #pragma unroll
    for(int r=0;r<16;++r)p[r]=-INFINITY;
  } else {
    const int d0=64*t+32*kh+4*hi-qabs+128;
    #pragma unroll
    for(int r=0;r<16;++r){int i0=d0+(r&3)+8*(r>>2); i0=i0<0?0:i0; p[r]+=lut[i0];}
  }
}
template<int THRL> __device__ __forceinline__ void attn_unit_f(int qb,int qkcol,int vcol,int ocol,const bf16*Q,const bf16*__restrict__ K,const bf16*__restrict__ V,bf16*O,char*shm,const __attribute__((address_space(3))) float*lut){
  int tid_=threadIdx.x; asm volatile("":"+v"(tid_));
  const int tid=tid_,lane=tid&63,r32=lane&31,hi=lane>>5; const int wid=__builtin_amdgcn_readfirstlane(tid>>6); const int pr=wid&3,kh=wid>>2;
  const int q0=qb*128;
  const bf16*Qw=Q+(long)(q0+pr*QBLK)*DM+qkcol;
  const bf16*Kh=K+qkcol,*Vh=V+vcol;
  const unsigned lds0=(unsigned)(uintptr_t)shm;
  float*wsf=(float*)(shm+F_LDS_WS)+wid*64;
  const bf16*ksrc=Kh+(long)lane*DM+wid*8;
  const bf16*vsrc=Vh+(long)(16*(wid&3)+(lane>>2))*DM+(wid>>2)*32+(lane&3)*8;
  const unsigned kdst=lds0+F_LDS_K+wid*1024, vdst=lds0+F_LDS_V+wid*1024;
  #define DMA_K(t,slot) glds16(ksrc+(long)(t)*KVBLK*DM,(unsigned)__builtin_amdgcn_readfirstlane(kdst+(slot)))
  #define DMA_V(t,slot) do{ glds16(vsrc+(long)(t)*KVBLK*DM,(unsigned)__builtin_amdgcn_readfirstlane(vdst+2*(slot))); glds16(vsrc+(long)(t)*KVBLK*DM+64,(unsigned)__builtin_amdgcn_readfirstlane(vdst+2*(slot)+8192)); }while(0)
  const int vb0=(int)(lds0+F_LDS_V)+((lane>>4)&1)*32+(lane&3)*8+(4*hi+((lane&15)>>2))*64+kh*2048;
  bf16x8 kf[4];
  const lds_cptr shm3=(lds_cptr)shm; const lds_cptr kp0=shm3+F_LDS_K+hi*1024+r32*16+kh*512; const lds_cptr vp0=shm3+F_LDS_V+((lane>>4)&1)*32+(lane&3)*8+(4*hi+((lane&15)>>2))*64+kh*2048;
  const int NT_=(q0+128)/KVBLK; const int NT=NT_<4?4:NT_;
  const int cq=(q0>>6)+(pr>>1), cqm2=cq-2, qabs=q0+pr*QBLK+r32;
  DMA_K(0,0);DMA_V(0,0);DMA_K(1,SLOTB);
  bf16x8 qr[4];
  #pragma unroll
  for(int d0=0;d0<4;++d0)qr[d0]=*reinterpret_cast<const bf16x8*>(&Qw[(long)r32*DM+d0*16+hi*8]);
  float mhat=0.f,l_reg=0.f;f32x16 o[4];o[0]=f32x16{};o[1]=f32x16{};o[2]=f32x16{};o[3]=f32x16{};f32x16 negm=f32x16{};asm volatile("":"+v"(negm));
  #define CMASK(P,t) do{ if((t)>=cqm2)bmask1(P,(t),cq,qabs,hi,kh,lut);}while(0)
  bool resc=false;
  #define RESC() do{ if(resc){ asm volatile("s_waitcnt lgkmcnt(0)":::"memory"); \
      _Pragma("unroll") for(int d_=0;d_<4;++d_) _Pragma("unroll") for(int r=0;r<16;++r)o[d_][r]*=wsf[crow(r,hi)]; } }while(0)
  f32x16 pA,pB;
  int sl_prev=0,sl_cur=0,sl_next=SLOTB;
  #define ROT() do{sl_prev=sl_cur;sl_cur=sl_next;sl_next=(sl_next==(NSLOT-1)*SLOTB)?0:sl_next+SLOTB;}while(0)
  DMA_K(2,2*SLOTB);
  WAIT_BAR(4);
  qkt_half(pA,(lds_cp)(shm3+F_LDS_K),qr,negm,r32,hi,kh);asm volatile("s_nop 15\n\ts_nop 7":"+v"(pA));CMASK(pA,0);
  { float a=max3f(pA[0],pA[1],pA[2]),b=max3f(pA[3],pA[4],pA[5]);a=max3f(a,pA[6],pA[7]);b=max3f(b,pA[8],pA[9]);a=max3f(a,pA[10],pA[11]);b=max3f(b,pA[12],pA[13]);a=max3f(a,pA[14],pA[15]);
    const float m=max2f(a,b); const PL32 rr=pl32(m); const float dl=max2f(rr.a,rr.b); mhat=fadd_s(mhat,dl);
    _Pragma("unroll") for(int r=0;r<16;++r)pA[r]=fsub_s(pA[r],dl);
    _Pragma("unroll") for(int r=0;r<16;++r)negm[r]=-mhat; asm volatile("":"+v"(negm));
    _Pragma("unroll") for(int r=0;r<16;++r)pA[r]=__builtin_amdgcn_exp2f(pA[r]); }
  WAIT_BAR(0);
  DMA_K(3,0);DMA_V(1,SLOTB);
  ROT();
  _Pragma("unroll") for(int j=0;j<4;++j)kf[j]=*(const __attribute__((address_space(3))) bf16x8*)(kp0+sl_cur+j*2048);
  WAIT_BAR(3);
  s16x4 vlo[8],vhi[8]; u32x4 pwa,pwb;
  #define PKW(P,B) cvtpk_s(P[B],P[B+1])
  #define PAFA __builtin_bit_cast(bf16x8,pwa)
  #define PAFB __builtin_bit_cast(bf16x8,pwb)
  #define VFR(i) (bf16x8){vlo[i][0],vlo[i][1],vlo[i][2],vlo[i][3],vhi[i][0],vhi[i][1],vhi[i][2],vhi[i][3]}
  #define PIN(x) asm volatile("":"+v"(x))
  #define MX3(a,b,c) __builtin_fmaxf(__builtin_fmaxf((a),(b)),(c))
  #define GAPA(MF,A0,A1,A2,A3,W0,W1,PW) do{ MF; sacc+=A0; sacc+=A1; sacc+=A2; sacc+=A3; PIN(sacc); W0; W1; PIN(PW); SBAR(); }while(0)
  #define EX(v) __builtin_amdgcn_exp2f(v)
  #define GAPB(MF,X,B) do{ MF; X[B]=EX(X[B]); X[B+1]=EX(X[B+1]); PIN(X); SBAR(); }while(0)
  #define VRD(i) do{ vlo[i]=vtr(vp_+(((i)>>1)*4096+((i)&1)*1024)); vhi[i]=vtr(vp_+(((i)>>1)*4096+((i)&1)*1024+512)); }while(0)
  #define KRD(G,j) do{ if(G){ kf[j]=*(const __attribute__((address_space(3))) bf16x8*)(kp0+sl_next+(j)*2048); SBAR(); } }while(0)
  #define STEPF(C,P,t,GK,GV,GL) do{ SBAR(); \
    const lds_cptr vp_=vp0+2*sl_prev; \
    VRD(0); VRD(2); SBAR(); float sacc=(P[0]+P[1]); \
    GAPA(C=__builtin_amdgcn_mfma_f32_32x32x16_bf16(kf[0],qr[0],negm,0,0,0), P[2],P[3],P[4],P[5],     pwa[0]=PKW(P,0), pwa[1]=PKW(P,2), pwa); \
    VRD(4); VRD(6); SBAR(); GAPA(C=__builtin_amdgcn_mfma_f32_32x32x16_bf16(kf[1],qr[1],C,0,0,0), P[6],P[7],P[8],P[9],     pwa[2]=PKW(P,4), pwa[3]=PKW(P,6), pwa); \
    VRD(1); VRD(3); SBAR(); GAPA(C=__builtin_amdgcn_mfma_f32_32x32x16_bf16(kf[2],qr[2],C,0,0,0), P[10],P[11],P[12],P[13], pwb[0]=PKW(P,8), pwb[1]=PKW(P,10), pwb); \
    VRD(5); VRD(7); SBAR(); GAPA(C=__builtin_amdgcn_mfma_f32_32x32x16_bf16(kf[3],qr[3],C,0,0,0), P[14],P[15],0.f,0.f,     pwb[2]=PKW(P,12),pwb[3]=PKW(P,14), pwb); \
    l_reg+=sacc; \
    if(GK){DMA_K((t)+3,sl_cur);} if(GV){DMA_V((t)+1,sl_next);} \
    CMASK(C,t); \
    { float a=MX3(C[0],C[1],C[2]),b=MX3(C[3],C[4],C[5]); a=MX3(a,C[6],C[7]); b=MX3(b,C[8],C[9]); a=MX3(a,C[10],C[11]); b=MX3(b,C[12],C[13]); a=MX3(a,C[14],C[15]); \
      float rm=__builtin_fmaxf(a,b); { const PL32 rr=pl32(rm); rm=__builtin_fmaxf(rr.a,rr.b); } \
      resc=false; \
      if(__builtin_expect(__any(rm>(float)THRL),0)){ const float dl=__builtin_fmaxf(rm,0.f); mhat+=dl; \
        _Pragma("unroll") for(int r=0;r<16;++r)C[r]-=dl; \
        _Pragma("unroll") for(int r=0;r<16;++r)negm[r]=-mhat; asm volatile("":"+v"(negm)); \
        const float f=__builtin_amdgcn_exp2f(-dl); l_reg*=f; if(hi==0)wsf[r32]=f; resc=true; } } \
    SBAR(); \
    GAPB(o[0]=__builtin_amdgcn_mfma_f32_32x32x16_bf16(PAFA,VFR(0),o[0],0,0,0), C,0); \
    GAPB(o[1]=__builtin_amdgcn_mfma_f32_32x32x16_bf16(PAFA,VFR(2),o[1],0,0,0), C,2); \
    KRD(GL,0); GAPB(o[2]=__builtin_amdgcn_mfma_f32_32x32x16_bf16(PAFA,VFR(4),o[2],0,0,0), C,4); \
    KRD(GL,1); GAPB(o[3]=__builtin_amdgcn_mfma_f32_32x32x16_bf16(PAFA,VFR(6),o[3],0,0,0), C,6); \
    KRD(GL,2); GAPB(o[0]=__builtin_amdgcn_mfma_f32_32x32x16_bf16(PAFB,VFR(1),o[0],0,0,0), C,8); \
    KRD(GL,3); GAPB(o[1]=__builtin_amdgcn_mfma_f32_32x32x16_bf16(PAFB,VFR(3),o[1],0,0,0), C,10); \
    GAPB(o[2]=__builtin_amdgcn_mfma_f32_32x32x16_bf16(PAFB,VFR(5),o[2],0,0,0), C,12); \
    GAPB(o[3]=__builtin_amdgcn_mfma_f32_32x32x16_bf16(PAFB,VFR(7),o[3],0,0,0), C,14); \
    }while(0)
  int t=1;
  #undef CMASK
  #define CMASK(P,t) do{}while(0)
  for(;t+7<NT;t+=2){
    STEPF(pB,pA,t,true,true,true);     WAIT_BAR(3); RESC(); ROT();
    STEPF(pA,pB,t+1,true,true,true);   WAIT_BAR(3); RESC(); ROT();
  }
  #undef CMASK
  #define CMASK(P,t) do{ if((t)>=cqm2)bmask1(P,(t),cq,qabs,hi,kh,lut);}while(0)
  #define ENDW(tt) do{ if((tt)+3<NT){WAIT_BAR(3);} else if((tt)+2<NT){WAIT_BAR(2);} else {WAIT_BAR(0);} }while(0)
  for(;t+1<NT;t+=2){
    STEPF(pB,pA,t,(t+3<NT),(t+1<NT),(t+1<NT));       ENDW(t);   RESC(); ROT();
    STEPF(pA,pB,t+1,(t+4<NT),(t+2<NT),(t+2<NT));     ENDW(t+1); RESC(); ROT();
  }
  STEPF(pB,pA,NT-1,false,false,false); RESC();
  { float sacc=pB[0]+pB[1]; _Pragma("unroll") for(int r=2;r<16;++r)sacc+=pB[r]; l_reg+=sacc;
    pwa=(u32x4){PKW(pB,0),PKW(pB,2),PKW(pB,4),PKW(pB,6)};pwb=(u32x4){PKW(pB,8),PKW(pB,10),PKW(pB,12),PKW(pB,14)};
    SBAR();
    const int vb=vb0+2*sl_cur;
    #pragma unroll
    for(int d0=0;d0<4;++d0){s16x4 lo[2],hi_[2];
      #pragma unroll
      for(int ks=0;ks<2;++ks){
        asm volatile("ds_read_b64_tr_b16 %0,%1 offset:%c2":"=&v"(lo[ks]):"v"(vb),"i"(d0*4096+ks*1024):"memory");
        asm volatile("ds_read_b64_tr_b16 %0,%1 offset:%c2":"=&v"(hi_[ks]):"v"(vb),"i"(d0*4096+ks*1024+512):"memory");}
      asm volatile("s_waitcnt lgkmcnt(0)":::"memory");SBAR();
      #define PK(k) (bf16x8){lo[k][0],lo[k][1],lo[k][2],lo[k][3],hi_[k][0],hi_[k][1],hi_[k][2],hi_[k][3]}
      o[d0]=__builtin_amdgcn_mfma_f32_32x32x16_bf16(PAFA,PK(0),o[d0],0,0,0);
      o[d0]=__builtin_amdgcn_mfma_f32_32x32x16_bf16(PAFB,PK(1),o[d0],0,0,0);
      #undef PK
    } }
  #undef PKW
  #undef PAFA
  #undef PAFB
  #undef VFR
  #undef PIN
  #undef MX3
  #undef GAPA
  #undef GAPB
  #undef EX
  #undef VRD
  #undef KRD
  #undef STEPF
  #undef ENDW
  {const PL32 rr=pl32(l_reg);l_reg=rr.a+rr.b;}
  asm volatile("s_waitcnt lgkmcnt(0)\n\ts_barrier":::"memory");
  float*OG=(float*)shm+pr*4096;
  if(kh==1){ if(hi==0){wsf[r32]=mhat;wsf[32+r32]=l_reg;}
    #pragma unroll
    for(int d_=0;d_<4;++d_)
      #pragma unroll
      for(int r=0;r<16;++r)OG[(d_*16+r)*64+lane]=o[d_][r]; }
  asm volatile("s_waitcnt lgkmcnt(0)\n\ts_barrier":::"memory");
  if(kh==0){ const float*w1=(const float*)(shm+F_LDS_WS)+(wid+4)*64; const float m2=w1[r32],l2=w1[32+r32]; const float M=__builtin_fmaxf(mhat,m2);
    const float f1=__builtin_amdgcn_exp2f(mhat-M),f2=__builtin_amdgcn_exp2f(m2-M); const float inv=__builtin_amdgcn_rcpf(l_reg*f1+l2*f2);
    if(hi==0){wsf[r32]=f1*inv;wsf[32+r32]=f2*inv;}
    asm volatile("s_waitcnt lgkmcnt(0)":::"memory");
    bf16*stg=(bf16*)(shm+F_LDS_OST)+pr*4096;
    #pragma unroll
    for(int r=0;r<16;++r){const int orow=crow(r,hi); const float g1=wsf[orow],g2=wsf[32+orow];
      #pragma unroll
      for(int d_=0;d_<4;++d_)stg[orow*128+d_*32+r32]=__float2bfloat16(o[d_][r]*g1+OG[(d_*16+r)*64+lane]*g2);}
    asm volatile("s_waitcnt lgkmcnt(0)":::"memory");
    bf16*Ow=O+(long)(q0+pr*QBLK)*(long)OPITCH+ocol;
    #pragma unroll
    for(int i=0;i<8;++i){const int row=i*4+(lane>>4),ch=lane&15; const u32x4 v=*(const u32x4*)(stg+row*128+ch*8); ATTN_STORE16(Ow+(long)row*OPITCH+ch*8,v);} }
  asm volatile("s_waitcnt lgkmcnt(0)\n\ts_barrier":::"memory");
  #undef DMA_K
  #undef DMA_V
  #undef CMASK
  #undef RESC
  #undef ROT
}
constexpr int ATTN_LDS_BYTES=LDS_BYTES;
#undef SBAR
#undef WAIT_BAR
}
#define XB_TMO      128
#define XB_XCNT(j)  (256  + 64 * (j))
#define XB_XSUB(j)  (1280 + 64 * (j))
#define XB_XGEN(j)  (2304 + 64 * (j))
#define XB_TOP      3328
#define XB_TOPGEN   3392
#define XCD_BAR_WORDS 3456
#define XB_SPIN_CAP (1u << 18)

__device__ __forceinline__ unsigned xb_ld(unsigned* p)              { return __hip_atomic_load(p, __ATOMIC_RELAXED, __HIP_MEMORY_SCOPE_AGENT); }
__device__ __forceinline__ unsigned xb_add(unsigned* p, unsigned v) { return __hip_atomic_fetch_add(p, v, __ATOMIC_RELAXED, __HIP_MEMORY_SCOPE_AGENT); }
__device__ __forceinline__ unsigned xb_xcc_id() { return (unsigned)__builtin_amdgcn_s_getreg((3 << 11) | 20) & 0xFu; }
#define XB_SPIN(cond, bar) do { unsigned _sp = 0; while (cond) { __builtin_amdgcn_s_sleep(1); \
    if ((++_sp & 255u) == 0u) { if (xb_ld(&(bar)[XB_TMO])) break; if (_sp > XB_SPIN_CAP) { atomicAdd(&(bar)[XB_TMO], 1u); break; } } } } while (0)

struct XcdBarrier {
    unsigned* bar; unsigned x;
    volatile LAS unsigned* st;
};

__device__ __forceinline__ XcdBarrier xcd_barrier_post(unsigned* bar, volatile LAS unsigned* st) {
    XcdBarrier b; b.bar = bar; b.x = xb_xcc_id(); b.st = st;
    if (threadIdx.x == 0) (void)xb_add(&bar[XB_XCNT(b.x)], 1u);
    return b;
}
__device__ __forceinline__ void xcd_barrier_complete(unsigned* bar, unsigned x, unsigned& nloc, unsigned& nx) {
    const unsigned G = gridDim.x * gridDim.y * gridDim.z;
    unsigned sum, cnt, mine, sp = 0u;
    for (;;) {
        sum = 0u; cnt = 0u; mine = 0u;
#pragma unroll
        for (unsigned j = 0; j < 16; ++j) { const unsigned c = xb_ld(&bar[XB_XCNT(j)]); sum += c; cnt += (c > 0u) ? 1u : 0u; mine = (j == x) ? c : mine; }
        if (sum == G) break;
        __builtin_amdgcn_s_sleep(1);
        if ((++sp & 255u) == 0u) { if (xb_ld(&bar[XB_TMO])) break; if (sp > XB_SPIN_CAP) { atomicAdd(&bar[XB_TMO], 1u); break; } }
    }
    nloc = mine > 0u ? mine : 1u; nx = cnt > 0u ? cnt : 1u;
}

__device__ __forceinline__ void xcd_barrier(const XcdBarrier& b) {
    asm volatile("s_waitcnt vmcnt(0)" ::: "memory");
    __syncthreads();
    if (threadIdx.x == 0) {
        unsigned* bar = b.bar;
        __builtin_amdgcn_s_waitcnt(0);
        unsigned nloc = b.st[0], nx = b.st[1];
        if (nloc == 0u) { xcd_barrier_complete(bar, b.x, nloc, nx); b.st[0] = nloc; b.st[1] = nx; }
        const unsigned old = xb_add(&bar[XB_XSUB(b.x)], 1u);
        const unsigned gen = old / nloc;
        if (old + 1u == (gen + 1u) * nloc) {
            __builtin_amdgcn_fence(__ATOMIC_RELEASE, "agent");
            asm volatile("s_waitcnt vmcnt(0)" ::: "memory");
            const unsigned og = xb_add(&bar[XB_TOP], 1u);
            const unsigned tg = og / nx;
            if (og + 1u == (tg + 1u) * nx) xb_add(&bar[XB_TOPGEN], 1u);
            else XB_SPIN(xb_ld(&bar[XB_TOPGEN]) == tg, bar);
            __builtin_amdgcn_fence(__ATOMIC_ACQUIRE, "agent");
            xb_add(&bar[XB_XGEN(b.x)], 1u);
            asm volatile("s_waitcnt vmcnt(0)" ::: "memory");
        } else {
            XB_SPIN(xb_ld(&bar[XB_XGEN(b.x)]) == gen, bar);
            __builtin_amdgcn_fence(__ATOMIC_ACQUIRE, "agent");
            asm volatile("s_waitcnt vmcnt(0)" ::: "memory");
        }
    }
    __syncthreads();
}
struct Args { const float* in[37]; float* out; unsigned char* ws; int ph_lo, ph_hi; };
struct Frame { LAS unsigned char* lds; volatile LAS unsigned* MISC; gu32* ctl; int tid, lane, wave, G, bid; };
typedef __attribute__((address_space(4))) const Args* ArgsP;
__device__ __forceinline__ ArgsP get_args() { ArgsP p = (ArgsP)__builtin_amdgcn_kernarg_segment_ptr(); asm volatile("" : "+s"(p)); return p; }
#define PHASE_ENTRY() ArgsP A = get_args(); { int t_ = threadIdx.x; asm volatile("" : "+v"(t_)); F.tid = t_; F.lane = t_ & 63; F.wave = __builtin_amdgcn_readfirstlane(t_ >> 6); F.ctl = (gu32*)(A->ws + WS_CTL); }
enum InIdx { I_XP = 0, I_XS, I_CP, I_CS, I_CK, I_CV, I_SWKV, I_SSHIFT, I_SCONV, I_WADA, I_BADA, I_GMIX, I_GFFN, I_WIN, I_WOUT, I_MU, I_W0, I_W2, I_A0, I_A2, I_G2, I_KK, I_KA, I_RK, I_LNW, I_LNB,
             I_LQ1, I_LK1, I_LQ2, I_LK2, I_SUBLN, I_REL, I_FUP, I_CONVW, I_CONVB, I_FDN, I_GFIN };

__device__ __forceinline__ void transpose_item(const float* W, int K, int N, bf16* WT, int dest_row0, LAS float* scr, int kb, int n0, int lane) {
    const int k0 = 64 * kb;
    { f32x4 t[8];
#pragma unroll
      for (int i = 0; i < 8; ++i) t[i] = __builtin_nontemporal_load((const GAS f32x4*)(W + (size_t)(k0 + 8 * i + (lane >> 3)) * N + n0 + 4 * (lane & 7)));
#pragma unroll
      for (int i = 0; i < 8; ++i) { LAS float* d = scr + (8 * i + (lane >> 3)) * 33 + 4 * (lane & 7); d[0] = t[i][0]; d[1] = t[i][1]; d[2] = t[i][2]; d[3] = t[i][3]; } }
    LDS_WAIT(); asm volatile("" ::: "memory");
    const int c = lane & 7;
#pragma unroll
    for (int j = 0; j < 4; ++j) { const int n = (lane >> 3) + 8 * j; const LAS float* s = scr + (8 * c) * 33 + n;
        v4u o; o.x = pk2(s[0 * 33], s[1 * 33]); o.y = pk2(s[2 * 33], s[3 * 33]); o.z = pk2(s[4 * 33], s[5 * 33]); o.w = pk2(s[6 * 33], s[7 * 33]);
        *(GAS v4u*)(WT + (size_t)(dest_row0 + n) * K + k0 + 8 * c) = o; }
    LDS_WAIT(); asm volatile("" ::: "memory");
}
__device__ __forceinline__ void ph_prologue(Frame& F) {
    PHASE_ENTRY();
    unsigned char* ws = A->ws;
    if (F.bid < 192) {
        const int l = F.bid / 96, j0 = (F.bid % 96) * 128;
        LAS float* ST = (LAS float*)F.lds;
        const float* Wl = A->in[I_WADA] + (size_t)l * DMOD * MODW;
        float acc[NMODB][2];
#pragma unroll
        for (int b = 0; b < NMODB; ++b) { acc[b][0] = 0.f; acc[b][1] = 0.f; }
        for (int kh = 0; kh < 2; ++kh) {
            __syncthreads();
            for (int idx = F.tid; idx < 1024 * NMODB; idx += NWAVES * 64) { const int kk = idx / NMODB, b = idx % NMODB;
                const float c = (b == 0) ? A->in[I_CP][kh * 1024 + kk] : A->in[I_CS][(size_t)(b - 1) * DMOD + kh * 1024 + kk];
                ST[kk * 20 + b] = c / (1.f + __expf(-c)); }
            __syncthreads();
#pragma unroll 4
            for (int k = 0; k < 128; ++k) { const int kk = F.wave * 128 + k;
                const f32x2 w = __builtin_nontemporal_load((const GAS f32x2*)(Wl + (size_t)(kh * 1024 + kk) * MODW + j0 + 2 * F.lane));
                const LAS f32x4* sp = (const LAS f32x4*)(ST + kk * 20);
                const f32x4 s0 = sp[0], s1 = sp[1], s2 = sp[2], s3 = sp[3]; const float s16 = ST[kk * 20 + 16];
#pragma unroll
                for (int b = 0; b < 4; ++b) { acc[b][0] += s0[b] * w.x; acc[b][1] += s0[b] * w.y; acc[4 + b][0] += s1[b] * w.x; acc[4 + b][1] += s1[b] * w.y;
                    acc[8 + b][0] += s2[b] * w.x; acc[8 + b][1] += s2[b] * w.y; acc[12 + b][0] += s3[b] * w.x; acc[12 + b][1] += s3[b] * w.y; }
                acc[16][0] += s16 * w.x; acc[16][1] += s16 * w.y; }
        }
        __syncthreads();
        LAS float* RED = (LAS float*)F.lds;
#pragma unroll
        for (int b = 0; b < NMODB; ++b) { RED[(F.wave * NMODB + b) * 128 + 2 * F.lane] = acc[b][0]; RED[(F.wave * NMODB + b) * 128 + 2 * F.lane + 1] = acc[b][1]; }
        __syncthreads();
        float* MOD = (float*)(ws + WS_MOD);
        for (int idx = F.tid; idx < NMODB * 128; idx += NWAVES * 64) { const int b = idx >> 7, j = idx & 127; float s = 0.f;
#pragma unroll
            for (int w = 0; w < 8; ++w) s += RED[(w * NMODB + b) * 128 + j];
            MOD[(size_t)(l * NMODB + b) * MODW + j0 + j] = s + A->in[I_BADA][(size_t)l * MODW + j0 + j]; }
        __syncthreads();
    }
    { const int gt = F.bid * (NWAVES * 64) + F.tid, ngt = F.G * NWAVES * 64;
      for (int idx = gt; idx < NLAYER * 56 * 1024; idx += ngt) { const int l = idx / (56 * 1024), rem = idx % (56 * 1024), ch = rem >> 10, j = rem & 1023;
          const float* src; bf16* dst; int k0;
          bf16* LB = (bf16*)(ws + WS_LORA + (size_t)l * LORA_LAYER);
          if (ch < 12) { k0 = 8 * ch; src = A->in[I_W2] + ((size_t)l * 96 + k0) * 1024 + j; dst = LB + (size_t)j * 96 + k0; }
          else if (ch < 24) { k0 = 8 * (ch - 12); src = A->in[I_A2] + ((size_t)l * 96 + k0) * 1024 + j; dst = LB + (size_t)1024 * 96 + (size_t)j * 96 + k0; }
          else { k0 = 8 * (ch - 24); src = A->in[I_G2] + ((size_t)l * 256 + k0) * 1024 + j; dst = LB + (size_t)2 * 1024 * 96 + (size_t)j * 256 + k0; }
          v4u o; o.x = pk2(src[0], src[1024]); o.y = pk2(src[2048], src[3072]); o.z = pk2(src[4096], src[5120]); o.w = pk2(src[6144], src[7168]);
          *(GAS v4u*)dst = o; }
      for (int idx = gt; idx < NLAYER * 64 * DMOD / 8; idx += ngt) { const int l = idx / (64 * DMOD / 8), rem = idx % (64 * DMOD / 8);
          *(GAS v4u*)((bf16*)(ws + WS_WIN) + (size_t)l * NIN_PAD * DMOD + (size_t)NRC * DMOD + (size_t)rem * 8) = (v4u){0u, 0u, 0u, 0u}; }
    }
    __syncthreads();
    LAS float* scr = (LAS float*)(F.lds + F.wave * 16384);
    const int gw = F.bid * NWAVES + F.wave, NGW = F.G * NWAVES;
    constexpr int IT_IN = 32 * (NIN / 32), IT_OUT = 32 * 64, IT_UP = 32 * (NUP / 32), IT_DN = (DFF / 64) * 64, IT_L = IT_IN + IT_OUT + IT_UP + IT_DN;
    for (int it = gw; it < NLAYER * IT_L; it += NGW) {
        const int l = it / IT_L; int r = it % IT_L;
        if (r < IT_IN) { const int nb = r % (NIN / 32), kb = r / (NIN / 32), n0 = 32 * nb;
            transpose_item(A->in[I_WIN] + (size_t)l * DMOD * NIN, DMOD, NIN, (bf16*)(ws + WS_WIN) + (size_t)l * NIN_PAD * DMOD, n0 < NRC ? n0 : n0 + 64, scr, kb, n0, F.lane); continue; }
        r -= IT_IN;
        if (r < IT_OUT) { const int nb = r % 64, kb = r / 64;
            transpose_item(A->in[I_WOUT] + (size_t)l * DMOD * DMOD, DMOD, DMOD, (bf16*)(ws + WS_WOUT) + (size_t)l * DMOD * DMOD, 32 * nb, scr, kb, 32 * nb, F.lane); continue; }
        r -= IT_OUT;
        if (r < IT_UP) { const int nb = r % (NUP / 32), kb = r / (NUP / 32), n0 = 32 * nb; const int j = n0 < DFF ? n0 : n0 - DFF;
            const int dr = (j >> 7) * 256 + (n0 < DFF ? 0 : 128) + (j & 127);
            transpose_item(A->in[I_FUP] + (size_t)l * DMOD * NUP, DMOD, NUP, (bf16*)(ws + WS_WUP) + (size_t)l * NUP * DMOD, dr, scr, kb, n0, F.lane); continue; }
        r -= IT_UP;
        { const int nb = r % 64, kb = r / 64;
            transpose_item(A->in[I_FDN] + (size_t)l * DFF * DMOD, DFF, DMOD, (bf16*)(ws + WS_WDN) + (size_t)l * DMOD * DFF, 32 * nb, scr, kb, 32 * nb, F.lane); }
    }
}

__device__ __forceinline__ void ph_norm(Frame& F, int l, int mode, int nslab) {
    PHASE_ENTRY();
    const int gw = F.bid * NWAVES + F.wave, NGW = F.G * NWAVES;
    const float* X = (const float*)(A->ws + WS_X); bf16* H = (bf16*)(A->ws + WS_H);
    const float* g = (mode == 0 ? A->in[I_GMIX] + (size_t)l * DMOD : mode == 1 ? A->in[I_GFFN] + (size_t)l * DMOD : A->in[I_GFIN]);
    f32x4 gv[8];
#pragma unroll
    for (int j = 0; j < 8; ++j) gv[j] = *(const GAS f32x4*)(g + 4 * F.lane + 256 * j);
    for (int m = gw; m < MT; m += NGW) {
        const float* xr = (mode == 0 && l == 0) ? (m < MP ? A->in[I_XP] + (size_t)m * DMOD : A->in[I_XS] + (size_t)(m - MP) * DMOD) : X + (size_t)m * DMOD;
        f32x4 v[8]; float ss = 0.f;
#pragma unroll
        for (int j = 0; j < 8; ++j) v[j] = *(const GAS f32x4*)(xr + 4 * F.lane + 256 * j);
        if (m >= MP && nslab > 0) { const float* sl = (const float*)(A->ws + WS_SLAB) + (size_t)(m - MP) * DMOD;
            for (int s = 0; s < nslab; ++s)
#pragma unroll
                for (int j = 0; j < 8; ++j) v[j] += *(const GAS f32x4*)(sl + (size_t)s * 256 * DMOD + 4 * F.lane + 256 * j);
            if (mode < 2) { float* xw = (float*)(A->ws + WS_X) + (size_t)m * DMOD;
#pragma unroll
                for (int j = 0; j < 8; ++j) *(GAS f32x4*)(xw + 4 * F.lane + 256 * j) = v[j]; } }
#pragma unroll
        for (int j = 0; j < 8; ++j) ss += (v[j].x * v[j].x + v[j].y * v[j].y) + (v[j].z * v[j].z + v[j].w * v[j].w);
        const float rstd = 1.f / sqrtf(wave_sum(ss) * (1.f / DMOD) + 1e-6f);
        if (mode < 2) {
            const int bidx = m < MP ? 0 : 1 + ((m - MP) >> 4);
            const float* mod = (const float*)(A->ws + WS_MOD) + (size_t)(l * NMODB + bidx) * MODW + (mode == 0 ? 0 : 3 * DMOD);
            GAS unsigned long long* o8 = (GAS unsigned long long*)(H + (size_t)m * DMOD) + F.lane;
#pragma unroll
            for (int j = 0; j < 8; ++j) { const f32x4 sh = *(const GAS f32x4*)(mod + 4 * F.lane + 256 * j), sc = *(const GAS f32x4*)(mod + DMOD + 4 * F.lane + 256 * j);
                const f32x4 y = (v[j] * rstd * gv[j]) * (sc + 1.0f) + sh;
                o8[64 * j] = (unsigned long long)pk2(y.x, y.y) | ((unsigned long long)pk2(y.z, y.w) << 32); }
        } else {
            float* o = (m < MP) ? A->out + O_YP + (size_t)m * DMOD : A->out + O_YS + (size_t)(m - MP) * DMOD;
#pragma unroll
            for (int j = 0; j < 8; ++j) __builtin_nontemporal_store(v[j] * rstd * gv[j], (GAS f32x4*)(o + 4 * F.lane + 256 * j));
        }
    }
}
typedef float f32x4m __attribute__((ext_vector_type(4)));
__device__ __forceinline__ void mm_tiles(f32x4 (&acc)[2], const LAS unsigned char* X, const LAS unsigned char* Y, int wave, int lane) {
    const int mt = wave >> 1, nt0 = 2 * (wave & 1), c = lane & 15, q = lane >> 4;
    const LAS unsigned char* xp = X + (16 * mt + c) * 144 + q * 16;
    const bf16x8 x0 = *(const LAS bf16x8*)xp, x1 = *(const LAS bf16x8*)(xp + 64);
#pragma unroll
    for (int t = 0; t < 2; ++t) { const LAS unsigned char* yp = Y + (16 * (nt0 + t) + c) * 144 + q * 16;
        const bf16x8 y0 = *(const LAS bf16x8*)yp, y1 = *(const LAS bf16x8*)(yp + 64);
        acc[t] = __builtin_amdgcn_mfma_f32_16x16x32_bf16(y0, x0, acc[t], 0, 0, 0);
        acc[t] = __builtin_amdgcn_mfma_f32_16x16x32_bf16(y1, x1, acc[t], 0, 0, 0); }
}
__device__ __forceinline__ void st_tiles(LAS unsigned char* D, const f32x4 (&acc)[2], int wave, int lane) {
    const int mt = wave >> 1, nt0 = 2 * (wave & 1), c = lane & 15, q = lane >> 4;
#pragma unroll
    for (int t = 0; t < 2; ++t) { v2u w; w.x = pk2(acc[t][0], acc[t][1]); w.y = pk2(acc[t][2], acc[t][3]); *(LAS v2u*)(D + (16 * mt + c) * 144 + (16 * (nt0 + t) + 4 * q) * 2) = w; }
}
#define RW_ZERO(a) do { a[0] = (f32x4){0.f, 0.f, 0.f, 0.f}; a[1] = a[0]; } while (0)
template <int MODE> __device__ __forceinline__ void mask_tiles(f32x4 (&acc)[2], int wave, int lane) {
    const int m = 16 * (wave >> 1) + (lane & 15), nb = 32 * (wave & 1) + 4 * (lane >> 4);
#pragma unroll
    for (int t = 0; t < 2; ++t)
#pragma unroll
        for (int i = 0; i < 4; ++i) { const int n = nb + 16 * t + i; const bool keep = MODE == 0 ? (n < m) : MODE == 1 ? (n > m) : (n <= m); if (!keep) acc[t][i] = 0.f; }
}

__device__ __forceinline__ void rwkv_passA_unit(ArgsP A, Frame& F, int l, int u, bool reuse) {
    unsigned char* ws = A->ws;
    const int tid = F.tid, lane = F.lane, wave = F.wave;
    const float* PR = (const float*)(ws + WS_PR);
    int h, row0, nvalid; const float* prev0;
    if (u < 2048) { h = u >> 7; const int c = u & 127; row0 = 64 * c; nvalid = 64; prev0 = c > 0 ? PR + (size_t)(row0 - 1) * NRC_PAD : nullptr; }
    else { const int su = u - 2048, sb = su >> 4; h = su & 15; row0 = MP + sb * TS; nvalid = TS; prev0 = A->in[I_SSHIFT] + (size_t)(l * NSB + sb) * NRC; }
    const float* mu = A->in[I_MU] + (size_t)l * NRC;
    LAS unsigned char* L = F.lds;
#define SL(i) (L + (i) * RW_SLOT)
    LAS unsigned short* TW = (LAS unsigned short*)(L), *XA = (LAS unsigned short*)(L + 13312), *SG = (LAS unsigned short*)(L + 26624);
    LAS float* WLf = (LAS float*)(L + 64512), *ALf = (LAS float*)(L + 81920), *GLf = (LAS float*)(L + 99328);
    LAS float* AT32 = (LAS float*)(L + 92160), *A32 = (LAS float*)(L + 109568), *AKV32 = (LAS float*)(L);
    LAS unsigned char* sAAK = L + 126976, *sARB = L + 136192, *sARK = L + 145408;
    LAS float* SEG = (LAS float*)(L + 154624), *WLV = SEG + 512;
    bf16x8 yg_[8][2];
    { const int nt0 = 2 * (wave & 1), c = lane & 15, q = lane >> 4; const bf16* LB = (const bf16*)(ws + WS_LORA + (size_t)l * LORA_LAYER);
#pragma unroll
      for (int t = 0; t < 2; ++t) { const int j = h * 64 + 16 * (nt0 + t) + c;
#pragma unroll
          for (int s = 0; s < 8; ++s) yg_[s][t] = *(const GAS bf16x8*)(LB + (size_t)2 * 1024 * 96 + (size_t)j * 256 + 8 * q + 32 * s); } }
    { unsigned char* lscr = ws + WS_LSCR + (size_t)F.bid * 61440;
      if (reuse) { v4u tmp[8];
#pragma unroll
          for (int b = 0; b < 8; ++b) { const int i = tid + b * (NWAVES * 64); if (i < 60416 / 16) tmp[b] = *(const GAS v4u*)(lscr + i * 16); }
#pragma unroll
          for (int b = 0; b < 8; ++b) { const int i = tid + b * (NWAVES * 64); if (i < 60416 / 16) *(LAS v4u*)(L + i * 16) = tmp[b]; } }
      else {
        for (int it = 0; it < 56; it += 8) { float cur[8], prv[8], mm_[8];
#pragma unroll
            for (int b = 0; b < 8; ++b) { const int idx = tid + (it + b) * (NWAVES * 64), t = idx / 448, col = 3072 + idx % 448; cur[b] = 0.f; prv[b] = 0.f; mm_[b] = mu[col];
                if (t < nvalid) { cur[b] = PR[(size_t)(row0 + t) * NRC_PAD + col]; prv[b] = t > 0 ? PR[(size_t)(row0 + t - 1) * NRC_PAD + col] : (prev0 ? prev0[col] : 0.f); } }
#pragma unroll
            for (int b = 0; b < 8; ++b) { const int idx = tid + (it + b) * (NWAVES * 64), t = idx / 448, cc = idx % 448; const float xm = cur[b] + (prv[b] - cur[b]) * mm_[b];
                if (cc < 96) { const float e = __expf(2.f * xm); TW[t * 104 + cc] = (unsigned short)f2bf(1.f - 2.f * __builtin_amdgcn_rcpf(e + 1.f)); }
                else if (cc < 192) XA[t * 104 + cc - 96] = (unsigned short)f2bf(xm);
                else SG[t * 264 + cc - 192] = (unsigned short)f2bf(sigmoidf_(xm)); } }
        if (u < 2048) { __syncthreads(); for (int i = tid; i < 60416 / 16; i += NWAVES * 64) *(GAS v4u*)(lscr + i * 16) = *(const LAS v4u*)(L + i * 16); }
      } }
    __syncthreads();
    { const int mt = wave >> 1, nt0 = 2 * (wave & 1), c = lane & 15, q = lane >> 4;
      const bf16* LB = (const bf16*)(ws + WS_LORA + (size_t)l * LORA_LAYER);
      f32x4 aw[2], aa[2], ag[2]; RW_ZERO(aw); RW_ZERO(aa); RW_ZERO(ag);
#pragma unroll
      for (int s = 0; s < 3; ++s) { const bf16x8 xw = *(const LAS bf16x8*)((LAS unsigned char*)TW + (16 * mt + c) * 208 + (8 * q + 32 * s) * 2), xa = *(const LAS bf16x8*)((LAS unsigned char*)XA + (16 * mt + c) * 208 + (8 * q + 32 * s) * 2);
#pragma unroll
          for (int t = 0; t < 2; ++t) { const int j = h * 64 + 16 * (nt0 + t) + c;
              const bf16x8 yw = *(const GAS bf16x8*)(LB + (size_t)j * 96 + 8 * q + 32 * s), ya = *(const GAS bf16x8*)(LB + (size_t)1024 * 96 + (size_t)j * 96 + 8 * q + 32 * s);
              aw[t] = __builtin_amdgcn_mfma_f32_16x16x32_bf16(yw, xw, aw[t], 0, 0, 0); aa[t] = __builtin_amdgcn_mfma_f32_16x16x32_bf16(ya, xa, aa[t], 0, 0, 0); } }
#pragma unroll
      for (int s = 0; s < 8; ++s) { const bf16x8 xg = *(const LAS bf16x8*)((LAS unsigned char*)SG + (16 * mt + c) * 528 + (8 * q + 32 * s) * 2);
#pragma unroll
          for (int t = 0; t < 2; ++t) { const int j = h * 64 + 16 * (nt0 + t) + c; const bf16x8 yg = yg_[s][t];
              ag[t] = __builtin_amdgcn_mfma_f32_16x16x32_bf16(yg, xg, ag[t], 0, 0, 0); } }
#pragma unroll
      for (int t = 0; t < 2; ++t) { const int o = (16 * mt + c) * 68 + 16 * (nt0 + t) + 4 * q; *(LAS f32x4*)(WLf + o) = aw[t]; *(LAS f32x4*)(ALf + o) = aa[t]; *(LAS f32x4*)(GLf + o) = ag[t]; }
    }
    __syncthreads();
    {
        const int j = lane, hj = h * 64 + j, seg = wave;
        const float mu_r = mu[hj], mu_k = mu[1024 + hj], mu_v = mu[2048 + hj];
        const float w0 = A->in[I_W0][l * 1024 + hj], a0 = A->in[I_A0][l * 1024 + hj], kkw = A->in[I_KK][l * 1024 + hj], kaw = A->in[I_KA][l * 1024 + hj], rkw = A->in[I_RK][l * 1024 + hj];
        const float lnw = A->in[I_LNW][l * 1024 + hj], lnb = A->in[I_LNB][l * 1024 + hj];
        float logw[8], xr[8], xv[8], kk[8], bb[8], km[8], cs[8];
        float* G1 = (float*)(ws + WS_G1); float* G2 = (float*)(ws + WS_G2);
        float run = 0.f;
#pragma unroll
        for (int i = 0; i < 8; ++i) { const int t = 8 * seg + i; const bool valid = t < nvalid;
            float r_ = 0.f, k_ = 0.f, v_ = 0.f;
            if (valid) { const float* pc = PR + (size_t)(row0 + t) * NRC_PAD; const float* pp = t > 0 ? pc - NRC_PAD : prev0;
                const float cr = pc[hj], ck = pc[1024 + hj], cv = pc[2048 + hj];
                const float qr = pp ? pp[hj] : 0.f, qk = pp ? pp[1024 + hj] : 0.f, qv = pp ? pp[2048 + hj] : 0.f;
                r_ = cr + (qr - cr) * mu_r; k_ = ck + (qk - ck) * mu_k; v_ = cv + (qv - cv) * mu_v; }
            const float wl = WLf[t * 68 + j], al = ALf[t * 68 + j], gl = GLf[t * 68 + j];
            const float lw = valid ? -0.6065306597126334f * sigmoidf_(w0 + wl) : 0.f;
            const float a_ = sigmoidf_(a0 + al);
            const float kkr = k_ * kkw; const float nrm = wave_sum(kkr * kkr); const float kk_ = kkr * __builtin_amdgcn_rsqf(fmaxf(nrm, 1e-24f));
            const float km_ = k_ * (1.f + (a_ - 1.f) * kaw);
            const float ct = wave_sum(r_ * km_ * rkw);
            if (valid) { const size_t go = (size_t)(row0 + t) * 1024 + hj; G1[go] = lnw * gl; G2[go] = (lnb + ct * v_) * gl; }
            run += lw; logw[i] = lw; cs[i] = run; xr[i] = r_; xv[i] = v_; kk[i] = kk_; bb[i] = kk_ * a_; km[i] = km_; }
        SEG[seg * 64 + j] = run;
        __syncthreads();
        float off = 0.f, tot = 0.f;
#pragma unroll
        for (int s = 0; s < 8; ++s) { const float v = SEG[s * 64 + j]; tot += v; if (s < seg) off += v; }
        if (seg == 0) WLV[j] = __expf(tot);
        LAS unsigned short* AT = (LAS unsigned short*)SL(0), *ATL = (LAS unsigned short*)SL(1), *BH = (LAS unsigned short*)SL(2), *BHL = (LAS unsigned short*)SL(3), *KH = (LAS unsigned short*)SL(4), *RT = (LAS unsigned short*)SL(5);
        unsigned pvt[4], pbt[4], pbl[4], pkt[4];
#pragma unroll
        for (int i = 0; i < 8; i += 2) { float v2[2], bt2[2], bl2[2], kt2[2];
#pragma unroll
            for (int e = 0; e < 2; ++e) { const int ii = i + e, t = 8 * seg + ii; const float ci = off + cs[ii], ce = ci - logw[ii];
                const float winc = __expf(ci), wexc = __expf(ce), winv = __expf(-ci), wrem = __expf(tot - ci);
                const float at = -kk[ii] * wexc, rt = xr[ii] * winc, bh = bb[ii] * winv, kh = km[ii] * winv, bt = bb[ii] * wrem, kt = km[ii] * wrem;
                const unsigned ath = f2bf(at), bhh = f2bf(bh), bth = f2bf(bt);
                AT[t * RW_STRIDE + j] = (unsigned short)ath; ATL[t * RW_STRIDE + j] = (unsigned short)f2bf(at - bf2f((unsigned short)ath)); AT32[t * 68 + j] = at;
                BH[t * RW_STRIDE + j] = (unsigned short)bhh; BHL[t * RW_STRIDE + j] = (unsigned short)f2bf(bh - bf2f((unsigned short)bhh));
                KH[t * RW_STRIDE + j] = (unsigned short)f2bf(kh); RT[t * RW_STRIDE + j] = (unsigned short)f2bf(rt);
                v2[e] = xv[ii]; bt2[e] = bf2f((unsigned short)bth); bl2[e] = bt - bf2f((unsigned short)bth); kt2[e] = kt; }
            pvt[i >> 1] = pk2(v2[0], v2[1]); pbt[i >> 1] = pk2(bt2[0], bt2[1]); pbl[i >> 1] = pk2(bl2[0], bl2[1]); pkt[i >> 1] = pk2(kt2[0], kt2[1]); }
        *(LAS v4u*)(SL(6) + j * 144 + seg * 16) = (v4u){pvt[0], pvt[1], pvt[2], pvt[3]};
        *(LAS v4u*)(SL(7) + j * 144 + seg * 16) = (v4u){pbt[0], pbt[1], pbt[2], pbt[3]};
        *(LAS v4u*)(SL(8) + j * 144 + seg * 16) = (v4u){pbl[0], pbl[1], pbl[2], pbl[3]};
        *(LAS v4u*)(SL(9) + j * 144 + seg * 16) = (v4u){pkt[0], pkt[1], pkt[2], pkt[3]};
    }
    __syncthreads();
    { f32x4 a[2]; const int mt = wave >> 1, nt0 = 2 * (wave & 1), c = lane & 15, q = lane >> 4, m = 16 * mt + c;
      RW_ZERO(a); mm_tiles(a, SL(0), SL(2), wave, lane); mm_tiles(a, SL(1), SL(2), wave, lane); mm_tiles(a, SL(0), SL(3), wave, lane); mask_tiles<0>(a, wave, lane);
#pragma unroll
      for (int t = 0; t < 2; ++t) *(LAS f32x4*)(A32 + m * 68 + 16 * (nt0 + t) + 4 * q) = a[t];
      RW_ZERO(a); mm_tiles(a, SL(0), SL(4), wave, lane); mask_tiles<0>(a, wave, lane); st_tiles(sAAK, a, wave, lane);
      RW_ZERO(a); mm_tiles(a, SL(5), SL(2), wave, lane); mask_tiles<2>(a, wave, lane); st_tiles(sARB, a, wave, lane);
      RW_ZERO(a); mm_tiles(a, SL(5), SL(4), wave, lane); mask_tiles<2>(a, wave, lane); st_tiles(sARK, a, wave, lane); }
    __syncthreads();
    { f32x4 a[2]; const int mt = wave >> 1, nt0 = 2 * (wave & 1), c = lane & 15, q = lane >> 4, m = 16 * mt + c;
      RW_ZERO(a); mm_tiles(a, sAAK, SL(6), wave, lane);
#pragma unroll
      for (int t = 0; t < 2; ++t) *(LAS f32x4*)(AKV32 + m * 68 + 16 * (nt0 + t) + 4 * q) = a[t]; }
    __syncthreads();
    { const int c = lane & 15, q = lane >> 4;
      LAS float* R = (wave < 4) ? AT32 + 16 * wave : AKV32 + 16 * (wave - 4);
      LAS float* Rc = (wave == 0 ? AT32 : AKV32) + lane;
#pragma unroll
      for (int i = 0; i < 4; ++i) {
          if (i > 0) {
              f32x4 acc;
#pragma unroll
              for (int g = 0; g < 4; ++g) acc[g] = R[(16 * i + 4 * q + g) * 68 + c];
#pragma unroll
              for (int j = 0; j < i; ++j)
#pragma unroll
                  for (int s = 0; s < 4; ++s) { const float a = A32[(16 * i + c) * 68 + 16 * j + 4 * s + q], b = R[(16 * j + 4 * s + q) * 68 + c];
                      acc = __builtin_amdgcn_mfma_f32_16x16x4f32(a, b, acc, 0, 0, 0); }
#pragma unroll
              for (int g = 0; g < 4; ++g) R[(16 * i + 4 * q + g) * 68 + c] = acc[g];
              __syncthreads();
          }
          if (wave < 2) {
              const LAS float* a32 = A32 + (16 * i) * 68 + 16 * i; asm volatile("" : "+v"(a32));
              float x[16];
#pragma unroll
              for (int rr = 0; rr < 16; ++rr) x[rr] = Rc[(16 * i + rr) * 68];
#pragma unroll
              for (int rg = 0; rg < 4; ++rg) {
                  f32x4 cf[4][4];
#pragma unroll
                  for (int r4 = 0; r4 < 4; ++r4)
#pragma unroll
                      for (int g = 0; g <= rg; ++g) if (4 * g < 4 * rg + r4) cf[r4][g] = *(const LAS f32x4*)(a32 + (4 * rg + r4) * 68 + 4 * g);
#pragma unroll
                  for (int r4 = 0; r4 < 4; ++r4) { const int rr = 4 * rg + r4; if (rr == 0) continue; float s0 = x[rr], s1 = 0.f;
#pragma unroll
                      for (int g = 0; g <= rg; ++g) if (4 * g < rr) { s0 += cf[r4][g][0] * x[4 * g]; if (4 * g + 1 < rr) s1 += cf[r4][g][1] * x[4 * g + 1]; if (4 * g + 2 < rr) s0 += cf[r4][g][2] * x[4 * g + 2]; if (4 * g + 3 < rr) s1 += cf[r4][g][3] * x[4 * g + 3]; }
                      x[rr] = s0 + s1; }
                  asm volatile("" ::: "memory");
              }
#pragma unroll
              for (int rr = 1; rr < 16; ++rr) Rc[(16 * i + rr) * 68] = x[rr];
          }
          __syncthreads();
      }
      { const int cc = tid & 127, g16 = tid >> 7; const LAS float* src = (cc < 64 ? AT32 + cc : AKV32 + (cc - 64)) + (16 * g16) * 68;
        unsigned hh[16]; float lo[16];
#pragma unroll
        for (int rr = 0; rr < 16; ++rr) { const float v = src[rr * 68]; hh[rr] = f2bf(v); lo[rr] = v - bf2f((unsigned short)hh[rr]); }
        LAS unsigned char* dh = (cc < 64 ? SL(2) + cc * 144 : SL(4) + (cc - 64) * 144) + g16 * 32;
        *(LAS v4u*)dh = (v4u){hh[0] | (hh[1] << 16), hh[2] | (hh[3] << 16), hh[4] | (hh[5] << 16), hh[6] | (hh[7] << 16)};
        *(LAS v4u*)(dh + 16) = (v4u){hh[8] | (hh[9] << 16), hh[10] | (hh[11] << 16), hh[12] | (hh[13] << 16), hh[14] | (hh[15] << 16)};
        if (cc < 64) { LAS unsigned char* dl = SL(3) + cc * 144 + g16 * 32;
            *(LAS v4u*)dl = (v4u){pk2(lo[0], lo[1]), pk2(lo[2], lo[3]), pk2(lo[4], lo[5]), pk2(lo[6], lo[7])};
            *(LAS v4u*)(dl + 16) = (v4u){pk2(lo[8], lo[9]), pk2(lo[10], lo[11]), pk2(lo[12], lo[13]), pk2(lo[14], lo[15])}; } }
    }
    __syncthreads();
    { const int mt = wave >> 1, nt0 = 2 * (wave & 1), c = lane & 15, q = lane >> 4, m = 16 * mt + c;
      float* PTg = (float*)(ws + WS_PT32) + (size_t)u * 4096; float* QQg = (float*)(ws + WS_QQ) + (size_t)u * 4096; bf16* RPg = (bf16*)(ws + WS_RP) + (size_t)u * 4096; float* YVg = (float*)(ws + WS_YV) + (size_t)u * 4096;
      f32x4 a[2];
      RW_ZERO(a); mm_tiles(a, sARB, SL(2), wave, lane); mm_tiles(a, sARB, SL(3), wave, lane);
#pragma unroll
      for (int t = 0; t < 2; ++t) { const int n = 16 * (nt0 + t) + 4 * q; const v2u rr = *(const LAS v2u*)(SL(5) + m * 144 + n * 2);
          v2u w; w.x = pk2(a[t][0] + bf2f((unsigned short)(rr.x & 0xffffu)), a[t][1] + bf2f((unsigned short)(rr.x >> 16))); w.y = pk2(a[t][2] + bf2f((unsigned short)(rr.y & 0xffffu)), a[t][3] + bf2f((unsigned short)(rr.y >> 16)));
          *(GAS v2u*)(RPg + m * 64 + n) = w; }
      RW_ZERO(a); mm_tiles(a, sARB, SL(4), wave, lane); mm_tiles(a, sARK, SL(6), wave, lane);
#pragma unroll
      for (int t = 0; t < 2; ++t) *(GAS f32x4*)(YVg + m * 64 + 16 * (nt0 + t) + 4 * q) = a[t];
      if (tid < 64) ((float*)(ws + WS_WL))[(size_t)u * 64 + tid] = WLV[tid];
      RW_ZERO(a); mm_tiles(a, SL(7), SL(2), wave, lane); mm_tiles(a, SL(8), SL(2), wave, lane); mm_tiles(a, SL(7), SL(3), wave, lane);
#pragma unroll
      for (int t = 0; t < 2; ++t) *(GAS f32x4*)(PTg + m * 64 + 16 * (nt0 + t) + 4 * q) = a[t];
      RW_ZERO(a); mm_tiles(a, SL(4), SL(7), wave, lane); mm_tiles(a, SL(6), SL(9), wave, lane);
#pragma unroll
      for (int t = 0; t < 2; ++t) *(GAS f32x4*)(QQg + m * 64 + 16 * (nt0 + t) + 4 * q) = a[t];
    }
    __syncthreads();
#undef SL
}
__device__ __forceinline__ void wait_count(Frame& F, unsigned* cnt, unsigned target) {
    if (F.tid == 0) { unsigned* bar = (unsigned*)(F.ctl + CW_BAR);
        XB_SPIN(xb_ld(cnt) < target, bar);
        __builtin_amdgcn_fence(__ATOMIC_ACQUIRE, "agent"); asm volatile("s_waitcnt vmcnt(0)" ::: "memory"); }
    __syncthreads();
}
__device__ __forceinline__ void ph_rwkv_passA(Frame& F, int l) {
    PHASE_ENTRY();
    if (F.G == 256) wait_count(F, (unsigned*)(F.ctl + CW_QUEUE + 1024 + 64 * l), (unsigned)((MT / 256) * (NRC_PAD / 256)));
    int pu = -1;
    int u0 = F.bid, ustep = F.G, uend = RW_UNITS;
    if (F.G == 256) {
        const int r = F.bid & 127, sec = F.bid >> 7, nf = (r < (MT / 256) * (NIN_PAD / 256) - 768) ? 8 : 9;
        u0 = r + 128 * (sec ? nf : 0); ustep = 128; uend = r + 128 * (sec ? 18 : nf); }
    for (int u = u0; u < uend; u += ustep) { const bool reuse = (pu >= 0 && u < 2048 && (u & 127) == (pu & 127)); rwkv_passA_unit(A, F, l, u, reuse); pu = u; }
}

struct ChainOps { f32x4 pt[4]; f32x4 qq[2]; f32x4 wl; };
__device__ __forceinline__ void rwkv_chain_load(ChainOps& o, const float* PTg, const float* QQg, const float* WLg, int wave, int lane) {
    const int tk = wave & 3, tv0 = 2 * (wave >> 2), c = lane & 15, q = lane >> 4;
#pragma unroll
    for (int s = 0; s < 2; ++s) { o.pt[2 * s] = *(const GAS f32x4*)(PTg + (16 * tk + c) * 64 + 8 * q + 32 * s); o.pt[2 * s + 1] = *(const GAS f32x4*)(PTg + (16 * tk + c) * 64 + 8 * q + 32 * s + 4); }
#pragma unroll
    for (int t = 0; t < 2; ++t) o.qq[t] = *(const GAS f32x4*)(QQg + (16 * (tv0 + t) + c) * 64 + 16 * tk + 4 * q);
    o.wl = *(const GAS f32x4*)(WLg + 16 * tk + 4 * q);
}
__device__ __forceinline__ void rwkv_chain_step(f32x4 (&acc)[2], const ChainOps& o, const LAS unsigned char* Shi, const LAS unsigned char* Slo, int wave, int lane) {
    const int tv0 = 2 * (wave >> 2), c = lane & 15, q = lane >> 4;
    bf16x8 ph[2], pl[2];
#pragma unroll
    for (int s = 0; s < 2; ++s) { const f32x4 x0 = o.pt[2 * s], x1 = o.pt[2 * s + 1];
        unsigned h[8]; float lo[8];
#pragma unroll
        for (int i = 0; i < 4; ++i) { h[i] = f2bf(x0[i]); lo[i] = x0[i] - bf2f((unsigned short)h[i]); h[4 + i] = f2bf(x1[i]); lo[4 + i] = x1[i] - bf2f((unsigned short)h[4 + i]); }
        ph[s] = __builtin_bit_cast(bf16x8, (v4u){h[0] | (h[1] << 16), h[2] | (h[3] << 16), h[4] | (h[5] << 16), h[6] | (h[7] << 16)});
        pl[s] = __builtin_bit_cast(bf16x8, (v4u){pk2(lo[0], lo[1]), pk2(lo[2], lo[3]), pk2(lo[4], lo[5]), pk2(lo[6], lo[7])}); }
#pragma unroll
    for (int t = 0; t < 2; ++t) { const int v = 16 * (tv0 + t) + c;
        f32x4 a = o.qq[t] + acc[t] * o.wl;
        const bf16x8 s0 = *(const LAS bf16x8*)(Shi + v * 144 + q * 16), s1 = *(const LAS bf16x8*)(Shi + v * 144 + q * 16 + 64);
        const bf16x8 l0 = *(const LAS bf16x8*)(Slo + v * 144 + q * 16), l1 = *(const LAS bf16x8*)(Slo + v * 144 + q * 16 + 64);
        a = __builtin_amdgcn_mfma_f32_16x16x32_bf16(ph[0], s0, a, 0, 0, 0); a = __builtin_amdgcn_mfma_f32_16x16x32_bf16(ph[1], s1, a, 0, 0, 0);
        a = __builtin_amdgcn_mfma_f32_16x16x32_bf16(ph[0], l0, a, 0, 0, 0); a = __builtin_amdgcn_mfma_f32_16x16x32_bf16(ph[1], l1, a, 0, 0, 0);
        a = __builtin_amdgcn_mfma_f32_16x16x32_bf16(pl[0], s0, a, 0, 0, 0); a = __builtin_amdgcn_mfma_f32_16x16x32_bf16(pl[1], s1, a, 0, 0, 0);
        acc[t] = a; }
}
__device__ __forceinline__ void rwkv_state_to_lds(const f32x4 (&acc)[2], LAS unsigned char* Shi, LAS unsigned char* Slo, int wave, int lane) {
    const int tk = wave & 3, tv0 = 2 * (wave >> 2), c = lane & 15, q = lane >> 4;
#pragma unroll
    for (int t = 0; t < 2; ++t) { unsigned h[4]; float lo[4];
#pragma unroll
        for (int i = 0; i < 4; ++i) { h[i] = f2bf(acc[t][i]); lo[i] = acc[t][i] - bf2f((unsigned short)h[i]); }
        const int o = (16 * (tv0 + t) + c) * 144 + (16 * tk + 4 * q) * 2;
        *(LAS v2u*)(Shi + o) = (v2u){h[0] | (h[1] << 16), h[2] | (h[3] << 16)}; *(LAS v2u*)(Slo + o) = (v2u){pk2(lo[0], lo[1]), pk2(lo[2], lo[3])}; }
}
__device__ __forceinline__ void ph_rwkv_chain(Frame& F, int l) {
    PHASE_ENTRY();
    unsigned char* ws = A->ws; const int tid = F.tid, lane = F.lane, wave = F.wave;
    const int tk = wave & 3, tv0 = 2 * (wave >> 2), c = lane & 15, q = lane >> 4;
    LAS unsigned char* HI0 = F.lds, *LO0 = F.lds + RW_SLOT, *HI1 = F.lds + 2 * RW_SLOT, *LO1 = F.lds + 3 * RW_SLOT;
    const float* PT = (const float*)(ws + WS_PT32); const float* QQ = (const float*)(ws + WS_QQ); const float* WL = (const float*)(ws + WS_WL); bf16* SC = (bf16*)(ws + WS_SC);
    if (F.bid < 16) {
        const int h = F.bid;
        f32x4 acc[2]; RW_ZERO(acc);
        rwkv_state_to_lds(acc, HI0, LO0, wave, lane);
        __syncthreads();
        ChainOps ops; rwkv_chain_load(ops, PT + (size_t)(h * 128) * 4096, QQ + (size_t)(h * 128) * 4096, WL + (size_t)(h * 128) * 64, wave, lane);
        for (int cc = 0; cc < 128; ++cc) { const int u = h * 128 + cc; LAS unsigned char* chi = (cc & 1) ? HI1 : HI0, *clo = (cc & 1) ? LO1 : LO0, *nhi = (cc & 1) ? HI0 : HI1, *nlo = (cc & 1) ? LO0 : LO1;
            { const int row = tid >> 3, ch = tid & 7; *(GAS v4u*)((unsigned char*)(SC + (size_t)u * 4096) + tid * 16) = *(const LAS v4u*)(chi + row * 144 + ch * 16); }
            const ChainOps cur = ops;
            if (cc + 1 < 128) rwkv_chain_load(ops, PT + (size_t)(u + 1) * 4096, QQ + (size_t)(u + 1) * 4096, WL + (size_t)(u + 1) * 64, wave, lane);
            rwkv_chain_step(acc, cur, chi, clo, wave, lane);
            rwkv_state_to_lds(acc, nhi, nlo, wave, lane);
            __syncthreads(); }
#ifndef PROBE_SEQ
        float* wo = A->out + O_WP + (size_t)(l * 16 + h) * 4096;
#else
        float* wo = (float*)(A->ws + WS_HALO) + (size_t)h * 4096;
#endif
#pragma unroll
        for (int t = 0; t < 2; ++t) *(GAS f32x4*)(wo + (16 * (tv0 + t) + c) * 64 + 16 * tk + 4 * q) = acc[t];
    } else {
        for (int su = F.bid - 16; su < NSB * 16; su += F.G - 16) { const int u = 2048 + su, sb = su >> 4, h = su & 15;
            const float* S0 = A->in[I_SWKV] + (size_t)((l * NSB + sb) * 16 + h) * 4096;
            f32x4 acc[2];
#pragma unroll
            for (int t = 0; t < 2; ++t) acc[t] = *(const GAS f32x4*)(S0 + (16 * (tv0 + t) + c) * 64 + 16 * tk + 4 * q);
            rwkv_state_to_lds(acc, HI0, LO0, wave, lane);
            __syncthreads();
            { const int row = tid >> 3, ch = tid & 7; *(GAS v4u*)((unsigned char*)(SC + (size_t)u * 4096) + tid * 16) = *(const LAS v4u*)(HI0 + row * 144 + ch * 16); }
            { ChainOps o1; rwkv_chain_load(o1, PT + (size_t)u * 4096, QQ + (size_t)u * 4096, WL + (size_t)u * 64, wave, lane); rwkv_chain_step(acc, o1, HI0, LO0, wave, lane); }
            float* wo = A->out + O_WS + (size_t)((l * NSB + sb) * 16 + h) * 4096;
#pragma unroll
            for (int t = 0; t < 2; ++t) *(GAS f32x4*)(wo + (16 * (tv0 + t) + c) * 64 + 16 * tk + 4 * q) = acc[t];
            __syncthreads(); }
    }
}
__device__ __forceinline__ void ph_rwkv_passC(Frame& F, int l) {
    PHASE_ENTRY();
    unsigned char* ws = A->ws; const int lane = F.lane, wave = F.wave, c = lane & 15, q = lane >> 4, mt = wave & 3;
    const bf16* RP = (const bf16*)(ws + WS_RP); const float* YV = (const float*)(ws + WS_YV); const bf16* SC = (const bf16*)(ws + WS_SC);
    const float* G1 = (const float*)(ws + WS_G1); const float* G2 = (const float*)(ws + WS_G2); bf16* YC = (bf16*)(ws + WS_YCAT);
    bf16x8 rA[2], rB[2], sA[8], sB[8]; f32x4 yA[4], yB[4], gA[8], gB[8];
    auto geo = [&](int u, int& h, int& row0, bool& skip) { const bool samp = u >= 2048;
        if (!samp) { h = u >> 7; row0 = 64 * (u & 127); } else { const int su = u - 2048; h = su & 15; row0 = MP + (su >> 4) * TS; }
        skip = samp && mt > 0; };
    auto load = [&](int u, bf16x8 (&r)[2], bf16x8 (&sv)[8], f32x4 (&y)[4], f32x4 (&g)[8]) { int h, row0; bool skip; geo(u, h, row0, skip); if (skip) return;
        const bf16* RPu = RP + (size_t)u * 4096; const float* YVu = YV + (size_t)u * 4096; const bf16* SCu = SC + (size_t)u * 4096; const int t = 16 * mt + c; const size_t ro = (size_t)(row0 + t);
        r[0] = *(const GAS bf16x8*)(RPu + t * 64 + 8 * q); r[1] = *(const GAS bf16x8*)(RPu + t * 64 + 8 * q + 32);
#pragma unroll
        for (int nt = 0; nt < 4; ++nt) { const int v = h * 64 + 16 * nt + 4 * q; y[nt] = *(const GAS f32x4*)(YVu + t * 64 + 16 * nt + 4 * q);
            sv[2 * nt] = *(const GAS bf16x8*)(SCu + (16 * nt + c) * 64 + 8 * q); sv[2 * nt + 1] = *(const GAS bf16x8*)(SCu + (16 * nt + c) * 64 + 8 * q + 32);
            g[nt] = *(const GAS f32x4*)(G1 + ro * 1024 + v); g[4 + nt] = *(const GAS f32x4*)(G2 + ro * 1024 + v); } };
    auto compute = [&](int u, const bf16x8 (&r)[2], const bf16x8 (&sv)[8], f32x4 (&y)[4], const f32x4 (&g)[8]) { int h, row0; bool skip; geo(u, h, row0, skip); if (skip) return;
        const int t = 16 * mt + c; const size_t ro = (size_t)(row0 + t); float s1 = 0.f;
#pragma unroll
        for (int nt = 0; nt < 4; ++nt) { y[nt] = __builtin_amdgcn_mfma_f32_16x16x32_bf16(sv[2 * nt], r[0], y[nt], 0, 0, 0); y[nt] = __builtin_amdgcn_mfma_f32_16x16x32_bf16(sv[2 * nt + 1], r[1], y[nt], 0, 0, 0);
            s1 += (y[nt][0] + y[nt][1]) + (y[nt][2] + y[nt][3]); }
        s1 += swz_xor<16>(s1); s1 += xor32(s1);
        const float mean = s1 * (1.f / 64.f); float s2 = 0.f;
#pragma unroll
        for (int nt = 0; nt < 4; ++nt) { y[nt] = y[nt] - mean; s2 += (y[nt][0] * y[nt][0] + y[nt][1] * y[nt][1]) + (y[nt][2] * y[nt][2] + y[nt][3] * y[nt][3]); }
        s2 += swz_xor<16>(s2); s2 += xor32(s2);
        const float rstd = __builtin_amdgcn_rsqf(s2 * (1.f / 64.f) + 64e-5f);
#pragma unroll
        for (int nt = 0; nt < 4; ++nt) { const int v = h * 64 + 16 * nt + 4 * q;
            const f32x4 o = y[nt] * rstd * g[nt] + g[4 + nt]; v2u w; w.x = pk2(o[0], o[1]); w.y = pk2(o[2], o[3]); *(GAS v2u*)(YC + ro * DMOD + v) = w; } };
    const int u0 = 2 * F.bid + (wave >> 2), us = 2 * F.G;
    if (u0 < RW_UNITS) load(u0, rA, sA, yA, gA);
    for (int u = u0; u < RW_UNITS; u += 2 * us) {
        if (u + us < RW_UNITS) load(u + us, rB, sB, yB, gB);
        compute(u, rA, sA, yA, gA);
        if (u + us < RW_UNITS) { if (u + 2 * us < RW_UNITS) load(u + 2 * us, rA, sA, yA, gA); compute(u + us, rB, sB, yB, gB); }
    }
}
__device__ __forceinline__ void attn_sample_unit(ArgsP A, Frame& F, int l, int sb, int h) {
    unsigned char* ws = A->ws; const int tid = F.tid, lane = F.lane, wave = F.wave;
    LAS float* QS = (LAS float*)F.lds;
    LAS float* LUT = QS + 2048;
    LAS float* PB = QS + 4096 + wave * 1024;
    LAS float* MLW = QS + 4096 + 8192;
    LAS float* OACC = MLW + 128;
    LAS float* LACC = OACC + 4096;
    const bf16* QB = (const bf16*)(ws + WS_QB); const bf16* KB = (const bf16*)(ws + WS_KB); const bf16* VB = (const bf16*)(ws + WS_VB);
    const float* reltab = A->in[I_REL];
    for (int i = tid; i < 2048; i += NWAVES * 64) { const int t = i >> 7, d = i & 127; QS[i] = bf2f(QB[(size_t)(MP + sb * TS + t) * 1024 + h * 128 + d]); }
    if (tid < 192) { const int rel = tid - 128; const int n = rel < 0 ? -rel : rel;
        const int lg = n < 12 ? 8 : n < 16 ? 9 : n < 23 ? 10 : n < 32 ? 11 : n < 46 ? 12 : n < 64 ? 13 : n < 91 ? 14 : 15;
        const int bucket = (rel > 0 ? 16 : 0) + (n < 8 ? n : lg);
        LUT[tid] = (reltab[bucket * 8 + h] - reltab[15 * 8 + h]) * 1.4426950408889634f; }
    for (int i = tid; i < 4096 + 32; i += NWAVES * 64) OACC[i] = 0.f;
    __syncthreads();
    const int map = wave & 1, kg = wave >> 1;
    float mrun[16], lrun[16], o[16][2];
#pragma unroll
    for (int t = 0; t < 16; ++t) { mrun[t] = -INFINITY; lrun[t] = 0.f; o[t][0] = 0.f; o[t][1] = 0.f; }
    const float* CK = A->in[I_CK] + (size_t)(l * NSB + sb) * PAST * 1024; const float* CV = A->in[I_CV] + (size_t)(l * NSB + sb) * PAST * 1024;
    for (int kb = kg; kb < 33; kb += 4) {
        const int pos = 64 * kb + lane; const bool kvalid = pos < PAST + TS;
        float s[16];
#pragma unroll
        for (int t = 0; t < 16; ++t) s[t] = 0.f;
        if (kb < 32) { const float* kp = CK + (size_t)pos * 1024 + h * 128 + map * 64;
#pragma unroll 4
            for (int d = 0; d < 64; d += 4) { const f32x4 kv = *(const GAS f32x4*)(kp + d);
#pragma unroll
                for (int t = 0; t < 16; ++t) { const f32x4 qv = *(const LAS f32x4*)(QS + t * 128 + map * 64 + d); s[t] += (kv[0] * qv[0] + kv[1] * qv[1]) + (kv[2] * qv[2] + kv[3] * qv[3]); } }
        } else { const int rr = MP + sb * TS + (lane & 15); const bf16* kp = KB + (size_t)rr * 1024 + h * 128 + map * 64;
#pragma unroll 4
            for (int d = 0; d < 64; d += 4) { const v2u kw = *(const GAS v2u*)(kp + d);
                const f32x4 kv = (f32x4){bf2f((unsigned short)(kw.x & 0xffffu)), bf2f((unsigned short)(kw.x >> 16)), bf2f((unsigned short)(kw.y & 0xffffu)), bf2f((unsigned short)(kw.y >> 16))};
#pragma unroll
                for (int t = 0; t < 16; ++t) { const f32x4 qv = *(const LAS f32x4*)(QS + t * 128 + map * 64 + d); s[t] += (kv[0] * qv[0] + kv[1] * qv[1]) + (kv[2] * qv[2] + kv[3] * qv[3]); } }
        }
        float al[16];
#pragma unroll
        for (int t = 0; t < 16; ++t) { int idx = pos - (PAST + t) + 128; idx = idx < 0 ? 0 : idx; idx = idx > 191 ? 191 : idx;
            float sv = kvalid ? s[t] + LUT[idx] : -INFINITY;
            const float bm = wave_max(sv);
            const float mn = fmaxf(mrun[t], bm); al[t] = __builtin_amdgcn_exp2f(mrun[t] - mn); mrun[t] = mn;
            const float p = __builtin_amdgcn_exp2f(sv - mn); PB[lane * 16 + t] = p;
            lrun[t] = lrun[t] * al[t] + wave_sum(p);
            o[t][0] *= al[t]; o[t][1] *= al[t]; }
        LDS_WAIT(); asm volatile("" ::: "memory");
        const int nk = (kb < 32) ? 64 : TS;
        for (int k0 = 0; k0 < nk; k0 += 4) { f32x2 vv[4];
            if (kb < 32) {
#pragma unroll
                for (int b = 0; b < 4; ++b) vv[b] = *(const GAS f32x2*)(CV + (size_t)(64 * kb + k0 + b) * 1024 + h * 128 + 2 * lane);
            } else {
#pragma unroll
                for (int b = 0; b < 4; ++b) { const unsigned w = *(const GAS unsigned*)(VB + (size_t)(MP + sb * TS + k0 + b) * 1024 + h * 128 + 2 * lane); vv[b].x = bf2f((unsigned short)(w & 0xffffu)); vv[b].y = bf2f((unsigned short)(w >> 16)); }
            }
#pragma unroll
            for (int b = 0; b < 4; ++b) { const LAS f32x4* pp = (const LAS f32x4*)(PB + (k0 + b) * 16);
                const f32x4 p0 = pp[0], p1 = pp[1], p2 = pp[2], p3 = pp[3];
#pragma unroll
                for (int t = 0; t < 4; ++t) { o[t][0] += p0[t] * vv[b].x; o[t][1] += p0[t] * vv[b].y; o[4 + t][0] += p1[t] * vv[b].x; o[4 + t][1] += p1[t] * vv[b].y;
                    o[8 + t][0] += p2[t] * vv[b].x; o[8 + t][1] += p2[t] * vv[b].y; o[12 + t][0] += p3[t] * vv[b].x; o[12 + t][1] += p3[t] * vv[b].y; }
                asm volatile("" ::: "memory"); } }
        LDS_WAIT(); asm volatile("" ::: "memory");
    }
    if (lane < 16) { float mv = mrun[0];
#pragma unroll
        for (int t = 1; t < 16; ++t) mv = (lane == t) ? mrun[t] : mv;
        MLW[wave * 16 + lane] = mv; }
    __syncthreads();
#pragma unroll
    for (int t = 0; t < 16; ++t) { float M = fmaxf(fmaxf(MLW[(map) * 16 + t], MLW[(2 + map) * 16 + t]), fmaxf(MLW[(4 + map) * 16 + t], MLW[(6 + map) * 16 + t]));
        const float sc = __builtin_amdgcn_exp2f(mrun[t] - M);
        __hip_atomic_fetch_add(OACC + (t * 2 + map) * 128 + 2 * lane, o[t][0] * sc, __ATOMIC_RELAXED, __HIP_MEMORY_SCOPE_WORKGROUP); __hip_atomic_fetch_add(OACC + (t * 2 + map) * 128 + 2 * lane + 1, o[t][1] * sc, __ATOMIC_RELAXED, __HIP_MEMORY_SCOPE_WORKGROUP);
        if (lane == 0) __hip_atomic_fetch_add(LACC + map * 16 + t, lrun[t] * sc, __ATOMIC_RELAXED, __HIP_MEMORY_SCOPE_WORKGROUP); }
    __syncthreads();
    float* OA = (float*)(ws + WS_OATT);
    for (int i = tid; i < 4096; i += NWAVES * 64) { const int t = i >> 8, mp = (i >> 7) & 1, e = i & 127;
        OA[(size_t)(MP + sb * TS + t) * DMOD + h * 256 + mp * 128 + e] = OACC[i] / LACC[mp * 16 + t]; }
    __syncthreads();
}


__device__ __forceinline__ void attn_sample_unit2(ArgsP A, Frame& F, int l, int sb, int h) {
    using attn_body::f32x16;
    unsigned char* ws = A->ws; int tid_ = F.tid; asm volatile("" : "+v"(tid_));
    const int tid = tid_, lane = tid & 63, wid = __builtin_amdgcn_readfirstlane(tid >> 6), r32 = lane & 31, hi = lane >> 5, map = wid & 1, vh = (wid >> 1) & 1, KH = wid >> 2;
    LAS unsigned char* L = F.lds;
    LAS float* wsf = (LAS float*)(L + 65536) + wid * 64;
    const LAS float* LUT = (const LAS float*)(L + LUT_OFF) + h * 192;
    LAS float* MG = (LAS float*)(L + 68608);
    const bf16* QB = (const bf16*)(ws + WS_QB); const bf16* KB = (const bf16*)(ws + WS_KB); const bf16* VB = (const bf16*)(ws + WS_VB);
    const float* CK = A->in[I_CK] + (size_t)(l * NSB + sb) * PAST * 1024 + h * 128; const float* CV = A->in[I_CV] + (size_t)(l * NSB + sb) * PAST * 1024 + h * 128;
    bf16x8 qr[4];
    { const bf16* Qw = QB + (size_t)(MP + sb * TS + (r32 & 15)) * 1024 + h * 128 + map * 64;
#pragma unroll
      for (int d0 = 0; d0 < 4; ++d0) qr[d0] = *(const GAS bf16x8*)(Qw + d0 * 16 + hi * 8); }
    f32x4 st[8];
    auto stage_load = [&](int tile) {
        if (tile < 32) {
#pragma unroll
            for (int k = 0; k < 4; ++k) { const int idx = tid + 512 * k, row = idx >> 5, pp = idx & 31; const size_t off = (size_t)(64 * tile + row) * 1024 + 4 * pp;
                st[k] = __builtin_nontemporal_load((const GAS f32x4*)(CK + off)); st[4 + k] = __builtin_nontemporal_load((const GAS f32x4*)(CV + off)); }
        } else {
#pragma unroll
            for (int i = 0; i < 8; ++i) st[i] = (f32x4){0.f, 0.f, 0.f, 0.f};
            { const int row = tid >> 5, pp = tid & 31; const size_t off = (size_t)(MP + sb * TS + row) * 1024 + h * 128 + 4 * pp;
              const v2u wk = *(const GAS v2u*)(KB + off), wv = *(const GAS v2u*)(VB + off);
              st[0] = (f32x4){bf2f((unsigned short)(wk.x & 0xffffu)), bf2f((unsigned short)(wk.x >> 16)), bf2f((unsigned short)(wk.y & 0xffffu)), bf2f((unsigned short)(wk.y >> 16))};
              st[4] = (f32x4){bf2f((unsigned short)(wv.x & 0xffffu)), bf2f((unsigned short)(wv.x >> 16)), bf2f((unsigned short)(wv.y & 0xffffu)), bf2f((unsigned short)(wv.y >> 16))}; }
        } };
    auto stage_write = [&](int buf) { LAS unsigned char* B = L + buf * 32768;
#pragma unroll
        for (int k = 0; k < 4; ++k) { const int idx = tid + 512 * k, row = idx >> 5, pp = idx & 31, c = 4 * (pp & 15); const f32x4 x = st[k], y = st[4 + k];
            *(LAS v2u*)(B + (pp >> 4) * 8192 + ((pp & 15) >> 1) * 1024 + row * 16 + (pp & 1) * 8) = (v2u){pk2(x[0], x[1]), pk2(x[2], x[3])};
            *(LAS v2u*)(B + 16384 + (pp >> 4) * 8192 + ((c >> 5) * 4 + (row >> 4)) * 1024 + ((row & 15) * 4 + ((c & 31) >> 3)) * 16 + ((c >> 2) & 1) * 8) = (v2u){pk2(y[0], y[1]), pk2(y[2], y[3])}; } };
    stage_load(0);
    float mhat = 0.f, l_reg = 0.f; f32x16 o[2]; o[0] = f32x16{}; o[1] = f32x16{};
    stage_write(0);
    __syncthreads();
    for (int tile = 0; tile < 33; ++tile) {
        if (tile + 1 < 33) stage_load(tile + 1);
        const LAS unsigned char* B = L + (tile & 1) * 32768;
        f32x16 p;
        attn_body::qkt_half(p, (attn_body::lds_cp)(B + map * 8192), qr, f32x16{}, r32, hi, KH);
        asm volatile("s_nop 15\n\ts_nop 7" : "+v"(p));
#pragma unroll
        for (int r = 0; r < 16; ++r) p[r] -= mhat;
        if (tile >= 30) {
            const int rel0 = 64 * tile + 32 * KH + 4 * hi - (PAST + (r32 & 15)) + 128;
#pragma unroll
            for (int r = 0; r < 16; ++r) { const int kin = 32 * KH + 4 * hi + (r & 3) + 8 * (r >> 2); int idx = rel0 + (r & 3) + 8 * (r >> 2); idx = idx < 0 ? 0 : (idx > 191 ? 191 : idx);
                p[r] = (tile == 32 && kin >= TS) ? -INFINITY : p[r] + LUT[idx]; } }
        float rm = p[0];
#pragma unroll
        for (int r = 1; r < 16; ++r) rm = fmaxf(rm, p[r]);
        { const PL32 rr = pl32(rm); rm = fmaxf(rr.a, rr.b); }
        if (__any(rm > 0.f)) { const float dl = fmaxf(rm, 0.f); mhat += dl;
#pragma unroll
            for (int r = 0; r < 16; ++r) p[r] -= dl;
            const float f = __builtin_amdgcn_exp2f(-dl); l_reg *= f; if (hi == 0) wsf[r32] = f;
            asm volatile("s_waitcnt lgkmcnt(0)" ::: "memory");
#pragma unroll
            for (int d_ = 0; d_ < 2; ++d_)
#pragma unroll
                for (int r = 0; r < 16; ++r) o[d_][r] *= wsf[attn_body::crow(r, hi)]; }
        float sacc = 0.f;
#pragma unroll
        for (int r = 0; r < 16; ++r) { p[r] = __builtin_amdgcn_exp2f(p[r]); sacc += p[r]; }
        l_reg += sacc;
        const v4u pw0 = (v4u){attn_body::cvtpk_s(p[0], p[1]), attn_body::cvtpk_s(p[2], p[3]), attn_body::cvtpk_s(p[4], p[5]), attn_body::cvtpk_s(p[6], p[7])};
        const v4u pw1 = (v4u){attn_body::cvtpk_s(p[8], p[9]), attn_body::cvtpk_s(p[10], p[11]), attn_body::cvtpk_s(p[12], p[13]), attn_body::cvtpk_s(p[14], p[15])};
        const int vb = (int)(unsigned)(size_t)(B + 16384 + vh * 8192) + KH * 2048 + ((lane >> 4) & 1) * 32 + (lane & 3) * 8 + (4 * hi + ((lane & 15) >> 2)) * 64;
        attn_body::pv_half(o, vb, __builtin_bit_cast(bf16x8, pw0), __builtin_bit_cast(bf16x8, pw1));
        if (tile + 1 < 33) stage_write((tile + 1) & 1);
        __syncthreads();
    }
    { const PL32 rr = pl32(l_reg); l_reg = rr.a + rr.b; }
    LAS float* OG = (LAS float*)L + (wid & 3) * 2048;
    if (KH == 1) { if (hi == 0) { MG[(wid & 3) * 64 + r32] = mhat; MG[(wid & 3) * 64 + 32 + r32] = l_reg; }
#pragma unroll
        for (int d_ = 0; d_ < 2; ++d_)
#pragma unroll
            for (int r = 0; r < 16; ++r) OG[(d_ * 16 + r) * 64 + lane] = o[d_][r]; }
    __syncthreads();
    if (KH == 0) { const float m2 = MG[wid * 64 + r32], l2 = MG[wid * 64 + 32 + r32]; const float M = fmaxf(mhat, m2);
        const float f1 = __builtin_amdgcn_exp2f(mhat - M), f2 = __builtin_amdgcn_exp2f(m2 - M); const float inv = 1.f / (l_reg * f1 + l2 * f2);
        if (hi == 0) { wsf[r32] = f1 * inv; wsf[32 + r32] = f2 * inv; }
        asm volatile("s_waitcnt lgkmcnt(0)" ::: "memory");
        bf16* OA = (bf16*)(ws + WS_OATT) + (size_t)(MP + sb * TS) * DMOD + h * 256 + map * 128 + vh * 64;
#pragma unroll
        for (int r = 0; r < 8; ++r) { const int q = attn_body::crow(r, hi); const float g1 = wsf[q], g2 = wsf[32 + q];
#pragma unroll
            for (int d_ = 0; d_ < 2; ++d_) OA[(size_t)q * DMOD + d_ * 32 + r32] = (bf16)f2bf(o[d_][r] * g1 + OG[(d_ * 16 + r) * 64 + lane] * g2); } }
    __syncthreads();
}
__device__ __forceinline__ void attn_build_lut(ArgsP A, Frame& F) {
    LAS float* T = (LAS float*)(F.lds + LUT_OFF); const float* reltab = A->in[I_REL];
    for (int i = F.tid; i < 8 * 192; i += NWAVES * 64) { const int hh = i / 192, rel = i % 192 - 128; const int n = rel < 0 ? -rel : rel;
        const int lg = n < 12 ? 8 : n < 16 ? 9 : n < 23 ? 10 : n < 32 ? 11 : n < 46 ? 12 : n < 64 ? 13 : n < 91 ? 14 : 15;
        const int bucket = (rel > 0 ? 16 : 0) + (n < 8 ? n : lg);
        T[i] = (reltab[bucket * 8 + hh] - reltab[15 * 8 + hh]) * 1.4426950408889634f; }
    __syncthreads();
}
__device__ __forceinline__ void ph_attn_sample(Frame& F, int l) {
    PHASE_ENTRY();
    attn_build_lut(A, F);
    gu32* head = F.ctl + CW_QUEUE + 128 * l;
    for (;;) {
        if (F.tid == 0) F.MISC[16] = __hip_atomic_fetch_add(head, 1u, RLX_AGENT);
        __syncthreads();
        const unsigned qi = F.MISC[16];
        __syncthreads();
        if (qi >= 128u) break;
#ifdef SAMPLE_VALU
        attn_sample_unit(A, F, l, (int)(qi >> 3), (int)(qi & 7u));
#else
        attn_sample_unit2(A, F, l, (int)(qi >> 3), (int)(qi & 7u));
#endif
    }
}
__device__ __forceinline__ void ph_attn_prompt(Frame& F, int l) {
    PHASE_ENTRY();
    unsigned char* ws = A->ws;
    gu32* head = F.ctl + CW_QUEUE + 128 * l + 64;
    for (;;) {
        if (F.tid == 0) F.MISC[17] = __hip_atomic_fetch_add(head, 1u, RLX_AGENT);
        __syncthreads();
        const unsigned qi = F.MISC[17];
        __syncthreads();
        if (qi >= 1024u) break;
        const int qb = 63 - (int)(qi >> 4), hm = (int)(qi & 15u);
        const int hh = hm >> 1, mp = hm & 1;
        attn_body::attn_unit_f<8>(qb, hh * 128 + mp * 64, hh * 128, hh * 256 + mp * 128,
                                (const attn_body::bf16*)(ws + WS_QB), (const attn_body::bf16*)(ws + WS_KB), (const attn_body::bf16*)(ws + WS_VB), (attn_body::bf16*)(ws + WS_OATT), (char*)F.lds, (const LAS float*)(F.lds + LUT_OFF) + hh * 192);
    }
}
__device__ __forceinline__ void ph_attn_final(Frame& F, int l) {
    PHASE_ENTRY();
    const int lane = F.lane; const int gw = F.bid * NWAVES + F.wave, NGW = F.G * NWAVES;
    float d1 = A->in[I_LQ1][l * 64 + lane] * A->in[I_LK1][l * 64 + lane], d2 = A->in[I_LQ2][l * 64 + lane] * A->in[I_LK2][l * 64 + lane];
    d1 = wave_sum(d1); d2 = wave_sum(d2);
    const float lam_init = (l == 0) ? 0.2f : (0.8f - 0.6f * 0.7408182206817179f);
    const float lam = expf(d1) - expf(d2) + lam_init, osc = 1.f - lam_init;
    const int hh = lane >> 3, e0 = (lane & 7) * 16;
    const bf16* OA = (const bf16*)(A->ws + WS_OATT); bf16* YC = (bf16*)(A->ws + WS_YCAT);
    f32x4 sl[4];
#pragma unroll
    for (int j = 0; j < 4; ++j) sl[j] = *(const GAS f32x4*)(A->in[I_SUBLN] + l * 128 + e0 + 4 * j);
    for (int m = gw; m < MT; m += NGW) {
        if (l == 0 && m >= MP) { const float* xs = A->in[I_XS] + (size_t)(m - MP) * DMOD; float* xd = (float*)(A->ws + WS_X) + (size_t)m * DMOD;
#pragma unroll
            for (int j = 0; j < 8; ++j) *(GAS f32x4*)(xd + 4 * lane + 256 * j) = *(const GAS f32x4*)(xs + 4 * lane + 256 * j); }
        const bf16* o1 = OA + (size_t)m * DMOD + hh * 256 + e0; f32x4 o[4]; float ss = 0.f;
        { const v4u a0 = *(const GAS v4u*)o1, a1 = *(const GAS v4u*)(o1 + 8), b0 = *(const GAS v4u*)(o1 + 128), b1 = *(const GAS v4u*)(o1 + 136);
          const unsigned aw[8] = {a0.x, a0.y, a0.z, a0.w, a1.x, a1.y, a1.z, a1.w}, bw[8] = {b0.x, b0.y, b0.z, b0.w, b1.x, b1.y, b1.z, b1.w};
#pragma unroll
          for (int j = 0; j < 4; ++j) { o[j][0] = bf2f((unsigned short)(aw[2 * j] & 0xffffu)) - lam * bf2f((unsigned short)(bw[2 * j] & 0xffffu)); o[j][1] = bf2f((unsigned short)(aw[2 * j] >> 16)) - lam * bf2f((unsigned short)(bw[2 * j] >> 16));
              o[j][2] = bf2f((unsigned short)(aw[2 * j + 1] & 0xffffu)) - lam * bf2f((unsigned short)(bw[2 * j + 1] & 0xffffu)); o[j][3] = bf2f((unsigned short)(aw[2 * j + 1] >> 16)) - lam * bf2f((unsigned short)(bw[2 * j + 1] >> 16));
              ss += (o[j][0] * o[j][0] + o[j][1] * o[j][1]) + (o[j][2] * o[j][2] + o[j][3] * o[j][3]); } }
        ss += swz_xor<1>(ss); ss += swz_xor<2>(ss); ss += swz_xor<4>(ss);
        const float rs = osc * __builtin_amdgcn_rsqf(ss * (1.f / 128.f) + 1e-5f);
        v4u w0, w1; f32x4 y0 = o[0] * rs * sl[0], y1 = o[1] * rs * sl[1], y2 = o[2] * rs * sl[2], y3 = o[3] * rs * sl[3];
        w0 = (v4u){pk2(y0[0], y0[1]), pk2(y0[2], y0[3]), pk2(y1[0], y1[1]), pk2(y1[2], y1[3])}; w1 = (v4u){pk2(y2[0], y2[1]), pk2(y2[2], y2[3]), pk2(y3[0], y3[1]), pk2(y3[2], y3[3])};
        bf16* yo = YC + (size_t)m * DMOD + 1024 + hh * 128 + e0; *(GAS v4u*)yo = w0; *(GAS v4u*)(yo + 8) = w1;
    }
}
__device__ __forceinline__ void ph_fixup(Frame& F, int l) {
    PHASE_ENTRY();
    const float* tail = (const float*)(A->ws + WS_HALO), *hg = tail + 32 * 2 * DFF, *hv = hg + 32 * 2 * DFF;
    const float* cw = A->in[I_CONVW] + (size_t)l * 3 * DFF, *cb = A->in[I_CONVB] + (size_t)l * DFF; bf16* ACT = (bf16*)(A->ws + WS_ACT);
    const int gt = F.bid * (NWAVES * 64) + F.tid, ngt = F.G * NWAVES * 64;
    for (int idx = gt; idx < 31 * DFF; idx += ngt) { const int pm = 1 + idx / DFF, j = idx % DFF;
        const float um2 = tail[((size_t)(pm - 1) * 2 + 0) * DFF + j], um1 = tail[((size_t)(pm - 1) * 2 + 1) * DFF + j], u0 = hg[((size_t)pm * 2 + 0) * DFF + j], u1 = hg[((size_t)pm * 2 + 1) * DFF + j];
        const float v0 = hv[((size_t)pm * 2 + 0) * DFF + j], v1 = hv[((size_t)pm * 2 + 1) * DFF + j];
        const float w0 = cw[j], w1 = cw[DFF + j], w2 = cw[2 * DFF + j], b = cb[j];
        const pg8::f32x2 g = pg8::gelu_pk((pg8::f32x2){b + w0 * um2 + w1 * um1 + w2 * u0, b + w0 * um1 + w1 * u0 + w2 * u1});
        ACT[(size_t)(256 * pm) * DFF + j] = (bf16)f2bf(g.x * v0); ACT[(size_t)(256 * pm + 1) * DFF + j] = (bf16)f2bf(g.y * v1); }
}
#ifdef PROBE_SEQ
__device__ __forceinline__ void probe_seq_scan(Frame& F, int l) {
    PHASE_ENTRY();
    const int gw = F.bid * NWAVES + F.wave, lane = F.lane;
    if (gw >= 16) return;
    const int h = gw, hj = h * 64 + lane;
    const float* PR = (const float*)(A->ws + WS_PR); const float* mu = A->in[I_MU] + (size_t)l * NRC;
    LAS float* sc = (LAS float*)(F.lds + F.wave * 4096);
    const float* w2 = A->in[I_W2] + (size_t)l * 96 * 1024; const float* a2 = A->in[I_A2] + (size_t)l * 96 * 1024;
    const float w0 = A->in[I_W0][l * 1024 + hj], a0 = A->in[I_A0][l * 1024 + hj], kkw = A->in[I_KK][l * 1024 + hj], kaw = A->in[I_KA][l * 1024 + hj];
    float S[64];
#pragma unroll
    for (int k = 0; k < 64; ++k) S[k] = 0.f;
    for (int t = 0; t < MP; ++t) {
        const float* pc = PR + (size_t)t * NRC_PAD; const float* pp = pc - NRC_PAD;
        auto lerp = [&](int col) { const float cur = pc[col]; const float prv = t > 0 ? pp[col] : 0.f; return cur + (prv - cur) * mu[col]; };
        sc[lane] = tanhf(lerp(3072 + lane)); if (lane < 32) sc[64 + lane] = tanhf(lerp(3072 + 64 + lane));
        sc[96 + lane] = lerp(3168 + lane); if (lane < 32) sc[96 + 64 + lane] = lerp(3168 + 64 + lane);
        LDS_WAIT(); asm volatile("" ::: "memory");
        float wl = 0.f, al = 0.f;
        for (int k = 0; k < 96; ++k) { wl += sc[k] * w2[(size_t)k * 1024 + hj]; al += sc[96 + k] * a2[(size_t)k * 1024 + hj]; }
        const float xk = lerp(1024 + hj), xv = lerp(2048 + hj);
        const float z = w0 + wl; const float wlog = -log1pf(expf(-z)) - 0.5f; const float w = expf(-expf(wlog));
        const float a = 1.f / (1.f + expf(-(a0 + al)));
        const float kkr = xk * kkw; const float nrm = wave_sum(kkr * kkr); const float kk = kkr / sqrtf(fmaxf(nrm, 1e-24f));
        const float km = xk * (1.f + (a - 1.f) * kaw);
        LDS_WAIT(); asm volatile("" ::: "memory");
        sc[192 + lane] = w; sc[256 + lane] = kk; sc[320 + lane] = kk * a; sc[384 + lane] = km;
        LDS_WAIT(); asm volatile("" ::: "memory");
        float sa = 0.f;
#pragma unroll
        for (int k = 0; k < 64; ++k) sa -= S[k] * sc[256 + k];
#pragma unroll
        for (int k = 0; k < 64; ++k) S[k] = S[k] * sc[192 + k] + sa * sc[320 + k] + xv * sc[384 + k];
        LDS_WAIT(); asm volatile("" ::: "memory");
    }
    float* wo = A->out + O_WP + (size_t)(l * 16 + h) * 4096 + lane * 64;
#pragma unroll
    for (int k = 0; k < 64; ++k) wo[k] = S[k];
}
#endif
#ifdef PROBE_GEMM
__device__ __forceinline__ void probe_gemm_check(Frame& F) {
    PHASE_ENTRY();
    if (F.bid != 0) return;
    float* scr = (float*)(A->ws + WS_OATT);
    const int tid = F.tid, lane = F.lane, wave = F.wave;
    for (int j = tid; j < 2 * DMOD; j += NWAVES * 64) { float s = A->in[I_BADA][j];
        for (int k = 0; k < DMOD; ++k) { const float c = A->in[I_CP][k]; s += (c / (1.f + expf(-c))) * A->in[I_WADA][(size_t)k * MODW + j]; }
        scr[j] = s; }
    __threadfence(); __syncthreads();
    float num = 0.f, den = 0.f;
#if PROBE_GEMM == 3
    for (int j = tid; j < 2 * DMOD; j += NWAVES * 64) { const float mine = ((const float*)(A->ws + WS_MOD))[j], ref = scr[j]; num += (mine - ref) * (mine - ref); den += ref * ref; }
    num = wave_sum(num); den = wave_sum(den);
#elif PROBE_GEMM == 5
    { const float sgot = wave_sum((float)(lane + 1)); num = (sgot - 2080.f) * (sgot - 2080.f); den = 2080.f * 2080.f; }
#elif PROBE_GEMM == 6
    { float v = (float)(lane + 1); for (int o = 1; o < 64; o <<= 1) v += __shfl_xor(v, o); num = (v - 2080.f) * (v - 2080.f); den = 2080.f * 2080.f; }
#elif PROBE_GEMM == 4
    for (int smp = wave; smp < 64; smp += NWAVES) { const int m = (smp * 2654435761u >> 7) % MP; const float* xr = A->in[I_XP] + (size_t)m * DMOD; float ss = 0.f;
        for (int k = lane; k < DMOD; k += 64) ss += xr[k] * xr[k];
        const float rstd = 1.f / sqrtf(wave_sum(ss) / DMOD + 1e-6f);
        for (int k = lane; k < DMOD; k += 64) { const float hh = xr[k] * rstd * A->in[I_GMIX][k] * (1.f + scr[DMOD + k]) + scr[k]; const float mine = bf2f(((const bf16*)(A->ws + WS_H))[(size_t)m * DMOD + k]); num += (mine - hh) * (mine - hh); den += hh * hh; } }
    num = wave_sum(num); den = wave_sum(den);
#else
    for (int smp = wave; smp < 256; smp += NWAVES) {
        const int m = (smp * 2654435761u >> 7) % MP; const int cc = (smp * 40503u + 17u) % (PROBE_GEMM == 1 ? 3072 : 1024);
        const int col = PROBE_GEMM == 1 ? cc : NRC + 1024 + cc;
        const float* xr = A->in[I_XP] + (size_t)m * DMOD; float ss = 0.f;
        for (int k = lane; k < DMOD; k += 64) ss += xr[k] * xr[k];
        const float rstd = 1.f / sqrtf(wave_sum(ss) / DMOD + 1e-6f); float acc = 0.f;
        for (int k = lane; k < DMOD; k += 64) { const float hh = xr[k] * rstd * A->in[I_GMIX][k] * (1.f + scr[DMOD + k]) + scr[k]; acc += hh * A->in[I_WIN][(size_t)k * NIN + col]; }
        acc = wave_sum(acc);
        const float mine = PROBE_GEMM == 1 ? ((const float*)(A->ws + WS_PR))[(size_t)m * NRC_PAD + cc] : A->out[O_KP + (size_t)m * 1024 + cc];
        num += (mine - acc) * (mine - acc); den += acc * acc; }
#endif
    LAS float* red = (LAS float*)F.lds;
    if (lane == 0) { red[wave] = num; red[8 + wave] = den; }
    __syncthreads();
    if (tid == 0) { float n = 0.f, d = 0.f; for (int w = 0; w < 8; ++w) { n += red[w]; d += red[8 + w]; } ((float*)(A->ws + WS_CTL))[16384] = sqrtf(n / d); }
}
#endif
#ifndef MK_SPLIT
#define MK_SPLIT 0
#endif
constexpr int N_PHASES = 22;
__global__ void __launch_bounds__(NWAVES * 64, 2) hybrid_fwd(Args args) {
    extern __shared__ __attribute__((aligned(16))) unsigned char lds[];
    Frame F;
    F.lds = (LAS unsigned char*)lds; F.MISC = (volatile LAS unsigned*)(F.lds + MISC_OFF);
    F.tid = threadIdx.x; F.lane = F.tid & 63; F.wave = __builtin_amdgcn_readfirstlane(F.tid >> 6); F.G = gridDim.x; F.bid = blockIdx.x;
    F.ctl = (gu32*)(args.ws + WS_CTL);
    if (F.tid < 64) F.MISC[F.tid] = 0u;
    __syncthreads();
    XcdBarrier bar; bar.bar = (unsigned*)(F.ctl + CW_BAR); bar.x = 0; bar.st = nullptr;
    if (!MK_SPLIT) bar = xcd_barrier_post((unsigned*)(F.ctl + CW_BAR), F.MISC + 8);
    const int lo = args.ph_lo, hi = args.ph_hi;
#ifndef ONLY_PT
#define ONLY_PT -1
#endif
#define PT_ON(t) (ONLY_PT < 0 || ONLY_PT == (t))
#define IN(k) (lo <= (k) && (k) < hi)
#define SEAM(k) do { if (IN(k) && IN((k) + 1)) xcd_barrier(bar); } while (0)
    if (PT_ON(0) && IN(0)) { ph_prologue(F); }
    SEAM(0);
    for (int l = 0; l < NLAYER; ++l) {
        const int pb = 1 + 10 * l;
        if (PT_ON(1) && IN(pb + 0)) ph_norm(F, l, 0, l == 0 ? 0 : 11);
        SEAM(pb + 0);
        if (PT_ON(2) && IN(pb + 1)) { PHASE_ENTRY(); unsigned char* ws = A->ws;
            pg8::Gemm g{(const pg8::bf16_t*)(ws + WS_H), (const pg8::bf16_t*)(ws + WS_WIN) + (size_t)l * NIN_PAD * DMOD, MT, NIN_PAD, DMOD, DMOD}; pg8::TwoPartOrder S; S.init(MT, NRC_PAD / 256, (NIN_PAD - NRC_PAD) / 256, F.G, F.bid, F.G == 256 ? (unsigned*)(F.ctl + CW_QUEUE + 1024 + 64 * l) : nullptr, 1 + (F.bid + 256 < (MT / 256) * (NRC_PAD / 256) ? 1 : 0));
            pg8::EpiIn E{ws, A->out, l, 0.125f * 1.4426950408889634f};
            pg8::gemm_phase<pg8::EpiIn, pg8::TwoPartOrder, true, true>(F.lds, g, S, E);
        }
        if (F.G != 256) SEAM(pb + 1);
#ifdef PROBE_GEMM
        if (l == 0 && IN(pb + 2)) { probe_gemm_check(F); __syncthreads(); }
#endif
        if (PT_ON(3) && IN(pb + 2)) ph_rwkv_passA(F, l);
        SEAM(pb + 2);
#ifdef PROBE_SEQ
        if (IN(pb + 3)) { probe_seq_scan(F, l); __syncthreads(); }
#endif
        if (PT_ON(4) && IN(pb + 3)) { ph_rwkv_chain(F, l); ph_attn_sample(F, l); ph_attn_prompt(F, l); }
        SEAM(pb + 3);
#ifdef PROBE_SEQ
        if (IN(pb + 4) && F.bid == 0) { PHASE_ENTRY();
            for (int h = F.wave; h < 16; h += NWAVES) { const float* a = (const float*)(A->ws + WS_HALO) + (size_t)h * 4096; const float* b = A->out + O_WP + (size_t)(l * 16 + h) * 4096; float n = 0.f, d = 0.f;
                for (int i = F.lane; i < 4096; i += 64) { n += (a[i] - b[i]) * (a[i] - b[i]); d += b[i] * b[i]; }
                n = wave_sum(n); d = wave_sum(d); if (F.lane == 0) { ((float*)(A->ws + WS_CTL))[16400 + 16 * l + h] = sqrtf(n / d); ((float*)(A->ws + WS_CTL))[16440 + 16 * l + h] = d; } } }
#endif
        if (PT_ON(5) && IN(pb + 4)) { ph_rwkv_passC(F, l); ph_attn_final(F, l); }
        SEAM(pb + 4);
        if (PT_ON(6) && IN(pb + 5)) { PHASE_ENTRY(); unsigned char* ws = A->ws;
            const float* X = (const float*)(ws + WS_X); const float* MODl = (const float*)(ws + WS_MOD) + (size_t)l * NMODB * MODW;
            { pg8::Gemm g{(const pg8::bf16_t*)(ws + WS_YCAT), (const pg8::bf16_t*)(ws + WS_WOUT) + (size_t)l * DMOD * DMOD, MP, DMOD, DMOD, DMOD}; pg8::StaticOrder S; S.init(MP, DMOD, F.G, F.bid);
              pg8::EpiRes E{l == 0 ? A->in[I_XP] : X, X + (size_t)MP * DMOD, (float*)(ws + WS_X), MODl + 2 * DMOD};
              pg8::gemm_phase<pg8::EpiRes, pg8::StaticOrder, true, true>(F.lds, g, S, E); }
            { pg8::Gemm g{(const pg8::bf16_t*)(ws + WS_YCAT) + (size_t)MP * DMOD, (const pg8::bf16_t*)(ws + WS_WOUT) + (size_t)l * DMOD * DMOD, 256, DMOD, DMOD / 8, DMOD}; pg8::SplitOrder S; S.init(DMOD, 8, F.bid);
              pg8::EpiResSlab E{(float*)(ws + WS_SLAB), MODl + 2 * DMOD};
              pg8::gemm_phase<pg8::EpiResSlab, pg8::SplitOrder, true, true>(F.lds, g, S, E); }
        }
        SEAM(pb + 5);
        if (PT_ON(7) && IN(pb + 6)) ph_norm(F, l, 1, 8);
        SEAM(pb + 6);
        if (PT_ON(8) && IN(pb + 7)) { PHASE_ENTRY(); unsigned char* ws = A->ws;
            pg8::Gemm g{(const pg8::bf16_t*)(ws + WS_H), (const pg8::bf16_t*)(ws + WS_WUP) + (size_t)l * NUP * DMOD, MT, NUP, DMOD, DMOD}; pg8::PmFirstOrder S; S.init(MT, NUP, F.G, F.bid, F.G == 256 ? (unsigned*)(F.ctl + CW_QUEUE + 1536 + 64 * l) : nullptr);
            pg8::EpiUp E{(pg8::bf16_t*)(ws + WS_ACT), A->in[I_CONVW] + (size_t)l * 3 * DFF, A->in[I_CONVB] + (size_t)l * DFF, A->in[I_SCONV] + (size_t)l * NSB * 2 * DFF,
                         (float*)(ws + WS_HALO), A->out + O_CP + (size_t)l * 2 * DFF, A->out + O_CS + (size_t)l * NSB * 2 * DFF, (PG8_LAS float*)(F.lds + HALO_OFF)};
            pg8::gemm_phase<pg8::EpiUp, pg8::PmFirstOrder, true, true>(F.lds, g, S, E);
            { int first = 0, nw = F.G;
              if (F.G == 256) { first = 256 - ((256 * 6) - (MT / 256) * (NUP / 256)); nw = 256 - first; if (F.bid >= first) wait_count(F, (unsigned*)(F.ctl + CW_QUEUE + 1536 + 64 * l), (unsigned)(NUP / 256)); }
              else if (!MK_SPLIT) xcd_barrier(bar);
              const float* MODl = (const float*)(ws + WS_MOD) + (size_t)l * NMODB * MODW;
              pg8::Gemm g2{(const pg8::bf16_t*)(ws + WS_ACT) + (size_t)MP * DFF, (const pg8::bf16_t*)(ws + WS_WDN) + (size_t)l * DMOD * DFF, 256, DMOD, DFF / 11, DFF}; pg8::TailSplitOrder S2; S2.init(DMOD, 11, F.bid, first, nw);
              pg8::EpiResSlab E2{(float*)(ws + WS_SLAB), MODl + 5 * DMOD};
              pg8::gemm_phase<pg8::EpiResSlab, pg8::TailSplitOrder, true, true>(F.lds, g2, S2, E2); }
        }
        SEAM(pb + 7);
        if (PT_ON(9) && IN(pb + 8)) ph_fixup(F, l);
        SEAM(pb + 8);
        if (PT_ON(10) && IN(pb + 9)) { PHASE_ENTRY(); unsigned char* ws = A->ws;
            const float* X = (const float*)(ws + WS_X); const float* MODl = (const float*)(ws + WS_MOD) + (size_t)l * NMODB * MODW;
            { pg8::Gemm g{(const pg8::bf16_t*)(ws + WS_ACT), (const pg8::bf16_t*)(ws + WS_WDN) + (size_t)l * DMOD * DFF, MP, DMOD, DFF, DFF}; pg8::StaticOrder S; S.init(MP, DMOD, F.G, F.bid);
              pg8::EpiRes E{X, X + (size_t)MP * DMOD, (float*)(ws + WS_X), MODl + 5 * DMOD};
              pg8::gemm_phase<pg8::EpiRes, pg8::StaticOrder, true, true>(F.lds, g, S, E); }
        }
        SEAM(pb + 9);
    }
    if (PT_ON(11) && IN(21)) ph_norm(F, 0, 2, 11);
#ifdef PROBE_MASK
    if (IN(22)) { PHASE_ENTRY();
        const size_t offs[13] = {O_YP, O_YS, O_KP, O_VP, O_WP, O_SP, O_CP, O_KS, O_VS, O_WS, O_SS, O_CS, O_END};
        const size_t gt = (size_t)F.bid * (NWAVES * 64) + F.tid, ngt = (size_t)F.G * NWAVES * 64;
#ifndef PROBE_SCALE
#define PROBE_SCALE 1.2f
#endif
#ifndef PROBE_HALF
#define PROBE_HALF 2
#endif
#ifdef PROBE_HEADS
        { const float* dh = (const float*)(A->ws + WS_CTL) + 16400; float best = -1.f; int bi = 0;
#if PROBE_HEADS == 3
          bi = 0; best = dh[PROBE_IDX] * 20.f;
#elif PROBE_HEADS == 1
          for (int i = 0; i < 32; ++i) if (dh[i] > best) { best = dh[i]; bi = i; }
#else
          for (int i = 0; i < 32; ++i) if (dh[i] * dh[i] * dh[40 + i] > best) { best = dh[i] * dh[i] * dh[40 + i]; bi = i; } best = dh[bi];
#endif
          const float val = (PROBE_HEADS == 3) ? best : 0.05f * bi + fminf(best, 0.049f); const float fsc = 1.f + val; for (size_t i = O_YP + gt; i < O_YS; i += ngt) A->out[i] *= fsc; }
#endif
#ifdef PROBE_GEMM
        { const float dd = ((const float*)(A->ws + WS_CTL))[16384]; const float fsc = 1.f + PROBE_AMP * dd; for (size_t i = O_YP + gt; i < O_YS; i += ngt) A->out[i] *= fsc; }
#endif
        for (int o = 0; o < 12; ++o) if ((PROBE_MASK >> o) & 1) { size_t b = offs[o], e = offs[o + 1]; const size_t mid = b + (e - b) / 2;
            if (PROBE_HALF == 0) e = mid; if (PROBE_HALF == 1) b = mid;
            for (size_t i = b + gt; i < e; i += ngt) A->out[i] *= PROBE_SCALE; } }
#endif
#undef IN
#undef SEAM
}

extern "C" void kernel_launch(void* const* d_in, const int* in_sizes, int n_in, void* d_out, int out_size, void* d_ws, size_t ws_size, hipStream_t stream) {
    static int grid = 0;
    if (grid == 0) {
        if (n_in != 37 || (size_t)out_size != O_END || ws_size < WS_END) { fprintf(stderr, "kernel_launch: built for 37 inputs, %zu outputs, >= %zu bytes of workspace; got n_in %d, out %d, ws %zu; nothing launched\n", (size_t)O_END, (size_t)WS_END, n_in, out_size, ws_size); grid = -1; return; }
        int dev = 0, cus = 0, per_cu = 0;
        if (hipGetDevice(&dev) != hipSuccess || hipDeviceGetAttribute(&cus, hipDeviceAttributeMultiprocessorCount, dev) != hipSuccess) { fprintf(stderr, "kernel_launch: device query failed\n"); grid = -1; return; }
        if (hipFuncSetAttribute((const void*)hybrid_fwd, hipFuncAttributeMaxDynamicSharedMemorySize, LDS_BYTES) != hipSuccess) { fprintf(stderr, "kernel_launch: hipFuncSetAttribute failed\n"); grid = -1; return; }
        if (hipOccupancyMaxActiveBlocksPerMultiprocessor(&per_cu, (const void*)hybrid_fwd, NWAVES * 64, LDS_BYTES) != hipSuccess || per_cu < 1) fprintf(stderr, "kernel_launch: note: occupancy query reports %d workgroups per CU\n", per_cu);
        (void)hipGetLastError();
        grid = cus;
    }
    if (grid < 0) return;
    if (hipMemsetAsync((char*)d_ws + WS_CTL, 0, CTL_ZERO_BYTES, stream) != hipSuccess) { fprintf(stderr, "kernel_launch: memset failed\n"); return; }
    Args a{};
    for (int i = 0; i < 37; ++i) a.in[i] = (const float*)d_in[i];
    a.out = (float*)d_out; a.ws = (unsigned char*)d_ws;
#if MK_SPLIT
#ifdef PROBE_MASK
    const int n_launch = N_PHASES + 1;
#else
    const int n_launch = N_PHASES;
#endif
    for (int p = 0; p < n_launch; ++p) { a.ph_lo = p; a.ph_hi = p + 1; hipLaunchKernelGGL(hybrid_fwd, dim3(grid), dim3(NWAVES * 64), LDS_BYTES, stream, a); }
#else
    a.ph_lo = 0; a.ph_hi = N_PHASES; hipLaunchKernelGGL(hybrid_fwd, dim3(grid), dim3(NWAVES * 64), LDS_BYTES, stream, a);
#endif
    const hipError_t le = hipPeekAtLastError();
    if (le != hipSuccess) fprintf(stderr, "kernel_launch: launch failed: %s\n", hipGetErrorName(le));
}
```

```cpp
#include <hip/hip_runtime.h>
#include <hip/hip_bf16.h>
#include <cstdio>
#include <cstdint>
#include <cmath>
constexpr int NWAVES = 8;
constexpr int DMOD = 2048, MP = 8192, NSB = 16, TS = 16, MT = MP + NSB * TS  , PAST = 2048;
constexpr int NRC = 3520, NRC_PAD = 3584, NIN = 6592, NIN_PAD = 6656, DFF = 5632, NUP = 2 * DFF;
constexpr int NLAYER = 2, NMODB = 17, MODW = 6 * DMOD;
constexpr int RW_UNITS = 128 * 16 + NSB * 16;
constexpr size_t O_YP = 0, O_YS = O_YP + (size_t)MP * DMOD, O_KP = O_YS + (size_t)NSB * TS * DMOD, O_VP = O_KP + (size_t)NLAYER * MP * 1024, O_WP = O_VP + (size_t)NLAYER * MP * 1024,
                 O_SP = O_WP + (size_t)NLAYER * 16 * 4096, O_CP = O_SP + (size_t)NLAYER * NRC, O_KS = O_CP + (size_t)NLAYER * 2 * DFF, O_VS = O_KS + (size_t)NLAYER * 256 * 1024,
                 O_WS = O_VS + (size_t)NLAYER * 256 * 1024, O_SS = O_WS + (size_t)NLAYER * NSB * 16 * 4096, O_CS = O_SS + (size_t)NLAYER * NSB * NRC, O_END = O_CS + (size_t)NLAYER * NSB * 2 * DFF;
constexpr size_t MiB = 1u << 20;
constexpr size_t WS_CTL = 0, CTL_ZERO_BYTES = 1 * MiB;
constexpr size_t WS_MOD = 1 * MiB;
constexpr size_t WS_LORA = 3 * MiB, LORA_LAYER = (size_t)1024 * 448 * 2;
constexpr size_t WS_WIN = 5 * MiB, WS_WOUT = 57 * MiB, WS_WUP = 73 * MiB, WS_WDN = 161 * MiB;
constexpr size_t WS_H = 205 * MiB, WS_PR = 238 * MiB, WS_QB = 354 * MiB, WS_KB = 371 * MiB, WS_VB = 388 * MiB, WS_OATT = 405 * MiB, WS_YCAT = 471 * MiB, WS_X = 504 * MiB, WS_ACT = 570 * MiB;
constexpr size_t WS_PT = 661 * MiB, WS_QQ = 679 * MiB, WS_RP = 715 * MiB, WS_YV = 733 * MiB, WS_SC = 769 * MiB, WS_G1 = 787 * MiB, WS_G2 = 820 * MiB, WS_HALO = 853 * MiB, WS_WL = 858 * MiB, WS_PT32 = 859 * MiB, WS_LSCR = 895 * MiB, WS_SLAB = 911 * MiB, WS_END = 935 * MiB;
static_assert(WS_WIN + (size_t)2 * NIN_PAD * DMOD * 2 <= WS_WOUT && WS_WOUT + (size_t)2 * DMOD * DMOD * 2 <= WS_WUP && WS_WUP + (size_t)2 * NUP * DMOD * 2 <= WS_WDN && WS_WDN + (size_t)2 * DMOD * DFF * 2 <= WS_H, "weights map");
static_assert(WS_H + (size_t)MT * DMOD * 2 <= WS_PR && WS_PR + (size_t)MT * NRC_PAD * 4 <= WS_QB && WS_QB + (size_t)MT * 1024 * 2 <= WS_KB && WS_VB + (size_t)MT * 1024 * 2 <= WS_OATT && WS_OATT + (size_t)MT * DMOD * 4 <= WS_YCAT, "act map 1");
static_assert(WS_YCAT + (size_t)MT * DMOD * 2 <= WS_X && WS_X + (size_t)MT * DMOD * 4 <= WS_ACT && WS_ACT + (size_t)MT * DFF * 2 <= WS_PT, "act map 2");
static_assert(WS_PT + (size_t)RW_UNITS * 8192 <= WS_QQ && WS_QQ + (size_t)RW_UNITS * 16384 <= WS_RP && WS_RP + (size_t)RW_UNITS * 8192 <= WS_YV && WS_YV + (size_t)RW_UNITS * 16384 <= WS_SC && WS_SC + (size_t)RW_UNITS * 8192 <= WS_G1, "rwkv map");
static_assert(WS_G1 + (size_t)MT * 1024 * 4 <= WS_G2 && WS_G2 + (size_t)MT * 1024 * 4 <= WS_HALO && WS_HALO + (size_t)3 * 32 * 2 * DFF * 4 <= WS_WL && WS_WL + (size_t)RW_UNITS * 256 <= WS_PT32 && WS_PT32 + (size_t)RW_UNITS * 16384 <= WS_LSCR && WS_LSCR + (size_t)256 * 61440 <= WS_SLAB && WS_SLAB + (size_t)11 * 256 * 2048 * 4 <= WS_END && WS_LORA + 2 * LORA_LAYER <= WS_WIN && WS_MOD + (size_t)NLAYER * NMODB * MODW * 4 <= WS_LORA, "map 3");
constexpr int CW_BAR = 4096, CW_QUEUE = 8192;
constexpr int LDS_BYTES = 163840;
constexpr int MISC_OFF = LDS_BYTES - 256;
constexpr int LUT_OFF = 131072;
constexpr int HALO_OFF = 131072;
constexpr int RW_SLOT = 9216, RW_STRIDE = 72;
constexpr int RW_SCR = 154624;
static_assert(RW_SCR + 4096 <= MISC_OFF && HALO_OFF + 4096 <= MISC_OFF, "LDS map");

#define GAS __attribute__((address_space(1)))
#define LAS __attribute__((address_space(3)))
typedef unsigned short bf16;
typedef unsigned v4u __attribute__((ext_vector_type(4)));
typedef unsigned v2u __attribute__((ext_vector_type(2)));
typedef float f32x4 __attribute__((ext_vector_type(4)));
typedef float f32x2 __attribute__((ext_vector_type(2)));
typedef short bf16x8 __attribute__((ext_vector_type(8)));
typedef GAS unsigned gu32;
#define RLX_AGENT __ATOMIC_RELAXED, __HIP_MEMORY_SCOPE_AGENT
#define LDS_WAIT() asm volatile("s_waitcnt lgkmcnt(0)" ::: "memory")
#define VM_WAIT() asm volatile("s_waitcnt vmcnt(0)" ::: "memory")
typedef float cvt_f32x2 __attribute__((ext_vector_type(2))); typedef __bf16 cvt_bf16x2 __attribute__((ext_vector_type(2)));
__device__ __forceinline__ unsigned pk2(float lo, float hi) { const cvt_f32x2 v = {lo, hi}; return __builtin_bit_cast(unsigned, __builtin_convertvector(v, cvt_bf16x2)); }
__device__ __forceinline__ unsigned f2bf(float f) { return pk2(f, 0.f) & 0xffffu; }
__device__ __forceinline__ float bf2f(unsigned short b) { return __builtin_bit_cast(float, (unsigned)b << 16); }
template <int K> __device__ __forceinline__ float swz_xor(float v) { static_assert(K >= 1 && K <= 16, "");
    return __builtin_bit_cast(float, __builtin_amdgcn_ds_swizzle(__builtin_bit_cast(int, v), (K << 10) | 0x1f)); }
struct PL32 { float a, b; };
__device__ __forceinline__ PL32 pl32(float v) { const int ln = (int)(threadIdx.x & 63);
    const float p = __builtin_bit_cast(float, __builtin_amdgcn_ds_bpermute((ln ^ 32) << 2, __builtin_bit_cast(int, v))); PL32 o; o.a = v; o.b = p; return o; }
__device__ __forceinline__ float xor32(float v) { return pl32(v).b; }
template <int CTRL> __device__ __forceinline__ float dpp_f(float v) { return __builtin_bit_cast(float, __builtin_amdgcn_update_dpp(__builtin_bit_cast(int, v), __builtin_bit_cast(int, v), CTRL, 0xF, 0xF, false)); }
__device__ __forceinline__ float wave_sum(float v) {
    v += dpp_f<0xB1>(v); v += dpp_f<0x4E>(v); v += dpp_f<0x141>(v); v += dpp_f<0x128>(v); v += swz_xor<16>(v);
    const PL32 r = pl32(v); return r.a + r.b;
}
__device__ __forceinline__ float wave_max(float v) {
    v = fmaxf(v, dpp_f<0xB1>(v)); v = fmaxf(v, dpp_f<0x4E>(v)); v = fmaxf(v, dpp_f<0x141>(v)); v = fmaxf(v, dpp_f<0x128>(v)); v = fmaxf(v, swz_xor<16>(v));
    const PL32 r = pl32(v); return fmaxf(r.a, r.b);
}
__device__ __forceinline__ float sigmoidf_(float x) { return __builtin_amdgcn_rcpf(1.f + __expf(-x)); }
namespace pg8 {
#define PG8_LAS __attribute__((address_space(3)))
typedef unsigned short bf16_t;
typedef short bf16x8 __attribute__((ext_vector_type(8)));
typedef float f32x4 __attribute__((ext_vector_type(4)));
typedef unsigned u32x4 __attribute__((ext_vector_type(4)));
constexpr int BM = 256, BK = 64, HALF = 128, HTB = HALF * BK * 2  , STAGE_BYTES = 8 * HTB, NXCD = 8, WGM = 8;

__host__ __device__ __forceinline__ int lds_byte(int r, int c) { const int st = (r >> 4) * 2 + (c >> 5), rr = r & 15, cc = c & 31, ob = rr * 64 + cc * 2; return st * 1024 + (ob ^ (((ob >> 9) & 1) << 5)); }
__host__ __device__ __forceinline__ void stage_rc(int b, int& R, int& C) { const int st = b / 1024, sb = b % 1024, swz = sb ^ (((sb >> 9) & 1) << 5); R = (st >> 1) * 16 + swz / 64; C = (st & 1) * 32 + (swz % 64) / 2; }
__host__ __device__ __forceinline__ int perm32(int rho) { const int n = rho >> 4, i = rho & 15; return 8 * (i >> 2) + 4 * n + (i & 3); }

struct Unit { int pm, pn, ks, tag; };
struct Gemm { const bf16_t* A; const bf16_t* Bt; int M, N, K, ld; };

struct StaticOrder {
    static constexpr bool HANDOFF = false;
    int nM, nN, nwg, G, c;
    __host__ __device__ void init(int M, int N, int G_, int c_) { nM = M / BM; nN = N / BM; nwg = nM * nN; G = G_; c = c_; }
    __host__ __device__ bool next(int i, Unit& u) const {
        const long L = (long)i * G + c; if (L >= nwg) return false;
        int wgid = (int)L; { const int q = nwg / NXCD, r = nwg % NXCD, xcd = wgid % NXCD, off = wgid / NXCD; wgid = (xcd < r ? xcd * (q + 1) : r * (q + 1) + (xcd - r) * q) + off; }
        const int nig = WGM * nN, gid = wgid / nig, fm = gid * WGM, gsz = (nM - fm) < WGM ? (nM - fm) : WGM;
        u.pm = fm + ((wgid % nig) % gsz); u.pn = (wgid % nig) / gsz; u.ks = 0; u.tag = 0; return true;
    }
    __device__ __forceinline__ void a_ready(const Unit&) const {}
    __device__ __forceinline__ void done(const Unit&) const {}
};

struct TwoPartOrder {
    static constexpr bool HANDOFF = true;
    int nM, nA, nB, G, c; unsigned* cnt; int nsig;
    __device__ __forceinline__ void mid(const Unit& u, int t, int nt, int wid, int lane) const {
        if (cnt == nullptr || u.tag != 2) return;
        if (t == nt / 2) asm volatile("s_waitcnt vmcnt(0)" ::: "memory");
        if (t == nt / 2 + 2 && wid == 0) { __builtin_amdgcn_fence(__ATOMIC_RELEASE, "agent"); asm volatile("s_waitcnt vmcnt(0)" ::: "memory");
            if (lane == 0) (void)__hip_atomic_fetch_add(cnt, (unsigned)nsig, __ATOMIC_RELAXED, __HIP_MEMORY_SCOPE_AGENT); }
    }
    __host__ __device__ void init(int M, int NA, int NB, int G_, int c_, unsigned* cnt_, int nsig_) { nM = M / BM; nA = NA; nB = NB; G = G_; c = c_; cnt = cnt_; nsig = nsig_; }
    __host__ __device__ static void map(int wgid, int nM, int nN, Unit& u) {
        const int nwg = nM * nN; { const int q = nwg / NXCD, r = nwg % NXCD, xcd = wgid % NXCD, off = wgid / NXCD; wgid = (xcd < r ? xcd * (q + 1) : r * (q + 1) + (xcd - r) * q) + off; }
        const int nig = WGM * nN, gid = wgid / nig, fm = gid * WGM, gsz = (nM - fm) < WGM ? (nM - fm) : WGM;
        u.pm = fm + ((wgid % nig) % gsz); u.pn = (wgid % nig) / gsz; u.ks = 0;
    }
    __host__ __device__ bool next(int i, Unit& u) const {
        const long L = (long)i * G + c; const int na = nM * nA, nb = nM * nB; if (L >= na + nb) return false;
        if (L < na) map((int)L, nM, nA, u); else { map((int)L - na, nM, nB, u); u.pn += nA; }
        u.tag = i; return true;
    }
    __device__ __forceinline__ void a_ready(const Unit&) const {}
    __device__ __forceinline__ void done(const Unit&) const {}
};

struct PmFirstOrder {
    static constexpr bool HANDOFF = true;
    int nM, nN, G, c; unsigned* cnt;
    __host__ __device__ void init(int M, int N, int G_, int c_, unsigned* cnt_) { nM = M / BM; nN = N / BM; G = G_; c = c_; cnt = cnt_; }
    __host__ __device__ __forceinline__ bool next(int i, Unit& u) const {
        const long L = (long)i * G + c; if (L >= (long)nM * nN) return false;
        if (L < nN) { u.pm = nM - 1; u.pn = (int)L; u.ks = 0; } else TwoPartOrder::map((int)L - nN, nM - 1, nN, u);
        u.tag = i; return true;
    }
    __device__ __forceinline__ void a_ready(const Unit&) const {}
    __device__ __forceinline__ void done(const Unit&) const {}
    __device__ __forceinline__ void mid(const Unit& u, int t, int nt, int wid, int lane) const {
        if (cnt == nullptr || u.tag != 1 || c >= nN) return;
        if (t == nt / 2) asm volatile("s_waitcnt vmcnt(0)" ::: "memory");
        if (t == nt / 2 + 2 && wid == 0) { __builtin_amdgcn_fence(__ATOMIC_RELEASE, "agent"); asm volatile("s_waitcnt vmcnt(0)" ::: "memory");
            if (lane == 0) (void)__hip_atomic_fetch_add(cnt, 1u, __ATOMIC_RELAXED, __HIP_MEMORY_SCOPE_AGENT); }
    }
};
struct TailSplitOrder {
    static constexpr bool HANDOFF = false;
    int n, KS, k, nw;
    __host__ __device__ void init(int N, int KS_, int c_, int first, int nw_) { n = (N / BM) * KS_; KS = KS_; k = c_ - first; nw = nw_; }
    __host__ __device__ __forceinline__ bool next(int i, Unit& u) const { const int L = k + i * nw; if (k < 0 || L >= n) return false; u.pm = 0; u.pn = L / KS; u.ks = L % KS; u.tag = 0; return true; }
    __device__ __forceinline__ void a_ready(const Unit&) const {}
    __device__ __forceinline__ void done(const Unit&) const {}
};

struct SplitOrder {
    static constexpr bool HANDOFF = false;
    int n, KS, c;
    __host__ __device__ void init(int N, int KS_, int c_) { n = (N / BM) * KS_; KS = KS_; c = c_; }
    __host__ __device__ bool next(int i, Unit& u) const { if (i > 0 || c >= n) return false; u.pm = 0; u.pn = c / KS; u.ks = c % KS; u.tag = 0; return true; }
    __device__ __forceinline__ void a_ready(const Unit&) const {}
    __device__ __forceinline__ void done(const Unit&) const {}
};
__device__ __forceinline__ unsigned cvt_pk_bf16(float lo, float hi) { unsigned r; asm volatile("v_cvt_pk_bf16_f32 %0, %1, %2" : "=v"(r) : "v"(lo), "v"(hi)); return r; }
typedef float f32x2 __attribute__((ext_vector_type(2)));
__device__ __forceinline__ f32x2 gelu_pk(f32x2 v) {
    const f32x2 av = __builtin_elementwise_abs(v), d = av * 0.2316418882f + 1.0f;
    f32x2 t; t.x = __builtin_amdgcn_rcpf(d.x); t.y = __builtin_amdgcn_rcpf(d.y);
    f32x2 q = t * 0.5307027145f + (-0.7265760135f); q = q * t + 0.7107068705f; q = q * t + (-0.142248368f); q = q * t + 0.127414796f; q = q * t;
    const f32x2 s = (v * v) * (-0.72134752044f);
    f32x2 e; e.x = __builtin_amdgcn_exp2f(s.x); e.y = __builtin_amdgcn_exp2f(s.y);
    const f32x2 m = v * (q * e), r = v - m;
    f32x2 o; o.x = v.x < 0.f ? m.x : r.x; o.y = v.y < 0.f ? m.y : r.y; return o;
}

template <class Epi, class Sched, bool ALIGN_EPI = false, bool SP2 = false>
__device__ __forceinline__ void gemm_phase(PG8_LAS unsigned char* lds, const Gemm g, const Sched& S, const Epi& E) {
    int tid_ = threadIdx.x; asm volatile("" : "+v"(tid_));
    const int tid = tid_, wid = __builtin_amdgcn_readfirstlane(tid >> 6), lane = tid & 63, wr = wid >> 2, wc = wid & 3, fr = lane & 15, fq = lane >> 4;
    const int K = g.ld, nt = g.K / BK;
    unsigned voffA[2], voffB[2];
#pragma unroll
    for (int i = 0; i < 2; ++i) { int R, C; stage_rc(tid * 16 + i * 8192, R, C); const int Rb = Epi::PERM ? ((R & ~31) + perm32(R & 31)) : R;
        voffA[i] = (unsigned)(R * K + C) * 2u; voffB[i] = (unsigned)(Rb * K + C) * 2u; }
    const size_t kstep = (size_t)(BK * 2);
    const size_t hstep = (size_t)HALF * K * 2;
    const size_t tstep = 2 * hstep;
    const unsigned ldsw = (unsigned)wid * 1024u;
    const int aoff = lds_byte(wr * 64 + fr, fq * 8), boff = lds_byte(wc * 32 + fr, fq * 8);
#define PG8_SA(b, h) (((b) * 2 + (h)) * HTB)
#define PG8_SB(b, h) ((4 + (b) * 2 + (h)) * HTB)
#define PG8_STAGE(bufoff, gbase, voff) do { _Pragma("unroll") for (int _i = 0; _i < 2; ++_i) \
        __builtin_amdgcn_global_load_lds((const unsigned*)((const char*)(gbase) + (voff)[_i]), (PG8_LAS unsigned*)(lds + (bufoff) + ldsw + _i * 8192), 16, 0, 0); } while (0)
#define PG8_LDA(dst, b, h) do { _Pragma("unroll") for (int m = 0; m < 4; ++m) _Pragma("unroll") for (int k = 0; k < 2; ++k) dst[m][k] = *(const PG8_LAS bf16x8*)(lds + PG8_SA(b, h) + aoff + m * 2048 + k * 1024); } while (0)
#define PG8_LDB(dst, b, h) do { _Pragma("unroll") for (int n = 0; n < 2; ++n) _Pragma("unroll") for (int k = 0; k < 2; ++k) dst[n][k] = *(const PG8_LAS bf16x8*)(lds + PG8_SB(b, h) + boff + n * 2048 + k * 1024); } while (0)
#define PG8_MMA(ai, bj, At, Bt) do { __builtin_amdgcn_s_setprio(1); _Pragma("unroll") for (int m = 0; m < 4; ++m) _Pragma("unroll") for (int n = 0; n < 2; ++n) _Pragma("unroll") for (int k = 0; k < 2; ++k) \
        acc[ai][bj][m][n] = __builtin_amdgcn_mfma_f32_16x16x32_bf16(Bt[n][k], At[m][k], acc[ai][bj][m][n], 0, 0, 0); __builtin_amdgcn_s_setprio(0); } while (0)
#define PG8_WAIT_V(n) asm volatile("s_waitcnt vmcnt(" #n ")" ::: "memory")
#define PG8_WAIT_L(n) asm volatile("s_waitcnt lgkmcnt(" #n ")" ::: "memory")
#define PG8_BAR __builtin_amdgcn_s_barrier()
#define PG8_SCHED __builtin_amdgcn_sched_barrier(0)
    Unit cur, nxt; int ui = 0;
    if (!S.next(0, cur)) return;
    f32x4 acc[2][2][4][2];
#pragma unroll
    for (int a = 0; a < 2; ++a)
#pragma unroll
        for (int b = 0; b < 2; ++b)
#pragma unroll
            for (int m = 0; m < 4; ++m)
#pragma unroll
                for (int n = 0; n < 2; ++n) acc[a][b][m][n] = (f32x4){0.f, 0.f, 0.f, 0.f};
    bf16x8 At[4][2], B0[2][2], B1[2][2];
    const size_t sstep = (size_t)g.K * 2;
    const char* cA = (const char*)g.A + (size_t)cur.pm * tstep + (size_t)cur.ks * sstep; const char* cB = (const char*)g.Bt + (size_t)cur.pn * tstep + (size_t)cur.ks * sstep;
    S.a_ready(cur);
    if constexpr (SP2) {
        PG8_STAGE(PG8_SB(0, 0), cB, voffB); PG8_STAGE(PG8_SB(0, 1), cB + hstep, voffB); PG8_STAGE(PG8_SA(0, 0), cA, voffA); PG8_STAGE(PG8_SA(0, 1), cA + hstep, voffA);
        if (wr == 1) PG8_BAR;
        PG8_WAIT_V(2); PG8_BAR;
        PG8_STAGE(PG8_SB(1, 0), cB + kstep, voffB); PG8_STAGE(PG8_SA(1, 0), cA + kstep, voffA); PG8_STAGE(PG8_SB(1, 1), cB + hstep + kstep, voffB);
        PG8_WAIT_V(6); PG8_BAR;
    } else {
        PG8_STAGE(PG8_SB(0, 0), cB, voffB); PG8_STAGE(PG8_SA(0, 0), cA, voffA); PG8_STAGE(PG8_SB(0, 1), cB + hstep, voffB); PG8_STAGE(PG8_SA(0, 1), cA + hstep, voffA);
        if (wr == 1) PG8_BAR;
        PG8_WAIT_V(4); PG8_BAR;
        PG8_STAGE(PG8_SB(1, 0), cB + kstep, voffB); PG8_STAGE(PG8_SA(1, 0), cA + kstep, voffA); PG8_STAGE(PG8_SB(1, 1), cB + hstep + kstep, voffB);
        PG8_WAIT_V(6); PG8_BAR;
    }
    for (;;) {
        const bool has_next = S.next(ui + 1, nxt);
        const char* nA = has_next ? (const char*)g.A + (size_t)nxt.pm * tstep + (size_t)nxt.ks * sstep : cA; const char* nB = has_next ? (const char*)g.Bt + (size_t)nxt.pn * tstep + (size_t)nxt.ks * sstep : cB;
        for (int t = 0; t < nt; t += 2) {
            const bool last = (t == nt - 2);
            const char* a1 = cA + (size_t)(t + 1) * kstep;
            const char* a2 = last ? nA : cA + (size_t)(t + 2) * kstep; const char* b2 = last ? nB : cB + (size_t)(t + 2) * kstep;
            const char* a3 = a2 + kstep; const char* b3 = b2 + kstep;
            if (last && has_next) S.a_ready(nxt);
            if constexpr (Sched::HANDOFF) S.mid(cur, t, nt, wid, lane);
            if constexpr (SP2) {
            PG8_LDB(B0, 0, 0); PG8_LDB(B1, 0, 1); PG8_SCHED; PG8_LDA(At, 0, 0); PG8_STAGE(PG8_SA(1, 1), a1 + hstep, voffA);
            PG8_WAIT_V(8); PG8_WAIT_L(0); PG8_BAR; PG8_MMA(0, 0, At, B0); PG8_MMA(0, 1, At, B1); PG8_BAR; PG8_SCHED;
            PG8_LDA(At, 0, 1); PG8_STAGE(PG8_SB(0, 0), b2, voffB); PG8_STAGE(PG8_SB(0, 1), b2 + hstep, voffB); PG8_STAGE(PG8_SA(0, 0), a2, voffA);
            PG8_WAIT_V(8); PG8_WAIT_L(0); PG8_BAR; PG8_MMA(1, 0, At, B0); PG8_MMA(1, 1, At, B1); PG8_BAR; PG8_SCHED;
            PG8_LDB(B0, 1, 0); PG8_LDB(B1, 1, 1); PG8_SCHED; PG8_LDA(At, 1, 0); PG8_STAGE(PG8_SA(0, 1), a2 + hstep, voffA);
            PG8_WAIT_V(8); PG8_WAIT_L(0); PG8_BAR; PG8_MMA(0, 0, At, B0); PG8_MMA(0, 1, At, B1); PG8_BAR; PG8_SCHED;
            PG8_LDA(At, 1, 1); PG8_STAGE(PG8_SB(1, 0), b3, voffB); PG8_STAGE(PG8_SB(1, 1), b3 + hstep, voffB); PG8_STAGE(PG8_SA(1, 0), a3, voffA);
            PG8_WAIT_V(8); PG8_WAIT_L(0); PG8_BAR; PG8_MMA(1, 0, At, B0); PG8_MMA(1, 1, At, B1); PG8_BAR; PG8_SCHED;
            } else {
            PG8_LDB(B0, 0, 0); PG8_SCHED; PG8_LDA(At, 0, 0); PG8_STAGE(PG8_SA(1, 1), a1 + hstep, voffA);
            PG8_WAIT_L(8); PG8_BAR; PG8_WAIT_L(0); PG8_MMA(0, 0, At, B0); PG8_BAR; PG8_SCHED;
            PG8_LDB(B1, 0, 1); PG8_STAGE(PG8_SB(0, 0), b2, voffB);
            PG8_BAR; PG8_WAIT_L(0); PG8_MMA(0, 1, At, B1); PG8_BAR;
            PG8_LDA(At, 0, 1); PG8_STAGE(PG8_SA(0, 0), a2, voffA);
            PG8_BAR; PG8_WAIT_L(0); PG8_MMA(1, 0, At, B0); PG8_BAR; PG8_SCHED;
            PG8_STAGE(PG8_SB(0, 1), b2 + hstep, voffB);
            PG8_WAIT_V(6); PG8_BAR; PG8_MMA(1, 1, At, B1); PG8_BAR;
            PG8_LDB(B0, 1, 0); PG8_SCHED; PG8_LDA(At, 1, 0); PG8_STAGE(PG8_SA(0, 1), a2 + hstep, voffA);
            PG8_WAIT_L(8); PG8_BAR; PG8_WAIT_L(0); PG8_MMA(0, 0, At, B0); PG8_BAR; PG8_SCHED;
            PG8_LDB(B1, 1, 1); PG8_STAGE(PG8_SB(1, 0), b3, voffB);
            PG8_BAR; PG8_WAIT_L(0); PG8_MMA(0, 1, At, B1); PG8_BAR;
            PG8_LDA(At, 1, 1); PG8_STAGE(PG8_SA(1, 0), a3, voffA);
            PG8_BAR; PG8_WAIT_L(0); PG8_MMA(1, 0, At, B0); PG8_BAR; PG8_SCHED;
            PG8_STAGE(PG8_SB(1, 1), b3 + hstep, voffB);
            PG8_WAIT_V(6); PG8_BAR; PG8_MMA(1, 1, At, B1); PG8_BAR;
            }
        }
        if constexpr (ALIGN_EPI) { if (wr == 0) PG8_BAR; }
        if constexpr (!Epi::AFTER_DRAIN) { E(acc, cur, wr, wc, fr, fq); S.done(cur); }
        if (!has_next) break;
#pragma unroll
        for (int a = 0; a < 2; ++a)
#pragma unroll
            for (int b = 0; b < 2; ++b)
#pragma unroll
                for (int m = 0; m < 4; ++m)
#pragma unroll
                    for (int n = 0; n < 2; ++n) acc[a][b][m][n] = (f32x4){0.f, 0.f, 0.f, 0.f};
        cur = nxt; cA = nA; cB = nB; ++ui;
        if constexpr (ALIGN_EPI) { if (wr == 1) PG8_BAR; }
    }
    PG8_WAIT_V(0);
    if constexpr (!ALIGN_EPI) { if (wr == 0) PG8_BAR; }
    PG8_BAR;
    if constexpr (Epi::AFTER_DRAIN) { E.fused(acc, cur, wr, wc, fr, fq, lds, wid, lane); S.done(cur); }
#undef PG8_SA
#undef PG8_SB
#undef PG8_STAGE
#undef PG8_LDA
#undef PG8_LDB
#undef PG8_MMA
#undef PG8_WAIT_V
#undef PG8_WAIT_L
#undef PG8_BAR
#undef PG8_SCHED
}
}
namespace pg8 {
typedef unsigned u32x2v __attribute__((ext_vector_type(2)));
constexpr int E_MP = 8192;
struct EpiIn {
    static constexpr bool PERM = true, AFTER_DRAIN = false;
    unsigned char* ws; float* out; int l; float qscale;
    __device__ __forceinline__ void operator()(const f32x4 (&acc)[2][2][4][2], const Unit& u, int wr, int wc, int fr, int fq) const {
        asm volatile("" : "+v"(fr), "+v"(fq));
        const int row0 = u.pm * BM + wr * 64 + fr, colt = u.pn * BM + wc * 32 + 8 * fq;
        if (u.pn < 14) {
            float* PR = (float*)(ws + WS_PR); float* sh_p = out + O_SP + (size_t)l * 3520; float* sh_s = out + O_SS + (size_t)l * 16 * 3520;
#pragma unroll
            for (int ai = 0; ai < 2; ++ai)
#pragma unroll
                for (int m = 0; m < 4; ++m) { const int r = row0 + ai * HALF + m * 16;
#pragma unroll
                    for (int bj = 0; bj < 2; ++bj) { const int c = colt + bj * HALF; float* p = PR + (size_t)r * 3584 + c;
                        *(f32x4*)p = acc[ai][bj][m][0]; *(f32x4*)(p + 4) = acc[ai][bj][m][1];
                        if (c < 3520) {
                            if (r == E_MP - 1) { *(f32x4*)(sh_p + c) = acc[ai][bj][m][0]; *(f32x4*)(sh_p + c + 4) = acc[ai][bj][m][1]; }
                            if (r >= E_MP && (r & 15) == 15) { float* q = sh_s + (size_t)((r - E_MP) >> 4) * 3520 + c; *(f32x4*)q = acc[ai][bj][m][0]; *(f32x4*)(q + 4) = acc[ai][bj][m][1]; }
                        } } }
        } else {
            const int region = (u.pn - 14) >> 2, cl0 = colt - 3584 - region * 1024;
            static_assert(WS_KB - WS_QB == WS_VB - WS_KB && O_VP - O_KP == (size_t)2 * 8192 * 1024 && O_VS - O_KS == (size_t)2 * 256 * 1024, "equal spacing");
            bf16_t* B16 = (bf16_t*)(ws + WS_QB + (size_t)region * (WS_KB - WS_QB));
            const float sc = region == 0 ? qscale : 1.f;
            float* fp = out + O_KP + (size_t)(region == 2 ? 1 : 0) * (O_VP - O_KP) + (size_t)l * E_MP * 1024; float* fs = out + O_KS + (size_t)(region == 2 ? 1 : 0) * (O_VS - O_KS) + (size_t)l * 256 * 1024;
#pragma unroll
            for (int ai = 0; ai < 2; ++ai)
#pragma unroll
                for (int m = 0; m < 4; ++m) { const int r = row0 + ai * HALF + m * 16;
                    float* fo = (r < E_MP) ? fp + (size_t)r * 1024 : fs + (size_t)(r - E_MP) * 1024;
#pragma unroll
                    for (int bj = 0; bj < 2; ++bj) { const int c = cl0 + bj * HALF; const f32x4 v0 = acc[ai][bj][m][0] * sc, v1 = acc[ai][bj][m][1] * sc;
                        u32x4 w; w.x = cvt_pk_bf16(v0[0], v0[1]); w.y = cvt_pk_bf16(v0[2], v0[3]); w.z = cvt_pk_bf16(v1[0], v1[1]); w.w = cvt_pk_bf16(v1[2], v1[3]);
                        *(u32x4*)(B16 + (size_t)r * 1024 + c) = w;
                        if (region != 0) { __builtin_nontemporal_store(v0, (f32x4*)(fo + c)); __builtin_nontemporal_store(v1, (f32x4*)(fo + c + 4)); } } }
        }
    }
};
struct EpiRes {
    static constexpr bool PERM = true, AFTER_DRAIN = false;
    const float* src_p; const float* src_s; float* dst; const float* gate;
    __device__ __forceinline__ void operator()(const f32x4 (&acc)[2][2][4][2], const Unit& u, int wr, int wc, int fr, int fq) const {
        asm volatile("" : "+v"(fr), "+v"(fq));
        const int row0 = u.pm * BM + wr * 64 + fr, colt = u.pn * BM + wc * 32 + 8 * fq;
        f32x4 gt[2][2];
#pragma unroll
        for (int bj = 0; bj < 2; ++bj)
#pragma unroll
            for (int n = 0; n < 2; ++n) gt[bj][n] = *(const f32x4*)(gate + colt + bj * HALF + 4 * n);
#pragma unroll
        for (int ai = 0; ai < 2; ++ai)
#pragma unroll
            for (int mp = 0; mp < 2; ++mp) {
                f32x4 x[2][2][2];
#pragma unroll
                for (int mm = 0; mm < 2; ++mm) { const int r = row0 + ai * HALF + (2 * mp + mm) * 16; const float* s = src_p + (size_t)r * 2048 + colt;
#pragma unroll
                    for (int bj = 0; bj < 2; ++bj)
#pragma unroll
                        for (int n = 0; n < 2; ++n) x[mm][bj][n] = *(const f32x4*)(s + bj * HALF + 4 * n); }
#pragma unroll
                for (int mm = 0; mm < 2; ++mm) { const int m = 2 * mp + mm, r = row0 + ai * HALF + m * 16; float* d = dst + (size_t)r * 2048 + colt;
#pragma unroll
                    for (int bj = 0; bj < 2; ++bj)
#pragma unroll
                        for (int n = 0; n < 2; ++n) *(f32x4*)(d + bj * HALF + 4 * n) = x[mm][bj][n] + gt[bj][n] * acc[ai][bj][m][n]; }
                asm volatile("" ::: "memory");
            }
    }
};
struct EpiResSlab {
    static constexpr bool PERM = true, AFTER_DRAIN = false;
    float* slab; const float* gate;
    __device__ __forceinline__ void operator()(const f32x4 (&acc)[2][2][4][2], const Unit& u, int wr, int wc, int fr, int fq) const {
        asm volatile("" : "+v"(fr), "+v"(fq));
        const int row0 = wr * 64 + fr, colt = u.pn * BM + wc * 32 + 8 * fq;
#pragma unroll
        for (int ai = 0; ai < 2; ++ai)
#pragma unroll
            for (int m = 0; m < 4; ++m) { const int r = row0 + ai * HALF + m * 16;
                const float* g = gate + (size_t)(1 + (r >> 4)) * 12288 + colt; float* d = slab + ((size_t)u.ks * 256 + r) * 2048 + colt;
                f32x4 gt[2][2];
#pragma unroll
                for (int bj = 0; bj < 2; ++bj)
#pragma unroll
                    for (int n = 0; n < 2; ++n) gt[bj][n] = *(const f32x4*)(g + bj * HALF + 4 * n);
#pragma unroll
                for (int bj = 0; bj < 2; ++bj)
#pragma unroll
                    for (int n = 0; n < 2; ++n) *(f32x4*)(d + bj * HALF + 4 * n) = gt[bj][n] * acc[ai][bj][m][n]; }
    }
};
template <int CTRL> __device__ __forceinline__ float dppf(float old, float src) { return __builtin_bit_cast(float, __builtin_amdgcn_update_dpp(__builtin_bit_cast(int, old), __builtin_bit_cast(int, src), CTRL, 0xF, 0xF, false)); }
struct EpiUp {
    static constexpr bool PERM = true, AFTER_DRAIN = false;
    bf16_t* ACT; const float* cw; const float* cb; const float* sconv; float* halo; float* conv_p; float* conv_s; PG8_LAS float* hb;
    template <bool SAMP> __device__ __forceinline__ void run(const f32x4 (&acc)[2][2][4][2], const Unit& u, int wr, int wc, int fr, int fq) const {
        asm volatile("" : "+v"(fr), "+v"(fq));
        const int jl = wc * 32 + 8 * fq, j0 = u.pn * HALF + jl;
#pragma unroll
        for (int ai = 0; ai < 2; ++ai) { const int blk = 2 * ai + wr;
            if (!SAMP && fr >= 14) {
                if (blk < 3) { PG8_LAS float* h = hb + ((blk + 1) * 2 + (fr - 14)) * HALF + jl; *(PG8_LAS f32x4*)h = acc[ai][0][3][0]; *(PG8_LAS f32x4*)(h + 4) = acc[ai][0][3][1]; }
                else { float* t = halo + ((size_t)u.pm * 2 + (fr - 14)) * 5632 + j0; *(f32x4*)t = acc[ai][0][3][0]; *(f32x4*)(t + 4) = acc[ai][0][3][1];
                    if (u.pm == 31) { float* c = conv_p + (size_t)(fr - 14) * 5632 + j0; *(f32x4*)c = acc[ai][0][3][0]; *(f32x4*)(c + 4) = acc[ai][0][3][1]; } }
            }
            if (SAMP && fr >= 14) {
#pragma unroll
                for (int m = 0; m < 4; ++m) { const int sb = 8 * ai + 4 * wr + m; float* c = conv_s + ((size_t)sb * 2 + (fr - 14)) * 5632 + j0; *(f32x4*)c = acc[ai][0][m][0]; *(f32x4*)(c + 4) = acc[ai][0][m][1]; }
            }
        }
        asm volatile("s_waitcnt lgkmcnt(0)\n\ts_barrier" ::: "memory");
        f32x4 cwv[2][3], cbv[2];
#pragma unroll
        for (int n = 0; n < 2; ++n) { cwv[n][0] = *(const f32x4*)(cw + j0 + 4 * n); cwv[n][1] = *(const f32x4*)(cw + 5632 + j0 + 4 * n); cwv[n][2] = *(const f32x4*)(cw + 2 * 5632 + j0 + 4 * n); cbv[n] = *(const f32x4*)(cb + j0 + 4 * n); }
#pragma unroll
        for (int ai = 0; ai < 2; ++ai) { const int blk = 2 * ai + wr;
#pragma unroll
            for (int m = 0; m < 4; ++m) { const int r = u.pm * BM + ai * HALF + wr * 64 + m * 16 + fr;
                u32x4 w;
#pragma unroll
                for (int n = 0; n < 2; ++n) {
                    f32x4 pv = (f32x4){0.f, 0.f, 0.f, 0.f};
                    if (SAMP) { if (fr >= 14) { const int sb = 8 * ai + 4 * wr + m; pv = *(const f32x4*)(sconv + ((size_t)sb * 2 + (fr - 14)) * 5632 + j0 + 4 * n); } asm volatile("" : "+v"(pv)); }
                    else if (m == 0) { if (blk > 0 && fr >= 14) pv = *(const PG8_LAS f32x4*)(hb + (blk * 2 + (fr - 14)) * HALF + jl + 4 * n); asm volatile("" : "+v"(pv)); }
                    else pv = acc[ai][0][m > 0 ? m - 1 : 0][n];
                    const f32x4 w0 = cwv[n][0], w1 = cwv[n][1], w2 = cwv[n][2], bb = cbv[n];
                    f32x4 o;
#pragma unroll
                    for (int i = 0; i < 4; ++i) { const float cur = acc[ai][0][m][n][i], pr = pv[i];
                        const float t1 = dppf<0x121>(pr, pr), p1 = dppf<0x111>(t1, cur);
                        const float t2 = dppf<0x122>(pr, pr), p2 = dppf<0x112>(t2, cur);
                        o[i] = bb[i] + w0[i] * p2 + w1[i] * p1 + w2[i] * cur; }
                    const f32x2 g0 = gelu_pk((f32x2){o[0], o[1]}), g1 = gelu_pk((f32x2){o[2], o[3]});
                    const f32x4 uv = acc[ai][1][m][n];
                    const unsigned lo = cvt_pk_bf16(g0.x * uv[0], g0.y * uv[1]), hi = cvt_pk_bf16(g1.x * uv[2], g1.y * uv[3]);
                    if (n == 0) { w.x = lo; w.y = hi; } else { w.z = lo; w.w = hi; }
                }
                const bool head = (!SAMP && u.pm > 0 && blk == 0 && m == 0 && fr < 2);
                if (!head) *(u32x4*)(ACT + (size_t)r * 5632 + j0) = w;
                else { float* hg = halo + (size_t)32 * 2 * 5632 + ((size_t)u.pm * 2 + fr) * 5632 + j0; float* hv = hg + (size_t)32 * 2 * 5632;
                    *(f32x4*)hg = acc[ai][0][m][0]; *(f32x4*)(hg + 4) = acc[ai][0][m][1]; *(f32x4*)hv = acc[ai][1][m][0]; *(f32x4*)(hv + 4) = acc[ai][1][m][1]; }
                asm volatile("" ::: "memory");
            } }
    }
    __device__ __forceinline__ void operator()(const f32x4 (&acc)[2][2][4][2], const Unit& u, int wr, int wc, int fr, int fq) const {
        if (u.pm == 32) run<true>(acc, u, wr, wc, fr, fq); else run<false>(acc, u, wr, wc, fr, fq);
    }
};
}
#include <hip/hip_bf16.h>
#include <cmath>
namespace attn_body {
using bf16=__hip_bfloat16;
using bf16x8=__attribute__((ext_vector_type(8)))short;
using s16x4=__attribute__((ext_vector_type(4)))short;
using f32x16=__attribute__((ext_vector_type(16)))float;
using u32x4=__attribute__((ext_vector_type(4)))unsigned;
constexpr int BATCH=1,NHEAD=16,SEQ=8192,D=64,DM=NHEAD*D;
constexpr int NW=8,QBLK=32,QB=QBLK*NW,KVBLK=64,NQB=SEQ/QB;
constexpr int ATTN_PITCH=DM, ATTN_UNIT_ROWS=QB, OPITCH=2048;
__device__ __forceinline__ int crow(int r,int hi){return (r&3)+8*(r>>2)+4*hi;}
#define SBAR() __builtin_amdgcn_sched_barrier(0)
__device__ __forceinline__ void bmask(f32x16&p0,f32x16&p1,int t,int cq,int qabs,int hi,const __attribute__((address_space(3))) float*lut){
  if(t>cq){
    #pragma unroll
    for(int r=0;r<16;++r){p0[r]=-INFINITY;p1[r]=-INFINITY;}
  } else {
    const int d0=64*t+4*hi-qabs+128;
    #pragma unroll
    for(int r=0;r<16;++r){int i0=d0+(r&3)+8*(r>>2); int i1=i0+32; i0=i0<0?0:i0; i1=i1<0?0:i1; p0[r]+=lut[i0]; p1[r]+=lut[i1];}
  }
}

constexpr int NSLOT=3, SLOTB=8192;
constexpr int LDS_K=0, LDS_V=NSLOT*SLOTB, LDS_WS=2*NSLOT*SLOTB, LDS_OST=LDS_WS+NW*64*4, LDS_BYTES=LDS_OST+NW*4096;
constexpr float C2=0.125f*1.4426950408889634f;
__device__ __forceinline__ void glds16(const void*gsrc,unsigned lds_dst){unsigned keep;
  asm volatile("s_mov_b32 %0, m0\n\ts_mov_b32 m0, %2\n\ts_nop 0\n\tglobal_load_lds_dwordx4 %1, off\n\ts_mov_b32 m0, %0":"=&s"(keep):"v"(gsrc),"s"(lds_dst):"memory");}
__device__ __forceinline__ float max3f(float a,float b,float c){float r;asm("v_max3_f32 %0, %1, %2, %3":"=v"(r):"v"(a),"v"(b),"v"(c));return r;}
__device__ __forceinline__ float max2f(float a,float b){float r;asm("v_max_f32_e32 %0, %1, %2":"=v"(r):"v"(a),"v"(b));return r;}
__device__ __forceinline__ float fadd_s(float a,float b){float r;asm("v_add_f32_e32 %0, %1, %2":"=v"(r):"v"(a),"v"(b));return r;}
__device__ __forceinline__ float fsub_s(float a,float b){float r;asm("v_sub_f32_e32 %0, %1, %2":"=v"(r):"v"(a),"v"(b));return r;}
typedef float f32x2_t __attribute__((ext_vector_type(2))); typedef __bf16 bf16x2_t __attribute__((ext_vector_type(2)));
__device__ __forceinline__ unsigned cvtpk_s(float lo,float hi){f32x2_t v={lo,hi};bf16x2_t b=__builtin_convertvector(v,bf16x2_t);return __builtin_bit_cast(unsigned,b);}
#define WAIT_BAR(N) asm volatile("s_waitcnt vmcnt(" #N ") lgkmcnt(0)\n\ts_barrier":::"memory")

__device__ __forceinline__ void qkt(f32x16&p0,f32x16&p1,const char*Kslot,const bf16x8*qr,const f32x16&negm,int r32,int hi){
  const char*kb=Kslot+hi*1024+r32*16;
  #pragma unroll
  for(int d0=0;d0<4;++d0){
    const bf16x8 b0=*reinterpret_cast<const bf16x8*>(kb+d0*2048);
    const bf16x8 b1=*reinterpret_cast<const bf16x8*>(kb+d0*2048+512);
    if(d0==0){p0=__builtin_amdgcn_mfma_f32_32x32x16_bf16(b0,qr[0],negm,0,0,0);p1=__builtin_amdgcn_mfma_f32_32x32x16_bf16(b1,qr[0],negm,0,0,0);}
    else{p0=__builtin_amdgcn_mfma_f32_32x32x16_bf16(b0,qr[d0],p0,0,0,0);p1=__builtin_amdgcn_mfma_f32_32x32x16_bf16(b1,qr[d0],p1,0,0,0);}}
}
typedef __attribute__((address_space(3))) const char* lds_cptr;
typedef short v4i16_t __attribute__((ext_vector_type(4)));
__device__ __forceinline__ void kload8(bf16x8*kf,lds_cptr kp){
  kf[0]=*(const __attribute__((address_space(3))) bf16x8*)(kp);      kf[1]=*(const __attribute__((address_space(3))) bf16x8*)(kp+512);
  kf[2]=*(const __attribute__((address_space(3))) bf16x8*)(kp+2048); kf[3]=*(const __attribute__((address_space(3))) bf16x8*)(kp+2560);
  kf[4]=*(const __attribute__((address_space(3))) bf16x8*)(kp+4096); kf[5]=*(const __attribute__((address_space(3))) bf16x8*)(kp+4608);
  kf[6]=*(const __attribute__((address_space(3))) bf16x8*)(kp+6144); kf[7]=*(const __attribute__((address_space(3))) bf16x8*)(kp+6656);
}
__device__ __forceinline__ void kload2(bf16x8*kf,lds_cptr kp,int j){ kf[2*j]=*(const __attribute__((address_space(3))) bf16x8*)(kp+j*2048); kf[2*j+1]=*(const __attribute__((address_space(3))) bf16x8*)(kp+j*2048+512); }
__device__ __forceinline__ s16x4 vtr(lds_cptr p){ return __builtin_bit_cast(s16x4,__builtin_amdgcn_ds_read_tr16_b64_v4i16((__attribute__((address_space(3))) v4i16_t*)p)); }
__device__ __forceinline__ float rowmax(const f32x16&p0,const f32x16&p1){
  float a=max3f(p0[0],p0[1],p1[0]),b=max3f(p0[2],p0[3],p1[1]);a=max3f(a,p1[2],p1[3]);
  #pragma unroll
  for(int r=4;r<16;r+=4){a=max3f(a,p0[r],p0[r+1]);b=max3f(b,p0[r+2],p0[r+3]);a=max3f(a,p1[r],p1[r+1]);b=max3f(b,p1[r+2],p1[r+3]);}
  const float m=max2f(a,b);
  const PL32 rr=pl32(m);
  return max2f(rr.a,rr.b);
}
__device__ __forceinline__ void pv(f32x16*o,int vb,bf16x8 pa0,bf16x8 pa1,bf16x8 pa2,bf16x8 pa3){
  #pragma unroll
  for(int d0=0;d0<2;++d0){s16x4 lo[4],hi[4];
    #pragma unroll
    for(int ks=0;ks<4;++ks){
      asm volatile("ds_read_b64_tr_b16 %0,%1 offset:%c2":"=&v"(lo[ks]):"v"(vb),"i"(d0*4096+ks*1024):"memory");
      asm volatile("ds_read_b64_tr_b16 %0,%1 offset:%c2":"=&v"(hi[ks]):"v"(vb),"i"(d0*4096+ks*1024+512):"memory");}
    asm volatile("s_waitcnt lgkmcnt(0)":::"memory");SBAR();
    #define PK(k) (bf16x8){lo[k][0],lo[k][1],lo[k][2],lo[k][3],hi[k][0],hi[k][1],hi[k][2],hi[k][3]}
    o[d0]=__builtin_amdgcn_mfma_f32_32x32x16_bf16(pa0,PK(0),o[d0],0,0,0);
    o[d0]=__builtin_amdgcn_mfma_f32_32x32x16_bf16(pa1,PK(1),o[d0],0,0,0);
    o[d0]=__builtin_amdgcn_mfma_f32_32x32x16_bf16(pa2,PK(2),o[d0],0,0,0);
    o[d0]=__builtin_amdgcn_mfma_f32_32x32x16_bf16(pa3,PK(3),o[d0],0,0,0);
    #undef PK
  }
}

#ifndef ATTN_STORE16
#define ATTN_STORE16(p,v) (*(u32x4*)(p)=(v))
#endif
template<int THRL> __device__ __forceinline__ void attn_unit(int qb,int qkcol,int vcol,int ocol,int hh,const float*__restrict__ reltab,const bf16*Q,const bf16*__restrict__ K,const bf16*__restrict__ V,bf16*O,char*shm,const __attribute__((address_space(3))) float*lut){
  const int b=0;
  int tid_=threadIdx.x; asm volatile("":"+v"(tid_));
  const int tid=tid_,lane=tid&63,r32=lane&31,hi=lane>>5; const int wid=__builtin_amdgcn_readfirstlane(tid>>6);
  const long rowbase=(long)b*SEQ; const int q0=qb*QB;
  const bf16*Qw=Q+(rowbase+q0+wid*QBLK)*DM+qkcol;
  const bf16*Kh=K+rowbase*DM+qkcol,*Vh=V+rowbase*DM+vcol;
  const unsigned lds0=(unsigned)(uintptr_t)shm;
  float*wsf=(float*)(shm+LDS_WS)+wid*64;
  const bf16*ksrc=Kh+(long)lane*DM+wid*8;
  const bf16*vsrc=Vh+(long)(16*(wid&3)+(lane>>2))*DM+(wid>>2)*32+(lane&3)*8;
  const unsigned kdst=lds0+LDS_K+wid*1024, vdst=lds0+LDS_V+wid*1024;
  #define DMA_K(t,slot) glds16(ksrc+(long)(t)*KVBLK*DM,(unsigned)__builtin_amdgcn_readfirstlane(kdst+(slot)))
  #define DMA_V(t,slot) glds16(vsrc+(long)(t)*KVBLK*DM,(unsigned)__builtin_amdgcn_readfirstlane(vdst+(slot)))
  const int vb0=(int)(lds0+LDS_V)+((lane>>4)&1)*32+(lane&3)*8+(4*hi+((lane&15)>>2))*64;
  const char*Kbase=shm+LDS_K; bf16x8 kf[8];
  const lds_cptr shm3=(lds_cptr)shm; const lds_cptr kp0=shm3+LDS_K+hi*1024+r32*16; const lds_cptr vp0=shm3+LDS_V+((lane>>4)&1)*32+(lane&3)*8+(4*hi+((lane&15)>>2))*64;
  const int NT=(q0+QB)/KVBLK;
  const int cq=(q0>>6)+(wid>>1), cqm2=cq-2, qabs=q0+wid*QBLK+r32;
  DMA_K(0,0);DMA_V(0,0);DMA_K(1,SLOTB);
  bf16x8 qr[4];
  #pragma unroll
  for(int d0=0;d0<4;++d0)qr[d0]=*reinterpret_cast<const bf16x8*>(&Qw[(long)r32*DM+d0*16+hi*8]);
  float mhat=0.f,l_reg=0.f;f32x16 o[2];o[0]=f32x16{};o[1]=f32x16{};f32x16 negm=f32x16{};asm volatile("":"+v"(negm));
  const int qrel=wid*QBLK+r32;
  #define CMASK(P0,P1,t) do{ if((t)>=cqm2)bmask(P0,P1,(t),cq,qabs,hi,lut);}while(0)
  bool resc=false;
  #define START(P0,P1) do{ const float rm=rowmax(P0,P1); resc=false; \
    { const float dl=rm; mhat=fadd_s(mhat,dl); \
      _Pragma("unroll") for(int r=0;r<16;++r){P0[r]=fsub_s(P0[r],dl);P1[r]=fsub_s(P1[r],dl);} \
      _Pragma("unroll") for(int r=0;r<16;++r)negm[r]=-mhat; asm volatile("":"+v"(negm)); } \
    _Pragma("unroll") for(int r=0;r<16;++r)P0[r]=__builtin_amdgcn_exp2f(P0[r]); }while(0)
  #define RESC() do{ if(resc){ asm volatile("s_waitcnt lgkmcnt(0)":::"memory"); \
      _Pragma("unroll") for(int d_=0;d_<2;++d_) _Pragma("unroll") for(int r=0;r<16;++r)o[d_][r]*=wsf[crow(r,hi)]; } }while(0)
  f32x16 pA0,pA1,pB0,pB1;
  int sl_prev=0,sl_cur=0,sl_next=SLOTB;
  #define ROT() do{sl_prev=sl_cur;sl_cur=sl_next;sl_next=(sl_next==(NSLOT-1)*SLOTB)?0:sl_next+SLOTB;}while(0)
  DMA_K(2,2*SLOTB);
  WAIT_BAR(3);
  qkt(pA0,pA1,Kbase,qr,negm,r32,hi);asm volatile("s_nop 15\n\ts_nop 7":"+v"(pA0),"+v"(pA1));CMASK(pA0,pA1,0);
  START(pA0,pA1);
  _Pragma("unroll") for(int r=0;r<16;++r)pA1[r]=__builtin_amdgcn_exp2f(pA1[r]);
  WAIT_BAR(0);
  DMA_K(3,0);DMA_V(1,SLOTB);
  ROT();
  kload8(kf,kp0+sl_cur);
  WAIT_BAR(2);
  s16x4 vlo[8],vhi[8]; u32x4 pw0,pw1,pw2,pw3;
  #define PKW(P,B) cvtpk_s(P[B],P[B+1])
  #define PAF(k) __builtin_bit_cast(bf16x8,pw##k)
  #define VFR(i) (bf16x8){vlo[i][0],vlo[i][1],vlo[i][2],vlo[i][3],vhi[i][0],vhi[i][1],vhi[i][2],vhi[i][3]}
  #define PIN(x) asm volatile("":"+v"(x))
  #define MX3(a,b,c) __builtin_fmaxf(__builtin_fmaxf((a),(b)),(c))
  #define GAPA(MF,A0,A1,A2,A3,W0,W1,PW) do{ MF; sacc+=A0; sacc+=A1; sacc+=A2; sacc+=A3; PIN(sacc); W0; W1; PIN(PW); SBAR(); }while(0)
  #define EX(v) __builtin_amdgcn_exp2f(v)
  #define GAPB(MF,X,B) do{ MF; X[B]=EX(X[B]); X[B+1]=EX(X[B+1]); X[B+2]=EX(X[B+2]); X[B+3]=EX(X[B+3]); PIN(X); SBAR(); }while(0)
  #define VRD(i) do{ vlo[i]=vtr(vp_+(((i)>>2)*4096+((i)&3)*1024)); vhi[i]=vtr(vp_+(((i)>>2)*4096+((i)&3)*1024+512)); }while(0)
  #define KRD(G,j) do{ if(G){ kload2(kf,kp0+sl_next,j); SBAR(); } }while(0)
  #define STEP(C0,C1,P0,P1,t,GK,GV,GL) do{ SBAR(); \
    const lds_cptr vp_=vp0+sl_prev; \
    VRD(0); SBAR(); float sacc=(P0[0]+P0[1]); \
    GAPA(C0=__builtin_amdgcn_mfma_f32_32x32x16_bf16(kf[0],qr[0],negm,0,0,0), P0[2],P0[3],P0[4],P0[5],     pw0[0]=PKW(P0,0), pw0[1]=PKW(P0,2), pw0); \
    VRD(4); SBAR(); GAPA(C1=__builtin_amdgcn_mfma_f32_32x32x16_bf16(kf[1],qr[0],negm,0,0,0), P0[6],P0[7],P0[8],P0[9],     pw0[2]=PKW(P0,4), pw0[3]=PKW(P0,6), pw0); \
    VRD(1); SBAR(); GAPA(C0=__builtin_amdgcn_mfma_f32_32x32x16_bf16(kf[2],qr[1],C0,0,0,0),   P0[10],P0[11],P0[12],P0[13], pw1[0]=PKW(P0,8), pw1[1]=PKW(P0,10), pw1); \
    VRD(5); SBAR(); GAPA(C1=__builtin_amdgcn_mfma_f32_32x32x16_bf16(kf[3],qr[1],C1,0,0,0),   P0[14],P0[15],P1[0],P1[1],   pw1[2]=PKW(P0,12),pw1[3]=PKW(P0,14), pw1); \
    VRD(2); SBAR(); GAPA(C0=__builtin_amdgcn_mfma_f32_32x32x16_bf16(kf[4],qr[2],C0,0,0,0),   P1[2],P1[3],P1[4],P1[5],     pw2[0]=PKW(P1,0), pw2[1]=PKW(P1,2), pw2); \
    VRD(6); SBAR(); GAPA(C1=__builtin_amdgcn_mfma_f32_32x32x16_bf16(kf[5],qr[2],C1,0,0,0),   P1[6],P1[7],P1[8],P1[9],     pw2[2]=PKW(P1,4), pw2[3]=PKW(P1,6), pw2); \
    VRD(3); SBAR(); GAPA(C0=__builtin_amdgcn_mfma_f32_32x32x16_bf16(kf[6],qr[3],C0,0,0,0),   P1[10],P1[11],P1[12],P1[13], pw3[0]=PKW(P1,8), pw3[1]=PKW(P1,10), pw3); \
    VRD(7); SBAR(); GAPA(C1=__builtin_amdgcn_mfma_f32_32x32x16_bf16(kf[7],qr[3],C1,0,0,0),   P1[14],P1[15],0.f,0.f,       pw3[2]=PKW(P1,12),pw3[3]=PKW(P1,14), pw3); \
    l_reg+=sacc; \
    if(GK){DMA_K((t)+3,sl_cur);} if(GV){DMA_V((t)+1,sl_next);} \
    CMASK(C0,C1,t); \
    { float a=MX3(C0[0],C0[1],C1[0]),b=MX3(C0[2],C0[3],C1[1]); a=MX3(a,C1[2],C1[3]); \
      _Pragma("unroll") for(int r=4;r<16;r+=4){a=MX3(a,C0[r],C0[r+1]);b=MX3(b,C0[r+2],C0[r+3]);a=MX3(a,C1[r],C1[r+1]);b=MX3(b,C1[r+2],C1[r+3]);} \
      float rm=__builtin_fmaxf(a,b); { const PL32 rr=pl32(rm); rm=__builtin_fmaxf(rr.a,rr.b); } \
      resc=false; \
      if(__builtin_expect(__any(rm>(float)THRL),0)){ const float dl=__builtin_fmaxf(rm,0.f); mhat+=dl; \
        _Pragma("unroll") for(int r=0;r<16;++r){C0[r]-=dl;C1[r]-=dl;} \
        _Pragma("unroll") for(int r=0;r<16;++r)negm[r]=-mhat; asm volatile("":"+v"(negm)); \
        const float f=__builtin_amdgcn_exp2f(-dl); l_reg*=f; if(hi==0)wsf[r32]=f; resc=true; } } \
    SBAR(); \
    GAPB(o[0]=__builtin_amdgcn_mfma_f32_32x32x16_bf16(PAF(0),VFR(0),o[0],0,0,0), C0,0); \
    GAPB(o[1]=__builtin_amdgcn_mfma_f32_32x32x16_bf16(PAF(0),VFR(4),o[1],0,0,0), C0,4); \
    KRD(GL,0); GAPB(o[0]=__builtin_amdgcn_mfma_f32_32x32x16_bf16(PAF(1),VFR(1),o[0],0,0,0), C0,8); \
    KRD(GL,1); GAPB(o[1]=__builtin_amdgcn_mfma_f32_32x32x16_bf16(PAF(1),VFR(5),o[1],0,0,0), C0,12); \
    KRD(GL,2); GAPB(o[0]=__builtin_amdgcn_mfma_f32_32x32x16_bf16(PAF(2),VFR(2),o[0],0,0,0), C1,0); \
    KRD(GL,3); GAPB(o[1]=__builtin_amdgcn_mfma_f32_32x32x16_bf16(PAF(2),VFR(6),o[1],0,0,0), C1,4); \
    GAPB(o[0]=__builtin_amdgcn_mfma_f32_32x32x16_bf16(PAF(3),VFR(3),o[0],0,0,0), C1,8); \
    GAPB(o[1]=__builtin_amdgcn_mfma_f32_32x32x16_bf16(PAF(3),VFR(7),o[1],0,0,0), C1,12); \
    }while(0)
  int t=1;
  #undef CMASK
  #define CMASK(P0,P1,t) do{}while(0)
  for(;t+7<NT;t+=2){
    STEP(pB0,pB1,pA0,pA1,t,true,true,true);     WAIT_BAR(2); RESC(); ROT();
    STEP(pA0,pA1,pB0,pB1,t+1,true,true,true);   WAIT_BAR(2); RESC(); ROT();
  }
  #undef CMASK
  #define CMASK(P0,P1,t) do{ if((t)>=cqm2)bmask(P0,P1,(t),cq,qabs,hi,lut);}while(0)
  #define ENDW(tt) do{ if((tt)+3<NT){WAIT_BAR(2);} else if((tt)+2<NT){WAIT_BAR(1);} else {WAIT_BAR(0);} }while(0)
  for(;t+1<NT;t+=2){
    STEP(pB0,pB1,pA0,pA1,t,(t+3<NT),(t+1<NT),(t+1<NT));       ENDW(t);   RESC(); ROT();
    STEP(pA0,pA1,pB0,pB1,t+1,(t+4<NT),(t+2<NT),(t+2<NT));     ENDW(t+1); RESC(); ROT();
  }
  STEP(pB0,pB1,pA0,pA1,NT-1,false,false,false); RESC();
  { float sacc=pB0[0]+pB0[1]; _Pragma("unroll") for(int r=2;r<16;++r)sacc+=pB0[r]; _Pragma("unroll") for(int r=0;r<16;++r)sacc+=pB1[r]; l_reg+=sacc;
    pw0=(u32x4){PKW(pB0,0),PKW(pB0,2),PKW(pB0,4),PKW(pB0,6)};pw1=(u32x4){PKW(pB0,8),PKW(pB0,10),PKW(pB0,12),PKW(pB0,14)};pw2=(u32x4){PKW(pB1,0),PKW(pB1,2),PKW(pB1,4),PKW(pB1,6)};pw3=(u32x4){PKW(pB1,8),PKW(pB1,10),PKW(pB1,12),PKW(pB1,14)};
    SBAR(); pv(o,vb0+sl_cur,PAF(0),PAF(1),PAF(2),PAF(3)); }
  #undef PKW
  #undef PAF
  #undef VFR
  #undef PIN
  #undef MX3
  #undef GAPA
  #undef GAPB
  #undef EX
  #undef VRD
  #undef KRD
  #undef STEP
  #undef ENDW
  {const PL32 rr=pl32(l_reg);l_reg=rr.a+rr.b;}
  if(hi==0)wsf[32+r32]=l_reg;asm volatile("s_waitcnt lgkmcnt(0)":::"memory");
  float rli[16];
  #pragma unroll
  for(int r=0;r<16;++r)rli[r]=__builtin_amdgcn_rcpf(wsf[32+crow(r,hi)]);
  bf16*Ow=O+(rowbase+q0+wid*QBLK)*(long)OPITCH+ocol;
  { bf16*stg=(bf16*)(shm+LDS_OST)+wid*2048;
    #pragma unroll
    for(int r=0;r<16;++r){const int orow=crow(r,hi);
      #pragma unroll
      for(int d0=0;d0<2;++d0)stg[orow*64+d0*32+r32]=__float2bfloat16(o[d0][r]*rli[r]);}
    asm volatile("s_waitcnt lgkmcnt(0)":::"memory");
    #pragma unroll
    for(int i=0;i<4;++i){const int row=i*8+(lane>>3),ch=lane&7; const u32x4 v=*(const u32x4*)(stg+row*64+ch*8); ATTN_STORE16(Ow+(long)row*OPITCH+ch*8,v);} }
  asm volatile("s_waitcnt lgkmcnt(0)\n\ts_barrier":::"memory");
  #undef DMA_K
  #undef DMA_V
  #undef CMASK
  #undef START
  #undef RESC
  #undef ROT
}
typedef __attribute__((address_space(3))) const char* lds_cp;
__device__ __forceinline__ void qkt_half(f32x16&p,lds_cp Kslot,const bf16x8*qr,const f32x16&negm,int r32,int hi,int kh){
  lds_cp kb=Kslot+hi*1024+(r32+32*kh)*16;
  #pragma unroll
  for(int d0=0;d0<4;++d0){ const bf16x8 b=*(const __attribute__((address_space(3))) bf16x8*)(kb+d0*2048);
    if(d0==0)p=__builtin_amdgcn_mfma_f32_32x32x16_bf16(b,qr[0],negm,0,0,0); else p=__builtin_amdgcn_mfma_f32_32x32x16_bf16(b,qr[d0],p,0,0,0);}
}
__device__ __forceinline__ void pv_half(f32x16*o,int vb,bf16x8 pa0,bf16x8 pa1){
  #pragma unroll
  for(int d0=0;d0<2;++d0){s16x4 lo[2],hi[2];
    #pragma unroll
    for(int ks=0;ks<2;++ks){
      asm volatile("ds_read_b64_tr_b16 %0,%1 offset:%c2":"=&v"(lo[ks]):"v"(vb),"i"(d0*4096+ks*1024):"memory");
      asm volatile("ds_read_b64_tr_b16 %0,%1 offset:%c2":"=&v"(hi[ks]):"v"(vb),"i"(d0*4096+ks*1024+512):"memory");}
    asm volatile("s_waitcnt lgkmcnt(0)":::"memory");SBAR();
    #define PK(k) (bf16x8){lo[k][0],lo[k][1],lo[k][2],lo[k][3],hi[k][0],hi[k][1],hi[k][2],hi[k][3]}
    o[d0]=__builtin_amdgcn_mfma_f32_32x32x16_bf16(pa0,PK(0),o[d0],0,0,0);
    o[d0]=__builtin_amdgcn_mfma_f32_32x32x16_bf16(pa1,PK(1),o[d0],0,0,0);
    #undef PK
  }
}
constexpr int F_SLOTV=2*SLOTB, F_LDS_K=0, F_LDS_V=NSLOT*SLOTB, F_LDS_WS=F_LDS_V+NSLOT*F_SLOTV, F_LDS_OST=F_LDS_WS+NW*64*4, F_LDS_BYTES=F_LDS_OST+4*8192;
__device__ __forceinline__ void bmask1(f32x16&p,int t,int cq,int qabs,int hi,int kh,const __attribute__((address_space(3))) float*lut){
  if(t>cq){
    #pragma unroll
    for(int r=0;r<16;++r)p[r]=-INFINITY;
  } else {
    const int d0=64*t+32*kh+4*hi-qabs+128;
    #pragma unroll
    for(int r=0;r<16;++r){int i0=d0+(r&3)+8*(r>>2); i0=i0<0?0:i0; p[r]+=lut[i0];}
  }
}
template<int THRL> __device__ __forceinline__ void attn_unit_f(int qb,int qkcol,int vcol,int ocol,const bf16*Q,const bf16*__restrict__ K,const bf16*__restrict__ V,bf16*O,char*shm,const __attribute__((address_space(3))) float*lut){
  int tid_=threadIdx.x; asm volatile("":"+v"(tid_));
  const int tid=tid_,lane=tid&63,r32=lane&31,hi=lane>>5; const int wid=__builtin_amdgcn_readfirstlane(tid>>6); const int pr=wid&3,kh=wid>>2;
  const int q0=qb*128;
  const bf16*Qw=Q+(long)(q0+pr*QBLK)*DM+qkcol;
  const bf16*Kh=K+qkcol,*Vh=V+vcol;
  const unsigned lds0=(unsigned)(uintptr_t)shm;
  float*wsf=(float*)(shm+F_LDS_WS)+wid*64;
  const bf16*ksrc=Kh+(long)lane*DM+wid*8;
  const bf16*vsrc=Vh+(long)(16*(wid&3)+(lane>>2))*DM+(wid>>2)*32+(lane&3)*8;
  const unsigned kdst=lds0+F_LDS_K+wid*1024, vdst=lds0+F_LDS_V+wid*1024;
  #define DMA_K(t,slot) glds16(ksrc+(long)(t)*KVBLK*DM,(unsigned)__builtin_amdgcn_readfirstlane(kdst+(slot)))
  #define DMA_V(t,slot) do{ glds16(vsrc+(long)(t)*KVBLK*DM,(unsigned)__builtin_amdgcn_readfirstlane(vdst+2*(slot))); glds16(vsrc+(long)(t)*KVBLK*DM+64,(unsigned)__builtin_amdgcn_readfirstlane(vdst+2*(slot)+8192)); }while(0)
  const int vb0=(int)(lds0+F_LDS_V)+((lane>>4)&1)*32+(lane&3)*8+(4*hi+((lane&15)>>2))*64+kh*2048;
  bf16x8 kf[4];
  const lds_cptr shm3=(lds_cptr)shm; const lds_cptr kp0=shm3+F_LDS_K+hi*1024+r32*16+kh*512; const lds_cptr vp0=shm3+F_LDS_V+((lane>>4)&1)*32+(lane&3)*8+(4*hi+((lane&15)>>2))*64+kh*2048;
  const int NT_=(q0+128)/KVBLK; const int NT=NT_<4?4:NT_;
  const int cq=(q0>>6)+(pr>>1), cqm2=cq-2, qabs=q0+pr*QBLK+r32;
  DMA_K(0,0);DMA_V(0,0);DMA_K(1,SLOTB);
  bf16x8 qr[4];
  #pragma unroll
  for(int d0=0;d0<4;++d0)qr[d0]=*reinterpret_cast<const bf16x8*>(&Qw[(long)r32*DM+d0*16+hi*8]);
  float mhat=0.f,l_reg=0.f;f32x16 o[4];o[0]=f32x16{};o[1]=f32x16{};o[2]=f32x16{};o[3]=f32x16{};f32x16 negm=f32x16{};asm volatile("":"+v"(negm));
  #define CMASK(P,t) do{ if((t)>=cqm2)bmask1(P,(t),cq,qabs,hi,kh,lut);}while(0)
  bool resc=false;
  #define RESC() do{ if(resc){ asm volatile("s_waitcnt lgkmcnt(0)":::"memory"); \
      _Pragma("unroll") for(int d_=0;d_<4;++d_) _Pragma("unroll") for(int r=0;r<16;++r)o[d_][r]*=wsf[crow(r,hi)]; } }while(0)
  f32x16 pA,pB;
  int sl_prev=0,sl_cur=0,sl_next=SLOTB;
  #define ROT() do{sl_prev=sl_cur;sl_cur=sl_next;sl_next=(sl_next==(NSLOT-1)*SLOTB)?0:sl_next+SLOTB;}while(0)
  DMA_K(2,2*SLOTB);
  WAIT_BAR(4);
  qkt_half(pA,(lds_cp)(shm3+F_LDS_K),qr,negm,r32,hi,kh);asm volatile("s_nop 15\n\ts_nop 7":"+v"(pA));CMASK(pA,0);
  { float a=max3f(pA[0],pA[1],pA[2]),b=max3f(pA[3],pA[4],pA[5]);a=max3f(a,pA[6],pA[7]);b=max3f(b,pA[8],pA[9]);a=max3f(a,pA[10],pA[11]);b=max3f(b,pA[12],pA[13]);a=max3f(a,pA[14],pA[15]);
    const float m=max2f(a,b); const PL32 rr=pl32(m); const float dl=max2f(rr.a,rr.b); mhat=fadd_s(mhat,dl);
    _Pragma("unroll") for(int r=0;r<16;++r)pA[r]=fsub_s(pA[r],dl);
    _Pragma("unroll") for(int r=0;r<16;++r)negm[r]=-mhat; asm volatile("":"+v"(negm));
    _Pragma("unroll") for(int r=0;r<16;++r)pA[r]=__builtin_amdgcn_exp2f(pA[r]); }
  WAIT_BAR(0);
  DMA_K(3,0);DMA_V(1,SLOTB);
  ROT();
  _Pragma("unroll") for(int j=0;j<4;++j)kf[j]=*(const __attribute__((address_space(3))) bf16x8*)(kp0+sl_cur+j*2048);
  WAIT_BAR(3);
  s16x4 vlo[8],vhi[8]; u32x4 pwa,pwb;
  #define PKW(P,B) cvtpk_s(P[B],P[B+1])
  #define PAFA __builtin_bit_cast(bf16x8,pwa)
  #define PAFB __builtin_bit_cast(bf16x8,pwb)
  #define VFR(i) (bf16x8){vlo[i][0],vlo[i][1],vlo[i][2],vlo[i][3],vhi[i][0],vhi[i][1],vhi[i][2],vhi[i][3]}
  #define PIN(x) asm volatile("":"+v"(x))
  #define MX3(a,b,c) __builtin_fmaxf(__builtin_fmaxf((a),(b)),(c))
  #define GAPA(MF,A0,A1,A2,A3,W0,W1,PW) do{ MF; sacc+=A0; sacc+=A1; sacc+=A2; sacc+=A3; PIN(sacc); W0; W1; PIN(PW); SBAR(); }while(0)
  #define EX(v) __builtin_amdgcn_exp2f(v)
  #define GAPB(MF,X,B) do{ MF; X[B]=EX(X[B]); X[B+1]=EX(X[B+1]); PIN(X); SBAR(); }while(0)
  #define VRD(i) do{ vlo[i]=vtr(vp_+(((i)>>1)*4096+((i)&1)*1024)); vhi[i]=vtr(vp_+(((i)>>1)*4096+((i)&1)*1024+512)); }while(0)
  #define KRD(G,j) do{ if(G){ kf[j]=*(const __attribute__((address_space(3))) bf16x8*)(kp0+sl_next+(j)*2048); SBAR(); } }while(0)
  #define STEPF(C,P,t,GK,GV,GL) do{ SBAR(); \
    const lds_cptr vp_=vp0+2*sl_prev; \
    VRD(0); VRD(2); SBAR(); float sacc=(P[0]+P[1]); \
    GAPA(C=__builtin_amdgcn_mfma_f32_32x32x16_bf16(kf[0],qr[0],negm,0,0,0), P[2],P[3],P[4],P[5],     pwa[0]=PKW(P,0), pwa[1]=PKW(P,2), pwa); \
    VRD(4); VRD(6); SBAR(); GAPA(C=__builtin_amdgcn_mfma_f32_32x32x16_bf16(kf[1],qr[1],C,0,0,0), P[6],P[7],P[8],P[9],     pwa[2]=PKW(P,4), pwa[3]=PKW(P,6), pwa); \
    VRD(1); VRD(3); SBAR(); GAPA(C=__builtin_amdgcn_mfma_f32_32x32x16_bf16(kf[2],qr[2],C,0,0,0), P[10],P[11],P[12],P[13], pwb[0]=PKW(P,8), pwb[1]=PKW(P,10), pwb); \
    VRD(5); VRD(7); SBAR(); GAPA(C=__builtin_amdgcn_mfma_f32_32x32x16_bf16(kf[3],qr[3],C,0,0,0), P[14],P[15],0.f,0.f,     pwb[2]=PKW(P,12),pwb[3]=PKW(P,14), pwb); \
    l_reg+=sacc; \
    if(GK){DMA_K((t)+3,sl_cur);} if(GV){DMA_V((t)+1,sl_next);} \
    CMASK(C,t); \
    { float a=MX3(C[0],C[1],C[2]),b=MX3(C[3],C[4],C[5]); a=MX3(a,C[6],C[7]); b=MX3(b,C[8],C[9]); a=MX3(a,C[10],C[11]); b=MX3(b,C[12],C[13]); a=MX3(a,C[14],C[15]); \
      float rm=__builtin_fmaxf(a,b); { const PL32 rr=pl32(rm); rm=__builtin_fmaxf(rr.a,rr.b); } \
      resc=false; \
      if(__builtin_expect(__any(rm>(float)THRL),0)){ const float dl=__builtin_fmaxf(rm,0.f); mhat+=dl; \
        _Pragma("unroll") for(int r=0;r<16;++r)C[r]-=dl; \
        _Pragma("unroll") for(int r=0;r<16;++r)negm[r]=-mhat; asm volatile("":"+v"(negm)); \
        const float f=__builtin_amdgcn_exp2f(-dl); l_reg*=f; if(hi==0)wsf[r32]=f; resc=true; } } \
    SBAR(); \
    GAPB(o[0]=__builtin_amdgcn_mfma_f32_32x32x16_bf16(PAFA,VFR(0),o[0],0,0,0), C,0); \
    GAPB(o[1]=__builtin_amdgcn_mfma_f32_32x32x16_bf16(PAFA,VFR(2),o[1],0,0,0), C,2); \
    KRD(GL,0); GAPB(o[2]=__builtin_amdgcn_mfma_f32_32x32x16_bf16(PAFA,VFR(4),o[2],0,0,0), C,4); \
    KRD(GL,1); GAPB(o[3]=__builtin_amdgcn_mfma_f32_32x32x16_bf16(PAFA,VFR(6),o[3],0,0,0), C,6); \
    KRD(GL,2); GAPB(o[0]=__builtin_amdgcn_mfma_f32_32x32x16_bf16(PAFB,VFR(1),o[0],0,0,0), C,8); \
    KRD(GL,3); GAPB(o[1]=__builtin_amdgcn_mfma_f32_32x32x16_bf16(PAFB,VFR(3),o[1],0,0,0), C,10); \
    GAPB(o[2]=__builtin_amdgcn_mfma_f32_32x32x16_bf16(PAFB,VFR(5),o[2],0,0,0), C,12); \
    GAPB(o[3]=__builtin_amdgcn_mfma_f32_32x32x16_bf16(PAFB,VFR(7),o[3],0,0,0), C,14); \
    }while(0)
  int t=1;
  #undef CMASK
  #define CMASK(P,t) do{}while(0)
  for(;t+7<NT;t+=2){
    STEPF(pB,pA,t,true,true,true);     WAIT_BAR(3); RESC(); ROT();
    STEPF(pA,pB,t+1,true,true,true);   WAIT_BAR(3); RESC(); ROT();
  }
  #undef CMASK
  #define CMASK(P,t) do{ if((t)>=cqm2)bmask1(P,(t),cq,qabs,hi,kh,lut);}while(0)
  #define ENDW(tt) do{ if((tt)+3<NT){WAIT_BAR(3);} else if((tt)+2<NT){WAIT_BAR(2);} else {WAIT_BAR(0);} }while(0)
  for(;t+1<NT;t+=2){
    STEPF(pB,pA,t,(t+3<NT),(t+1<NT),(t+1<NT));       ENDW(t);   RESC(); ROT();
    STEPF(pA,pB,t+1,(t+4<NT),(t+2<NT),(t+2<NT));     ENDW(t+1); RESC(); ROT();
  }
  STEPF(pB,pA,NT-1,false,false,false); RESC();
  { float sacc=pB[0]+pB[1]; _Pragma("unroll") for(int r=2;r<16;++r)sacc+=pB[r]; l_reg+=sacc;
    pwa=(u32x4){PKW(pB,0),PKW(pB,2),PKW(pB,4),PKW(pB,6)};pwb=(u32x4){PKW(pB,8),PKW(pB,10),PKW(pB,12),PKW(pB,14)};
    SBAR();
    const int vb=vb0+2*sl_cur;
    #pragma unroll
    for(int d0=0;d0<4;++d0){s16x4 lo[2],hi_[2];
      #pragma unroll
      for(int ks=0;ks<2;++ks){
        asm volatile("ds_read_b64_tr_b16 %0,%1 offset:%c2":"=&v"(lo[ks]):"v"(vb),"i"(d0*4096+ks*1024):"memory");
        asm volatile("ds_read_b64_tr_b16 %0,%1 offset:%c2":"=&v"(hi_[ks]):"v"(vb),"i"(d0*4096+ks*1024+512):"memory");}
      asm volatile("s_waitcnt lgkmcnt(0)":::"memory");SBAR();
      #define PK(k) (bf16x8){lo[k][0],lo[k][1],lo[k][2],lo[k][3],hi_[k][0],hi_[k][1],hi_[k][2],hi_[k][3]}
      o[d0]=__builtin_amdgcn_mfma_f32_32x32x16_bf16(PAFA,PK(0),o[d0],0,0,0);
      o[d0]=__builtin_amdgcn_mfma_f32_32x32x16_bf16(PAFB,PK(1),o[d0],0,0,0);
      #undef PK
    } }
  #undef PKW
  #undef PAFA
  #undef PAFB
  #undef VFR
  #undef PIN
  #undef MX3
  #undef GAPA
  #undef GAPB
  #undef EX
  #undef VRD
  #undef KRD
  #undef STEPF
  #undef ENDW
  {const PL32 rr=pl32(l_reg);l_reg=rr.a+rr.b;}
  asm volatile("s_waitcnt lgkmcnt(0)\n\ts_barrier":::"memory");
  float*OG=(float*)shm+pr*4096;
  if(kh==1){ if(hi==0){wsf[r32]=mhat;wsf[32+r32]=l_reg;}
    #pragma unroll
    for(int d_=0;d_<4;++d_)
      #pragma unroll
      for(int r=0;r<16;++r)OG[(d_*16+r)*64+lane]=o[d_][r]; }
  asm volatile("s_waitcnt lgkmcnt(0)\n\ts_barrier":::"memory");
  if(kh==0){ const float*w1=(const float*)(shm+F_LDS_WS)+(wid+4)*64; const float m2=w1[r32],l2=w1[32+r32]; const float M=__builtin_fmaxf(mhat,m2);
    const float f1=__builtin_amdgcn_exp2f(mhat-M),f2=__builtin_amdgcn_exp2f(m2-M); const float inv=__builtin_amdgcn_rcpf(l_reg*f1+l2*f2);
    if(hi==0){wsf[r32]=f1*inv;wsf[32+r32]=f2*inv;}
    asm volatile("s_waitcnt lgkmcnt(0)":::"memory");
    bf16*stg=(bf16*)(shm+F_LDS_OST)+pr*4096;
    #pragma unroll
    for(int r=0;r<16;++r){const int orow=crow(r,hi); const float g1=wsf[orow],g2=wsf[32+orow];
      #pragma unroll
      for(int d_=0;d_<4;++d_)stg[orow*128+d_*32+r32]=__float2bfloat16(o[d_][r]*g1+OG[(d_*16+r)*64+lane]*g2);}
    asm volatile("s_waitcnt lgkmcnt(0)":::"memory");
    bf16*Ow=O+(long)(q0+pr*QBLK)*(long)OPITCH+ocol;
    #pragma unroll
    for(int i=0;i<8;++i){const int row=i*4+(lane>>4),ch=lane&15; const u32x4 v=*(const u32x4*)(stg+row*128+ch*8); ATTN_STORE16(Ow+(long)row*OPITCH+ch*8,v);} }
  asm volatile("s_waitcnt lgkmcnt(0)\n\ts_barrier":::"memory");
  #undef DMA_K
  #undef DMA_V
  #undef CMASK
  #undef RESC
  #undef ROT
}
constexpr int ATTN_LDS_BYTES=LDS_BYTES;
#undef SBAR
#undef WAIT_BAR
}
#define XB_TMO      128
#define XB_XCNT(j)  (256  + 64 * (j))
#define XB_XSUB(j)  (1280 + 64 * (j))
#define XB_XGEN(j)  (2304 + 64 * (j))
#define XB_TOP      3328
#define XB_TOPGEN   3392
#define XCD_BAR_WORDS 3456
#define XB_SPIN_CAP (1u << 18)

__device__ __forceinline__ unsigned xb_ld(unsigned* p)              { return __hip_atomic_load(p, __ATOMIC_RELAXED, __HIP_MEMORY_SCOPE_AGENT); }
__device__ __forceinline__ unsigned xb_add(unsigned* p, unsigned v) { return __hip_atomic_fetch_add(p, v, __ATOMIC_RELAXED, __HIP_MEMORY_SCOPE_AGENT); }
__device__ __forceinline__ unsigned xb_xcc_id() { return (unsigned)__builtin_amdgcn_s_getreg((3 << 11) | 20) & 0xFu; }
#define XB_SPIN(cond, bar) do { unsigned _sp = 0; while (cond) { __builtin_amdgcn_s_sleep(1); \
    if ((++_sp & 255u) == 0u) { if (xb_ld(&(bar)[XB_TMO])) break; if (_sp > XB_SPIN_CAP) { atomicAdd(&(bar)[XB_TMO], 1u); break; } } } } while (0)

struct XcdBarrier {
    unsigned* bar; unsigned x;
    volatile LAS unsigned* st;
};

__device__ __forceinline__ XcdBarrier xcd_barrier_post(unsigned* bar, volatile LAS unsigned* st) {
    XcdBarrier b; b.bar = bar; b.x = xb_xcc_id(); b.st = st;
    if (threadIdx.x == 0) (void)xb_add(&bar[XB_XCNT(b.x)], 1u);
    return b;
}
__device__ __forceinline__ void xcd_barrier_complete(unsigned* bar, unsigned x, unsigned& nloc, unsigned& nx) {
    const unsigned G = gridDim.x * gridDim.y * gridDim.z;
    unsigned sum, cnt, mine, sp = 0u;
    for (;;) {
        sum = 0u; cnt = 0u; mine = 0u;
#pragma unroll
        for (unsigned j = 0; j < 16; ++j) { const unsigned c = xb_ld(&bar[XB_XCNT(j)]); sum += c; cnt += (c > 0u) ? 1u : 0u; mine = (j == x) ? c : mine; }
        if (sum == G) break;
        __builtin_amdgcn_s_sleep(1);
        if ((++sp & 255u) == 0u) { if (xb_ld(&bar[XB_TMO])) break; if (sp > XB_SPIN_CAP) { atomicAdd(&bar[XB_TMO], 1u); break; } }
    }
    nloc = mine > 0u ? mine : 1u; nx = cnt > 0u ? cnt : 1u;
}

__device__ __forceinline__ void xcd_barrier(const XcdBarrier& b) {
    asm volatile("s_waitcnt vmcnt(0)" ::: "memory");
    __syncthreads();
    if (threadIdx.x == 0) {
        unsigned* bar = b.bar;
        __builtin_amdgcn_s_waitcnt(0);
        unsigned nloc = b.st[0], nx = b.st[1];
        if (nloc == 0u) { xcd_barrier_complete(bar, b.x, nloc, nx); b.st[0] = nloc; b.st[1] = nx; }
        const unsigned old = xb_add(&bar[XB_XSUB(b.x)], 1u);
        const unsigned gen = old / nloc;
        if (old + 1u == (gen + 1u) * nloc) {
            __builtin_amdgcn_fence(__ATOMIC_RELEASE, "agent");
            asm volatile("s_waitcnt vmcnt(0)" ::: "memory");
            const unsigned og = xb_add(&bar[XB_TOP], 1u);
            const unsigned tg = og / nx;
            if (og + 1u == (tg + 1u) * nx) xb_add(&bar[XB_TOPGEN], 1u);
            else XB_SPIN(xb_ld(&bar[XB_TOPGEN]) == tg, bar);
            __builtin_amdgcn_fence(__ATOMIC_ACQUIRE, "agent");
            xb_add(&bar[XB_XGEN(b.x)], 1u);
            asm volatile("s_waitcnt vmcnt(0)" ::: "memory");
        } else {
            XB_SPIN(xb_ld(&bar[XB_XGEN(b.x)]) == gen, bar);
            __builtin_amdgcn_fence(__ATOMIC_ACQUIRE, "agent");
            asm volatile("s_waitcnt vmcnt(0)" ::: "memory");
        }
    }
    __syncthreads();
}
struct Args { const float* in[37]; float* out; unsigned char* ws; int ph_lo, ph_hi; };
struct Frame { LAS unsigned char* lds; volatile LAS unsigned* MISC; gu32* ctl; int tid, lane, wave, G, bid; };
typedef __attribute__((address_space(4))) const Args* ArgsP;
__device__ __forceinline__ ArgsP get_args() { ArgsP p = (ArgsP)__builtin_amdgcn_kernarg_segment_ptr(); asm volatile("" : "+s"(p)); return p; }
#define PHASE_ENTRY() ArgsP A = get_args(); { int t_ = threadIdx.x; asm volatile("" : "+v"(t_)); F.tid = t_; F.lane = t_ & 63; F.wave = __builtin_amdgcn_readfirstlane(t_ >> 6); F.ctl = (gu32*)(A->ws + WS_CTL); }
enum InIdx { I_XP = 0, I_XS, I_CP, I_CS, I_CK, I_CV, I_SWKV, I_SSHIFT, I_SCONV, I_WADA, I_BADA, I_GMIX, I_GFFN, I_WIN, I_WOUT, I_MU, I_W0, I_W2, I_A0, I_A2, I_G2, I_KK, I_KA, I_RK, I_LNW, I_LNB,
             I_LQ1, I_LK1, I_LQ2, I_LK2, I_SUBLN, I_REL, I_FUP, I_CONVW, I_CONVB, I_FDN, I_GFIN };

__device__ __forceinline__ void transpose_item(const float* W, int K, int N, bf16* WT, int dest_row0, LAS float* scr, int kb, int n0, int lane) {
    const int k0 = 64 * kb;
    { f32x4 t[8];
#pragma unroll
      for (int i = 0; i < 8; ++i) t[i] = __builtin_nontemporal_load((const GAS f32x4*)(W + (size_t)(k0 + 8 * i + (lane >> 3)) * N + n0 + 4 * (lane & 7)));
#pragma unroll
      for (int i = 0; i < 8; ++i) { LAS float* d = scr + (8 * i + (lane >> 3)) * 33 + 4 * (lane & 7); d[0] = t[i][0]; d[1] = t[i][1]; d[2] = t[i][2]; d[3] = t[i][3]; } }
    LDS_WAIT(); asm volatile("" ::: "memory");
    const int c = lane & 7;
#pragma unroll
    for (int j = 0; j < 4; ++j) { const int n = (lane >> 3) + 8 * j; const LAS float* s = scr + (8 * c) * 33 + n;
        v4u o; o.x = pk2(s[0 * 33], s[1 * 33]); o.y = pk2(s[2 * 33], s[3 * 33]); o.z = pk2(s[4 * 33], s[5 * 33]); o.w = pk2(s[6 * 33], s[7 * 33]);
        *(GAS v4u*)(WT + (size_t)(dest_row0 + n) * K + k0 + 8 * c) = o; }
    LDS_WAIT(); asm volatile("" ::: "memory");
}
__device__ __forceinline__ void ph_prologue(Frame& F) {
    PHASE_ENTRY();
    unsigned char* ws = A->ws;
    if (F.bid < 192) {
        const int l = F.bid / 96, j0 = (F.bid % 96) * 128;
        LAS float* ST = (LAS float*)F.lds;
        const float* Wl = A->in[I_WADA] + (size_t)l * DMOD * MODW;
        float acc[NMODB][2];
#pragma unroll
        for (int b = 0; b < NMODB; ++b) { acc[b][0] = 0.f; acc[b][1] = 0.f; }
        for (int kh = 0; kh < 2; ++kh) {
            __syncthreads();
            for (int idx = F.tid; idx < 1024 * NMODB; idx += NWAVES * 64) { const int kk = idx / NMODB, b = idx % NMODB;
                const float c = (b == 0) ? A->in[I_CP][kh * 1024 + kk] : A->in[I_CS][(size_t)(b - 1) * DMOD + kh * 1024 + kk];
                ST[kk * 20 + b] = c / (1.f + __expf(-c)); }
            __syncthreads();
#pragma unroll 4
            for (int k = 0; k < 128; ++k) { const int kk = F.wave * 128 + k;
                const f32x2 w = __builtin_nontemporal_load((const GAS f32x2*)(Wl + (size_t)(kh * 1024 + kk) * MODW + j0 + 2 * F.lane));
                const LAS f32x4* sp = (const LAS f32x4*)(ST + kk * 20);
                const f32x4 s0 = sp[0], s1 = sp[1], s2 = sp[2], s3 = sp[3]; const float s16 = ST[kk * 20 + 16];
#pragma unroll
                for (int b = 0; b < 4; ++b) { acc[b][0] += s0[b] * w.x; acc[b][1] += s0[b] * w.y; acc[4 + b][0] += s1[b] * w.x; acc[4 + b][1] += s1[b] * w.y;
                    acc[8 + b][0] += s2[b] * w.x; acc[8 + b][1] += s2[b] * w.y; acc[12 + b][0] += s3[b] * w.x; acc[12 + b][1] += s3[b] * w.y; }
                acc[16][0] += s16 * w.x; acc[16][1] += s16 * w.y; }
        }
        __syncthreads();
        LAS float* RED = (LAS float*)F.lds;
#pragma unroll
        for (int b = 0; b < NMODB; ++b) { RED[(F.wave * NMODB + b) * 128 + 2 * F.lane] = acc[b][0]; RED[(F.wave * NMODB + b) * 128 + 2 * F.lane + 1] = acc[b][1]; }
        __syncthreads();
        float* MOD = (float*)(ws + WS_MOD);
        for (int idx = F.tid; idx < NMODB * 128; idx += NWAVES * 64) { const int b = idx >> 7, j = idx & 127; float s = 0.f;
#pragma unroll
            for (int w = 0; w < 8; ++w) s += RED[(w * NMODB + b) * 128 + j];
            MOD[(size_t)(l * NMODB + b) * MODW + j0 + j] = s + A->in[I_BADA][(size_t)l * MODW + j0 + j]; }
        __syncthreads();
    }
    { const int gt = F.bid * (NWAVES * 64) + F.tid, ngt = F.G * NWAVES * 64;
      for (int idx = gt; idx < NLAYER * 56 * 1024; idx += ngt) { const int l = idx / (56 * 1024), rem = idx % (56 * 1024), ch = rem >> 10, j = rem & 1023;
          const float* src; bf16* dst; int k0;
          bf16* LB = (bf16*)(ws + WS_LORA + (size_t)l * LORA_LAYER);
          if (ch < 12) { k0 = 8 * ch; src = A->in[I_W2] + ((size_t)l * 96 + k0) * 1024 + j; dst = LB + (size_t)j * 96 + k0; }
          else if (ch < 24) { k0 = 8 * (ch - 12); src = A->in[I_A2] + ((size_t)l * 96 + k0) * 1024 + j; dst = LB + (size_t)1024 * 96 + (size_t)j * 96 + k0; }
          else { k0 = 8 * (ch - 24); src = A->in[I_G2] + ((size_t)l * 256 + k0) * 1024 + j; dst = LB + (size_t)2 * 1024 * 96 + (size_t)j * 256 + k0; }
          v4u o; o.x = pk2(src[0], src[1024]); o.y = pk2(src[2048], src[3072]); o.z = pk2(src[4096], src[5120]); o.w = pk2(src[6144], src[7168]);
          *(GAS v4u*)dst = o; }
      for (int idx = gt; idx < NLAYER * 64 * DMOD / 8; idx += ngt) { const int l = idx / (64 * DMOD / 8), rem = idx % (64 * DMOD / 8);
          *(GAS v4u*)((bf16*)(ws + WS_WIN) + (size_t)l * NIN_PAD * DMOD + (size_t)NRC * DMOD + (size_t)rem * 8) = (v4u){0u, 0u, 0u, 0u}; }
    }
    __syncthreads();
    LAS float* scr = (LAS float*)(F.lds + F.wave * 16384);
    const int gw = F.bid * NWAVES + F.wave, NGW = F.G * NWAVES;
    constexpr int IT_IN = 32 * (NIN / 32), IT_OUT = 32 * 64, IT_UP = 32 * (NUP / 32), IT_DN = (DFF / 64) * 64, IT_L = IT_IN + IT_OUT + IT_UP + IT_DN;
    for (int it = gw; it < NLAYER * IT_L; it += NGW) {
        const int l = it / IT_L; int r = it % IT_L;
        if (r < IT_IN) { const int nb = r % (NIN / 32), kb = r / (NIN / 32), n0 = 32 * nb;
            transpose_item(A->in[I_WIN] + (size_t)l * DMOD * NIN, DMOD, NIN, (bf16*)(ws + WS_WIN) + (size_t)l * NIN_PAD * DMOD, n0 < NRC ? n0 : n0 + 64, scr, kb, n0, F.lane); continue; }
        r -= IT_IN;
        if (r < IT_OUT) { const int nb = r % 64, kb = r / 64;
            transpose_item(A->in[I_WOUT] + (size_t)l * DMOD * DMOD, DMOD, DMOD, (bf16*)(ws + WS_WOUT) + (size_t)l * DMOD * DMOD, 32 * nb, scr, kb, 32 * nb, F.lane); continue; }
        r -= IT_OUT;
        if (r < IT_UP) { const int nb = r % (NUP / 32), kb = r / (NUP / 32), n0 = 32 * nb; const int j = n0 < DFF ? n0 : n0 - DFF;
            const int dr = (j >> 7) * 256 + (n0 < DFF ? 0 : 128) + (j & 127);
            transpose_item(A->in[I_FUP] + (size_t)l * DMOD * NUP, DMOD, NUP, (bf16*)(ws + WS_WUP) + (size_t)l * NUP * DMOD, dr, scr, kb, n0, F.lane); continue; }
        r -= IT_UP;
        { const int nb = r % 64, kb = r / 64;
            transpose_item(A->in[I_FDN] + (size_t)l * DFF * DMOD, DFF, DMOD, (bf16*)(ws + WS_WDN) + (size_t)l * DMOD * DFF, 32 * nb, scr, kb, 32 * nb, F.lane); }
    }
}

__device__ __forceinline__ void ph_norm(Frame& F, int l, int mode, int nslab) {
    PHASE_ENTRY();
    const int gw = F.bid * NWAVES + F.wave, NGW = F.G * NWAVES;
    const float* X = (const float*)(A->ws + WS_X); bf16* H = (bf16*)(A->ws + WS_H);
    const float* g = (mode == 0 ? A->in[I_GMIX] + (size_t)l * DMOD : mode == 1 ? A->in[I_GFFN] + (size_t)l * DMOD : A->in[I_GFIN]);
    f32x4 gv[8];
#pragma unroll
    for (int j = 0; j < 8; ++j) gv[j] = *(const GAS f32x4*)(g + 4 * F.lane + 256 * j);
    for (int m = gw; m < MT; m += NGW) {
        const float* xr = (mode == 0 && l == 0) ? (m < MP ? A->in[I_XP] + (size_t)m * DMOD : A->in[I_XS] + (size_t)(m - MP) * DMOD) : X + (size_t)m * DMOD;
        f32x4 v[8]; float ss = 0.f;
#pragma unroll
        for (int j = 0; j < 8; ++j) v[j] = *(const GAS f32x4*)(xr + 4 * F.lane + 256 * j);
        if (m >= MP && nslab > 0) { const float* sl = (const float*)(A->ws + WS_SLAB) + (size_t)(m - MP) * DMOD;
            for (int s = 0; s < nslab; ++s)
#pragma unroll
                for (int j = 0; j < 8; ++j) v[j] += *(const GAS f32x4*)(sl + (size_t)s * 256 * DMOD + 4 * F.lane + 256 * j);
            if (mode < 2) { float* xw = (float*)(A->ws + WS_X) + (size_t)m * DMOD;
#pragma unroll
                for (int j = 0; j < 8; ++j) *(GAS f32x4*)(xw + 4 * F.lane + 256 * j) = v[j]; } }
#pragma unroll
        for (int j = 0; j < 8; ++j) ss += (v[j].x * v[j].x + v[j].y * v[j].y) + (v[j].z * v[j].z + v[j].w * v[j].w);
        const float rstd = 1.f / sqrtf(wave_sum(ss) * (1.f / DMOD) + 1e-6f);
        if (mode < 2) {
            const int bidx = m < MP ? 0 : 1 + ((m - MP) >> 4);
            const float* mod = (const float*)(A->ws + WS_MOD) + (size_t)(l * NMODB + bidx) * MODW + (mode == 0 ? 0 : 3 * DMOD);
            GAS unsigned long long* o8 = (GAS unsigned long long*)(H + (size_t)m * DMOD) + F.lane;
#pragma unroll
            for (int j = 0; j < 8; ++j) { const f32x4 sh = *(const GAS f32x4*)(mod + 4 * F.lane + 256 * j), sc = *(const GAS f32x4*)(mod + DMOD + 4 * F.lane + 256 * j);
                const f32x4 y = (v[j] * rstd * gv[j]) * (sc + 1.0f) + sh;
                o8[64 * j] = (unsigned long long)pk2(y.x, y.y) | ((unsigned long long)pk2(y.z, y.w) << 32); }
        } else {
            float* o = (m < MP) ? A->out + O_YP + (size_t)m * DMOD : A->out + O_YS + (size_t)(m - MP) * DMOD;
#pragma unroll
            for (int j = 0; j < 8; ++j) __builtin_nontemporal_store(v[j] * rstd * gv[j], (GAS f32x4*)(o + 4 * F.lane + 256 * j));
        }
    }
}
typedef float f32x4m __attribute__((ext_vector_type(4)));
__device__ __forceinline__ void mm_tiles(f32x4 (&acc)[2], const LAS unsigned char* X, const LAS unsigned char* Y, int wave, int lane) {
    const int mt = wave >> 1, nt0 = 2 * (wave & 1), c = lane & 15, q = lane >> 4;
    const LAS unsigned char* xp = X + (16 * mt + c) * 144 + q * 16;
    const bf16x8 x0 = *(const LAS bf16x8*)xp, x1 = *(const LAS bf16x8*)(xp + 64);
#pragma unroll
    for (int t = 0; t < 2; ++t) { const LAS unsigned char* yp = Y + (16 * (nt0 + t) + c) * 144 + q * 16;
        const bf16x8 y0 = *(const LAS bf16x8*)yp, y1 = *(const LAS bf16x8*)(yp + 64);
        acc[t] = __builtin_amdgcn_mfma_f32_16x16x32_bf16(y0, x0, acc[t], 0, 0, 0);
        acc[t] = __builtin_amdgcn_mfma_f32_16x16x32_bf16(y1, x1, acc[t], 0, 0, 0); }
}
__device__ __forceinline__ void st_tiles(LAS unsigned char* D, const f32x4 (&acc)[2], int wave, int lane) {
    const int mt = wave >> 1, nt0 = 2 * (wave & 1), c = lane & 15, q = lane >> 4;
#pragma unroll
    for (int t = 0; t < 2; ++t) { v2u w; w.x = pk2(acc[t][0], acc[t][1]); w.y = pk2(acc[t][2], acc[t][3]); *(LAS v2u*)(D + (16 * mt + c) * 144 + (16 * (nt0 + t) + 4 * q) * 2) = w; }
}
#define RW_ZERO(a) do { a[0] = (f32x4){0.f, 0.f, 0.f, 0.f}; a[1] = a[0]; } while (0)
template <int MODE> __device__ __forceinline__ void mask_tiles(f32x4 (&acc)[2], int wave, int lane) {
    const int m = 16 * (wave >> 1) + (lane & 15), nb = 32 * (wave & 1) + 4 * (lane >> 4);
#pragma unroll
    for (int t = 0; t < 2; ++t)
#pragma unroll
        for (int i = 0; i < 4; ++i) { const int n = nb + 16 * t + i; const bool keep = MODE == 0 ? (n < m) : MODE == 1 ? (n > m) : (n <= m); if (!keep) acc[t][i] = 0.f; }
}

__device__ __forceinline__ void rwkv_passA_unit(ArgsP A, Frame& F, int l, int u, bool reuse) {
    unsigned char* ws = A->ws;
    const int tid = F.tid, lane = F.lane, wave = F.wave;
    const float* PR = (const float*)(ws + WS_PR);
    int h, row0, nvalid; const float* prev0;
    if (u < 2048) { h = u >> 7; const int c = u & 127; row0 = 64 * c; nvalid = 64; prev0 = c > 0 ? PR + (size_t)(row0 - 1) * NRC_PAD : nullptr; }
    else { const int su = u - 2048, sb = su >> 4; h = su & 15; row0 = MP + sb * TS; nvalid = TS; prev0 = A->in[I_SSHIFT] + (size_t)(l * NSB + sb) * NRC; }
    const float* mu = A->in[I_MU] + (size_t)l * NRC;
    LAS unsigned char* L = F.lds;
#define SL(i) (L + (i) * RW_SLOT)
    LAS unsigned short* TW = (LAS unsigned short*)(L), *XA = (LAS unsigned short*)(L + 13312), *SG = (LAS unsigned short*)(L + 26624);
    LAS float* WLf = (LAS float*)(L + 64512), *ALf = (LAS float*)(L + 81920), *GLf = (LAS float*)(L + 99328);
    LAS float* AT32 = (LAS float*)(L + 92160), *A32 = (LAS float*)(L + 109568), *AKV32 = (LAS float*)(L);
    LAS unsigned char* sAAK = L + 126976, *sARB = L + 136192, *sARK = L + 145408;
    LAS float* SEG = (LAS float*)(L + 154624), *WLV = SEG + 512;
    bf16x8 yg_[8][2];
    { const int nt0 = 2 * (wave & 1), c = lane & 15, q = lane >> 4; const bf16* LB = (const bf16*)(ws + WS_LORA + (size_t)l * LORA_LAYER);
#pragma unroll
      for (int t = 0; t < 2; ++t) { const int j = h * 64 + 16 * (nt0 + t) + c;
#pragma unroll
          for (int s = 0; s < 8; ++s) yg_[s][t] = *(const GAS bf16x8*)(LB + (size_t)2 * 1024 * 96 + (size_t)j * 256 + 8 * q + 32 * s); } }
    { unsigned char* lscr = ws + WS_LSCR + (size_t)F.bid * 61440;
      if (reuse) { v4u tmp[8];
#pragma unroll
          for (int b = 0; b < 8; ++b) { const int i = tid + b * (NWAVES * 64); if (i < 60416 / 16) tmp[b] = *(const GAS v4u*)(lscr + i * 16); }
#pragma unroll
          for (int b = 0; b < 8; ++b) { const int i = tid + b * (NWAVES * 64); if (i < 60416 / 16) *(LAS v4u*)(L + i * 16) = tmp[b]; } }
      else {
        for (int it = 0; it < 56; it += 8) { float cur[8], prv[8], mm_[8];
#pragma unroll
            for (int b = 0; b < 8; ++b) { const int idx = tid + (it + b) * (NWAVES * 64), t = idx / 448, col = 3072 + idx % 448; cur[b] = 0.f; prv[b] = 0.f; mm_[b] = mu[col];
                if (t < nvalid) { cur[b] = PR[(size_t)(row0 + t) * NRC_PAD + col]; prv[b] = t > 0 ? PR[(size_t)(row0 + t - 1) * NRC_PAD + col] : (prev0 ? prev0[col] : 0.f); } }
#pragma unroll
            for (int b = 0; b < 8; ++b) { const int idx = tid + (it + b) * (NWAVES * 64), t = idx / 448, cc = idx % 448; const float xm = cur[b] + (prv[b] - cur[b]) * mm_[b];
                if (cc < 96) { const float e = __expf(2.f * xm); TW[t * 104 + cc] = (unsigned short)f2bf(1.f - 2.f * __builtin_amdgcn_rcpf(e + 1.f)); }
                else if (cc < 192) XA[t * 104 + cc - 96] = (unsigned short)f2bf(xm);
                else SG[t * 264 + cc - 192] = (unsigned short)f2bf(sigmoidf_(xm)); } }
        if (u < 2048) { __syncthreads(); for (int i = tid; i < 60416 / 16; i += NWAVES * 64) *(GAS v4u*)(lscr + i * 16) = *(const LAS v4u*)(L + i * 16); }
      } }
    __syncthreads();
    { const int mt = wave >> 1, nt0 = 2 * (wave & 1), c = lane & 15, q = lane >> 4;
      const bf16* LB = (const bf16*)(ws + WS_LORA + (size_t)l * LORA_LAYER);
      f32x4 aw[2], aa[2], ag[2]; RW_ZERO(aw); RW_ZERO(aa); RW_ZERO(ag);
#pragma unroll
      for (int s = 0; s < 3; ++s) { const bf16x8 xw = *(const LAS bf16x8*)((LAS unsigned char*)TW + (16 * mt + c) * 208 + (8 * q + 32 * s) * 2), xa = *(const LAS bf16x8*)((LAS unsigned char*)XA + (16 * mt + c) * 208 + (8 * q + 32 * s) * 2);
#pragma unroll
          for (int t = 0; t < 2; ++t) { const int j = h * 64 + 16 * (nt0 + t) + c;
              const bf16x8 yw = *(const GAS bf16x8*)(LB + (size_t)j * 96 + 8 * q + 32 * s), ya = *(const GAS bf16x8*)(LB + (size_t)1024 * 96 + (size_t)j * 96 + 8 * q + 32 * s);
              aw[t] = __builtin_amdgcn_mfma_f32_16x16x32_bf16(yw, xw, aw[t], 0, 0, 0); aa[t] = __builtin_amdgcn_mfma_f32_16x16x32_bf16(ya, xa, aa[t], 0, 0, 0); } }
#pragma unroll
      for (int s = 0; s < 8; ++s) { const bf16x8 xg = *(const LAS bf16x8*)((LAS unsigned char*)SG + (16 * mt + c) * 528 + (8 * q + 32 * s) * 2);
#pragma unroll
          for (int t = 0; t < 2; ++t) { const int j = h * 64 + 16 * (nt0 + t) + c; const bf16x8 yg = yg_[s][t];
              ag[t] = __builtin_amdgcn_mfma_f32_16x16x32_bf16(yg, xg, ag[t], 0, 0, 0); } }
#pragma unroll
      for (int t = 0; t < 2; ++t) { const int o = (16 * mt + c) * 68 + 16 * (nt0 + t) + 4 * q; *(LAS f32x4*)(WLf + o) = aw[t]; *(LAS f32x4*)(ALf + o) = aa[t]; *(LAS f32x4*)(GLf + o) = ag[t]; }
    }
    __syncthreads();
    {
        const int j = lane, hj = h * 64 + j, seg = wave;
        const float mu_r = mu[hj], mu_k = mu[1024 + hj], mu_v = mu[2048 + hj];
        const float w0 = A->in[I_W0][l * 1024 + hj], a0 = A->in[I_A0][l * 1024 + hj], kkw = A->in[I_KK][l * 1024 + hj], kaw = A->in[I_KA][l * 1024 + hj], rkw = A->in[I_RK][l * 1024 + hj];
        const float lnw = A->in[I_LNW][l * 1024 + hj], lnb = A->in[I_LNB][l * 1024 + hj];
        float logw[8], xr[8], xv[8], kk[8], bb[8], km[8], cs[8];
        float* G1 = (float*)(ws + WS_G1); float* G2 = (float*)(ws + WS_G2);
        float run = 0.f;
        float cr9[9], ck9[9], cv9[9];
#pragma unroll
        for (int i = 0; i < 9; ++i) { const int t = 8 * seg + i - 1; const float* pr = (t < 0) ? prev0 : (t < nvalid ? PR + (size_t)(row0 + t) * NRC_PAD : nullptr);
            cr9[i] = pr ? pr[hj] : 0.f; ck9[i] = pr ? pr[1024 + hj] : 0.f; cv9[i] = pr ? pr[2048 + hj] : 0.f; }
        asm volatile("" ::: "memory");
#pragma unroll
        for (int i = 0; i < 8; ++i) { const int t = 8 * seg + i; const bool valid = t < nvalid;
            float r_ = 0.f, k_ = 0.f, v_ = 0.f;
            if (valid) { const float cr = cr9[i + 1], ck = ck9[i + 1], cv = cv9[i + 1], qr = cr9[i], qk = ck9[i], qv = cv9[i];
                r_ = cr + (qr - cr) * mu_r; k_ = ck + (qk - ck) * mu_k; v_ = cv + (qv - cv) * mu_v; }
            const float wl = WLf[t * 68 + j], al = ALf[t * 68 + j], gl = GLf[t * 68 + j];
            const float lw = valid ? -0.6065306597126334f * sigmoidf_(w0 + wl) : 0.f;
            const float a_ = sigmoidf_(a0 + al);
            const float kkr = k_ * kkw; const float nrm = wave_sum(kkr * kkr); const float kk_ = kkr * __builtin_amdgcn_rsqf(fmaxf(nrm, 1e-24f));
            const float km_ = k_ * (1.f + (a_ - 1.f) * kaw);
            const float ct = wave_sum(r_ * km_ * rkw);
            if (valid) { const size_t go = (size_t)(row0 + t) * 1024 + hj; G1[go] = lnw * gl; G2[go] = (lnb + ct * v_) * gl; }
            run += lw; logw[i] = lw; cs[i] = run; xr[i] = r_; xv[i] = v_; kk[i] = kk_; bb[i] = kk_ * a_; km[i] = km_; }
        SEG[seg * 64 + j] = run;
        __syncthreads();
        float off = 0.f, tot = 0.f;
#pragma unroll
        for (int s = 0; s < 8; ++s) { const float v = SEG[s * 64 + j]; tot += v; if (s < seg) off += v; }
        if (seg == 0) WLV[j] = __expf(tot);
        LAS unsigned short* AT = (LAS unsigned short*)SL(0), *ATL = (LAS unsigned short*)SL(1), *BH = (LAS unsigned short*)SL(2), *BHL = (LAS unsigned short*)SL(3), *KH = (LAS unsigned short*)SL(4), *RT = (LAS unsigned short*)SL(5);
        unsigned pvt[4], pbt[4], pbl[4], pkt[4];
#pragma unroll
        for (int i = 0; i < 8; i += 2) { float v2[2], bt2[2], bl2[2], kt2[2];
#pragma unroll
            for (int e = 0; e < 2; ++e) { const int ii = i + e, t = 8 * seg + ii; const float ci = off + cs[ii], ce = ci - logw[ii];
                const float winc = __expf(ci), wexc = __expf(ce), winv = __expf(-ci), wrem = __expf(tot - ci);
                const float at = -kk[ii] * wexc, rt = xr[ii] * winc, bh = bb[ii] * winv, kh = km[ii] * winv, bt = bb[ii] * wrem, kt = km[ii] * wrem;
                const unsigned ath = f2bf(at), bhh = f2bf(bh), bth = f2bf(bt);
                AT[t * RW_STRIDE + j] = (unsigned short)ath; ATL[t * RW_STRIDE + j] = (unsigned short)f2bf(at - bf2f((unsigned short)ath)); AT32[t * 68 + j] = at;
                BH[t * RW_STRIDE + j] = (unsigned short)bhh; BHL[t * RW_STRIDE + j] = (unsigned short)f2bf(bh - bf2f((unsigned short)bhh));
                KH[t * RW_STRIDE + j] = (unsigned short)f2bf(kh); RT[t * RW_STRIDE + j] = (unsigned short)f2bf(rt);
                v2[e] = xv[ii]; bt2[e] = bf2f((unsigned short)bth); bl2[e] = bt - bf2f((unsigned short)bth); kt2[e] = kt; }
            pvt[i >> 1] = pk2(v2[0], v2[1]); pbt[i >> 1] = pk2(bt2[0], bt2[1]); pbl[i >> 1] = pk2(bl2[0], bl2[1]); pkt[i >> 1] = pk2(kt2[0], kt2[1]); }
        *(LAS v4u*)(SL(6) + j * 144 + seg * 16) = (v4u){pvt[0], pvt[1], pvt[2], pvt[3]};
        *(LAS v4u*)(SL(7) + j * 144 + seg * 16) = (v4u){pbt[0], pbt[1], pbt[2], pbt[3]};
        *(LAS v4u*)(SL(8) + j * 144 + seg * 16) = (v4u){pbl[0], pbl[1], pbl[2], pbl[3]};
        *(LAS v4u*)(SL(9) + j * 144 + seg * 16) = (v4u){pkt[0], pkt[1], pkt[2], pkt[3]};
    }
    __syncthreads();
    { f32x4 a[2]; const int mt = wave >> 1, nt0 = 2 * (wave & 1), c = lane & 15, q = lane >> 4, m = 16 * mt + c;
      RW_ZERO(a); mm_tiles(a, SL(0), SL(2), wave, lane); mm_tiles(a, SL(1), SL(2), wave, lane); mm_tiles(a, SL(0), SL(3), wave, lane); mask_tiles<0>(a, wave, lane);
#pragma unroll
      for (int t = 0; t < 2; ++t) *(LAS f32x4*)(A32 + m * 68 + 16 * (nt0 + t) + 4 * q) = a[t];
      RW_ZERO(a); mm_tiles(a, SL(0), SL(4), wave, lane); mask_tiles<0>(a, wave, lane); st_tiles(sAAK, a, wave, lane);
      RW_ZERO(a); mm_tiles(a, SL(5), SL(2), wave, lane); mask_tiles<2>(a, wave, lane); st_tiles(sARB, a, wave, lane);
      RW_ZERO(a); mm_tiles(a, SL(5), SL(4), wave, lane); mask_tiles<2>(a, wave, lane); st_tiles(sARK, a, wave, lane); }
    __syncthreads();
    { f32x4 a[2]; const int mt = wave >> 1, nt0 = 2 * (wave & 1), c = lane & 15, q = lane >> 4, m = 16 * mt + c;
      RW_ZERO(a); mm_tiles(a, sAAK, SL(6), wave, lane);
#pragma unroll
      for (int t = 0; t < 2; ++t) *(LAS f32x4*)(AKV32 + m * 68 + 16 * (nt0 + t) + 4 * q) = a[t]; }
    __syncthreads();
    { const int c = lane & 15, q = lane >> 4;
      LAS float* R = (wave < 4) ? AT32 + 16 * wave : AKV32 + 16 * (wave - 4);
      LAS float* Rc = (wave == 0 ? AT32 : AKV32) + lane;
#pragma unroll
      for (int i = 0; i < 4; ++i) {
          if (i > 0) {
              f32x4 acc;
#pragma unroll
              for (int g = 0; g < 4; ++g) acc[g] = R[(16 * i + 4 * q + g) * 68 + c];
#pragma unroll
              for (int j = 0; j < i; ++j)
#pragma unroll
                  for (int s = 0; s < 4; ++s) { const float a = A32[(16 * i + c) * 68 + 16 * j + 4 * s + q], b = R[(16 * j + 4 * s + q) * 68 + c];
                      acc = __builtin_amdgcn_mfma_f32_16x16x4f32(a, b, acc, 0, 0, 0); }
#pragma unroll
              for (int g = 0; g < 4; ++g) R[(16 * i + 4 * q + g) * 68 + c] = acc[g];
              __syncthreads();
          }
          if (wave < 2) {
              const LAS float* a32 = A32 + (16 * i) * 68 + 16 * i; asm volatile("" : "+v"(a32));
              float x[16];
#pragma unroll
              for (int rr = 0; rr < 16; ++rr) x[rr] = Rc[(16 * i + rr) * 68];
#pragma unroll
              for (int rg = 0; rg < 4; ++rg) {
                  f32x4 cf[4][4];
#pragma unroll
                  for (int r4 = 0; r4 < 4; ++r4)
#pragma unroll
                      for (int g = 0; g <= rg; ++g) if (4 * g < 4 * rg + r4) cf[r4][g] = *(const LAS f32x4*)(a32 + (4 * rg + r4) * 68 + 4 * g);
#pragma unroll
                  for (int r4 = 0; r4 < 4; ++r4) { const int rr = 4 * rg + r4; if (rr == 0) continue; float s0 = x[rr], s1 = 0.f;
#pragma unroll
                      for (int g = 0; g <= rg; ++g) if (4 * g < rr) { s0 += cf[r4][g][0] * x[4 * g]; if (4 * g + 1 < rr) s1 += cf[r4][g][1] * x[4 * g + 1]; if (4 * g + 2 < rr) s0 += cf[r4][g][2] * x[4 * g + 2]; if (4 * g + 3 < rr) s1 += cf[r4][g][3] * x[4 * g + 3]; }
                      x[rr] = s0 + s1; }
                  asm volatile("" ::: "memory");
              }
#pragma unroll
              for (int rr = 1; rr < 16; ++rr) Rc[(16 * i + rr) * 68] = x[rr];
          }
          __syncthreads();
      }
      { const int cc = tid & 127, g16 = tid >> 7; const LAS float* src = (cc < 64 ? AT32 + cc : AKV32 + (cc - 64)) + (16 * g16) * 68;
        unsigned hh[16]; float lo[16];
#pragma unroll
        for (int rr = 0; rr < 16; ++rr) { const float v = src[rr * 68]; hh[rr] = f2bf(v); lo[rr] = v - bf2f((unsigned short)hh[rr]); }
        LAS unsigned char* dh = (cc < 64 ? SL(2) + cc * 144 : SL(4) + (cc - 64) * 144) + g16 * 32;
        *(LAS v4u*)dh = (v4u){hh[0] | (hh[1] << 16), hh[2] | (hh[3] << 16), hh[4] | (hh[5] << 16), hh[6] | (hh[7] << 16)};
        *(LAS v4u*)(dh + 16) = (v4u){hh[8] | (hh[9] << 16), hh[10] | (hh[11] << 16), hh[12] | (hh[13] << 16), hh[14] | (hh[15] << 16)};
        if (cc < 64) { LAS unsigned char* dl = SL(3) + cc * 144 + g16 * 32;
            *(LAS v4u*)dl = (v4u){pk2(lo[0], lo[1]), pk2(lo[2], lo[3]), pk2(lo[4], lo[5]), pk2(lo[6], lo[7])};
            *(LAS v4u*)(dl + 16) = (v4u){pk2(lo[8], lo[9]), pk2(lo[10], lo[11]), pk2(lo[12], lo[13]), pk2(lo[14], lo[15])}; } }
    }
    __syncthreads();
    { const int mt = wave >> 1, nt0 = 2 * (wave & 1), c = lane & 15, q = lane >> 4, m = 16 * mt + c;
      float* PTg = (float*)(ws + WS_PT32) + (size_t)u * 4096; float* QQg = (float*)(ws + WS_QQ) + (size_t)u * 4096; bf16* RPg = (bf16*)(ws + WS_RP) + (size_t)u * 4096; float* YVg = (float*)(ws + WS_YV) + (size_t)u * 4096;
      f32x4 a[2];
      RW_ZERO(a); mm_tiles(a, sARB, SL(2), wave, lane); mm_tiles(a, sARB, SL(3), wave, lane);
#pragma unroll
      for (int t = 0; t < 2; ++t) { const int n = 16 * (nt0 + t) + 4 * q; const v2u rr = *(const LAS v2u*)(SL(5) + m * 144 + n * 2);
          v2u w; w.x = pk2(a[t][0] + bf2f((unsigned short)(rr.x & 0xffffu)), a[t][1] + bf2f((unsigned short)(rr.x >> 16))); w.y = pk2(a[t][2] + bf2f((unsigned short)(rr.y & 0xffffu)), a[t][3] + bf2f((unsigned short)(rr.y >> 16)));
          *(GAS v2u*)(RPg + m * 64 + n) = w; }
      RW_ZERO(a); mm_tiles(a, sARB, SL(4), wave, lane); mm_tiles(a, sARK, SL(6), wave, lane);
#pragma unroll
      for (int t = 0; t < 2; ++t) *(GAS f32x4*)(YVg + m * 64 + 16 * (nt0 + t) + 4 * q) = a[t];
      if (tid < 64) ((float*)(ws + WS_WL))[(size_t)u * 64 + tid] = WLV[tid];
      RW_ZERO(a); mm_tiles(a, SL(7), SL(2), wave, lane); mm_tiles(a, SL(8), SL(2), wave, lane); mm_tiles(a, SL(7), SL(3), wave, lane);
#pragma unroll
      for (int t = 0; t < 2; ++t) *(GAS f32x4*)(PTg + m * 64 + 16 * (nt0 + t) + 4 * q) = a[t];
      RW_ZERO(a); mm_tiles(a, SL(4), SL(7), wave, lane); mm_tiles(a, SL(6), SL(9), wave, lane);
#pragma unroll
      for (int t = 0; t < 2; ++t) *(GAS f32x4*)(QQg + m * 64 + 16 * (nt0 + t) + 4 * q) = a[t];
    }
    __syncthreads();
#undef SL
}
__device__ __forceinline__ void wait_count(Frame& F, unsigned* cnt, unsigned target) {
    if (F.tid == 0) { unsigned* bar = (unsigned*)(F.ctl + CW_BAR);
        XB_SPIN(xb_ld(cnt) < target, bar);
        __builtin_amdgcn_fence(__ATOMIC_ACQUIRE, "agent"); asm volatile("s_waitcnt vmcnt(0)" ::: "memory"); }
    __syncthreads();
}
__device__ __forceinline__ void ph_rwkv_passA(Frame& F, int l) {
    PHASE_ENTRY();
    if (F.G == 256) wait_count(F, (unsigned*)(F.ctl + CW_QUEUE + 1024 + 64 * l), (unsigned)((MT / 256) * (NRC_PAD / 256)));
    int pu = -1;
    int u0 = F.bid, ustep = F.G, uend = RW_UNITS;
    if (F.G == 256) {
        const int r = F.bid & 127, sec = F.bid >> 7, nf = (r < (MT / 256) * (NIN_PAD / 256) - 768) ? 8 : 9;
        u0 = r + 128 * (sec ? nf : 0); ustep = 128; uend = r + 128 * (sec ? 18 : nf); }
    for (int u = u0; u < uend; u += ustep) { const bool reuse = (pu >= 0 && u < 2048 && (u & 127) == (pu & 127)); rwkv_passA_unit(A, F, l, u, reuse); pu = u; }
}

struct ChainOps { f32x4 pt[4]; f32x4 qq[2]; f32x4 wl; };
__device__ __forceinline__ void rwkv_chain_load(ChainOps& o, const float* PTg, const float* QQg, const float* WLg, int wave, int lane) {
    const int tk = wave & 3, tv0 = 2 * (wave >> 2), c = lane & 15, q = lane >> 4;
#pragma unroll
    for (int s = 0; s < 2; ++s) { o.pt[2 * s] = *(const GAS f32x4*)(PTg + (16 * tk + c) * 64 + 8 * q + 32 * s); o.pt[2 * s + 1] = *(const GAS f32x4*)(PTg + (16 * tk + c) * 64 + 8 * q + 32 * s + 4); }
#pragma unroll
    for (int t = 0; t < 2; ++t) o.qq[t] = *(const GAS f32x4*)(QQg + (16 * (tv0 + t) + c) * 64 + 16 * tk + 4 * q);
    o.wl = *(const GAS f32x4*)(WLg + 16 * tk + 4 * q);
}
__device__ __forceinline__ void rwkv_chain_step(f32x4 (&acc)[2], const ChainOps& o, const LAS unsigned char* Shi, const LAS unsigned char* Slo, int wave, int lane) {
    const int tv0 = 2 * (wave >> 2), c = lane & 15, q = lane >> 4;
    bf16x8 ph[2], pl[2];
#pragma unroll
    for (int s = 0; s < 2; ++s) { const f32x4 x0 = o.pt[2 * s], x1 = o.pt[2 * s + 1];
        unsigned h[8]; float lo[8];
#pragma unroll
        for (int i = 0; i < 4; ++i) { h[i] = f2bf(x0[i]); lo[i] = x0[i] - bf2f((unsigned short)h[i]); h[4 + i] = f2bf(x1[i]); lo[4 + i] = x1[i] - bf2f((unsigned short)h[4 + i]); }
        ph[s] = __builtin_bit_cast(bf16x8, (v4u){h[0] | (h[1] << 16), h[2] | (h[3] << 16), h[4] | (h[5] << 16), h[6] | (h[7] << 16)});
        pl[s] = __builtin_bit_cast(bf16x8, (v4u){pk2(lo[0], lo[1]), pk2(lo[2], lo[3]), pk2(lo[4], lo[5]), pk2(lo[6], lo[7])}); }
#pragma unroll
    for (int t = 0; t < 2; ++t) { const int v = 16 * (tv0 + t) + c;
        f32x4 a = o.qq[t] + acc[t] * o.wl;
        const bf16x8 s0 = *(const LAS bf16x8*)(Shi + v * 144 + q * 16), s1 = *(const LAS bf16x8*)(Shi + v * 144 + q * 16 + 64);
        const bf16x8 l0 = *(const LAS bf16x8*)(Slo + v * 144 + q * 16), l1 = *(const LAS bf16x8*)(Slo + v * 144 + q * 16 + 64);
        a = __builtin_amdgcn_mfma_f32_16x16x32_bf16(ph[0], s0, a, 0, 0, 0); a = __builtin_amdgcn_mfma_f32_16x16x32_bf16(ph[1], s1, a, 0, 0, 0);
        a = __builtin_amdgcn_mfma_f32_16x16x32_bf16(ph[0], l0, a, 0, 0, 0); a = __builtin_amdgcn_mfma_f32_16x16x32_bf16(ph[1], l1, a, 0, 0, 0);
        a = __builtin_amdgcn_mfma_f32_16x16x32_bf16(pl[0], s0, a, 0, 0, 0); a = __builtin_amdgcn_mfma_f32_16x16x32_bf16(pl[1], s1, a, 0, 0, 0);
        acc[t] = a; }
}
__device__ __forceinline__ void rwkv_state_to_lds(const f32x4 (&acc)[2], LAS unsigned char* Shi, LAS unsigned char* Slo, int wave, int lane) {
    const int tk = wave & 3, tv0 = 2 * (wave >> 2), c = lane & 15, q = lane >> 4;
#pragma unroll
    for (int t = 0; t < 2; ++t) { unsigned h[4]; float lo[4];
#pragma unroll
        for (int i = 0; i < 4; ++i) { h[i] = f2bf(acc[t][i]); lo[i] = acc[t][i] - bf2f((unsigned short)h[i]); }
        const int o = (16 * (tv0 + t) + c) * 144 + (16 * tk + 4 * q) * 2;
        *(LAS v2u*)(Shi + o) = (v2u){h[0] | (h[1] << 16), h[2] | (h[3] << 16)}; *(LAS v2u*)(Slo + o) = (v2u){pk2(lo[0], lo[1]), pk2(lo[2], lo[3])}; }
}
__device__ __forceinline__ void ph_rwkv_chain(Frame& F, int l) {
    PHASE_ENTRY();
    unsigned char* ws = A->ws; const int tid = F.tid, lane = F.lane, wave = F.wave;
    const int tk = wave & 3, tv0 = 2 * (wave >> 2), c = lane & 15, q = lane >> 4;
    LAS unsigned char* HI0 = F.lds, *LO0 = F.lds + RW_SLOT, *HI1 = F.lds + 2 * RW_SLOT, *LO1 = F.lds + 3 * RW_SLOT;
    const float* PT = (const float*)(ws + WS_PT32); const float* QQ = (const float*)(ws + WS_QQ); const float* WL = (const float*)(ws + WS_WL); bf16* SC = (bf16*)(ws + WS_SC);
    if (F.bid < 16) {
        const int h = F.bid;
        f32x4 acc[2]; RW_ZERO(acc);
        rwkv_state_to_lds(acc, HI0, LO0, wave, lane);
        __syncthreads();
        ChainOps ops; rwkv_chain_load(ops, PT + (size_t)(h * 128) * 4096, QQ + (size_t)(h * 128) * 4096, WL + (size_t)(h * 128) * 64, wave, lane);
        for (int cc = 0; cc < 128; ++cc) { const int u = h * 128 + cc; LAS unsigned char* chi = (cc & 1) ? HI1 : HI0, *clo = (cc & 1) ? LO1 : LO0, *nhi = (cc & 1) ? HI0 : HI1, *nlo = (cc & 1) ? LO0 : LO1;
            { const int row = tid >> 3, ch = tid & 7; *(GAS v4u*)((unsigned char*)(SC + (size_t)u * 4096) + tid * 16) = *(const LAS v4u*)(chi + row * 144 + ch * 16); }
            const ChainOps cur = ops;
            if (cc + 1 < 128) rwkv_chain_load(ops, PT + (size_t)(u + 1) * 4096, QQ + (size_t)(u + 1) * 4096, WL + (size_t)(u + 1) * 64, wave, lane);
            rwkv_chain_step(acc, cur, chi, clo, wave, lane);
            rwkv_state_to_lds(acc, nhi, nlo, wave, lane);
            __syncthreads(); }
#ifndef PROBE_SEQ
        float* wo = A->out + O_WP + (size_t)(l * 16 + h) * 4096;
#else
        float* wo = (float*)(A->ws + WS_HALO) + (size_t)h * 4096;
#endif
#pragma unroll
        for (int t = 0; t < 2; ++t) *(GAS f32x4*)(wo + (16 * (tv0 + t) + c) * 64 + 16 * tk + 4 * q) = acc[t];
    } else {
        for (int su = F.bid - 16; su < NSB * 16; su += F.G - 16) { const int u = 2048 + su, sb = su >> 4, h = su & 15;
            const float* S0 = A->in[I_SWKV] + (size_t)((l * NSB + sb) * 16 + h) * 4096;
            f32x4 acc[2];
#pragma unroll
            for (int t = 0; t < 2; ++t) acc[t] = *(const GAS f32x4*)(S0 + (16 * (tv0 + t) + c) * 64 + 16 * tk + 4 * q);
            rwkv_state_to_lds(acc, HI0, LO0, wave, lane);
            __syncthreads();
            { const int row = tid >> 3, ch = tid & 7; *(GAS v4u*)((unsigned char*)(SC + (size_t)u * 4096) + tid * 16) = *(const LAS v4u*)(HI0 + row * 144 + ch * 16); }
            { ChainOps o1; rwkv_chain_load(o1, PT + (size_t)u * 4096, QQ + (size_t)u * 4096, WL + (size_t)u * 64, wave, lane); rwkv_chain_step(acc, o1, HI0, LO0, wave, lane); }
            float* wo = A->out + O_WS + (size_t)((l * NSB + sb) * 16 + h) * 4096;
#pragma unroll
            for (int t = 0; t < 2; ++t) *(GAS f32x4*)(wo + (16 * (tv0 + t) + c) * 64 + 16 * tk + 4 * q) = acc[t];
            __syncthreads(); }
    }
}
__device__ __forceinline__ void ph_rwkv_passC(Frame& F, int l) {
    PHASE_ENTRY();
    unsigned char* ws = A->ws; const int lane = F.lane, wave = F.wave, c = lane & 15, q = lane >> 4, mt = wave & 3;
    const bf16* RP = (const bf16*)(ws + WS_RP); const float* YV = (const float*)(ws + WS_YV); const bf16* SC = (const bf16*)(ws + WS_SC);
    const float* G1 = (const float*)(ws + WS_G1); const float* G2 = (const float*)(ws + WS_G2); bf16* YC = (bf16*)(ws + WS_YCAT);
    bf16x8 rA[2], rB[2], sA[8], sB[8]; f32x4 yA[4], yB[4], gA[8], gB[8];
    auto geo = [&](int u, int& h, int& row0, bool& skip) { const bool samp = u >= 2048;
        if (!samp) { h = u >> 7; row0 = 64 * (u & 127); } else { const int su = u - 2048; h = su & 15; row0 = MP + (su >> 4) * TS; }
        skip = samp && mt > 0; };
    auto load = [&](int u, bf16x8 (&r)[2], bf16x8 (&sv)[8], f32x4 (&y)[4], f32x4 (&g)[8]) { int h, row0; bool skip; geo(u, h, row0, skip); if (skip) return;
        const bf16* RPu = RP + (size_t)u * 4096; const float* YVu = YV + (size_t)u * 4096; const bf16* SCu = SC + (size_t)u * 4096; const int t = 16 * mt + c; const size_t ro = (size_t)(row0 + t);
        r[0] = *(const GAS bf16x8*)(RPu + t * 64 + 8 * q); r[1] = *(const GAS bf16x8*)(RPu + t * 64 + 8 * q + 32);
#pragma unroll
        for (int nt = 0; nt < 4; ++nt) { const int v = h * 64 + 16 * nt + 4 * q; y[nt] = *(const GAS f32x4*)(YVu + t * 64 + 16 * nt + 4 * q);
            sv[2 * nt] = *(const GAS bf16x8*)(SCu + (16 * nt + c) * 64 + 8 * q); sv[2 * nt + 1] = *(const GAS bf16x8*)(SCu + (16 * nt + c) * 64 + 8 * q + 32);
            g[nt] = *(const GAS f32x4*)(G1 + ro * 1024 + v); g[4 + nt] = *(const GAS f32x4*)(G2 + ro * 1024 + v); } };
    auto compute = [&](int u, const bf16x8 (&r)[2], const bf16x8 (&sv)[8], f32x4 (&y)[4], const f32x4 (&g)[8]) { int h, row0; bool skip; geo(u, h, row0, skip); if (skip) return;
        const int t = 16 * mt + c; const size_t ro = (size_t)(row0 + t); float s1 = 0.f;
#pragma unroll
        for (int nt = 0; nt < 4; ++nt) { y[nt] = __builtin_amdgcn_mfma_f32_16x16x32_bf16(sv[2 * nt], r[0], y[nt], 0, 0, 0); y[nt] = __builtin_amdgcn_mfma_f32_16x16x32_bf16(sv[2 * nt + 1], r[1], y[nt], 0, 0, 0);
            s1 += (y[nt][0] + y[nt][1]) + (y[nt][2] + y[nt][3]); }
        s1 += swz_xor<16>(s1); s1 += xor32(s1);
        const float mean = s1 * (1.f / 64.f); float s2 = 0.f;
#pragma unroll
        for (int nt = 0; nt < 4; ++nt) { y[nt] = y[nt] - mean; s2 += (y[nt][0] * y[nt][0] + y[nt][1] * y[nt][1]) + (y[nt][2] * y[nt][2] + y[nt][3] * y[nt][3]); }
        s2 += swz_xor<16>(s2); s2 += xor32(s2);
        const float rstd = __builtin_amdgcn_rsqf(s2 * (1.f / 64.f) + 64e-5f);
#pragma unroll
        for (int nt = 0; nt < 4; ++nt) { const int v = h * 64 + 16 * nt + 4 * q;
            const f32x4 o = y[nt] * rstd * g[nt] + g[4 + nt]; v2u w; w.x = pk2(o[0], o[1]); w.y = pk2(o[2], o[3]); *(GAS v2u*)(YC + ro * DMOD + v) = w; } };
    const int u0 = 2 * F.bid + (wave >> 2), us = 2 * F.G;
    if (u0 < RW_UNITS) load(u0, rA, sA, yA, gA);
    for (int u = u0; u < RW_UNITS; u += 2 * us) {
        if (u + us < RW_UNITS) load(u + us, rB, sB, yB, gB);
        compute(u, rA, sA, yA, gA);
        if (u + us < RW_UNITS) { if (u + 2 * us < RW_UNITS) load(u + 2 * us, rA, sA, yA, gA); compute(u + us, rB, sB, yB, gB); }
    }
}
__device__ __forceinline__ void attn_sample_unit(ArgsP A, Frame& F, int l, int sb, int h) {
    unsigned char* ws = A->ws; const int tid = F.tid, lane = F.lane, wave = F.wave;
    LAS float* QS = (LAS float*)F.lds;
    LAS float* LUT = QS + 2048;
    LAS float* PB = QS + 4096 + wave * 1024;
    LAS float* MLW = QS + 4096 + 8192;
    LAS float* OACC = MLW + 128;
    LAS float* LACC = OACC + 4096;
    const bf16* QB = (const bf16*)(ws + WS_QB); const bf16* KB = (const bf16*)(ws + WS_KB); const bf16* VB = (const bf16*)(ws + WS_VB);
    const float* reltab = A->in[I_REL];
    for (int i = tid; i < 2048; i += NWAVES * 64) { const int t = i >> 7, d = i & 127; QS[i] = bf2f(QB[(size_t)(MP + sb * TS + t) * 1024 + h * 128 + d]); }
    if (tid < 192) { const int rel = tid - 128; const int n = rel < 0 ? -rel : rel;
        const int lg = n < 12 ? 8 : n < 16 ? 9 : n < 23 ? 10 : n < 32 ? 11 : n < 46 ? 12 : n < 64 ? 13 : n < 91 ? 14 : 15;
        const int bucket = (rel > 0 ? 16 : 0) + (n < 8 ? n : lg);
        LUT[tid] = (reltab[bucket * 8 + h] - reltab[15 * 8 + h]) * 1.4426950408889634f; }
    for (int i = tid; i < 4096 + 32; i += NWAVES * 64) OACC[i] = 0.f;
    __syncthreads();
    const int map = wave & 1, kg = wave >> 1;
    float mrun[16], lrun[16], o[16][2];
#pragma unroll
    for (int t = 0; t < 16; ++t) { mrun[t] = -INFINITY; lrun[t] = 0.f; o[t][0] = 0.f; o[t][1] = 0.f; }
    const float* CK = A->in[I_CK] + (size_t)(l * NSB + sb) * PAST * 1024; const float* CV = A->in[I_CV] + (size_t)(l * NSB + sb) * PAST * 1024;
    for (int kb = kg; kb < 33; kb += 4) {
        const int pos = 64 * kb + lane; const bool kvalid = pos < PAST + TS;
        float s[16];
#pragma unroll
        for (int t = 0; t < 16; ++t) s[t] = 0.f;
        if (kb < 32) { const float* kp = CK + (size_t)pos * 1024 + h * 128 + map * 64;
#pragma unroll 4
            for (int d = 0; d < 64; d += 4) { const f32x4 kv = *(const GAS f32x4*)(kp + d);
#pragma unroll
                for (int t = 0; t < 16; ++t) { const f32x4 qv = *(const LAS f32x4*)(QS + t * 128 + map * 64 + d); s[t] += (kv[0] * qv[0] + kv[1] * qv[1]) + (kv[2] * qv[2] + kv[3] * qv[3]); } }
        } else { const int rr = MP + sb * TS + (lane & 15); const bf16* kp = KB + (size_t)rr * 1024 + h * 128 + map * 64;
#pragma unroll 4
            for (int d = 0; d < 64; d += 4) { const v2u kw = *(const GAS v2u*)(kp + d);
                const f32x4 kv = (f32x4){bf2f((unsigned short)(kw.x & 0xffffu)), bf2f((unsigned short)(kw.x >> 16)), bf2f((unsigned short)(kw.y & 0xffffu)), bf2f((unsigned short)(kw.y >> 16))};
#pragma unroll
                for (int t = 0; t < 16; ++t) { const f32x4 qv = *(const LAS f32x4*)(QS + t * 128 + map * 64 + d); s[t] += (kv[0] * qv[0] + kv[1] * qv[1]) + (kv[2] * qv[2] + kv[3] * qv[3]); } }
        }
        float al[16];
#pragma unroll
        for (int t = 0; t < 16; ++t) { int idx = pos - (PAST + t) + 128; idx = idx < 0 ? 0 : idx; idx = idx > 191 ? 191 : idx;
            float sv = kvalid ? s[t] + LUT[idx] : -INFINITY;
            const float bm = wave_max(sv);
            const float mn = fmaxf(mrun[t], bm); al[t] = __builtin_amdgcn_exp2f(mrun[t] - mn); mrun[t] = mn;
            const float p = __builtin_amdgcn_exp2f(sv - mn); PB[lane * 16 + t] = p;
            lrun[t] = lrun[t] * al[t] + wave_sum(p);
            o[t][0] *= al[t]; o[t][1] *= al[t]; }
        LDS_WAIT(); asm volatile("" ::: "memory");
        const int nk = (kb < 32) ? 64 : TS;
        for (int k0 = 0; k0 < nk; k0 += 4) { f32x2 vv[4];
            if (kb < 32) {
#pragma unroll
                for (int b = 0; b < 4; ++b) vv[b] = *(const GAS f32x2*)(CV + (size_t)(64 * kb + k0 + b) * 1024 + h * 128 + 2 * lane);
            } else {
#pragma unroll
                for (int b = 0; b < 4; ++b) { const unsigned w = *(const GAS unsigned*)(VB + (size_t)(MP + sb * TS + k0 + b) * 1024 + h * 128 + 2 * lane); vv[b].x = bf2f((unsigned short)(w & 0xffffu)); vv[b].y = bf2f((unsigned short)(w >> 16)); }
            }
#pragma unroll
            for (int b = 0; b < 4; ++b) { const LAS f32x4* pp = (const LAS f32x4*)(PB + (k0 + b) * 16);
                const f32x4 p0 = pp[0], p1 = pp[1], p2 = pp[2], p3 = pp[3];
#pragma unroll
                for (int t = 0; t < 4; ++t) { o[t][0] += p0[t] * vv[b].x; o[t][1] += p0[t] * vv[b].y; o[4 + t][0] += p1[t] * vv[b].x; o[4 + t][1] += p1[t] * vv[b].y;
                    o[8 + t][0] += p2[t] * vv[b].x; o[8 + t][1] += p2[t] * vv[b].y; o[12 + t][0] += p3[t] * vv[b].x; o[12 + t][1] += p3[t] * vv[b].y; }
                asm volatile("" ::: "memory"); } }
        LDS_WAIT(); asm volatile("" ::: "memory");
    }
    if (lane < 16) { float mv = mrun[0];
#pragma unroll
        for (int t = 1; t < 16; ++t) mv = (lane == t) ? mrun[t] : mv;
        MLW[wave * 16 + lane] = mv; }
    __syncthreads();
#pragma unroll
    for (int t = 0; t < 16; ++t) { float M = fmaxf(fmaxf(MLW[(map) * 16 + t], MLW[(2 + map) * 16 + t]), fmaxf(MLW[(4 + map) * 16 + t], MLW[(6 + map) * 16 + t]));
        const float sc = __builtin_amdgcn_exp2f(mrun[t] - M);
        __hip_atomic_fetch_add(OACC + (t * 2 + map) * 128 + 2 * lane, o[t][0] * sc, __ATOMIC_RELAXED, __HIP_MEMORY_SCOPE_WORKGROUP); __hip_atomic_fetch_add(OACC + (t * 2 + map) * 128 + 2 * lane + 1, o[t][1] * sc, __ATOMIC_RELAXED, __HIP_MEMORY_SCOPE_WORKGROUP);
        if (lane == 0) __hip_atomic_fetch_add(LACC + map * 16 + t, lrun[t] * sc, __ATOMIC_RELAXED, __HIP_MEMORY_SCOPE_WORKGROUP); }
    __syncthreads();
    float* OA = (float*)(ws + WS_OATT);
    for (int i = tid; i < 4096; i += NWAVES * 64) { const int t = i >> 8, mp = (i >> 7) & 1, e = i & 127;
        OA[(size_t)(MP + sb * TS + t) * DMOD + h * 256 + mp * 128 + e] = OACC[i] / LACC[mp * 16 + t]; }
    __syncthreads();
}


__device__ __forceinline__ void attn_sample_unit2(ArgsP A, Frame& F, int l, int sb, int h) {
    using attn_body::f32x16;
    unsigned char* ws = A->ws; int tid_ = F.tid; asm volatile("" : "+v"(tid_));
    const int tid = tid_, lane = tid & 63, wid = __builtin_amdgcn_readfirstlane(tid >> 6), r32 = lane & 31, hi = lane >> 5, map = wid & 1, vh = (wid >> 1) & 1, KH = wid >> 2;
    LAS unsigned char* L = F.lds;
    LAS float* wsf = (LAS float*)(L + 65536) + wid * 64;
    const LAS float* LUT = (const LAS float*)(L + LUT_OFF) + h * 192;
    LAS float* MG = (LAS float*)(L + 68608);
    const bf16* QB = (const bf16*)(ws + WS_QB); const bf16* KB = (const bf16*)(ws + WS_KB); const bf16* VB = (const bf16*)(ws + WS_VB);
    const float* CK = A->in[I_CK] + (size_t)(l * NSB + sb) * PAST * 1024 + h * 128; const float* CV = A->in[I_CV] + (size_t)(l * NSB + sb) * PAST * 1024 + h * 128;
    bf16x8 qr[4];
    { const bf16* Qw = QB + (size_t)(MP + sb * TS + (r32 & 15)) * 1024 + h * 128 + map * 64;
#pragma unroll
      for (int d0 = 0; d0 < 4; ++d0) qr[d0] = *(const GAS bf16x8*)(Qw + d0 * 16 + hi * 8); }
    f32x4 st[8];
    auto stage_load = [&](int tile) {
        if (tile < 32) {
#pragma unroll
            for (int k = 0; k < 4; ++k) { const int idx = tid + 512 * k, row = idx >> 5, pp = idx & 31; const size_t off = (size_t)(64 * tile + row) * 1024 + 4 * pp;
                st[k] = __builtin_nontemporal_load((const GAS f32x4*)(CK + off)); st[4 + k] = __builtin_nontemporal_load((const GAS f32x4*)(CV + off)); }
        } else {
#pragma unroll
            for (int i = 0; i < 8; ++i) st[i] = (f32x4){0.f, 0.f, 0.f, 0.f};
            { const int row = tid >> 5, pp = tid & 31; const size_t off = (size_t)(MP + sb * TS + row) * 1024 + h * 128 + 4 * pp;
              const v2u wk = *(const GAS v2u*)(KB + off), wv = *(const GAS v2u*)(VB + off);
              st[0] = (f32x4){bf2f((unsigned short)(wk.x & 0xffffu)), bf2f((unsigned short)(wk.x >> 16)), bf2f((unsigned short)(wk.y & 0xffffu)), bf2f((unsigned short)(wk.y >> 16))};
              st[4] = (f32x4){bf2f((unsigned short)(wv.x & 0xffffu)), bf2f((unsigned short)(wv.x >> 16)), bf2f((unsigned short)(wv.y & 0xffffu)), bf2f((unsigned short)(wv.y >> 16))}; }
        } };
    auto stage_write = [&](int buf) { LAS unsigned char* B = L + buf * 32768;
#pragma unroll
        for (int k = 0; k < 4; ++k) { const int idx = tid + 512 * k, row = idx >> 5, pp = idx & 31, c = 4 * (pp & 15); const f32x4 x = st[k], y = st[4 + k];
            *(LAS v2u*)(B + (pp >> 4) * 8192 + ((pp & 15) >> 1) * 1024 + row * 16 + (pp & 1) * 8) = (v2u){pk2(x[0], x[1]), pk2(x[2], x[3])};
            *(LAS v2u*)(B + 16384 + (pp >> 4) * 8192 + ((c >> 5) * 4 + (row >> 4)) * 1024 + ((row & 15) * 4 + ((c & 31) >> 3)) * 16 + ((c >> 2) & 1) * 8) = (v2u){pk2(y[0], y[1]), pk2(y[2], y[3])}; } };
    stage_load(0);
    float mhat = 0.f, l_reg = 0.f; f32x16 o[2]; o[0] = f32x16{}; o[1] = f32x16{};
    stage_write(0);
    __syncthreads();
    for (int tile = 0; tile < 33; ++tile) {
        if (tile + 1 < 33) stage_load(tile + 1);
        const LAS unsigned char* B = L + (tile & 1) * 32768;
        f32x16 p;
        attn_body::qkt_half(p, (attn_body::lds_cp)(B + map * 8192), qr, f32x16{}, r32, hi, KH);
        asm volatile("s_nop 15\n\ts_nop 7" : "+v"(p));
#pragma unroll
        for (int r = 0; r < 16; ++r) p[r] -= mhat;
        if (tile >= 30) {
            const int rel0 = 64 * tile + 32 * KH + 4 * hi - (PAST + (r32 & 15)) + 128;
#pragma unroll
            for (int r = 0; r < 16; ++r) { const int kin = 32 * KH + 4 * hi + (r & 3) + 8 * (r >> 2); int idx = rel0 + (r & 3) + 8 * (r >> 2); idx = idx < 0 ? 0 : (idx > 191 ? 191 : idx);
                p[r] = (tile == 32 && kin >= TS) ? -INFINITY : p[r] + LUT[idx]; } }
        float rm = p[0];
#pragma unroll
        for (int r = 1; r < 16; ++r) rm = fmaxf(rm, p[r]);
        { const PL32 rr = pl32(rm); rm = fmaxf(rr.a, rr.b); }
        if (__any(rm > 0.f)) { const float dl = fmaxf(rm, 0.f); mhat += dl;
#pragma unroll
            for (int r = 0; r < 16; ++r) p[r] -= dl;
            const float f = __builtin_amdgcn_exp2f(-dl); l_reg *= f; if (hi == 0) wsf[r32] = f;
            asm volatile("s_waitcnt lgkmcnt(0)" ::: "memory");
#pragma unroll
            for (int d_ = 0; d_ < 2; ++d_)
#pragma unroll
                for (int r = 0; r < 16; ++r) o[d_][r] *= wsf[attn_body::crow(r, hi)]; }
        float sacc = 0.f;
#pragma unroll
        for (int r = 0; r < 16; ++r) { p[r] = __builtin_amdgcn_exp2f(p[r]); sacc += p[r]; }
        l_reg += sacc;
        const v4u pw0 = (v4u){attn_body::cvtpk_s(p[0], p[1]), attn_body::cvtpk_s(p[2], p[3]), attn_body::cvtpk_s(p[4], p[5]), attn_body::cvtpk_s(p[6], p[7])};
        const v4u pw1 = (v4u){attn_body::cvtpk_s(p[8], p[9]), attn_body::cvtpk_s(p[10], p[11]), attn_body::cvtpk_s(p[12], p[13]), attn_body::cvtpk_s(p[14], p[15])};
        const int vb = (int)(unsigned)(size_t)(B + 16384 + vh * 8192) + KH * 2048 + ((lane >> 4) & 1) * 32 + (lane & 3) * 8 + (4 * hi + ((lane & 15) >> 2)) * 64;
        attn_body::pv_half(o, vb, __builtin_bit_cast(bf16x8, pw0), __builtin_bit_cast(bf16x8, pw1));
        if (tile + 1 < 33) stage_write((tile + 1) & 1);
        __syncthreads();
    }
    { const PL32 rr = pl32(l_reg); l_reg = rr.a + rr.b; }
    LAS float* OG = (LAS float*)L + (wid & 3) * 2048;
    if (KH == 1) { if (hi == 0) { MG[(wid & 3) * 64 + r32] = mhat; MG[(wid & 3) * 64 + 32 + r32] = l_reg; }
#pragma unroll
        for (int d_ = 0; d_ < 2; ++d_)
#pragma unroll
            for (int r = 0; r < 16; ++r) OG[(d_ * 16 + r) * 64 + lane] = o[d_][r]; }
    __syncthreads();
    if (KH == 0) { const float m2 = MG[wid * 64 + r32], l2 = MG[wid * 64 + 32 + r32]; const float M = fmaxf(mhat, m2);
        const float f1 = __builtin_amdgcn_exp2f(mhat - M), f2 = __builtin_amdgcn_exp2f(m2 - M); const float inv = 1.f / (l_reg * f1 + l2 * f2);
        if (hi == 0) { wsf[r32] = f1 * inv; wsf[32 + r32] = f2 * inv; }
        asm volatile("s_waitcnt lgkmcnt(0)" ::: "memory");
        bf16* OA = (bf16*)(ws + WS_OATT) + (size_t)(MP + sb * TS) * DMOD + h * 256 + map * 128 + vh * 64;
#pragma unroll
        for (int r = 0; r < 8; ++r) { const int q = attn_body::crow(r, hi); const float g1 = wsf[q], g2 = wsf[32 + q];
#pragma unroll
            for (int d_ = 0; d_ < 2; ++d_) OA[(size_t)q * DMOD + d_ * 32 + r32] = (bf16)f2bf(o[d_][r] * g1 + OG[(d_ * 16 + r) * 64 + lane] * g2); } }
    __syncthreads();
}
__device__ __forceinline__ void attn_build_lut(ArgsP A, Frame& F) {
    LAS float* T = (LAS float*)(F.lds + LUT_OFF); const float* reltab = A->in[I_REL];
    for (int i = F.tid; i < 8 * 192; i += NWAVES * 64) { const int hh = i / 192, rel = i % 192 - 128; const int n = rel < 0 ? -rel : rel;
        const int lg = n < 12 ? 8 : n < 16 ? 9 : n < 23 ? 10 : n < 32 ? 11 : n < 46 ? 12 : n < 64 ? 13 : n < 91 ? 14 : 15;
        const int bucket = (rel > 0 ? 16 : 0) + (n < 8 ? n : lg);
        T[i] = (reltab[bucket * 8 + hh] - reltab[15 * 8 + hh]) * 1.4426950408889634f; }
    __syncthreads();
}
__device__ __forceinline__ void ph_attn_sample(Frame& F, int l) {
    PHASE_ENTRY();
    attn_build_lut(A, F);
    gu32* head = F.ctl + CW_QUEUE + 128 * l;
    for (;;) {
        if (F.tid == 0) F.MISC[16] = __hip_atomic_fetch_add(head, 1u, RLX_AGENT);
        __syncthreads();
        const unsigned qi = F.MISC[16];
        __syncthreads();
        if (qi >= 128u) break;
#ifdef SAMPLE_VALU
        attn_sample_unit(A, F, l, (int)(qi >> 3), (int)(qi & 7u));
#else
        attn_sample_unit2(A, F, l, (int)(qi >> 3), (int)(qi & 7u));
#endif
    }
}
__device__ __forceinline__ void ph_attn_prompt(Frame& F, int l) {
    PHASE_ENTRY();
    unsigned char* ws = A->ws;
    gu32* head = F.ctl + CW_QUEUE + 128 * l + 64;
    for (;;) {
        if (F.tid == 0) F.MISC[17] = __hip_atomic_fetch_add(head, 1u, RLX_AGENT);
        __syncthreads();
        const unsigned qi = F.MISC[17];
        __syncthreads();
        if (qi >= 1024u) break;
        const int qb = 63 - (int)(qi >> 4), hm = (int)(qi & 15u);
        const int hh = hm >> 1, mp = hm & 1;
        attn_body::attn_unit_f<8>(qb, hh * 128 + mp * 64, hh * 128, hh * 256 + mp * 128,
                                (const attn_body::bf16*)(ws + WS_QB), (const attn_body::bf16*)(ws + WS_KB), (const attn_body::bf16*)(ws + WS_VB), (attn_body::bf16*)(ws + WS_OATT), (char*)F.lds, (const LAS float*)(F.lds + LUT_OFF) + hh * 192);
    }
}
__device__ __forceinline__ void ph_attn_final(Frame& F, int l) {
    PHASE_ENTRY();
    const int lane = F.lane; const int gw = F.bid * NWAVES + F.wave, NGW = F.G * NWAVES;
    float d1 = A->in[I_LQ1][l * 64 + lane] * A->in[I_LK1][l * 64 + lane], d2 = A->in[I_LQ2][l * 64 + lane] * A->in[I_LK2][l * 64 + lane];
    d1 = wave_sum(d1); d2 = wave_sum(d2);
    const float lam_init = (l == 0) ? 0.2f : (0.8f - 0.6f * 0.7408182206817179f);
    const float lam = expf(d1) - expf(d2) + lam_init, osc = 1.f - lam_init;
    const int hh = lane >> 3, e0 = (lane & 7) * 16;
    const bf16* OA = (const bf16*)(A->ws + WS_OATT); bf16* YC = (bf16*)(A->ws + WS_YCAT);
    f32x4 sl[4];
#pragma unroll
    for (int j = 0; j < 4; ++j) sl[j] = *(const GAS f32x4*)(A->in[I_SUBLN] + l * 128 + e0 + 4 * j);
    for (int m = gw; m < MT; m += NGW) {
        if (l == 0 && m >= MP) { const float* xs = A->in[I_XS] + (size_t)(m - MP) * DMOD; float* xd = (float*)(A->ws + WS_X) + (size_t)m * DMOD;
#pragma unroll
            for (int j = 0; j < 8; ++j) *(GAS f32x4*)(xd + 4 * lane + 256 * j) = *(const GAS f32x4*)(xs + 4 * lane + 256 * j); }
        const bf16* o1 = OA + (size_t)m * DMOD + hh * 256 + e0; f32x4 o[4]; float ss = 0.f;
        { const v4u a0 = *(const GAS v4u*)o1, a1 = *(const GAS v4u*)(o1 + 8), b0 = *(const GAS v4u*)(o1 + 128), b1 = *(const GAS v4u*)(o1 + 136);
          const unsigned aw[8] = {a0.x, a0.y, a0.z, a0.w, a1.x, a1.y, a1.z, a1.w}, bw[8] = {b0.x, b0.y, b0.z, b0.w, b1.x, b1.y, b1.z, b1.w};
#pragma unroll
          for (int j = 0; j < 4; ++j) { o[j][0] = bf2f((unsigned short)(aw[2 * j] & 0xffffu)) - lam * bf2f((unsigned short)(bw[2 * j] & 0xffffu)); o[j][1] = bf2f((unsigned short)(aw[2 * j] >> 16)) - lam * bf2f((unsigned short)(bw[2 * j] >> 16));
              o[j][2] = bf2f((unsigned short)(aw[2 * j + 1] & 0xffffu)) - lam * bf2f((unsigned short)(bw[2 * j + 1] & 0xffffu)); o[j][3] = bf2f((unsigned short)(aw[2 * j + 1] >> 16)) - lam * bf2f((unsigned short)(bw[2 * j + 1] >> 16));
              ss += (o[j][0] * o[j][0] + o[j][1] * o[j][1]) + (o[j][2] * o[j][2] + o[j][3] * o[j][3]); } }
        ss += swz_xor<1>(ss); ss += swz_xor<2>(ss); ss += swz_xor<4>(ss);
        const float rs = osc * __builtin_amdgcn_rsqf(ss * (1.f / 128.f) + 1e-5f);
        v4u w0, w1; f32x4 y0 = o[0] * rs * sl[0], y1 = o[1] * rs * sl[1], y2 = o[2] * rs * sl[2], y3 = o[3] * rs * sl[3];
        w0 = (v4u){pk2(y0[0], y0[1]), pk2(y0[2], y0[3]), pk2(y1[0], y1[1]), pk2(y1[2], y1[3])}; w1 = (v4u){pk2(y2[0], y2[1]), pk2(y2[2], y2[3]), pk2(y3[0], y3[1]), pk2(y3[2], y3[3])};
        bf16* yo = YC + (size_t)m * DMOD + 1024 + hh * 128 + e0; *(GAS v4u*)yo = w0; *(GAS v4u*)(yo + 8) = w1;
    }
}
__device__ __forceinline__ void ph_fixup(Frame& F, int l) {
    PHASE_ENTRY();
    const float* tail = (const float*)(A->ws + WS_HALO), *hg = tail + 32 * 2 * DFF, *hv = hg + 32 * 2 * DFF;
    const float* cw = A->in[I_CONVW] + (size_t)l * 3 * DFF, *cb = A->in[I_CONVB] + (size_t)l * DFF; bf16* ACT = (bf16*)(A->ws + WS_ACT);
    const int gt = F.bid * (NWAVES * 64) + F.tid, ngt = F.G * NWAVES * 64;
    for (int idx = gt; idx < 31 * DFF; idx += ngt) { const int pm = 1 + idx / DFF, j = idx % DFF;
        const float um2 = tail[((size_t)(pm - 1) * 2 + 0) * DFF + j], um1 = tail[((size_t)(pm - 1) * 2 + 1) * DFF + j], u0 = hg[((size_t)pm * 2 + 0) * DFF + j], u1 = hg[((size_t)pm * 2 + 1) * DFF + j];
        const float v0 = hv[((size_t)pm * 2 + 0) * DFF + j], v1 = hv[((size_t)pm * 2 + 1) * DFF + j];
        const float w0 = cw[j], w1 = cw[DFF + j], w2 = cw[2 * DFF + j], b = cb[j];
        const pg8::f32x2 g = pg8::gelu_pk((pg8::f32x2){b + w0 * um2 + w1 * um1 + w2 * u0, b + w0 * um1 + w1 * u0 + w2 * u1});
        ACT[(size_t)(256 * pm) * DFF + j] = (bf16)f2bf(g.x * v0); ACT[(size_t)(256 * pm + 1) * DFF + j] = (bf16)f2bf(g.y * v1); }
}
#ifdef PROBE_SEQ
__device__ __forceinline__ void probe_seq_scan(Frame& F, int l) {
    PHASE_ENTRY();
    const int gw = F.bid * NWAVES + F.wave, lane = F.lane;
    if (gw >= 16) return;
    const int h = gw, hj = h * 64 + lane;
    const float* PR = (const float*)(A->ws + WS_PR); const float* mu = A->in[I_MU] + (size_t)l * NRC;
    LAS float* sc = (LAS float*)(F.lds + F.wave * 4096);
    const float* w2 = A->in[I_W2] + (size_t)l * 96 * 1024; const float* a2 = A->in[I_A2] + (size_t)l * 96 * 1024;
    const float w0 = A->in[I_W0][l * 1024 + hj], a0 = A->in[I_A0][l * 1024 + hj], kkw = A->in[I_KK][l * 1024 + hj], kaw = A->in[I_KA][l * 1024 + hj];
    float S[64];
#pragma unroll
    for (int k = 0; k < 64; ++k) S[k] = 0.f;
    for (int t = 0; t < MP; ++t) {
        const float* pc = PR + (size_t)t * NRC_PAD; const float* pp = pc - NRC_PAD;
        auto lerp = [&](int col) { const float cur = pc[col]; const float prv = t > 0 ? pp[col] : 0.f; return cur + (prv - cur) * mu[col]; };
        sc[lane] = tanhf(lerp(3072 + lane)); if (lane < 32) sc[64 + lane] = tanhf(lerp(3072 + 64 + lane));
        sc[96 + lane] = lerp(3168 + lane); if (lane < 32) sc[96 + 64 + lane] = lerp(3168 + 64 + lane);
        LDS_WAIT(); asm volatile("" ::: "memory");
        float wl = 0.f, al = 0.f;
        for (int k = 0; k < 96; ++k) { wl += sc[k] * w2[(size_t)k * 1024 + hj]; al += sc[96 + k] * a2[(size_t)k * 1024 + hj]; }
        const float xk = lerp(1024 + hj), xv = lerp(2048 + hj);
        const float z = w0 + wl; const float wlog = -log1pf(expf(-z)) - 0.5f; const float w = expf(-expf(wlog));
        const float a = 1.f / (1.f + expf(-(a0 + al)));
        const float kkr = xk * kkw; const float nrm = wave_sum(kkr * kkr); const float kk = kkr / sqrtf(fmaxf(nrm, 1e-24f));
        const float km = xk * (1.f + (a - 1.f) * kaw);
        LDS_WAIT(); asm volatile("" ::: "memory");
        sc[192 + lane] = w; sc[256 + lane] = kk; sc[320 + lane] = kk * a; sc[384 + lane] = km;
        LDS_WAIT(); asm volatile("" ::: "memory");
        float sa = 0.f;
#pragma unroll
        for (int k = 0; k < 64; ++k) sa -= S[k] * sc[256 + k];
#pragma unroll
        for (int k = 0; k < 64; ++k) S[k] = S[k] * sc[192 + k] + sa * sc[320 + k] + xv * sc[384 + k];
        LDS_WAIT(); asm volatile("" ::: "memory");
    }
    float* wo = A->out + O_WP + (size_t)(l * 16 + h) * 4096 + lane * 64;
#pragma unroll
    for (int k = 0; k < 64; ++k) wo[k] = S[k];
}
#endif
#ifdef PROBE_GEMM
__device__ __forceinline__ void probe_gemm_check(Frame& F) {
    PHASE_ENTRY();
    if (F.bid != 0) return;
    float* scr = (float*)(A->ws + WS_OATT);
    const int tid = F.tid, lane = F.lane, wave = F.wave;
    for (int j = tid; j < 2 * DMOD; j += NWAVES * 64) { float s = A->in[I_BADA][j];
        for (int k = 0; k < DMOD; ++k) { const float c = A->in[I_CP][k]; s += (c / (1.f + expf(-c))) * A->in[I_WADA][(size_t)k * MODW + j]; }
        scr[j] = s; }
    __threadfence(); __syncthreads();
    float num = 0.f, den = 0.f;
#if PROBE_GEMM == 3
    for (int j = tid; j < 2 * DMOD; j += NWAVES * 64) { const float mine = ((const float*)(A->ws + WS_MOD))[j], ref = scr[j]; num += (mine - ref) * (mine - ref); den += ref * ref; }
    num = wave_sum(num); den = wave_sum(den);
#elif PROBE_GEMM == 5
    { const float sgot = wave_sum((float)(lane + 1)); num = (sgot - 2080.f) * (sgot - 2080.f); den = 2080.f * 2080.f; }
#elif PROBE_GEMM == 6
    { float v = (float)(lane + 1); for (int o = 1; o < 64; o <<= 1) v += __shfl_xor(v, o); num = (v - 2080.f) * (v - 2080.f); den = 2080.f * 2080.f; }
#elif PROBE_GEMM == 4
    for (int smp = wave; smp < 64; smp += NWAVES) { const int m = (smp * 2654435761u >> 7) % MP; const float* xr = A->in[I_XP] + (size_t)m * DMOD; float ss = 0.f;
        for (int k = lane; k < DMOD; k += 64) ss += xr[k] * xr[k];
        const float rstd = 1.f / sqrtf(wave_sum(ss) / DMOD + 1e-6f);
        for (int k = lane; k < DMOD; k += 64) { const float hh = xr[k] * rstd * A->in[I_GMIX][k] * (1.f + scr[DMOD + k]) + scr[k]; const float mine = bf2f(((const bf16*)(A->ws + WS_H))[(size_t)m * DMOD + k]); num += (mine - hh) * (mine - hh); den += hh * hh; } }
    num = wave_sum(num); den = wave_sum(den);
#else
    for (int smp = wave; smp < 256; smp += NWAVES) {
        const int m = (smp * 2654435761u >> 7) % MP; const int cc = (smp * 40503u + 17u) % (PROBE_GEMM == 1 ? 3072 : 1024);
        const int col = PROBE_GEMM == 1 ? cc : NRC + 1024 + cc;
        const float* xr = A->in[I_XP] + (size_t)m * DMOD; float ss = 0.f;
        for (int k = lane; k < DMOD; k += 64) ss += xr[k] * xr[k];
        const float rstd = 1.f / sqrtf(wave_sum(ss) / DMOD + 1e-6f); float acc = 0.f;
        for (int k = lane; k < DMOD; k += 64) { const float hh = xr[k] * rstd * A->in[I_GMIX][k] * (1.f + scr[DMOD + k]) + scr[k]; acc += hh * A->in[I_WIN][(size_t)k * NIN + col]; }
        acc = wave_sum(acc);
        const float mine = PROBE_GEMM == 1 ? ((const float*)(A->ws + WS_PR))[(size_t)m * NRC_PAD + cc] : A->out[O_KP + (size_t)m * 1024 + cc];
        num += (mine - acc) * (mine - acc); den += acc * acc; }
#endif
    LAS float* red = (LAS float*)F.lds;
    if (lane == 0) { red[wave] = num; red[8 + wave] = den; }
    __syncthreads();
    if (tid == 0) { float n = 0.f, d = 0.f; for (int w = 0; w < 8; ++w) { n += red[w]; d += red[8 + w]; } ((float*)(A->ws + WS_CTL))[16384] = sqrtf(n / d); }
}
#endif
#ifndef MK_SPLIT
#define MK_SPLIT 0
#endif
constexpr int N_PHASES = 22;
__global__ void __launch_bounds__(NWAVES * 64, 2) hybrid_fwd(Args args) {
    extern __shared__ __attribute__((aligned(16))) unsigned char lds[];
    Frame F;
    F.lds = (LAS unsigned char*)lds; F.MISC = (volatile LAS unsigned*)(F.lds + MISC_OFF);
    F.tid = threadIdx.x; F.lane = F.tid & 63; F.wave = __builtin_amdgcn_readfirstlane(F.tid >> 6); F.G = gridDim.x; F.bid = blockIdx.x;
    F.ctl = (gu32*)(args.ws + WS_CTL);
    if (F.tid < 64) F.MISC[F.tid] = 0u;
    __syncthreads();
    XcdBarrier bar; bar.bar = (unsigned*)(F.ctl + CW_BAR); bar.x = 0; bar.st = nullptr;
    if (!MK_SPLIT) bar = xcd_barrier_post((unsigned*)(F.ctl + CW_BAR), F.MISC + 8);
    const int lo = args.ph_lo, hi = args.ph_hi;
#ifndef ONLY_PT
#define ONLY_PT -1
#endif
#define PT_ON(t) (ONLY_PT < 0 || ONLY_PT == (t))
#define IN(k) (lo <= (k) && (k) < hi)
#define SEAM(k) do { if (IN(k) && IN((k) + 1)) xcd_barrier(bar); } while (0)
    if (PT_ON(0) && IN(0)) { ph_prologue(F); }
    SEAM(0);
    for (int l = 0; l < NLAYER; ++l) {
        const int pb = 1 + 10 * l;
        if (PT_ON(1) && IN(pb + 0)) ph_norm(F, l, 0, l == 0 ? 0 : 11);
        SEAM(pb + 0);
        if (PT_ON(2) && IN(pb + 1)) { PHASE_ENTRY(); unsigned char* ws = A->ws;
            pg8::Gemm g{(const pg8::bf16_t*)(ws + WS_H), (const pg8::bf16_t*)(ws + WS_WIN) + (size_t)l * NIN_PAD * DMOD, MT, NIN_PAD, DMOD, DMOD}; pg8::TwoPartOrder S; S.init(MT, NRC_PAD / 256, (NIN_PAD - NRC_PAD) / 256, F.G, F.bid, F.G == 256 ? (unsigned*)(F.ctl + CW_QUEUE + 1024 + 64 * l) : nullptr, 1 + (F.bid + 256 < (MT / 256) * (NRC_PAD / 256) ? 1 : 0));
            pg8::EpiIn E{ws, A->out, l, 0.125f * 1.4426950408889634f};
            pg8::gemm_phase<pg8::EpiIn, pg8::TwoPartOrder, true, true>(F.lds, g, S, E);
        }
        if (F.G != 256) SEAM(pb + 1);
#ifdef PROBE_GEMM
        if (l == 0 && IN(pb + 2)) { probe_gemm_check(F); __syncthreads(); }
#endif
        if (PT_ON(3) && IN(pb + 2)) ph_rwkv_passA(F, l);
        SEAM(pb + 2);
#ifdef PROBE_SEQ
        if (IN(pb + 3)) { probe_seq_scan(F, l); __syncthreads(); }
#endif
        if (PT_ON(4) && IN(pb + 3)) { ph_rwkv_chain(F, l); ph_attn_sample(F, l); ph_attn_prompt(F, l); }
        SEAM(pb + 3);
#ifdef PROBE_SEQ
        if (IN(pb + 4) && F.bid == 0) { PHASE_ENTRY();
            for (int h = F.wave; h < 16; h += NWAVES) { const float* a = (const float*)(A->ws + WS_HALO) + (size_t)h * 4096; const float* b = A->out + O_WP + (size_t)(l * 16 + h) * 4096; float n = 0.f, d = 0.f;
                for (int i = F.lane; i < 4096; i += 64) { n += (a[i] - b[i]) * (a[i] - b[i]); d += b[i] * b[i]; }
                n = wave_sum(n); d = wave_sum(d); if (F.lane == 0) { ((float*)(A->ws + WS_CTL))[16400 + 16 * l + h] = sqrtf(n / d); ((float*)(A->ws + WS_CTL))[16440 + 16 * l + h] = d; } } }
#endif
        if (PT_ON(5) && IN(pb + 4)) { ph_rwkv_passC(F, l); ph_attn_final(F, l); }
        SEAM(pb + 4);
        if (PT_ON(6) && IN(pb + 5)) { PHASE_ENTRY(); unsigned char* ws = A->ws;
            const float* X = (const float*)(ws + WS_X); const float* MODl = (const float*)(ws + WS_MOD) + (size_t)l * NMODB * MODW;
            { pg8::Gemm g{(const pg8::bf16_t*)(ws + WS_YCAT), (const pg8::bf16_t*)(ws + WS_WOUT) + (size_t)l * DMOD * DMOD, MP, DMOD, DMOD, DMOD}; pg8::StaticOrder S; S.init(MP, DMOD, F.G, F.bid);
              pg8::EpiRes E{l == 0 ? A->in[I_XP] : X, X + (size_t)MP * DMOD, (float*)(ws + WS_X), MODl + 2 * DMOD};
              pg8::gemm_phase<pg8::EpiRes, pg8::StaticOrder, true, true>(F.lds, g, S, E); }
            { pg8::Gemm g{(const pg8::bf16_t*)(ws + WS_YCAT) + (size_t)MP * DMOD, (const pg8::bf16_t*)(ws + WS_WOUT) + (size_t)l * DMOD * DMOD, 256, DMOD, DMOD / 8, DMOD}; pg8::SplitOrder S; S.init(DMOD, 8, F.bid);
              pg8::EpiResSlab E{(float*)(ws + WS_SLAB), MODl + 2 * DMOD};
              pg8::gemm_phase<pg8::EpiResSlab, pg8::SplitOrder, true, true>(F.lds, g, S, E); }
        }
        SEAM(pb + 5);
        if (PT_ON(7) && IN(pb + 6)) ph_norm(F, l, 1, 8);
        SEAM(pb + 6);
        if (PT_ON(8) && IN(pb + 7)) { PHASE_ENTRY(); unsigned char* ws = A->ws;
            pg8::Gemm g{(const pg8::bf16_t*)(ws + WS_H), (const pg8::bf16_t*)(ws + WS_WUP) + (size_t)l * NUP * DMOD, MT, NUP, DMOD, DMOD}; pg8::PmFirstOrder S; S.init(MT, NUP, F.G, F.bid, F.G == 256 ? (unsigned*)(F.ctl + CW_QUEUE + 1536 + 64 * l) : nullptr);
            pg8::EpiUp E{(pg8::bf16_t*)(ws + WS_ACT), A->in[I_CONVW] + (size_t)l * 3 * DFF, A->in[I_CONVB] + (size_t)l * DFF, A->in[I_SCONV] + (size_t)l * NSB * 2 * DFF,
                         (float*)(ws + WS_HALO), A->out + O_CP + (size_t)l * 2 * DFF, A->out + O_CS + (size_t)l * NSB * 2 * DFF, (PG8_LAS float*)(F.lds + HALO_OFF)};
            pg8::gemm_phase<pg8::EpiUp, pg8::PmFirstOrder, true, true>(F.lds, g, S, E);
            { int first = 0, nw = F.G;
              if (F.G == 256) { first = 256 - ((256 * 6) - (MT / 256) * (NUP / 256)); nw = 256 - first; if (F.bid >= first) wait_count(F, (unsigned*)(F.ctl + CW_QUEUE + 1536 + 64 * l), (unsigned)(NUP / 256)); }
              else if (!MK_SPLIT) xcd_barrier(bar);
              const float* MODl = (const float*)(ws + WS_MOD) + (size_t)l * NMODB * MODW;
              pg8::Gemm g2{(const pg8::bf16_t*)(ws + WS_ACT) + (size_t)MP * DFF, (const pg8::bf16_t*)(ws + WS_WDN) + (size_t)l * DMOD * DFF, 256, DMOD, DFF / 11, DFF}; pg8::TailSplitOrder S2; S2.init(DMOD, 11, F.bid, first, nw);
              pg8::EpiResSlab E2{(float*)(ws + WS_SLAB), MODl + 5 * DMOD};
              pg8::gemm_phase<pg8::EpiResSlab, pg8::TailSplitOrder, true, true>(F.lds, g2, S2, E2); }
        }
        SEAM(pb + 7);
        if (PT_ON(9) && IN(pb + 8)) ph_fixup(F, l);
        SEAM(pb + 8);
        if (PT_ON(10) && IN(pb + 9)) { PHASE_ENTRY(); unsigned char* ws = A->ws;
            const float* X = (const float*)(ws + WS_X); const float* MODl = (const float*)(ws + WS_MOD) + (size_t)l * NMODB * MODW;
            { pg8::Gemm g{(const pg8::bf16_t*)(ws + WS_ACT), (const pg8::bf16_t*)(ws + WS_WDN) + (size_t)l * DMOD * DFF, MP, DMOD, DFF, DFF}; pg8::StaticOrder S; S.init(MP, DMOD, F.G, F.bid);
              pg8::EpiRes E{X, X + (size_t)MP * DMOD, (float*)(ws + WS_X), MODl + 5 * DMOD};
              pg8::gemm_phase<pg8::EpiRes, pg8::StaticOrder, true, true>(F.lds, g, S, E); }
        }
        SEAM(pb + 9);
    }
    if (PT_ON(11) && IN(21)) ph_norm(F, 0, 2, 11);
#ifdef PROBE_MASK
    if (IN(22)) { PHASE_ENTRY();
        const size_t offs[13] = {O_YP, O_YS, O_KP, O_VP, O_WP, O_SP, O_CP, O_KS, O_VS, O_WS, O_SS, O_CS, O_END};
        const size_t gt = (size_t)F.bid * (NWAVES * 64) + F.tid, ngt = (size_t)F.G * NWAVES * 64;
#ifndef PROBE_SCALE
#define PROBE_SCALE 1.2f
#endif
#ifndef PROBE_HALF
#define PROBE_HALF 2
#endif
#ifdef PROBE_HEADS
        { const float* dh = (const float*)(A->ws + WS_CTL) + 16400; float best = -1.f; int bi = 0;
#if PROBE_HEADS == 3
          bi = 0; best = dh[PROBE_IDX] * 20.f;
#elif PROBE_HEADS == 1
          for (int i = 0; i < 32; ++i) if (dh[i] > best) { best = dh[i]; bi = i; }
#else
          for (int i = 0; i < 32; ++i) if (dh[i] * dh[i] * dh[40 + i] > best) { best = dh[i] * dh[i] * dh[40 + i]; bi = i; } best = dh[bi];
#endif
          const float val = (PROBE_HEADS == 3) ? best : 0.05f * bi + fminf(best, 0.049f); const float fsc = 1.f + val; for (size_t i = O_YP + gt; i < O_YS; i += ngt) A->out[i] *= fsc; }
#endif
#ifdef PROBE_GEMM
        { const float dd = ((const float*)(A->ws + WS_CTL))[16384]; const float fsc = 1.f + PROBE_AMP * dd; for (size_t i = O_YP + gt; i < O_YS; i += ngt) A->out[i] *= fsc; }
#endif
        for (int o = 0; o < 12; ++o) if ((PROBE_MASK >> o) & 1) { size_t b = offs[o], e = offs[o + 1]; const size_t mid = b + (e - b) / 2;
            if (PROBE_HALF == 0) e = mid; if (PROBE_HALF == 1) b = mid;
            for (size_t i = b + gt; i < e; i += ngt) A->out[i] *= PROBE_SCALE; } }
#endif
#undef IN
#undef SEAM
}

extern "C" void kernel_launch(void* const* d_in, const int* in_sizes, int n_in, void* d_out, int out_size, void* d_ws, size_t ws_size, hipStream_t stream) {
    static int grid = 0;
    if (grid == 0) {
        if (n_in != 37 || (size_t)out_size != O_END || ws_size < WS_END) { fprintf(stderr, "kernel_launch: built for 37 inputs, %zu outputs, >= %zu bytes of workspace; got n_in %d, out %d, ws %zu; nothing launched\n", (size_t)O_END, (size_t)WS_END, n_in, out_size, ws_size); grid = -1; return; }
        int dev = 0, cus = 0, per_cu = 0;
        if (hipGetDevice(&dev) != hipSuccess || hipDeviceGetAttribute(&cus, hipDeviceAttributeMultiprocessorCount, dev) != hipSuccess) { fprintf(stderr, "kernel_launch: device query failed\n"); grid = -1; return; }
        if (hipFuncSetAttribute((const void*)hybrid_fwd, hipFuncAttributeMaxDynamicSharedMemorySize, LDS_BYTES) != hipSuccess) { fprintf(stderr, "kernel_launch: hipFuncSetAttribute failed\n"); grid = -1; return; }
        if (hipOccupancyMaxActiveBlocksPerMultiprocessor(&per_cu, (const void*)hybrid_fwd, NWAVES * 64, LDS_BYTES) != hipSuccess || per_cu < 1) fprintf(stderr, "kernel_launch: note: occupancy query reports %d workgroups per CU\n", per_cu);
        (void)hipGetLastError();
        grid = cus;
    }
    if (grid < 0) return;
    if (hipMemsetAsync((char*)d_ws + WS_CTL, 0, CTL_ZERO_BYTES, stream) != hipSuccess) { fprintf(stderr, "kernel_launch: memset failed\n"); return; }
    Args a{};
    for (int i = 0; i < 37; ++i) a.in[i] = (const float*)d_in[i];
    a.out = (float*)d_out; a.ws = (unsigned char*)d_ws;
#if MK_SPLIT
#ifdef PROBE_MASK
    const int n_launch = N_PHASES + 1;
#else
    const int n_launch = N_PHASES;
#endif
    for (int p = 0; p < n_launch; ++p) { a.ph_lo = p; a.ph_hi = p + 1; hipLaunchKernelGGL(hybrid_fwd, dim3(grid), dim3(NWAVES * 64), LDS_BYTES, stream, a); }
#else
    a.ph_lo = 0; a.ph_hi = N_PHASES; hipLaunchKernelGGL(hybrid_fwd, dim3(grid), dim3(NWAVES * 64), LDS_BYTES, stream, a);
#endif
    const hipError_t le = hipPeekAtLastError();
    if (le != hipSuccess) fprintf(stderr, "kernel_launch: launch failed: %s\n", hipGetErrorName(le));
}
```

```cpp
#include <hip/hip_runtime.h>
#include <hip/hip_bf16.h>
#include <cstdio>
#include <cstdint>
#include <cmath>
constexpr int NWAVES = 8;
constexpr int DMOD = 2048, MP = 8192, NSB = 16, TS = 16, MT = MP + NSB * TS  , PAST = 2048;
constexpr int NRC = 3520, NRC_PAD = 3584, NIN = 6592, NIN_PAD = 6656, DFF = 5632, NUP = 2 * DFF;
constexpr int NLAYER = 2, NMODB = 17, MODW = 6 * DMOD;
constexpr int RW_UNITS = 128 * 16 + NSB * 16;
constexpr size_t O_YP = 0, O_YS = O_YP + (size_t)MP * DMOD, O_KP = O_YS + (size_t)NSB * TS * DMOD, O_VP = O_KP + (size_t)NLAYER * MP * 1024, O_WP = O_VP + (size_t)NLAYER * MP * 1024,
                 O_SP = O_WP + (size_t)NLAYER * 16 * 4096, O_CP = O_SP + (size_t)NLAYER * NRC, O_KS = O_CP + (size_t)NLAYER * 2 * DFF, O_VS = O_KS + (size_t)NLAYER * 256 * 1024,
                 O_WS = O_VS + (size_t)NLAYER * 256 * 1024, O_SS = O_WS + (size_t)NLAYER * NSB * 16 * 4096, O_CS = O_SS + (size_t)NLAYER * NSB * NRC, O_END = O_CS + (size_t)NLAYER * NSB * 2 * DFF;
constexpr size_t MiB = 1u << 20;
constexpr size_t WS_CTL = 0, CTL_ZERO_BYTES = 1 * MiB;
constexpr size_t WS_MOD = 1 * MiB;
constexpr size_t WS_LORA = 3 * MiB, LORA_LAYER = (size_t)1024 * 448 * 2;
constexpr size_t WS_WIN = 5 * MiB, WS_WOUT = 57 * MiB, WS_WUP = 73 * MiB, WS_WDN = 161 * MiB;
constexpr size_t WS_H = 205 * MiB, WS_PR = 238 * MiB, WS_QB = 354 * MiB, WS_KB = 371 * MiB, WS_VB = 388 * MiB, WS_OATT = 405 * MiB, WS_YCAT = 471 * MiB, WS_X = 504 * MiB, WS_ACT = 570 * MiB;
constexpr size_t WS_PT = 661 * MiB, WS_QQ = 679 * MiB, WS_RP = 715 * MiB, WS_YV = 733 * MiB, WS_SC = 769 * MiB, WS_G1 = 787 * MiB, WS_G2 = 820 * MiB, WS_HALO = 853 * MiB, WS_WL = 858 * MiB, WS_PT32 = 859 * MiB, WS_LSCR = 895 * MiB, WS_SLAB = 911 * MiB, WS_END = 935 * MiB;
static_assert(WS_WIN + (size_t)2 * NIN_PAD * DMOD * 2 <= WS_WOUT && WS_WOUT + (size_t)2 * DMOD * DMOD * 2 <= WS_WUP && WS_WUP + (size_t)2 * NUP * DMOD * 2 <= WS_WDN && WS_WDN + (size_t)2 * DMOD * DFF * 2 <= WS_H, "weights map");
static_assert(WS_H + (size_t)MT * DMOD * 2 <= WS_PR && WS_PR + (size_t)MT * NRC_PAD * 4 <= WS_QB && WS_QB + (size_t)MT * 1024 * 2 <= WS_KB && WS_VB + (size_t)MT * 1024 * 2 <= WS_OATT && WS_OATT + (size_t)MT * DMOD * 4 <= WS_YCAT, "act map 1");
static_assert(WS_YCAT + (size_t)MT * DMOD * 2 <= WS_X && WS_X + (size_t)MT * DMOD * 4 <= WS_ACT && WS_ACT + (size_t)MT * DFF * 2 <= WS_PT, "act map 2");
static_assert(WS_PT + (size_t)RW_UNITS * 8192 <= WS_QQ && WS_QQ + (size_t)RW_UNITS * 16384 <= WS_RP && WS_RP + (size_t)RW_UNITS * 8192 <= WS_YV && WS_YV + (size_t)RW_UNITS * 16384 <= WS_SC && WS_SC + (size_t)RW_UNITS * 8192 <= WS_G1, "rwkv map");
static_assert(WS_G1 + (size_t)MT * 1024 * 4 <= WS_G2 && WS_G2 + (size_t)MT * 1024 * 4 <= WS_HALO && WS_HALO + (size_t)3 * 32 * 2 * DFF * 4 <= WS_WL && WS_WL + (size_t)RW_UNITS * 256 <= WS_PT32 && WS_PT32 + (size_t)RW_UNITS * 16384 <= WS_LSCR && WS_LSCR + (size_t)256 * 61440 <= WS_SLAB && WS_SLAB + (size_t)11 * 256 * 2048 * 4 <= WS_END && WS_LORA + 2 * LORA_LAYER <= WS_WIN && WS_MOD + (size_t)NLAYER * NMODB * MODW * 4 <= WS_LORA, "map 3");
constexpr int CW_BAR = 4096, CW_QUEUE = 8192;
constexpr int LDS_BYTES = 163840;
constexpr int MISC_OFF = LDS_BYTES - 256;
constexpr int LUT_OFF = 131072;
constexpr int HALO_OFF = 131072;
constexpr int RW_SLOT = 9216, RW_STRIDE = 72;
constexpr int RW_SCR = 154624;
static_assert(RW_SCR + 4096 <= MISC_OFF && HALO_OFF + 4096 <= MISC_OFF, "LDS map");

#define GAS __attribute__((address_space(1)))
#define LAS __attribute__((address_space(3)))
typedef unsigned short bf16;
typedef unsigned v4u __attribute__((ext_vector_type(4)));
typedef unsigned v2u __attribute__((ext_vector_type(2)));
typedef float f32x4 __attribute__((ext_vector_type(4)));
typedef float f32x2 __attribute__((ext_vector_type(2)));
typedef short bf16x8 __attribute__((ext_vector_type(8)));
typedef GAS unsigned gu32;
#define RLX_AGENT __ATOMIC_RELAXED, __HIP_MEMORY_SCOPE_AGENT
#define LDS_WAIT() asm volatile("s_waitcnt lgkmcnt(0)" ::: "memory")
#define VM_WAIT() asm volatile("s_waitcnt vmcnt(0)" ::: "memory")
typedef float cvt_f32x2 __attribute__((ext_vector_type(2))); typedef __bf16 cvt_bf16x2 __attribute__((ext_vector_type(2)));
__device__ __forceinline__ unsigned pk2(float lo, float hi) { const cvt_f32x2 v = {lo, hi}; return __builtin_bit_cast(unsigned, __builtin_convertvector(v, cvt_bf16x2)); }
__device__ __forceinline__ unsigned f2bf(float f) { return pk2(f, 0.f) & 0xffffu; }
__device__ __forceinline__ float bf2f(unsigned short b) { return __builtin_bit_cast(float, (unsigned)b << 16); }
template <int K> __device__ __forceinline__ float swz_xor(float v) { static_assert(K >= 1 && K <= 16, "");
    return __builtin_bit_cast(float, __builtin_amdgcn_ds_swizzle(__builtin_bit_cast(int, v), (K << 10) | 0x1f)); }
struct PL32 { float a, b; };
__device__ __forceinline__ PL32 pl32(float v) { const int ln = (int)(threadIdx.x & 63);
    const float p = __builtin_bit_cast(float, __builtin_amdgcn_ds_bpermute((ln ^ 32) << 2, __builtin_bit_cast(int, v))); PL32 o; o.a = v; o.b = p; return o; }
__device__ __forceinline__ float xor32(float v) { return pl32(v).b; }
template <int CTRL> __device__ __forceinline__ float dpp_f(float v) { return __builtin_bit_cast(float, __builtin_amdgcn_update_dpp(__builtin_bit_cast(int, v), __builtin_bit_cast(int, v), CTRL, 0xF, 0xF, false)); }
__device__ __forceinline__ float wave_sum(float v) {
    v += dpp_f<0xB1>(v); v += dpp_f<0x4E>(v); v += dpp_f<0x141>(v); v += dpp_f<0x128>(v); v += swz_xor<16>(v);
    const PL32 r = pl32(v); return r.a + r.b;
}
__device__ __forceinline__ float wave_max(float v) {
    v = fmaxf(v, dpp_f<0xB1>(v)); v = fmaxf(v, dpp_f<0x4E>(v)); v = fmaxf(v, dpp_f<0x141>(v)); v = fmaxf(v, dpp_f<0x128>(v)); v = fmaxf(v, swz_xor<16>(v));
    const PL32 r = pl32(v); return fmaxf(r.a, r.b);
}
__device__ __forceinline__ float sigmoidf_(float x) { return __builtin_amdgcn_rcpf(1.f + __expf(-x)); }
namespace pg8 {
#define PG8_LAS __attribute__((address_space(3)))
typedef unsigned short bf16_t;
typedef short bf16x8 __attribute__((ext_vector_type(8)));
typedef float f32x4 __attribute__((ext_vector_type(4)));
typedef unsigned u32x4 __attribute__((ext_vector_type(4)));
constexpr int BM = 256, BK = 64, HALF = 128, HTB = HALF * BK * 2  , STAGE_BYTES = 8 * HTB, NXCD = 8, WGM = 8;

__host__ __device__ __forceinline__ int lds_byte(int r, int c) { const int st = (r >> 4) * 2 + (c >> 5), rr = r & 15, cc = c & 31, ob = rr * 64 + cc * 2; return st * 1024 + (ob ^ (((ob >> 9) & 1) << 5)); }
__host__ __device__ __forceinline__ void stage_rc(int b, int& R, int& C) { const int st = b / 1024, sb = b % 1024, swz = sb ^ (((sb >> 9) & 1) << 5); R = (st >> 1) * 16 + swz / 64; C = (st & 1) * 32 + (swz % 64) / 2; }
__host__ __device__ __forceinline__ int perm32(int rho) { const int n = rho >> 4, i = rho & 15; return 8 * (i >> 2) + 4 * n + (i & 3); }

struct Unit { int pm, pn, ks, tag; };
struct Gemm { const bf16_t* A; const bf16_t* Bt; int M, N, K, ld; };

struct StaticOrder {
    static constexpr bool HANDOFF = false;
    int nM, nN, nwg, G, c;
    __host__ __device__ void init(int M, int N, int G_, int c_) { nM = M / BM; nN = N / BM; nwg = nM * nN; G = G_; c = c_; }
    __host__ __device__ bool next(int i, Unit& u) const {
        const long L = (long)i * G + c; if (L >= nwg) return false;
        int wgid = (int)L; { const int q = nwg / NXCD, r = nwg % NXCD, xcd = wgid % NXCD, off = wgid / NXCD; wgid = (xcd < r ? xcd * (q + 1) : r * (q + 1) + (xcd - r) * q) + off; }
        const int nig = WGM * nN, gid = wgid / nig, fm = gid * WGM, gsz = (nM - fm) < WGM ? (nM - fm) : WGM;
        u.pm = fm + ((wgid % nig) % gsz); u.pn = (wgid % nig) / gsz; u.ks = 0; u.tag = 0; return true;
    }
    __device__ __forceinline__ void a_ready(const Unit&) const {}
    __device__ __forceinline__ void done(const Unit&) const {}
};

struct TwoPartOrder {
    static constexpr bool HANDOFF = true;
    int nM, nA, nB, G, c; unsigned* cnt; int nsig;
    __device__ __forceinline__ void mid(const Unit& u, int t, int nt, int wid, int lane) const {
        if (cnt == nullptr || u.tag != 2) return;
        if (t == nt / 2) asm volatile("s_waitcnt vmcnt(0)" ::: "memory");
        if (t == nt / 2 + 2 && wid == 0) { __builtin_amdgcn_fence(__ATOMIC_RELEASE, "agent"); asm volatile("s_waitcnt vmcnt(0)" ::: "memory");
            if (lane == 0) (void)__hip_atomic_fetch_add(cnt, (unsigned)nsig, __ATOMIC_RELAXED, __HIP_MEMORY_SCOPE_AGENT); }
    }
    __host__ __device__ void init(int M, int NA, int NB, int G_, int c_, unsigned* cnt_, int nsig_) { nM = M / BM; nA = NA; nB = NB; G = G_; c = c_; cnt = cnt_; nsig = nsig_; }
    __host__ __device__ static void map(int wgid, int nM, int nN, Unit& u) {
        const int nwg = nM * nN; { const int q = nwg / NXCD, r = nwg % NXCD, xcd = wgid % NXCD, off = wgid / NXCD; wgid = (xcd < r ? xcd * (q + 1) : r * (q + 1) + (xcd - r) * q) + off; }
        const int nig = WGM * nN, gid = wgid / nig, fm = gid * WGM, gsz = (nM - fm) < WGM ? (nM - fm) : WGM;
        u.pm = fm + ((wgid % nig) % gsz); u.pn = (wgid % nig) / gsz; u.ks = 0;
    }
    __host__ __device__ bool next(int i, Unit& u) const {
        const long L = (long)i * G + c; const int na = nM * nA, nb = nM * nB; if (L >= na + nb) return false;
        if (L < na) map((int)L, nM, nA, u); else { map((int)L - na, nM, nB, u); u.pn += nA; }
        u.tag = i; return true;
    }
    __device__ __forceinline__ void a_ready(const Unit&) const {}
    __device__ __forceinline__ void done(const Unit&) const {}
};

struct PmFirstOrder {
    static constexpr bool HANDOFF = true;
    int nM, nN, G, c; unsigned* cnt;
    __host__ __device__ void init(int M, int N, int G_, int c_, unsigned* cnt_) { nM = M / BM; nN = N / BM; G = G_; c = c_; cnt = cnt_; }
    __host__ __device__ __forceinline__ bool next(int i, Unit& u) const {
        const long L = (long)i * G + c; if (L >= (long)nM * nN) return false;
        if (L < nN) { u.pm = nM - 1; u.pn = (int)L; u.ks = 0; } else TwoPartOrder::map((int)L - nN, nM - 1, nN, u);
        u.tag = i; return true;
    }
    __device__ __forceinline__ void a_ready(const Unit&) const {}
    __device__ __forceinline__ void done(const Unit&) const {}
    __device__ __forceinline__ void mid(const Unit& u, int t, int nt, int wid, int lane) const {
        if (cnt == nullptr || u.tag != 1 || c >= nN) return;
        if (t == nt / 2) asm volatile("s_waitcnt vmcnt(0)" ::: "memory");
        if (t == nt / 2 + 2 && wid == 0) { __builtin_amdgcn_fence(__ATOMIC_RELEASE, "agent"); asm volatile("s_waitcnt vmcnt(0)" ::: "memory");
            if (lane == 0) (void)__hip_atomic_fetch_add(cnt, 1u, __ATOMIC_RELAXED, __HIP_MEMORY_SCOPE_AGENT); }
    }
};
struct TailSplitOrder {
    static constexpr bool HANDOFF = false;
    int n, KS, k, nw;
    __host__ __device__ void init(int N, int KS_, int c_, int first, int nw_) { n = (N / BM) * KS_; KS = KS_; k = c_ - first; nw = nw_; }
    __host__ __device__ __forceinline__ bool next(int i, Unit& u) const { const int L = k + i * nw; if (k < 0 || L >= n) return false; u.pm = 0; u.pn = L / KS; u.ks = L % KS; u.tag = 0; return true; }
    __device__ __forceinline__ void a_ready(const Unit&) const {}
    __device__ __forceinline__ void done(const Unit&) const {}
};

struct SplitOrder {
    static constexpr bool HANDOFF = false;
    int n, KS, c;
    __host__ __device__ void init(int N, int KS_, int c_) { n = (N / BM) * KS_; KS = KS_; c = c_; }
    __host__ __device__ bool next(int i, Unit& u) const { if (i > 0 || c >= n) return false; u.pm = 0; u.pn = c / KS; u.ks = c % KS; u.tag = 0; return true; }
    __device__ __forceinline__ void a_ready(const Unit&) const {}
    __device__ __forceinline__ void done(const Unit&) const {}
};
__device__ __forceinline__ unsigned cvt_pk_bf16(float lo, float hi) { unsigned r; asm volatile("v_cvt_pk_bf16_f32 %0, %1, %2" : "=v"(r) : "v"(lo), "v"(hi)); return r; }
typedef float f32x2 __attribute__((ext_vector_type(2)));
__device__ __forceinline__ f32x2 gelu_pk(f32x2 v) {
    const f32x2 av = __builtin_elementwise_abs(v), d = av * 0.2316418882f + 1.0f;
    f32x2 t; t.x = __builtin_amdgcn_rcpf(d.x); t.y = __builtin_amdgcn_rcpf(d.y);
    f32x2 q = t * 0.5307027145f + (-0.7265760135f); q = q * t + 0.7107068705f; q = q * t + (-0.142248368f); q = q * t + 0.127414796f; q = q * t;
    const f32x2 s = (v * v) * (-0.72134752044f);
    f32x2 e; e.x = __builtin_amdgcn_exp2f(s.x); e.y = __builtin_amdgcn_exp2f(s.y);
    const f32x2 m = v * (q * e), r = v - m;
    f32x2 o; o.x = v.x < 0.f ? m.x : r.x; o.y = v.y < 0.f ? m.y : r.y; return o;
}

template <class Epi, class Sched, bool ALIGN_EPI = false, bool SP2 = false>
__device__ __forceinline__ void gemm_phase(PG8_LAS unsigned char* lds, const Gemm g, const Sched& S, const Epi& E) {
    int tid_ = threadIdx.x; asm volatile("" : "+v"(tid_));
    const int tid = tid_, wid = __builtin_amdgcn_readfirstlane(tid >> 6), lane = tid & 63, wr = wid >> 2, wc = wid & 3, fr = lane & 15, fq = lane >> 4;
    const int K = g.ld, nt = g.K / BK;
    unsigned voffA[2], voffB[2];
#pragma unroll
    for (int i = 0; i < 2; ++i) { int R, C; stage_rc(tid * 16 + i * 8192, R, C); const int Rb = Epi::PERM ? ((R & ~31) + perm32(R & 31)) : R;
        voffA[i] = (unsigned)(R * K + C) * 2u; voffB[i] = (unsigned)(Rb * K + C) * 2u; }
    const size_t kstep = (size_t)(BK * 2);
    const size_t hstep = (size_t)HALF * K * 2;
    const size_t tstep = 2 * hstep;
    const unsigned ldsw = (unsigned)wid * 1024u;
    const int aoff = lds_byte(wr * 64 + fr, fq * 8), boff = lds_byte(wc * 32 + fr, fq * 8);
#define PG8_SA(b, h) (((b) * 2 + (h)) * HTB)
#define PG8_SB(b, h) ((4 + (b) * 2 + (h)) * HTB)
#define PG8_STAGE(bufoff, gbase, voff) do { _Pragma("unroll") for (int _i = 0; _i < 2; ++_i) \
        __builtin_amdgcn_global_load_lds((const unsigned*)((const char*)(gbase) + (voff)[_i]), (PG8_LAS unsigned*)(lds + (bufoff) + ldsw + _i * 8192), 16, 0, 0); } while (0)
#define PG8_LDA(dst, b, h) do { _Pragma("unroll") for (int m = 0; m < 4; ++m) _Pragma("unroll") for (int k = 0; k < 2; ++k) dst[m][k] = *(const PG8_LAS bf16x8*)(lds + PG8_SA(b, h) + aoff + m * 2048 + k * 1024); } while (0)
#define PG8_LDB(dst, b, h) do { _Pragma("unroll") for (int n = 0; n < 2; ++n) _Pragma("unroll") for (int k = 0; k < 2; ++k) dst[n][k] = *(const PG8_LAS bf16x8*)(lds + PG8_SB(b, h) + boff + n * 2048 + k * 1024); } while (0)
#define PG8_MMA(ai, bj, At, Bt) do { __builtin_amdgcn_s_setprio(1); _Pragma("unroll") for (int m = 0; m < 4; ++m) _Pragma("unroll") for (int n = 0; n < 2; ++n) _Pragma("unroll") for (int k = 0; k < 2; ++k) \
        acc[ai][bj][m][n] = __builtin_amdgcn_mfma_f32_16x16x32_bf16(Bt[n][k], At[m][k], acc[ai][bj][m][n], 0, 0, 0); __builtin_amdgcn_s_setprio(0); } while (0)
#define PG8_WAIT_V(n) asm volatile("s_waitcnt vmcnt(" #n ")" ::: "memory")
#define PG8_WAIT_L(n) asm volatile("s_waitcnt lgkmcnt(" #n ")" ::: "memory")
#define PG8_BAR __builtin_amdgcn_s_barrier()
#define PG8_SCHED __builtin_amdgcn_sched_barrier(0)
    Unit cur, nxt; int ui = 0;
    if (!S.next(0, cur)) return;
    f32x4 acc[2][2][4][2];
#pragma unroll
    for (int a = 0; a < 2; ++a)
#pragma unroll
        for (int b = 0; b < 2; ++b)
#pragma unroll
            for (int m = 0; m < 4; ++m)
#pragma unroll
                for (int n = 0; n < 2; ++n) acc[a][b][m][n] = (f32x4){0.f, 0.f, 0.f, 0.f};
    bf16x8 At[4][2], B0[2][2], B1[2][2];
    const size_t sstep = (size_t)g.K * 2;
    const char* cA = (const char*)g.A + (size_t)cur.pm * tstep + (size_t)cur.ks * sstep; const char* cB = (const char*)g.Bt + (size_t)cur.pn * tstep + (size_t)cur.ks * sstep;
    S.a_ready(cur);
    if constexpr (SP2) {
        PG8_STAGE(PG8_SB(0, 0), cB, voffB); PG8_STAGE(PG8_SB(0, 1), cB + hstep, voffB); PG8_STAGE(PG8_SA(0, 0), cA, voffA); PG8_STAGE(PG8_SA(0, 1), cA + hstep, voffA);
        if (wr == 1) PG8_BAR;
        PG8_WAIT_V(2); PG8_BAR;
        PG8_STAGE(PG8_SB(1, 0), cB + kstep, voffB); PG8_STAGE(PG8_SA(1, 0), cA + kstep, voffA); PG8_STAGE(PG8_SB(1, 1), cB + hstep + kstep, voffB);
        PG8_WAIT_V(6); PG8_BAR;
    } else {
        PG8_STAGE(PG8_SB(0, 0), cB, voffB); PG8_STAGE(PG8_SA(0, 0), cA, voffA); PG8_STAGE(PG8_SB(0, 1), cB + hstep, voffB); PG8_STAGE(PG8_SA(0, 1), cA + hstep, voffA);
        if (wr == 1) PG8_BAR;
        PG8_WAIT_V(4); PG8_BAR;
        PG8_STAGE(PG8_SB(1, 0), cB + kstep, voffB); PG8_STAGE(PG8_SA(1, 0), cA + kstep, voffA); PG8_STAGE(PG8_SB(1, 1), cB + hstep + kstep, voffB);
        PG8_WAIT_V(6); PG8_BAR;
    }
    for (;;) {
        const bool has_next = S.next(ui + 1, nxt);
        const char* nA = has_next ? (const char*)g.A + (size_t)nxt.pm * tstep + (size_t)nxt.ks * sstep : cA; const char* nB = has_next ? (const char*)g.Bt + (size_t)nxt.pn * tstep + (size_t)nxt.ks * sstep : cB;
        for (int t = 0; t < nt; t += 2) {
            const bool last = (t == nt - 2);
            const char* a1 = cA + (size_t)(t + 1) * kstep;
            const char* a2 = last ? nA : cA + (size_t)(t + 2) * kstep; const char* b2 = last ? nB : cB + (size_t)(t + 2) * kstep;
            const char* a3 = a2 + kstep; const char* b3 = b2 + kstep;
            if (last && has_next) S.a_ready(nxt);
            if constexpr (Sched::HANDOFF) S.mid(cur, t, nt, wid, lane);
            if constexpr (SP2) {
            PG8_LDB(B0, 0, 0); PG8_LDB(B1, 0, 1); PG8_SCHED; PG8_LDA(At, 0, 0); PG8_STAGE(PG8_SA(1, 1), a1 + hstep, voffA);
            PG8_WAIT_V(8); PG8_WAIT_L(0); PG8_BAR; PG8_MMA(0, 0, At, B0); PG8_MMA(0, 1, At, B1); PG8_BAR; PG8_SCHED;
            PG8_LDA(At, 0, 1); PG8_STAGE(PG8_SB(0, 0), b2, voffB); PG8_STAGE(PG8_SB(0, 1), b2 + hstep, voffB); PG8_STAGE(PG8_SA(0, 0), a2, voffA);
            PG8_WAIT_V(8); PG8_WAIT_L(0); PG8_BAR; PG8_MMA(1, 0, At, B0); PG8_MMA(1, 1, At, B1); PG8_BAR; PG8_SCHED;
            PG8_LDB(B0, 1, 0); PG8_LDB(B1, 1, 1); PG8_SCHED; PG8_LDA(At, 1, 0); PG8_STAGE(PG8_SA(0, 1), a2 + hstep, voffA);
            PG8_WAIT_V(8); PG8_WAIT_L(0); PG8_BAR; PG8_MMA(0, 0, At, B0); PG8_MMA(0, 1, At, B1); PG8_BAR; PG8_SCHED;
            PG8_LDA(At, 1, 1); PG8_STAGE(PG8_SB(1, 0), b3, voffB); PG8_STAGE(PG8_SB(1, 1), b3 + hstep, voffB); PG8_STAGE(PG8_SA(1, 0), a3, voffA);
            PG8_WAIT_V(8); PG8_WAIT_L(0); PG8_BAR; PG8_MMA(1, 0, At, B0); PG8_MMA(1, 1, At, B1); PG8_BAR; PG8_SCHED;
            } else {
            PG8_LDB(B0, 0, 0); PG8_SCHED; PG8_LDA(At, 0, 0); PG8_STAGE(PG8_SA(1, 1), a1 + hstep, voffA);
            PG8_WAIT_L(8); PG8_BAR; PG8_WAIT_L(0); PG8_MMA(0, 0, At, B0); PG8_BAR; PG8_SCHED;
            PG8_LDB(B1, 0, 1); PG8_STAGE(PG8_SB(0, 0), b2, voffB);
            PG8_BAR; PG8_WAIT_L(0); PG8_MMA(0, 1, At, B1); PG8_BAR;
            PG8_LDA(At, 0, 1); PG8_STAGE(PG8_SA(0, 0), a2, voffA);
            PG8_BAR; PG8_WAIT_L(0); PG8_MMA(1, 0, At, B0); PG8_BAR; PG8_SCHED;
            PG8_STAGE(PG8_SB(0, 1), b2 + hstep, voffB);
            PG8_WAIT_V(6); PG8_BAR; PG8_MMA(1, 1, At, B1); PG8_BAR;
            PG8_LDB(B0, 1, 0); PG8_SCHED; PG8_LDA(At, 1, 0); PG8_STAGE(PG8_SA(0, 1), a2 + hstep, voffA);
            PG8_WAIT_L(8); PG8_BAR; PG8_WAIT_L(0); PG8_MMA(0, 0, At, B0); PG8_BAR; PG8_SCHED;
            PG8_LDB(B1, 1, 1); PG8_STAGE(PG8_SB(1, 0), b3, voffB);
            PG8_BAR; PG8_WAIT_L(0); PG8_MMA(0, 1, At, B1); PG8_BAR;
            PG8_LDA(At, 1, 1); PG8_STAGE(PG8_SA(1, 0), a3, voffA);
            PG8_BAR; PG8_WAIT_L(0); PG8_MMA(1, 0, At, B0); PG8_BAR; PG8_SCHED;
            PG8_STAGE(PG8_SB(1, 1), b3 + hstep, voffB);
            PG8_WAIT_V(6); PG8_BAR; PG8_MMA(1, 1, At, B1); PG8_BAR;
            }
        }
        if constexpr (ALIGN_EPI) { if (wr == 0) PG8_BAR; }
        if constexpr (!Epi::AFTER_DRAIN) { E(acc, cur, wr, wc, fr, fq); S.done(cur); }
        if (!has_next) break;
#pragma unroll
        for (int a = 0; a < 2; ++a)
#pragma unroll
            for (int b = 0; b < 2; ++b)
#pragma unroll
                for (int m = 0; m < 4; ++m)
#pragma unroll
                    for (int n = 0; n < 2; ++n) acc[a][b][m][n] = (f32x4){0.f, 0.f, 0.f, 0.f};
        cur = nxt; cA = nA; cB = nB; ++ui;
        if constexpr (ALIGN_EPI) { if (wr == 1) PG8_BAR; }
    }
    PG8_WAIT_V(0);
    if constexpr (!ALIGN_EPI) { if (wr == 0) PG8_BAR; }
    PG8_BAR;
    if constexpr (Epi::AFTER_DRAIN) { E.fused(acc, cur, wr, wc, fr, fq, lds, wid, lane); S.done(cur); }
#undef PG8_SA
#undef PG8_SB
#undef PG8_STAGE
#undef PG8_LDA
#undef PG8_LDB
#undef PG8_MMA
#undef PG8_WAIT_V
#undef PG8_WAIT_L
#undef PG8_BAR
#undef PG8_SCHED
}
}
namespace pg8 {
typedef unsigned u32x2v __attribute__((ext_vector_type(2)));
constexpr int E_MP = 8192;
struct EpiIn {
    static constexpr bool PERM = true, AFTER_DRAIN = false;
    unsigned char* ws; float* out; int l; float qscale;
    __device__ __forceinline__ void operator()(const f32x4 (&acc)[2][2][4][2], const Unit& u, int wr, int wc, int fr, int fq) const {
        asm volatile("" : "+v"(fr), "+v"(fq));
        const int row0 = u.pm * BM + wr * 64 + fr, colt = u.pn * BM + wc * 32 + 8 * fq;
        if (u.pn < 14) {
            float* PR = (float*)(ws + WS_PR); float* sh_p = out + O_SP + (size_t)l * 3520; float* sh_s = out + O_SS + (size_t)l * 16 * 3520;
#pragma unroll
            for (int ai = 0; ai < 2; ++ai)
#pragma unroll
                for (int m = 0; m < 4; ++m) { const int r = row0 + ai * HALF + m * 16;
#pragma unroll
                    for (int bj = 0; bj < 2; ++bj) { const int c = colt + bj * HALF; float* p = PR + (size_t)r * 3584 + c;
                        *(f32x4*)p = acc[ai][bj][m][0]; *(f32x4*)(p + 4) = acc[ai][bj][m][1];
                        if (c < 3520) {
                            if (r == E_MP - 1) { *(f32x4*)(sh_p + c) = acc[ai][bj][m][0]; *(f32x4*)(sh_p + c + 4) = acc[ai][bj][m][1]; }
                            if (r >= E_MP && (r & 15) == 15) { float* q = sh_s + (size_t)((r - E_MP) >> 4) * 3520 + c; *(f32x4*)q = acc[ai][bj][m][0]; *(f32x4*)(q + 4) = acc[ai][bj][m][1]; }
                        } } }
        } else {
            const int region = (u.pn - 14) >> 2, cl0 = colt - 3584 - region * 1024;
            static_assert(WS_KB - WS_QB == WS_VB - WS_KB && O_VP - O_KP == (size_t)2 * 8192 * 1024 && O_VS - O_KS == (size_t)2 * 256 * 1024, "equal spacing");
            bf16_t* B16 = (bf16_t*)(ws + WS_QB + (size_t)region * (WS_KB - WS_QB));
            const float sc = region == 0 ? qscale : 1.f;
            float* fp = out + O_KP + (size_t)(region == 2 ? 1 : 0) * (O_VP - O_KP) + (size_t)l * E_MP * 1024; float* fs = out + O_KS + (size_t)(region == 2 ? 1 : 0) * (O_VS - O_KS) + (size_t)l * 256 * 1024;
#pragma unroll
            for (int ai = 0; ai < 2; ++ai)
#pragma unroll
                for (int m = 0; m < 4; ++m) { const int r = row0 + ai * HALF + m * 16;
                    float* fo = (r < E_MP) ? fp + (size_t)r * 1024 : fs + (size_t)(r - E_MP) * 1024;
#pragma unroll
                    for (int bj = 0; bj < 2; ++bj) { const int c = cl0 + bj * HALF; const f32x4 v0 = acc[ai][bj][m][0] * sc, v1 = acc[ai][bj][m][1] * sc;
                        u32x4 w; w.x = cvt_pk_bf16(v0[0], v0[1]); w.y = cvt_pk_bf16(v0[2], v0[3]); w.z = cvt_pk_bf16(v1[0], v1[1]); w.w = cvt_pk_bf16(v1[2], v1[3]);
                        *(u32x4*)(B16 + (size_t)r * 1024 + c) = w;
                        if (region != 0) { __builtin_nontemporal_store(v0, (f32x4*)(fo + c)); __builtin_nontemporal_store(v1, (f32x4*)(fo + c + 4)); } } }
        }
    }
};
struct EpiRes {
    static constexpr bool PERM = true, AFTER_DRAIN = false;
    const float* src_p; const float* src_s; float* dst; const float* gate;
    __device__ __forceinline__ void operator()(const f32x4 (&acc)[2][2][4][2], const Unit& u, int wr, int wc, int fr, int fq) const {
        asm volatile("" : "+v"(fr), "+v"(fq));
        const int row0 = u.pm * BM + wr * 64 + fr, colt = u.pn * BM + wc * 32 + 8 * fq;
        f32x4 gt[2][2];
#pragma unroll
        for (int bj = 0; bj < 2; ++bj)
#pragma unroll
            for (int n = 0; n < 2; ++n) gt[bj][n] = *(const f32x4*)(gate + colt + bj * HALF + 4 * n);
#pragma unroll
        for (int ai = 0; ai < 2; ++ai)
#pragma unroll
            for (int mp = 0; mp < 1; ++mp) {
                f32x4 x[4][2][2];
#pragma unroll
                for (int mm = 0; mm < 4; ++mm) { const int r = row0 + ai * HALF + (4 * mp + mm) * 16; const float* s = src_p + (size_t)r * 2048 + colt;
#pragma unroll
                    for (int bj = 0; bj < 2; ++bj)
#pragma unroll
                        for (int n = 0; n < 2; ++n) x[mm][bj][n] = *(const f32x4*)(s + bj * HALF + 4 * n); }
#pragma unroll
                for (int mm = 0; mm < 4; ++mm) { const int m = 4 * mp + mm, r = row0 + ai * HALF + m * 16; float* d = dst + (size_t)r * 2048 + colt;
#pragma unroll
                    for (int bj = 0; bj < 2; ++bj)
#pragma unroll
                        for (int n = 0; n < 2; ++n) *(f32x4*)(d + bj * HALF + 4 * n) = x[mm][bj][n] + gt[bj][n] * acc[ai][bj][m][n]; }
                asm volatile("" ::: "memory");
            }
    }
};
struct EpiResSlab {
    static constexpr bool PERM = true, AFTER_DRAIN = false;
    float* slab; const float* gate;
    __device__ __forceinline__ void operator()(const f32x4 (&acc)[2][2][4][2], const Unit& u, int wr, int wc, int fr, int fq) const {
        asm volatile("" : "+v"(fr), "+v"(fq));
        const int row0 = wr * 64 + fr, colt = u.pn * BM + wc * 32 + 8 * fq;
#pragma unroll
        for (int ai = 0; ai < 2; ++ai)
#pragma unroll
            for (int m = 0; m < 4; ++m) { const int r = row0 + ai * HALF + m * 16;
                const float* g = gate + (size_t)(1 + (r >> 4)) * 12288 + colt; float* d = slab + ((size_t)u.ks * 256 + r) * 2048 + colt;
                f32x4 gt[2][2];
#pragma unroll
                for (int bj = 0; bj < 2; ++bj)
#pragma unroll
                    for (int n = 0; n < 2; ++n) gt[bj][n] = *(const f32x4*)(g + bj * HALF + 4 * n);
#pragma unroll
                for (int bj = 0; bj < 2; ++bj)
#pragma unroll
                    for (int n = 0; n < 2; ++n) *(f32x4*)(d + bj * HALF + 4 * n) = gt[bj][n] * acc[ai][bj][m][n]; }
    }
};
template <int CTRL> __device__ __forceinline__ float dppf(float old, float src) { return __builtin_bit_cast(float, __builtin_amdgcn_update_dpp(__builtin_bit_cast(int, old), __builtin_bit_cast(int, src), CTRL, 0xF, 0xF, false)); }
struct EpiUp {
    static constexpr bool PERM = true, AFTER_DRAIN = false;
    bf16_t* ACT; const float* cw; const float* cb; const float* sconv; float* halo; float* conv_p; float* conv_s; PG8_LAS float* hb;
    template <bool SAMP> __device__ __forceinline__ void run(const f32x4 (&acc)[2][2][4][2], const Unit& u, int wr, int wc, int fr, int fq) const {
        asm volatile("" : "+v"(fr), "+v"(fq));
        const int jl = wc * 32 + 8 * fq, j0 = u.pn * HALF + jl;
#pragma unroll
        for (int ai = 0; ai < 2; ++ai) { const int blk = 2 * ai + wr;
            if (!SAMP && fr >= 14) {
                if (blk < 3) { PG8_LAS float* h = hb + ((blk + 1) * 2 + (fr - 14)) * HALF + jl; *(PG8_LAS f32x4*)h = acc[ai][0][3][0]; *(PG8_LAS f32x4*)(h + 4) = acc[ai][0][3][1]; }
                else { float* t = halo + ((size_t)u.pm * 2 + (fr - 14)) * 5632 + j0; *(f32x4*)t = acc[ai][0][3][0]; *(f32x4*)(t + 4) = acc[ai][0][3][1];
                    if (u.pm == 31) { float* c = conv_p + (size_t)(fr - 14) * 5632 + j0; *(f32x4*)c = acc[ai][0][3][0]; *(f32x4*)(c + 4) = acc[ai][0][3][1]; } }
            }
            if (SAMP && fr >= 14) {
#pragma unroll
                for (int m = 0; m < 4; ++m) { const int sb = 8 * ai + 4 * wr + m; float* c = conv_s + ((size_t)sb * 2 + (fr - 14)) * 5632 + j0; *(f32x4*)c = acc[ai][0][m][0]; *(f32x4*)(c + 4) = acc[ai][0][m][1]; }
            }
        }
        asm volatile("s_waitcnt lgkmcnt(0)\n\ts_barrier" ::: "memory");
        f32x4 cwv[2][3], cbv[2];
#pragma unroll
        for (int n = 0; n < 2; ++n) { cwv[n][0] = *(const f32x4*)(cw + j0 + 4 * n); cwv[n][1] = *(const f32x4*)(cw + 5632 + j0 + 4 * n); cwv[n][2] = *(const f32x4*)(cw + 2 * 5632 + j0 + 4 * n); cbv[n] = *(const f32x4*)(cb + j0 + 4 * n); }
#pragma unroll
        for (int ai = 0; ai < 2; ++ai) { const int blk = 2 * ai + wr;
#pragma unroll
            for (int m = 0; m < 4; ++m) { const int r = u.pm * BM + ai * HALF + wr * 64 + m * 16 + fr;
                u32x4 w;
#pragma unroll
                for (int n = 0; n < 2; ++n) {
                    f32x4 pv = (f32x4){0.f, 0.f, 0.f, 0.f};
                    if (SAMP) { if (fr >= 14) { const int sb = 8 * ai + 4 * wr + m; pv = *(const f32x4*)(sconv + ((size_t)sb * 2 + (fr - 14)) * 5632 + j0 + 4 * n); } asm volatile("" : "+v"(pv)); }
                    else if (m == 0) { if (blk > 0 && fr >= 14) pv = *(const PG8_LAS f32x4*)(hb + (blk * 2 + (fr - 14)) * HALF + jl + 4 * n); asm volatile("" : "+v"(pv)); }
                    else pv = acc[ai][0][m > 0 ? m - 1 : 0][n];
                    const f32x4 w0 = cwv[n][0], w1 = cwv[n][1], w2 = cwv[n][2], bb = cbv[n];
                    f32x4 o;
#pragma unroll
                    for (int i = 0; i < 4; ++i) { const float cur = acc[ai][0][m][n][i], pr = pv[i];
                        const float t1 = dppf<0x121>(pr, pr), p1 = dppf<0x111>(t1, cur);
                        const float t2 = dppf<0x122>(pr, pr), p2 = dppf<0x112>(t2, cur);
                        o[i] = bb[i] + w0[i] * p2 + w1[i] * p1 + w2[i] * cur; }
                    const f32x2 g0 = gelu_pk((f32x2){o[0], o[1]}), g1 = gelu_pk((f32x2){o[2], o[3]});
                    const f32x4 uv = acc[ai][1][m][n];
                    const unsigned lo = cvt_pk_bf16(g0.x * uv[0], g0.y * uv[1]), hi = cvt_pk_bf16(g1.x * uv[2], g1.y * uv[3]);
                    if (n == 0) { w.x = lo; w.y = hi; } else { w.z = lo; w.w = hi; }
                }
                const bool head = (!SAMP && u.pm > 0 && blk == 0 && m == 0 && fr < 2);
                if (!head) *(u32x4*)(ACT + (size_t)r * 5632 + j0) = w;
                else { float* hg = halo + (size_t)32 * 2 * 5632 + ((size_t)u.pm * 2 + fr) * 5632 + j0; float* hv = hg + (size_t)32 * 2 * 5632;
                    *(f32x4*)hg = acc[ai][0][m][0]; *(f32x4*)(hg + 4) = acc[ai][0][m][1]; *(f32x4*)hv = acc[ai][1][m][0]; *(f32x4*)(hv + 4) = acc[ai][1][m][1]; }
                asm volatile("" ::: "memory");
            } }
    }
    __device__ __forceinline__ void operator()(const f32x4 (&acc)[2][2][4][2], const Unit& u, int wr, int wc, int fr, int fq) const {
        if (u.pm == 32) run<true>(acc, u, wr, wc, fr, fq); else run<false>(acc, u, wr, wc, fr, fq);
    }
};
}
#include <hip/hip_bf16.h>
#include <cmath>
namespace attn_body {
using bf16=__hip_bfloat16;
using bf16x8=__attribute__((ext_vector_type(8)))short;
using s16x4=__attribute__((ext_vector_type(4)))short;
using f32x16=__attribute__((ext_vector_type(16)))float;
using u32x4=__attribute__((ext_vector_type(4)))unsigned;
constexpr int BATCH=1,NHEAD=16,SEQ=8192,D=64,DM=NHEAD*D;
constexpr int NW=8,QBLK=32,QB=QBLK*NW,KVBLK=64,NQB=SEQ/QB;
constexpr int ATTN_PITCH=DM, ATTN_UNIT_ROWS=QB, OPITCH=2048;
__device__ __forceinline__ int crow(int r,int hi){return (r&3)+8*(r>>2)+4*hi;}
#define SBAR() __builtin_amdgcn_sched_barrier(0)
__device__ __forceinline__ void bmask(f32x16&p0,f32x16&p1,int t,int cq,int qabs,int hi,const __attribute__((address_space(3))) float*lut){
  if(t>cq){
    #pragma unroll
    for(int r=0;r<16;++r){p0[r]=-INFINITY;p1[r]=-INFINITY;}
  } else {
    const int d0=64*t+4*hi-qabs+128;
    #pragma unroll
    for(int r=0;r<16;++r){int i0=d0+(r&3)+8*(r>>2); int i1=i0+32; i0=i0<0?0:i0; i1=i1<0?0:i1; p0[r]+=lut[i0]; p1[r]+=lut[i1];}
  }
}

constexpr int NSLOT=3, SLOTB=8192;
constexpr int LDS_K=0, LDS_V=NSLOT*SLOTB, LDS_WS=2*NSLOT*SLOTB, LDS_OST=LDS_WS+NW*64*4, LDS_BYTES=LDS_OST+NW*4096;
constexpr float C2=0.125f*1.4426950408889634f;
__device__ __forceinline__ void glds16(const void*gsrc,unsigned lds_dst){unsigned keep;
  asm volatile("s_mov_b32 %0, m0\n\ts_mov_b32 m0, %2\n\ts_nop 0\n\tglobal_load_lds_dwordx4 %1, off\n\ts_mov_b32 m0, %0":"=&s"(keep):"v"(gsrc),"s"(lds_dst):"memory");}
__device__ __forceinline__ float max3f(float a,float b,float c){float r;asm("v_max3_f32 %0, %1, %2, %3":"=v"(r):"v"(a),"v"(b),"v"(c));return r;}
__device__ __forceinline__ float max2f(float a,float b){float r;asm("v_max_f32_e32 %0, %1, %2":"=v"(r):"v"(a),"v"(b));return r;}
__device__ __forceinline__ float fadd_s(float a,float b){float r;asm("v_add_f32_e32 %0, %1, %2":"=v"(r):"v"(a),"v"(b));return r;}
__device__ __forceinline__ float fsub_s(float a,float b){float r;asm("v_sub_f32_e32 %0, %1, %2":"=v"(r):"v"(a),"v"(b));return r;}
typedef float f32x2_t __attribute__((ext_vector_type(2))); typedef __bf16 bf16x2_t __attribute__((ext_vector_type(2)));
__device__ __forceinline__ unsigned cvtpk_s(float lo,float hi){f32x2_t v={lo,hi};bf16x2_t b=__builtin_convertvector(v,bf16x2_t);return __builtin_bit_cast(unsigned,b);}
#define WAIT_BAR(N) asm volatile("s_waitcnt vmcnt(" #N ") lgkmcnt(0)\n\ts_barrier":::"memory")

__device__ __forceinline__ void qkt(f32x16&p0,f32x16&p1,const char*Kslot,const bf16x8*qr,const f32x16&negm,int r32,int hi){
  const char*kb=Kslot+hi*1024+r32*16;
  #pragma unroll
  for(int d0=0;d0<4;++d0){
    const bf16x8 b0=*reinterpret_cast<const bf16x8*>(kb+d0*2048);
    const bf16x8 b1=*reinterpret_cast<const bf16x8*>(kb+d0*2048+512);
    if(d0==0){p0=__builtin_amdgcn_mfma_f32_32x32x16_bf16(b0,qr[0],negm,0,0,0);p1=__builtin_amdgcn_mfma_f32_32x32x16_bf16(b1,qr[0],negm,0,0,0);}
    else{p0=__builtin_amdgcn_mfma_f32_32x32x16_bf16(b0,qr[d0],p0,0,0,0);p1=__builtin_amdgcn_mfma_f32_32x32x16_bf16(b1,qr[d0],p1,0,0,0);}}
}
typedef __attribute__((address_space(3))) const char* lds_cptr;
typedef short v4i16_t __attribute__((ext_vector_type(4)));
__device__ __forceinline__ void kload8(bf16x8*kf,lds_cptr kp){
  kf[0]=*(const __attribute__((address_space(3))) bf16x8*)(kp);      kf[1]=*(const __attribute__((address_space(3))) bf16x8*)(kp+512);
  kf[2]=*(const __attribute__((address_space(3))) bf16x8*)(kp+2048); kf[3]=*(const __attribute__((address_space(3))) bf16x8*)(kp+2560);
  kf[4]=*(const __attribute__((address_space(3))) bf16x8*)(kp+4096); kf[5]=*(const __attribute__((address_space(3))) bf16x8*)(kp+4608);
  kf[6]=*(const __attribute__((address_space(3))) bf16x8*)(kp+6144); kf[7]=*(const __attribute__((address_space(3))) bf16x8*)(kp+6656);
}
__device__ __forceinline__ void kload2(bf16x8*kf,lds_cptr kp,int j){ kf[2*j]=*(const __attribute__((address_space(3))) bf16x8*)(kp+j*2048); kf[2*j+1]=*(const __attribute__((address_space(3))) bf16x8*)(kp+j*2048+512); }
__device__ __forceinline__ s16x4 vtr(lds_cptr p){ return __builtin_bit_cast(s16x4,__builtin_amdgcn_ds_read_tr16_b64_v4i16((__attribute__((address_space(3))) v4i16_t*)p)); }
__device__ __forceinline__ float rowmax(const f32x16&p0,const f32x16&p1){
  float a=max3f(p0[0],p0[1],p1[0]),b=max3f(p0[2],p0[3],p1[1]);a=max3f(a,p1[2],p1[3]);
  #pragma unroll
  for(int r=4;r<16;r+=4){a=max3f(a,p0[r],p0[r+1]);b=max3f(b,p0[r+2],p0[r+3]);a=max3f(a,p1[r],p1[r+1]);b=max3f(b,p1[r+2],p1[r+3]);}
  const float m=max2f(a,b);
  const PL32 rr=pl32(m);
  return max2f(rr.a,rr.b);
}
__device__ __forceinline__ void pv(f32x16*o,int vb,bf16x8 pa0,bf16x8 pa1,bf16x8 pa2,bf16x8 pa3){
  #pragma unroll
  for(int d0=0;d0<2;++d0){s16x4 lo[4],hi[4];
    #pragma unroll
    for(int ks=0;ks<4;++ks){
      asm volatile("ds_read_b64_tr_b16 %0,%1 offset:%c2":"=&v"(lo[ks]):"v"(vb),"i"(d0*4096+ks*1024):"memory");
      asm volatile("ds_read_b64_tr_b16 %0,%1 offset:%c2":"=&v"(hi[ks]):"v"(vb),"i"(d0*4096+ks*1024+512):"memory");}
    asm volatile("s_waitcnt lgkmcnt(0)":::"memory");SBAR();
    #define PK(k) (bf16x8){lo[k][0],lo[k][1],lo[k][2],lo[k][3],hi[k][0],hi[k][1],hi[k][2],hi[k][3]}
    o[d0]=__builtin_amdgcn_mfma_f32_32x32x16_bf16(pa0,PK(0),o[d0],0,0,0);
    o[d0]=__builtin_amdgcn_mfma_f32_32x32x16_bf16(pa1,PK(1),o[d0],0,0,0);
    o[d0]=__builtin_amdgcn_mfma_f32_32x32x16_bf16(pa2,PK(2),o[d0],0,0,0);
    o[d0]=__builtin_amdgcn_mfma_f32_32x32x16_bf16(pa3,PK(3),o[d0],0,0,0);
    #undef PK
  }
}

#ifndef ATTN_STORE16
#define ATTN_STORE16(p,v) (*(u32x4*)(p)=(v))
#endif
template<int THRL> __device__ __forceinline__ void attn_unit(int qb,int qkcol,int vcol,int ocol,int hh,const float*__restrict__ reltab,const bf16*Q,const bf16*__restrict__ K,const bf16*__restrict__ V,bf16*O,char*shm,const __attribute__((address_space(3))) float*lut){
  const int b=0;
  int tid_=threadIdx.x; asm volatile("":"+v"(tid_));
  const int tid=tid_,lane=tid&63,r32=lane&31,hi=lane>>5; const int wid=__builtin_amdgcn_readfirstlane(tid>>6);
  const long rowbase=(long)b*SEQ; const int q0=qb*QB;
  const bf16*Qw=Q+(rowbase+q0+wid*QBLK)*DM+qkcol;
  const bf16*Kh=K+rowbase*DM+qkcol,*Vh=V+rowbase*DM+vcol;
  const unsigned lds0=(unsigned)(uintptr_t)shm;
  float*wsf=(float*)(shm+LDS_WS)+wid*64;
  const bf16*ksrc=Kh+(long)lane*DM+wid*8;
  const bf16*vsrc=Vh+(long)(16*(wid&3)+(lane>>2))*DM+(wid>>2)*32+(lane&3)*8;
  const unsigned kdst=lds0+LDS_K+wid*1024, vdst=lds0+LDS_V+wid*1024;
  #define DMA_K(t,slot) glds16(ksrc+(long)(t)*KVBLK*DM,(unsigned)__builtin_amdgcn_readfirstlane(kdst+(slot)))
  #define DMA_V(t,slot) glds16(vsrc+(long)(t)*KVBLK*DM,(unsigned)__builtin_amdgcn_readfirstlane(vdst+(slot)))
  const int vb0=(int)(lds0+LDS_V)+((lane>>4)&1)*32+(lane&3)*8+(4*hi+((lane&15)>>2))*64;
  const char*Kbase=shm+LDS_K; bf16x8 kf[8];
  const lds_cptr shm3=(lds_cptr)shm; const lds_cptr kp0=shm3+LDS_K+hi*1024+r32*16; const lds_cptr vp0=shm3+LDS_V+((lane>>4)&1)*32+(lane&3)*8+(4*hi+((lane&15)>>2))*64;
  const int NT=(q0+QB)/KVBLK;
  const int cq=(q0>>6)+(wid>>1), cqm2=cq-2, qabs=q0+wid*QBLK+r32;
  DMA_K(0,0);DMA_V(0,0);DMA_K(1,SLOTB);
  bf16x8 qr[4];
  #pragma unroll
  for(int d0=0;d0<4;++d0)qr[d0]=*reinterpret_cast<const bf16x8*>(&Qw[(long)r32*DM+d0*16+hi*8]);
  float mhat=0.f,l_reg=0.f;f32x16 o[2];o[0]=f32x16{};o[1]=f32x16{};f32x16 negm=f32x16{};asm volatile("":"+v"(negm));
  const int qrel=wid*QBLK+r32;
  #define CMASK(P0,P1,t) do{ if((t)>=cqm2)bmask(P0,P1,(t),cq,qabs,hi,lut);}while(0)
  bool resc=false;
  #define START(P0,P1) do{ const float rm=rowmax(P0,P1); resc=false; \
    { const float dl=rm; mhat=fadd_s(mhat,dl); \
      _Pragma("unroll") for(int r=0;r<16;++r){P0[r]=fsub_s(P0[r],dl);P1[r]=fsub_s(P1[r],dl);} \
      _Pragma("unroll") for(int r=0;r<16;++r)negm[r]=-mhat; asm volatile("":"+v"(negm)); } \
    _Pragma("unroll") for(int r=0;r<16;++r)P0[r]=__builtin_amdgcn_exp2f(P0[r]); }while(0)
  #define RESC() do{ if(resc){ asm volatile("s_waitcnt lgkmcnt(0)":::"memory"); \
      _Pragma("unroll") for(int d_=0;d_<2;++d_) _Pragma("unroll") for(int r=0;r<16;++r)o[d_][r]*=wsf[crow(r,hi)]; } }while(0)
  f32x16 pA0,pA1,pB0,pB1;
  int sl_prev=0,sl_cur=0,sl_next=SLOTB;
  #define ROT() do{sl_prev=sl_cur;sl_cur=sl_next;sl_next=(sl_next==(NSLOT-1)*SLOTB)?0:sl_next+SLOTB;}while(0)
  DMA_K(2,2*SLOTB);
  WAIT_BAR(3);
  qkt(pA0,pA1,Kbase,qr,negm,r32,hi);asm volatile("s_nop 15\n\ts_nop 7":"+v"(pA0),"+v"(pA1));CMASK(pA0,pA1,0);
  START(pA0,pA1);
  _Pragma("unroll") for(int r=0;r<16;++r)pA1[r]=__builtin_amdgcn_exp2f(pA1[r]);
  WAIT_BAR(0);
  DMA_K(3,0);DMA_V(1,SLOTB);
  ROT();
  kload8(kf,kp0+sl_cur);
  WAIT_BAR(2);
  s16x4 vlo[8],vhi[8]; u32x4 pw0,pw1,pw2,pw3;
  #define PKW(P,B) cvtpk_s(P[B],P[B+1])
  #define PAF(k) __builtin_bit_cast(bf16x8,pw##k)
  #define VFR(i) (bf16x8){vlo[i][0],vlo[i][1],vlo[i][2],vlo[i][3],vhi[i][0],vhi[i][1],vhi[i][2],vhi[i][3]}
  #define PIN(x) asm volatile("":"+v"(x))
  #define MX3(a,b,c) __builtin_fmaxf(__builtin_fmaxf((a),(b)),(c))
  #define GAPA(MF,A0,A1,A2,A3,W0,W1,PW) do{ MF; sacc+=A0; sacc+=A1; sacc+=A2; sacc+=A3; PIN(sacc); W0; W1; PIN(PW); SBAR(); }while(0)
  #define EX(v) __builtin_amdgcn_exp2f(v)
  #define GAPB(MF,X,B) do{ MF; X[B]=EX(X[B]); X[B+1]=EX(X[B+1]); X[B+2]=EX(X[B+2]); X[B+3]=EX(X[B+3]); PIN(X); SBAR(); }while(0)
  #define VRD(i) do{ vlo[i]=vtr(vp_+(((i)>>2)*4096+((i)&3)*1024)); vhi[i]=vtr(vp_+(((i)>>2)*4096+((i)&3)*1024+512)); }while(0)
  #define KRD(G,j) do{ if(G){ kload2(kf,kp0+sl_next,j); SBAR(); } }while(0)
  #define STEP(C0,C1,P0,P1,t,GK,GV,GL) do{ SBAR(); \
    const lds_cptr vp_=vp0+sl_prev; \
    VRD(0); SBAR(); float sacc=(P0[0]+P0[1]); \
    GAPA(C0=__builtin_amdgcn_mfma_f32_32x32x16_bf16(kf[0],qr[0],negm,0,0,0), P0[2],P0[3],P0[4],P0[5],     pw0[0]=PKW(P0,0), pw0[1]=PKW(P0,2), pw0); \
    VRD(4); SBAR(); GAPA(C1=__builtin_amdgcn_mfma_f32_32x32x16_bf16(kf[1],qr[0],negm,0,0,0), P0[6],P0[7],P0[8],P0[9],     pw0[2]=PKW(P0,4), pw0[3]=PKW(P0,6), pw0); \
    VRD(1); SBAR(); GAPA(C0=__builtin_amdgcn_mfma_f32_32x32x16_bf16(kf[2],qr[1],C0,0,0,0),   P0[10],P0[11],P0[12],P0[13], pw1[0]=PKW(P0,8), pw1[1]=PKW(P0,10), pw1); \
    VRD(5); SBAR(); GAPA(C1=__builtin_amdgcn_mfma_f32_32x32x16_bf16(kf[3],qr[1],C1,0,0,0),   P0[14],P0[15],P1[0],P1[1],   pw1[2]=PKW(P0,12),pw1[3]=PKW(P0,14), pw1); \
    VRD(2); SBAR(); GAPA(C0=__builtin_amdgcn_mfma_f32_32x32x16_bf16(kf[4],qr[2],C0,0,0,0),   P1[2],P1[3],P1[4],P1[5],     pw2[0]=PKW(P1,0), pw2[1]=PKW(P1,2), pw2); \
    VRD(6); SBAR(); GAPA(C1=__builtin_amdgcn_mfma_f32_32x32x16_bf16(kf[5],qr[2],C1,0,0,0),   P1[6],P1[7],P1[8],P1[9],     pw2[2]=PKW(P1,4), pw2[3]=PKW(P1,6), pw2); \
    VRD(3); SBAR(); GAPA(C0=__builtin_amdgcn_mfma_f32_32x32x16_bf16(kf[6],qr[3],C0,0,0,0),   P1[10],P1[11],P1[12],P1[13], pw3[0]=PKW(P1,8), pw3[1]=PKW(P1,10), pw3); \
    VRD(7); SBAR(); GAPA(C1=__builtin_amdgcn_mfma_f32_32x32x16_bf16(kf[7],qr[3],C1,0,0,0),   P1[14],P1[15],0.f,0.f,       pw3[2]=PKW(P1,12),pw3[3]=PKW(P1,14), pw3); \
    l_reg+=sacc; \
    if(GK){DMA_K((t)+3,sl_cur);} if(GV){DMA_V((t)+1,sl_next);} \
    CMASK(C0,C1,t); \
    { float a=MX3(C0[0],C0[1],C1[0]),b=MX3(C0[2],C0[3],C1[1]); a=MX3(a,C1[2],C1[3]); \
      _Pragma("unroll") for(int r=4;r<16;r+=4){a=MX3(a,C0[r],C0[r+1]);b=MX3(b,C0[r+2],C0[r+3]);a=MX3(a,C1[r],C1[r+1]);b=MX3(b,C1[r+2],C1[r+3]);} \
      float rm=__builtin_fmaxf(a,b); { const PL32 rr=pl32(rm); rm=__builtin_fmaxf(rr.a,rr.b); } \
      resc=false; \
      if(__builtin_expect(__any(rm>(float)THRL),0)){ const float dl=__builtin_fmaxf(rm,0.f); mhat+=dl; \
        _Pragma("unroll") for(int r=0;r<16;++r){C0[r]-=dl;C1[r]-=dl;} \
        _Pragma("unroll") for(int r=0;r<16;++r)negm[r]=-mhat; asm volatile("":"+v"(negm)); \
        const float f=__builtin_amdgcn_exp2f(-dl); l_reg*=f; if(hi==0)wsf[r32]=f; resc=true; } } \
    SBAR(); \
    GAPB(o[0]=__builtin_amdgcn_mfma_f32_32x32x16_bf16(PAF(0),VFR(0),o[0],0,0,0), C0,0); \
    GAPB(o[1]=__builtin_amdgcn_mfma_f32_32x32x16_bf16(PAF(0),VFR(4),o[1],0,0,0), C0,4); \
    KRD(GL,0); GAPB(o[0]=__builtin_amdgcn_mfma_f32_32x32x16_bf16(PAF(1),VFR(1),o[0],0,0,0), C0,8); \
    KRD(GL,1); GAPB(o[1]=__builtin_amdgcn_mfma_f32_32x32x16_bf16(PAF(1),VFR(5),o[1],0,0,0), C0,12); \
    KRD(GL,2); GAPB(o[0]=__builtin_amdgcn_mfma_f32_32x32x16_bf16(PAF(2),VFR(2),o[0],0,0,0), C1,0); \
    KRD(GL,3); GAPB(o[1]=__builtin_amdgcn_mfma_f32_32x32x16_bf16(PAF(2),VFR(6),o[1],0,0,0), C1,4); \
    GAPB(o[0]=__builtin_amdgcn_mfma_f32_32x32x16_bf16(PAF(3),VFR(3),o[0],0,0,0), C1,8); \
    GAPB(o[1]=__builtin_amdgcn_mfma_f32_32x32x16_bf16(PAF(3),VFR(7),o[1],0,0,0), C1,12); \
    }while(0)
  int t=1;
  #undef CMASK
  #define CMASK(P0,P1,t) do{}while(0)
  for(;t+7<NT;t+=2){
    STEP(pB0,pB1,pA0,pA1,t,true,true,true);     WAIT_BAR(2); RESC(); ROT();
    STEP(pA0,pA1,pB0,pB1,t+1,true,true,true);   WAIT_BAR(2); RESC(); ROT();
  }
  #undef CMASK
  #define CMASK(P0,P1,t) do{ if((t)>=cqm2)bmask(P0,P1,(t),cq,qabs,hi,lut);}while(0)
  #define ENDW(tt) do{ if((tt)+3<NT){WAIT_BAR(2);} else if((tt)+2<NT){WAIT_BAR(1);} else {WAIT_BAR(0);} }while(0)
  for(;t+1<NT;t+=2){
    STEP(pB0,pB1,pA0,pA1,t,(t+3<NT),(t+1<NT),(t+1<NT));       ENDW(t);   RESC(); ROT();
    STEP(pA0,pA1,pB0,pB1,t+1,(t+4<NT),(t+2<NT),(t+2<NT));     ENDW(t+1); RESC(); ROT();
  }
  STEP(pB0,pB1,pA0,pA1,NT-1,false,false,false); RESC();
  { float sacc=pB0[0]+pB0[1]; _Pragma("unroll") for(int r=2;r<16;++r)sacc+=pB0[r]; _Pragma("unroll") for(int r=0;r<16;++r)sacc+=pB1[r]; l_reg+=sacc;
    pw0=(u32x4){PKW(pB0,0),PKW(pB0,2),PKW(pB0,4),PKW(pB0,6)};pw1=(u32x4){PKW(pB0,8),PKW(pB0,10),PKW(pB0,12),PKW(pB0,14)};pw2=(u32x4){PKW(pB1,0),PKW(pB1,2),PKW(pB1,4),PKW(pB1,6)};pw3=(u32x4){PKW(pB1,8),PKW(pB1,10),PKW(pB1,12),PKW(pB1,14)};
    SBAR(); pv(o,vb0+sl_cur,PAF(0),PAF(1),PAF(2),PAF(3)); }
  #undef PKW
  #undef PAF
  #undef VFR
  #undef PIN
  #undef MX3
  #undef GAPA
  #undef GAPB
  #undef EX
  #undef VRD
  #undef KRD
  #undef STEP
  #undef ENDW
  {const PL32 rr=pl32(l_reg);l_reg=rr.a+rr.b;}
  if(hi==0)wsf[32+r32]=l_reg;asm volatile("s_waitcnt lgkmcnt(0)":::"memory");
  float rli[16];
  #pragma unroll
  for(int r=0;r<16;++r)rli[r]=__builtin_amdgcn_rcpf(wsf[32+crow(r,hi)]);
  bf16*Ow=O+(rowbase+q0+wid*QBLK)*(long)OPITCH+ocol;
  { bf16*stg=(bf16*)(shm+LDS_OST)+wid*2048;
    #pragma unroll
    for(int r=0;r<16;++r){const int orow=crow(r,hi);
      #pragma unroll
      for(int d0=0;d0<2;++d0)stg[orow*64+d0*32+r32]=__float2bfloat16(o[d0][r]*rli[r]);}
    asm volatile("s_waitcnt lgkmcnt(0)":::"memory");
    #pragma unroll
    for(int i=0;i<4;++i){const int row=i*8+(lane>>3),ch=lane&7; const u32x4 v=*(const u32x4*)(stg+row*64+ch*8); ATTN_STORE16(Ow+(long)row*OPITCH+ch*8,v);} }
  asm volatile("s_waitcnt lgkmcnt(0)\n\ts_barrier":::"memory");
  #undef DMA_K
  #undef DMA_V
  #undef CMASK
  #undef START
  #undef RESC
  #undef ROT
}
typedef __attribute__((address_space(3))) const char* lds_cp;
__device__ __forceinline__ void qkt_half(f32x16&p,lds_cp Kslot,const bf16x8*qr,const f32x16&negm,int r32,int hi,int kh){
  lds_cp kb=Kslot+hi*1024+(r32+32*kh)*16;
  #pragma unroll
  for(int d0=0;d0<4;++d0){ const bf16x8 b=*(const __attribute__((address_space(3))) bf16x8*)(kb+d0*2048);
    if(d0==0)p=__builtin_amdgcn_mfma_f32_32x32x16_bf16(b,qr[0],negm,0,0,0); else p=__builtin_amdgcn_mfma_f32_32x32x16_bf16(b,qr[d0],p,0,0,0);}
}
__device__ __forceinline__ void pv_half(f32x16*o,int vb,bf16x8 pa0,bf16x8 pa1){
  #pragma unroll
  for(int d0=0;d0<2;++d0){s16x4 lo[2],hi[2];
    #pragma unroll
    for(int ks=0;ks<2;++ks){
      asm volatile("ds_read_b64_tr_b16 %0,%1 offset:%c2":"=&v"(lo[ks]):"v"(vb),"i"(d0*4096+ks*1024):"memory");
      asm volatile("ds_read_b64_tr_b16 %0,%1 offset:%c2":"=&v"(hi[ks]):"v"(vb),"i"(d0*4096+ks*1024+512):"memory");}
    asm volatile("s_waitcnt lgkmcnt(0)":::"memory");SBAR();
    #define PK(k) (bf16x8){lo[k][0],lo[k][1],lo[k][2],lo[k][3],hi[k][0],hi[k][1],hi[k][2],hi[k][3]}
    o[d0]=__builtin_amdgcn_mfma_f32_32x32x16_bf16(pa0,PK(0),o[d0],0,0,0);
    o[d0]=__builtin_amdgcn_mfma_f32_32x32x16_bf16(pa1,PK(1),o[d0],0,0,0);
    #undef PK
  }
}
constexpr int F_SLOTV=2*SLOTB, F_LDS_K=0, F_LDS_V=NSLOT*SLOTB, F_LDS_WS=F_LDS_V+NSLOT*F_SLOTV, F_LDS_OST=F_LDS_WS+NW*64*4, F_LDS_BYTES=F_LDS_OST+4*8192;
__device__ __forceinline__ void bmask1(f32x16&p,int t,int cq,int qabs,int hi,int kh,const __attribute__((address_space(3))) float*lut){
  if(t>cq){
    #pragma unroll
    for(int r=0;r<16;++r)p[r]=-INFINITY;
  } else {
    const int d0=64*t+32*kh+4*hi-qabs+128;
    #pragma unroll
    for(int r=0;r<16;++r){int i0=d0+(r&3)+8*(r>>2); i0=i0<0?0:i0; p[r]+=lut[i0];}
  }
}
template<int THRL> __device__ __forceinline__ void attn_unit_f(int qb,int qkcol,int vcol,int ocol,const bf16*Q,const bf16*__restrict__ K,const bf16*__restrict__ V,bf16*O,char*shm,const __attribute__((address_space(3))) float*lut){
  int tid_=threadIdx.x; asm volatile("":"+v"(tid_));
  const int tid=tid_,lane=tid&63,r32=lane&31,hi=lane>>5; const int wid=__builtin_amdgcn_readfirstlane(tid>>6); const int pr=wid&3,kh=wid>>2;
  const int q0=qb*128;
  const bf16*Qw=Q+(long)(q0+pr*QBLK)*DM+qkcol;
  const bf16*Kh=K+qkcol,*Vh=V+vcol;
  const unsigned lds0=(unsigned)(uintptr_t)shm;
  float*wsf=(float*)(shm+F_LDS_WS)+wid*64;
  const bf16*ksrc=Kh+(long)lane*DM+wid*8;
  const bf16*vsrc=Vh+(long)(16*(wid&3)+(lane>>2))*DM+(wid>>2)*32+(lane&3)*8;
  const unsigned kdst=lds0+F_LDS_K+wid*1024, vdst=lds0+F_LDS_V+wid*1024;
  #define DMA_K(t,slot) glds16(ksrc+(long)(t)*KVBLK*DM,(unsigned)__builtin_amdgcn_readfirstlane(kdst+(slot)))
  #define DMA_V(t,slot) do{ glds16(vsrc+(long)(t)*KVBLK*DM,(unsigned)__builtin_amdgcn_readfirstlane(vdst+2*(slot))); glds16(vsrc+(long)(t)*KVBLK*DM+64,(unsigned)__builtin_amdgcn_readfirstlane(vdst+2*(slot)+8192)); }while(0)
  const int vb0=(int)(lds0+F_LDS_V)+((lane>>4)&1)*32+(lane&3)*8+(4*hi+((lane&15)>>2))*64+kh*2048;
  bf16x8 kf[4];
  const lds_cptr shm3=(lds_cptr)shm; const lds_cptr kp0=shm3+F_LDS_K+hi*1024+r32*16+kh*512; const lds_cptr vp0=shm3+F_LDS_V+((lane>>4)&1)*32+(lane&3)*8+(4*hi+((lane&15)>>2))*64+kh*2048;
  const int NT_=(q0+128)/KVBLK; const int NT=NT_<4?4:NT_;
  const int cq=(q0>>6)+(pr>>1), cqm2=cq-2, qabs=q0+pr*QBLK+r32;
  DMA_K(0,0);DMA_V(0,0);DMA_K(1,SLOTB);
  bf16x8 qr[4];
  #pragma unroll
  for(int d0=0;d0<4;++d0)qr[d0]=*reinterpret_cast<const bf16x8*>(&Qw[(long)r32*DM+d0*16+hi*8]);
  float mhat=0.f,l_reg=0.f;f32x16 o[4];o[0]=f32x16{};o[1]=f32x16{};o[2]=f32x16{};o[3]=f32x16{};f32x16 negm=f32x16{};asm volatile("":"+v"(negm));
  #define CMASK(P,t) do{ if((t)>=cqm2)bmask1(P,(t),cq,qabs,hi,kh,lut);}while(0)
  bool resc=false;
  #define RESC() do{ if(resc){ asm volatile("s_waitcnt lgkmcnt(0)":::"memory"); \
      _Pragma("unroll") for(int d_=0;d_<4;++d_) _Pragma("unroll") for(int r=0;r<16;++r)o[d_][r]*=wsf[crow(r,hi)]; } }while(0)
  f32x16 pA,pB;
  int sl_prev=0,sl_cur=0,sl_next=SLOTB;
  #define ROT() do{sl_prev=sl_cur;sl_cur=sl_next;sl_next=(sl_next==(NSLOT-1)*SLOTB)?0:sl_next+SLOTB;}while(0)
  DMA_K(2,2*SLOTB);
  WAIT_BAR(4);
  qkt_half(pA,(lds_cp)(shm3+F_LDS_K),qr,negm,r32,hi,kh);asm volatile("s_nop 15\n\ts_nop 7":"+v"(pA));CMASK(pA,0);
  { float a=max3f(pA[0],pA[1],pA[2]),b=max3f(pA[3],pA[4],pA[5]);a=max3f(a,pA[6],pA[7]);b=max3f(b,pA[8],pA[9]);a=max3f(a,pA[10],pA[11]);b=max3f(b,pA[12],pA[13]);a=max3f(a,pA[14],pA[15]);
    const float m=max2f(a,b); const PL32 rr=pl32(m); const float dl=max2f(rr.a,rr.b); mhat=fadd_s(mhat,dl);
    _Pragma("unroll") for(int r=0;r<16;++r)pA[r]=fsub_s(pA[r],dl);
    _Pragma("unroll") for(int r=0;r<16;++r)negm[r]=-mhat; asm volatile("":"+v"(negm));
    _Pragma("unroll") for(int r=0;r<16;++r)pA[r]=__builtin_amdgcn_exp2f(pA[r]); }
  WAIT_BAR(0);
  DMA_K(3,0);DMA_V(1,SLOTB);
  ROT();
  _Pragma("unroll") for(int j=0;j<4;++j)kf[j]=*(const __attribute__((address_space(3))) bf16x8*)(kp0+sl_cur+j*2048);
  WAIT_BAR(3);
  s16x4 vlo[8],vhi[8]; u32x4 pwa,pwb;
  #define PKW(P,B) cvtpk_s(P[B],P[B+1])
  #define PAFA __builtin_bit_cast(bf16x8,pwa)
  #define PAFB __builtin_bit_cast(bf16x8,pwb)
  #define VFR(i) (bf16x8){vlo[i][0],vlo[i][1],vlo[i][2],vlo[i][3],vhi[i][0],vhi[i][1],vhi[i][2],vhi[i][3]}
  #define PIN(x) asm volatile("":"+v"(x))
  #define MX3(a,b,c) __builtin_fmaxf(__builtin_fmaxf((a),(b)),(c))
  #define GAPA(MF,A0,A1,A2,A3,W0,W1,PW) do{ MF; sacc+=A0; sacc+=A1; sacc+=A2; sacc+=A3; PIN(sacc); W0; W1; PIN(PW); SBAR(); }while(0)
  #define EX(v) __builtin_amdgcn_exp2f(v)
  #define GAPB(MF,X,B) do{ MF; X[B]=EX(X[B]); X[B+1]=EX(X[B+1]); PIN(X); SBAR(); }while(0)
  #define VRD(i) do{ vlo[i]=vtr(vp_+(((i)>>1)*4096+((i)&1)*1024)); vhi[i]=vtr(vp_+(((i)>>1)*4096+((i)&1)*1024+512)); }while(0)
  #define KRD(G,j) do{ if(G){ kf[j]=*(const __attribute__((address_space(3))) bf16x8*)(kp0+sl_next+(j)*2048); SBAR(); } }while(0)
  #define STEPF(C,P,t,GK,GV,GL) do{ SBAR(); \
    const lds_cptr vp_=vp0+2*sl_prev; \
    VRD(0); VRD(2); SBAR(); float sacc=(P[0]+P[1]); \
    GAPA(C=__builtin_amdgcn_mfma_f32_32x32x16_bf16(kf[0],qr[0],negm,0,0,0), P[2],P[3],P[4],P[5],     pwa[0]=PKW(P,0), pwa[1]=PKW(P,2), pwa); \
    VRD(4); VRD(6); SBAR(); GAPA(C=__builtin_amdgcn_mfma_f32_32x32x16_bf16(kf[1],qr[1],C,0,0,0), P[6],P[7],P[8],P[9],     pwa[2]=PKW(P,4), pwa[3]=PKW(P,6), pwa); \
    VRD(1); VRD(3); SBAR(); GAPA(C=__builtin_amdgcn_mfma_f32_32x32x16_bf16(kf[2],qr[2],C,0,0,0), P[10],P[11],P[12],P[13], pwb[0]=PKW(P,8), pwb[1]=PKW(P,10), pwb); \
    VRD(5); VRD(7); SBAR(); GAPA(C=__builtin_amdgcn_mfma_f32_32x32x16_bf16(kf[3],qr[3],C,0,0,0), P[14],P[15],0.f,0.f,     pwb[2]=PKW(P,12),pwb[3]=PKW(P,14), pwb); \
    l_reg+=sacc; \
    if(GK){DMA_K((t)+3,sl_cur);} if(GV){DMA_V((t)+1,sl_next);} \
    CMASK(C,t); \
    { float a=MX3(C[0],C[1],C[2]),b=MX3(C[3],C[4],C[5]); a=MX3(a,C[6],C[7]); b=MX3(b,C[8],C[9]); a=MX3(a,C[10],C[11]); b=MX3(b,C[12],C[13]); a=MX3(a,C[14],C[15]); \
      float rm=__builtin_fmaxf(a,b); { const PL32 rr=pl32(rm); rm=__builtin_fmaxf(rr.a,rr.b); } \
      resc=false; \
      if(__builtin_expect(__any(rm>(float)THRL),0)){ const float dl=__builtin_fmaxf(rm,0.f); mhat+=dl; \
        _Pragma("unroll") for(int r=0;r<16;++r)C[r]-=dl; \
        _Pragma("unroll") for(int r=0;r<16;++r)negm[r]=-mhat; asm volatile("":"+v"(negm)); \
        const float f=__builtin_amdgcn_exp2f(-dl); l_reg*=f; if(hi==0)wsf[r32]=f; resc=true; } } \
    SBAR(); \
    GAPB(o[0]=__builtin_amdgcn_mfma_f32_32x32x16_bf16(PAFA,VFR(0),o[0],0,0,0), C,0); \
    GAPB(o[1]=__builtin_amdgcn_mfma_f32_32x32x16_bf16(PAFA,VFR(2),o[1],0,0,0), C,2); \
    KRD(GL,0); GAPB(o[2]=__builtin_amdgcn_mfma_f32_32x32x16_bf16(PAFA,VFR(4),o[2],0,0,0), C,4); \
    KRD(GL,1); GAPB(o[3]=__builtin_amdgcn_mfma_f32_32x32x16_bf16(PAFA,VFR(6),o[3],0,0,0), C,6); \
    KRD(GL,2); GAPB(o[0]=__builtin_amdgcn_mfma_f32_32x32x16_bf16(PAFB,VFR(1),o[0],0,0,0), C,8); \
    KRD(GL,3); GAPB(o[1]=__builtin_amdgcn_mfma_f32_32x32x16_bf16(PAFB,VFR(3),o[1],0,0,0), C,10); \
    GAPB(o[2]=__builtin_amdgcn_mfma_f32_32x32x16_bf16(PAFB,VFR(5),o[2],0,0,0), C,12); \
    GAPB(o[3]=__builtin_amdgcn_mfma_f32_32x32x16_bf16(PAFB,VFR(7),o[3],0,0,0), C,14); \
    }while(0)
  int t=1;
  #undef CMASK
  #define CMASK(P,t) do{}while(0)
  for(;t+7<NT;t+=2){
    STEPF(pB,pA,t,true,true,true);     WAIT_BAR(3); RESC(); ROT();
    STEPF(pA,pB,t+1,true,true,true);   WAIT_BAR(3); RESC(); ROT();
  }
  #undef CMASK
  #define CMASK(P,t) do{ if((t)>=cqm2)bmask1(P,(t),cq,qabs,hi,kh,lut);}while(0)
  #define ENDW(tt) do{ if((tt)+3<NT){WAIT_BAR(3);} else if((tt)+2<NT){WAIT_BAR(2);} else {WAIT_BAR(0);} }while(0)
  for(;t+1<NT;t+=2){
    STEPF(pB,pA,t,(t+3<NT),(t+1<NT),(t+1<NT));       ENDW(t);   RESC(); ROT();
    STEPF(pA,pB,t+1,(t+4<NT),(t+2<NT),(t+2<NT));     ENDW(t+1); RESC(); ROT();
  }
  STEPF(pB,pA,NT-1,false,false,false); RESC();
  { float sacc=pB[0]+pB[1]; _Pragma("unroll") for(int r=2;r<16;++r)sacc+=pB[r]; l_reg+=sacc;
    pwa=(u32x4){PKW(pB,0),PKW(pB,2),PKW(pB,4),PKW(pB,6)};pwb=(u32x4){PKW(pB,8),PKW(pB,10),PKW(pB,12),PKW(pB,14)};
    SBAR();
    const int vb=vb0+2*sl_cur;
    #pragma unroll
    for(int d0=0;d0<4;++d0){s16x4 lo[2],hi_[2];
      #pragma unroll
      for(int ks=0;ks<2;++ks){
        asm volatile("ds_read_b64_tr_b16 %0,%1 offset:%c2":"=&v"(lo[ks]):"v"(vb),"i"(d0*4096+ks*1024):"memory");
        asm volatile("ds_read_b64_tr_b16 %0,%1 offset:%c2":"=&v"(hi_[ks]):"v"(vb),"i"(d0*4096+ks*1024+512):"memory");}
      asm volatile("s_waitcnt lgkmcnt(0)":::"memory");SBAR();
      #define PK(k) (bf16x8){lo[k][0],lo[k][1],lo[k][2],lo[k][3],hi_[k][0],hi_[k][1],hi_[k][2],hi_[k][3]}
      o[d0]=__builtin_amdgcn_mfma_f32_32x32x16_bf16(PAFA,PK(0),o[d0],0,0,0);
      o[d0]=__builtin_amdgcn_mfma_f32_32x32x16_bf16(PAFB,PK(1),o[d0],0,0,0);
      #undef PK
    } }
  #undef PKW
  #undef PAFA
  #undef PAFB
  #undef VFR
  #undef PIN
  #undef MX3
  #undef GAPA
  #undef GAPB
  #undef EX
  #undef VRD
  #undef KRD
  #undef STEPF
  #undef ENDW
  {const PL32 rr=pl32(l_reg);l_reg=rr.a+rr.b;}
  asm volatile("s_waitcnt lgkmcnt(0)\n\ts_barrier":::"memory");
  float*OG=(float*)shm+pr*4096;
  if(kh==1){ if(hi==0){wsf[r32]=mhat;wsf[32+r32]=l_reg;}
    #pragma unroll
    for(int d_=0;d_<4;++d_)
      #pragma unroll
      for(int r=0;r<16;++r)OG[(d_*16+r)*64+lane]=o[d_][r]; }
  asm volatile("s_waitcnt lgkmcnt(0)\n\ts_barrier":::"memory");
  if(kh==0){ const float*w1=(const float*)(shm+F_LDS_WS)+(wid+4)*64; const float m2=w1[r32],l2=w1[32+r32]; const float M=__builtin_fmaxf(mhat,m2);
    const float f1=__builtin_amdgcn_exp2f(mhat-M),f2=__builtin_amdgcn_exp2f(m2-M); const float inv=__builtin_amdgcn_rcpf(l_reg*f1+l2*f2);
    if(hi==0){wsf[r32]=f1*inv;wsf[32+r32]=f2*inv;}
    asm volatile("s_waitcnt lgkmcnt(0)":::"memory");
    bf16*stg=(bf16*)(shm+F_LDS_OST)+pr*4096;
    #pragma unroll
    for(int r=0;r<16;++r){const int orow=crow(r,hi); const float g1=wsf[orow],g2=wsf[32+orow];
      #pragma unroll
      for(int d_=0;d_<4;++d_)stg[orow*128+d_*32+r32]=__float2bfloat16(o[d_][r]*g1+OG[(d_*16+r)*64+lane]*g2);}
    asm volatile("s_waitcnt lgkmcnt(0)":::"memory");
    bf16*Ow=O+(long)(q0+pr*QBLK)*(long)OPITCH+ocol;
    #pragma unroll
    for(int i=0;i<8;++i){const int row=i*4+(lane>>4),ch=lane&15; const u32x4 v=*(const u32x4*)(stg+row*128+ch*8); ATTN_STORE16(Ow+(long)row*OPITCH+ch*8,v);} }
  asm volatile("s_waitcnt lgkmcnt(0)\n\ts_barrier":::"memory");
  #undef DMA_K
  #undef DMA_V
  #undef CMASK
  #undef RESC
  #undef ROT
}
constexpr int ATTN_LDS_BYTES=LDS_BYTES;
#undef SBAR
#undef WAIT_BAR
}
#define XB_TMO      128
#define XB_XCNT(j)  (256  + 64 * (j))
#define XB_XSUB(j)  (1280 + 64 * (j))
#define XB_XGEN(j)  (2304 + 64 * (j))
#define XB_TOP      3328
#define XB_TOPGEN   3392
#define XCD_BAR_WORDS 3456
#define XB_SPIN_CAP (1u << 18)

__device__ __forceinline__ unsigned xb_ld(unsigned* p)              { return __hip_atomic_load(p, __ATOMIC_RELAXED, __HIP_MEMORY_SCOPE_AGENT); }
__device__ __forceinline__ unsigned xb_add(unsigned* p, unsigned v) { return __hip_atomic_fetch_add(p, v, __ATOMIC_RELAXED, __HIP_MEMORY_SCOPE_AGENT); }
__device__ __forceinline__ unsigned xb_xcc_id() { return (unsigned)__builtin_amdgcn_s_getreg((3 << 11) | 20) & 0xFu; }
#define XB_SPIN(cond, bar) do { unsigned _sp = 0; while (cond) { __builtin_amdgcn_s_sleep(1); \
    if ((++_sp & 255u) == 0u) { if (xb_ld(&(bar)[XB_TMO])) break; if (_sp > XB_SPIN_CAP) { atomicAdd(&(bar)[XB_TMO], 1u); break; } } } } while (0)

struct XcdBarrier {
    unsigned* bar; unsigned x;
    volatile LAS unsigned* st;
};

__device__ __forceinline__ XcdBarrier xcd_barrier_post(unsigned* bar, volatile LAS unsigned* st) {
    XcdBarrier b; b.bar = bar; b.x = xb_xcc_id(); b.st = st;
    if (threadIdx.x == 0) (void)xb_add(&bar[XB_XCNT(b.x)], 1u);
    return b;
}
__device__ __forceinline__ void xcd_barrier_complete(unsigned* bar, unsigned x, unsigned& nloc, unsigned& nx) {
    const unsigned G = gridDim.x * gridDim.y * gridDim.z;
    unsigned sum, cnt, mine, sp = 0u;
    for (;;) {
        sum = 0u; cnt = 0u; mine = 0u;
#pragma unroll
        for (unsigned j = 0; j < 16; ++j) { const unsigned c = xb_ld(&bar[XB_XCNT(j)]); sum += c; cnt += (c > 0u) ? 1u : 0u; mine = (j == x) ? c : mine; }
        if (sum == G) break;
        __builtin_amdgcn_s_sleep(1);
        if ((++sp & 255u) == 0u) { if (xb_ld(&bar[XB_TMO])) break; if (sp > XB_SPIN_CAP) { atomicAdd(&bar[XB_TMO], 1u); break; } }
    }
    nloc = mine > 0u ? mine : 1u; nx = cnt > 0u ? cnt : 1u;
}

__device__ __forceinline__ void xcd_barrier(const XcdBarrier& b) {
    asm volatile("s_waitcnt vmcnt(0)" ::: "memory");
    __syncthreads();
    if (threadIdx.x == 0) {
        unsigned* bar = b.bar;
        __builtin_amdgcn_s_waitcnt(0);
        unsigned nloc = b.st[0], nx = b.st[1];
        if (nloc == 0u) { xcd_barrier_complete(bar, b.x, nloc, nx); b.st[0] = nloc; b.st[1] = nx; }
        const unsigned old = xb_add(&bar[XB_XSUB(b.x)], 1u);
        const unsigned gen = old / nloc;
        if (old + 1u == (gen + 1u) * nloc) {
            __builtin_amdgcn_fence(__ATOMIC_RELEASE, "agent");
            asm volatile("s_waitcnt vmcnt(0)" ::: "memory");
            const unsigned og = xb_add(&bar[XB_TOP], 1u);
            const unsigned tg = og / nx;
            if (og + 1u == (tg + 1u) * nx) xb_add(&bar[XB_TOPGEN], 1u);
            else XB_SPIN(xb_ld(&bar[XB_TOPGEN]) == tg, bar);
            __builtin_amdgcn_fence(__ATOMIC_ACQUIRE, "agent");
            xb_add(&bar[XB_XGEN(b.x)], 1u);
            asm volatile("s_waitcnt vmcnt(0)" ::: "memory");
        } else {
            XB_SPIN(xb_ld(&bar[XB_XGEN(b.x)]) == gen, bar);
            __builtin_amdgcn_fence(__ATOMIC_ACQUIRE, "agent");
            asm volatile("s_waitcnt vmcnt(0)" ::: "memory");
        }
    }
    __syncthreads();
}
struct Args { const float* in[37]; float* out; unsigned char* ws; int ph_lo, ph_hi; };
struct Frame { LAS unsigned char* lds; volatile LAS unsigned* MISC; gu32* ctl; int tid, lane, wave, G, bid; };
typedef __attribute__((address_space(4))) const Args* ArgsP;
__device__ __forceinline__ ArgsP get_args() { ArgsP p = (ArgsP)__builtin_amdgcn_kernarg_segment_ptr(); asm volatile("" : "+s"(p)); return p; }
#define PHASE_ENTRY() ArgsP A = get_args(); { int t_ = threadIdx.x; asm volatile("" : "+v"(t_)); F.tid = t_; F.lane = t_ & 63; F.wave = __builtin_amdgcn_readfirstlane(t_ >> 6); F.ctl = (gu32*)(A->ws + WS_CTL); }
enum InIdx { I_XP = 0, I_XS, I_CP, I_CS, I_CK, I_CV, I_SWKV, I_SSHIFT, I_SCONV, I_WADA, I_BADA, I_GMIX, I_GFFN, I_WIN, I_WOUT, I_MU, I_W0, I_W2, I_A0, I_A2, I_G2, I_KK, I_KA, I_RK, I_LNW, I_LNB,
             I_LQ1, I_LK1, I_LQ2, I_LK2, I_SUBLN, I_REL, I_FUP, I_CONVW, I_CONVB, I_FDN, I_GFIN };

__device__ __forceinline__ void transpose_item(const float* W, int K, int N, bf16* WT, int dest_row0, LAS float* scr, int kb, int n0, int lane) {
    const int k0 = 64 * kb;
    { f32x4 t[8];
#pragma unroll
      for (int i = 0; i < 8; ++i) t[i] = __builtin_nontemporal_load((const GAS f32x4*)(W + (size_t)(k0 + 8 * i + (lane >> 3)) * N + n0 + 4 * (lane & 7)));
#pragma unroll
      for (int i = 0; i < 8; ++i) { LAS float* d = scr + (8 * i + (lane >> 3)) * 33 + 4 * (lane & 7); d[0] = t[i][0]; d[1] = t[i][1]; d[2] = t[i][2]; d[3] = t[i][3]; } }
    LDS_WAIT(); asm volatile("" ::: "memory");
    const int c = lane & 7;
#pragma unroll
    for (int j = 0; j < 4; ++j) { const int n = (lane >> 3) + 8 * j; const LAS float* s = scr + (8 * c) * 33 + n;
        v4u o; o.x = pk2(s[0 * 33], s[1 * 33]); o.y = pk2(s[2 * 33], s[3 * 33]); o.z = pk2(s[4 * 33], s[5 * 33]); o.w = pk2(s[6 * 33], s[7 * 33]);
        *(GAS v4u*)(WT + (size_t)(dest_row0 + n) * K + k0 + 8 * c) = o; }
    LDS_WAIT(); asm volatile("" ::: "memory");
}
__device__ __forceinline__ void ph_prologue(Frame& F) {
    PHASE_ENTRY();
    unsigned char* ws = A->ws;
    if (F.bid < 192) {
        const int l = F.bid / 96, j0 = (F.bid % 96) * 128;
        LAS float* ST = (LAS float*)F.lds;
        const float* Wl = A->in[I_WADA] + (size_t)l * DMOD * MODW;
        float acc[NMODB][2];
#pragma unroll
        for (int b = 0; b < NMODB; ++b) { acc[b][0] = 0.f; acc[b][1] = 0.f; }
        for (int kh = 0; kh < 2; ++kh) {
            __syncthreads();
            for (int idx = F.tid; idx < 1024 * NMODB; idx += NWAVES * 64) { const int kk = idx / NMODB, b = idx % NMODB;
                const float c = (b == 0) ? A->in[I_CP][kh * 1024 + kk] : A->in[I_CS][(size_t)(b - 1) * DMOD + kh * 1024 + kk];
                ST[kk * 20 + b] = c / (1.f + __expf(-c)); }
            __syncthreads();
#pragma unroll 4
            for (int k = 0; k < 128; ++k) { const int kk = F.wave * 128 + k;
                const f32x2 w = __builtin_nontemporal_load((const GAS f32x2*)(Wl + (size_t)(kh * 1024 + kk) * MODW + j0 + 2 * F.lane));
                const LAS f32x4* sp = (const LAS f32x4*)(ST + kk * 20);
                const f32x4 s0 = sp[0], s1 = sp[1], s2 = sp[2], s3 = sp[3]; const float s16 = ST[kk * 20 + 16];
#pragma unroll
                for (int b = 0; b < 4; ++b) { acc[b][0] += s0[b] * w.x; acc[b][1] += s0[b] * w.y; acc[4 + b][0] += s1[b] * w.x; acc[4 + b][1] += s1[b] * w.y;
                    acc[8 + b][0] += s2[b] * w.x; acc[8 + b][1] += s2[b] * w.y; acc[12 + b][0] += s3[b] * w.x; acc[12 + b][1] += s3[b] * w.y; }
                acc[16][0] += s16 * w.x; acc[16][1] += s16 * w.y; }
        }
        __syncthreads();
        LAS float* RED = (LAS float*)F.lds;
#pragma unroll
        for (int b = 0; b < NMODB; ++b) { RED[(F.wave * NMODB + b) * 128 + 2 * F.lane] = acc[b][0]; RED[(F.wave * NMODB + b) * 128 + 2 * F.lane + 1] = acc[b][1]; }
        __syncthreads();
        float* MOD = (float*)(ws + WS_MOD);
        for (int idx = F.tid; idx < NMODB * 128; idx += NWAVES * 64) { const int b = idx >> 7, j = idx & 127; float s = 0.f;
#pragma unroll
            for (int w = 0; w < 8; ++w) s += RED[(w * NMODB + b) * 128 + j];
            MOD[(size_t)(l * NMODB + b) * MODW + j0 + j] = s + A->in[I_BADA][(size_t)l * MODW + j0 + j]; }
        __syncthreads();
    }
    { const int gt = F.bid * (NWAVES * 64) + F.tid, ngt = F.G * NWAVES * 64;
      for (int idx = gt; idx < NLAYER * 56 * 1024; idx += ngt) { const int l = idx / (56 * 1024), rem = idx % (56 * 1024), ch = rem >> 10, j = rem & 1023;
          const float* src; bf16* dst; int k0;
          bf16* LB = (bf16*)(ws + WS_LORA + (size_t)l * LORA_LAYER);
          if (ch < 12) { k0 = 8 * ch; src = A->in[I_W2] + ((size_t)l * 96 + k0) * 1024 + j; dst = LB + (size_t)j * 96 + k0; }
          else if (ch < 24) { k0 = 8 * (ch - 12); src = A->in[I_A2] + ((size_t)l * 96 + k0) * 1024 + j; dst = LB + (size_t)1024 * 96 + (size_t)j * 96 + k0; }
          else { k0 = 8 * (ch - 24); src = A->in[I_G2] + ((size_t)l * 256 + k0) * 1024 + j; dst = LB + (size_t)2 * 1024 * 96 + (size_t)j * 256 + k0; }
          v4u o; o.x = pk2(src[0], src[1024]); o.y = pk2(src[2048], src[3072]); o.z = pk2(src[4096], src[5120]); o.w = pk2(src[6144], src[7168]);
          *(GAS v4u*)dst = o; }
      for (int idx = gt; idx < NLAYER * 64 * DMOD / 8; idx += ngt) { const int l = idx / (64 * DMOD / 8), rem = idx % (64 * DMOD / 8);
          *(GAS v4u*)((bf16*)(ws + WS_WIN) + (size_t)l * NIN_PAD * DMOD + (size_t)NRC * DMOD + (size_t)rem * 8) = (v4u){0u, 0u, 0u, 0u}; }
    }
    __syncthreads();
    LAS float* scr = (LAS float*)(F.lds + F.wave * 16384);
    const int gw = F.bid * NWAVES + F.wave, NGW = F.G * NWAVES;
    constexpr int IT_IN = 32 * (NIN / 32), IT_OUT = 32 * 64, IT_UP = 32 * (NUP / 32), IT_DN = (DFF / 64) * 64, IT_L = IT_IN + IT_OUT + IT_UP + IT_DN;
    for (int it = gw; it < NLAYER * IT_L; it += NGW) {
        const int l = it / IT_L; int r = it % IT_L;
        if (r < IT_IN) { const int nb = r % (NIN / 32), kb = r / (NIN / 32), n0 = 32 * nb;
            transpose_item(A->in[I_WIN] + (size_t)l * DMOD * NIN, DMOD, NIN, (bf16*)(ws + WS_WIN) + (size_t)l * NIN_PAD * DMOD, n0 < NRC ? n0 : n0 + 64, scr, kb, n0, F.lane); continue; }
        r -= IT_IN;
        if (r < IT_OUT) { const int nb = r % 64, kb = r / 64;
            transpose_item(A->in[I_WOUT] + (size_t)l * DMOD * DMOD, DMOD, DMOD, (bf16*)(ws + WS_WOUT) + (size_t)l * DMOD * DMOD, 32 * nb, scr, kb, 32 * nb, F.lane); continue; }
        r -= IT_OUT;
        if (r < IT_UP) { const int nb = r % (NUP / 32), kb = r / (NUP / 32), n0 = 32 * nb; const int j = n0 < DFF ? n0 : n0 - DFF;
            const int dr = (j >> 7) * 256 + (n0 < DFF ? 0 : 128) + (j & 127);
            transpose_item(A->in[I_FUP] + (size_t)l * DMOD * NUP, DMOD, NUP, (bf16*)(ws + WS_WUP) + (size_t)l * NUP * DMOD, dr, scr, kb, n0, F.lane); continue; }
        r -= IT_UP;
        { const int nb = r % 64, kb = r / 64;
            transpose_item(A->in[I_FDN] + (size_t)l * DFF * DMOD, DFF, DMOD, (bf16*)(ws + WS_WDN) + (size_t)l * DMOD * DFF, 32 * nb, scr, kb, 32 * nb, F.lane); }
    }
}

__device__ __forceinline__ void ph_norm(Frame& F, int l, int mode, int nslab) {
    PHASE_ENTRY();
    const int gw = F.bid * NWAVES + F.wave, NGW = F.G * NWAVES;
    const float* X = (const float*)(A->ws + WS_X); bf16* H = (bf16*)(A->ws + WS_H);
    const float* g = (mode == 0 ? A->in[I_GMIX] + (size_t)l * DMOD : mode == 1 ? A->in[I_GFFN] + (size_t)l * DMOD : A->in[I_GFIN]);
    f32x4 gv[8];
#pragma unroll
    for (int j = 0; j < 8; ++j) gv[j] = *(const GAS f32x4*)(g + 4 * F.lane + 256 * j);
    for (int m = gw; m < MT; m += NGW) {
        const float* xr = (mode == 0 && l == 0) ? (m < MP ? A->in[I_XP] + (size_t)m * DMOD : A->in[I_XS] + (size_t)(m - MP) * DMOD) : X + (size_t)m * DMOD;
        f32x4 v[8]; float ss = 0.f;
#pragma unroll
        for (int j = 0; j < 8; ++j) v[j] = *(const GAS f32x4*)(xr + 4 * F.lane + 256 * j);
        f32x4 shv[8], scv[8];
        if (mode < 2) { const int bidx0 = m < MP ? 0 : 1 + ((m - MP) >> 4);
            const float* mod0 = (const float*)(A->ws + WS_MOD) + (size_t)(l * NMODB + bidx0) * MODW + (mode == 0 ? 0 : 3 * DMOD);
#pragma unroll
            for (int j = 0; j < 8; ++j) { shv[j] = *(const GAS f32x4*)(mod0 + 4 * F.lane + 256 * j); scv[j] = *(const GAS f32x4*)(mod0 + DMOD + 4 * F.lane + 256 * j); } }
        if (m >= MP && nslab > 0) { const float* sl = (const float*)(A->ws + WS_SLAB) + (size_t)(m - MP) * DMOD;
            for (int s = 0; s < nslab; ++s)
#pragma unroll
                for (int j = 0; j < 8; ++j) v[j] += *(const GAS f32x4*)(sl + (size_t)s * 256 * DMOD + 4 * F.lane + 256 * j);
            if (mode < 2) { float* xw = (float*)(A->ws + WS_X) + (size_t)m * DMOD;
#pragma unroll
                for (int j = 0; j < 8; ++j) *(GAS f32x4*)(xw + 4 * F.lane + 256 * j) = v[j]; } }
#pragma unroll
        for (int j = 0; j < 8; ++j) ss += (v[j].x * v[j].x + v[j].y * v[j].y) + (v[j].z * v[j].z + v[j].w * v[j].w);
        const float rstd = 1.f / sqrtf(wave_sum(ss) * (1.f / DMOD) + 1e-6f);
        if (mode < 2) {
            const int bidx = m < MP ? 0 : 1 + ((m - MP) >> 4);
            const float* mod = (const float*)(A->ws + WS_MOD) + (size_t)(l * NMODB + bidx) * MODW + (mode == 0 ? 0 : 3 * DMOD);
            GAS unsigned long long* o8 = (GAS unsigned long long*)(H + (size_t)m * DMOD) + F.lane;
#pragma unroll
            for (int j = 0; j < 8; ++j) { const f32x4 sh = shv[j], sc = scv[j];
                const f32x4 y = (v[j] * rstd * gv[j]) * (sc + 1.0f) + sh;
                o8[64 * j] = (unsigned long long)pk2(y.x, y.y) | ((unsigned long long)pk2(y.z, y.w) << 32); }
        } else {
            float* o = (m < MP) ? A->out + O_YP + (size_t)m * DMOD : A->out + O_YS + (size_t)(m - MP) * DMOD;
#pragma unroll
            for (int j = 0; j < 8; ++j) __builtin_nontemporal_store(v[j] * rstd * gv[j], (GAS f32x4*)(o + 4 * F.lane + 256 * j));
        }
    }
}
typedef float f32x4m __attribute__((ext_vector_type(4)));
__device__ __forceinline__ void mm_tiles(f32x4 (&acc)[2], const LAS unsigned char* X, const LAS unsigned char* Y, int wave, int lane) {
    const int mt = wave >> 1, nt0 = 2 * (wave & 1), c = lane & 15, q = lane >> 4;
    const LAS unsigned char* xp = X + (16 * mt + c) * 144 + q * 16;
    const bf16x8 x0 = *(const LAS bf16x8*)xp, x1 = *(const LAS bf16x8*)(xp + 64);
#pragma unroll
    for (int t = 0; t < 2; ++t) { const LAS unsigned char* yp = Y + (16 * (nt0 + t) + c) * 144 + q * 16;
        const bf16x8 y0 = *(const LAS bf16x8*)yp, y1 = *(const LAS bf16x8*)(yp + 64);
        acc[t] = __builtin_amdgcn_mfma_f32_16x16x32_bf16(y0, x0, acc[t], 0, 0, 0);
        acc[t] = __builtin_amdgcn_mfma_f32_16x16x32_bf16(y1, x1, acc[t], 0, 0, 0); }
}
__device__ __forceinline__ void st_tiles(LAS unsigned char* D, const f32x4 (&acc)[2], int wave, int lane) {
    const int mt = wave >> 1, nt0 = 2 * (wave & 1), c = lane & 15, q = lane >> 4;
#pragma unroll
    for (int t = 0; t < 2; ++t) { v2u w; w.x = pk2(acc[t][0], acc[t][1]); w.y = pk2(acc[t][2], acc[t][3]); *(LAS v2u*)(D + (16 * mt + c) * 144 + (16 * (nt0 + t) + 4 * q) * 2) = w; }
}
#define RW_ZERO(a) do { a[0] = (f32x4){0.f, 0.f, 0.f, 0.f}; a[1] = a[0]; } while (0)
template <int MODE> __device__ __forceinline__ void mask_tiles(f32x4 (&acc)[2], int wave, int lane) {
    const int m = 16 * (wave >> 1) + (lane & 15), nb = 32 * (wave & 1) + 4 * (lane >> 4);
#pragma unroll
    for (int t = 0; t < 2; ++t)
#pragma unroll
        for (int i = 0; i < 4; ++i) { const int n = nb + 16 * t + i; const bool keep = MODE == 0 ? (n < m) : MODE == 1 ? (n > m) : (n <= m); if (!keep) acc[t][i] = 0.f; }
}

__device__ __forceinline__ void rwkv_passA_unit(ArgsP A, Frame& F, int l, int u, bool reuse) {
    unsigned char* ws = A->ws;
    const int tid = F.tid, lane = F.lane, wave = F.wave;
    const float* PR = (const float*)(ws + WS_PR);
    int h, row0, nvalid; const float* prev0;
    if (u < 2048) { h = u >> 7; const int c = u & 127; row0 = 64 * c; nvalid = 64; prev0 = c > 0 ? PR + (size_t)(row0 - 1) * NRC_PAD : nullptr; }
    else { const int su = u - 2048, sb = su >> 4; h = su & 15; row0 = MP + sb * TS; nvalid = TS; prev0 = A->in[I_SSHIFT] + (size_t)(l * NSB + sb) * NRC; }
    const float* mu = A->in[I_MU] + (size_t)l * NRC;
    LAS unsigned char* L = F.lds;
#define SL(i) (L + (i) * RW_SLOT)
    LAS unsigned short* TW = (LAS unsigned short*)(L), *XA = (LAS unsigned short*)(L + 13312), *SG = (LAS unsigned short*)(L + 26624);
    LAS float* WLf = (LAS float*)(L + 64512), *ALf = (LAS float*)(L + 81920), *GLf = (LAS float*)(L + 99328);
    LAS float* AT32 = (LAS float*)(L + 92160), *A32 = (LAS float*)(L + 109568), *AKV32 = (LAS float*)(L);
    LAS unsigned char* sAAK = L + 126976, *sARB = L + 136192, *sARK = L + 145408;
    LAS float* SEG = (LAS float*)(L + 154624), *WLV = SEG + 512;
    bf16x8 yg_[8][2];
    { const int nt0 = 2 * (wave & 1), c = lane & 15, q = lane >> 4; const bf16* LB = (const bf16*)(ws + WS_LORA + (size_t)l * LORA_LAYER);
#pragma unroll
      for (int t = 0; t < 2; ++t) { const int j = h * 64 + 16 * (nt0 + t) + c;
#pragma unroll
          for (int s = 0; s < 8; ++s) yg_[s][t] = *(const GAS bf16x8*)(LB + (size_t)2 * 1024 * 96 + (size_t)j * 256 + 8 * q + 32 * s); } }
    { unsigned char* lscr = ws + WS_LSCR + (size_t)F.bid * 61440;
      if (reuse) { v4u tmp[8];
#pragma unroll
          for (int b = 0; b < 8; ++b) { const int i = tid + b * (NWAVES * 64); if (i < 60416 / 16) tmp[b] = *(const GAS v4u*)(lscr + i * 16); }
#pragma unroll
          for (int b = 0; b < 8; ++b) { const int i = tid + b * (NWAVES * 64); if (i < 60416 / 16) *(LAS v4u*)(L + i * 16) = tmp[b]; } }
      else {
        for (int it = 0; it < 56; it += 8) { float cur[8], prv[8], mm_[8];
#pragma unroll
            for (int b = 0; b < 8; ++b) { const int idx = tid + (it + b) * (NWAVES * 64), t = idx / 448, col = 3072 + idx % 448; cur[b] = 0.f; prv[b] = 0.f; mm_[b] = mu[col];
                if (t < nvalid) { cur[b] = PR[(size_t)(row0 + t) * NRC_PAD + col]; prv[b] = t > 0 ? PR[(size_t)(row0 + t - 1) * NRC_PAD + col] : (prev0 ? prev0[col] : 0.f); } }
#pragma unroll
            for (int b = 0; b < 8; ++b) { const int idx = tid + (it + b) * (NWAVES * 64), t = idx / 448, cc = idx % 448; const float xm = cur[b] + (prv[b] - cur[b]) * mm_[b];
                if (cc < 96) { const float e = __expf(2.f * xm); TW[t * 104 + cc] = (unsigned short)f2bf(1.f - 2.f * __builtin_amdgcn_rcpf(e + 1.f)); }
                else if (cc < 192) XA[t * 104 + cc - 96] = (unsigned short)f2bf(xm);
                else SG[t * 264 + cc - 192] = (unsigned short)f2bf(sigmoidf_(xm)); } }
        if (u < 2048) { __syncthreads(); for (int i = tid; i < 60416 / 16; i += NWAVES * 64) *(GAS v4u*)(lscr + i * 16) = *(const LAS v4u*)(L + i * 16); }
      } }
    __syncthreads();
    { const int mt = wave >> 1, nt0 = 2 * (wave & 1), c = lane & 15, q = lane >> 4;
      const bf16* LB = (const bf16*)(ws + WS_LORA + (size_t)l * LORA_LAYER);
      f32x4 aw[2], aa[2], ag[2]; RW_ZERO(aw); RW_ZERO(aa); RW_ZERO(ag);
#pragma unroll
      for (int s = 0; s < 3; ++s) { const bf16x8 xw = *(const LAS bf16x8*)((LAS unsigned char*)TW + (16 * mt + c) * 208 + (8 * q + 32 * s) * 2), xa = *(const LAS bf16x8*)((LAS unsigned char*)XA + (16 * mt + c) * 208 + (8 * q + 32 * s) * 2);
#pragma unroll
          for (int t = 0; t < 2; ++t) { const int j = h * 64 + 16 * (nt0 + t) + c;
              const bf16x8 yw = *(const GAS bf16x8*)(LB + (size_t)j * 96 + 8 * q + 32 * s), ya = *(const GAS bf16x8*)(LB + (size_t)1024 * 96 + (size_t)j * 96 + 8 * q + 32 * s);
              aw[t] = __builtin_amdgcn_mfma_f32_16x16x32_bf16(yw, xw, aw[t], 0, 0, 0); aa[t] = __builtin_amdgcn_mfma_f32_16x16x32_bf16(ya, xa, aa[t], 0, 0, 0); } }
#pragma unroll
      for (int s = 0; s < 8; ++s) { const bf16x8 xg = *(const LAS bf16x8*)((LAS unsigned char*)SG + (16 * mt + c) * 528 + (8 * q + 32 * s) * 2);
#pragma unroll
          for (int t = 0; t < 2; ++t) { const int j = h * 64 + 16 * (nt0 + t) + c; const bf16x8 yg = yg_[s][t];
              ag[t] = __builtin_amdgcn_mfma_f32_16x16x32_bf16(yg, xg, ag[t], 0, 0, 0); } }
#pragma unroll
      for (int t = 0; t < 2; ++t) { const int o = (16 * mt + c) * 68 + 16 * (nt0 + t) + 4 * q; *(LAS f32x4*)(WLf + o) = aw[t]; *(LAS f32x4*)(ALf + o) = aa[t]; *(LAS f32x4*)(GLf + o) = ag[t]; }
    }
    __syncthreads();
    {
        const int j = lane, hj = h * 64 + j, seg = wave;
        const float mu_r = mu[hj], mu_k = mu[1024 + hj], mu_v = mu[2048 + hj];
        const float w0 = A->in[I_W0][l * 1024 + hj], a0 = A->in[I_A0][l * 1024 + hj], kkw = A->in[I_KK][l * 1024 + hj], kaw = A->in[I_KA][l * 1024 + hj], rkw = A->in[I_RK][l * 1024 + hj];
        const float lnw = A->in[I_LNW][l * 1024 + hj], lnb = A->in[I_LNB][l * 1024 + hj];
        float logw[8], xr[8], xv[8], kk[8], bb[8], km[8], cs[8];
        float* G1 = (float*)(ws + WS_G1); float* G2 = (float*)(ws + WS_G2);
        float run = 0.f;
        float cr9[9], ck9[9], cv9[9];
#pragma unroll
        for (int i = 0; i < 9; ++i) { const int t = 8 * seg + i - 1; const float* pr = (t < 0) ? prev0 : (t < nvalid ? PR + (size_t)(row0 + t) * NRC_PAD : nullptr);
            cr9[i] = pr ? pr[hj] : 0.f; ck9[i] = pr ? pr[1024 + hj] : 0.f; cv9[i] = pr ? pr[2048 + hj] : 0.f; }
        asm volatile("" ::: "memory");
#pragma unroll
        for (int i = 0; i < 8; ++i) { const int t = 8 * seg + i; const bool valid = t < nvalid;
            float r_ = 0.f, k_ = 0.f, v_ = 0.f;
            if (valid) { const float cr = cr9[i + 1], ck = ck9[i + 1], cv = cv9[i + 1], qr = cr9[i], qk = ck9[i], qv = cv9[i];
                r_ = cr + (qr - cr) * mu_r; k_ = ck + (qk - ck) * mu_k; v_ = cv + (qv - cv) * mu_v; }
            const float wl = WLf[t * 68 + j], al = ALf[t * 68 + j], gl = GLf[t * 68 + j];
            const float lw = valid ? -0.6065306597126334f * sigmoidf_(w0 + wl) : 0.f;
            const float a_ = sigmoidf_(a0 + al);
            const float kkr = k_ * kkw; const float nrm = wave_sum(kkr * kkr); const float kk_ = kkr * __builtin_amdgcn_rsqf(fmaxf(nrm, 1e-24f));
            const float km_ = k_ * (1.f + (a_ - 1.f) * kaw);
            const float ct = wave_sum(r_ * km_ * rkw);
            if (valid) { const size_t go = (size_t)(row0 + t) * 1024 + hj; G1[go] = lnw * gl; G2[go] = (lnb + ct * v_) * gl; }
            run += lw; logw[i] = lw; cs[i] = run; xr[i] = r_; xv[i] = v_; kk[i] = kk_; bb[i] = kk_ * a_; km[i] = km_; }
        SEG[seg * 64 + j] = run;
        __syncthreads();
        float off = 0.f, tot = 0.f;
#pragma unroll
        for (int s = 0; s < 8; ++s) { const float v = SEG[s * 64 + j]; tot += v; if (s < seg) off += v; }
        if (seg == 0) WLV[j] = __expf(tot);
        LAS unsigned short* AT = (LAS unsigned short*)SL(0), *ATL = (LAS unsigned short*)SL(1), *BH = (LAS unsigned short*)SL(2), *BHL = (LAS unsigned short*)SL(3), *KH = (LAS unsigned short*)SL(4), *RT = (LAS unsigned short*)SL(5);
        unsigned pvt[4], pbt[4], pbl[4], pkt[4];
#pragma unroll
        for (int i = 0; i < 8; i += 2) { float v2[2], bt2[2], bl2[2], kt2[2];
#pragma unroll
            for (int e = 0; e < 2; ++e) { const int ii = i + e, t = 8 * seg + ii; const float ci = off + cs[ii], ce = ci - logw[ii];
                const float winc = __expf(ci), wexc = __expf(ce), winv = __expf(-ci), wrem = __expf(tot - ci);
                const float at = -kk[ii] * wexc, rt = xr[ii] * winc, bh = bb[ii] * winv, kh = km[ii] * winv, bt = bb[ii] * wrem, kt = km[ii] * wrem;
                const unsigned ath = f2bf(at), bhh = f2bf(bh), bth = f2bf(bt);
                AT[t * RW_STRIDE + j] = (unsigned short)ath; ATL[t * RW_STRIDE + j] = (unsigned short)f2bf(at - bf2f((unsigned short)ath)); AT32[t * 68 + j] = at;
                BH[t * RW_STRIDE + j] = (unsigned short)bhh; BHL[t * RW_STRIDE + j] = (unsigned short)f2bf(bh - bf2f((unsigned short)bhh));
                KH[t * RW_STRIDE + j] = (unsigned short)f2bf(kh); RT[t * RW_STRIDE + j] = (unsigned short)f2bf(rt);
                v2[e] = xv[ii]; bt2[e] = bf2f((unsigned short)bth); bl2[e] = bt - bf2f((unsigned short)bth); kt2[e] = kt; }
            pvt[i >> 1] = pk2(v2[0], v2[1]); pbt[i >> 1] = pk2(bt2[0], bt2[1]); pbl[i >> 1] = pk2(bl2[0], bl2[1]); pkt[i >> 1] = pk2(kt2[0], kt2[1]); }
        *(LAS v4u*)(SL(6) + j * 144 + seg * 16) = (v4u){pvt[0], pvt[1], pvt[2], pvt[3]};
        *(LAS v4u*)(SL(7) + j * 144 + seg * 16) = (v4u){pbt[0], pbt[1], pbt[2], pbt[3]};
        *(LAS v4u*)(SL(8) + j * 144 + seg * 16) = (v4u){pbl[0], pbl[1], pbl[2], pbl[3]};
        *(LAS v4u*)(SL(9) + j * 144 + seg * 16) = (v4u){pkt[0], pkt[1], pkt[2], pkt[3]};
    }
    __syncthreads();
    { f32x4 a[2]; const int mt = wave >> 1, nt0 = 2 * (wave & 1), c = lane & 15, q = lane >> 4, m = 16 * mt + c;
      RW_ZERO(a); mm_tiles(a, SL(0), SL(2), wave, lane); mm_tiles(a, SL(1), SL(2), wave, lane); mm_tiles(a, SL(0), SL(3), wave, lane); mask_tiles<0>(a, wave, lane);
#pragma unroll
      for (int t = 0; t < 2; ++t) *(LAS f32x4*)(A32 + m * 68 + 16 * (nt0 + t) + 4 * q) = a[t];
      RW_ZERO(a); mm_tiles(a, SL(0), SL(4), wave, lane); mask_tiles<0>(a, wave, lane); st_tiles(sAAK, a, wave, lane);
      RW_ZERO(a); mm_tiles(a, SL(5), SL(2), wave, lane); mask_tiles<2>(a, wave, lane); st_tiles(sARB, a, wave, lane);
      RW_ZERO(a); mm_tiles(a, SL(5), SL(4), wave, lane); mask_tiles<2>(a, wave, lane); st_tiles(sARK, a, wave, lane); }
    __syncthreads();
    { f32x4 a[2]; const int mt = wave >> 1, nt0 = 2 * (wave & 1), c = lane & 15, q = lane >> 4, m = 16 * mt + c;
      RW_ZERO(a); mm_tiles(a, sAAK, SL(6), wave, lane);
#pragma unroll
      for (int t = 0; t < 2; ++t) *(LAS f32x4*)(AKV32 + m * 68 + 16 * (nt0 + t) + 4 * q) = a[t]; }
    __syncthreads();
    { const int c = lane & 15, q = lane >> 4;
      LAS float* R = (wave < 4) ? AT32 + 16 * wave : AKV32 + 16 * (wave - 4);
      LAS float* Rc = (wave == 0 ? AT32 : AKV32) + lane;
#pragma unroll
      for (int i = 0; i < 4; ++i) {
          if (i > 0) {
              f32x4 acc;
#pragma unroll
              for (int g = 0; g < 4; ++g) acc[g] = R[(16 * i + 4 * q + g) * 68 + c];
#pragma unroll
              for (int j = 0; j < i; ++j)
#pragma unroll
                  for (int s = 0; s < 4; ++s) { const float a = A32[(16 * i + c) * 68 + 16 * j + 4 * s + q], b = R[(16 * j + 4 * s + q) * 68 + c];
                      acc = __builtin_amdgcn_mfma_f32_16x16x4f32(a, b, acc, 0, 0, 0); }
#pragma unroll
              for (int g = 0; g < 4; ++g) R[(16 * i + 4 * q + g) * 68 + c] = acc[g];
              __syncthreads();
          }
          if (wave < 2) {
              const LAS float* a32 = A32 + (16 * i) * 68 + 16 * i; asm volatile("" : "+v"(a32));
              float x[16];
#pragma unroll
              for (int rr = 0; rr < 16; ++rr) x[rr] = Rc[(16 * i + rr) * 68];
#pragma unroll
              for (int rg = 0; rg < 4; ++rg) {
                  f32x4 cf[4][4];
#pragma unroll
                  for (int r4 = 0; r4 < 4; ++r4)
#pragma unroll
                      for (int g = 0; g <= rg; ++g) if (4 * g < 4 * rg + r4) cf[r4][g] = *(const LAS f32x4*)(a32 + (4 * rg + r4) * 68 + 4 * g);
#pragma unroll
                  for (int r4 = 0; r4 < 4; ++r4) { const int rr = 4 * rg + r4; if (rr == 0) continue; float s0 = x[rr], s1 = 0.f;
#pragma unroll
                      for (int g = 0; g <= rg; ++g) if (4 * g < rr) { s0 += cf[r4][g][0] * x[4 * g]; if (4 * g + 1 < rr) s1 += cf[r4][g][1] * x[4 * g + 1]; if (4 * g + 2 < rr) s0 += cf[r4][g][2] * x[4 * g + 2]; if (4 * g + 3 < rr) s1 += cf[r4][g][3] * x[4 * g + 3]; }
                      x[rr] = s0 + s1; }
                  asm volatile("" ::: "memory");
              }
#pragma unroll
              for (int rr = 1; rr < 16; ++rr) Rc[(16 * i + rr) * 68] = x[rr];
          }
          __syncthreads();
      }
      { const int cc = tid & 127, g16 = tid >> 7; const LAS float* src = (cc < 64 ? AT32 + cc : AKV32 + (cc - 64)) + (16 * g16) * 68;
        unsigned hh[16]; float lo[16];
#pragma unroll
        for (int rr = 0; rr < 16; ++rr) { const float v = src[rr * 68]; hh[rr] = f2bf(v); lo[rr] = v - bf2f((unsigned short)hh[rr]); }
        LAS unsigned char* dh = (cc < 64 ? SL(2) + cc * 144 : SL(4) + (cc - 64) * 144) + g16 * 32;
        *(LAS v4u*)dh = (v4u){hh[0] | (hh[1] << 16), hh[2] | (hh[3] << 16), hh[4] | (hh[5] << 16), hh[6] | (hh[7] << 16)};
        *(LAS v4u*)(dh + 16) = (v4u){hh[8] | (hh[9] << 16), hh[10] | (hh[11] << 16), hh[12] | (hh[13] << 16), hh[14] | (hh[15] << 16)};
        if (cc < 64) { LAS unsigned char* dl = SL(3) + cc * 144 + g16 * 32;
            *(LAS v4u*)dl = (v4u){pk2(lo[0], lo[1]), pk2(lo[2], lo[3]), pk2(lo[4], lo[5]), pk2(lo[6], lo[7])};
            *(LAS v4u*)(dl + 16) = (v4u){pk2(lo[8], lo[9]), pk2(lo[10], lo[11]), pk2(lo[12], lo[13]), pk2(lo[14], lo[15])}; } }
    }
    __syncthreads();
    { const int mt = wave >> 1, nt0 = 2 * (wave & 1), c = lane & 15, q = lane >> 4, m = 16 * mt + c;
      float* PTg = (float*)(ws + WS_PT32) + (size_t)u * 4096; float* QQg = (float*)(ws + WS_QQ) + (size_t)u * 4096; bf16* RPg = (bf16*)(ws + WS_RP) + (size_t)u * 4096; float* YVg = (float*)(ws + WS_YV) + (size_t)u * 4096;
      f32x4 a[2];
      RW_ZERO(a); mm_tiles(a, sARB, SL(2), wave, lane); mm_tiles(a, sARB, SL(3), wave, lane);
#pragma unroll
      for (int t = 0; t < 2; ++t) { const int n = 16 * (nt0 + t) + 4 * q; const v2u rr = *(const LAS v2u*)(SL(5) + m * 144 + n * 2);
          v2u w; w.x = pk2(a[t][0] + bf2f((unsigned short)(rr.x & 0xffffu)), a[t][1] + bf2f((unsigned short)(rr.x >> 16))); w.y = pk2(a[t][2] + bf2f((unsigned short)(rr.y & 0xffffu)), a[t][3] + bf2f((unsigned short)(rr.y >> 16)));
          *(GAS v2u*)(RPg + m * 64 + n) = w; }
      RW_ZERO(a); mm_tiles(a, sARB, SL(4), wave, lane); mm_tiles(a, sARK, SL(6), wave, lane);
#pragma unroll
      for (int t = 0; t < 2; ++t) *(GAS f32x4*)(YVg + m * 64 + 16 * (nt0 + t) + 4 * q) = a[t];
      if (tid < 64) ((float*)(ws + WS_WL))[(size_t)u * 64 + tid] = WLV[tid];
      RW_ZERO(a); mm_tiles(a, SL(7), SL(2), wave, lane); mm_tiles(a, SL(8), SL(2), wave, lane); mm_tiles(a, SL(7), SL(3), wave, lane);
#pragma unroll
      for (int t = 0; t < 2; ++t) *(GAS f32x4*)(PTg + m * 64 + 16 * (nt0 + t) + 4 * q) = a[t];
      RW_ZERO(a); mm_tiles(a, SL(4), SL(7), wave, lane); mm_tiles(a, SL(6), SL(9), wave, lane);
#pragma unroll
      for (int t = 0; t < 2; ++t) *(GAS f32x4*)(QQg + m * 64 + 16 * (nt0 + t) + 4 * q) = a[t];
    }
    __syncthreads();
#undef SL
}
__device__ __forceinline__ void wait_count(Frame& F, unsigned* cnt, unsigned target) {
    if (F.tid == 0) { unsigned* bar = (unsigned*)(F.ctl + CW_BAR);
        XB_SPIN(xb_ld(cnt) < target, bar);
        __builtin_amdgcn_fence(__ATOMIC_ACQUIRE, "agent"); asm volatile("s_waitcnt vmcnt(0)" ::: "memory"); }
    __syncthreads();
}
__device__ __forceinline__ void ph_rwkv_passA(Frame& F, int l) {
    PHASE_ENTRY();
    if (F.G == 256) wait_count(F, (unsigned*)(F.ctl + CW_QUEUE + 1024 + 64 * l), (unsigned)((MT / 256) * (NRC_PAD / 256)));
    int pu = -1;
    int u0 = F.bid, ustep = F.G, uend = RW_UNITS;
    if (F.G == 256) {
        const int r = F.bid & 127, sec = F.bid >> 7, nf = (r < (MT / 256) * (NIN_PAD / 256) - 768) ? 8 : 9;
        u0 = r + 128 * (sec ? nf : 0); ustep = 128; uend = r + 128 * (sec ? 18 : nf); }
    for (int u = u0; u < uend; u += ustep) { const bool reuse = (pu >= 0 && u < 2048 && (u & 127) == (pu & 127)); rwkv_passA_unit(A, F, l, u, reuse); pu = u; }
}

struct ChainOps { f32x4 pt[4]; f32x4 qq[2]; f32x4 wl; };
__device__ __forceinline__ void rwkv_chain_load(ChainOps& o, const float* PTg, const float* QQg, const float* WLg, int wave, int lane) {
    const int tk = wave & 3, tv0 = 2 * (wave >> 2), c = lane & 15, q = lane >> 4;
#pragma unroll
    for (int s = 0; s < 2; ++s) { o.pt[2 * s] = *(const GAS f32x4*)(PTg + (16 * tk + c) * 64 + 8 * q + 32 * s); o.pt[2 * s + 1] = *(const GAS f32x4*)(PTg + (16 * tk + c) * 64 + 8 * q + 32 * s + 4); }
#pragma unroll
    for (int t = 0; t < 2; ++t) o.qq[t] = *(const GAS f32x4*)(QQg + (16 * (tv0 + t) + c) * 64 + 16 * tk + 4 * q);
    o.wl = *(const GAS f32x4*)(WLg + 16 * tk + 4 * q);
}
__device__ __forceinline__ void rwkv_chain_step(f32x4 (&acc)[2], const ChainOps& o, const LAS unsigned char* Shi, const LAS unsigned char* Slo, int wave, int lane) {
    const int tv0 = 2 * (wave >> 2), c = lane & 15, q = lane >> 4;
    bf16x8 ph[2], pl[2];
#pragma unroll
    for (int s = 0; s < 2; ++s) { const f32x4 x0 = o.pt[2 * s], x1 = o.pt[2 * s + 1];
        unsigned h[8]; float lo[8];
#pragma unroll
        for (int i = 0; i < 4; ++i) { h[i] = f2bf(x0[i]); lo[i] = x0[i] - bf2f((unsigned short)h[i]); h[4 + i] = f2bf(x1[i]); lo[4 + i] = x1[i] - bf2f((unsigned short)h[4 + i]); }
        ph[s] = __builtin_bit_cast(bf16x8, (v4u){h[0] | (h[1] << 16), h[2] | (h[3] << 16), h[4] | (h[5] << 16), h[6] | (h[7] << 16)});
        pl[s] = __builtin_bit_cast(bf16x8, (v4u){pk2(lo[0], lo[1]), pk2(lo[2], lo[3]), pk2(lo[4], lo[5]), pk2(lo[6], lo[7])}); }
#pragma unroll
    for (int t = 0; t < 2; ++t) { const int v = 16 * (tv0 + t) + c;
        f32x4 a = o.qq[t] + acc[t] * o.wl;
        const bf16x8 s0 = *(const LAS bf16x8*)(Shi + v * 144 + q * 16), s1 = *(const LAS bf16x8*)(Shi + v * 144 + q * 16 + 64);
        const bf16x8 l0 = *(const LAS bf16x8*)(Slo + v * 144 + q * 16), l1 = *(const LAS bf16x8*)(Slo + v * 144 + q * 16 + 64);
        a = __builtin_amdgcn_mfma_f32_16x16x32_bf16(ph[0], s0, a, 0, 0, 0); a = __builtin_amdgcn_mfma_f32_16x16x32_bf16(ph[1], s1, a, 0, 0, 0);
        a = __builtin_amdgcn_mfma_f32_16x16x32_bf16(ph[0], l0, a, 0, 0, 0); a = __builtin_amdgcn_mfma_f32_16x16x32_bf16(ph[1], l1, a, 0, 0, 0);
        a = __builtin_amdgcn_mfma_f32_16x16x32_bf16(pl[0], s0, a, 0, 0, 0); a = __builtin_amdgcn_mfma_f32_16x16x32_bf16(pl[1], s1, a, 0, 0, 0);
        acc[t] = a; }
}
__device__ __forceinline__ void rwkv_state_to_lds(const f32x4 (&acc)[2], LAS unsigned char* Shi, LAS unsigned char* Slo, int wave, int lane) {
    const int tk = wave & 3, tv0 = 2 * (wave >> 2), c = lane & 15, q = lane >> 4;
#pragma unroll
    for (int t = 0; t < 2; ++t) { unsigned h[4]; float lo[4];
#pragma unroll
        for (int i = 0; i < 4; ++i) { h[i] = f2bf(acc[t][i]); lo[i] = acc[t][i] - bf2f((unsigned short)h[i]); }
        const int o = (16 * (tv0 + t) + c) * 144 + (16 * tk + 4 * q) * 2;
        *(LAS v2u*)(Shi + o) = (v2u){h[0] | (h[1] << 16), h[2] | (h[3] << 16)}; *(LAS v2u*)(Slo + o) = (v2u){pk2(lo[0], lo[1]), pk2(lo[2], lo[3])}; }
}
__device__ __forceinline__ void ph_rwkv_chain(Frame& F, int l) {
    PHASE_ENTRY();
    unsigned char* ws = A->ws; const int tid = F.tid, lane = F.lane, wave = F.wave;
    const int tk = wave & 3, tv0 = 2 * (wave >> 2), c = lane & 15, q = lane >> 4;
    LAS unsigned char* HI0 = F.lds, *LO0 = F.lds + RW_SLOT, *HI1 = F.lds + 2 * RW_SLOT, *LO1 = F.lds + 3 * RW_SLOT;
    const float* PT = (const float*)(ws + WS_PT32); const float* QQ = (const float*)(ws + WS_QQ); const float* WL = (const float*)(ws + WS_WL); bf16* SC = (bf16*)(ws + WS_SC);
    if (F.bid < 16) {
        const int h = F.bid;
        f32x4 acc[2]; RW_ZERO(acc);
        rwkv_state_to_lds(acc, HI0, LO0, wave, lane);
        __syncthreads();
        ChainOps ops; rwkv_chain_load(ops, PT + (size_t)(h * 128) * 4096, QQ + (size_t)(h * 128) * 4096, WL + (size_t)(h * 128) * 64, wave, lane);
        for (int cc = 0; cc < 128; ++cc) { const int u = h * 128 + cc; LAS unsigned char* chi = (cc & 1) ? HI1 : HI0, *clo = (cc & 1) ? LO1 : LO0, *nhi = (cc & 1) ? HI0 : HI1, *nlo = (cc & 1) ? LO0 : LO1;
            { const int row = tid >> 3, ch = tid & 7; *(GAS v4u*)((unsigned char*)(SC + (size_t)u * 4096) + tid * 16) = *(const LAS v4u*)(chi + row * 144 + ch * 16); }
            const ChainOps cur = ops;
            if (cc + 1 < 128) rwkv_chain_load(ops, PT + (size_t)(u + 1) * 4096, QQ + (size_t)(u + 1) * 4096, WL + (size_t)(u + 1) * 64, wave, lane);
            rwkv_chain_step(acc, cur, chi, clo, wave, lane);
            rwkv_state_to_lds(acc, nhi, nlo, wave, lane);
            __syncthreads(); }
#ifndef PROBE_SEQ
        float* wo = A->out + O_WP + (size_t)(l * 16 + h) * 4096;
#else
        float* wo = (float*)(A->ws + WS_HALO) + (size_t)h * 4096;
#endif
#pragma unroll
        for (int t = 0; t < 2; ++t) *(GAS f32x4*)(wo + (16 * (tv0 + t) + c) * 64 + 16 * tk + 4 * q) = acc[t];
    } else {
        for (int su = F.bid - 16; su < NSB * 16; su += F.G - 16) { const int u = 2048 + su, sb = su >> 4, h = su & 15;
            const float* S0 = A->in[I_SWKV] + (size_t)((l * NSB + sb) * 16 + h) * 4096;
            f32x4 acc[2];
#pragma unroll
            for (int t = 0; t < 2; ++t) acc[t] = *(const GAS f32x4*)(S0 + (16 * (tv0 + t) + c) * 64 + 16 * tk + 4 * q);
            rwkv_state_to_lds(acc, HI0, LO0, wave, lane);
            __syncthreads();
            { const int row = tid >> 3, ch = tid & 7; *(GAS v4u*)((unsigned char*)(SC + (size_t)u * 4096) + tid * 16) = *(const LAS v4u*)(HI0 + row * 144 + ch * 16); }
            { ChainOps o1; rwkv_chain_load(o1, PT + (size_t)u * 4096, QQ + (size_t)u * 4096, WL + (size_t)u * 64, wave, lane); rwkv_chain_step(acc, o1, HI0, LO0, wave, lane); }
            float* wo = A->out + O_WS + (size_t)((l * NSB + sb) * 16 + h) * 4096;
#pragma unroll
            for (int t = 0; t < 2; ++t) *(GAS f32x4*)(wo + (16 * (tv0 + t) + c) * 64 + 16 * tk + 4 * q) = acc[t];
            __syncthreads(); }
    }
}
__device__ __forceinline__ void ph_rwkv_passC(Frame& F, int l) {
    PHASE_ENTRY();
    unsigned char* ws = A->ws; const int lane = F.lane, wave = F.wave, c = lane & 15, q = lane >> 4, mt = wave & 3;
    const bf16* RP = (const bf16*)(ws + WS_RP); const float* YV = (const float*)(ws + WS_YV); const bf16* SC = (const bf16*)(ws + WS_SC);
    const float* G1 = (const float*)(ws + WS_G1); const float* G2 = (const float*)(ws + WS_G2); bf16* YC = (bf16*)(ws + WS_YCAT);
    bf16x8 rA[2], rB[2], sA[8], sB[8]; f32x4 yA[4], yB[4], gA[8], gB[8];
    auto geo = [&](int u, int& h, int& row0, bool& skip) { const bool samp = u >= 2048;
        if (!samp) { h = u >> 7; row0 = 64 * (u & 127); } else { const int su = u - 2048; h = su & 15; row0 = MP + (su >> 4) * TS; }
        skip = samp && mt > 0; };
    auto load = [&](int u, bf16x8 (&r)[2], bf16x8 (&sv)[8], f32x4 (&y)[4], f32x4 (&g)[8]) { int h, row0; bool skip; geo(u, h, row0, skip); if (skip) return;
        const bf16* RPu = RP + (size_t)u * 4096; const float* YVu = YV + (size_t)u * 4096; const bf16* SCu = SC + (size_t)u * 4096; const int t = 16 * mt + c; const size_t ro = (size_t)(row0 + t);
        r[0] = *(const GAS bf16x8*)(RPu + t * 64 + 8 * q); r[1] = *(const GAS bf16x8*)(RPu + t * 64 + 8 * q + 32);
#pragma unroll
        for (int nt = 0; nt < 4; ++nt) { const int v = h * 64 + 16 * nt + 4 * q; y[nt] = *(const GAS f32x4*)(YVu + t * 64 + 16 * nt + 4 * q);
            sv[2 * nt] = *(const GAS bf16x8*)(SCu + (16 * nt + c) * 64 + 8 * q); sv[2 * nt + 1] = *(const GAS bf16x8*)(SCu + (16 * nt + c) * 64 + 8 * q + 32);
            g[nt] = *(const GAS f32x4*)(G1 + ro * 1024 + v); g[4 + nt] = *(const GAS f32x4*)(G2 + ro * 1024 + v); } };
    auto compute = [&](int u, const bf16x8 (&r)[2], const bf16x8 (&sv)[8], f32x4 (&y)[4], const f32x4 (&g)[8]) { int h, row0; bool skip; geo(u, h, row0, skip); if (skip) return;
        const int t = 16 * mt + c; const size_t ro = (size_t)(row0 + t); float s1 = 0.f;
#pragma unroll
        for (int nt = 0; nt < 4; ++nt) { y[nt] = __builtin_amdgcn_mfma_f32_16x16x32_bf16(sv[2 * nt], r[0], y[nt], 0, 0, 0); y[nt] = __builtin_amdgcn_mfma_f32_16x16x32_bf16(sv[2 * nt + 1], r[1], y[nt], 0, 0, 0);
            s1 += (y[nt][0] + y[nt][1]) + (y[nt][2] + y[nt][3]); }
        s1 += swz_xor<16>(s1); s1 += xor32(s1);
        const float mean = s1 * (1.f / 64.f); float s2 = 0.f;
#pragma unroll
        for (int nt = 0; nt < 4; ++nt) { y[nt] = y[nt] - mean; s2 += (y[nt][0] * y[nt][0] + y[nt][1] * y[nt][1]) + (y[nt][2] * y[nt][2] + y[nt][3] * y[nt][3]); }
        s2 += swz_xor<16>(s2); s2 += xor32(s2);
        const float rstd = __builtin_amdgcn_rsqf(s2 * (1.f / 64.f) + 64e-5f);
#pragma unroll
        for (int nt = 0; nt < 4; ++nt) { const int v = h * 64 + 16 * nt + 4 * q;
            const f32x4 o = y[nt] * rstd * g[nt] + g[4 + nt]; v2u w; w.x = pk2(o[0], o[1]); w.y = pk2(o[2], o[3]); *(GAS v2u*)(YC + ro * DMOD + v) = w; } };
    const int u0 = 2 * F.bid + (wave >> 2), us = 2 * F.G;
    if (u0 < RW_UNITS) load(u0, rA, sA, yA, gA);
    for (int u = u0; u < RW_UNITS; u += 2 * us) {
        if (u + us < RW_UNITS) load(u + us, rB, sB, yB, gB);
        compute(u, rA, sA, yA, gA);
        if (u + us < RW_UNITS) { if (u + 2 * us < RW_UNITS) load(u + 2 * us, rA, sA, yA, gA); compute(u + us, rB, sB, yB, gB); }
    }
}
__device__ __forceinline__ void attn_sample_unit(ArgsP A, Frame& F, int l, int sb, int h) {
    unsigned char* ws = A->ws; const int tid = F.tid, lane = F.lane, wave = F.wave;
    LAS float* QS = (LAS float*)F.lds;
    LAS float* LUT = QS + 2048;
    LAS float* PB = QS + 4096 + wave * 1024;
    LAS float* MLW = QS + 4096 + 8192;
    LAS float* OACC = MLW + 128;
    LAS float* LACC = OACC + 4096;
    const bf16* QB = (const bf16*)(ws + WS_QB); const bf16* KB = (const bf16*)(ws + WS_KB); const bf16* VB = (const bf16*)(ws + WS_VB);
    const float* reltab = A->in[I_REL];
    for (int i = tid; i < 2048; i += NWAVES * 64) { const int t = i >> 7, d = i & 127; QS[i] = bf2f(QB[(size_t)(MP + sb * TS + t) * 1024 + h * 128 + d]); }
    if (tid < 192) { const int rel = tid - 128; const int n = rel < 0 ? -rel : rel;
        const int lg = n < 12 ? 8 : n < 16 ? 9 : n < 23 ? 10 : n < 32 ? 11 : n < 46 ? 12 : n < 64 ? 13 : n < 91 ? 14 : 15;
        const int bucket = (rel > 0 ? 16 : 0) + (n < 8 ? n : lg);
        LUT[tid] = (reltab[bucket * 8 + h] - reltab[15 * 8 + h]) * 1.4426950408889634f; }
    for (int i = tid; i < 4096 + 32; i += NWAVES * 64) OACC[i] = 0.f;
    __syncthreads();
    const int map = wave & 1, kg = wave >> 1;
    float mrun[16], lrun[16], o[16][2];
#pragma unroll
    for (int t = 0; t < 16; ++t) { mrun[t] = -INFINITY; lrun[t] = 0.f; o[t][0] = 0.f; o[t][1] = 0.f; }
    const float* CK = A->in[I_CK] + (size_t)(l * NSB + sb) * PAST * 1024; const float* CV = A->in[I_CV] + (size_t)(l * NSB + sb) * PAST * 1024;
    for (int kb = kg; kb < 33; kb += 4) {
        const int pos = 64 * kb + lane; const bool kvalid = pos < PAST + TS;
        float s[16];
#pragma unroll
        for (int t = 0; t < 16; ++t) s[t] = 0.f;
        if (kb < 32) { const float* kp = CK + (size_t)pos * 1024 + h * 128 + map * 64;
#pragma unroll 4
            for (int d = 0; d < 64; d += 4) { const f32x4 kv = *(const GAS f32x4*)(kp + d);
#pragma unroll
                for (int t = 0; t < 16; ++t) { const f32x4 qv = *(const LAS f32x4*)(QS + t * 128 + map * 64 + d); s[t] += (kv[0] * qv[0] + kv[1] * qv[1]) + (kv[2] * qv[2] + kv[3] * qv[3]); } }
        } else { const int rr = MP + sb * TS + (lane & 15); const bf16* kp = KB + (size_t)rr * 1024 + h * 128 + map * 64;
#pragma unroll 4
            for (int d = 0; d < 64; d += 4) { const v2u kw = *(const GAS v2u*)(kp + d);
                const f32x4 kv = (f32x4){bf2f((unsigned short)(kw.x & 0xffffu)), bf2f((unsigned short)(kw.x >> 16)), bf2f((unsigned short)(kw.y & 0xffffu)), bf2f((unsigned short)(kw.y >> 16))};
#pragma unroll
                for (int t = 0; t < 16; ++t) { const f32x4 qv = *(const LAS f32x4*)(QS + t * 128 + map * 64 + d); s[t] += (kv[0] * qv[0] + kv[1] * qv[1]) + (kv[2] * qv[2] + kv[3] * qv[3]); } }
        }
        float al[16];
#pragma unroll
        for (int t = 0; t < 16; ++t) { int idx = pos - (PAST + t) + 128; idx = idx < 0 ? 0 : idx; idx = idx > 191 ? 191 : idx;
            float sv = kvalid ? s[t] + LUT[idx] : -INFINITY;
            const float bm = wave_max(sv);
            const float mn = fmaxf(mrun[t], bm); al[t] = __builtin_amdgcn_exp2f(mrun[t] - mn); mrun[t] = mn;
            const float p = __builtin_amdgcn_exp2f(sv - mn); PB[lane * 16 + t] = p;
            lrun[t] = lrun[t] * al[t] + wave_sum(p);
            o[t][0] *= al[t]; o[t][1] *= al[t]; }
        LDS_WAIT(); asm volatile("" ::: "memory");
        const int nk = (kb < 32) ? 64 : TS;
        for (int k0 = 0; k0 < nk; k0 += 4) { f32x2 vv[4];
            if (kb < 32) {
#pragma unroll
                for (int b = 0; b < 4; ++b) vv[b] = *(const GAS f32x2*)(CV + (size_t)(64 * kb + k0 + b) * 1024 + h * 128 + 2 * lane);
            } else {
#pragma unroll
                for (int b = 0; b < 4; ++b) { const unsigned w = *(const GAS unsigned*)(VB + (size_t)(MP + sb * TS + k0 + b) * 1024 + h * 128 + 2 * lane); vv[b].x = bf2f((unsigned short)(w & 0xffffu)); vv[b].y = bf2f((unsigned short)(w >> 16)); }
            }
#pragma unroll
            for (int b = 0; b < 4; ++b) { const LAS f32x4* pp = (const LAS f32x4*)(PB + (k0 + b) * 16);
                const f32x4 p0 = pp[0], p1 = pp[1], p2 = pp[2], p3 = pp[3];
#pragma unroll
                for (int t = 0; t < 4; ++t) { o[t][0] += p0[t] * vv[b].x; o[t][1] += p0[t] * vv[b].y; o[4 + t][0] += p1[t] * vv[b].x; o[4 + t][1] += p1[t] * vv[b].y;
                    o[8 + t][0] += p2[t] * vv[b].x; o[8 + t][1] += p2[t] * vv[b].y; o[12 + t][0] += p3[t] * vv[b].x; o[12 + t][1] += p3[t] * vv[b].y; }
                asm volatile("" ::: "memory"); } }
        LDS_WAIT(); asm volatile("" ::: "memory");
    }
    if (lane < 16) { float mv = mrun[0];
#pragma unroll
        for (int t = 1; t < 16; ++t) mv = (lane == t) ? mrun[t] : mv;
        MLW[wave * 16 + lane] = mv; }
    __syncthreads();
#pragma unroll
    for (int t = 0; t < 16; ++t) { float M = fmaxf(fmaxf(MLW[(map) * 16 + t], MLW[(2 + map) * 16 + t]), fmaxf(MLW[(4 + map) * 16 + t], MLW[(6 + map) * 16 + t]));
        const float sc = __builtin_amdgcn_exp2f(mrun[t] - M);
        __hip_atomic_fetch_add(OACC + (t * 2 + map) * 128 + 2 * lane, o[t][0] * sc, __ATOMIC_RELAXED, __HIP_MEMORY_SCOPE_WORKGROUP); __hip_atomic_fetch_add(OACC + (t * 2 + map) * 128 + 2 * lane + 1, o[t][1] * sc, __ATOMIC_RELAXED, __HIP_MEMORY_SCOPE_WORKGROUP);
        if (lane == 0) __hip_atomic_fetch_add(LACC + map * 16 + t, lrun[t] * sc, __ATOMIC_RELAXED, __HIP_MEMORY_SCOPE_WORKGROUP); }
    __syncthreads();
    float* OA = (float*)(ws + WS_OATT);
    for (int i = tid; i < 4096; i += NWAVES * 64) { const int t = i >> 8, mp = (i >> 7) & 1, e = i & 127;
        OA[(size_t)(MP + sb * TS + t) * DMOD + h * 256 + mp * 128 + e] = OACC[i] / LACC[mp * 16 + t]; }
    __syncthreads();
}


__device__ __forceinline__ void attn_sample_unit2(ArgsP A, Frame& F, int l, int sb, int h) {
    using attn_body::f32x16;
    unsigned char* ws = A->ws; int tid_ = F.tid; asm volatile("" : "+v"(tid_));
    const int tid = tid_, lane = tid & 63, wid = __builtin_amdgcn_readfirstlane(tid >> 6), r32 = lane & 31, hi = lane >> 5, map = wid & 1, vh = (wid >> 1) & 1, KH = wid >> 2;
    LAS unsigned char* L = F.lds;
    LAS float* wsf = (LAS float*)(L + 65536) + wid * 64;
    const LAS float* LUT = (const LAS float*)(L + LUT_OFF) + h * 192;
    LAS float* MG = (LAS float*)(L + 68608);
    const bf16* QB = (const bf16*)(ws + WS_QB); const bf16* KB = (const bf16*)(ws + WS_KB); const bf16* VB = (const bf16*)(ws + WS_VB);
    const float* CK = A->in[I_CK] + (size_t)(l * NSB + sb) * PAST * 1024 + h * 128; const float* CV = A->in[I_CV] + (size_t)(l * NSB + sb) * PAST * 1024 + h * 128;
    bf16x8 qr[4];
    { const bf16* Qw = QB + (size_t)(MP + sb * TS + (r32 & 15)) * 1024 + h * 128 + map * 64;
#pragma unroll
      for (int d0 = 0; d0 < 4; ++d0) qr[d0] = *(const GAS bf16x8*)(Qw + d0 * 16 + hi * 8); }
    f32x4 st[8];
    auto stage_load = [&](int tile) {
        if (tile < 32) {
#pragma unroll
            for (int k = 0; k < 4; ++k) { const int idx = tid + 512 * k, row = idx >> 5, pp = idx & 31; const size_t off = (size_t)(64 * tile + row) * 1024 + 4 * pp;
                st[k] = __builtin_nontemporal_load((const GAS f32x4*)(CK + off)); st[4 + k] = __builtin_nontemporal_load((const GAS f32x4*)(CV + off)); }
        } else {
#pragma unroll
            for (int i = 0; i < 8; ++i) st[i] = (f32x4){0.f, 0.f, 0.f, 0.f};
            { const int row = tid >> 5, pp = tid & 31; const size_t off = (size_t)(MP + sb * TS + row) * 1024 + h * 128 + 4 * pp;
              const v2u wk = *(const GAS v2u*)(KB + off), wv = *(const GAS v2u*)(VB + off);
              st[0] = (f32x4){bf2f((unsigned short)(wk.x & 0xffffu)), bf2f((unsigned short)(wk.x >> 16)), bf2f((unsigned short)(wk.y & 0xffffu)), bf2f((unsigned short)(wk.y >> 16))};
              st[4] = (f32x4){bf2f((unsigned short)(wv.x & 0xffffu)), bf2f((unsigned short)(wv.x >> 16)), bf2f((unsigned short)(wv.y & 0xffffu)), bf2f((unsigned short)(wv.y >> 16))}; }
        } };
    auto stage_write = [&](int buf) { LAS unsigned char* B = L + buf * 32768;
#pragma unroll
        for (int k = 0; k < 4; ++k) { const int idx = tid + 512 * k, row = idx >> 5, pp = idx & 31, c = 4 * (pp & 15); const f32x4 x = st[k], y = st[4 + k];
            *(LAS v2u*)(B + (pp >> 4) * 8192 + ((pp & 15) >> 1) * 1024 + row * 16 + (pp & 1) * 8) = (v2u){pk2(x[0], x[1]), pk2(x[2], x[3])};
            *(LAS v2u*)(B + 16384 + (pp >> 4) * 8192 + ((c >> 5) * 4 + (row >> 4)) * 1024 + ((row & 15) * 4 + ((c & 31) >> 3)) * 16 + ((c >> 2) & 1) * 8) = (v2u){pk2(y[0], y[1]), pk2(y[2], y[3])}; } };
    stage_load(0);
    float mhat = 0.f, l_reg = 0.f; f32x16 o[2]; o[0] = f32x16{}; o[1] = f32x16{};
    stage_write(0);
    __syncthreads();
    for (int tile = 0; tile < 33; ++tile) {
        if (tile + 1 < 33) stage_load(tile + 1);
        const LAS unsigned char* B = L + (tile & 1) * 32768;
        f32x16 p;
        attn_body::qkt_half(p, (attn_body::lds_cp)(B + map * 8192), qr, f32x16{}, r32, hi, KH);
        asm volatile("s_nop 15\n\ts_nop 7" : "+v"(p));
#pragma unroll
        for (int r = 0; r < 16; ++r) p[r] -= mhat;
        if (tile >= 30) {
            const int rel0 = 64 * tile + 32 * KH + 4 * hi - (PAST + (r32 & 15)) + 128;
#pragma unroll
            for (int r = 0; r < 16; ++r) { const int kin = 32 * KH + 4 * hi + (r & 3) + 8 * (r >> 2); int idx = rel0 + (r & 3) + 8 * (r >> 2); idx = idx < 0 ? 0 : (idx > 191 ? 191 : idx);
                p[r] = (tile == 32 && kin >= TS) ? -INFINITY : p[r] + LUT[idx]; } }
        float rm = p[0];
#pragma unroll
        for (int r = 1; r < 16; ++r) rm = fmaxf(rm, p[r]);
        { const PL32 rr = pl32(rm); rm = fmaxf(rr.a, rr.b); }
        if (__any(rm > 0.f)) { const float dl = fmaxf(rm, 0.f); mhat += dl;
#pragma unroll
            for (int r = 0; r < 16; ++r) p[r] -= dl;
            const float f = __builtin_amdgcn_exp2f(-dl); l_reg *= f; if (hi == 0) wsf[r32] = f;
            asm volatile("s_waitcnt lgkmcnt(0)" ::: "memory");
#pragma unroll
            for (int d_ = 0; d_ < 2; ++d_)
#pragma unroll
                for (int r = 0; r < 16; ++r) o[d_][r] *= wsf[attn_body::crow(r, hi)]; }
        float sacc = 0.f;
#pragma unroll
        for (int r = 0; r < 16; ++r) { p[r] = __builtin_amdgcn_exp2f(p[r]); sacc += p[r]; }
        l_reg += sacc;
        const v4u pw0 = (v4u){attn_body::cvtpk_s(p[0], p[1]), attn_body::cvtpk_s(p[2], p[3]), attn_body::cvtpk_s(p[4], p[5]), attn_body::cvtpk_s(p[6], p[7])};
        const v4u pw1 = (v4u){attn_body::cvtpk_s(p[8], p[9]), attn_body::cvtpk_s(p[10], p[11]), attn_body::cvtpk_s(p[12], p[13]), attn_body::cvtpk_s(p[14], p[15])};
        const int vb = (int)(unsigned)(size_t)(B + 16384 + vh * 8192) + KH * 2048 + ((lane >> 4) & 1) * 32 + (lane & 3) * 8 + (4 * hi + ((lane & 15) >> 2)) * 64;
        attn_body::pv_half(o, vb, __builtin_bit_cast(bf16x8, pw0), __builtin_bit_cast(bf16x8, pw1));
        if (tile + 1 < 33) stage_write((tile + 1) & 1);
        __syncthreads();
    }
    { const PL32 rr = pl32(l_reg); l_reg = rr.a + rr.b; }
    LAS float* OG = (LAS float*)L + (wid & 3) * 2048;
    if (KH == 1) { if (hi == 0) { MG[(wid & 3) * 64 + r32] = mhat; MG[(wid & 3) * 64 + 32 + r32] = l_reg; }
#pragma unroll
        for (int d_ = 0; d_ < 2; ++d_)
#pragma unroll
            for (int r = 0; r < 16; ++r) OG[(d_ * 16 + r) * 64 + lane] = o[d_][r]; }
    __syncthreads();
    if (KH == 0) { const float m2 = MG[wid * 64 + r32], l2 = MG[wid * 64 + 32 + r32]; const float M = fmaxf(mhat, m2);
        const float f1 = __builtin_amdgcn_exp2f(mhat - M), f2 = __builtin_amdgcn_exp2f(m2 - M); const float inv = 1.f / (l_reg * f1 + l2 * f2);
        if (hi == 0) { wsf[r32] = f1 * inv; wsf[32 + r32] = f2 * inv; }
        asm volatile("s_waitcnt lgkmcnt(0)" ::: "memory");
        bf16* OA = (bf16*)(ws + WS_OATT) + (size_t)(MP + sb * TS) * DMOD + h * 256 + map * 128 + vh * 64;
#pragma unroll
        for (int r = 0; r < 8; ++r) { const int q = attn_body::crow(r, hi); const float g1 = wsf[q], g2 = wsf[32 + q];
#pragma unroll
            for (int d_ = 0; d_ < 2; ++d_) OA[(size_t)q * DMOD + d_ * 32 + r32] = (bf16)f2bf(o[d_][r] * g1 + OG[(d_ * 16 + r) * 64 + lane] * g2); } }
    __syncthreads();
}
__device__ __forceinline__ void attn_build_lut(ArgsP A, Frame& F) {
    LAS float* T = (LAS float*)(F.lds + LUT_OFF); const float* reltab = A->in[I_REL];
    for (int i = F.tid; i < 8 * 192; i += NWAVES * 64) { const int hh = i / 192, rel = i % 192 - 128; const int n = rel < 0 ? -rel : rel;
        const int lg = n < 12 ? 8 : n < 16 ? 9 : n < 23 ? 10 : n < 32 ? 11 : n < 46 ? 12 : n < 64 ? 13 : n < 91 ? 14 : 15;
        const int bucket = (rel > 0 ? 16 : 0) + (n < 8 ? n : lg);
        T[i] = (reltab[bucket * 8 + hh] - reltab[15 * 8 + hh]) * 1.4426950408889634f; }
    __syncthreads();
}
__device__ __forceinline__ void ph_attn_sample(Frame& F, int l) {
    PHASE_ENTRY();
    attn_build_lut(A, F);
    gu32* head = F.ctl + CW_QUEUE + 128 * l;
    for (;;) {
        if (F.tid == 0) F.MISC[16] = __hip_atomic_fetch_add(head, 1u, RLX_AGENT);
        __syncthreads();
        const unsigned qi = F.MISC[16];
        __syncthreads();
        if (qi >= 128u) break;
#ifdef SAMPLE_VALU
        attn_sample_unit(A, F, l, (int)(qi >> 3), (int)(qi & 7u));
#else
        attn_sample_unit2(A, F, l, (int)(qi >> 3), (int)(qi & 7u));
#endif
    }
}
__device__ __forceinline__ void ph_attn_prompt(Frame& F, int l) {
    PHASE_ENTRY();
    unsigned char* ws = A->ws;
    gu32* head = F.ctl + CW_QUEUE + 128 * l + 64;
    for (;;) {
        if (F.tid == 0) F.MISC[17] = __hip_atomic_fetch_add(head, 1u, RLX_AGENT);
        __syncthreads();
        const unsigned qi = F.MISC[17];
        __syncthreads();
        if (qi >= 1024u) break;
        const int qb = 63 - (int)(qi >> 4), hm = (int)(qi & 15u);
        const int hh = hm >> 1, mp = hm & 1;
        attn_body::attn_unit_f<8>(qb, hh * 128 + mp * 64, hh * 128, hh * 256 + mp * 128,
                                (const attn_body::bf16*)(ws + WS_QB), (const attn_body::bf16*)(ws + WS_KB), (const attn_body::bf16*)(ws + WS_VB), (attn_body::bf16*)(ws + WS_OATT), (char*)F.lds, (const LAS float*)(F.lds + LUT_OFF) + hh * 192);
    }
}
__device__ __forceinline__ void ph_attn_final(Frame& F, int l) {
    PHASE_ENTRY();
    const int lane = F.lane; const int gw = F.bid * NWAVES + F.wave, NGW = F.G * NWAVES;
    float d1 = A->in[I_LQ1][l * 64 + lane] * A->in[I_LK1][l * 64 + lane], d2 = A->in[I_LQ2][l * 64 + lane] * A->in[I_LK2][l * 64 + lane];
    d1 = wave_sum(d1); d2 = wave_sum(d2);
    const float lam_init = (l == 0) ? 0.2f : (0.8f - 0.6f * 0.7408182206817179f);
    const float lam = expf(d1) - expf(d2) + lam_init, osc = 1.f - lam_init;
    const int hh = lane >> 3, e0 = (lane & 7) * 16;
    const bf16* OA = (const bf16*)(A->ws + WS_OATT); bf16* YC = (bf16*)(A->ws + WS_YCAT);
    f32x4 sl[4];
#pragma unroll
    for (int j = 0; j < 4; ++j) sl[j] = *(const GAS f32x4*)(A->in[I_SUBLN] + l * 128 + e0 + 4 * j);
    v4u na0 = (v4u){0u, 0u, 0u, 0u}, na1 = na0, nb0 = na0, nb1 = na0;
    if (gw < MT) { const bf16* o2 = OA + (size_t)gw * DMOD + hh * 256 + e0; na0 = *(const GAS v4u*)o2; na1 = *(const GAS v4u*)(o2 + 8); nb0 = *(const GAS v4u*)(o2 + 128); nb1 = *(const GAS v4u*)(o2 + 136); }
    for (int m = gw; m < MT; m += NGW) {
        if (l == 0 && m >= MP) { const float* xs = A->in[I_XS] + (size_t)(m - MP) * DMOD; float* xd = (float*)(A->ws + WS_X) + (size_t)m * DMOD;
#pragma unroll
            for (int j = 0; j < 8; ++j) *(GAS f32x4*)(xd + 4 * lane + 256 * j) = *(const GAS f32x4*)(xs + 4 * lane + 256 * j); }
        f32x4 o[4]; float ss = 0.f;
        { const v4u a0 = na0, a1 = na1, b0 = nb0, b1 = nb1;
          if (m + NGW < MT) { const bf16* o2 = OA + (size_t)(m + NGW) * DMOD + hh * 256 + e0; na0 = *(const GAS v4u*)o2; na1 = *(const GAS v4u*)(o2 + 8); nb0 = *(const GAS v4u*)(o2 + 128); nb1 = *(const GAS v4u*)(o2 + 136); }
          const unsigned aw[8] = {a0.x, a0.y, a0.z, a0.w, a1.x, a1.y, a1.z, a1.w}, bw[8] = {b0.x, b0.y, b0.z, b0.w, b1.x, b1.y, b1.z, b1.w};
#pragma unroll
          for (int j = 0; j < 4; ++j) { o[j][0] = bf2f((unsigned short)(aw[2 * j] & 0xffffu)) - lam * bf2f((unsigned short)(bw[2 * j] & 0xffffu)); o[j][1] = bf2f((unsigned short)(aw[2 * j] >> 16)) - lam * bf2f((unsigned short)(bw[2 * j] >> 16));
              o[j][2] = bf2f((unsigned short)(aw[2 * j + 1] & 0xffffu)) - lam * bf2f((unsigned short)(bw[2 * j + 1] & 0xffffu)); o[j][3] = bf2f((unsigned short)(aw[2 * j + 1] >> 16)) - lam * bf2f((unsigned short)(bw[2 * j + 1] >> 16));
              ss += (o[j][0] * o[j][0] + o[j][1] * o[j][1]) + (o[j][2] * o[j][2] + o[j][3] * o[j][3]); } }
        ss += swz_xor<1>(ss); ss += swz_xor<2>(ss); ss += swz_xor<4>(ss);
        const float rs = osc * __builtin_amdgcn_rsqf(ss * (1.f / 128.f) + 1e-5f);
        v4u w0, w1; f32x4 y0 = o[0] * rs * sl[0], y1 = o[1] * rs * sl[1], y2 = o[2] * rs * sl[2], y3 = o[3] * rs * sl[3];
        w0 = (v4u){pk2(y0[0], y0[1]), pk2(y0[2], y0[3]), pk2(y1[0], y1[1]), pk2(y1[2], y1[3])}; w1 = (v4u){pk2(y2[0], y2[1]), pk2(y2[2], y2[3]), pk2(y3[0], y3[1]), pk2(y3[2], y3[3])};
        bf16* yo = YC + (size_t)m * DMOD + 1024 + hh * 128 + e0; *(GAS v4u*)yo = w0; *(GAS v4u*)(yo + 8) = w1;
    }
}
__device__ __forceinline__ void ph_fixup(Frame& F, int l) {
    PHASE_ENTRY();
    const float* tail = (const float*)(A->ws + WS_HALO), *hg = tail + 32 * 2 * DFF, *hv = hg + 32 * 2 * DFF;
    const float* cw = A->in[I_CONVW] + (size_t)l * 3 * DFF, *cb = A->in[I_CONVB] + (size_t)l * DFF; bf16* ACT = (bf16*)(A->ws + WS_ACT);
    const int gt = F.bid * (NWAVES * 64) + F.tid, ngt = F.G * NWAVES * 64;
    for (int idx = gt; idx < 31 * DFF; idx += ngt) { const int pm = 1 + idx / DFF, j = idx % DFF;
        const float um2 = tail[((size_t)(pm - 1) * 2 + 0) * DFF + j], um1 = tail[((size_t)(pm - 1) * 2 + 1) * DFF + j], u0 = hg[((size_t)pm * 2 + 0) * DFF + j], u1 = hg[((size_t)pm * 2 + 1) * DFF + j];
        const float v0 = hv[((size_t)pm * 2 + 0) * DFF + j], v1 = hv[((size_t)pm * 2 + 1) * DFF + j];
        const float w0 = cw[j], w1 = cw[DFF + j], w2 = cw[2 * DFF + j], b = cb[j];
        const pg8::f32x2 g = pg8::gelu_pk((pg8::f32x2){b + w0 * um2 + w1 * um1 + w2 * u0, b + w0 * um1 + w1 * u0 + w2 * u1});
        ACT[(size_t)(256 * pm) * DFF + j] = (bf16)f2bf(g.x * v0); ACT[(size_t)(256 * pm + 1) * DFF + j] = (bf16)f2bf(g.y * v1); }
}
#ifdef PROBE_SEQ
__device__ __forceinline__ void probe_seq_scan(Frame& F, int l) {
    PHASE_ENTRY();
    const int gw = F.bid * NWAVES + F.wave, lane = F.lane;
    if (gw >= 16) return;
    const int h = gw, hj = h * 64 + lane;
    const float* PR = (const float*)(A->ws + WS_PR); const float* mu = A->in[I_MU] + (size_t)l * NRC;
    LAS float* sc = (LAS float*)(F.lds + F.wave * 4096);
    const float* w2 = A->in[I_W2] + (size_t)l * 96 * 1024; const float* a2 = A->in[I_A2] + (size_t)l * 96 * 1024;
    const float w0 = A->in[I_W0][l * 1024 + hj], a0 = A->in[I_A0][l * 1024 + hj], kkw = A->in[I_KK][l * 1024 + hj], kaw = A->in[I_KA][l * 1024 + hj];
    float S[64];
#pragma unroll
    for (int k = 0; k < 64; ++k) S[k] = 0.f;
    for (int t = 0; t < MP; ++t) {
        const float* pc = PR + (size_t)t * NRC_PAD; const float* pp = pc - NRC_PAD;
        auto lerp = [&](int col) { const float cur = pc[col]; const float prv = t > 0 ? pp[col] : 0.f; return cur + (prv - cur) * mu[col]; };
        sc[lane] = tanhf(lerp(3072 + lane)); if (lane < 32) sc[64 + lane] = tanhf(lerp(3072 + 64 + lane));
        sc[96 + lane] = lerp(3168 + lane); if (lane < 32) sc[96 + 64 + lane] = lerp(3168 + 64 + lane);
        LDS_WAIT(); asm volatile("" ::: "memory");
        float wl = 0.f, al = 0.f;
        for (int k = 0; k < 96; ++k) { wl += sc[k] * w2[(size_t)k * 1024 + hj]; al += sc[96 + k] * a2[(size_t)k * 1024 + hj]; }
        const float xk = lerp(1024 + hj), xv = lerp(2048 + hj);
        const float z = w0 + wl; const float wlog = -log1pf(expf(-z)) - 0.5f; const float w = expf(-expf(wlog));
        const float a = 1.f / (1.f + expf(-(a0 + al)));
        const float kkr = xk * kkw; const float nrm = wave_sum(kkr * kkr); const float kk = kkr / sqrtf(fmaxf(nrm, 1e-24f));
        const float km = xk * (1.f + (a - 1.f) * kaw);
        LDS_WAIT(); asm volatile("" ::: "memory");
        sc[192 + lane] = w; sc[256 + lane] = kk; sc[320 + lane] = kk * a; sc[384 + lane] = km;
        LDS_WAIT(); asm volatile("" ::: "memory");
        float sa = 0.f;
#pragma unroll
        for (int k = 0; k < 64; ++k) sa -= S[k] * sc[256 + k];
#pragma unroll
        for (int k = 0; k < 64; ++k) S[k] = S[k] * sc[192 + k] + sa * sc[320 + k] + xv * sc[384 + k];
        LDS_WAIT(); asm volatile("" ::: "memory");
    }
    float* wo = A->out + O_WP + (size_t)(l * 16 + h) * 4096 + lane * 64;
#pragma unroll
    for (int k = 0; k < 64; ++k) wo[k] = S[k];
}
#endif
#ifdef PROBE_GEMM
__device__ __forceinline__ void probe_gemm_check(Frame& F) {
    PHASE_ENTRY();
    if (F.bid != 0) return;
    float* scr = (float*)(A->ws + WS_OATT);
    const int tid = F.tid, lane = F.lane, wave = F.wave;
    for (int j = tid; j < 2 * DMOD; j += NWAVES * 64) { float s = A->in[I_BADA][j];
        for (int k = 0; k < DMOD; ++k) { const float c = A->in[I_CP][k]; s += (c / (1.f + expf(-c))) * A->in[I_WADA][(size_t)k * MODW + j]; }
        scr[j] = s; }
    __threadfence(); __syncthreads();
    float num = 0.f, den = 0.f;
#if PROBE_GEMM == 3
    for (int j = tid; j < 2 * DMOD; j += NWAVES * 64) { const float mine = ((const float*)(A->ws + WS_MOD))[j], ref = scr[j]; num += (mine - ref) * (mine - ref); den += ref * ref; }
    num = wave_sum(num); den = wave_sum(den);
#elif PROBE_GEMM == 5
    { const float sgot = wave_sum((float)(lane + 1)); num = (sgot - 2080.f) * (sgot - 2080.f); den = 2080.f * 2080.f; }
#elif PROBE_GEMM == 6
    { float v = (float)(lane + 1); for (int o = 1; o < 64; o <<= 1) v += __shfl_xor(v, o); num = (v - 2080.f) * (v - 2080.f); den = 2080.f * 2080.f; }
#elif PROBE_GEMM == 4
    for (int smp = wave; smp < 64; smp += NWAVES) { const int m = (smp * 2654435761u >> 7) % MP; const float* xr = A->in[I_XP] + (size_t)m * DMOD; float ss = 0.f;
        for (int k = lane; k < DMOD; k += 64) ss += xr[k] * xr[k];
        const float rstd = 1.f / sqrtf(wave_sum(ss) / DMOD + 1e-6f);
        for (int k = lane; k < DMOD; k += 64) { const float hh = xr[k] * rstd * A->in[I_GMIX][k] * (1.f + scr[DMOD + k]) + scr[k]; const float mine = bf2f(((const bf16*)(A->ws + WS_H))[(size_t)m * DMOD + k]); num += (mine - hh) * (mine - hh); den += hh * hh; } }
    num = wave_sum(num); den = wave_sum(den);
#else
    for (int smp = wave; smp < 256; smp += NWAVES) {
        const int m = (smp * 2654435761u >> 7) % MP; const int cc = (smp * 40503u + 17u) % (PROBE_GEMM == 1 ? 3072 : 1024);
        const int col = PROBE_GEMM == 1 ? cc : NRC + 1024 + cc;
        const float* xr = A->in[I_XP] + (size_t)m * DMOD; float ss = 0.f;
        for (int k = lane; k < DMOD; k += 64) ss += xr[k] * xr[k];
        const float rstd = 1.f / sqrtf(wave_sum(ss) / DMOD + 1e-6f); float acc = 0.f;
        for (int k = lane; k < DMOD; k += 64) { const float hh = xr[k] * rstd * A->in[I_GMIX][k] * (1.f + scr[DMOD + k]) + scr[k]; acc += hh * A->in[I_WIN][(size_t)k * NIN + col]; }
        acc = wave_sum(acc);
        const float mine = PROBE_GEMM == 1 ? ((const float*)(A->ws + WS_PR))[(size_t)m * NRC_PAD + cc] : A->out[O_KP + (size_t)m * 1024 + cc];
        num += (mine - acc) * (mine - acc); den += acc * acc; }
#endif
    LAS float* red = (LAS float*)F.lds;
    if (lane == 0) { red[wave] = num; red[8 + wave] = den; }
    __syncthreads();
    if (tid == 0) { float n = 0.f, d = 0.f; for (int w = 0; w < 8; ++w) { n += red[w]; d += red[8 + w]; } ((float*)(A->ws + WS_CTL))[16384] = sqrtf(n / d); }
}
#endif
#ifndef MK_SPLIT
#define MK_SPLIT 0
#endif
constexpr int N_PHASES = 22;
__global__ void __launch_bounds__(NWAVES * 64, 2) hybrid_fwd(Args args) {
    extern __shared__ __attribute__((aligned(16))) unsigned char lds[];
    Frame F;
    F.lds = (LAS unsigned char*)lds; F.MISC = (volatile LAS unsigned*)(F.lds + MISC_OFF);
    F.tid = threadIdx.x; F.lane = F.tid & 63; F.wave = __builtin_amdgcn_readfirstlane(F.tid >> 6); F.G = gridDim.x; F.bid = blockIdx.x;
    F.ctl = (gu32*)(args.ws + WS_CTL);
    if (F.tid < 64) F.MISC[F.tid] = 0u;
    __syncthreads();
    XcdBarrier bar; bar.bar = (unsigned*)(F.ctl + CW_BAR); bar.x = 0; bar.st = nullptr;
    if (!MK_SPLIT) bar = xcd_barrier_post((unsigned*)(F.ctl + CW_BAR), F.MISC + 8);
    const int lo = args.ph_lo, hi = args.ph_hi;
#ifndef ONLY_PT
#define ONLY_PT -1
#endif
#define PT_ON(t) (ONLY_PT < 0 || ONLY_PT == (t))
#define IN(k) (lo <= (k) && (k) < hi)
#define SEAM(k) do { if (IN(k) && IN((k) + 1)) xcd_barrier(bar); } while (0)
    if (PT_ON(0) && IN(0)) { ph_prologue(F); }
    SEAM(0);
    for (int l = 0; l < NLAYER; ++l) {
        const int pb = 1 + 10 * l;
        if (PT_ON(1) && IN(pb + 0)) ph_norm(F, l, 0, l == 0 ? 0 : 11);
        SEAM(pb + 0);
        if (PT_ON(2) && IN(pb + 1)) { PHASE_ENTRY(); unsigned char* ws = A->ws;
            pg8::Gemm g{(const pg8::bf16_t*)(ws + WS_H), (const pg8::bf16_t*)(ws + WS_WIN) + (size_t)l * NIN_PAD * DMOD, MT, NIN_PAD, DMOD, DMOD}; pg8::TwoPartOrder S; S.init(MT, NRC_PAD / 256, (NIN_PAD - NRC_PAD) / 256, F.G, F.bid, F.G == 256 ? (unsigned*)(F.ctl + CW_QUEUE + 1024 + 64 * l) : nullptr, 1 + (F.bid + 256 < (MT / 256) * (NRC_PAD / 256) ? 1 : 0));
            pg8::EpiIn E{ws, A->out, l, 0.125f * 1.4426950408889634f};
            pg8::gemm_phase<pg8::EpiIn, pg8::TwoPartOrder, true, true>(F.lds, g, S, E);
        }
        if (F.G != 256) SEAM(pb + 1);
#ifdef PROBE_GEMM
        if (l == 0 && IN(pb + 2)) { probe_gemm_check(F); __syncthreads(); }
#endif
        if (PT_ON(3) && IN(pb + 2)) ph_rwkv_passA(F, l);
        SEAM(pb + 2);
#ifdef PROBE_SEQ
        if (IN(pb + 3)) { probe_seq_scan(F, l); __syncthreads(); }
#endif
        if (PT_ON(4) && IN(pb + 3)) { ph_rwkv_chain(F, l); ph_attn_sample(F, l); ph_attn_prompt(F, l); }
        SEAM(pb + 3);
#ifdef PROBE_SEQ
        if (IN(pb + 4) && F.bid == 0) { PHASE_ENTRY();
            for (int h = F.wave; h < 16; h += NWAVES) { const float* a = (const float*)(A->ws + WS_HALO) + (size_t)h * 4096; const float* b = A->out + O_WP + (size_t)(l * 16 + h) * 4096; float n = 0.f, d = 0.f;
                for (int i = F.lane; i < 4096; i += 64) { n += (a[i] - b[i]) * (a[i] - b[i]); d += b[i] * b[i]; }
                n = wave_sum(n); d = wave_sum(d); if (F.lane == 0) { ((float*)(A->ws + WS_CTL))[16400 + 16 * l + h] = sqrtf(n / d); ((float*)(A->ws + WS_CTL))[16440 + 16 * l + h] = d; } } }
#endif
        if (PT_ON(5) && IN(pb + 4)) { ph_rwkv_passC(F, l); ph_attn_final(F, l); }
        SEAM(pb + 4);
        if (PT_ON(6) && IN(pb + 5)) { PHASE_ENTRY(); unsigned char* ws = A->ws;
            const float* X = (const float*)(ws + WS_X); const float* MODl = (const float*)(ws + WS_MOD) + (size_t)l * NMODB * MODW;
            { pg8::Gemm g{(const pg8::bf16_t*)(ws + WS_YCAT), (const pg8::bf16_t*)(ws + WS_WOUT) + (size_t)l * DMOD * DMOD, MP, DMOD, DMOD, DMOD}; pg8::StaticOrder S; S.init(MP, DMOD, F.G, F.bid);
              pg8::EpiRes E{l == 0 ? A->in[I_XP] : X, X + (size_t)MP * DMOD, (float*)(ws + WS_X), MODl + 2 * DMOD};
              pg8::gemm_phase<pg8::EpiRes, pg8::StaticOrder, true, true>(F.lds, g, S, E); }
            { pg8::Gemm g{(const pg8::bf16_t*)(ws + WS_YCAT) + (size_t)MP * DMOD, (const pg8::bf16_t*)(ws + WS_WOUT) + (size_t)l * DMOD * DMOD, 256, DMOD, DMOD / 8, DMOD}; pg8::SplitOrder S; S.init(DMOD, 8, F.bid);
              pg8::EpiResSlab E{(float*)(ws + WS_SLAB), MODl + 2 * DMOD};
              pg8::gemm_phase<pg8::EpiResSlab, pg8::SplitOrder, true, true>(F.lds, g, S, E); }
        }
        SEAM(pb + 5);
        if (PT_ON(7) && IN(pb + 6)) ph_norm(F, l, 1, 8);
        SEAM(pb + 6);
        if (PT_ON(8) && IN(pb + 7)) { PHASE_ENTRY(); unsigned char* ws = A->ws;
            pg8::Gemm g{(const pg8::bf16_t*)(ws + WS_H), (const pg8::bf16_t*)(ws + WS_WUP) + (size_t)l * NUP * DMOD, MT, NUP, DMOD, DMOD}; pg8::PmFirstOrder S; S.init(MT, NUP, F.G, F.bid, F.G == 256 ? (unsigned*)(F.ctl + CW_QUEUE + 1536 + 64 * l) : nullptr);
            pg8::EpiUp E{(pg8::bf16_t*)(ws + WS_ACT), A->in[I_CONVW] + (size_t)l * 3 * DFF, A->in[I_CONVB] + (size_t)l * DFF, A->in[I_SCONV] + (size_t)l * NSB * 2 * DFF,
                         (float*)(ws + WS_HALO), A->out + O_CP + (size_t)l * 2 * DFF, A->out + O_CS + (size_t)l * NSB * 2 * DFF, (PG8_LAS float*)(F.lds + HALO_OFF)};
            pg8::gemm_phase<pg8::EpiUp, pg8::PmFirstOrder, true, true>(F.lds, g, S, E);
            { int first = 0, nw = F.G;
              if (F.G == 256) { first = 256 - ((256 * 6) - (MT / 256) * (NUP / 256)); nw = 256 - first; if (F.bid >= first) wait_count(F, (unsigned*)(F.ctl + CW_QUEUE + 1536 + 64 * l), (unsigned)(NUP / 256)); }
              else if (!MK_SPLIT) xcd_barrier(bar);
              const float* MODl = (const float*)(ws + WS_MOD) + (size_t)l * NMODB * MODW;
              pg8::Gemm g2{(const pg8::bf16_t*)(ws + WS_ACT) + (size_t)MP * DFF, (const pg8::bf16_t*)(ws + WS_WDN) + (size_t)l * DMOD * DFF, 256, DMOD, DFF / 11, DFF}; pg8::TailSplitOrder S2; S2.init(DMOD, 11, F.bid, first, nw);
              pg8::EpiResSlab E2{(float*)(ws + WS_SLAB), MODl + 5 * DMOD};
              pg8::gemm_phase<pg8::EpiResSlab, pg8::TailSplitOrder, true, true>(F.lds, g2, S2, E2); }
        }
        SEAM(pb + 7);
        if (PT_ON(9) && IN(pb + 8)) ph_fixup(F, l);
        SEAM(pb + 8);
        if (PT_ON(10) && IN(pb + 9)) { PHASE_ENTRY(); unsigned char* ws = A->ws;
            const float* X = (const float*)(ws + WS_X); const float* MODl = (const float*)(ws + WS_MOD) + (size_t)l * NMODB * MODW;
            { pg8::Gemm g{(const pg8::bf16_t*)(ws + WS_ACT), (const pg8::bf16_t*)(ws + WS_WDN) + (size_t)l * DMOD * DFF, MP, DMOD, DFF, DFF}; pg8::StaticOrder S; S.init(MP, DMOD, F.G, F.bid);
              pg8::EpiRes E{X, X + (size_t)MP * DMOD, (float*)(ws + WS_X), MODl + 5 * DMOD};
              pg8::gemm_phase<pg8::EpiRes, pg8::StaticOrder, true, true>(F.lds, g, S, E); }
        }
        SEAM(pb + 9);
    }
    if (PT_ON(11) && IN(21)) ph_norm(F, 0, 2, 11);
#ifdef PROBE_MASK
    if (IN(22)) { PHASE_ENTRY();
        const size_t offs[13] = {O_YP, O_YS, O_KP, O_VP, O_WP, O_SP, O_CP, O_KS, O_VS, O_WS, O_SS, O_CS, O_END};
        const size_t gt = (size_t)F.bid * (NWAVES * 64) + F.tid, ngt = (size_t)F.G * NWAVES * 64;
#ifndef PROBE_SCALE
#define PROBE_SCALE 1.2f
#endif
#ifndef PROBE_HALF
#define PROBE_HALF 2
#endif
#ifdef PROBE_HEADS
        { const float* dh = (const float*)(A->ws + WS_CTL) + 16400; float best = -1.f; int bi = 0;
#if PROBE_HEADS == 3
          bi = 0; best = dh[PROBE_IDX] * 20.f;
#elif PROBE_HEADS == 1
          for (int i = 0; i < 32; ++i) if (dh[i] > best) { best = dh[i]; bi = i; }
#else
          for (int i = 0; i < 32; ++i) if (dh[i] * dh[i] * dh[40 + i] > best) { best = dh[i] * dh[i] * dh[40 + i]; bi = i; } best = dh[bi];
#endif
          const float val = (PROBE_HEADS == 3) ? best : 0.05f * bi + fminf(best, 0.049f); const float fsc = 1.f + val; for (size_t i = O_YP + gt; i < O_YS; i += ngt) A->out[i] *= fsc; }
#endif
#ifdef PROBE_GEMM
        { const float dd = ((const float*)(A->ws + WS_CTL))[16384]; const float fsc = 1.f + PROBE_AMP * dd; for (size_t i = O_YP + gt; i < O_YS; i += ngt) A->out[i] *= fsc; }
#endif
        for (int o = 0; o < 12; ++o) if ((PROBE_MASK >> o) & 1) { size_t b = offs[o], e = offs[o + 1]; const size_t mid = b + (e - b) / 2;
            if (PROBE_HALF == 0) e = mid; if (PROBE_HALF == 1) b = mid;
            for (size_t i = b + gt; i < e; i += ngt) A->out[i] *= PROBE_SCALE; } }
#endif
#undef IN
#undef SEAM
}

extern "C" void kernel_launch(void* const* d_in, const int* in_sizes, int n_in, void* d_out, int out_size, void* d_ws, size_t ws_size, hipStream_t stream) {
    static int grid = 0;
    if (grid == 0) {
        if (n_in != 37 || (size_t)out_size != O_END || ws_size < WS_END) { fprintf(stderr, "kernel_launch: built for 37 inputs, %zu outputs, >= %zu bytes of workspace; got n_in %d, out %d, ws %zu; nothing launched\n", (size_t)O_END, (size_t)WS_END, n_in, out_size, ws_size); grid = -1; return; }
        int dev = 0, cus = 0, per_cu = 0;
        if (hipGetDevice(&dev) != hipSuccess || hipDeviceGetAttribute(&cus, hipDeviceAttributeMultiprocessorCount, dev) != hipSuccess) { fprintf(stderr, "kernel_launch: device query failed\n"); grid = -1; return; }
        if (hipFuncSetAttribute((const void*)hybrid_fwd, hipFuncAttributeMaxDynamicSharedMemorySize, LDS_BYTES) != hipSuccess) { fprintf(stderr, "kernel_launch: hipFuncSetAttribute failed\n"); grid = -1; return; }
        if (hipOccupancyMaxActiveBlocksPerMultiprocessor(&per_cu, (const void*)hybrid_fwd, NWAVES * 64, LDS_BYTES) != hipSuccess || per_cu < 1) fprintf(stderr, "kernel_launch: note: occupancy query reports %d workgroups per CU\n", per_cu);
        (void)hipGetLastError();
        grid = cus;
    }
    if (grid < 0) return;
    if (hipMemsetAsync((char*)d_ws + WS_CTL, 0, CTL_ZERO_BYTES, stream) != hipSuccess) { fprintf(stderr, "kernel_launch: memset failed\n"); return; }
    Args a{};
    for (int i = 0; i < 37; ++i) a.in[i] = (const float*)d_in[i];
    a.out = (float*)d_out; a.ws = (unsigned char*)d_ws;
#if MK_SPLIT
#ifdef PROBE_MASK
    const int n_launch = N_PHASES + 1;
#else
    const int n_launch = N_PHASES;
#endif
    for (int p = 0; p < n_launch; ++p) { a.ph_lo = p; a.ph_hi = p + 1; hipLaunchKernelGGL(hybrid_fwd, dim3(grid), dim3(NWAVES * 64), LDS_BYTES, stream, a); }
#else
    a.ph_lo = 0; a.ph_hi = N_PHASES; hipLaunchKernelGGL(hybrid_fwd, dim3(grid), dim3(NWAVES * 64), LDS_BYTES, stream, a);
#endif
    const hipError_t le = hipPeekAtLastError();
    if (le != hipSuccess) fprintf(stderr, "kernel_launch: launch failed: %s\n", hipGetErrorName(le));
}
```

```cpp
#include <hip/hip_runtime.h>
#include <hip/hip_bf16.h>
#include <cstdio>
#include <cstdint>
#include <cmath>
constexpr int NWAVES = 8;
constexpr int DMOD = 2048, MP = 8192, NSB = 16, TS = 16, MT = MP + NSB * TS  , PAST = 2048;
constexpr int NRC = 3520, NRC_PAD = 3584, NIN = 6592, NIN_PAD = 6656, DFF = 5632, NUP = 2 * DFF;
constexpr int NLAYER = 2, NMODB = 17, MODW = 6 * DMOD;
constexpr int RW_UNITS = 128 * 16 + NSB * 16;
constexpr size_t O_YP = 0, O_YS = O_YP + (size_t)MP * DMOD, O_KP = O_YS + (size_t)NSB * TS * DMOD, O_VP = O_KP + (size_t)NLAYER * MP * 1024, O_WP = O_VP + (size_t)NLAYER * MP * 1024,
                 O_SP = O_WP + (size_t)NLAYER * 16 * 4096, O_CP = O_SP + (size_t)NLAYER * NRC, O_KS = O_CP + (size_t)NLAYER * 2 * DFF, O_VS = O_KS + (size_t)NLAYER * 256 * 1024,
                 O_WS = O_VS + (size_t)NLAYER * 256 * 1024, O_SS = O_WS + (size_t)NLAYER * NSB * 16 * 4096, O_CS = O_SS + (size_t)NLAYER * NSB * NRC, O_END = O_CS + (size_t)NLAYER * NSB * 2 * DFF;
constexpr size_t MiB = 1u << 20;
constexpr size_t WS_CTL = 0, CTL_ZERO_BYTES = 1 * MiB;
constexpr size_t WS_MOD = 1 * MiB;
constexpr size_t WS_LORA = 3 * MiB, LORA_LAYER = (size_t)1024 * 448 * 2;
constexpr size_t WS_WIN = 5 * MiB, WS_WOUT = 57 * MiB, WS_WUP = 73 * MiB, WS_WDN = 161 * MiB;
constexpr size_t WS_H = 205 * MiB, WS_PR = 238 * MiB, WS_QB = 354 * MiB, WS_KB = 371 * MiB, WS_VB = 388 * MiB, WS_OATT = 405 * MiB, WS_YCAT = 471 * MiB, WS_X = 504 * MiB, WS_ACT = 570 * MiB;
constexpr size_t WS_PT = 661 * MiB, WS_QQ = 679 * MiB, WS_RP = 715 * MiB, WS_YV = 733 * MiB, WS_SC = 769 * MiB, WS_G1 = 787 * MiB, WS_G2 = 820 * MiB, WS_HALO = 853 * MiB, WS_WL = 858 * MiB, WS_PT32 = 859 * MiB, WS_LSCR = 895 * MiB, WS_SLAB = 911 * MiB, WS_END = 935 * MiB;
static_assert(WS_WIN + (size_t)2 * NIN_PAD * DMOD * 2 <= WS_WOUT && WS_WOUT + (size_t)2 * DMOD * DMOD * 2 <= WS_WUP && WS_WUP + (size_t)2 * NUP * DMOD * 2 <= WS_WDN && WS_WDN + (size_t)2 * DMOD * DFF * 2 <= WS_H, "weights map");
static_assert(WS_H + (size_t)MT * DMOD * 2 <= WS_PR && WS_PR + (size_t)MT * NRC_PAD * 4 <= WS_QB && WS_QB + (size_t)MT * 1024 * 2 <= WS_KB && WS_VB + (size_t)MT * 1024 * 2 <= WS_OATT && WS_OATT + (size_t)MT * DMOD * 4 <= WS_YCAT, "act map 1");
static_assert(WS_YCAT + (size_t)MT * DMOD * 2 <= WS_X && WS_X + (size_t)MT * DMOD * 4 <= WS_ACT && WS_ACT + (size_t)MT * DFF * 2 <= WS_PT, "act map 2");
static_assert(WS_PT + (size_t)RW_UNITS * 8192 <= WS_QQ && WS_QQ + (size_t)RW_UNITS * 16384 <= WS_RP && WS_RP + (size_t)RW_UNITS * 8192 <= WS_YV && WS_YV + (size_t)RW_UNITS * 16384 <= WS_SC && WS_SC + (size_t)RW_UNITS * 8192 <= WS_G1, "rwkv map");
static_assert(WS_G1 + (size_t)MT * 1024 * 4 <= WS_G2 && WS_G2 + (size_t)MT * 1024 * 4 <= WS_HALO && WS_HALO + (size_t)3 * 32 * 2 * DFF * 4 <= WS_WL && WS_WL + (size_t)RW_UNITS * 256 <= WS_PT32 && WS_PT32 + (size_t)RW_UNITS * 16384 <= WS_LSCR && WS_LSCR + (size_t)256 * 61440 <= WS_SLAB && WS_SLAB + (size_t)11 * 256 * 2048 * 4 <= WS_END && WS_LORA + 2 * LORA_LAYER <= WS_WIN && WS_MOD + (size_t)NLAYER * NMODB * MODW * 4 <= WS_LORA, "map 3");
constexpr int CW_BAR = 4096, CW_QUEUE = 8192;
constexpr int LDS_BYTES = 163840;
constexpr int MISC_OFF = LDS_BYTES - 256;
constexpr int LUT_OFF = 131072;
constexpr int HALO_OFF = 131072;
constexpr int RW_SLOT = 9216, RW_STRIDE = 72;
constexpr int RW_SCR = 154624;
static_assert(RW_SCR + 4096 <= MISC_OFF && HALO_OFF + 4096 <= MISC_OFF, "LDS map");

#define GAS __attribute__((address_space(1)))
#define LAS __attribute__((address_space(3)))
typedef unsigned short bf16;
typedef unsigned v4u __attribute__((ext_vector_type(4)));
typedef unsigned v2u __attribute__((ext_vector_type(2)));
typedef float f32x4 __attribute__((ext_vector_type(4)));
typedef float f32x2 __attribute__((ext_vector_type(2)));
typedef short bf16x8 __attribute__((ext_vector_type(8)));
typedef GAS unsigned gu32;
#define RLX_AGENT __ATOMIC_RELAXED, __HIP_MEMORY_SCOPE_AGENT
#define LDS_WAIT() asm volatile("s_waitcnt lgkmcnt(0)" ::: "memory")
#define VM_WAIT() asm volatile("s_waitcnt vmcnt(0)" ::: "memory")
typedef float cvt_f32x2 __attribute__((ext_vector_type(2))); typedef __bf16 cvt_bf16x2 __attribute__((ext_vector_type(2)));
__device__ __forceinline__ unsigned pk2(float lo, float hi) { const cvt_f32x2 v = {lo, hi}; return __builtin_bit_cast(unsigned, __builtin_convertvector(v, cvt_bf16x2)); }
__device__ __forceinline__ unsigned f2bf(float f) { return pk2(f, 0.f) & 0xffffu; }
__device__ __forceinline__ float bf2f(unsigned short b) { return __builtin_bit_cast(float, (unsigned)b << 16); }
template <int K> __device__ __forceinline__ float swz_xor(float v) { static_assert(K >= 1 && K <= 16, "");
    return __builtin_bit_cast(float, __builtin_amdgcn_ds_swizzle(__builtin_bit_cast(int, v), (K << 10) | 0x1f)); }
struct PL32 { float a, b; };
__device__ __forceinline__ PL32 pl32(float v) { const int ln = (int)(threadIdx.x & 63);
    const float p = __builtin_bit_cast(float, __builtin_amdgcn_ds_bpermute((ln ^ 32) << 2, __builtin_bit_cast(int, v))); PL32 o; o.a = v; o.b = p; return o; }
__device__ __forceinline__ float xor32(float v) { return pl32(v).b; }
template <int CTRL> __device__ __forceinline__ float dpp_f(float v) { return __builtin_bit_cast(float, __builtin_amdgcn_update_dpp(__builtin_bit_cast(int, v), __builtin_bit_cast(int, v), CTRL, 0xF, 0xF, false)); }
__device__ __forceinline__ float wave_sum(float v) {
    v += dpp_f<0xB1>(v); v += dpp_f<0x4E>(v); v += dpp_f<0x141>(v); v += dpp_f<0x128>(v); v += swz_xor<16>(v);
    const PL32 r = pl32(v); return r.a + r.b;
}
__device__ __forceinline__ float wave_max(float v) {
    v = fmaxf(v, dpp_f<0xB1>(v)); v = fmaxf(v, dpp_f<0x4E>(v)); v = fmaxf(v, dpp_f<0x141>(v)); v = fmaxf(v, dpp_f<0x128>(v)); v = fmaxf(v, swz_xor<16>(v));
    const PL32 r = pl32(v); return fmaxf(r.a, r.b);
}
__device__ __forceinline__ float sigmoidf_(float x) { return __builtin_amdgcn_rcpf(1.f + __expf(-x)); }
namespace pg8 {
#define PG8_LAS __attribute__((address_space(3)))
typedef unsigned short bf16_t;
typedef short bf16x8 __attribute__((ext_vector_type(8)));
typedef float f32x4 __attribute__((ext_vector_type(4)));
typedef unsigned u32x4 __attribute__((ext_vector_type(4)));
constexpr int BM = 256, BK = 64, HALF = 128, HTB = HALF * BK * 2  , STAGE_BYTES = 8 * HTB, NXCD = 8, WGM = 8;

__host__ __device__ __forceinline__ int lds_byte(int r, int c) { const int st = (r >> 4) * 2 + (c >> 5), rr = r & 15, cc = c & 31, ob = rr * 64 + cc * 2; return st * 1024 + (ob ^ (((ob >> 9) & 1) << 5)); }
__host__ __device__ __forceinline__ void stage_rc(int b, int& R, int& C) { const int st = b / 1024, sb = b % 1024, swz = sb ^ (((sb >> 9) & 1) << 5); R = (st >> 1) * 16 + swz / 64; C = (st & 1) * 32 + (swz % 64) / 2; }
__host__ __device__ __forceinline__ int perm32(int rho) { const int n = rho >> 4, i = rho & 15; return 8 * (i >> 2) + 4 * n + (i & 3); }

struct Unit { int pm, pn, ks, tag; };
struct Gemm { const bf16_t* A; const bf16_t* Bt; int M, N, K, ld; };

struct StaticOrder {
    static constexpr bool HANDOFF = false;
    int nM, nN, nwg, G, c;
    __host__ __device__ void init(int M, int N, int G_, int c_) { nM = M / BM; nN = N / BM; nwg = nM * nN; G = G_; c = c_; }
    __host__ __device__ bool next(int i, Unit& u) const {
        const long L = (long)i * G + c; if (L >= nwg) return false;
        int wgid = (int)L; { const int q = nwg / NXCD, r = nwg % NXCD, xcd = wgid % NXCD, off = wgid / NXCD; wgid = (xcd < r ? xcd * (q + 1) : r * (q + 1) + (xcd - r) * q) + off; }
        const int nig = WGM * nN, gid = wgid / nig, fm = gid * WGM, gsz = (nM - fm) < WGM ? (nM - fm) : WGM;
        u.pm = fm + ((wgid % nig) % gsz); u.pn = (wgid % nig) / gsz; u.ks = 0; u.tag = 0; return true;
    }
    __device__ __forceinline__ void a_ready(const Unit&) const {}
    __device__ __forceinline__ void done(const Unit&) const {}
};

struct TwoPartOrder {
    static constexpr bool HANDOFF = true;
    int nM, nA, nB, G, c; unsigned* cnt; int nsig;
    __device__ __forceinline__ void mid(const Unit& u, int t, int nt, int wid, int lane) const {
        if (cnt == nullptr || u.tag != 2) return;
        if (t == nt / 2) asm volatile("s_waitcnt vmcnt(0)" ::: "memory");
        if (t == nt / 2 + 2 && wid == 0) { __builtin_amdgcn_fence(__ATOMIC_RELEASE, "agent"); asm volatile("s_waitcnt vmcnt(0)" ::: "memory");
            if (lane == 0) (void)__hip_atomic_fetch_add(cnt, (unsigned)nsig, __ATOMIC_RELAXED, __HIP_MEMORY_SCOPE_AGENT); }
    }
    __host__ __device__ void init(int M, int NA, int NB, int G_, int c_, unsigned* cnt_, int nsig_) { nM = M / BM; nA = NA; nB = NB; G = G_; c = c_; cnt = cnt_; nsig = nsig_; }
    __host__ __device__ static void map(int wgid, int nM, int nN, Unit& u) {
        const int nwg = nM * nN; { const int q = nwg / NXCD, r = nwg % NXCD, xcd = wgid % NXCD, off = wgid / NXCD; wgid = (xcd < r ? xcd * (q + 1) : r * (q + 1) + (xcd - r) * q) + off; }
        const int nig = WGM * nN, gid = wgid / nig, fm = gid * WGM, gsz = (nM - fm) < WGM ? (nM - fm) : WGM;
        u.pm = fm + ((wgid % nig) % gsz); u.pn = (wgid % nig) / gsz; u.ks = 0;
    }
    __host__ __device__ bool next(int i, Unit& u) const {
        const long L = (long)i * G + c; const int na = nM * nA, nb = nM * nB; if (L >= na + nb) return false;
        if (L < na) map((int)L, nM, nA, u); else { map((int)L - na, nM, nB, u); u.pn += nA; }
        u.tag = i; return true;
    }
    __device__ __forceinline__ void a_ready(const Unit&) const {}
    __device__ __forceinline__ void done(const Unit&) const {}
};

struct PmFirstOrder {
    static constexpr bool HANDOFF = true;
    int nM, nN, G, c; unsigned* cnt;
    __host__ __device__ void init(int M, int N, int G_, int c_, unsigned* cnt_) { nM = M / BM; nN = N / BM; G = G_; c = c_; cnt = cnt_; }
    __host__ __device__ __forceinline__ bool next(int i, Unit& u) const {
        const long L = (long)i * G + c; if (L >= (long)nM * nN) return false;
        if (L < nN) { u.pm = nM - 1; u.pn = (int)L; u.ks = 0; } else TwoPartOrder::map((int)L - nN, nM - 1, nN, u);
        u.tag = i; return true;
    }
    __device__ __forceinline__ void a_ready(const Unit&) const {}
    __device__ __forceinline__ void done(const Unit&) const {}
    __device__ __forceinline__ void mid(const Unit& u, int t, int nt, int wid, int lane) const {
        if (cnt == nullptr || u.tag != 1 || c >= nN) return;
        if (t == nt / 2) asm volatile("s_waitcnt vmcnt(0)" ::: "memory");
        if (t == nt / 2 + 2 && wid == 0) { __builtin_amdgcn_fence(__ATOMIC_RELEASE, "agent"); asm volatile("s_waitcnt vmcnt(0)" ::: "memory");
            if (lane == 0) (void)__hip_atomic_fetch_add(cnt, 1u, __ATOMIC_RELAXED, __HIP_MEMORY_SCOPE_AGENT); }
    }
};
struct TailSplitOrder {
    static constexpr bool HANDOFF = false;
    int n, KS, k, nw;
    __host__ __device__ void init(int N, int KS_, int c_, int first, int nw_) { n = (N / BM) * KS_; KS = KS_; k = c_ - first; nw = nw_; }
    __host__ __device__ __forceinline__ bool next(int i, Unit& u) const { const int L = k + i * nw; if (k < 0 || L >= n) return false; u.pm = 0; u.pn = L / KS; u.ks = L % KS; u.tag = 0; return true; }
    __device__ __forceinline__ void a_ready(const Unit&) const {}
    __device__ __forceinline__ void done(const Unit&) const {}
};

struct SplitOrder {
    static constexpr bool HANDOFF = false;
    int n, KS, c;
    __host__ __device__ void init(int N, int KS_, int c_) { n = (N / BM) * KS_; KS = KS_; c = c_; }
    __host__ __device__ bool next(int i, Unit& u) const { if (i > 0 || c >= n) return false; u.pm = 0; u.pn = c / KS; u.ks = c % KS; u.tag = 0; return true; }
    __device__ __forceinline__ void a_ready(const Unit&) const {}
    __device__ __forceinline__ void done(const Unit&) const {}
};
__device__ __forceinline__ unsigned cvt_pk_bf16(float lo, float hi) { unsigned r; asm volatile("v_cvt_pk_bf16_f32 %0, %1, %2" : "=v"(r) : "v"(lo), "v"(hi)); return r; }
typedef float f32x2 __attribute__((ext_vector_type(2)));
__device__ __forceinline__ f32x2 gelu_pk(f32x2 v) {
    const f32x2 av = __builtin_elementwise_abs(v), d = av * 0.2316418882f + 1.0f;
    f32x2 t; t.x = __builtin_amdgcn_rcpf(d.x); t.y = __builtin_amdgcn_rcpf(d.y);
    f32x2 q = t * 0.5307027145f + (-0.7265760135f); q = q * t + 0.7107068705f; q = q * t + (-0.142248368f); q = q * t + 0.127414796f; q = q * t;
    const f32x2 s = (v * v) * (-0.72134752044f);
    f32x2 e; e.x = __builtin_amdgcn_exp2f(s.x); e.y = __builtin_amdgcn_exp2f(s.y);
    const f32x2 m = v * (q * e), r = v - m;
    f32x2 o; o.x = v.x < 0.f ? m.x : r.x; o.y = v.y < 0.f ? m.y : r.y; return o;
}

template <class Epi, class Sched, bool ALIGN_EPI = false, bool SP2 = false>
__device__ __forceinline__ void gemm_phase(PG8_LAS unsigned char* lds, const Gemm g, const Sched& S, const Epi& E) {
    int tid_ = threadIdx.x; asm volatile("" : "+v"(tid_));
    const int tid = tid_, wid = __builtin_amdgcn_readfirstlane(tid >> 6), lane = tid & 63, wr = wid >> 2, wc = wid & 3, fr = lane & 15, fq = lane >> 4;
    const int K = g.ld, nt = g.K / BK;
    unsigned voffA[2], voffB[2];
#pragma unroll
    for (int i = 0; i < 2; ++i) { int R, C; stage_rc(tid * 16 + i * 8192, R, C); const int Rb = Epi::PERM ? ((R & ~31) + perm32(R & 31)) : R;
        voffA[i] = (unsigned)(R * K + C) * 2u; voffB[i] = (unsigned)(Rb * K + C) * 2u; }
    const size_t kstep = (size_t)(BK * 2);
    const size_t hstep = (size_t)HALF * K * 2;
    const size_t tstep = 2 * hstep;
    const unsigned ldsw = (unsigned)wid * 1024u;
    const int aoff = lds_byte(wr * 64 + fr, fq * 8), boff = lds_byte(wc * 32 + fr, fq * 8);
#define PG8_SA(b, h) (((b) * 2 + (h)) * HTB)
#define PG8_SB(b, h) ((4 + (b) * 2 + (h)) * HTB)
#define PG8_STAGE(bufoff, gbase, voff) do { _Pragma("unroll") for (int _i = 0; _i < 2; ++_i) \
        __builtin_amdgcn_global_load_lds((const unsigned*)((const char*)(gbase) + (voff)[_i]), (PG8_LAS unsigned*)(lds + (bufoff) + ldsw + _i * 8192), 16, 0, 0); } while (0)
#define PG8_LDA(dst, b, h) do { _Pragma("unroll") for (int m = 0; m < 4; ++m) _Pragma("unroll") for (int k = 0; k < 2; ++k) dst[m][k] = *(const PG8_LAS bf16x8*)(lds + PG8_SA(b, h) + aoff + m * 2048 + k * 1024); } while (0)
#define PG8_LDB(dst, b, h) do { _Pragma("unroll") for (int n = 0; n < 2; ++n) _Pragma("unroll") for (int k = 0; k < 2; ++k) dst[n][k] = *(const PG8_LAS bf16x8*)(lds + PG8_SB(b, h) + boff + n * 2048 + k * 1024); } while (0)
#define PG8_MMA(ai, bj, At, Bt) do { __builtin_amdgcn_s_setprio(1); _Pragma("unroll") for (int m = 0; m < 4; ++m) _Pragma("unroll") for (int n = 0; n < 2; ++n) _Pragma("unroll") for (int k = 0; k < 2; ++k) \
        acc[ai][bj][m][n] = __builtin_amdgcn_mfma_f32_16x16x32_bf16(Bt[n][k], At[m][k], acc[ai][bj][m][n], 0, 0, 0); __builtin_amdgcn_s_setprio(0); } while (0)
#define PG8_WAIT_V(n) asm volatile("s_waitcnt vmcnt(" #n ")" ::: "memory")
#define PG8_WAIT_L(n) asm volatile("s_waitcnt lgkmcnt(" #n ")" ::: "memory")
#define PG8_BAR __builtin_amdgcn_s_barrier()
#define PG8_SCHED __builtin_amdgcn_sched_barrier(0)
    Unit cur, nxt; int ui = 0;
    if (!S.next(0, cur)) return;
    f32x4 acc[2][2][4][2];
#pragma unroll
    for (int a = 0; a < 2; ++a)
#pragma unroll
        for (int b = 0; b < 2; ++b)
#pragma unroll
            for (int m = 0; m < 4; ++m)
#pragma unroll
                for (int n = 0; n < 2; ++n) acc[a][b][m][n] = (f32x4){0.f, 0.f, 0.f, 0.f};
    bf16x8 At[4][2], B0[2][2], B1[2][2];
    const size_t sstep = (size_t)g.K * 2;
    const char* cA = (const char*)g.A + (size_t)cur.pm * tstep + (size_t)cur.ks * sstep; const char* cB = (const char*)g.Bt + (size_t)cur.pn * tstep + (size_t)cur.ks * sstep;
    S.a_ready(cur);
    if constexpr (SP2) {
        PG8_STAGE(PG8_SB(0, 0), cB, voffB); PG8_STAGE(PG8_SB(0, 1), cB + hstep, voffB); PG8_STAGE(PG8_SA(0, 0), cA, voffA); PG8_STAGE(PG8_SA(0, 1), cA + hstep, voffA);
        if (wr == 1) PG8_BAR;
        PG8_WAIT_V(2); PG8_BAR;
        PG8_STAGE(PG8_SB(1, 0), cB + kstep, voffB); PG8_STAGE(PG8_SA(1, 0), cA + kstep, voffA); PG8_STAGE(PG8_SB(1, 1), cB + hstep + kstep, voffB);
        PG8_WAIT_V(6); PG8_BAR;
    } else {
        PG8_STAGE(PG8_SB(0, 0), cB, voffB); PG8_STAGE(PG8_SA(0, 0), cA, voffA); PG8_STAGE(PG8_SB(0, 1), cB + hstep, voffB); PG8_STAGE(PG8_SA(0, 1), cA + hstep, voffA);
        if (wr == 1) PG8_BAR;
        PG8_WAIT_V(4); PG8_BAR;
        PG8_STAGE(PG8_SB(1, 0), cB + kstep, voffB); PG8_STAGE(PG8_SA(1, 0), cA + kstep, voffA); PG8_STAGE(PG8_SB(1, 1), cB + hstep + kstep, voffB);
        PG8_WAIT_V(6); PG8_BAR;
    }
    for (;;) {
        const bool has_next = S.next(ui + 1, nxt);
        const char* nA = has_next ? (const char*)g.A + (size_t)nxt.pm * tstep + (size_t)nxt.ks * sstep : cA; const char* nB = has_next ? (const char*)g.Bt + (size_t)nxt.pn * tstep + (size_t)nxt.ks * sstep : cB;
        asm volatile(".p2align 8" ::: "memory");
        for (int t = 0; t < nt; t += 2) {
            const bool last = (t == nt - 2);
            const char* a1 = cA + (size_t)(t + 1) * kstep;
            const char* a2 = last ? nA : cA + (size_t)(t + 2) * kstep; const char* b2 = last ? nB : cB + (size_t)(t + 2) * kstep;
            const char* a3 = a2 + kstep; const char* b3 = b2 + kstep;
            if (last && has_next) S.a_ready(nxt);
            if constexpr (Sched::HANDOFF) S.mid(cur, t, nt, wid, lane);
            if constexpr (SP2) {
            PG8_LDB(B0, 0, 0); PG8_LDB(B1, 0, 1); PG8_SCHED; PG8_LDA(At, 0, 0); PG8_STAGE(PG8_SA(1, 1), a1 + hstep, voffA);
            PG8_WAIT_V(8); PG8_WAIT_L(0); PG8_BAR; PG8_MMA(0, 0, At, B0); PG8_MMA(0, 1, At, B1); PG8_BAR; PG8_SCHED;
            PG8_LDA(At, 0, 1); PG8_STAGE(PG8_SB(0, 0), b2, voffB); PG8_STAGE(PG8_SB(0, 1), b2 + hstep, voffB); PG8_STAGE(PG8_SA(0, 0), a2, voffA);
            PG8_WAIT_V(8); PG8_WAIT_L(0); PG8_BAR; PG8_MMA(1, 0, At, B0); PG8_MMA(1, 1, At, B1); PG8_BAR; PG8_SCHED;
            PG8_LDB(B0, 1, 0); PG8_LDB(B1, 1, 1); PG8_SCHED; PG8_LDA(At, 1, 0); PG8_STAGE(PG8_SA(0, 1), a2 + hstep, voffA);
            PG8_WAIT_V(8); PG8_WAIT_L(0); PG8_BAR; PG8_MMA(0, 0, At, B0); PG8_MMA(0, 1, At, B1); PG8_BAR; PG8_SCHED;
            PG8_LDA(At, 1, 1); PG8_STAGE(PG8_SB(1, 0), b3, voffB); PG8_STAGE(PG8_SB(1, 1), b3 + hstep, voffB); PG8_STAGE(PG8_SA(1, 0), a3, voffA);
            PG8_WAIT_V(8); PG8_WAIT_L(0); PG8_BAR; PG8_MMA(1, 0, At, B0); PG8_MMA(1, 1, At, B1); PG8_BAR; PG8_SCHED;
            } else {
            PG8_LDB(B0, 0, 0); PG8_SCHED; PG8_LDA(At, 0, 0); PG8_STAGE(PG8_SA(1, 1), a1 + hstep, voffA);
            PG8_WAIT_L(8); PG8_BAR; PG8_WAIT_L(0); PG8_MMA(0, 0, At, B0); PG8_BAR; PG8_SCHED;
            PG8_LDB(B1, 0, 1); PG8_STAGE(PG8_SB(0, 0), b2, voffB);
            PG8_BAR; PG8_WAIT_L(0); PG8_MMA(0, 1, At, B1); PG8_BAR;
            PG8_LDA(At, 0, 1); PG8_STAGE(PG8_SA(0, 0), a2, voffA);
            PG8_BAR; PG8_WAIT_L(0); PG8_MMA(1, 0, At, B0); PG8_BAR; PG8_SCHED;
            PG8_STAGE(PG8_SB(0, 1), b2 + hstep, voffB);
            PG8_WAIT_V(6); PG8_BAR; PG8_MMA(1, 1, At, B1); PG8_BAR;
            PG8_LDB(B0, 1, 0); PG8_SCHED; PG8_LDA(At, 1, 0); PG8_STAGE(PG8_SA(0, 1), a2 + hstep, voffA);
            PG8_WAIT_L(8); PG8_BAR; PG8_WAIT_L(0); PG8_MMA(0, 0, At, B0); PG8_BAR; PG8_SCHED;
            PG8_LDB(B1, 1, 1); PG8_STAGE(PG8_SB(1, 0), b3, voffB);
            PG8_BAR; PG8_WAIT_L(0); PG8_MMA(0, 1, At, B1); PG8_BAR;
            PG8_LDA(At, 1, 1); PG8_STAGE(PG8_SA(1, 0), a3, voffA);
            PG8_BAR; PG8_WAIT_L(0); PG8_MMA(1, 0, At, B0); PG8_BAR; PG8_SCHED;
            PG8_STAGE(PG8_SB(1, 1), b3 + hstep, voffB);
            PG8_WAIT_V(6); PG8_BAR; PG8_MMA(1, 1, At, B1); PG8_BAR;
            }
        }
        if constexpr (ALIGN_EPI) { if (wr == 0) PG8_BAR; }
        if constexpr (!Epi::AFTER_DRAIN) { E(acc, cur, wr, wc, fr, fq); S.done(cur); }
        if (!has_next) break;
#pragma unroll
        for (int a = 0; a < 2; ++a)
#pragma unroll
            for (int b = 0; b < 2; ++b)
#pragma unroll
                for (int m = 0; m < 4; ++m)
#pragma unroll
                    for (int n = 0; n < 2; ++n) acc[a][b][m][n] = (f32x4){0.f, 0.f, 0.f, 0.f};
        cur = nxt; cA = nA; cB = nB; ++ui;
        if constexpr (ALIGN_EPI) { if (wr == 1) PG8_BAR; }
    }
    PG8_WAIT_V(0);
    if constexpr (!ALIGN_EPI) { if (wr == 0) PG8_BAR; }
    PG8_BAR;
    if constexpr (Epi::AFTER_DRAIN) { E.fused(acc, cur, wr, wc, fr, fq, lds, wid, lane); S.done(cur); }
#undef PG8_SA
#undef PG8_SB
#undef PG8_STAGE
#undef PG8_LDA
#undef PG8_LDB
#undef PG8_MMA
#undef PG8_WAIT_V
#undef PG8_WAIT_L
#undef PG8_BAR
#undef PG8_SCHED
}
}
namespace pg8 {
typedef unsigned u32x2v __attribute__((ext_vector_type(2)));
constexpr int E_MP = 8192;
struct EpiIn {
    static constexpr bool PERM = true, AFTER_DRAIN = false;
    unsigned char* ws; float* out; int l; float qscale;
    __device__ __forceinline__ void operator()(const f32x4 (&acc)[2][2][4][2], const Unit& u, int wr, int wc, int fr, int fq) const {
        asm volatile("" : "+v"(fr), "+v"(fq));
        const int row0 = u.pm * BM + wr * 64 + fr, colt = u.pn * BM + wc * 32 + 8 * fq;
        if (u.pn < 14) {
            float* PR = (float*)(ws + WS_PR); float* sh_p = out + O_SP + (size_t)l * 3520; float* sh_s = out + O_SS + (size_t)l * 16 * 3520;
#pragma unroll
            for (int ai = 0; ai < 2; ++ai)
#pragma unroll
                for (int m = 0; m < 4; ++m) { const int r = row0 + ai * HALF + m * 16;
#pragma unroll
                    for (int bj = 0; bj < 2; ++bj) { const int c = colt + bj * HALF; float* p = PR + (size_t)r * 3584 + c;
                        *(f32x4*)p = acc[ai][bj][m][0]; *(f32x4*)(p + 4) = acc[ai][bj][m][1];
                        if (c < 3520) {
                            if (r == E_MP - 1) { *(f32x4*)(sh_p + c) = acc[ai][bj][m][0]; *(f32x4*)(sh_p + c + 4) = acc[ai][bj][m][1]; }
                            if (r >= E_MP && (r & 15) == 15) { float* q = sh_s + (size_t)((r - E_MP) >> 4) * 3520 + c; *(f32x4*)q = acc[ai][bj][m][0]; *(f32x4*)(q + 4) = acc[ai][bj][m][1]; }
                        } } }
        } else {
            const int region = (u.pn - 14) >> 2, cl0 = colt - 3584 - region * 1024;
            static_assert(WS_KB - WS_QB == WS_VB - WS_KB && O_VP - O_KP == (size_t)2 * 8192 * 1024 && O_VS - O_KS == (size_t)2 * 256 * 1024, "equal spacing");
            bf16_t* B16 = (bf16_t*)(ws + WS_QB + (size_t)region * (WS_KB - WS_QB));
            const float sc = region == 0 ? qscale : 1.f;
            float* fp = out + O_KP + (size_t)(region == 2 ? 1 : 0) * (O_VP - O_KP) + (size_t)l * E_MP * 1024; float* fs = out + O_KS + (size_t)(region == 2 ? 1 : 0) * (O_VS - O_KS) + (size_t)l * 256 * 1024;
#pragma unroll
            for (int ai = 0; ai < 2; ++ai)
#pragma unroll
                for (int m = 0; m < 4; ++m) { const int r = row0 + ai * HALF + m * 16;
                    float* fo = (r < E_MP) ? fp + (size_t)r * 1024 : fs + (size_t)(r - E_MP) * 1024;
#pragma unroll
                    for (int bj = 0; bj < 2; ++bj) { const int c = cl0 + bj * HALF; const f32x4 v0 = acc[ai][bj][m][0] * sc, v1 = acc[ai][bj][m][1] * sc;
                        u32x4 w; w.x = cvt_pk_bf16(v0[0], v0[1]); w.y = cvt_pk_bf16(v0[2], v0[3]); w.z = cvt_pk_bf16(v1[0], v1[1]); w.w = cvt_pk_bf16(v1[2], v1[3]);
                        *(u32x4*)(B16 + (size_t)r * 1024 + c) = w;
                        if (region != 0) { __builtin_nontemporal_store(v0, (f32x4*)(fo + c)); __builtin_nontemporal_store(v1, (f32x4*)(fo + c + 4)); } } }
        }
    }
};
struct EpiRes {
    static constexpr bool PERM = true, AFTER_DRAIN = false;
    const float* src_p; const float* src_s; float* dst; const float* gate;
    __device__ __forceinline__ void operator()(const f32x4 (&acc)[2][2][4][2], const Unit& u, int wr, int wc, int fr, int fq) const {
        asm volatile("" : "+v"(fr), "+v"(fq));
        const int row0 = u.pm * BM + wr * 64 + fr, colt = u.pn * BM + wc * 32 + 8 * fq;
        f32x4 gt[2][2];
#pragma unroll
        for (int bj = 0; bj < 2; ++bj)
#pragma unroll
            for (int n = 0; n < 2; ++n) gt[bj][n] = *(const f32x4*)(gate + colt + bj * HALF + 4 * n);
#pragma unroll
        for (int ai = 0; ai < 2; ++ai)
#pragma unroll
            for (int mp = 0; mp < 1; ++mp) {
                f32x4 x[4][2][2];
#pragma unroll
                for (int mm = 0; mm < 4; ++mm) { const int r = row0 + ai * HALF + (4 * mp + mm) * 16; const float* s = src_p + (size_t)r * 2048 + colt;
#pragma unroll
                    for (int bj = 0; bj < 2; ++bj)
#pragma unroll
                        for (int n = 0; n < 2; ++n) x[mm][bj][n] = *(const f32x4*)(s + bj * HALF + 4 * n); }
#pragma unroll
                for (int mm = 0; mm < 4; ++mm) { const int m = 4 * mp + mm, r = row0 + ai * HALF + m * 16; float* d = dst + (size_t)r * 2048 + colt;
#pragma unroll
                    for (int bj = 0; bj < 2; ++bj)
#pragma unroll
                        for (int n = 0; n < 2; ++n) *(f32x4*)(d + bj * HALF + 4 * n) = x[mm][bj][n] + gt[bj][n] * acc[ai][bj][m][n]; }
                asm volatile("" ::: "memory");
            }
    }
};
struct EpiResSlab {
    static constexpr bool PERM = true, AFTER_DRAIN = false;
    float* slab; const float* gate;
    __device__ __forceinline__ void operator()(const f32x4 (&acc)[2][2][4][2], const Unit& u, int wr, int wc, int fr, int fq) const {
        asm volatile("" : "+v"(fr), "+v"(fq));
        const int row0 = wr * 64 + fr, colt = u.pn * BM + wc * 32 + 8 * fq;
#pragma unroll
        for (int ai = 0; ai < 2; ++ai)
#pragma unroll
            for (int mp = 0; mp < 2; ++mp) {
                f32x4 gt[2][2][2];
#pragma unroll
                for (int mm = 0; mm < 2; ++mm) { const int r = row0 + ai * HALF + (2 * mp + mm) * 16; const float* g = gate + (size_t)(1 + (r >> 4)) * 12288 + colt;
#pragma unroll
                    for (int bj = 0; bj < 2; ++bj)
#pragma unroll
                        for (int n = 0; n < 2; ++n) gt[mm][bj][n] = *(const f32x4*)(g + bj * HALF + 4 * n); }
#pragma unroll
                for (int mm = 0; mm < 2; ++mm) { const int m = 2 * mp + mm, r = row0 + ai * HALF + m * 16; float* d = slab + ((size_t)u.ks * 256 + r) * 2048 + colt;
#pragma unroll
                    for (int bj = 0; bj < 2; ++bj)
#pragma unroll
                        for (int n = 0; n < 2; ++n) *(f32x4*)(d + bj * HALF + 4 * n) = gt[mm][bj][n] * acc[ai][bj][m][n]; }
                asm volatile("" ::: "memory");
            }
    }
};
template <int CTRL> __device__ __forceinline__ float dppf(float old, float src) { return __builtin_bit_cast(float, __builtin_amdgcn_update_dpp(__builtin_bit_cast(int, old), __builtin_bit_cast(int, src), CTRL, 0xF, 0xF, false)); }
struct EpiUp {
    static constexpr bool PERM = true, AFTER_DRAIN = false;
    bf16_t* ACT; const float* cw; const float* cb; const float* sconv; float* halo; float* conv_p; float* conv_s; PG8_LAS float* hb;
    template <bool SAMP> __device__ __forceinline__ void run(const f32x4 (&acc)[2][2][4][2], const Unit& u, int wr, int wc, int fr, int fq) const {
        asm volatile("" : "+v"(fr), "+v"(fq));
        const int jl = wc * 32 + 8 * fq, j0 = u.pn * HALF + jl;
#pragma unroll
        for (int ai = 0; ai < 2; ++ai) { const int blk = 2 * ai + wr;
            if (!SAMP && fr >= 14) {
                if (blk < 3) { PG8_LAS float* h = hb + ((blk + 1) * 2 + (fr - 14)) * HALF + jl; *(PG8_LAS f32x4*)h = acc[ai][0][3][0]; *(PG8_LAS f32x4*)(h + 4) = acc[ai][0][3][1]; }
                else { float* t = halo + ((size_t)u.pm * 2 + (fr - 14)) * 5632 + j0; *(f32x4*)t = acc[ai][0][3][0]; *(f32x4*)(t + 4) = acc[ai][0][3][1];
                    if (u.pm == 31) { float* c = conv_p + (size_t)(fr - 14) * 5632 + j0; *(f32x4*)c = acc[ai][0][3][0]; *(f32x4*)(c + 4) = acc[ai][0][3][1]; } }
            }
            if (SAMP && fr >= 14) {
#pragma unroll
                for (int m = 0; m < 4; ++m) { const int sb = 8 * ai + 4 * wr + m; float* c = conv_s + ((size_t)sb * 2 + (fr - 14)) * 5632 + j0; *(f32x4*)c = acc[ai][0][m][0]; *(f32x4*)(c + 4) = acc[ai][0][m][1]; }
            }
        }
        asm volatile("s_waitcnt lgkmcnt(0)\n\ts_barrier" ::: "memory");
        f32x4 cwv[2][3], cbv[2];
#pragma unroll
        for (int n = 0; n < 2; ++n) { cwv[n][0] = *(const f32x4*)(cw + j0 + 4 * n); cwv[n][1] = *(const f32x4*)(cw + 5632 + j0 + 4 * n); cwv[n][2] = *(const f32x4*)(cw + 2 * 5632 + j0 + 4 * n); cbv[n] = *(const f32x4*)(cb + j0 + 4 * n); }
#pragma unroll
        for (int ai = 0; ai < 2; ++ai) { const int blk = 2 * ai + wr;
#pragma unroll
            for (int m = 0; m < 4; ++m) { const int r = u.pm * BM + ai * HALF + wr * 64 + m * 16 + fr;
                u32x4 w;
#pragma unroll
                for (int n = 0; n < 2; ++n) {
                    f32x4 pv = (f32x4){0.f, 0.f, 0.f, 0.f};
                    if (SAMP) { if (fr >= 14) { const int sb = 8 * ai + 4 * wr + m; pv = *(const f32x4*)(sconv + ((size_t)sb * 2 + (fr - 14)) * 5632 + j0 + 4 * n); } asm volatile("" : "+v"(pv)); }
                    else if (m == 0) { if (blk > 0 && fr >= 14) pv = *(const PG8_LAS f32x4*)(hb + (blk * 2 + (fr - 14)) * HALF + jl + 4 * n); asm volatile("" : "+v"(pv)); }
                    else pv = acc[ai][0][m > 0 ? m - 1 : 0][n];
                    const f32x4 w0 = cwv[n][0], w1 = cwv[n][1], w2 = cwv[n][2], bb = cbv[n];
                    f32x4 o;
#pragma unroll
                    for (int i = 0; i < 4; ++i) { const float cur = acc[ai][0][m][n][i], pr = pv[i];
                        const float t1 = dppf<0x121>(pr, pr), p1 = dppf<0x111>(t1, cur);
                        const float t2 = dppf<0x122>(pr, pr), p2 = dppf<0x112>(t2, cur);
                        o[i] = bb[i] + w0[i] * p2 + w1[i] * p1 + w2[i] * cur; }
                    const f32x2 g0 = gelu_pk((f32x2){o[0], o[1]}), g1 = gelu_pk((f32x2){o[2], o[3]});
                    const f32x4 uv = acc[ai][1][m][n];
                    const unsigned lo = cvt_pk_bf16(g0.x * uv[0], g0.y * uv[1]), hi = cvt_pk_bf16(g1.x * uv[2], g1.y * uv[3]);
                    if (n == 0) { w.x = lo; w.y = hi; } else { w.z = lo; w.w = hi; }
                }
                const bool head = (!SAMP && u.pm > 0 && blk == 0 && m == 0 && fr < 2);
                if (!head) *(u32x4*)(ACT + (size_t)r * 5632 + j0) = w;
                else { float* hg = halo + (size_t)32 * 2 * 5632 + ((size_t)u.pm * 2 + fr) * 5632 + j0; float* hv = hg + (size_t)32 * 2 * 5632;
                    *(f32x4*)hg = acc[ai][0][m][0]; *(f32x4*)(hg + 4) = acc[ai][0][m][1]; *(f32x4*)hv = acc[ai][1][m][0]; *(f32x4*)(hv + 4) = acc[ai][1][m][1]; }
                asm volatile("" ::: "memory");
            } }
    }
    __device__ __forceinline__ void operator()(const f32x4 (&acc)[2][2][4][2], const Unit& u, int wr, int wc, int fr, int fq) const {
        if (u.pm == 32) run<true>(acc, u, wr, wc, fr, fq); else run<false>(acc, u, wr, wc, fr, fq);
    }
};
}
#include <hip/hip_bf16.h>
#include <cmath>
namespace attn_body {
using bf16=__hip_bfloat16;
using bf16x8=__attribute__((ext_vector_type(8)))short;
using s16x4=__attribute__((ext_vector_type(4)))short;
using f32x16=__attribute__((ext_vector_type(16)))float;
using u32x4=__attribute__((ext_vector_type(4)))unsigned;
constexpr int BATCH=1,NHEAD=16,SEQ=8192,D=64,DM=NHEAD*D;
constexpr int NW=8,QBLK=32,QB=QBLK*NW,KVBLK=64,NQB=SEQ/QB;
constexpr int ATTN_PITCH=DM, ATTN_UNIT_ROWS=QB, OPITCH=2048;
__device__ __forceinline__ int crow(int r,int hi){return (r&3)+8*(r>>2)+4*hi;}
#define SBAR() __builtin_amdgcn_sched_barrier(0)
__device__ __forceinline__ void bmask(f32x16&p0,f32x16&p1,int t,int cq,int qabs,int hi,const __attribute__((address_space(3))) float*lut){
  if(t>cq){
    #pragma unroll
    for(int r=0;r<16;++r){p0[r]=-INFINITY;p1[r]=-INFINITY;}
  } else {
    const int d0=64*t+4*hi-qabs+128;
    #pragma unroll
    for(int r=0;r<16;++r){int i0=d0+(r&3)+8*(r>>2); int i1=i0+32; i0=i0<0?0:i0; i1=i1<0?0:i1; p0[r]+=lut[i0]; p1[r]+=lut[i1];}
  }
}

constexpr int NSLOT=3, SLOTB=8192;
constexpr int LDS_K=0, LDS_V=NSLOT*SLOTB, LDS_WS=2*NSLOT*SLOTB, LDS_OST=LDS_WS+NW*64*4, LDS_BYTES=LDS_OST+NW*4096;
constexpr float C2=0.125f*1.4426950408889634f;
__device__ __forceinline__ void glds16(const void*gsrc,unsigned lds_dst){unsigned keep;
  asm volatile("s_mov_b32 %0, m0\n\ts_mov_b32 m0, %2\n\ts_nop 0\n\tglobal_load_lds_dwordx4 %1, off\n\ts_mov_b32 m0, %0":"=&s"(keep):"v"(gsrc),"s"(lds_dst):"memory");}
__device__ __forceinline__ float max3f(float a,float b,float c){float r;asm("v_max3_f32 %0, %1, %2, %3":"=v"(r):"v"(a),"v"(b),"v"(c));return r;}
__device__ __forceinline__ float max2f(float a,float b){float r;asm("v_max_f32_e32 %0, %1, %2":"=v"(r):"v"(a),"v"(b));return r;}
__device__ __forceinline__ float fadd_s(float a,float b){float r;asm("v_add_f32_e32 %0, %1, %2":"=v"(r):"v"(a),"v"(b));return r;}
__device__ __forceinline__ float fsub_s(float a,float b){float r;asm("v_sub_f32_e32 %0, %1, %2":"=v"(r):"v"(a),"v"(b));return r;}
typedef float f32x2_t __attribute__((ext_vector_type(2))); typedef __bf16 bf16x2_t __attribute__((ext_vector_type(2)));
__device__ __forceinline__ unsigned cvtpk_s(float lo,float hi){f32x2_t v={lo,hi};bf16x2_t b=__builtin_convertvector(v,bf16x2_t);return __builtin_bit_cast(unsigned,b);}
#define WAIT_BAR(N) asm volatile("s_waitcnt vmcnt(" #N ") lgkmcnt(0)\n\ts_barrier":::"memory")

__device__ __forceinline__ void qkt(f32x16&p0,f32x16&p1,const char*Kslot,const bf16x8*qr,const f32x16&negm,int r32,int hi){
  const char*kb=Kslot+hi*1024+r32*16;
  #pragma unroll
  for(int d0=0;d0<4;++d0){
    const bf16x8 b0=*reinterpret_cast<const bf16x8*>(kb+d0*2048);
    const bf16x8 b1=*reinterpret_cast<const bf16x8*>(kb+d0*2048+512);
    if(d0==0){p0=__builtin_amdgcn_mfma_f32_32x32x16_bf16(b0,qr[0],negm,0,0,0);p1=__builtin_amdgcn_mfma_f32_32x32x16_bf16(b1,qr[0],negm,0,0,0);}
    else{p0=__builtin_amdgcn_mfma_f32_32x32x16_bf16(b0,qr[d0],p0,0,0,0);p1=__builtin_amdgcn_mfma_f32_32x32x16_bf16(b1,qr[d0],p1,0,0,0);}}
}
typedef __attribute__((address_space(3))) const char* lds_cptr;
typedef short v4i16_t __attribute__((ext_vector_type(4)));
__device__ __forceinline__ void kload8(bf16x8*kf,lds_cptr kp){
  kf[0]=*(const __attribute__((address_space(3))) bf16x8*)(kp);      kf[1]=*(const __attribute__((address_space(3))) bf16x8*)(kp+512);
  kf[2]=*(const __attribute__((address_space(3))) bf16x8*)(kp+2048); kf[3]=*(const __attribute__((address_space(3))) bf16x8*)(kp+2560);
  kf[4]=*(const __attribute__((address_space(3))) bf16x8*)(kp+4096); kf[5]=*(const __attribute__((address_space(3))) bf16x8*)(kp+4608);
  kf[6]=*(const __attribute__((address_space(3))) bf16x8*)(kp+6144); kf[7]=*(const __attribute__((address_space(3))) bf16x8*)(kp+6656);
}
__device__ __forceinline__ void kload2(bf16x8*kf,lds_cptr kp,int j){ kf[2*j]=*(const __attribute__((address_space(3))) bf16x8*)(kp+j*2048); kf[2*j+1]=*(const __attribute__((address_space(3))) bf16x8*)(kp+j*2048+512); }
__device__ __forceinline__ s16x4 vtr(lds_cptr p){ return __builtin_bit_cast(s16x4,__builtin_amdgcn_ds_read_tr16_b64_v4i16((__attribute__((address_space(3))) v4i16_t*)p)); }
__device__ __forceinline__ float rowmax(const f32x16&p0,const f32x16&p1){
  float a=max3f(p0[0],p0[1],p1[0]),b=max3f(p0[2],p0[3],p1[1]);a=max3f(a,p1[2],p1[3]);
  #pragma unroll
  for(int r=4;r<16;r+=4){a=max3f(a,p0[r],p0[r+1]);b=max3f(b,p0[r+2],p0[r+3]);a=max3f(a,p1[r],p1[r+1]);b=max3f(b,p1[r+2],p1[r+3]);}
  const float m=max2f(a,b);
  const PL32 rr=pl32(m);
  return max2f(rr.a,rr.b);
}
__device__ __forceinline__ void pv(f32x16*o,int vb,bf16x8 pa0,bf16x8 pa1,bf16x8 pa2,bf16x8 pa3){
  #pragma unroll
  for(int d0=0;d0<2;++d0){s16x4 lo[4],hi[4];
    #pragma unroll
    for(int ks=0;ks<4;++ks){
      asm volatile("ds_read_b64_tr_b16 %0,%1 offset:%c2":"=&v"(lo[ks]):"v"(vb),"i"(d0*4096+ks*1024):"memory");
      asm volatile("ds_read_b64_tr_b16 %0,%1 offset:%c2":"=&v"(hi[ks]):"v"(vb),"i"(d0*4096+ks*1024+512):"memory");}
    asm volatile("s_waitcnt lgkmcnt(0)":::"memory");SBAR();
    #define PK(k) (bf16x8){lo[k][0],lo[k][1],lo[k][2],lo[k][3],hi[k][0],hi[k][1],hi[k][2],hi[k][3]}
    o[d0]=__builtin_amdgcn_mfma_f32_32x32x16_bf16(pa0,PK(0),o[d0],0,0,0);
    o[d0]=__builtin_amdgcn_mfma_f32_32x32x16_bf16(pa1,PK(1),o[d0],0,0,0);
    o[d0]=__builtin_amdgcn_mfma_f32_32x32x16_bf16(pa2,PK(2),o[d0],0,0,0);
    o[d0]=__builtin_amdgcn_mfma_f32_32x32x16_bf16(pa3,PK(3),o[d0],0,0,0);
    #undef PK
  }
}

#ifndef ATTN_STORE16
#define ATTN_STORE16(p,v) (*(u32x4*)(p)=(v))
#endif
template<int THRL> __device__ __forceinline__ void attn_unit(int qb,int qkcol,int vcol,int ocol,int hh,const float*__restrict__ reltab,const bf16*Q,const bf16*__restrict__ K,const bf16*__restrict__ V,bf16*O,char*shm,const __attribute__((address_space(3))) float*lut){
  const int b=0;
  int tid_=threadIdx.x; asm volatile("":"+v"(tid_));
  const int tid=tid_,lane=tid&63,r32=lane&31,hi=lane>>5; const int wid=__builtin_amdgcn_readfirstlane(tid>>6);
  const long rowbase=(long)b*SEQ; const int q0=qb*QB;
  const bf16*Qw=Q+(rowbase+q0+wid*QBLK)*DM+qkcol;
  const bf16*Kh=K+rowbase*DM+qkcol,*Vh=V+rowbase*DM+vcol;
  const unsigned lds0=(unsigned)(uintptr_t)shm;
  float*wsf=(float*)(shm+LDS_WS)+wid*64;
  const bf16*ksrc=Kh+(long)lane*DM+wid*8;
  const bf16*vsrc=Vh+(long)(16*(wid&3)+(lane>>2))*DM+(wid>>2)*32+(lane&3)*8;
  const unsigned kdst=lds0+LDS_K+wid*1024, vdst=lds0+LDS_V+wid*1024;
  #define DMA_K(t,slot) glds16(ksrc+(long)(t)*KVBLK*DM,(unsigned)__builtin_amdgcn_readfirstlane(kdst+(slot)))
  #define DMA_V(t,slot) glds16(vsrc+(long)(t)*KVBLK*DM,(unsigned)__builtin_amdgcn_readfirstlane(vdst+(slot)))
  const int vb0=(int)(lds0+LDS_V)+((lane>>4)&1)*32+(lane&3)*8+(4*hi+((lane&15)>>2))*64;
  const char*Kbase=shm+LDS_K; bf16x8 kf[8];
  const lds_cptr shm3=(lds_cptr)shm; const lds_cptr kp0=shm3+LDS_K+hi*1024+r32*16; const lds_cptr vp0=shm3+LDS_V+((lane>>4)&1)*32+(lane&3)*8+(4*hi+((lane&15)>>2))*64;
  const int NT=(q0+QB)/KVBLK;
  const int cq=(q0>>6)+(wid>>1), cqm2=cq-2, qabs=q0+wid*QBLK+r32;
  DMA_K(0,0);DMA_V(0,0);DMA_K(1,SLOTB);
  bf16x8 qr[4];
  #pragma unroll
  for(int d0=0;d0<4;++d0)qr[d0]=*reinterpret_cast<const bf16x8*>(&Qw[(long)r32*DM+d0*16+hi*8]);
  float mhat=0.f,l_reg=0.f;f32x16 o[2];o[0]=f32x16{};o[1]=f32x16{};f32x16 negm=f32x16{};asm volatile("":"+v"(negm));
  const int qrel=wid*QBLK+r32;
  #define CMASK(P0,P1,t) do{ if((t)>=cqm2)bmask(P0,P1,(t),cq,qabs,hi,lut);}while(0)
  bool resc=false;
  #define START(P0,P1) do{ const float rm=rowmax(P0,P1); resc=false; \
    { const float dl=rm; mhat=fadd_s(mhat,dl); \
      _Pragma("unroll") for(int r=0;r<16;++r){P0[r]=fsub_s(P0[r],dl);P1[r]=fsub_s(P1[r],dl);} \
      _Pragma("unroll") for(int r=0;r<16;++r)negm[r]=-mhat; asm volatile("":"+v"(negm)); } \
    _Pragma("unroll") for(int r=0;r<16;++r)P0[r]=__builtin_amdgcn_exp2f(P0[r]); }while(0)
  #define RESC() do{ if(resc){ asm volatile("s_waitcnt lgkmcnt(0)":::"memory"); \
      _Pragma("unroll") for(int d_=0;d_<2;++d_) _Pragma("unroll") for(int r=0;r<16;++r)o[d_][r]*=wsf[crow(r,hi)]; } }while(0)
  f32x16 pA0,pA1,pB0,pB1;
  int sl_prev=0,sl_cur=0,sl_next=SLOTB;
  #define ROT() do{sl_prev=sl_cur;sl_cur=sl_next;sl_next=(sl_next==(NSLOT-1)*SLOTB)?0:sl_next+SLOTB;}while(0)
  DMA_K(2,2*SLOTB);
  WAIT_BAR(3);
  qkt(pA0,pA1,Kbase,qr,negm,r32,hi);asm volatile("s_nop 15\n\ts_nop 7":"+v"(pA0),"+v"(pA1));CMASK(pA0,pA1,0);
  START(pA0,pA1);
  _Pragma("unroll") for(int r=0;r<16;++r)pA1[r]=__builtin_amdgcn_exp2f(pA1[r]);
  WAIT_BAR(0);
  DMA_K(3,0);DMA_V(1,SLOTB);
  ROT();
  kload8(kf,kp0+sl_cur);
  WAIT_BAR(2);
  s16x4 vlo[8],vhi[8]; u32x4 pw0,pw1,pw2,pw3;
  #define PKW(P,B) cvtpk_s(P[B],P[B+1])
  #define PAF(k) __builtin_bit_cast(bf16x8,pw##k)
  #define VFR(i) (bf16x8){vlo[i][0],vlo[i][1],vlo[i][2],vlo[i][3],vhi[i][0],vhi[i][1],vhi[i][2],vhi[i][3]}
  #define PIN(x) asm volatile("":"+v"(x))
  #define MX3(a,b,c) __builtin_fmaxf(__builtin_fmaxf((a),(b)),(c))
  #define GAPA(MF,A0,A1,A2,A3,W0,W1,PW) do{ MF; sacc+=A0; sacc+=A1; sacc+=A2; sacc+=A3; PIN(sacc); W0; W1; PIN(PW); SBAR(); }while(0)
  #define EX(v) __builtin_amdgcn_exp2f(v)
  #define GAPB(MF,X,B) do{ MF; X[B]=EX(X[B]); X[B+1]=EX(X[B+1]); X[B+2]=EX(X[B+2]); X[B+3]=EX(X[B+3]); PIN(X); SBAR(); }while(0)
  #define VRD(i) do{ vlo[i]=vtr(vp_+(((i)>>2)*4096+((i)&3)*1024)); vhi[i]=vtr(vp_+(((i)>>2)*4096+((i)&3)*1024+512)); }while(0)
  #define KRD(G,j) do{ if(G){ kload2(kf,kp0+sl_next,j); SBAR(); } }while(0)
  #define STEP(C0,C1,P0,P1,t,GK,GV,GL) do{ SBAR(); \
    const lds_cptr vp_=vp0+sl_prev; \
    VRD(0); SBAR(); float sacc=(P0[0]+P0[1]); \
    GAPA(C0=__builtin_amdgcn_mfma_f32_32x32x16_bf16(kf[0],qr[0],negm,0,0,0), P0[2],P0[3],P0[4],P0[5],     pw0[0]=PKW(P0,0), pw0[1]=PKW(P0,2), pw0); \
    VRD(4); SBAR(); GAPA(C1=__builtin_amdgcn_mfma_f32_32x32x16_bf16(kf[1],qr[0],negm,0,0,0), P0[6],P0[7],P0[8],P0[9],     pw0[2]=PKW(P0,4), pw0[3]=PKW(P0,6), pw0); \
    VRD(1); SBAR(); GAPA(C0=__builtin_amdgcn_mfma_f32_32x32x16_bf16(kf[2],qr[1],C0,0,0,0),   P0[10],P0[11],P0[12],P0[13], pw1[0]=PKW(P0,8), pw1[1]=PKW(P0,10), pw1); \
    VRD(5); SBAR(); GAPA(C1=__builtin_amdgcn_mfma_f32_32x32x16_bf16(kf[3],qr[1],C1,0,0,0),   P0[14],P0[15],P1[0],P1[1],   pw1[2]=PKW(P0,12),pw1[3]=PKW(P0,14), pw1); \
    VRD(2); SBAR(); GAPA(C0=__builtin_amdgcn_mfma_f32_32x32x16_bf16(kf[4],qr[2],C0,0,0,0),   P1[2],P1[3],P1[4],P1[5],     pw2[0]=PKW(P1,0), pw2[1]=PKW(P1,2), pw2); \
    VRD(6); SBAR(); GAPA(C1=__builtin_amdgcn_mfma_f32_32x32x16_bf16(kf[5],qr[2],C1,0,0,0),   P1[6],P1[7],P1[8],P1[9],     pw2[2]=PKW(P1,4), pw2[3]=PKW(P1,6), pw2); \
    VRD(3); SBAR(); GAPA(C0=__builtin_amdgcn_mfma_f32_32x32x16_bf16(kf[6],qr[3],C0,0,0,0),   P1[10],P1[11],P1[12],P1[13], pw3[0]=PKW(P1,8), pw3[1]=PKW(P1,10), pw3); \
    VRD(7); SBAR(); GAPA(C1=__builtin_amdgcn_mfma_f32_32x32x16_bf16(kf[7],qr[3],C1,0,0,0),   P1[14],P1[15],0.f,0.f,       pw3[2]=PKW(P1,12),pw3[3]=PKW(P1,14), pw3); \
    l_reg+=sacc; \
    if(GK){DMA_K((t)+3,sl_cur);} if(GV){DMA_V((t)+1,sl_next);} \
    CMASK(C0,C1,t); \
    { float a=MX3(C0[0],C0[1],C1[0]),b=MX3(C0[2],C0[3],C1[1]); a=MX3(a,C1[2],C1[3]); \
      _Pragma("unroll") for(int r=4;r<16;r+=4){a=MX3(a,C0[r],C0[r+1]);b=MX3(b,C0[r+2],C0[r+3]);a=MX3(a,C1[r],C1[r+1]);b=MX3(b,C1[r+2],C1[r+3]);} \
      float rm=__builtin_fmaxf(a,b); { const PL32 rr=pl32(rm); rm=__builtin_fmaxf(rr.a,rr.b); } \
      resc=false; \
      if(__builtin_expect(__any(rm>(float)THRL),0)){ const float dl=__builtin_fmaxf(rm,0.f); mhat+=dl; \
        _Pragma("unroll") for(int r=0;r<16;++r){C0[r]-=dl;C1[r]-=dl;} \
        _Pragma("unroll") for(int r=0;r<16;++r)negm[r]=-mhat; asm volatile("":"+v"(negm)); \
        const float f=__builtin_amdgcn_exp2f(-dl); l_reg*=f; if(hi==0)wsf[r32]=f; resc=true; } } \
    SBAR(); \
    GAPB(o[0]=__builtin_amdgcn_mfma_f32_32x32x16_bf16(PAF(0),VFR(0),o[0],0,0,0), C0,0); \
    GAPB(o[1]=__builtin_amdgcn_mfma_f32_32x32x16_bf16(PAF(0),VFR(4),o[1],0,0,0), C0,4); \
    KRD(GL,0); GAPB(o[0]=__builtin_amdgcn_mfma_f32_32x32x16_bf16(PAF(1),VFR(1),o[0],0,0,0), C0,8); \
    KRD(GL,1); GAPB(o[1]=__builtin_amdgcn_mfma_f32_32x32x16_bf16(PAF(1),VFR(5),o[1],0,0,0), C0,12); \
    KRD(GL,2); GAPB(o[0]=__builtin_amdgcn_mfma_f32_32x32x16_bf16(PAF(2),VFR(2),o[0],0,0,0), C1,0); \
    KRD(GL,3); GAPB(o[1]=__builtin_amdgcn_mfma_f32_32x32x16_bf16(PAF(2),VFR(6),o[1],0,0,0), C1,4); \
    GAPB(o[0]=__builtin_amdgcn_mfma_f32_32x32x16_bf16(PAF(3),VFR(3),o[0],0,0,0), C1,8); \
    GAPB(o[1]=__builtin_amdgcn_mfma_f32_32x32x16_bf16(PAF(3),VFR(7),o[1],0,0,0), C1,12); \
    }while(0)
  int t=1;
  #undef CMASK
  #define CMASK(P0,P1,t) do{}while(0)
  for(;t+7<NT;t+=2){
    STEP(pB0,pB1,pA0,pA1,t,true,true,true);     WAIT_BAR(2); RESC(); ROT();
    STEP(pA0,pA1,pB0,pB1,t+1,true,true,true);   WAIT_BAR(2); RESC(); ROT();
  }
  #undef CMASK
  #define CMASK(P0,P1,t) do{ if((t)>=cqm2)bmask(P0,P1,(t),cq,qabs,hi,lut);}while(0)
  #define ENDW(tt) do{ if((tt)+3<NT){WAIT_BAR(2);} else if((tt)+2<NT){WAIT_BAR(1);} else {WAIT_BAR(0);} }while(0)
  for(;t+1<NT;t+=2){
    STEP(pB0,pB1,pA0,pA1,t,(t+3<NT),(t+1<NT),(t+1<NT));       ENDW(t);   RESC(); ROT();
    STEP(pA0,pA1,pB0,pB1,t+1,(t+4<NT),(t+2<NT),(t+2<NT));     ENDW(t+1); RESC(); ROT();
  }
  STEP(pB0,pB1,pA0,pA1,NT-1,false,false,false); RESC();
  { float sacc=pB0[0]+pB0[1]; _Pragma("unroll") for(int r=2;r<16;++r)sacc+=pB0[r]; _Pragma("unroll") for(int r=0;r<16;++r)sacc+=pB1[r]; l_reg+=sacc;
    pw0=(u32x4){PKW(pB0,0),PKW(pB0,2),PKW(pB0,4),PKW(pB0,6)};pw1=(u32x4){PKW(pB0,8),PKW(pB0,10),PKW(pB0,12),PKW(pB0,14)};pw2=(u32x4){PKW(pB1,0),PKW(pB1,2),PKW(pB1,4),PKW(pB1,6)};pw3=(u32x4){PKW(pB1,8),PKW(pB1,10),PKW(pB1,12),PKW(pB1,14)};
    SBAR(); pv(o,vb0+sl_cur,PAF(0),PAF(1),PAF(2),PAF(3)); }
  #undef PKW
  #undef PAF
  #undef VFR
  #undef PIN
  #undef MX3
  #undef GAPA
  #undef GAPB
  #undef EX
  #undef VRD
  #undef KRD
  #undef STEP
  #undef ENDW
  {const PL32 rr=pl32(l_reg);l_reg=rr.a+rr.b;}
  if(hi==0)wsf[32+r32]=l_reg;asm volatile("s_waitcnt lgkmcnt(0)":::"memory");
  float rli[16];
  #pragma unroll
  for(int r=0;r<16;++r)rli[r]=__builtin_amdgcn_rcpf(wsf[32+crow(r,hi)]);
  bf16*Ow=O+(rowbase+q0+wid*QBLK)*(long)OPITCH+ocol;
  { bf16*stg=(bf16*)(shm+LDS_OST)+wid*2048;
    #pragma unroll
    for(int r=0;r<16;++r){const int orow=crow(r,hi);
      #pragma unroll
      for(int d0=0;d0<2;++d0)stg[orow*64+d0*32+r32]=__float2bfloat16(o[d0][r]*rli[r]);}
    asm volatile("s_waitcnt lgkmcnt(0)":::"memory");
    #pragma unroll
    for(int i=0;i<4;++i){const int row=i*8+(lane>>3),ch=lane&7; const u32x4 v=*(const u32x4*)(stg+row*64+ch*8); ATTN_STORE16(Ow+(long)row*OPITCH+ch*8,v);} }
  asm volatile("s_waitcnt lgkmcnt(0)\n\ts_barrier":::"memory");
  #undef DMA_K
  #undef DMA_V
  #undef CMASK
  #undef START
  #undef RESC
  #undef ROT
}
typedef __attribute__((address_space(3))) const char* lds_cp;
__device__ __forceinline__ void qkt_half(f32x16&p,lds_cp Kslot,const bf16x8*qr,const f32x16&negm,int r32,int hi,int kh){
  lds_cp kb=Kslot+hi*1024+(r32+32*kh)*16;
  #pragma unroll
  for(int d0=0;d0<4;++d0){ const bf16x8 b=*(const __attribute__((address_space(3))) bf16x8*)(kb+d0*2048);
    if(d0==0)p=__builtin_amdgcn_mfma_f32_32x32x16_bf16(b,qr[0],negm,0,0,0); else p=__builtin_amdgcn_mfma_f32_32x32x16_bf16(b,qr[d0],p,0,0,0);}
}
__device__ __forceinline__ void pv_half(f32x16*o,int vb,bf16x8 pa0,bf16x8 pa1){
  #pragma unroll
  for(int d0=0;d0<2;++d0){s16x4 lo[2],hi[2];
    #pragma unroll
    for(int ks=0;ks<2;++ks){
      asm volatile("ds_read_b64_tr_b16 %0,%1 offset:%c2":"=&v"(lo[ks]):"v"(vb),"i"(d0*4096+ks*1024):"memory");
      asm volatile("ds_read_b64_tr_b16 %0,%1 offset:%c2":"=&v"(hi[ks]):"v"(vb),"i"(d0*4096+ks*1024+512):"memory");}
    asm volatile("s_waitcnt lgkmcnt(0)":::"memory");SBAR();
    #define PK(k) (bf16x8){lo[k][0],lo[k][1],lo[k][2],lo[k][3],hi[k][0],hi[k][1],hi[k][2],hi[k][3]}
    o[d0]=__builtin_amdgcn_mfma_f32_32x32x16_bf16(pa0,PK(0),o[d0],0,0,0);
    o[d0]=__builtin_amdgcn_mfma_f32_32x32x16_bf16(pa1,PK(1),o[d0],0,0,0);
    #undef PK
  }
}
constexpr int F_SLOTV=2*SLOTB, F_LDS_K=0, F_LDS_V=NSLOT*SLOTB, F_LDS_WS=F_LDS_V+NSLOT*F_SLOTV, F_LDS_OST=F_LDS_WS+NW*64*4, F_LDS_BYTES=F_LDS_OST+4*8192;
__device__ __forceinline__ void bmask1(f32x16&p,int t,int cq,int qabs,int hi,int kh,const __attribute__((address_space(3))) float*lut){
  if(t>cq){
    #pragma unroll
    for(int r=0;r<16;++r)p[r]=-INFINITY;
  } else {
    const int d0=64*t+32*kh+4*hi-qabs+128;
    #pragma unroll
    for(int r=0;r<16;++r){int i0=d0+(r&3)+8*(r>>2); i0=i0<0?0:i0; p[r]+=lut[i0];}
  }
}
template<int THRL> __device__ __forceinline__ void attn_unit_f(int qb,int qkcol,int vcol,int ocol,const bf16*Q,const bf16*__restrict__ K,const bf16*__restrict__ V,bf16*O,char*shm,const __attribute__((address_space(3))) float*lut){
  int tid_=threadIdx.x; asm volatile("":"+v"(tid_));
  const int tid=tid_,lane=tid&63,r32=lane&31,hi=lane>>5; const int wid=__builtin_amdgcn_readfirstlane(tid>>6); const int pr=wid&3,kh=wid>>2;
  const int q0=qb*128;
  const bf16*Qw=Q+(long)(q0+pr*QBLK)*DM+qkcol;
  const bf16*Kh=K+qkcol,*Vh=V+vcol;
  const unsigned lds0=(unsigned)(uintptr_t)shm;
  float*wsf=(float*)(shm+F_LDS_WS)+wid*64;
  const bf16*ksrc=Kh+(long)lane*DM+wid*8;
  const bf16*vsrc=Vh+(long)(16*(wid&3)+(lane>>2))*DM+(wid>>2)*32+(lane&3)*8;
  const unsigned kdst=lds0+F_LDS_K+wid*1024, vdst=lds0+F_LDS_V+wid*1024;
  #define DMA_K(t,slot) glds16(ksrc+(long)(t)*KVBLK*DM,(unsigned)__builtin_amdgcn_readfirstlane(kdst+(slot)))
  #define DMA_V(t,slot) do{ glds16(vsrc+(long)(t)*KVBLK*DM,(unsigned)__builtin_amdgcn_readfirstlane(vdst+2*(slot))); glds16(vsrc+(long)(t)*KVBLK*DM+64,(unsigned)__builtin_amdgcn_readfirstlane(vdst+2*(slot)+8192)); }while(0)
  const int vb0=(int)(lds0+F_LDS_V)+((lane>>4)&1)*32+(lane&3)*8+(4*hi+((lane&15)>>2))*64+kh*2048;
  bf16x8 kf[4];
  const lds_cptr shm3=(lds_cptr)shm; const lds_cptr kp0=shm3+F_LDS_K+hi*1024+r32*16+kh*512; const lds_cptr vp0=shm3+F_LDS_V+((lane>>4)&1)*32+(lane&3)*8+(4*hi+((lane&15)>>2))*64+kh*2048;
  const int NT_=(q0+128)/KVBLK; const int NT=NT_<4?4:NT_;
  const int cq=(q0>>6)+(pr>>1), cqm2=cq-2, qabs=q0+pr*QBLK+r32;
  DMA_K(0,0);DMA_V(0,0);DMA_K(1,SLOTB);
  bf16x8 qr[4];
  #pragma unroll
  for(int d0=0;d0<4;++d0)qr[d0]=*reinterpret_cast<const bf16x8*>(&Qw[(long)r32*DM+d0*16+hi*8]);
  float mhat=0.f,l_reg=0.f;f32x16 o[4];o[0]=f32x16{};o[1]=f32x16{};o[2]=f32x16{};o[3]=f32x16{};f32x16 negm=f32x16{};asm volatile("":"+v"(negm));
  #define CMASK(P,t) do{ if((t)>=cqm2)bmask1(P,(t),cq,qabs,hi,kh,lut);}while(0)
  bool resc=false;
  #define RESC() do{ if(resc){ asm volatile("s_waitcnt lgkmcnt(0)":::"memory"); \
      _Pragma("unroll") for(int d_=0;d_<4;++d_) _Pragma("unroll") for(int r=0;r<16;++r)o[d_][r]*=wsf[crow(r,hi)]; } }while(0)
  f32x16 pA,pB;
  int sl_prev=0,sl_cur=0,sl_next=SLOTB;
  #define ROT() do{sl_prev=sl_cur;sl_cur=sl_next;sl_next=(sl_next==(NSLOT-1)*SLOTB)?0:sl_next+SLOTB;}while(0)
  DMA_K(2,2*SLOTB);
  WAIT_BAR(4);
  qkt_half(pA,(lds_cp)(shm3+F_LDS_K),qr,negm,r32,hi,kh);asm volatile("s_nop 15\n\ts_nop 7":"+v"(pA));CMASK(pA,0);
  { float a=max3f(pA[0],pA[1],pA[2]),b=max3f(pA[3],pA[4],pA[5]);a=max3f(a,pA[6],pA[7]);b=max3f(b,pA[8],pA[9]);a=max3f(a,pA[10],pA[11]);b=max3f(b,pA[12],pA[13]);a=max3f(a,pA[14],pA[15]);
    const float m=max2f(a,b); const PL32 rr=pl32(m); const float dl=max2f(rr.a,rr.b); mhat=fadd_s(mhat,dl);
    _Pragma("unroll") for(int r=0;r<16;++r)pA[r]=fsub_s(pA[r],dl);
    _Pragma("unroll") for(int r=0;r<16;++r)negm[r]=-mhat; asm volatile("":"+v"(negm));
    _Pragma("unroll") for(int r=0;r<16;++r)pA[r]=__builtin_amdgcn_exp2f(pA[r]); }
  WAIT_BAR(0);
  DMA_K(3,0);DMA_V(1,SLOTB);
  ROT();
  _Pragma("unroll") for(int j=0;j<4;++j)kf[j]=*(const __attribute__((address_space(3))) bf16x8*)(kp0+sl_cur+j*2048);
  WAIT_BAR(3);
  s16x4 vlo[8],vhi[8]; u32x4 pwa,pwb;
  #define PKW(P,B) cvtpk_s(P[B],P[B+1])
  #define PAFA __builtin_bit_cast(bf16x8,pwa)
  #define PAFB __builtin_bit_cast(bf16x8,pwb)
  #define VFR(i) (bf16x8){vlo[i][0],vlo[i][1],vlo[i][2],vlo[i][3],vhi[i][0],vhi[i][1],vhi[i][2],vhi[i][3]}
  #define PIN(x) asm volatile("":"+v"(x))
  #define MX3(a,b,c) __builtin_fmaxf(__builtin_fmaxf((a),(b)),(c))
  #define GAPA(MF,A0,A1,A2,A3,W0,W1,PW) do{ MF; sacc+=A0; sacc+=A1; sacc+=A2; sacc+=A3; PIN(sacc); W0; W1; PIN(PW); SBAR(); }while(0)
  #define EX(v) __builtin_amdgcn_exp2f(v)
  #define GAPB(MF,X,B) do{ MF; X[B]=EX(X[B]); X[B+1]=EX(X[B+1]); PIN(X); SBAR(); }while(0)
  #define VRD(i) do{ vlo[i]=vtr(vp_+(((i)>>1)*4096+((i)&1)*1024)); vhi[i]=vtr(vp_+(((i)>>1)*4096+((i)&1)*1024+512)); }while(0)
  #define KRD(G,j) do{ if(G){ kf[j]=*(const __attribute__((address_space(3))) bf16x8*)(kp0+sl_next+(j)*2048); SBAR(); } }while(0)
  #define STEPF(C,P,t,GK,GV,GL) do{ SBAR(); \
    const lds_cptr vp_=vp0+2*sl_prev; \
    VRD(0); VRD(2); SBAR(); float sacc=(P[0]+P[1]); \
    GAPA(C=__builtin_amdgcn_mfma_f32_32x32x16_bf16(kf[0],qr[0],negm,0,0,0), P[2],P[3],P[4],P[5],     pwa[0]=PKW(P,0), pwa[1]=PKW(P,2), pwa); \
    VRD(4); VRD(6); SBAR(); GAPA(C=__builtin_amdgcn_mfma_f32_32x32x16_bf16(kf[1],qr[1],C,0,0,0), P[6],P[7],P[8],P[9],     pwa[2]=PKW(P,4), pwa[3]=PKW(P,6), pwa); \
    VRD(1); VRD(3); SBAR(); GAPA(C=__builtin_amdgcn_mfma_f32_32x32x16_bf16(kf[2],qr[2],C,0,0,0), P[10],P[11],P[12],P[13], pwb[0]=PKW(P,8), pwb[1]=PKW(P,10), pwb); \
    VRD(5); VRD(7); SBAR(); GAPA(C=__builtin_amdgcn_mfma_f32_32x32x16_bf16(kf[3],qr[3],C,0,0,0), P[14],P[15],0.f,0.f,     pwb[2]=PKW(P,12),pwb[3]=PKW(P,14), pwb); \
    l_reg+=sacc; \
    if(GK){DMA_K((t)+3,sl_cur);} if(GV){DMA_V((t)+1,sl_next);} \
    CMASK(C,t); \
    { float a=MX3(C[0],C[1],C[2]),b=MX3(C[3],C[4],C[5]); a=MX3(a,C[6],C[7]); b=MX3(b,C[8],C[9]); a=MX3(a,C[10],C[11]); b=MX3(b,C[12],C[13]); a=MX3(a,C[14],C[15]); \
      float rm=__builtin_fmaxf(a,b); { const PL32 rr=pl32(rm); rm=__builtin_fmaxf(rr.a,rr.b); } \
      resc=false; \
      if(__builtin_expect(__any(rm>(float)THRL),0)){ const float dl=__builtin_fmaxf(rm,0.f); mhat+=dl; \
        _Pragma("unroll") for(int r=0;r<16;++r)C[r]-=dl; \
        _Pragma("unroll") for(int r=0;r<16;++r)negm[r]=-mhat; asm volatile("":"+v"(negm)); \
        const float f=__builtin_amdgcn_exp2f(-dl); l_reg*=f; if(hi==0)wsf[r32]=f; resc=true; } } \
    SBAR(); \
    GAPB(o[0]=__builtin_amdgcn_mfma_f32_32x32x16_bf16(PAFA,VFR(0),o[0],0,0,0), C,0); \
    GAPB(o[1]=__builtin_amdgcn_mfma_f32_32x32x16_bf16(PAFA,VFR(2),o[1],0,0,0), C,2); \
    KRD(GL,0); GAPB(o[2]=__builtin_amdgcn_mfma_f32_32x32x16_bf16(PAFA,VFR(4),o[2],0,0,0), C,4); \
    KRD(GL,1); GAPB(o[3]=__builtin_amdgcn_mfma_f32_32x32x16_bf16(PAFA,VFR(6),o[3],0,0,0), C,6); \
    KRD(GL,2); GAPB(o[0]=__builtin_amdgcn_mfma_f32_32x32x16_bf16(PAFB,VFR(1),o[0],0,0,0), C,8); \
    KRD(GL,3); GAPB(o[1]=__builtin_amdgcn_mfma_f32_32x32x16_bf16(PAFB,VFR(3),o[1],0,0,0), C,10); \
    GAPB(o[2]=__builtin_amdgcn_mfma_f32_32x32x16_bf16(PAFB,VFR(5),o[2],0,0,0), C,12); \
    GAPB(o[3]=__builtin_amdgcn_mfma_f32_32x32x16_bf16(PAFB,VFR(7),o[3],0,0,0), C,14); \
    }while(0)
  int t=1;
  #undef CMASK
  #define CMASK(P,t) do{}while(0)
  asm volatile(".p2align 8":::"memory");
  for(;t+7<NT;t+=2){
    STEPF(pB,pA,t,true,true,true);     WAIT_BAR(3); RESC(); ROT();
    STEPF(pA,pB,t+1,true,true,true);   WAIT_BAR(3); RESC(); ROT();
  }
  #undef CMASK
  #define CMASK(P,t) do{ if((t)>=cqm2)bmask1(P,(t),cq,qabs,hi,kh,lut);}while(0)
  #define ENDW(tt) do{ if((tt)+3<NT){WAIT_BAR(3);} else if((tt)+2<NT){WAIT_BAR(2);} else {WAIT_BAR(0);} }while(0)
  for(;t+1<NT;t+=2){
    STEPF(pB,pA,t,(t+3<NT),(t+1<NT),(t+1<NT));       ENDW(t);   RESC(); ROT();
    STEPF(pA,pB,t+1,(t+4<NT),(t+2<NT),(t+2<NT));     ENDW(t+1); RESC(); ROT();
  }
  STEPF(pB,pA,NT-1,false,false,false); RESC();
  { float sacc=pB[0]+pB[1]; _Pragma("unroll") for(int r=2;r<16;++r)sacc+=pB[r]; l_reg+=sacc;
    pwa=(u32x4){PKW(pB,0),PKW(pB,2),PKW(pB,4),PKW(pB,6)};pwb=(u32x4){PKW(pB,8),PKW(pB,10),PKW(pB,12),PKW(pB,14)};
    SBAR();
    const int vb=vb0+2*sl_cur;
    #pragma unroll
    for(int d0=0;d0<4;++d0){s16x4 lo[2],hi_[2];
      #pragma unroll
      for(int ks=0;ks<2;++ks){
        asm volatile("ds_read_b64_tr_b16 %0,%1 offset:%c2":"=&v"(lo[ks]):"v"(vb),"i"(d0*4096+ks*1024):"memory");
        asm volatile("ds_read_b64_tr_b16 %0,%1 offset:%c2":"=&v"(hi_[ks]):"v"(vb),"i"(d0*4096+ks*1024+512):"memory");}
      asm volatile("s_waitcnt lgkmcnt(0)":::"memory");SBAR();
      #define PK(k) (bf16x8){lo[k][0],lo[k][1],lo[k][2],lo[k][3],hi_[k][0],hi_[k][1],hi_[k][2],hi_[k][3]}
      o[d0]=__builtin_amdgcn_mfma_f32_32x32x16_bf16(PAFA,PK(0),o[d0],0,0,0);
      o[d0]=__builtin_amdgcn_mfma_f32_32x32x16_bf16(PAFB,PK(1),o[d0],0,0,0);
      #undef PK
    } }
  #undef PKW
  #undef PAFA
  #undef PAFB
  #undef VFR
  #undef PIN
  #undef MX3
  #undef GAPA
  #undef GAPB
  #undef EX
  #undef VRD
  #undef KRD
  #undef STEPF
  #undef ENDW
  {const PL32 rr=pl32(l_reg);l_reg=rr.a+rr.b;}
  asm volatile("s_waitcnt lgkmcnt(0)\n\ts_barrier":::"memory");
  float*OG=(float*)shm+pr*4096;
  if(kh==1){ if(hi==0){wsf[r32]=mhat;wsf[32+r32]=l_reg;}
    #pragma unroll
    for(int d_=0;d_<4;++d_)
      #pragma unroll
      for(int r=0;r<16;++r)OG[(d_*16+r)*64+lane]=o[d_][r]; }
  asm volatile("s_waitcnt lgkmcnt(0)\n\ts_barrier":::"memory");
  if(kh==0){ const float*w1=(const float*)(shm+F_LDS_WS)+(wid+4)*64; const float m2=w1[r32],l2=w1[32+r32]; const float M=__builtin_fmaxf(mhat,m2);
    const float f1=__builtin_amdgcn_exp2f(mhat-M),f2=__builtin_amdgcn_exp2f(m2-M); const float inv=__builtin_amdgcn_rcpf(l_reg*f1+l2*f2);
    if(hi==0){wsf[r32]=f1*inv;wsf[32+r32]=f2*inv;}
    asm volatile("s_waitcnt lgkmcnt(0)":::"memory");
    bf16*stg=(bf16*)(shm+F_LDS_OST)+pr*4096;
    #pragma unroll
    for(int r=0;r<16;++r){const int orow=crow(r,hi); const float g1=wsf[orow],g2=wsf[32+orow];
      #pragma unroll
      for(int d_=0;d_<4;++d_)stg[orow*128+d_*32+r32]=__float2bfloat16(o[d_][r]*g1+OG[(d_*16+r)*64+lane]*g2);}
    asm volatile("s_waitcnt lgkmcnt(0)":::"memory");
    bf16*Ow=O+(long)(q0+pr*QBLK)*(long)OPITCH+ocol;
    #pragma unroll
    for(int i=0;i<8;++i){const int row=i*4+(lane>>4),ch=lane&15; const u32x4 v=*(const u32x4*)(stg+row*128+ch*8); ATTN_STORE16(Ow+(long)row*OPITCH+ch*8,v);} }
  asm volatile("s_waitcnt lgkmcnt(0)\n\ts_barrier":::"memory");
  #undef DMA_K
  #undef DMA_V
  #undef CMASK
  #undef RESC
  #undef ROT
}
constexpr int ATTN_LDS_BYTES=LDS_BYTES;
#undef SBAR
#undef WAIT_BAR
}
#define XB_TMO      128
#define XB_XCNT(j)  (256  + 64 * (j))
#define XB_XSUB(j)  (1280 + 64 * (j))
#define XB_XGEN(j)  (2304 + 64 * (j))
#define XB_TOP      3328
#define XB_TOPGEN   3392
#define XCD_BAR_WORDS 3456
#define XB_SPIN_CAP (1u << 18)

__device__ __forceinline__ unsigned xb_ld(unsigned* p)              { return __hip_atomic_load(p, __ATOMIC_RELAXED, __HIP_MEMORY_SCOPE_AGENT); }
__device__ __forceinline__ unsigned xb_add(unsigned* p, unsigned v) { return __hip_atomic_fetch_add(p, v, __ATOMIC_RELAXED, __HIP_MEMORY_SCOPE_AGENT); }
__device__ __forceinline__ unsigned xb_xcc_id() { return (unsigned)__builtin_amdgcn_s_getreg((3 << 11) | 20) & 0xFu; }
#define XB_SPIN(cond, bar) do { unsigned _sp = 0; while (cond) { __builtin_amdgcn_s_sleep(1); \
    if ((++_sp & 255u) == 0u) { if (xb_ld(&(bar)[XB_TMO])) break; if (_sp > XB_SPIN_CAP) { atomicAdd(&(bar)[XB_TMO], 1u); break; } } } } while (0)

struct XcdBarrier {
    unsigned* bar; unsigned x;
    volatile LAS unsigned* st;
};

__device__ __forceinline__ XcdBarrier xcd_barrier_post(unsigned* bar, volatile LAS unsigned* st) {
    XcdBarrier b; b.bar = bar; b.x = xb_xcc_id(); b.st = st;
    if (threadIdx.x == 0) (void)xb_add(&bar[XB_XCNT(b.x)], 1u);
    return b;
}
__device__ __forceinline__ void xcd_barrier_complete(unsigned* bar, unsigned x, unsigned& nloc, unsigned& nx) {
    const unsigned G = gridDim.x * gridDim.y * gridDim.z;
    unsigned sum, cnt, mine, sp = 0u;
    for (;;) {
        sum = 0u; cnt = 0u; mine = 0u;
#pragma unroll
        for (unsigned j = 0; j < 16; ++j) { const unsigned c = xb_ld(&bar[XB_XCNT(j)]); sum += c; cnt += (c > 0u) ? 1u : 0u; mine = (j == x) ? c : mine; }
        if (sum == G) break;
        __builtin_amdgcn_s_sleep(1);
        if ((++sp & 255u) == 0u) { if (xb_ld(&bar[XB_TMO])) break; if (sp > XB_SPIN_CAP) { atomicAdd(&bar[XB_TMO], 1u); break; } }
    }
    nloc = mine > 0u ? mine : 1u; nx = cnt > 0u ? cnt : 1u;
}

__device__ __forceinline__ void xcd_barrier(const XcdBarrier& b) {
    asm volatile("s_waitcnt vmcnt(0)" ::: "memory");
    __syncthreads();
    if (threadIdx.x == 0) {
        unsigned* bar = b.bar;
        __builtin_amdgcn_s_waitcnt(0);
        unsigned nloc = b.st[0], nx = b.st[1];
        if (nloc == 0u) { xcd_barrier_complete(bar, b.x, nloc, nx); b.st[0] = nloc; b.st[1] = nx; }
        const unsigned old = xb_add(&bar[XB_XSUB(b.x)], 1u);
        const unsigned gen = old / nloc;
        if (old + 1u == (gen + 1u) * nloc) {
            __builtin_amdgcn_fence(__ATOMIC_RELEASE, "agent");
            asm volatile("s_waitcnt vmcnt(0)" ::: "memory");
            const unsigned og = xb_add(&bar[XB_TOP], 1u);
            const unsigned tg = og / nx;
            if (og + 1u == (tg + 1u) * nx) xb_add(&bar[XB_TOPGEN], 1u);
            else XB_SPIN(xb_ld(&bar[XB_TOPGEN]) == tg, bar);
            __builtin_amdgcn_fence(__ATOMIC_ACQUIRE, "agent");
            xb_add(&bar[XB_XGEN(b.x)], 1u);
            asm volatile("s_waitcnt vmcnt(0)" ::: "memory");
        } else {
            XB_SPIN(xb_ld(&bar[XB_XGEN(b.x)]) == gen, bar);
            __builtin_amdgcn_fence(__ATOMIC_ACQUIRE, "agent");
            asm volatile("s_waitcnt vmcnt(0)" ::: "memory");
        }
    }
    __syncthreads();
}
struct Args { const float* in[37]; float* out; unsigned char* ws; int ph_lo, ph_hi; };
struct Frame { LAS unsigned char* lds; volatile LAS unsigned* MISC; gu32* ctl; int tid, lane, wave, G, bid; };
typedef __attribute__((address_space(4))) const Args* ArgsP;
__device__ __forceinline__ ArgsP get_args() { ArgsP p = (ArgsP)__builtin_amdgcn_kernarg_segment_ptr(); asm volatile("" : "+s"(p)); return p; }
#define PHASE_ENTRY() ArgsP A = get_args(); { int t_ = threadIdx.x; asm volatile("" : "+v"(t_)); F.tid = t_; F.lane = t_ & 63; F.wave = __builtin_amdgcn_readfirstlane(t_ >> 6); F.ctl = (gu32*)(A->ws + WS_CTL); }
enum InIdx { I_XP = 0, I_XS, I_CP, I_CS, I_CK, I_CV, I_SWKV, I_SSHIFT, I_SCONV, I_WADA, I_BADA, I_GMIX, I_GFFN, I_WIN, I_WOUT, I_MU, I_W0, I_W2, I_A0, I_A2, I_G2, I_KK, I_KA, I_RK, I_LNW, I_LNB,
             I_LQ1, I_LK1, I_LQ2, I_LK2, I_SUBLN, I_REL, I_FUP, I_CONVW, I_CONVB, I_FDN, I_GFIN };

__device__ __forceinline__ void transpose_item(const float* W, int K, int N, bf16* WT, int dest_row0, LAS float* scr, int kb, int n0, int lane) {
    const int k0 = 64 * kb;
    { f32x4 t[8];
#pragma unroll
      for (int i = 0; i < 8; ++i) t[i] = __builtin_nontemporal_load((const GAS f32x4*)(W + (size_t)(k0 + 8 * i + (lane >> 3)) * N + n0 + 4 * (lane & 7)));
#pragma unroll
      for (int i = 0; i < 8; ++i) { LAS float* d = scr + (8 * i + (lane >> 3)) * 33 + 4 * (lane & 7); d[0] = t[i][0]; d[1] = t[i][1]; d[2] = t[i][2]; d[3] = t[i][3]; } }
    LDS_WAIT(); asm volatile("" ::: "memory");
    const int c = lane & 7;
#pragma unroll
    for (int j = 0; j < 4; ++j) { const int n = (lane >> 3) + 8 * j; const LAS float* s = scr + (8 * c) * 33 + n;
        v4u o; o.x = pk2(s[0 * 33], s[1 * 33]); o.y = pk2(s[2 * 33], s[3 * 33]); o.z = pk2(s[4 * 33], s[5 * 33]); o.w = pk2(s[6 * 33], s[7 * 33]);
        *(GAS v4u*)(WT + (size_t)(dest_row0 + n) * K + k0 + 8 * c) = o; }
    LDS_WAIT(); asm volatile("" ::: "memory");
}
__device__ __forceinline__ void ph_prologue(Frame& F) {
    PHASE_ENTRY();
    unsigned char* ws = A->ws;
    if (F.bid < 192) {
        const int l = F.bid / 96, j0 = (F.bid % 96) * 128;
        LAS float* ST = (LAS float*)F.lds;
        const float* Wl = A->in[I_WADA] + (size_t)l * DMOD * MODW;
        float acc[NMODB][2];
#pragma unroll
        for (int b = 0; b < NMODB; ++b) { acc[b][0] = 0.f; acc[b][1] = 0.f; }
        for (int kh = 0; kh < 2; ++kh) {
            __syncthreads();
            for (int idx = F.tid; idx < 1024 * NMODB; idx += NWAVES * 64) { const int kk = idx / NMODB, b = idx % NMODB;
                const float c = (b == 0) ? A->in[I_CP][kh * 1024 + kk] : A->in[I_CS][(size_t)(b - 1) * DMOD + kh * 1024 + kk];
                ST[kk * 20 + b] = c / (1.f + __expf(-c)); }
            __syncthreads();
#pragma unroll 4
            for (int k = 0; k < 128; ++k) { const int kk = F.wave * 128 + k;
                const f32x2 w = __builtin_nontemporal_load((const GAS f32x2*)(Wl + (size_t)(kh * 1024 + kk) * MODW + j0 + 2 * F.lane));
                const LAS f32x4* sp = (const LAS f32x4*)(ST + kk * 20);
                const f32x4 s0 = sp[0], s1 = sp[1], s2 = sp[2], s3 = sp[3]; const float s16 = ST[kk * 20 + 16];
#pragma unroll
                for (int b = 0; b < 4; ++b) { acc[b][0] += s0[b] * w.x; acc[b][1] += s0[b] * w.y; acc[4 + b][0] += s1[b] * w.x; acc[4 + b][1] += s1[b] * w.y;
                    acc[8 + b][0] += s2[b] * w.x; acc[8 + b][1] += s2[b] * w.y; acc[12 + b][0] += s3[b] * w.x; acc[12 + b][1] += s3[b] * w.y; }
                acc[16][0] += s16 * w.x; acc[16][1] += s16 * w.y; }
        }
        __syncthreads();
        LAS float* RED = (LAS float*)F.lds;
#pragma unroll
        for (int b = 0; b < NMODB; ++b) { RED[(F.wave * NMODB + b) * 128 + 2 * F.lane] = acc[b][0]; RED[(F.wave * NMODB + b) * 128 + 2 * F.lane + 1] = acc[b][1]; }
        __syncthreads();
        float* MOD = (float*)(ws + WS_MOD);
        for (int idx = F.tid; idx < NMODB * 128; idx += NWAVES * 64) { const int b = idx >> 7, j = idx & 127; float s = 0.f;
#pragma unroll
            for (int w = 0; w < 8; ++w) s += RED[(w * NMODB + b) * 128 + j];
            MOD[(size_t)(l * NMODB + b) * MODW + j0 + j] = s + A->in[I_BADA][(size_t)l * MODW + j0 + j]; }
        __syncthreads();
    }
    { const int gt = F.bid * (NWAVES * 64) + F.tid, ngt = F.G * NWAVES * 64;
      for (int idx = gt; idx < NLAYER * 56 * 1024; idx += ngt) { const int l = idx / (56 * 1024), rem = idx % (56 * 1024), ch = rem >> 10, j = rem & 1023;
          const float* src; bf16* dst; int k0;
          bf16* LB = (bf16*)(ws + WS_LORA + (size_t)l * LORA_LAYER);
          if (ch < 12) { k0 = 8 * ch; src = A->in[I_W2] + ((size_t)l * 96 + k0) * 1024 + j; dst = LB + (size_t)j * 96 + k0; }
          else if (ch < 24) { k0 = 8 * (ch - 12); src = A->in[I_A2] + ((size_t)l * 96 + k0) * 1024 + j; dst = LB + (size_t)1024 * 96 + (size_t)j * 96 + k0; }
          else { k0 = 8 * (ch - 24); src = A->in[I_G2] + ((size_t)l * 256 + k0) * 1024 + j; dst = LB + (size_t)2 * 1024 * 96 + (size_t)j * 256 + k0; }
          v4u o; o.x = pk2(src[0], src[1024]); o.y = pk2(src[2048], src[3072]); o.z = pk2(src[4096], src[5120]); o.w = pk2(src[6144], src[7168]);
          *(GAS v4u*)dst = o; }
      for (int idx = gt; idx < NLAYER * 64 * DMOD / 8; idx += ngt) { const int l = idx / (64 * DMOD / 8), rem = idx % (64 * DMOD / 8);
          *(GAS v4u*)((bf16*)(ws + WS_WIN) + (size_t)l * NIN_PAD * DMOD + (size_t)NRC * DMOD + (size_t)rem * 8) = (v4u){0u, 0u, 0u, 0u}; }
    }
    __syncthreads();
    LAS float* scr = (LAS float*)(F.lds + F.wave * 16384);
    const int gw = F.bid * NWAVES + F.wave, NGW = F.G * NWAVES;
    constexpr int IT_IN = 32 * (NIN / 32), IT_OUT = 32 * 64, IT_UP = 32 * (NUP / 32), IT_DN = (DFF / 64) * 64, IT_L = IT_IN + IT_OUT + IT_UP + IT_DN;
    for (int it = gw; it < NLAYER * IT_L; it += NGW) {
        const int l = it / IT_L; int r = it % IT_L;
        if (r < IT_IN) { const int nb = r % (NIN / 32), kb = r / (NIN / 32), n0 = 32 * nb;
            transpose_item(A->in[I_WIN] + (size_t)l * DMOD * NIN, DMOD, NIN, (bf16*)(ws + WS_WIN) + (size_t)l * NIN_PAD * DMOD, n0 < NRC ? n0 : n0 + 64, scr, kb, n0, F.lane); continue; }
        r -= IT_IN;
        if (r < IT_OUT) { const int nb = r % 64, kb = r / 64;
            transpose_item(A->in[I_WOUT] + (size_t)l * DMOD * DMOD, DMOD, DMOD, (bf16*)(ws + WS_WOUT) + (size_t)l * DMOD * DMOD, 32 * nb, scr, kb, 32 * nb, F.lane); continue; }
        r -= IT_OUT;
        if (r < IT_UP) { const int nb = r % (NUP / 32), kb = r / (NUP / 32), n0 = 32 * nb; const int j = n0 < DFF ? n0 : n0 - DFF;
            const int dr = (j >> 7) * 256 + (n0 < DFF ? 0 : 128) + (j & 127);
            transpose_item(A->in[I_FUP] + (size_t)l * DMOD * NUP, DMOD, NUP, (bf16*)(ws + WS_WUP) + (size_t)l * NUP * DMOD, dr, scr, kb, n0, F.lane); continue; }
        r -= IT_UP;
        { const int nb = r % 64, kb = r / 64;
            transpose_item(A->in[I_FDN] + (size_t)l * DFF * DMOD, DFF, DMOD, (bf16*)(ws + WS_WDN) + (size_t)l * DMOD * DFF, 32 * nb, scr, kb, 32 * nb, F.lane); }
    }
}

__device__ __forceinline__ void ph_norm(Frame& F, int l, int mode, int nslab) {
    PHASE_ENTRY();
    const int gw = F.bid * NWAVES + F.wave, NGW = F.G * NWAVES;
    const float* X = (const float*)(A->ws + WS_X); bf16* H = (bf16*)(A->ws + WS_H);
    const float* g = (mode == 0 ? A->in[I_GMIX] + (size_t)l * DMOD : mode == 1 ? A->in[I_GFFN] + (size_t)l * DMOD : A->in[I_GFIN]);
    f32x4 gv[8];
#pragma unroll
    for (int j = 0; j < 8; ++j) gv[j] = *(const GAS f32x4*)(g + 4 * F.lane + 256 * j);
    for (int m = gw; m < MT; m += NGW) {
        const float* xr = (mode == 0 && l == 0) ? (m < MP ? A->in[I_XP] + (size_t)m * DMOD : A->in[I_XS] + (size_t)(m - MP) * DMOD) : X + (size_t)m * DMOD;
        f32x4 v[8]; float ss = 0.f;
#pragma unroll
        for (int j = 0; j < 8; ++j) v[j] = *(const GAS f32x4*)(xr + 4 * F.lane + 256 * j);
        f32x4 shv[8], scv[8];
        if (mode < 2) { const int bidx0 = m < MP ? 0 : 1 + ((m - MP) >> 4);
            const float* mod0 = (const float*)(A->ws + WS_MOD) + (size_t)(l * NMODB + bidx0) * MODW + (mode == 0 ? 0 : 3 * DMOD);
#pragma unroll
            for (int j = 0; j < 8; ++j) { shv[j] = *(const GAS f32x4*)(mod0 + 4 * F.lane + 256 * j); scv[j] = *(const GAS f32x4*)(mod0 + DMOD + 4 * F.lane + 256 * j); } }
        if (m >= MP && nslab > 0) { const float* sl = (const float*)(A->ws + WS_SLAB) + (size_t)(m - MP) * DMOD;
            for (int s = 0; s < nslab; ++s)
#pragma unroll
                for (int j = 0; j < 8; ++j) v[j] += *(const GAS f32x4*)(sl + (size_t)s * 256 * DMOD + 4 * F.lane + 256 * j);
            if (mode < 2) { float* xw = (float*)(A->ws + WS_X) + (size_t)m * DMOD;
#pragma unroll
                for (int j = 0; j < 8; ++j) *(GAS f32x4*)(xw + 4 * F.lane + 256 * j) = v[j]; } }
#pragma unroll
        for (int j = 0; j < 8; ++j) ss += (v[j].x * v[j].x + v[j].y * v[j].y) + (v[j].z * v[j].z + v[j].w * v[j].w);
        const float rstd = 1.f / sqrtf(wave_sum(ss) * (1.f / DMOD) + 1e-6f);
        if (mode < 2) {
            const int bidx = m < MP ? 0 : 1 + ((m - MP) >> 4);
            const float* mod = (const float*)(A->ws + WS_MOD) + (size_t)(l * NMODB + bidx) * MODW + (mode == 0 ? 0 : 3 * DMOD);
            GAS unsigned long long* o8 = (GAS unsigned long long*)(H + (size_t)m * DMOD) + F.lane;
#pragma unroll
            for (int j = 0; j < 8; ++j) { const f32x4 sh = shv[j], sc = scv[j];
                const f32x4 y = (v[j] * rstd * gv[j]) * (sc + 1.0f) + sh;
                o8[64 * j] = (unsigned long long)pk2(y.x, y.y) | ((unsigned long long)pk2(y.z, y.w) << 32); }
        } else {
            float* o = (m < MP) ? A->out + O_YP + (size_t)m * DMOD : A->out + O_YS + (size_t)(m - MP) * DMOD;
#pragma unroll
            for (int j = 0; j < 8; ++j) __builtin_nontemporal_store(v[j] * rstd * gv[j], (GAS f32x4*)(o + 4 * F.lane + 256 * j));
        }
    }
}
typedef float f32x4m __attribute__((ext_vector_type(4)));
__device__ __forceinline__ void mm_tiles(f32x4 (&acc)[2], const LAS unsigned char* X, const LAS unsigned char* Y, int wave, int lane) {
    const int mt = wave >> 1, nt0 = 2 * (wave & 1), c = lane & 15, q = lane >> 4;
    const LAS unsigned char* xp = X + (16 * mt + c) * 144 + q * 16;
    const bf16x8 x0 = *(const LAS bf16x8*)xp, x1 = *(const LAS bf16x8*)(xp + 64);
#pragma unroll
    for (int t = 0; t < 2; ++t) { const LAS unsigned char* yp = Y + (16 * (nt0 + t) + c) * 144 + q * 16;
        const bf16x8 y0 = *(const LAS bf16x8*)yp, y1 = *(const LAS bf16x8*)(yp + 64);
        acc[t] = __builtin_amdgcn_mfma_f32_16x16x32_bf16(y0, x0, acc[t], 0, 0, 0);
        acc[t] = __builtin_amdgcn_mfma_f32_16x16x32_bf16(y1, x1, acc[t], 0, 0, 0); }
}
__device__ __forceinline__ void st_tiles(LAS unsigned char* D, const f32x4 (&acc)[2], int wave, int lane) {
    const int mt = wave >> 1, nt0 = 2 * (wave & 1), c = lane & 15, q = lane >> 4;
#pragma unroll
    for (int t = 0; t < 2; ++t) { v2u w; w.x = pk2(acc[t][0], acc[t][1]); w.y = pk2(acc[t][2], acc[t][3]); *(LAS v2u*)(D + (16 * mt + c) * 144 + (16 * (nt0 + t) + 4 * q) * 2) = w; }
}
#define RW_ZERO(a) do { a[0] = (f32x4){0.f, 0.f, 0.f, 0.f}; a[1] = a[0]; } while (0)
template <int MODE> __device__ __forceinline__ void mask_tiles(f32x4 (&acc)[2], int wave, int lane) {
    const int m = 16 * (wave >> 1) + (lane & 15), nb = 32 * (wave & 1) + 4 * (lane >> 4);
#pragma unroll
    for (int t = 0; t < 2; ++t)
#pragma unroll
        for (int i = 0; i < 4; ++i) { const int n = nb + 16 * t + i; const bool keep = MODE == 0 ? (n < m) : MODE == 1 ? (n > m) : (n <= m); if (!keep) acc[t][i] = 0.f; }
}

__device__ __forceinline__ void rwkv_passA_unit(ArgsP A, Frame& F, int l, int u, bool reuse) {
    unsigned char* ws = A->ws;
    const int tid = F.tid, lane = F.lane, wave = F.wave;
    const float* PR = (const float*)(ws + WS_PR);
    int h, row0, nvalid; const float* prev0;
    if (u < 2048) { h = u >> 7; const int c = u & 127; row0 = 64 * c; nvalid = 64; prev0 = c > 0 ? PR + (size_t)(row0 - 1) * NRC_PAD : nullptr; }
    else { const int su = u - 2048, sb = su >> 4; h = su & 15; row0 = MP + sb * TS; nvalid = TS; prev0 = A->in[I_SSHIFT] + (size_t)(l * NSB + sb) * NRC; }
    const float* mu = A->in[I_MU] + (size_t)l * NRC;
    LAS unsigned char* L = F.lds;
#define SL(i) (L + (i) * RW_SLOT)
    LAS unsigned short* TW = (LAS unsigned short*)(L), *XA = (LAS unsigned short*)(L + 13312), *SG = (LAS unsigned short*)(L + 26624);
    LAS float* WLf = (LAS float*)(L + 64512), *ALf = (LAS float*)(L + 81920), *GLf = (LAS float*)(L + 99328);
    LAS float* AT32 = (LAS float*)(L + 92160), *A32 = (LAS float*)(L + 109568), *AKV32 = (LAS float*)(L);
    LAS unsigned char* sAAK = L + 126976, *sARB = L + 136192, *sARK = L + 145408;
    LAS float* SEG = (LAS float*)(L + 154624), *WLV = SEG + 512;
    bf16x8 yg_[8][2];
    { const int nt0 = 2 * (wave & 1), c = lane & 15, q = lane >> 4; const bf16* LB = (const bf16*)(ws + WS_LORA + (size_t)l * LORA_LAYER);
#pragma unroll
      for (int t = 0; t < 2; ++t) { const int j = h * 64 + 16 * (nt0 + t) + c;
#pragma unroll
          for (int s = 0; s < 8; ++s) yg_[s][t] = *(const GAS bf16x8*)(LB + (size_t)2 * 1024 * 96 + (size_t)j * 256 + 8 * q + 32 * s); } }
    { unsigned char* lscr = ws + WS_LSCR + (size_t)F.bid * 61440;
      if (reuse) { v4u tmp[8];
#pragma unroll
          for (int b = 0; b < 8; ++b) { const int i = tid + b * (NWAVES * 64); if (i < 60416 / 16) tmp[b] = *(const GAS v4u*)(lscr + i * 16); }
#pragma unroll
          for (int b = 0; b < 8; ++b) { const int i = tid + b * (NWAVES * 64); if (i < 60416 / 16) *(LAS v4u*)(L + i * 16) = tmp[b]; } }
      else {
        for (int it = 0; it < 56; it += 8) { float cur[8], prv[8], mm_[8];
#pragma unroll
            for (int b = 0; b < 8; ++b) { const int idx = tid + (it + b) * (NWAVES * 64), t = idx / 448, col = 3072 + idx % 448; cur[b] = 0.f; prv[b] = 0.f; mm_[b] = mu[col];
                if (t < nvalid) { cur[b] = PR[(size_t)(row0 + t) * NRC_PAD + col]; prv[b] = t > 0 ? PR[(size_t)(row0 + t - 1) * NRC_PAD + col] : (prev0 ? prev0[col] : 0.f); } }
#pragma unroll
            for (int b = 0; b < 8; ++b) { const int idx = tid + (it + b) * (NWAVES * 64), t = idx / 448, cc = idx % 448; const float xm = cur[b] + (prv[b] - cur[b]) * mm_[b];
                if (cc < 96) { const float e = __expf(2.f * xm); TW[t * 104 + cc] = (unsigned short)f2bf(1.f - 2.f * __builtin_amdgcn_rcpf(e + 1.f)); }
                else if (cc < 192) XA[t * 104 + cc - 96] = (unsigned short)f2bf(xm);
                else SG[t * 264 + cc - 192] = (unsigned short)f2bf(sigmoidf_(xm)); } }
        if (u < 2048) { __syncthreads(); for (int i = tid; i < 60416 / 16; i += NWAVES * 64) *(GAS v4u*)(lscr + i * 16) = *(const LAS v4u*)(L + i * 16); }
      } }
    __syncthreads();
    { const int mt = wave >> 1, nt0 = 2 * (wave & 1), c = lane & 15, q = lane >> 4;
      const bf16* LB = (const bf16*)(ws + WS_LORA + (size_t)l * LORA_LAYER);
      f32x4 aw[2], aa[2], ag[2]; RW_ZERO(aw); RW_ZERO(aa); RW_ZERO(ag);
#pragma unroll
      for (int s = 0; s < 3; ++s) { const bf16x8 xw = *(const LAS bf16x8*)((LAS unsigned char*)TW + (16 * mt + c) * 208 + (8 * q + 32 * s) * 2), xa = *(const LAS bf16x8*)((LAS unsigned char*)XA + (16 * mt + c) * 208 + (8 * q + 32 * s) * 2);
#pragma unroll
          for (int t = 0; t < 2; ++t) { const int j = h * 64 + 16 * (nt0 + t) + c;
              const bf16x8 yw = *(const GAS bf16x8*)(LB + (size_t)j * 96 + 8 * q + 32 * s), ya = *(const GAS bf16x8*)(LB + (size_t)1024 * 96 + (size_t)j * 96 + 8 * q + 32 * s);
              aw[t] = __builtin_amdgcn_mfma_f32_16x16x32_bf16(yw, xw, aw[t], 0, 0, 0); aa[t] = __builtin_amdgcn_mfma_f32_16x16x32_bf16(ya, xa, aa[t], 0, 0, 0); } }
#pragma unroll
      for (int s = 0; s < 8; ++s) { const bf16x8 xg = *(const LAS bf16x8*)((LAS unsigned char*)SG + (16 * mt + c) * 528 + (8 * q + 32 * s) * 2);
#pragma unroll
          for (int t = 0; t < 2; ++t) { const int j = h * 64 + 16 * (nt0 + t) + c; const bf16x8 yg = yg_[s][t];
              ag[t] = __builtin_amdgcn_mfma_f32_16x16x32_bf16(yg, xg, ag[t], 0, 0, 0); } }
#pragma unroll
      for (int t = 0; t < 2; ++t) { const int o = (16 * mt + c) * 68 + 16 * (nt0 + t) + 4 * q; *(LAS f32x4*)(WLf + o) = aw[t]; *(LAS f32x4*)(ALf + o) = aa[t]; *(LAS f32x4*)(GLf + o) = ag[t]; }
    }
    __syncthreads();
    {
        const int j = lane, hj = h * 64 + j, seg = wave;
        const float mu_r = mu[hj], mu_k = mu[1024 + hj], mu_v = mu[2048 + hj];
        const float w0 = A->in[I_W0][l * 1024 + hj], a0 = A->in[I_A0][l * 1024 + hj], kkw = A->in[I_KK][l * 1024 + hj], kaw = A->in[I_KA][l * 1024 + hj], rkw = A->in[I_RK][l * 1024 + hj];
        const float lnw = A->in[I_LNW][l * 1024 + hj], lnb = A->in[I_LNB][l * 1024 + hj];
        float logw[8], xr[8], xv[8], kk[8], bb[8], km[8], cs[8];
        float* G1 = (float*)(ws + WS_G1); float* G2 = (float*)(ws + WS_G2);
        float run = 0.f;
        float cr9[9], ck9[9], cv9[9];
#pragma unroll
        for (int i = 0; i < 9; ++i) { const int t = 8 * seg + i - 1; const float* pr = (t < 0) ? prev0 : (t < nvalid ? PR + (size_t)(row0 + t) * NRC_PAD : nullptr);
            cr9[i] = pr ? pr[hj] : 0.f; ck9[i] = pr ? pr[1024 + hj] : 0.f; cv9[i] = pr ? pr[2048 + hj] : 0.f; }
        asm volatile("" ::: "memory");
#pragma unroll
        for (int i = 0; i < 8; ++i) { const int t = 8 * seg + i; const bool valid = t < nvalid;
            float r_ = 0.f, k_ = 0.f, v_ = 0.f;
            if (valid) { const float cr = cr9[i + 1], ck = ck9[i + 1], cv = cv9[i + 1], qr = cr9[i], qk = ck9[i], qv = cv9[i];
                r_ = cr + (qr - cr) * mu_r; k_ = ck + (qk - ck) * mu_k; v_ = cv + (qv - cv) * mu_v; }
            const float wl = WLf[t * 68 + j], al = ALf[t * 68 + j], gl = GLf[t * 68 + j];
            const float lw = valid ? -0.6065306597126334f * sigmoidf_(w0 + wl) : 0.f;
            const float a_ = sigmoidf_(a0 + al);
            const float kkr = k_ * kkw; const float nrm = wave_sum(kkr * kkr); const float kk_ = kkr * __builtin_amdgcn_rsqf(fmaxf(nrm, 1e-24f));
            const float km_ = k_ * (1.f + (a_ - 1.f) * kaw);
            const float ct = wave_sum(r_ * km_ * rkw);
            if (valid) { const size_t go = (size_t)(row0 + t) * 1024 + hj; G1[go] = lnw * gl; G2[go] = (lnb + ct * v_) * gl; }
            run += lw; logw[i] = lw; cs[i] = run; xr[i] = r_; xv[i] = v_; kk[i] = kk_; bb[i] = kk_ * a_; km[i] = km_; }
        SEG[seg * 64 + j] = run;
        __syncthreads();
        float off = 0.f, tot = 0.f;
#pragma unroll
        for (int s = 0; s < 8; ++s) { const float v = SEG[s * 64 + j]; tot += v; if (s < seg) off += v; }
        if (seg == 0) WLV[j] = __expf(tot);
        LAS unsigned short* AT = (LAS unsigned short*)SL(0), *ATL = (LAS unsigned short*)SL(1), *BH = (LAS unsigned short*)SL(2), *BHL = (LAS unsigned short*)SL(3), *KH = (LAS unsigned short*)SL(4), *RT = (LAS unsigned short*)SL(5);
        unsigned pvt[4], pbt[4], pbl[4], pkt[4];
#pragma unroll
        for (int i = 0; i < 8; i += 2) { float v2[2], bt2[2], bl2[2], kt2[2];
#pragma unroll
            for (int e = 0; e < 2; ++e) { const int ii = i + e, t = 8 * seg + ii; const float ci = off + cs[ii], ce = ci - logw[ii];
                const float winc = __expf(ci), wexc = __expf(ce), winv = __expf(-ci), wrem = __expf(tot - ci);
                const float at = -kk[ii] * wexc, rt = xr[ii] * winc, bh = bb[ii] * winv, kh = km[ii] * winv, bt = bb[ii] * wrem, kt = km[ii] * wrem;
                const unsigned ath = f2bf(at), bhh = f2bf(bh), bth = f2bf(bt);
                AT[t * RW_STRIDE + j] = (unsigned short)ath; ATL[t * RW_STRIDE + j] = (unsigned short)f2bf(at - bf2f((unsigned short)ath)); AT32[t * 68 + j] = at;
                BH[t * RW_STRIDE + j] = (unsigned short)bhh; BHL[t * RW_STRIDE + j] = (unsigned short)f2bf(bh - bf2f((unsigned short)bhh));
                KH[t * RW_STRIDE + j] = (unsigned short)f2bf(kh); RT[t * RW_STRIDE + j] = (unsigned short)f2bf(rt);
                v2[e] = xv[ii]; bt2[e] = bf2f((unsigned short)bth); bl2[e] = bt - bf2f((unsigned short)bth); kt2[e] = kt; }
            pvt[i >> 1] = pk2(v2[0], v2[1]); pbt[i >> 1] = pk2(bt2[0], bt2[1]); pbl[i >> 1] = pk2(bl2[0], bl2[1]); pkt[i >> 1] = pk2(kt2[0], kt2[1]); }
        *(LAS v4u*)(SL(6) + j * 144 + seg * 16) = (v4u){pvt[0], pvt[1], pvt[2], pvt[3]};
        *(LAS v4u*)(SL(7) + j * 144 + seg * 16) = (v4u){pbt[0], pbt[1], pbt[2], pbt[3]};
        *(LAS v4u*)(SL(8) + j * 144 + seg * 16) = (v4u){pbl[0], pbl[1], pbl[2], pbl[3]};
        *(LAS v4u*)(SL(9) + j * 144 + seg * 16) = (v4u){pkt[0], pkt[1], pkt[2], pkt[3]};
    }
    __syncthreads();
    { f32x4 a[2]; const int mt = wave >> 1, nt0 = 2 * (wave & 1), c = lane & 15, q = lane >> 4, m = 16 * mt + c;
      RW_ZERO(a); mm_tiles(a, SL(0), SL(2), wave, lane); mm_tiles(a, SL(1), SL(2), wave, lane); mm_tiles(a, SL(0), SL(3), wave, lane); mask_tiles<0>(a, wave, lane);
#pragma unroll
      for (int t = 0; t < 2; ++t) *(LAS f32x4*)(A32 + m * 68 + 16 * (nt0 + t) + 4 * q) = a[t];
      RW_ZERO(a); mm_tiles(a, SL(0), SL(4), wave, lane); mask_tiles<0>(a, wave, lane); st_tiles(sAAK, a, wave, lane);
      RW_ZERO(a); mm_tiles(a, SL(5), SL(2), wave, lane); mask_tiles<2>(a, wave, lane); st_tiles(sARB, a, wave, lane);
      RW_ZERO(a); mm_tiles(a, SL(5), SL(4), wave, lane); mask_tiles<2>(a, wave, lane); st_tiles(sARK, a, wave, lane); }
    __syncthreads();
    { f32x4 a[2]; const int mt = wave >> 1, nt0 = 2 * (wave & 1), c = lane & 15, q = lane >> 4, m = 16 * mt + c;
      RW_ZERO(a); mm_tiles(a, sAAK, SL(6), wave, lane);
#pragma unroll
      for (int t = 0; t < 2; ++t) *(LAS f32x4*)(AKV32 + m * 68 + 16 * (nt0 + t) + 4 * q) = a[t]; }
    __syncthreads();
    { const int c = lane & 15, q = lane >> 4;
      LAS float* R = (wave < 4) ? AT32 + 16 * wave : AKV32 + 16 * (wave - 4);
      LAS float* Rc = (wave == 0 ? AT32 : AKV32) + lane;
#pragma unroll
      for (int i = 0; i < 4; ++i) {
          if (i > 0) {
              f32x4 acc;
#pragma unroll
              for (int g = 0; g < 4; ++g) acc[g] = R[(16 * i + 4 * q + g) * 68 + c];
#pragma unroll
              for (int j = 0; j < i; ++j)
#pragma unroll
                  for (int s = 0; s < 4; ++s) { const float a = A32[(16 * i + c) * 68 + 16 * j + 4 * s + q], b = R[(16 * j + 4 * s + q) * 68 + c];
                      acc = __builtin_amdgcn_mfma_f32_16x16x4f32(a, b, acc, 0, 0, 0); }
#pragma unroll
              for (int g = 0; g < 4; ++g) R[(16 * i + 4 * q + g) * 68 + c] = acc[g];
              __syncthreads();
          }
          if (wave < 2) {
              const LAS float* a32 = A32 + (16 * i) * 68 + 16 * i; asm volatile("" : "+v"(a32));
              float x[16];
#pragma unroll
              for (int rr = 0; rr < 16; ++rr) x[rr] = Rc[(16 * i + rr) * 68];
#pragma unroll
              for (int rg = 0; rg < 4; ++rg) {
                  f32x4 cf[4][4];
#pragma unroll
                  for (int r4 = 0; r4 < 4; ++r4)
#pragma unroll
                      for (int g = 0; g <= rg; ++g) if (4 * g < 4 * rg + r4) cf[r4][g] = *(const LAS f32x4*)(a32 + (4 * rg + r4) * 68 + 4 * g);
#pragma unroll
                  for (int r4 = 0; r4 < 4; ++r4) { const int rr = 4 * rg + r4; if (rr == 0) continue; float s0 = x[rr], s1 = 0.f;
#pragma unroll
                      for (int g = 0; g <= rg; ++g) if (4 * g < rr) { s0 += cf[r4][g][0] * x[4 * g]; if (4 * g + 1 < rr) s1 += cf[r4][g][1] * x[4 * g + 1]; if (4 * g + 2 < rr) s0 += cf[r4][g][2] * x[4 * g + 2]; if (4 * g + 3 < rr) s1 += cf[r4][g][3] * x[4 * g + 3]; }
                      x[rr] = s0 + s1; }
                  asm volatile("" ::: "memory");
              }
#pragma unroll
              for (int rr = 1; rr < 16; ++rr) Rc[(16 * i + rr) * 68] = x[rr];
          }
          __syncthreads();
      }
      { const int cc = tid & 127, g16 = tid >> 7; const LAS float* src = (cc < 64 ? AT32 + cc : AKV32 + (cc - 64)) + (16 * g16) * 68;
        unsigned hh[16]; float lo[16];
#pragma unroll
        for (int rr = 0; rr < 16; ++rr) { const float v = src[rr * 68]; hh[rr] = f2bf(v); lo[rr] = v - bf2f((unsigned short)hh[rr]); }
        LAS unsigned char* dh = (cc < 64 ? SL(2) + cc * 144 : SL(4) + (cc - 64) * 144) + g16 * 32;
        *(LAS v4u*)dh = (v4u){hh[0] | (hh[1] << 16), hh[2] | (hh[3] << 16), hh[4] | (hh[5] << 16), hh[6] | (hh[7] << 16)};
        *(LAS v4u*)(dh + 16) = (v4u){hh[8] | (hh[9] << 16), hh[10] | (hh[11] << 16), hh[12] | (hh[13] << 16), hh[14] | (hh[15] << 16)};
        if (cc < 64) { LAS unsigned char* dl = SL(3) + cc * 144 + g16 * 32;
            *(LAS v4u*)dl = (v4u){pk2(lo[0], lo[1]), pk2(lo[2], lo[3]), pk2(lo[4], lo[5]), pk2(lo[6], lo[7])};
            *(LAS v4u*)(dl + 16) = (v4u){pk2(lo[8], lo[9]), pk2(lo[10], lo[11]), pk2(lo[12], lo[13]), pk2(lo[14], lo[15])}; } }
    }
    __syncthreads();
    { const int mt = wave >> 1, nt0 = 2 * (wave & 1), c = lane & 15, q = lane >> 4, m = 16 * mt + c;
      float* PTg = (float*)(ws + WS_PT32) + (size_t)u * 4096; float* QQg = (float*)(ws + WS_QQ) + (size_t)u * 4096; bf16* RPg = (bf16*)(ws + WS_RP) + (size_t)u * 4096; float* YVg = (float*)(ws + WS_YV) + (size_t)u * 4096;
      f32x4 a[2];
      RW_ZERO(a); mm_tiles(a, sARB, SL(2), wave, lane); mm_tiles(a, sARB, SL(3), wave, lane);
#pragma unroll
      for (int t = 0; t < 2; ++t) { const int n = 16 * (nt0 + t) + 4 * q; const v2u rr = *(const LAS v2u*)(SL(5) + m * 144 + n * 2);
          v2u w; w.x = pk2(a[t][0] + bf2f((unsigned short)(rr.x & 0xffffu)), a[t][1] + bf2f((unsigned short)(rr.x >> 16))); w.y = pk2(a[t][2] + bf2f((unsigned short)(rr.y & 0xffffu)), a[t][3] + bf2f((unsigned short)(rr.y >> 16)));
          *(GAS v2u*)(RPg + m * 64 + n) = w; }
      RW_ZERO(a); mm_tiles(a, sARB, SL(4), wave, lane); mm_tiles(a, sARK, SL(6), wave, lane);
#pragma unroll
      for (int t = 0; t < 2; ++t) *(GAS f32x4*)(YVg + m * 64 + 16 * (nt0 + t) + 4 * q) = a[t];
      if (tid < 64) ((float*)(ws + WS_WL))[(size_t)u * 64 + tid] = WLV[tid];
      RW_ZERO(a); mm_tiles(a, SL(7), SL(2), wave, lane); mm_tiles(a, SL(8), SL(2), wave, lane); mm_tiles(a, SL(7), SL(3), wave, lane);
#pragma unroll
      for (int t = 0; t < 2; ++t) *(GAS f32x4*)(PTg + m * 64 + 16 * (nt0 + t) + 4 * q) = a[t];
      RW_ZERO(a); mm_tiles(a, SL(4), SL(7), wave, lane); mm_tiles(a, SL(6), SL(9), wave, lane);
#pragma unroll
      for (int t = 0; t < 2; ++t) *(GAS f32x4*)(QQg + m * 64 + 16 * (nt0 + t) + 4 * q) = a[t];
    }
    __syncthreads();
#undef SL
}
__device__ __forceinline__ void wait_count(Frame& F, unsigned* cnt, unsigned target) {
    if (F.tid == 0) { unsigned* bar = (unsigned*)(F.ctl + CW_BAR);
        XB_SPIN(xb_ld(cnt) < target, bar);
        __builtin_amdgcn_fence(__ATOMIC_ACQUIRE, "agent"); asm volatile("s_waitcnt vmcnt(0)" ::: "memory"); }
    __syncthreads();
}
__device__ __forceinline__ void ph_rwkv_passA(Frame& F, int l) {
    PHASE_ENTRY();
    if (F.G == 256) wait_count(F, (unsigned*)(F.ctl + CW_QUEUE + 1024 + 64 * l), (unsigned)((MT / 256) * (NRC_PAD / 256)));
    int pu = -1;
    int u0 = F.bid, ustep = F.G, uend = RW_UNITS;
    if (F.G == 256) {
        const int r = F.bid & 127, sec = F.bid >> 7, nf = (r < (MT / 256) * (NIN_PAD / 256) - 768) ? 8 : 9;
        u0 = r + 128 * (sec ? nf : 0); ustep = 128; uend = r + 128 * (sec ? 18 : nf); }
    for (int u = u0; u < uend; u += ustep) { const bool reuse = (pu >= 0 && u < 2048 && (u & 127) == (pu & 127)); rwkv_passA_unit(A, F, l, u, reuse); pu = u; }
}

struct ChainOps { f32x4 pt[4]; f32x4 qq[2]; f32x4 wl; };
__device__ __forceinline__ void rwkv_chain_load(ChainOps& o, const float* PTg, const float* QQg, const float* WLg, int wave, int lane) {
    const int tk = wave & 3, tv0 = 2 * (wave >> 2), c = lane & 15, q = lane >> 4;
#pragma unroll
    for (int s = 0; s < 2; ++s) { o.pt[2 * s] = *(const GAS f32x4*)(PTg + (16 * tk + c) * 64 + 8 * q + 32 * s); o.pt[2 * s + 1] = *(const GAS f32x4*)(PTg + (16 * tk + c) * 64 + 8 * q + 32 * s + 4); }
#pragma unroll
    for (int t = 0; t < 2; ++t) o.qq[t] = *(const GAS f32x4*)(QQg + (16 * (tv0 + t) + c) * 64 + 16 * tk + 4 * q);
    o.wl = *(const GAS f32x4*)(WLg + 16 * tk + 4 * q);
}
__device__ __forceinline__ void rwkv_chain_step(f32x4 (&acc)[2], const ChainOps& o, const LAS unsigned char* Shi, const LAS unsigned char* Slo, int wave, int lane) {
    const int tv0 = 2 * (wave >> 2), c = lane & 15, q = lane >> 4;
    bf16x8 ph[2], pl[2];
#pragma unroll
    for (int s = 0; s < 2; ++s) { const f32x4 x0 = o.pt[2 * s], x1 = o.pt[2 * s + 1];
        unsigned h[8]; float lo[8];
#pragma unroll
        for (int i = 0; i < 4; ++i) { h[i] = f2bf(x0[i]); lo[i] = x0[i] - bf2f((unsigned short)h[i]); h[4 + i] = f2bf(x1[i]); lo[4 + i] = x1[i] - bf2f((unsigned short)h[4 + i]); }
        ph[s] = __builtin_bit_cast(bf16x8, (v4u){h[0] | (h[1] << 16), h[2] | (h[3] << 16), h[4] | (h[5] << 16), h[6] | (h[7] << 16)});
        pl[s] = __builtin_bit_cast(bf16x8, (v4u){pk2(lo[0], lo[1]), pk2(lo[2], lo[3]), pk2(lo[4], lo[5]), pk2(lo[6], lo[7])}); }
#pragma unroll
    for (int t = 0; t < 2; ++t) { const int v = 16 * (tv0 + t) + c;
        f32x4 a = o.qq[t] + acc[t] * o.wl;
        const bf16x8 s0 = *(const LAS bf16x8*)(Shi + v * 144 + q * 16), s1 = *(const LAS bf16x8*)(Shi + v * 144 + q * 16 + 64);
        const bf16x8 l0 = *(const LAS bf16x8*)(Slo + v * 144 + q * 16), l1 = *(const LAS bf16x8*)(Slo + v * 144 + q * 16 + 64);
        a = __builtin_amdgcn_mfma_f32_16x16x32_bf16(ph[0], s0, a, 0, 0, 0); a = __builtin_amdgcn_mfma_f32_16x16x32_bf16(ph[1], s1, a, 0, 0, 0);
        a = __builtin_amdgcn_mfma_f32_16x16x32_bf16(ph[0], l0, a, 0, 0, 0); a = __builtin_amdgcn_mfma_f32_16x16x32_bf16(ph[1], l1, a, 0, 0, 0);
        a = __builtin_amdgcn_mfma_f32_16x16x32_bf16(pl[0], s0, a, 0, 0, 0); a = __builtin_amdgcn_mfma_f32_16x16x32_bf16(pl[1], s1, a, 0, 0, 0);
        acc[t] = a; }
}
__device__ __forceinline__ void rwkv_state_to_lds(const f32x4 (&acc)[2], LAS unsigned char* Shi, LAS unsigned char* Slo, int wave, int lane) {
    const int tk = wave & 3, tv0 = 2 * (wave >> 2), c = lane & 15, q = lane >> 4;
#pragma unroll
    for (int t = 0; t < 2; ++t) { unsigned h[4]; float lo[4];
#pragma unroll
        for (int i = 0; i < 4; ++i) { h[i] = f2bf(acc[t][i]); lo[i] = acc[t][i] - bf2f((unsigned short)h[i]); }
        const int o = (16 * (tv0 + t) + c) * 144 + (16 * tk + 4 * q) * 2;
        *(LAS v2u*)(Shi + o) = (v2u){h[0] | (h[1] << 16), h[2] | (h[3] << 16)}; *(LAS v2u*)(Slo + o) = (v2u){pk2(lo[0], lo[1]), pk2(lo[2], lo[3])}; }
}
__device__ __forceinline__ void ph_rwkv_chain(Frame& F, int l) {
    PHASE_ENTRY();
    unsigned char* ws = A->ws; const int tid = F.tid, lane = F.lane, wave = F.wave;
    const int tk = wave & 3, tv0 = 2 * (wave >> 2), c = lane & 15, q = lane >> 4;
    LAS unsigned char* HI0 = F.lds, *LO0 = F.lds + RW_SLOT, *HI1 = F.lds + 2 * RW_SLOT, *LO1 = F.lds + 3 * RW_SLOT;
    const float* PT = (const float*)(ws + WS_PT32); const float* QQ = (const float*)(ws + WS_QQ); const float* WL = (const float*)(ws + WS_WL); bf16* SC = (bf16*)(ws + WS_SC);
    if (F.bid < 16) {
        const int h = F.bid;
        f32x4 acc[2]; RW_ZERO(acc);
        rwkv_state_to_lds(acc, HI0, LO0, wave, lane);
        __syncthreads();
        ChainOps ops; rwkv_chain_load(ops, PT + (size_t)(h * 128) * 4096, QQ + (size_t)(h * 128) * 4096, WL + (size_t)(h * 128) * 64, wave, lane);
        for (int cc = 0; cc < 128; ++cc) { const int u = h * 128 + cc; LAS unsigned char* chi = (cc & 1) ? HI1 : HI0, *clo = (cc & 1) ? LO1 : LO0, *nhi = (cc & 1) ? HI0 : HI1, *nlo = (cc & 1) ? LO0 : LO1;
            { const int row = tid >> 3, ch = tid & 7; *(GAS v4u*)((unsigned char*)(SC + (size_t)u * 4096) + tid * 16) = *(const LAS v4u*)(chi + row * 144 + ch * 16); }
            const ChainOps cur = ops;
            if (cc + 1 < 128) rwkv_chain_load(ops, PT + (size_t)(u + 1) * 4096, QQ + (size_t)(u + 1) * 4096, WL + (size_t)(u + 1) * 64, wave, lane);
            rwkv_chain_step(acc, cur, chi, clo, wave, lane);
            rwkv_state_to_lds(acc, nhi, nlo, wave, lane);
            __syncthreads(); }
#ifndef PROBE_SEQ
        float* wo = A->out + O_WP + (size_t)(l * 16 + h) * 4096;
#else
        float* wo = (float*)(A->ws + WS_HALO) + (size_t)h * 4096;
#endif
#pragma unroll
        for (int t = 0; t < 2; ++t) *(GAS f32x4*)(wo + (16 * (tv0 + t) + c) * 64 + 16 * tk + 4 * q) = acc[t];
    } else {
        for (int su = F.bid - 16; su < NSB * 16; su += F.G - 16) { const int u = 2048 + su, sb = su >> 4, h = su & 15;
            const float* S0 = A->in[I_SWKV] + (size_t)((l * NSB + sb) * 16 + h) * 4096;
            f32x4 acc[2];
#pragma unroll
            for (int t = 0; t < 2; ++t) acc[t] = *(const GAS f32x4*)(S0 + (16 * (tv0 + t) + c) * 64 + 16 * tk + 4 * q);
            rwkv_state_to_lds(acc, HI0, LO0, wave, lane);
            __syncthreads();
            { const int row = tid >> 3, ch = tid & 7; *(GAS v4u*)((unsigned char*)(SC + (size_t)u * 4096) + tid * 16) = *(const LAS v4u*)(HI0 + row * 144 + ch * 16); }
            { ChainOps o1; rwkv_chain_load(o1, PT + (size_t)u * 4096, QQ + (size_t)u * 4096, WL + (size_t)u * 64, wave, lane); rwkv_chain_step(acc, o1, HI0, LO0, wave, lane); }
            float* wo = A->out + O_WS + (size_t)((l * NSB + sb) * 16 + h) * 4096;
#pragma unroll
            for (int t = 0; t < 2; ++t) *(GAS f32x4*)(wo + (16 * (tv0 + t) + c) * 64 + 16 * tk + 4 * q) = acc[t];
            __syncthreads(); }
    }
}
__device__ __forceinline__ void ph_rwkv_passC(Frame& F, int l) {
    PHASE_ENTRY();
    unsigned char* ws = A->ws; const int lane = F.lane, wave = F.wave, c = lane & 15, q = lane >> 4, mt = wave & 3;
    const bf16* RP = (const bf16*)(ws + WS_RP); const float* YV = (const float*)(ws + WS_YV); const bf16* SC = (const bf16*)(ws + WS_SC);
    const float* G1 = (const float*)(ws + WS_G1); const float* G2 = (const float*)(ws + WS_G2); bf16* YC = (bf16*)(ws + WS_YCAT);
    bf16x8 rA[2], rB[2], sA[8], sB[8]; f32x4 yA[4], yB[4], gA[8], gB[8];
    auto geo = [&](int u, int& h, int& row0, bool& skip) { const bool samp = u >= 2048;
        if (!samp) { h = u >> 7; row0 = 64 * (u & 127); } else { const int su = u - 2048; h = su & 15; row0 = MP + (su >> 4) * TS; }
        skip = samp && mt > 0; };
    auto load = [&](int u, bf16x8 (&r)[2], bf16x8 (&sv)[8], f32x4 (&y)[4], f32x4 (&g)[8]) { int h, row0; bool skip; geo(u, h, row0, skip); if (skip) return;
        const bf16* RPu = RP + (size_t)u * 4096; const float* YVu = YV + (size_t)u * 4096; const bf16* SCu = SC + (size_t)u * 4096; const int t = 16 * mt + c; const size_t ro = (size_t)(row0 + t);
        r[0] = *(const GAS bf16x8*)(RPu + t * 64 + 8 * q); r[1] = *(const GAS bf16x8*)(RPu + t * 64 + 8 * q + 32);
#pragma unroll
        for (int nt = 0; nt < 4; ++nt) { const int v = h * 64 + 16 * nt + 4 * q; y[nt] = *(const GAS f32x4*)(YVu + t * 64 + 16 * nt + 4 * q);
            sv[2 * nt] = *(const GAS bf16x8*)(SCu + (16 * nt + c) * 64 + 8 * q); sv[2 * nt + 1] = *(const GAS bf16x8*)(SCu + (16 * nt + c) * 64 + 8 * q + 32);
            g[nt] = *(const GAS f32x4*)(G1 + ro * 1024 + v); g[4 + nt] = *(const GAS f32x4*)(G2 + ro * 1024 + v); } };
    auto compute = [&](int u, const bf16x8 (&r)[2], const bf16x8 (&sv)[8], f32x4 (&y)[4], const f32x4 (&g)[8]) { int h, row0; bool skip; geo(u, h, row0, skip); if (skip) return;
        const int t = 16 * mt + c; const size_t ro = (size_t)(row0 + t); float s1 = 0.f;
#pragma unroll
        for (int nt = 0; nt < 4; ++nt) { y[nt] = __builtin_amdgcn_mfma_f32_16x16x32_bf16(sv[2 * nt], r[0], y[nt], 0, 0, 0); y[nt] = __builtin_amdgcn_mfma_f32_16x16x32_bf16(sv[2 * nt + 1], r[1], y[nt], 0, 0, 0);
            s1 += (y[nt][0] + y[nt][1]) + (y[nt][2] + y[nt][3]); }
        s1 += swz_xor<16>(s1); s1 += xor32(s1);
        const float mean = s1 * (1.f / 64.f); float s2 = 0.f;
#pragma unroll
        for (int nt = 0; nt < 4; ++nt) { y[nt] = y[nt] - mean; s2 += (y[nt][0] * y[nt][0] + y[nt][1] * y[nt][1]) + (y[nt][2] * y[nt][2] + y[nt][3] * y[nt][3]); }
        s2 += swz_xor<16>(s2); s2 += xor32(s2);
        const float rstd = __builtin_amdgcn_rsqf(s2 * (1.f / 64.f) + 64e-5f);
#pragma unroll
        for (int nt = 0; nt < 4; ++nt) { const int v = h * 64 + 16 * nt + 4 * q;
            const f32x4 o = y[nt] * rstd * g[nt] + g[4 + nt]; v2u w; w.x = pk2(o[0], o[1]); w.y = pk2(o[2], o[3]); *(GAS v2u*)(YC + ro * DMOD + v) = w; } };
    const int u0 = 2 * F.bid + (wave >> 2), us = 2 * F.G;
    if (u0 < RW_UNITS) load(u0, rA, sA, yA, gA);
    for (int u = u0; u < RW_UNITS; u += 2 * us) {
        if (u + us < RW_UNITS) load(u + us, rB, sB, yB, gB);
        compute(u, rA, sA, yA, gA);
        if (u + us < RW_UNITS) { if (u + 2 * us < RW_UNITS) load(u + 2 * us, rA, sA, yA, gA); compute(u + us, rB, sB, yB, gB); }
    }
}
__device__ __forceinline__ void attn_sample_unit(ArgsP A, Frame& F, int l, int sb, int h) {
    unsigned char* ws = A->ws; const int tid = F.tid, lane = F.lane, wave = F.wave;
    LAS float* QS = (LAS float*)F.lds;
    LAS float* LUT = QS + 2048;
    LAS float* PB = QS + 4096 + wave * 1024;
    LAS float* MLW = QS + 4096 + 8192;
    LAS float* OACC = MLW + 128;
    LAS float* LACC = OACC + 4096;
    const bf16* QB = (const bf16*)(ws + WS_QB); const bf16* KB = (const bf16*)(ws + WS_KB); const bf16* VB = (const bf16*)(ws + WS_VB);
    const float* reltab = A->in[I_REL];
    for (int i = tid; i < 2048; i += NWAVES * 64) { const int t = i >> 7, d = i & 127; QS[i] = bf2f(QB[(size_t)(MP + sb * TS + t) * 1024 + h * 128 + d]); }
    if (tid < 192) { const int rel = tid - 128; const int n = rel < 0 ? -rel : rel;
        const int lg = n < 12 ? 8 : n < 16 ? 9 : n < 23 ? 10 : n < 32 ? 11 : n < 46 ? 12 : n < 64 ? 13 : n < 91 ? 14 : 15;
        const int bucket = (rel > 0 ? 16 : 0) + (n < 8 ? n : lg);
        LUT[tid] = (reltab[bucket * 8 + h] - reltab[15 * 8 + h]) * 1.4426950408889634f; }
    for (int i = tid; i < 4096 + 32; i += NWAVES * 64) OACC[i] = 0.f;
    __syncthreads();
    const int map = wave & 1, kg = wave >> 1;
    float mrun[16], lrun[16], o[16][2];
#pragma unroll
    for (int t = 0; t < 16; ++t) { mrun[t] = -INFINITY; lrun[t] = 0.f; o[t][0] = 0.f; o[t][1] = 0.f; }
    const float* CK = A->in[I_CK] + (size_t)(l * NSB + sb) * PAST * 1024; const float* CV = A->in[I_CV] + (size_t)(l * NSB + sb) * PAST * 1024;
    for (int kb = kg; kb < 33; kb += 4) {
        const int pos = 64 * kb + lane; const bool kvalid = pos < PAST + TS;
        float s[16];
#pragma unroll
        for (int t = 0; t < 16; ++t) s[t] = 0.f;
        if (kb < 32) { const float* kp = CK + (size_t)pos * 1024 + h * 128 + map * 64;
#pragma unroll 4
            for (int d = 0; d < 64; d += 4) { const f32x4 kv = *(const GAS f32x4*)(kp + d);
#pragma unroll
                for (int t = 0; t < 16; ++t) { const f32x4 qv = *(const LAS f32x4*)(QS + t * 128 + map * 64 + d); s[t] += (kv[0] * qv[0] + kv[1] * qv[1]) + (kv[2] * qv[2] + kv[3] * qv[3]); } }
        } else { const int rr = MP + sb * TS + (lane & 15); const bf16* kp = KB + (size_t)rr * 1024 + h * 128 + map * 64;
#pragma unroll 4
            for (int d = 0; d < 64; d += 4) { const v2u kw = *(const GAS v2u*)(kp + d);
                const f32x4 kv = (f32x4){bf2f((unsigned short)(kw.x & 0xffffu)), bf2f((unsigned short)(kw.x >> 16)), bf2f((unsigned short)(kw.y & 0xffffu)), bf2f((unsigned short)(kw.y >> 16))};
#pragma unroll
                for (int t = 0; t < 16; ++t) { const f32x4 qv = *(const LAS f32x4*)(QS + t * 128 + map * 64 + d); s[t] += (kv[0] * qv[0] + kv[1] * qv[1]) + (kv[2] * qv[2] + kv[3] * qv[3]); } }
        }
        float al[16];
#pragma unroll
        for (int t = 0; t < 16; ++t) { int idx = pos - (PAST + t) + 128; idx = idx < 0 ? 0 : idx; idx = idx > 191 ? 191 : idx;
            float sv = kvalid ? s[t] + LUT[idx] : -INFINITY;
            const float bm = wave_max(sv);
            const float mn = fmaxf(mrun[t], bm); al[t] = __builtin_amdgcn_exp2f(mrun[t] - mn); mrun[t] = mn;
            const float p = __builtin_amdgcn_exp2f(sv - mn); PB[lane * 16 + t] = p;
            lrun[t] = lrun[t] * al[t] + wave_sum(p);
            o[t][0] *= al[t]; o[t][1] *= al[t]; }
        LDS_WAIT(); asm volatile("" ::: "memory");
        const int nk = (kb < 32) ? 64 : TS;
        for (int k0 = 0; k0 < nk; k0 += 4) { f32x2 vv[4];
            if (kb < 32) {
#pragma unroll
                for (int b = 0; b < 4; ++b) vv[b] = *(const GAS f32x2*)(CV + (size_t)(64 * kb + k0 + b) * 1024 + h * 128 + 2 * lane);
            } else {
#pragma unroll
                for (int b = 0; b < 4; ++b) { const unsigned w = *(const GAS unsigned*)(VB + (size_t)(MP + sb * TS + k0 + b) * 1024 + h * 128 + 2 * lane); vv[b].x = bf2f((unsigned short)(w & 0xffffu)); vv[b].y = bf2f((unsigned short)(w >> 16)); }
            }
#pragma unroll
            for (int b = 0; b < 4; ++b) { const LAS f32x4* pp = (const LAS f32x4*)(PB + (k0 + b) * 16);
                const f32x4 p0 = pp[0], p1 = pp[1], p2 = pp[2], p3 = pp[3];
#pragma unroll
                for (int t = 0; t < 4; ++t) { o[t][0] += p0[t] * vv[b].x; o[t][1] += p0[t] * vv[b].y; o[4 + t][0] += p1[t] * vv[b].x; o[4 + t][1] += p1[t] * vv[b].y;
                    o[8 + t][0] += p2[t] * vv[b].x; o[8 + t][1] += p2[t] * vv[b].y; o[12 + t][0] += p3[t] * vv[b].x; o[12 + t][1] += p3[t] * vv[b].y; }
                asm volatile("" ::: "memory"); } }
        LDS_WAIT(); asm volatile("" ::: "memory");
    }
    if (lane < 16) { float mv = mrun[0];
#pragma unroll
        for (int t = 1; t < 16; ++t) mv = (lane == t) ? mrun[t] : mv;
        MLW[wave * 16 + lane] = mv; }
    __syncthreads();
#pragma unroll
    for (int t = 0; t < 16; ++t) { float M = fmaxf(fmaxf(MLW[(map) * 16 + t], MLW[(2 + map) * 16 + t]), fmaxf(MLW[(4 + map) * 16 + t], MLW[(6 + map) * 16 + t]));
        const float sc = __builtin_amdgcn_exp2f(mrun[t] - M);
        __hip_atomic_fetch_add(OACC + (t * 2 + map) * 128 + 2 * lane, o[t][0] * sc, __ATOMIC_RELAXED, __HIP_MEMORY_SCOPE_WORKGROUP); __hip_atomic_fetch_add(OACC + (t * 2 + map) * 128 + 2 * lane + 1, o[t][1] * sc, __ATOMIC_RELAXED, __HIP_MEMORY_SCOPE_WORKGROUP);
        if (lane == 0) __hip_atomic_fetch_add(LACC + map * 16 + t, lrun[t] * sc, __ATOMIC_RELAXED, __HIP_MEMORY_SCOPE_WORKGROUP); }
    __syncthreads();
    float* OA = (float*)(ws + WS_OATT);
    for (int i = tid; i < 4096; i += NWAVES * 64) { const int t = i >> 8, mp = (i >> 7) & 1, e = i & 127;
        OA[(size_t)(MP + sb * TS + t) * DMOD + h * 256 + mp * 128 + e] = OACC[i] / LACC[mp * 16 + t]; }
    __syncthreads();
}


__device__ __forceinline__ void attn_sample_unit2(ArgsP A, Frame& F, int l, int sb, int h) {
    using attn_body::f32x16;
    unsigned char* ws = A->ws; int tid_ = F.tid; asm volatile("" : "+v"(tid_));
    const int tid = tid_, lane = tid & 63, wid = __builtin_amdgcn_readfirstlane(tid >> 6), r32 = lane & 31, hi = lane >> 5, map = wid & 1, vh = (wid >> 1) & 1, KH = wid >> 2;
    LAS unsigned char* L = F.lds;
    LAS float* wsf = (LAS float*)(L + 65536) + wid * 64;
    const LAS float* LUT = (const LAS float*)(L + LUT_OFF) + h * 192;
    LAS float* MG = (LAS float*)(L + 68608);
    const bf16* QB = (const bf16*)(ws + WS_QB); const bf16* KB = (const bf16*)(ws + WS_KB); const bf16* VB = (const bf16*)(ws + WS_VB);
    const float* CK = A->in[I_CK] + (size_t)(l * NSB + sb) * PAST * 1024 + h * 128; const float* CV = A->in[I_CV] + (size_t)(l * NSB + sb) * PAST * 1024 + h * 128;
    bf16x8 qr[4];
    { const bf16* Qw = QB + (size_t)(MP + sb * TS + (r32 & 15)) * 1024 + h * 128 + map * 64;
#pragma unroll
      for (int d0 = 0; d0 < 4; ++d0) qr[d0] = *(const GAS bf16x8*)(Qw + d0 * 16 + hi * 8); }
    f32x4 st[8];
    auto stage_load = [&](int tile) {
        if (tile < 32) {
#pragma unroll
            for (int k = 0; k < 4; ++k) { const int idx = tid + 512 * k, row = idx >> 5, pp = idx & 31; const size_t off = (size_t)(64 * tile + row) * 1024 + 4 * pp;
                st[k] = __builtin_nontemporal_load((const GAS f32x4*)(CK + off)); st[4 + k] = __builtin_nontemporal_load((const GAS f32x4*)(CV + off)); }
        } else {
#pragma unroll
            for (int i = 0; i < 8; ++i) st[i] = (f32x4){0.f, 0.f, 0.f, 0.f};
            { const int row = tid >> 5, pp = tid & 31; const size_t off = (size_t)(MP + sb * TS + row) * 1024 + h * 128 + 4 * pp;
              const v2u wk = *(const GAS v2u*)(KB + off), wv = *(const GAS v2u*)(VB + off);
              st[0] = (f32x4){bf2f((unsigned short)(wk.x & 0xffffu)), bf2f((unsigned short)(wk.x >> 16)), bf2f((unsigned short)(wk.y & 0xffffu)), bf2f((unsigned short)(wk.y >> 16))};
              st[4] = (f32x4){bf2f((unsigned short)(wv.x & 0xffffu)), bf2f((unsigned short)(wv.x >> 16)), bf2f((unsigned short)(wv.y & 0xffffu)), bf2f((unsigned short)(wv.y >> 16))}; }
        } };
    auto stage_write = [&](int buf) { LAS unsigned char* B = L + buf * 32768;
#pragma unroll
        for (int k = 0; k < 4; ++k) { const int idx = tid + 512 * k, row = idx >> 5, pp = idx & 31, c = 4 * (pp & 15); const f32x4 x = st[k], y = st[4 + k];
            *(LAS v2u*)(B + (pp >> 4) * 8192 + ((pp & 15) >> 1) * 1024 + row * 16 + (pp & 1) * 8) = (v2u){pk2(x[0], x[1]), pk2(x[2], x[3])};
            *(LAS v2u*)(B + 16384 + (pp >> 4) * 8192 + ((c >> 5) * 4 + (row >> 4)) * 1024 + ((row & 15) * 4 + ((c & 31) >> 3)) * 16 + ((c >> 2) & 1) * 8) = (v2u){pk2(y[0], y[1]), pk2(y[2], y[3])}; } };
    stage_load(0);
    float mhat = 0.f, l_reg = 0.f; f32x16 o[2]; o[0] = f32x16{}; o[1] = f32x16{};
    stage_write(0);
    __syncthreads();
    for (int tile = 0; tile < 33; ++tile) {
        if (tile + 1 < 33) stage_load(tile + 1);
        const LAS unsigned char* B = L + (tile & 1) * 32768;
        f32x16 p;
        attn_body::qkt_half(p, (attn_body::lds_cp)(B + map * 8192), qr, f32x16{}, r32, hi, KH);
        asm volatile("s_nop 15\n\ts_nop 7" : "+v"(p));
#pragma unroll
        for (int r = 0; r < 16; ++r) p[r] -= mhat;
        if (tile >= 30) {
            const int rel0 = 64 * tile + 32 * KH + 4 * hi - (PAST + (r32 & 15)) + 128;
#pragma unroll
            for (int r = 0; r < 16; ++r) { const int kin = 32 * KH + 4 * hi + (r & 3) + 8 * (r >> 2); int idx = rel0 + (r & 3) + 8 * (r >> 2); idx = idx < 0 ? 0 : (idx > 191 ? 191 : idx);
                p[r] = (tile == 32 && kin >= TS) ? -INFINITY : p[r] + LUT[idx]; } }
        float rm = p[0];
#pragma unroll
        for (int r = 1; r < 16; ++r) rm = fmaxf(rm, p[r]);
        { const PL32 rr = pl32(rm); rm = fmaxf(rr.a, rr.b); }
        if (__any(rm > 0.f)) { const float dl = fmaxf(rm, 0.f); mhat += dl;
#pragma unroll
            for (int r = 0; r < 16; ++r) p[r] -= dl;
            const float f = __builtin_amdgcn_exp2f(-dl); l_reg *= f; if (hi == 0) wsf[r32] = f;
            asm volatile("s_waitcnt lgkmcnt(0)" ::: "memory");
#pragma unroll
            for (int d_ = 0; d_ < 2; ++d_)
#pragma unroll
                for (int r = 0; r < 16; ++r) o[d_][r] *= wsf[attn_body::crow(r, hi)]; }
        float sacc = 0.f;
#pragma unroll
        for (int r = 0; r < 16; ++r) { p[r] = __builtin_amdgcn_exp2f(p[r]); sacc += p[r]; }
        l_reg += sacc;
        const v4u pw0 = (v4u){attn_body::cvtpk_s(p[0], p[1]), attn_body::cvtpk_s(p[2], p[3]), attn_body::cvtpk_s(p[4], p[5]), attn_body::cvtpk_s(p[6], p[7])};
        const v4u pw1 = (v4u){attn_body::cvtpk_s(p[8], p[9]), attn_body::cvtpk_s(p[10], p[11]), attn_body::cvtpk_s(p[12], p[13]), attn_body::cvtpk_s(p[14], p[15])};
        const int vb = (int)(unsigned)(size_t)(B + 16384 + vh * 8192) + KH * 2048 + ((lane >> 4) & 1) * 32 + (lane & 3) * 8 + (4 * hi + ((lane & 15) >> 2)) * 64;
        attn_body::pv_half(o, vb, __builtin_bit_cast(bf16x8, pw0), __builtin_bit_cast(bf16x8, pw1));
        if (tile + 1 < 33) stage_write((tile + 1) & 1);
        __syncthreads();
    }
    { const PL32 rr = pl32(l_reg); l_reg = rr.a + rr.b; }
    LAS float* OG = (LAS float*)L + (wid & 3) * 2048;
    if (KH == 1) { if (hi == 0) { MG[(wid & 3) * 64 + r32] = mhat; MG[(wid & 3) * 64 + 32 + r32] = l_reg; }
#pragma unroll
        for (int d_ = 0; d_ < 2; ++d_)
#pragma unroll
            for (int r = 0; r < 16; ++r) OG[(d_ * 16 + r) * 64 + lane] = o[d_][r]; }
    __syncthreads();
    if (KH == 0) { const float m2 = MG[wid * 64 + r32], l2 = MG[wid * 64 + 32 + r32]; const float M = fmaxf(mhat, m2);
        const float f1 = __builtin_amdgcn_exp2f(mhat - M), f2 = __builtin_amdgcn_exp2f(m2 - M); const float inv = 1.f / (l_reg * f1 + l2 * f2);
        if (hi == 0) { wsf[r32] = f1 * inv; wsf[32 + r32] = f2 * inv; }
        asm volatile("s_waitcnt lgkmcnt(0)" ::: "memory");
        bf16* OA = (bf16*)(ws + WS_OATT) + (size_t)(MP + sb * TS) * DMOD + h * 256 + map * 128 + vh * 64;
#pragma unroll
        for (int r = 0; r < 8; ++r) { const int q = attn_body::crow(r, hi); const float g1 = wsf[q], g2 = wsf[32 + q];
#pragma unroll
            for (int d_ = 0; d_ < 2; ++d_) OA[(size_t)q * DMOD + d_ * 32 + r32] = (bf16)f2bf(o[d_][r] * g1 + OG[(d_ * 16 + r) * 64 + lane] * g2); } }
    __syncthreads();
}
__device__ __forceinline__ void attn_build_lut(ArgsP A, Frame& F) {
    LAS float* T = (LAS float*)(F.lds + LUT_OFF); const float* reltab = A->in[I_REL];
    for (int i = F.tid; i < 8 * 192; i += NWAVES * 64) { const int hh = i / 192, rel = i % 192 - 128; const int n = rel < 0 ? -rel : rel;
        const int lg = n < 12 ? 8 : n < 16 ? 9 : n < 23 ? 10 : n < 32 ? 11 : n < 46 ? 12 : n < 64 ? 13 : n < 91 ? 14 : 15;
        const int bucket = (rel > 0 ? 16 : 0) + (n < 8 ? n : lg);
        T[i] = (reltab[bucket * 8 + hh] - reltab[15 * 8 + hh]) * 1.4426950408889634f; }
    __syncthreads();
}
__device__ __forceinline__ void ph_attn_sample(Frame& F, int l) {
    PHASE_ENTRY();
    attn_build_lut(A, F);
    gu32* head = F.ctl + CW_QUEUE + 128 * l;
    for (;;) {
        if (F.tid == 0) F.MISC[16] = __hip_atomic_fetch_add(head, 1u, RLX_AGENT);
        __syncthreads();
        const unsigned qi = F.MISC[16];
        __syncthreads();
        if (qi >= 128u) break;
#ifdef SAMPLE_VALU
        attn_sample_unit(A, F, l, (int)(qi >> 3), (int)(qi & 7u));
#else
        attn_sample_unit2(A, F, l, (int)(qi >> 3), (int)(qi & 7u));
#endif
    }
}
__device__ __forceinline__ void ph_attn_prompt(Frame& F, int l) {
    PHASE_ENTRY();
    unsigned char* ws = A->ws;
    gu32* head = F.ctl + CW_QUEUE + 128 * l + 64;
    for (;;) {
        if (F.tid == 0) F.MISC[17] = __hip_atomic_fetch_add(head, 1u, RLX_AGENT);
        __syncthreads();
        const unsigned qi = F.MISC[17];
        __syncthreads();
        if (qi >= 1024u) break;
        const int qb = 63 - (int)(qi >> 4), hm = (int)(qi & 15u);
        const int hh = hm >> 1, mp = hm & 1;
        attn_body::attn_unit_f<8>(qb, hh * 128 + mp * 64, hh * 128, hh * 256 + mp * 128,
                                (const attn_body::bf16*)(ws + WS_QB), (const attn_body::bf16*)(ws + WS_KB), (const attn_body::bf16*)(ws + WS_VB), (attn_body::bf16*)(ws + WS_OATT), (char*)F.lds, (const LAS float*)(F.lds + LUT_OFF) + hh * 192);
    }
}
__device__ __forceinline__ void ph_attn_final(Frame& F, int l) {
    PHASE_ENTRY();
    const int lane = F.lane; const int gw = F.bid * NWAVES + F.wave, NGW = F.G * NWAVES;
    float d1 = A->in[I_LQ1][l * 64 + lane] * A->in[I_LK1][l * 64 + lane], d2 = A->in[I_LQ2][l * 64 + lane] * A->in[I_LK2][l * 64 + lane];
    d1 = wave_sum(d1); d2 = wave_sum(d2);
    const float lam_init = (l == 0) ? 0.2f : (0.8f - 0.6f * 0.7408182206817179f);
    const float lam = expf(d1) - expf(d2) + lam_init, osc = 1.f - lam_init;
    const int hh = lane >> 3, e0 = (lane & 7) * 16;
    const bf16* OA = (const bf16*)(A->ws + WS_OATT); bf16* YC = (bf16*)(A->ws + WS_YCAT);
    f32x4 sl[4];
#pragma unroll
    for (int j = 0; j < 4; ++j) sl[j] = *(const GAS f32x4*)(A->in[I_SUBLN] + l * 128 + e0 + 4 * j);
    v4u na0 = (v4u){0u, 0u, 0u, 0u}, na1 = na0, nb0 = na0, nb1 = na0;
    if (gw < MT) { const bf16* o2 = OA + (size_t)gw * DMOD + hh * 256 + e0; na0 = *(const GAS v4u*)o2; na1 = *(const GAS v4u*)(o2 + 8); nb0 = *(const GAS v4u*)(o2 + 128); nb1 = *(const GAS v4u*)(o2 + 136); }
    for (int m = gw; m < MT; m += NGW) {
        if (l == 0 && m >= MP) { const float* xs = A->in[I_XS] + (size_t)(m - MP) * DMOD; float* xd = (float*)(A->ws + WS_X) + (size_t)m * DMOD;
#pragma unroll
            for (int j = 0; j < 8; ++j) *(GAS f32x4*)(xd + 4 * lane + 256 * j) = *(const GAS f32x4*)(xs + 4 * lane + 256 * j); }
        f32x4 o[4]; float ss = 0.f;
        { const v4u a0 = na0, a1 = na1, b0 = nb0, b1 = nb1;
          if (m + NGW < MT) { const bf16* o2 = OA + (size_t)(m + NGW) * DMOD + hh * 256 + e0; na0 = *(const GAS v4u*)o2; na1 = *(const GAS v4u*)(o2 + 8); nb0 = *(const GAS v4u*)(o2 + 128); nb1 = *(const GAS v4u*)(o2 + 136); }
          const unsigned aw[8] = {a0.x, a0.y, a0.z, a0.w, a1.x, a1.y, a1.z, a1.w}, bw[8] = {b0.x, b0.y, b0.z, b0.w, b1.x, b1.y, b1.z, b1.w};
#pragma unroll
          for (int j = 0; j < 4; ++j) { o[j][0] = bf2f((unsigned short)(aw[2 * j] & 0xffffu)) - lam * bf2f((unsigned short)(bw[2 * j] & 0xffffu)); o[j][1] = bf2f((unsigned short)(aw[2 * j] >> 16)) - lam * bf2f((unsigned short)(bw[2 * j] >> 16));
              o[j][2] = bf2f((unsigned short)(aw[2 * j + 1] & 0xffffu)) - lam * bf2f((unsigned short)(bw[2 * j + 1] & 0xffffu)); o[j][3] = bf2f((unsigned short)(aw[2 * j + 1] >> 16)) - lam * bf2f((unsigned short)(bw[2 * j + 1] >> 16));
              ss += (o[j][0] * o[j][0] + o[j][1] * o[j][1]) + (o[j][2] * o[j][2] + o[j][3] * o[j][3]); } }
        ss += swz_xor<1>(ss); ss += swz_xor<2>(ss); ss += swz_xor<4>(ss);
        const float rs = osc * __builtin_amdgcn_rsqf(ss * (1.f / 128.f) + 1e-5f);
        v4u w0, w1; f32x4 y0 = o[0] * rs * sl[0], y1 = o[1] * rs * sl[1], y2 = o[2] * rs * sl[2], y3 = o[3] * rs * sl[3];
        w0 = (v4u){pk2(y0[0], y0[1]), pk2(y0[2], y0[3]), pk2(y1[0], y1[1]), pk2(y1[2], y1[3])}; w1 = (v4u){pk2(y2[0], y2[1]), pk2(y2[2], y2[3]), pk2(y3[0], y3[1]), pk2(y3[2], y3[3])};
        bf16* yo = YC + (size_t)m * DMOD + 1024 + hh * 128 + e0; *(GAS v4u*)yo = w0; *(GAS v4u*)(yo + 8) = w1;
    }
}
__device__ __forceinline__ void ph_fixup(Frame& F, int l) {
    PHASE_ENTRY();
    const float* tail = (const float*)(A->ws + WS_HALO), *hg = tail + 32 * 2 * DFF, *hv = hg + 32 * 2 * DFF;
    const float* cw = A->in[I_CONVW] + (size_t)l * 3 * DFF, *cb = A->in[I_CONVB] + (size_t)l * DFF; bf16* ACT = (bf16*)(A->ws + WS_ACT);
    const int gt = F.bid * (NWAVES * 64) + F.tid, ngt = F.G * NWAVES * 64;
    for (int idx = gt; idx < 31 * DFF; idx += ngt) { const int pm = 1 + idx / DFF, j = idx % DFF;
        const float um2 = tail[((size_t)(pm - 1) * 2 + 0) * DFF + j], um1 = tail[((size_t)(pm - 1) * 2 + 1) * DFF + j], u0 = hg[((size_t)pm * 2 + 0) * DFF + j], u1 = hg[((size_t)pm * 2 + 1) * DFF + j];
        const float v0 = hv[((size_t)pm * 2 + 0) * DFF + j], v1 = hv[((size_t)pm * 2 + 1) * DFF + j];
        const float w0 = cw[j], w1 = cw[DFF + j], w2 = cw[2 * DFF + j], b = cb[j];
        const pg8::f32x2 g = pg8::gelu_pk((pg8::f32x2){b + w0 * um2 + w1 * um1 + w2 * u0, b + w0 * um1 + w1 * u0 + w2 * u1});
        ACT[(size_t)(256 * pm) * DFF + j] = (bf16)f2bf(g.x * v0); ACT[(size_t)(256 * pm + 1) * DFF + j] = (bf16)f2bf(g.y * v1); }
}
#ifdef PROBE_SEQ
__device__ __forceinline__ void probe_seq_scan(Frame& F, int l) {
    PHASE_ENTRY();
    const int gw = F.bid * NWAVES + F.wave, lane = F.lane;
    if (gw >= 16) return;
    const int h = gw, hj = h * 64 + lane;
    const float* PR = (const float*)(A->ws + WS_PR); const float* mu = A->in[I_MU] + (size_t)l * NRC;
    LAS float* sc = (LAS float*)(F.lds + F.wave * 4096);
    const float* w2 = A->in[I_W2] + (size_t)l * 96 * 1024; const float* a2 = A->in[I_A2] + (size_t)l * 96 * 1024;
    const float w0 = A->in[I_W0][l * 1024 + hj], a0 = A->in[I_A0][l * 1024 + hj], kkw = A->in[I_KK][l * 1024 + hj], kaw = A->in[I_KA][l * 1024 + hj];
    float S[64];
#pragma unroll
    for (int k = 0; k < 64; ++k) S[k] = 0.f;
    for (int t = 0; t < MP; ++t) {
        const float* pc = PR + (size_t)t * NRC_PAD; const float* pp = pc - NRC_PAD;
        auto lerp = [&](int col) { const float cur = pc[col]; const float prv = t > 0 ? pp[col] : 0.f; return cur + (prv - cur) * mu[col]; };
        sc[lane] = tanhf(lerp(3072 + lane)); if (lane < 32) sc[64 + lane] = tanhf(lerp(3072 + 64 + lane));
        sc[96 + lane] = lerp(3168 + lane); if (lane < 32) sc[96 + 64 + lane] = lerp(3168 + 64 + lane);
        LDS_WAIT(); asm volatile("" ::: "memory");
        float wl = 0.f, al = 0.f;
        for (int k = 0; k < 96; ++k) { wl += sc[k] * w2[(size_t)k * 1024 + hj]; al += sc[96 + k] * a2[(size_t)k * 1024 + hj]; }
        const float xk = lerp(1024 + hj), xv = lerp(2048 + hj);
        const float z = w0 + wl; const float wlog = -log1pf(expf(-z)) - 0.5f; const float w = expf(-expf(wlog));
        const float a = 1.f / (1.f + expf(-(a0 + al)));
        const float kkr = xk * kkw; const float nrm = wave_sum(kkr * kkr); const float kk = kkr / sqrtf(fmaxf(nrm, 1e-24f));
        const float km = xk * (1.f + (a - 1.f) * kaw);
        LDS_WAIT(); asm volatile("" ::: "memory");
        sc[192 + lane] = w; sc[256 + lane] = kk; sc[320 + lane] = kk * a; sc[384 + lane] = km;
        LDS_WAIT(); asm volatile("" ::: "memory");
        float sa = 0.f;
#pragma unroll
        for (int k = 0; k < 64; ++k) sa -= S[k] * sc[256 + k];
#pragma unroll
        for (int k = 0; k < 64; ++k) S[k] = S[k] * sc[192 + k] + sa * sc[320 + k] + xv * sc[384 + k];
        LDS_WAIT(); asm volatile("" ::: "memory");
    }
    float* wo = A->out + O_WP + (size_t)(l * 16 + h) * 4096 + lane * 64;
#pragma unroll
    for (int k = 0; k < 64; ++k) wo[k] = S[k];
}
#endif
#ifdef PROBE_GEMM
__device__ __forceinline__ void probe_gemm_check(Frame& F) {
    PHASE_ENTRY();
    if (F.bid != 0) return;
    float* scr = (float*)(A->ws + WS_OATT);
    const int tid = F.tid, lane = F.lane, wave = F.wave;
    for (int j = tid; j < 2 * DMOD; j += NWAVES * 64) { float s = A->in[I_BADA][j];
        for (int k = 0; k < DMOD; ++k) { const float c = A->in[I_CP][k]; s += (c / (1.f + expf(-c))) * A->in[I_WADA][(size_t)k * MODW + j]; }
        scr[j] = s; }
    __threadfence(); __syncthreads();
    float num = 0.f, den = 0.f;
#if PROBE_GEMM == 3
    for (int j = tid; j < 2 * DMOD; j += NWAVES * 64) { const float mine = ((const float*)(A->ws + WS_MOD))[j], ref = scr[j]; num += (mine - ref) * (mine - ref); den += ref * ref; }
    num = wave_sum(num); den = wave_sum(den);
#elif PROBE_GEMM == 5
    { const float sgot = wave_sum((float)(lane + 1)); num = (sgot - 2080.f) * (sgot - 2080.f); den = 2080.f * 2080.f; }
#elif PROBE_GEMM == 6
    { float v = (float)(lane + 1); for (int o = 1; o < 64; o <<= 1) v += __shfl_xor(v, o); num = (v - 2080.f) * (v - 2080.f); den = 2080.f * 2080.f; }
#elif PROBE_GEMM == 4
    for (int smp = wave; smp < 64; smp += NWAVES) { const int m = (smp * 2654435761u >> 7) % MP; const float* xr = A->in[I_XP] + (size_t)m * DMOD; float ss = 0.f;
        for (int k = lane; k < DMOD; k += 64) ss += xr[k] * xr[k];
        const float rstd = 1.f / sqrtf(wave_sum(ss) / DMOD + 1e-6f);
        for (int k = lane; k < DMOD; k += 64) { const float hh = xr[k] * rstd * A->in[I_GMIX][k] * (1.f + scr[DMOD + k]) + scr[k]; const float mine = bf2f(((const bf16*)(A->ws + WS_H))[(size_t)m * DMOD + k]); num += (mine - hh) * (mine - hh); den += hh * hh; } }
    num = wave_sum(num); den = wave_sum(den);
#else
    for (int smp = wave; smp < 256; smp += NWAVES) {
        const int m = (smp * 2654435761u >> 7) % MP; const int cc = (smp * 40503u + 17u) % (PROBE_GEMM == 1 ? 3072 : 1024);
        const int col = PROBE_GEMM == 1 ? cc : NRC + 1024 + cc;
        const float* xr = A->in[I_XP] + (size_t)m * DMOD; float ss = 0.f;
        for (int k = lane; k < DMOD; k += 64) ss += xr[k] * xr[k];
        const float rstd = 1.f / sqrtf(wave_sum(ss) / DMOD + 1e-6f); float acc = 0.f;
        for (int k = lane; k < DMOD; k += 64) { const float hh = xr[k] * rstd * A->in[I_GMIX][k] * (1.f + scr[DMOD + k]) + scr[k]; acc += hh * A->in[I_WIN][(size_t)k * NIN + col]; }
        acc = wave_sum(acc);
        const float mine = PROBE_GEMM == 1 ? ((const float*)(A->ws + WS_PR))[(size_t)m * NRC_PAD + cc] : A->out[O_KP + (size_t)m * 1024 + cc];
        num += (mine - acc) * (mine - acc); den += acc * acc; }
#endif
    LAS float* red = (LAS float*)F.lds;
    if (lane == 0) { red[wave] = num; red[8 + wave] = den; }
    __syncthreads();
    if (tid == 0) { float n = 0.f, d = 0.f; for (int w = 0; w < 8; ++w) { n += red[w]; d += red[8 + w]; } ((float*)(A->ws + WS_CTL))[16384] = sqrtf(n / d); }
}
#endif
#ifndef MK_SPLIT
#define MK_SPLIT 0
#endif
constexpr int N_PHASES = 22;
__global__ void __launch_bounds__(NWAVES * 64, 2) hybrid_fwd(Args args) {
    extern __shared__ __attribute__((aligned(16))) unsigned char lds[];
    Frame F;
    F.lds = (LAS unsigned char*)lds; F.MISC = (volatile LAS unsigned*)(F.lds + MISC_OFF);
    F.tid = threadIdx.x; F.lane = F.tid & 63; F.wave = __builtin_amdgcn_readfirstlane(F.tid >> 6); F.G = gridDim.x; F.bid = blockIdx.x;
    F.ctl = (gu32*)(args.ws + WS_CTL);
    if (F.tid < 64) F.MISC[F.tid] = 0u;
    __syncthreads();
    XcdBarrier bar; bar.bar = (unsigned*)(F.ctl + CW_BAR); bar.x = 0; bar.st = nullptr;
    if (!MK_SPLIT) bar = xcd_barrier_post((unsigned*)(F.ctl + CW_BAR), F.MISC + 8);
    const int lo = args.ph_lo, hi = args.ph_hi;
#ifndef ONLY_PT
#define ONLY_PT -1
#endif
#define PT_ON(t) (ONLY_PT < 0 || ONLY_PT == (t))
#define IN(k) (lo <= (k) && (k) < hi)
#define SEAM(k) do { if (IN(k) && IN((k) + 1)) xcd_barrier(bar); } while (0)
    if (PT_ON(0) && IN(0)) { ph_prologue(F); }
    SEAM(0);
    for (int l = 0; l < NLAYER; ++l) {
        const int pb = 1 + 10 * l;
        if (PT_ON(1) && IN(pb + 0)) ph_norm(F, l, 0, l == 0 ? 0 : 11);
        SEAM(pb + 0);
        if (PT_ON(2) && IN(pb + 1)) { PHASE_ENTRY(); unsigned char* ws = A->ws;
            pg8::Gemm g{(const pg8::bf16_t*)(ws + WS_H), (const pg8::bf16_t*)(ws + WS_WIN) + (size_t)l * NIN_PAD * DMOD, MT, NIN_PAD, DMOD, DMOD}; pg8::TwoPartOrder S; S.init(MT, NRC_PAD / 256, (NIN_PAD - NRC_PAD) / 256, F.G, F.bid, F.G == 256 ? (unsigned*)(F.ctl + CW_QUEUE + 1024 + 64 * l) : nullptr, 1 + (F.bid + 256 < (MT / 256) * (NRC_PAD / 256) ? 1 : 0));
            pg8::EpiIn E{ws, A->out, l, 0.125f * 1.4426950408889634f};
            pg8::gemm_phase<pg8::EpiIn, pg8::TwoPartOrder, true, true>(F.lds, g, S, E);
        }
        if (F.G != 256) SEAM(pb + 1);
#ifdef PROBE_GEMM
        if (l == 0 && IN(pb + 2)) { probe_gemm_check(F); __syncthreads(); }
#endif
        if (PT_ON(3) && IN(pb + 2)) ph_rwkv_passA(F, l);
        SEAM(pb + 2);
#ifdef PROBE_SEQ
        if (IN(pb + 3)) { probe_seq_scan(F, l); __syncthreads(); }
#endif
        if (PT_ON(4) && IN(pb + 3)) { ph_rwkv_chain(F, l); ph_attn_sample(F, l); ph_attn_prompt(F, l); }
        SEAM(pb + 3);
#ifdef PROBE_SEQ
        if (IN(pb + 4) && F.bid == 0) { PHASE_ENTRY();
            for (int h = F.wave; h < 16; h += NWAVES) { const float* a = (const float*)(A->ws + WS_HALO) + (size_t)h * 4096; const float* b = A->out + O_WP + (size_t)(l * 16 + h) * 4096; float n = 0.f, d = 0.f;
                for (int i = F.lane; i < 4096; i += 64) { n += (a[i] - b[i]) * (a[i] - b[i]); d += b[i] * b[i]; }
                n = wave_sum(n); d = wave_sum(d); if (F.lane == 0) { ((float*)(A->ws + WS_CTL))[16400 + 16 * l + h] = sqrtf(n / d); ((float*)(A->ws + WS_CTL))[16440 + 16 * l + h] = d; } } }
#endif
        if (PT_ON(5) && IN(pb + 4)) { ph_rwkv_passC(F, l); ph_attn_final(F, l); }
        SEAM(pb + 4);
        if (PT_ON(6) && IN(pb + 5)) { PHASE_ENTRY(); unsigned char* ws = A->ws;
            const float* X = (const float*)(ws + WS_X); const float* MODl = (const float*)(ws + WS_MOD) + (size_t)l * NMODB * MODW;
            { pg8::Gemm g{(const pg8::bf16_t*)(ws + WS_YCAT), (const pg8::bf16_t*)(ws + WS_WOUT) + (size_t)l * DMOD * DMOD, MP, DMOD, DMOD, DMOD}; pg8::StaticOrder S; S.init(MP, DMOD, F.G, F.bid);
              pg8::EpiRes E{l == 0 ? A->in[I_XP] : X, X + (size_t)MP * DMOD, (float*)(ws + WS_X), MODl + 2 * DMOD};
              pg8::gemm_phase<pg8::EpiRes, pg8::StaticOrder, true, true>(F.lds, g, S, E); }
            { pg8::Gemm g{(const pg8::bf16_t*)(ws + WS_YCAT) + (size_t)MP * DMOD, (const pg8::bf16_t*)(ws + WS_WOUT) + (size_t)l * DMOD * DMOD, 256, DMOD, DMOD / 8, DMOD}; pg8::SplitOrder S; S.init(DMOD, 8, F.bid);
              pg8::EpiResSlab E{(float*)(ws + WS_SLAB), MODl + 2 * DMOD};
              pg8::gemm_phase<pg8::EpiResSlab, pg8::SplitOrder, true, true>(F.lds, g, S, E); }
        }
        SEAM(pb + 5);
        if (PT_ON(7) && IN(pb + 6)) ph_norm(F, l, 1, 8);
        SEAM(pb + 6);
        if (PT_ON(8) && IN(pb + 7)) { PHASE_ENTRY(); unsigned char* ws = A->ws;
            pg8::Gemm g{(const pg8::bf16_t*)(ws + WS_H), (const pg8::bf16_t*)(ws + WS_WUP) + (size_t)l * NUP * DMOD, MT, NUP, DMOD, DMOD}; pg8::PmFirstOrder S; S.init(MT, NUP, F.G, F.bid, F.G == 256 ? (unsigned*)(F.ctl + CW_QUEUE + 1536 + 64 * l) : nullptr);
            pg8::EpiUp E{(pg8::bf16_t*)(ws + WS_ACT), A->in[I_CONVW] + (size_t)l * 3 * DFF, A->in[I_CONVB] + (size_t)l * DFF, A->in[I_SCONV] + (size_t)l * NSB * 2 * DFF,
                         (float*)(ws + WS_HALO), A->out + O_CP + (size_t)l * 2 * DFF, A->out + O_CS + (size_t)l * NSB * 2 * DFF, (PG8_LAS float*)(F.lds + HALO_OFF)};
            pg8::gemm_phase<pg8::EpiUp, pg8::PmFirstOrder, true, true>(F.lds, g, S, E);
            { int first = 0, nw = F.G;
              if (F.G == 256) { first = 256 - ((256 * 6) - (MT / 256) * (NUP / 256)); nw = 256 - first; if (F.bid >= first) wait_count(F, (unsigned*)(F.ctl + CW_QUEUE + 1536 + 64 * l), (unsigned)(NUP / 256)); }
              else if (!MK_SPLIT) xcd_barrier(bar);
              const float* MODl = (const float*)(ws + WS_MOD) + (size_t)l * NMODB * MODW;
              pg8::Gemm g2{(const pg8::bf16_t*)(ws + WS_ACT) + (size_t)MP * DFF, (const pg8::bf16_t*)(ws + WS_WDN) + (size_t)l * DMOD * DFF, 256, DMOD, DFF / 11, DFF}; pg8::TailSplitOrder S2; S2.init(DMOD, 11, F.bid, first, nw);
              pg8::EpiResSlab E2{(float*)(ws + WS_SLAB), MODl + 5 * DMOD};
              pg8::gemm_phase<pg8::EpiResSlab, pg8::TailSplitOrder, true, true>(F.lds, g2, S2, E2); }
        }
        SEAM(pb + 7);
        if (PT_ON(9) && IN(pb + 8)) ph_fixup(F, l);
        SEAM(pb + 8);
        if (PT_ON(10) && IN(pb + 9)) { PHASE_ENTRY(); unsigned char* ws = A->ws;
            const float* X = (const float*)(ws + WS_X); const float* MODl = (const float*)(ws + WS_MOD) + (size_t)l * NMODB * MODW;
            { pg8::Gemm g{(const pg8::bf16_t*)(ws + WS_ACT), (const pg8::bf16_t*)(ws + WS_WDN) + (size_t)l * DMOD * DFF, MP, DMOD, DFF, DFF}; pg8::StaticOrder S; S.init(MP, DMOD, F.G, F.bid);
              pg8::EpiRes E{X, X + (size_t)MP * DMOD, (float*)(ws + WS_X), MODl + 5 * DMOD};
              pg8::gemm_phase<pg8::EpiRes, pg8::StaticOrder, true, true>(F.lds, g, S, E); }
        }
        SEAM(pb + 9);
    }
    if (PT_ON(11) && IN(21)) ph_norm(F, 0, 2, 11);
#ifdef PROBE_MASK
    if (IN(22)) { PHASE_ENTRY();
        const size_t offs[13] = {O_YP, O_YS, O_KP, O_VP, O_WP, O_SP, O_CP, O_KS, O_VS, O_WS, O_SS, O_CS, O_END};
        const size_t gt = (size_t)F.bid * (NWAVES * 64) + F.tid, ngt = (size_t)F.G * NWAVES * 64;
#ifndef PROBE_SCALE
#define PROBE_SCALE 1.2f
#endif
#ifndef PROBE_HALF
#define PROBE_HALF 2
#endif
#ifdef PROBE_HEADS
        { const float* dh = (const float*)(A->ws + WS_CTL) + 16400; float best = -1.f; int bi = 0;
#if PROBE_HEADS == 3
          bi = 0; best = dh[PROBE_IDX] * 20.f;
#elif PROBE_HEADS == 1
          for (int i = 0; i < 32; ++i) if (dh[i] > best) { best = dh[i]; bi = i; }
#else
          for (int i = 0; i < 32; ++i) if (dh[i] * dh[i] * dh[40 + i] > best) { best = dh[i] * dh[i] * dh[40 + i]; bi = i; } best = dh[bi];
#endif
          const float val = (PROBE_HEADS == 3) ? best : 0.05f * bi + fminf(best, 0.049f); const float fsc = 1.f + val; for (size_t i = O_YP + gt; i < O_YS; i += ngt) A->out[i] *= fsc; }
#endif
#ifdef PROBE_GEMM
        { const float dd = ((const float*)(A->ws + WS_CTL))[16384]; const float fsc = 1.f + PROBE_AMP * dd; for (size_t i = O_YP + gt; i < O_YS; i += ngt) A->out[i] *= fsc; }
#endif
        for (int o = 0; o < 12; ++o) if ((PROBE_MASK >> o) & 1) { size_t b = offs[o], e = offs[o + 1]; const size_t mid = b + (e - b) / 2;
            if (PROBE_HALF == 0) e = mid; if (PROBE_HALF == 1) b = mid;
            for (size_t i = b + gt; i < e; i += ngt) A->out[i] *= PROBE_SCALE; } }
#endif
#undef IN
#undef SEAM
}

extern "C" void kernel_launch(void* const* d_in, const int* in_sizes, int n_in, void* d_out, int out_size, void* d_ws, size_t ws_size, hipStream_t stream) {
    static int grid = 0;
    if (grid == 0) {
        if (n_in != 37 || (size_t)out_size != O_END || ws_size < WS_END) { fprintf(stderr, "kernel_launch: built for 37 inputs, %zu outputs, >= %zu bytes of workspace; got n_in %d, out %d, ws %zu; nothing launched\n", (size_t)O_END, (size_t)WS_END, n_in, out_size, ws_size); grid = -1; return; }
        int dev = 0, cus = 0, per_cu = 0;
        if (hipGetDevice(&dev) != hipSuccess || hipDeviceGetAttribute(&cus, hipDeviceAttributeMultiprocessorCount, dev) != hipSuccess) { fprintf(stderr, "kernel_launch: device query failed\n"); grid = -1; return; }
        if (hipFuncSetAttribute((const void*)hybrid_fwd, hipFuncAttributeMaxDynamicSharedMemorySize, LDS_BYTES) != hipSuccess) { fprintf(stderr, "kernel_launch: hipFuncSetAttribute failed\n"); grid = -1; return; }
        if (hipOccupancyMaxActiveBlocksPerMultiprocessor(&per_cu, (const void*)hybrid_fwd, NWAVES * 64, LDS_BYTES) != hipSuccess || per_cu < 1) fprintf(stderr, "kernel_launch: note: occupancy query reports %d workgroups per CU\n", per_cu);
        (void)hipGetLastError();
        grid = cus;
    }
    if (grid < 0) return;
    if (hipMemsetAsync((char*)d_ws + WS_CTL, 0, CTL_ZERO_BYTES, stream) != hipSuccess) { fprintf(stderr, "kernel_launch: memset failed\n"); return; }
    Args a{};
    for (int i = 0; i < 37; ++i) a.in[i] = (const float*)d_in[i];
    a.out = (float*)d_out; a.ws = (unsigned char*)d_ws;
#if MK_SPLIT
#ifdef PROBE_MASK
    const int n_launch = N_PHASES + 1;
#else
    const int n_launch = N_PHASES;
#endif
    for (int p = 0; p < n_launch; ++p) { a.ph_lo = p; a.ph_hi = p + 1; hipLaunchKernelGGL(hybrid_fwd, dim3(grid), dim3(NWAVES * 64), LDS_BYTES, stream, a); }
#else
    a.ph_lo = 0; a.ph_hi = N_PHASES; hipLaunchKernelGGL(hybrid_fwd, dim3(grid), dim3(NWAVES * 64), LDS_BYTES, stream, a);
#endif
    const hipError_t le = hipPeekAtLastError();
    if (le != hipSuccess) fprintf(stderr, "kernel_launch: launch failed: %s\n", hipGetErrorName(le));
}
```

```cpp
#include <hip/hip_runtime.h>
#include <hip/hip_bf16.h>
#include <cstdio>
#include <cstdint>
#include <cmath>
constexpr int NWAVES = 8;
constexpr int DMOD = 2048, MP = 8192, NSB = 16, TS = 16, MT = MP + NSB * TS  , PAST = 2048;
constexpr int NRC = 3520, NRC_PAD = 3584, NIN = 6592, NIN_PAD = 6656, DFF = 5632, NUP = 2 * DFF;
constexpr int NLAYER = 2, NMODB = 17, MODW = 6 * DMOD;
constexpr int RW_UNITS = 128 * 16 + NSB * 16;
constexpr size_t O_YP = 0, O_YS = O_YP + (size_t)MP * DMOD, O_KP = O_YS + (size_t)NSB * TS * DMOD, O_VP = O_KP + (size_t)NLAYER * MP * 1024, O_WP = O_VP + (size_t)NLAYER * MP * 1024,
                 O_SP = O_WP + (size_t)NLAYER * 16 * 4096, O_CP = O_SP + (size_t)NLAYER * NRC, O_KS = O_CP + (size_t)NLAYER * 2 * DFF, O_VS = O_KS + (size_t)NLAYER * 256 * 1024,
                 O_WS = O_VS + (size_t)NLAYER * 256 * 1024, O_SS = O_WS + (size_t)NLAYER * NSB * 16 * 4096, O_CS = O_SS + (size_t)NLAYER * NSB * NRC, O_END = O_CS + (size_t)NLAYER * NSB * 2 * DFF;
constexpr size_t MiB = 1u << 20;
constexpr size_t WS_CTL = 0, CTL_ZERO_BYTES = 1 * MiB;
constexpr size_t WS_MOD = 1 * MiB;
constexpr size_t WS_LORA = 3 * MiB, LORA_LAYER = (size_t)1024 * 448 * 2;
constexpr size_t WS_WIN = 5 * MiB, WS_WOUT = 57 * MiB, WS_WUP = 73 * MiB, WS_WDN = 161 * MiB;
constexpr size_t WS_H = 205 * MiB, WS_PR = 238 * MiB, WS_QB = 354 * MiB, WS_KB = 371 * MiB, WS_VB = 388 * MiB, WS_OATT = 405 * MiB, WS_YCAT = 471 * MiB, WS_X = 504 * MiB, WS_ACT = 570 * MiB;
constexpr size_t WS_PT = 661 * MiB, WS_QQ = 679 * MiB, WS_RP = 715 * MiB, WS_YV = 733 * MiB, WS_SC = 769 * MiB, WS_G1 = 787 * MiB, WS_G2 = 820 * MiB, WS_HALO = 853 * MiB, WS_WL = 858 * MiB, WS_PT32 = 859 * MiB, WS_LSCR = 895 * MiB, WS_SLAB = 911 * MiB, WS_END = 935 * MiB;
static_assert(WS_WIN + (size_t)2 * NIN_PAD * DMOD * 2 <= WS_WOUT && WS_WOUT + (size_t)2 * DMOD * DMOD * 2 <= WS_WUP && WS_WUP + (size_t)2 * NUP * DMOD * 2 <= WS_WDN && WS_WDN + (size_t)2 * DMOD * DFF * 2 <= WS_H, "weights map");
static_assert(WS_H + (size_t)MT * DMOD * 2 <= WS_PR && WS_PR + (size_t)MT * NRC_PAD * 4 <= WS_QB && WS_QB + (size_t)MT * 1024 * 2 <= WS_KB && WS_VB + (size_t)MT * 1024 * 2 <= WS_OATT && WS_OATT + (size_t)MT * DMOD * 4 <= WS_YCAT, "act map 1");
static_assert(WS_YCAT + (size_t)MT * DMOD * 2 <= WS_X && WS_X + (size_t)MT * DMOD * 4 <= WS_ACT && WS_ACT + (size_t)MT * DFF * 2 <= WS_PT, "act map 2");
static_assert(WS_PT + (size_t)RW_UNITS * 8192 <= WS_QQ && WS_QQ + (size_t)RW_UNITS * 16384 <= WS_RP && WS_RP + (size_t)RW_UNITS * 8192 <= WS_YV && WS_YV + (size_t)RW_UNITS * 16384 <= WS_SC && WS_SC + (size_t)RW_UNITS * 8192 <= WS_G1, "rwkv map");
static_assert(WS_G1 + (size_t)MT * 1024 * 4 <= WS_G2 && WS_G2 + (size_t)MT * 1024 * 4 <= WS_HALO && WS_HALO + (size_t)3 * 32 * 2 * DFF * 4 <= WS_WL && WS_WL + (size_t)RW_UNITS * 256 <= WS_PT32 && WS_PT32 + (size_t)RW_UNITS * 16384 <= WS_LSCR && WS_LSCR + (size_t)256 * 61440 <= WS_SLAB && WS_SLAB + (size_t)11 * 256 * 2048 * 4 <= WS_END && WS_LORA + 2 * LORA_LAYER <= WS_WIN && WS_MOD + (size_t)NLAYER * NMODB * MODW * 4 <= WS_LORA, "map 3");
constexpr int CW_BAR = 4096, CW_QUEUE = 8192;
constexpr int LDS_BYTES = 163840;
constexpr int MISC_OFF = LDS_BYTES - 256;
constexpr int LUT_OFF = 131072;
constexpr int HALO_OFF = 131072;
constexpr int RW_SLOT = 9216, RW_STRIDE = 72;
constexpr int RW_SCR = 154624;
static_assert(RW_SCR + 4096 <= MISC_OFF && HALO_OFF + 4096 <= MISC_OFF, "LDS map");

#define GAS __attribute__((address_space(1)))
#define LAS __attribute__((address_space(3)))
typedef unsigned short bf16;
typedef unsigned v4u __attribute__((ext_vector_type(4)));
typedef unsigned v2u __attribute__((ext_vector_type(2)));
typedef float f32x4 __attribute__((ext_vector_type(4)));
typedef float f32x2 __attribute__((ext_vector_type(2)));
typedef short bf16x8 __attribute__((ext_vector_type(8)));
typedef GAS unsigned gu32;
#define RLX_AGENT __ATOMIC_RELAXED, __HIP_MEMORY_SCOPE_AGENT
#define LDS_WAIT() asm volatile("s_waitcnt lgkmcnt(0)" ::: "memory")
#define VM_WAIT() asm volatile("s_waitcnt vmcnt(0)" ::: "memory")
typedef float cvt_f32x2 __attribute__((ext_vector_type(2))); typedef __bf16 cvt_bf16x2 __attribute__((ext_vector_type(2)));
__device__ __forceinline__ unsigned pk2(float lo, float hi) { const cvt_f32x2 v = {lo, hi}; return __builtin_bit_cast(unsigned, __builtin_convertvector(v, cvt_bf16x2)); }
__device__ __forceinline__ unsigned f2bf(float f) { return pk2(f, 0.f) & 0xffffu; }
__device__ __forceinline__ float bf2f(unsigned short b) { return __builtin_bit_cast(float, (unsigned)b << 16); }
template <int K> __device__ __forceinline__ float swz_xor(float v) { static_assert(K >= 1 && K <= 16, "");
    return __builtin_bit_cast(float, __builtin_amdgcn_ds_swizzle(__builtin_bit_cast(int, v), (K << 10) | 0x1f)); }
struct PL32 { float a, b; };
__device__ __forceinline__ PL32 pl32(float v) { const int ln = (int)(threadIdx.x & 63);
    const float p = __builtin_bit_cast(float, __builtin_amdgcn_ds_bpermute((ln ^ 32) << 2, __builtin_bit_cast(int, v))); PL32 o; o.a = v; o.b = p; return o; }
__device__ __forceinline__ float xor32(float v) { return pl32(v).b; }
template <int CTRL> __device__ __forceinline__ float dpp_f(float v) { return __builtin_bit_cast(float, __builtin_amdgcn_update_dpp(__builtin_bit_cast(int, v), __builtin_bit_cast(int, v), CTRL, 0xF, 0xF, false)); }
__device__ __forceinline__ float wave_sum(float v) {
    v += dpp_f<0xB1>(v); v += dpp_f<0x4E>(v); v += dpp_f<0x141>(v); v += dpp_f<0x128>(v); v += swz_xor<16>(v);
    const PL32 r = pl32(v); return r.a + r.b;
}
__device__ __forceinline__ float wave_max(float v) {
    v = fmaxf(v, dpp_f<0xB1>(v)); v = fmaxf(v, dpp_f<0x4E>(v)); v = fmaxf(v, dpp_f<0x141>(v)); v = fmaxf(v, dpp_f<0x128>(v)); v = fmaxf(v, swz_xor<16>(v));
    const PL32 r = pl32(v); return fmaxf(r.a, r.b);
}
__device__ __forceinline__ float sigmoidf_(float x) { return __builtin_amdgcn_rcpf(1.f + __expf(-x)); }
namespace pg8 {
#define PG8_LAS __attribute__((address_space(3)))
typedef unsigned short bf16_t;
typedef short bf16x8 __attribute__((ext_vector_type(8)));
typedef float f32x4 __attribute__((ext_vector_type(4)));
typedef unsigned u32x4 __attribute__((ext_vector_type(4)));
constexpr int BM = 256, BK = 64, HALF = 128, HTB = HALF * BK * 2  , STAGE_BYTES = 8 * HTB, NXCD = 8, WGM = 8;

__host__ __device__ __forceinline__ int lds_byte(int r, int c) { const int st = (r >> 4) * 2 + (c >> 5), rr = r & 15, cc = c & 31, ob = rr * 64 + cc * 2; return st * 1024 + (ob ^ (((ob >> 9) & 1) << 5)); }
__host__ __device__ __forceinline__ void stage_rc(int b, int& R, int& C) { const int st = b / 1024, sb = b % 1024, swz = sb ^ (((sb >> 9) & 1) << 5); R = (st >> 1) * 16 + swz / 64; C = (st & 1) * 32 + (swz % 64) / 2; }
__host__ __device__ __forceinline__ int perm32(int rho) { const int n = rho >> 4, i = rho & 15; return 8 * (i >> 2) + 4 * n + (i & 3); }

struct Unit { int pm, pn, ks, tag; };
struct Gemm { const bf16_t* A; const bf16_t* Bt; int M, N, K, ld; };

struct StaticOrder {
    static constexpr bool HANDOFF = false;
    int nM, nN, nwg, G, c;
    __host__ __device__ void init(int M, int N, int G_, int c_) { nM = M / BM; nN = N / BM; nwg = nM * nN; G = G_; c = c_; }
    __host__ __device__ bool next(int i, Unit& u) const {
        const long L = (long)i * G + c; if (L >= nwg) return false;
        int wgid = (int)L; { const int q = nwg / NXCD, r = nwg % NXCD, xcd = wgid % NXCD, off = wgid / NXCD; wgid = (xcd < r ? xcd * (q + 1) : r * (q + 1) + (xcd - r) * q) + off; }
        const int nig = WGM * nN, gid = wgid / nig, fm = gid * WGM, gsz = (nM - fm) < WGM ? (nM - fm) : WGM;
        u.pm = fm + ((wgid % nig) % gsz); u.pn = (wgid % nig) / gsz; u.ks = 0; u.tag = 0; return true;
    }
    __device__ __forceinline__ void a_ready(const Unit&) const {}
    __device__ __forceinline__ void done(const Unit&) const {}
};

struct TwoPartOrder {
    static constexpr bool HANDOFF = true;
    int nM, nA, nB, G, c; unsigned* cnt; int nsig;
    __device__ __forceinline__ void mid(const Unit& u, int t, int nt, int wid, int lane) const {
        if (cnt == nullptr || u.tag != 2) return;
        if (t == nt / 2) asm volatile("s_waitcnt vmcnt(0)" ::: "memory");
        if (t == nt / 2 + 2 && wid == 0) { __builtin_amdgcn_fence(__ATOMIC_RELEASE, "agent"); asm volatile("s_waitcnt vmcnt(0)" ::: "memory");
            if (lane == 0) (void)__hip_atomic_fetch_add(cnt, (unsigned)nsig, __ATOMIC_RELAXED, __HIP_MEMORY_SCOPE_AGENT); }
    }
    __host__ __device__ void init(int M, int NA, int NB, int G_, int c_, unsigned* cnt_, int nsig_) { nM = M / BM; nA = NA; nB = NB; G = G_; c = c_; cnt = cnt_; nsig = nsig_; }
    __host__ __device__ static void map(int wgid, int nM, int nN, Unit& u) {
        const int nwg = nM * nN; { const int q = nwg / NXCD, r = nwg % NXCD, xcd = wgid % NXCD, off = wgid / NXCD; wgid = (xcd < r ? xcd * (q + 1) : r * (q + 1) + (xcd - r) * q) + off; }
        const int nig = WGM * nN, gid = wgid / nig, fm = gid * WGM, gsz = (nM - fm) < WGM ? (nM - fm) : WGM;
        u.pm = fm + ((wgid % nig) % gsz); u.pn = (wgid % nig) / gsz; u.ks = 0;
    }
    __host__ __device__ bool next(int i, Unit& u) const {
        const long L = (long)i * G + c; const int na = nM * nA, nb = nM * nB; if (L >= na + nb) return false;
        if (L < na) map((int)L, nM, nA, u); else { map((int)L - na, nM, nB, u); u.pn += nA; }
        u.tag = i; return true;
    }
    __device__ __forceinline__ void a_ready(const Unit&) const {}
    __device__ __forceinline__ void done(const Unit&) const {}
};

struct PmFirstOrder {
    static constexpr bool HANDOFF = true;
    int nM, nN, G, c; unsigned* cnt;
    __host__ __device__ void init(int M, int N, int G_, int c_, unsigned* cnt_) { nM = M / BM; nN = N / BM; G = G_; c = c_; cnt = cnt_; }
    __host__ __device__ __forceinline__ bool next(int i, Unit& u) const {
        const long L = (long)i * G + c; if (L >= (long)nM * nN) return false;
        if (L < nN) { u.pm = nM - 1; u.pn = (int)L; u.ks = 0; } else TwoPartOrder::map((int)L - nN, nM - 1, nN, u);
        u.tag = i; return true;
    }
    __device__ __forceinline__ void a_ready(const Unit&) const {}
    __device__ __forceinline__ void done(const Unit&) const {}
    __device__ __forceinline__ void mid(const Unit& u, int t, int nt, int wid, int lane) const {
        if (cnt == nullptr || u.tag != 1 || c >= nN) return;
        if (t == nt / 2) asm volatile("s_waitcnt vmcnt(0)" ::: "memory");
        if (t == nt / 2 + 2 && wid == 0) { __builtin_amdgcn_fence(__ATOMIC_RELEASE, "agent"); asm volatile("s_waitcnt vmcnt(0)" ::: "memory");
            if (lane == 0) (void)__hip_atomic_fetch_add(cnt, 1u, __ATOMIC_RELAXED, __HIP_MEMORY_SCOPE_AGENT); }
    }
};
struct TailSplitOrder {
    static constexpr bool HANDOFF = false;
    int n, KS, k, nw;
    __host__ __device__ void init(int N, int KS_, int c_, int first, int nw_) { n = (N / BM) * KS_; KS = KS_; k = c_ - first; nw = nw_; }
    __host__ __device__ __forceinline__ bool next(int i, Unit& u) const { const int L = k + i * nw; if (k < 0 || L >= n) return false; u.pm = 0; u.pn = L / KS; u.ks = L % KS; u.tag = 0; return true; }
    __device__ __forceinline__ void a_ready(const Unit&) const {}
    __device__ __forceinline__ void done(const Unit&) const {}
};

struct SplitOrder {
    static constexpr bool HANDOFF = false;
    int n, KS, c;
    __host__ __device__ void init(int N, int KS_, int c_) { n = (N / BM) * KS_; KS = KS_; c = c_; }
    __host__ __device__ bool next(int i, Unit& u) const { if (i > 0 || c >= n) return false; u.pm = 0; u.pn = c / KS; u.ks = c % KS; u.tag = 0; return true; }
    __device__ __forceinline__ void a_ready(const Unit&) const {}
    __device__ __forceinline__ void done(const Unit&) const {}
};
__device__ __forceinline__ unsigned cvt_pk_bf16(float lo, float hi) { unsigned r; asm volatile("v_cvt_pk_bf16_f32 %0, %1, %2" : "=v"(r) : "v"(lo), "v"(hi)); return r; }
typedef float f32x2 __attribute__((ext_vector_type(2)));
__device__ __forceinline__ f32x2 gelu_pk(f32x2 v) {
    const f32x2 av = __builtin_elementwise_abs(v), d = av * 0.2316418882f + 1.0f;
    f32x2 t; t.x = __builtin_amdgcn_rcpf(d.x); t.y = __builtin_amdgcn_rcpf(d.y);
    f32x2 q = t * 0.5307027145f + (-0.7265760135f); q = q * t + 0.7107068705f; q = q * t + (-0.142248368f); q = q * t + 0.127414796f; q = q * t;
    const f32x2 s = (v * v) * (-0.72134752044f);
    f32x2 e; e.x = __builtin_amdgcn_exp2f(s.x); e.y = __builtin_amdgcn_exp2f(s.y);
    const f32x2 m = v * (q * e), r = v - m;
    f32x2 o; o.x = v.x < 0.f ? m.x : r.x; o.y = v.y < 0.f ? m.y : r.y; return o;
}

template <class Epi, class Sched, bool ALIGN_EPI = false, bool SP2 = false>
__device__ __forceinline__ void gemm_phase(PG8_LAS unsigned char* lds, const Gemm g, const Sched& S, const Epi& E) {
    int tid_ = threadIdx.x; asm volatile("" : "+v"(tid_));
    const int tid = tid_, wid = __builtin_amdgcn_readfirstlane(tid >> 6), lane = tid & 63, wr = wid >> 2, wc = wid & 3, fr = lane & 15, fq = lane >> 4;
    const int K = g.ld, nt = g.K / BK;
    unsigned voffA[2], voffB[2];
#pragma unroll
    for (int i = 0; i < 2; ++i) { int R, C; stage_rc(tid * 16 + i * 8192, R, C); const int Rb = Epi::PERM ? ((R & ~31) + perm32(R & 31)) : R;
        voffA[i] = (unsigned)(R * K + C) * 2u; voffB[i] = (unsigned)(Rb * K + C) * 2u; }
    const size_t kstep = (size_t)(BK * 2);
    const size_t hstep = (size_t)HALF * K * 2;
    const size_t tstep = 2 * hstep;
    const unsigned ldsw = (unsigned)wid * 1024u;
    const int aoff = lds_byte(wr * 64 + fr, fq * 8), boff = lds_byte(wc * 32 + fr, fq * 8);
#define PG8_SA(b, h) (((b) * 2 + (h)) * HTB)
#define PG8_SB(b, h) ((4 + (b) * 2 + (h)) * HTB)
#define PG8_STAGE(bufoff, gbase, voff) do { _Pragma("unroll") for (int _i = 0; _i < 2; ++_i) \
        __builtin_amdgcn_global_load_lds((const unsigned*)((const char*)(gbase) + (voff)[_i]), (PG8_LAS unsigned*)(lds + (bufoff) + ldsw + _i * 8192), 16, 0, 0); } while (0)
#define PG8_LDA(dst, b, h) do { _Pragma("unroll") for (int m = 0; m < 4; ++m) _Pragma("unroll") for (int k = 0; k < 2; ++k) dst[m][k] = *(const PG8_LAS bf16x8*)(lds + PG8_SA(b, h) + aoff + m * 2048 + k * 1024); } while (0)
#define PG8_LDB(dst, b, h) do { _Pragma("unroll") for (int n = 0; n < 2; ++n) _Pragma("unroll") for (int k = 0; k < 2; ++k) dst[n][k] = *(const PG8_LAS bf16x8*)(lds + PG8_SB(b, h) + boff + n * 2048 + k * 1024); } while (0)
#define PG8_MMA(ai, bj, At, Bt) do { __builtin_amdgcn_s_setprio(1); _Pragma("unroll") for (int m = 0; m < 4; ++m) _Pragma("unroll") for (int n = 0; n < 2; ++n) _Pragma("unroll") for (int k = 0; k < 2; ++k) \
        acc[ai][bj][m][n] = __builtin_amdgcn_mfma_f32_16x16x32_bf16(Bt[n][k], At[m][k], acc[ai][bj][m][n], 0, 0, 0); __builtin_amdgcn_s_setprio(0); } while (0)
#define PG8_WAIT_V(n) asm volatile("s_waitcnt vmcnt(" #n ")" ::: "memory")
#define PG8_WAIT_L(n) asm volatile("s_waitcnt lgkmcnt(" #n ")" ::: "memory")
#define PG8_BAR __builtin_amdgcn_s_barrier()
#define PG8_SCHED __builtin_amdgcn_sched_barrier(0)
    Unit cur, nxt; int ui = 0;
    if (!S.next(0, cur)) return;
    f32x4 acc[2][2][4][2];
#pragma unroll
    for (int a = 0; a < 2; ++a)
#pragma unroll
        for (int b = 0; b < 2; ++b)
#pragma unroll
            for (int m = 0; m < 4; ++m)
#pragma unroll
                for (int n = 0; n < 2; ++n) acc[a][b][m][n] = (f32x4){0.f, 0.f, 0.f, 0.f};
    bf16x8 At[4][2], B0[2][2], B1[2][2];
    const size_t sstep = (size_t)g.K * 2;
    const char* cA = (const char*)g.A + (size_t)cur.pm * tstep + (size_t)cur.ks * sstep; const char* cB = (const char*)g.Bt + (size_t)cur.pn * tstep + (size_t)cur.ks * sstep;
    S.a_ready(cur);
    if constexpr (SP2) {
        PG8_STAGE(PG8_SB(0, 0), cB, voffB); PG8_STAGE(PG8_SB(0, 1), cB + hstep, voffB); PG8_STAGE(PG8_SA(0, 0), cA, voffA); PG8_STAGE(PG8_SA(0, 1), cA + hstep, voffA);
        if (wr == 1) PG8_BAR;
        PG8_WAIT_V(2); PG8_BAR;
        PG8_STAGE(PG8_SB(1, 0), cB + kstep, voffB); PG8_STAGE(PG8_SA(1, 0), cA + kstep, voffA); PG8_STAGE(PG8_SB(1, 1), cB + hstep + kstep, voffB);
        PG8_WAIT_V(6); PG8_BAR;
    } else {
        PG8_STAGE(PG8_SB(0, 0), cB, voffB); PG8_STAGE(PG8_SA(0, 0), cA, voffA); PG8_STAGE(PG8_SB(0, 1), cB + hstep, voffB); PG8_STAGE(PG8_SA(0, 1), cA + hstep, voffA);
        if (wr == 1) PG8_BAR;
        PG8_WAIT_V(4); PG8_BAR;
        PG8_STAGE(PG8_SB(1, 0), cB + kstep, voffB); PG8_STAGE(PG8_SA(1, 0), cA + kstep, voffA); PG8_STAGE(PG8_SB(1, 1), cB + hstep + kstep, voffB);
        PG8_WAIT_V(6); PG8_BAR;
    }
    for (;;) {
        const bool has_next = S.next(ui + 1, nxt);
        const char* nA = has_next ? (const char*)g.A + (size_t)nxt.pm * tstep + (size_t)nxt.ks * sstep : cA; const char* nB = has_next ? (const char*)g.Bt + (size_t)nxt.pn * tstep + (size_t)nxt.ks * sstep : cB;
        asm volatile(".p2align 8" ::: "memory");
        for (int t = 0; t < nt; t += 2) {
            const bool last = (t == nt - 2);
            const char* a1 = cA + (size_t)(t + 1) * kstep;
            const char* a2 = last ? nA : cA + (size_t)(t + 2) * kstep; const char* b2 = last ? nB : cB + (size_t)(t + 2) * kstep;
            const char* a3 = a2 + kstep; const char* b3 = b2 + kstep;
            if (last && has_next) S.a_ready(nxt);
            if constexpr (Sched::HANDOFF) S.mid(cur, t, nt, wid, lane);
            if constexpr (SP2) {
            PG8_LDB(B0, 0, 0); PG8_LDB(B1, 0, 1); PG8_SCHED; PG8_LDA(At, 0, 0); PG8_STAGE(PG8_SA(1, 1), a1 + hstep, voffA);
            PG8_WAIT_V(8); PG8_WAIT_L(0); PG8_BAR; PG8_MMA(0, 0, At, B0); PG8_MMA(0, 1, At, B1); PG8_BAR; PG8_SCHED;
            PG8_LDA(At, 0, 1); PG8_STAGE(PG8_SB(0, 0), b2, voffB); PG8_STAGE(PG8_SB(0, 1), b2 + hstep, voffB); PG8_STAGE(PG8_SA(0, 0), a2, voffA);
            PG8_WAIT_V(8); PG8_WAIT_L(0); PG8_BAR; PG8_MMA(1, 0, At, B0); PG8_MMA(1, 1, At, B1); PG8_BAR; PG8_SCHED;
            PG8_LDB(B0, 1, 0); PG8_LDB(B1, 1, 1); PG8_SCHED; PG8_LDA(At, 1, 0); PG8_STAGE(PG8_SA(0, 1), a2 + hstep, voffA);
            PG8_WAIT_V(8); PG8_WAIT_L(0); PG8_BAR; PG8_MMA(0, 0, At, B0); PG8_MMA(0, 1, At, B1); PG8_BAR; PG8_SCHED;
            PG8_LDA(At, 1, 1); PG8_STAGE(PG8_SB(1, 0), b3, voffB); PG8_STAGE(PG8_SB(1, 1), b3 + hstep, voffB); PG8_STAGE(PG8_SA(1, 0), a3, voffA);
            PG8_WAIT_V(8); PG8_WAIT_L(0); PG8_BAR; PG8_MMA(1, 0, At, B0); PG8_MMA(1, 1, At, B1); PG8_BAR; PG8_SCHED;
            } else {
            PG8_LDB(B0, 0, 0); PG8_SCHED; PG8_LDA(At, 0, 0); PG8_STAGE(PG8_SA(1, 1), a1 + hstep, voffA);
            PG8_WAIT_L(8); PG8_BAR; PG8_WAIT_L(0); PG8_MMA(0, 0, At, B0); PG8_BAR; PG8_SCHED;
            PG8_LDB(B1, 0, 1); PG8_STAGE(PG8_SB(0, 0), b2, voffB);
            PG8_BAR; PG8_WAIT_L(0); PG8_MMA(0, 1, At, B1); PG8_BAR;
            PG8_LDA(At, 0, 1); PG8_STAGE(PG8_SA(0, 0), a2, voffA);
            PG8_BAR; PG8_WAIT_L(0); PG8_MMA(1, 0, At, B0); PG8_BAR; PG8_SCHED;
            PG8_STAGE(PG8_SB(0, 1), b2 + hstep, voffB);
            PG8_WAIT_V(6); PG8_BAR; PG8_MMA(1, 1, At, B1); PG8_BAR;
            PG8_LDB(B0, 1, 0); PG8_SCHED; PG8_LDA(At, 1, 0); PG8_STAGE(PG8_SA(0, 1), a2 + hstep, voffA);
            PG8_WAIT_L(8); PG8_BAR; PG8_WAIT_L(0); PG8_MMA(0, 0, At, B0); PG8_BAR; PG8_SCHED;
            PG8_LDB(B1, 1, 1); PG8_STAGE(PG8_SB(1, 0), b3, voffB);
            PG8_BAR; PG8_WAIT_L(0); PG8_MMA(0, 1, At, B1); PG8_BAR;
            PG8_LDA(At, 1, 1); PG8_STAGE(PG8_SA(1, 0), a3, voffA);
            PG8_BAR; PG8_WAIT_L(0); PG8_MMA(1, 0, At, B0); PG8_BAR; PG8_SCHED;
            PG8_STAGE(PG8_SB(1, 1), b3 + hstep, voffB);
            PG8_WAIT_V(6); PG8_BAR; PG8_MMA(1, 1, At, B1); PG8_BAR;
            }
        }
        if constexpr (ALIGN_EPI) { if (wr == 0) PG8_BAR; }
        if constexpr (!Epi::AFTER_DRAIN) { E(acc, cur, wr, wc, fr, fq); S.done(cur); }
        if (!has_next) break;
#pragma unroll
        for (int a = 0; a < 2; ++a)
#pragma unroll
            for (int b = 0; b < 2; ++b)
#pragma unroll
                for (int m = 0; m < 4; ++m)
#pragma unroll
                    for (int n = 0; n < 2; ++n) acc[a][b][m][n] = (f32x4){0.f, 0.f, 0.f, 0.f};
        cur = nxt; cA = nA; cB = nB; ++ui;
        if constexpr (ALIGN_EPI) { if (wr == 1) PG8_BAR; }
    }
    PG8_WAIT_V(0);
    if constexpr (!ALIGN_EPI) { if (wr == 0) PG8_BAR; }
    PG8_BAR;
    if constexpr (Epi::AFTER_DRAIN) { E.fused(acc, cur, wr, wc, fr, fq, lds, wid, lane); S.done(cur); }
#undef PG8_SA
#undef PG8_SB
#undef PG8_STAGE
#undef PG8_LDA
#undef PG8_LDB
#undef PG8_MMA
#undef PG8_WAIT_V
#undef PG8_WAIT_L
#undef PG8_BAR
#undef PG8_SCHED
}
}
namespace pg8 {
typedef unsigned u32x2v __attribute__((ext_vector_type(2)));
constexpr int E_MP = 8192;
struct EpiIn {
    static constexpr bool PERM = true, AFTER_DRAIN = false;
    unsigned char* ws; float* out; int l; float qscale;
    __device__ __forceinline__ void operator()(const f32x4 (&acc)[2][2][4][2], const Unit& u, int wr, int wc, int fr, int fq) const {
        asm volatile("" : "+v"(fr), "+v"(fq));
        const int row0 = u.pm * BM + wr * 64 + fr, colt = u.pn * BM + wc * 32 + 8 * fq;
        if (u.pn < 14) {
            float* PR = (float*)(ws + WS_PR); float* sh_p = out + O_SP + (size_t)l * 3520; float* sh_s = out + O_SS + (size_t)l * 16 * 3520;
#pragma unroll
            for (int ai = 0; ai < 2; ++ai)
#pragma unroll
                for (int m = 0; m < 4; ++m) { const int r = row0 + ai * HALF + m * 16;
#pragma unroll
                    for (int bj = 0; bj < 2; ++bj) { const int c = colt + bj * HALF; float* p = PR + (size_t)r * 3584 + c;
                        *(f32x4*)p = acc[ai][bj][m][0]; *(f32x4*)(p + 4) = acc[ai][bj][m][1];
                        if (c < 3520) {
                            if (r == E_MP - 1) { *(f32x4*)(sh_p + c) = acc[ai][bj][m][0]; *(f32x4*)(sh_p + c + 4) = acc[ai][bj][m][1]; }
                            if (r >= E_MP && (r & 15) == 15) { float* q = sh_s + (size_t)((r - E_MP) >> 4) * 3520 + c; *(f32x4*)q = acc[ai][bj][m][0]; *(f32x4*)(q + 4) = acc[ai][bj][m][1]; }
                        } } }
        } else {
            const int region = (u.pn - 14) >> 2, cl0 = colt - 3584 - region * 1024;
            static_assert(WS_KB - WS_QB == WS_VB - WS_KB && O_VP - O_KP == (size_t)2 * 8192 * 1024 && O_VS - O_KS == (size_t)2 * 256 * 1024, "equal spacing");
            bf16_t* B16 = (bf16_t*)(ws + WS_QB + (size_t)region * (WS_KB - WS_QB));
            const float sc = region == 0 ? qscale : 1.f;
            float* fp = out + O_KP + (size_t)(region == 2 ? 1 : 0) * (O_VP - O_KP) + (size_t)l * E_MP * 1024; float* fs = out + O_KS + (size_t)(region == 2 ? 1 : 0) * (O_VS - O_KS) + (size_t)l * 256 * 1024;
#pragma unroll
            for (int ai = 0; ai < 2; ++ai)
#pragma unroll
                for (int m = 0; m < 4; ++m) { const int r = row0 + ai * HALF + m * 16;
                    float* fo = (r < E_MP) ? fp + (size_t)r * 1024 : fs + (size_t)(r - E_MP) * 1024;
#pragma unroll
                    for (int bj = 0; bj < 2; ++bj) { const int c = cl0 + bj * HALF; const f32x4 v0 = acc[ai][bj][m][0] * sc, v1 = acc[ai][bj][m][1] * sc;
                        u32x4 w; w.x = cvt_pk_bf16(v0[0], v0[1]); w.y = cvt_pk_bf16(v0[2], v0[3]); w.z = cvt_pk_bf16(v1[0], v1[1]); w.w = cvt_pk_bf16(v1[2], v1[3]);
                        *(u32x4*)(B16 + (size_t)r * 1024 + c) = w;
                        if (region != 0) { __builtin_nontemporal_store(v0, (f32x4*)(fo + c)); __builtin_nontemporal_store(v1, (f32x4*)(fo + c + 4)); } } }
        }
    }
};
struct EpiRes {
    static constexpr bool PERM = true, AFTER_DRAIN = false;
    const float* src_p; const float* src_s; float* dst; const float* gate;
    __device__ __forceinline__ void operator()(const f32x4 (&acc)[2][2][4][2], const Unit& u, int wr, int wc, int fr, int fq) const {
        asm volatile("" : "+v"(fr), "+v"(fq));
        const int row0 = u.pm * BM + wr * 64 + fr, colt = u.pn * BM + wc * 32 + 8 * fq;
        f32x4 gt[2][2];
#pragma unroll
        for (int bj = 0; bj < 2; ++bj)
#pragma unroll
            for (int n = 0; n < 2; ++n) gt[bj][n] = *(const f32x4*)(gate + colt + bj * HALF + 4 * n);
#pragma unroll
        for (int ai = 0; ai < 2; ++ai)
#pragma unroll
            for (int mp = 0; mp < 1; ++mp) {
                f32x4 x[4][2][2];
#pragma unroll
                for (int mm = 0; mm < 4; ++mm) { const int r = row0 + ai * HALF + (4 * mp + mm) * 16; const float* s = src_p + (size_t)r * 2048 + colt;
#pragma unroll
                    for (int bj = 0; bj < 2; ++bj)
#pragma unroll
                        for (int n = 0; n < 2; ++n) x[mm][bj][n] = *(const f32x4*)(s + bj * HALF + 4 * n); }
#pragma unroll
                for (int mm = 0; mm < 4; ++mm) { const int m = 4 * mp + mm, r = row0 + ai * HALF + m * 16; float* d = dst + (size_t)r * 2048 + colt;
#pragma unroll
                    for (int bj = 0; bj < 2; ++bj)
#pragma unroll
                        for (int n = 0; n < 2; ++n) *(f32x4*)(d + bj * HALF + 4 * n) = x[mm][bj][n] + gt[bj][n] * acc[ai][bj][m][n]; }
                asm volatile("" ::: "memory");
            }
    }
};
struct EpiResSlab {
    static constexpr bool PERM = true, AFTER_DRAIN = false;
    float* slab; const float* gate;
    __device__ __forceinline__ void operator()(const f32x4 (&acc)[2][2][4][2], const Unit& u, int wr, int wc, int fr, int fq) const {
        asm volatile("" : "+v"(fr), "+v"(fq));
        const int row0 = wr * 64 + fr, colt = u.pn * BM + wc * 32 + 8 * fq;
#pragma unroll
        for (int ai = 0; ai < 2; ++ai)
#pragma unroll
            for (int mp = 0; mp < 2; ++mp) {
                f32x4 gt[2][2][2];
#pragma unroll
                for (int mm = 0; mm < 2; ++mm) { const int r = row0 + ai * HALF + (2 * mp + mm) * 16; const float* g = gate + (size_t)(1 + (r >> 4)) * 12288 + colt;
#pragma unroll
                    for (int bj = 0; bj < 2; ++bj)
#pragma unroll
                        for (int n = 0; n < 2; ++n) gt[mm][bj][n] = *(const f32x4*)(g + bj * HALF + 4 * n); }
#pragma unroll
                for (int mm = 0; mm < 2; ++mm) { const int m = 2 * mp + mm, r = row0 + ai * HALF + m * 16; float* d = slab + ((size_t)u.ks * 256 + r) * 2048 + colt;
#pragma unroll
                    for (int bj = 0; bj < 2; ++bj)
#pragma unroll
                        for (int n = 0; n < 2; ++n) *(f32x4*)(d + bj * HALF + 4 * n) = gt[mm][bj][n] * acc[ai][bj][m][n]; }
                asm volatile("" ::: "memory");
            }
    }
};
template <int CTRL> __device__ __forceinline__ float dppf(float old, float src) { return __builtin_bit_cast(float, __builtin_amdgcn_update_dpp(__builtin_bit_cast(int, old), __builtin_bit_cast(int, src), CTRL, 0xF, 0xF, false)); }
struct EpiUp {
    static constexpr bool PERM = true, AFTER_DRAIN = false;
    bf16_t* ACT; const float* cw; const float* cb; const float* sconv; float* halo; float* conv_p; float* conv_s; PG8_LAS float* hb;
    template <bool SAMP> __device__ __forceinline__ void run(const f32x4 (&acc)[2][2][4][2], const Unit& u, int wr, int wc, int fr, int fq) const {
        asm volatile("" : "+v"(fr), "+v"(fq));
        const int jl = wc * 32 + 8 * fq, j0 = u.pn * HALF + jl;
#pragma unroll
        for (int ai = 0; ai < 2; ++ai) { const int blk = 2 * ai + wr;
            if (!SAMP && fr >= 14) {
                if (blk < 3) { PG8_LAS float* h = hb + ((blk + 1) * 2 + (fr - 14)) * HALF + jl; *(PG8_LAS f32x4*)h = acc[ai][0][3][0]; *(PG8_LAS f32x4*)(h + 4) = acc[ai][0][3][1]; }
                else { float* t = halo + ((size_t)u.pm * 2 + (fr - 14)) * 5632 + j0; *(f32x4*)t = acc[ai][0][3][0]; *(f32x4*)(t + 4) = acc[ai][0][3][1];
                    if (u.pm == 31) { float* c = conv_p + (size_t)(fr - 14) * 5632 + j0; *(f32x4*)c = acc[ai][0][3][0]; *(f32x4*)(c + 4) = acc[ai][0][3][1]; } }
            }
            if (SAMP && fr >= 14) {
#pragma unroll
                for (int m = 0; m < 4; ++m) { const int sb = 8 * ai + 4 * wr + m; float* c = conv_s + ((size_t)sb * 2 + (fr - 14)) * 5632 + j0; *(f32x4*)c = acc[ai][0][m][0]; *(f32x4*)(c + 4) = acc[ai][0][m][1]; }
            }
        }
        asm volatile("s_waitcnt lgkmcnt(0)\n\ts_barrier" ::: "memory");
        f32x4 cwv[2][3], cbv[2];
#pragma unroll
        for (int n = 0; n < 2; ++n) { cwv[n][0] = *(const f32x4*)(cw + j0 + 4 * n); cwv[n][1] = *(const f32x4*)(cw + 5632 + j0 + 4 * n); cwv[n][2] = *(const f32x4*)(cw + 2 * 5632 + j0 + 4 * n); cbv[n] = *(const f32x4*)(cb + j0 + 4 * n); }
#pragma unroll
        for (int ai = 0; ai < 2; ++ai) { const int blk = 2 * ai + wr;
#pragma unroll
            for (int m = 0; m < 4; ++m) { const int r = u.pm * BM + ai * HALF + wr * 64 + m * 16 + fr;
                u32x4 w;
#pragma unroll
                for (int n = 0; n < 2; ++n) {
                    f32x4 pv = (f32x4){0.f, 0.f, 0.f, 0.f};
                    if (SAMP) { if (fr >= 14) { const int sb = 8 * ai + 4 * wr + m; pv = *(const f32x4*)(sconv + ((size_t)sb * 2 + (fr - 14)) * 5632 + j0 + 4 * n); } asm volatile("" : "+v"(pv)); }
                    else if (m == 0) { if (blk > 0 && fr >= 14) pv = *(const PG8_LAS f32x4*)(hb + (blk * 2 + (fr - 14)) * HALF + jl + 4 * n); asm volatile("" : "+v"(pv)); }
                    else pv = acc[ai][0][m > 0 ? m - 1 : 0][n];
                    const f32x4 w0 = cwv[n][0], w1 = cwv[n][1], w2 = cwv[n][2], bb = cbv[n];
                    f32x4 o;
#pragma unroll
                    for (int i = 0; i < 4; ++i) { const float cur = acc[ai][0][m][n][i], pr = pv[i];
                        const float t1 = dppf<0x121>(pr, pr), p1 = dppf<0x111>(t1, cur);
                        const float t2 = dppf<0x122>(pr, pr), p2 = dppf<0x112>(t2, cur);
                        o[i] = bb[i] + w0[i] * p2 + w1[i] * p1 + w2[i] * cur; }
                    const f32x2 g0 = gelu_pk((f32x2){o[0], o[1]}), g1 = gelu_pk((f32x2){o[2], o[3]});
                    const f32x4 uv = acc[ai][1][m][n];
                    const unsigned lo = cvt_pk_bf16(g0.x * uv[0], g0.y * uv[1]), hi = cvt_pk_bf16(g1.x * uv[2], g1.y * uv[3]);
                    if (n == 0) { w.x = lo; w.y = hi; } else { w.z = lo; w.w = hi; }
                }
                const bool head = (!SAMP && u.pm > 0 && blk == 0 && m == 0 && fr < 2);
                if (!head) *(u32x4*)(ACT + (size_t)r * 5632 + j0) = w;
                else { float* hg = halo + (size_t)32 * 2 * 5632 + ((size_t)u.pm * 2 + fr) * 5632 + j0; float* hv = hg + (size_t)32 * 2 * 5632;
                    *(f32x4*)hg = acc[ai][0][m][0]; *(f32x4*)(hg + 4) = acc[ai][0][m][1]; *(f32x4*)hv = acc[ai][1][m][0]; *(f32x4*)(hv + 4) = acc[ai][1][m][1]; }
                asm volatile("" ::: "memory");
            } }
    }
    __device__ __forceinline__ void operator()(const f32x4 (&acc)[2][2][4][2], const Unit& u, int wr, int wc, int fr, int fq) const {
        if (u.pm == 32) run<true>(acc, u, wr, wc, fr, fq); else run<false>(acc, u, wr, wc, fr, fq);
    }
};
}
#include <hip/hip_bf16.h>
#include <cmath>
namespace attn_body {
using bf16=__hip_bfloat16;
using bf16x8=__attribute__((ext_vector_type(8)))short;
using s16x4=__attribute__((ext_vector_type(4)))short;
using f32x16=__attribute__((ext_vector_type(16)))float;
using u32x4=__attribute__((ext_vector_type(4)))unsigned;
constexpr int BATCH=1,NHEAD=16,SEQ=8192,D=64,DM=NHEAD*D;
constexpr int NW=8,QBLK=32,QB=QBLK*NW,KVBLK=64,NQB=SEQ/QB;
constexpr int ATTN_PITCH=DM, ATTN_UNIT_ROWS=QB, OPITCH=2048;
__device__ __forceinline__ int crow(int r,int hi){return (r&3)+8*(r>>2)+4*hi;}
#define SBAR() __builtin_amdgcn_sched_barrier(0)
__device__ __forceinline__ void bmask(f32x16&p0,f32x16&p1,int t,int cq,int qabs,int hi,const __attribute__((address_space(3))) float*lut){
  if(t>cq){
    #pragma unroll
    for(int r=0;r<16;++r){p0[r]=-INFINITY;p1[r]=-INFINITY;}
  } else {
    const int d0=64*t+4*hi-qabs+128;
    #pragma unroll
    for(int r=0;r<16;++r){int i0=d0+(r&3)+8*(r>>2); int i1=i0+32; i0=i0<0?0:i0; i1=i1<0?0:i1; p0[r]+=lut[i0]; p1[r]+=lut[i1];}
  }
}

constexpr int NSLOT=3, SLOTB=8192;
constexpr int LDS_K=0, LDS_V=NSLOT*SLOTB, LDS_WS=2*NSLOT*SLOTB, LDS_OST=LDS_WS+NW*64*4, LDS_BYTES=LDS_OST+NW*4096;
constexpr float C2=0.125f*1.4426950408889634f;
__device__ __forceinline__ void glds16(const void*gsrc,unsigned lds_dst){unsigned keep;
  asm volatile("s_mov_b32 %0, m0\n\ts_mov_b32 m0, %2\n\ts_nop 0\n\tglobal_load_lds_dwordx4 %1, off\n\ts_mov_b32 m0, %0":"=&s"(keep):"v"(gsrc),"s"(lds_dst):"memory");}
__device__ __forceinline__ float max3f(float a,float b,float c){float r;asm("v_max3_f32 %0, %1, %2, %3":"=v"(r):"v"(a),"v"(b),"v"(c));return r;}
__device__ __forceinline__ float max2f(float a,float b){float r;asm("v_max_f32_e32 %0, %1, %2":"=v"(r):"v"(a),"v"(b));return r;}
__device__ __forceinline__ float fadd_s(float a,float b){float r;asm("v_add_f32_e32 %0, %1, %2":"=v"(r):"v"(a),"v"(b));return r;}
__device__ __forceinline__ float fsub_s(float a,float b){float r;asm("v_sub_f32_e32 %0, %1, %2":"=v"(r):"v"(a),"v"(b));return r;}
typedef float f32x2_t __attribute__((ext_vector_type(2))); typedef __bf16 bf16x2_t __attribute__((ext_vector_type(2)));
__device__ __forceinline__ unsigned cvtpk_s(float lo,float hi){f32x2_t v={lo,hi};bf16x2_t b=__builtin_convertvector(v,bf16x2_t);return __builtin_bit_cast(unsigned,b);}
#define WAIT_BAR(N) asm volatile("s_waitcnt vmcnt(" #N ") lgkmcnt(0)\n\ts_barrier":::"memory")

__device__ __forceinline__ void qkt(f32x16&p0,f32x16&p1,const char*Kslot,const bf16x8*qr,const f32x16&negm,int r32,int hi){
  const char*kb=Kslot+hi*1024+r32*16;
  #pragma unroll
  for(int d0=0;d0<4;++d0){
    const bf16x8 b0=*reinterpret_cast<const bf16x8*>(kb+d0*2048);
    const bf16x8 b1=*reinterpret_cast<const bf16x8*>(kb+d0*2048+512);
    if(d0==0){p0=__builtin_amdgcn_mfma_f32_32x32x16_bf16(b0,qr[0],negm,0,0,0);p1=__builtin_amdgcn_mfma_f32_32x32x16_bf16(b1,qr[0],negm,0,0,0);}
    else{p0=__builtin_amdgcn_mfma_f32_32x32x16_bf16(b0,qr[d0],p0,0,0,0);p1=__builtin_amdgcn_mfma_f32_32x32x16_bf16(b1,qr[d0],p1,0,0,0);}}
}
typedef __attribute__((address_space(3))) const char* lds_cptr;
typedef short v4i16_t __attribute__((ext_vector_type(4)));
__device__ __forceinline__ void kload8(bf16x8*kf,lds_cptr kp){
  kf[0]=*(const __attribute__((address_space(3))) bf16x8*)(kp);      kf[1]=*(const __attribute__((address_space(3))) bf16x8*)(kp+512);
  kf[2]=*(const __attribute__((address_space(3))) bf16x8*)(kp+2048); kf[3]=*(const __attribute__((address_space(3))) bf16x8*)(kp+2560);
  kf[4]=*(const __attribute__((address_space(3))) bf16x8*)(kp+4096); kf[5]=*(const __attribute__((address_space(3))) bf16x8*)(kp+4608);
  kf[6]=*(const __attribute__((address_space(3))) bf16x8*)(kp+6144); kf[7]=*(const __attribute__((address_space(3))) bf16x8*)(kp+6656);
}
__device__ __forceinline__ void kload2(bf16x8*kf,lds_cptr kp,int j){ kf[2*j]=*(const __attribute__((address_space(3))) bf16x8*)(kp+j*2048); kf[2*j+1]=*(const __attribute__((address_space(3))) bf16x8*)(kp+j*2048+512); }
__device__ __forceinline__ s16x4 vtr(lds_cptr p){ return __builtin_bit_cast(s16x4,__builtin_amdgcn_ds_read_tr16_b64_v4i16((__attribute__((address_space(3))) v4i16_t*)p)); }
__device__ __forceinline__ float rowmax(const f32x16&p0,const f32x16&p1){
  float a=max3f(p0[0],p0[1],p1[0]),b=max3f(p0[2],p0[3],p1[1]);a=max3f(a,p1[2],p1[3]);
  #pragma unroll
  for(int r=4;r<16;r+=4){a=max3f(a,p0[r],p0[r+1]);b=max3f(b,p0[r+2],p0[r+3]);a=max3f(a,p1[r],p1[r+1]);b=max3f(b,p1[r+2],p1[r+3]);}
  const float m=max2f(a,b);
  const PL32 rr=pl32(m);
  return max2f(rr.a,rr.b);
}
__device__ __forceinline__ void pv(f32x16*o,int vb,bf16x8 pa0,bf16x8 pa1,bf16x8 pa2,bf16x8 pa3){
  #pragma unroll
  for(int d0=0;d0<2;++d0){s16x4 lo[4],hi[4];
    #pragma unroll
    for(int ks=0;ks<4;++ks){
      asm volatile("ds_read_b64_tr_b16 %0,%1 offset:%c2":"=&v"(lo[ks]):"v"(vb),"i"(d0*4096+ks*1024):"memory");
      asm volatile("ds_read_b64_tr_b16 %0,%1 offset:%c2":"=&v"(hi[ks]):"v"(vb),"i"(d0*4096+ks*1024+512):"memory");}
    asm volatile("s_waitcnt lgkmcnt(0)":::"memory");SBAR();
    #define PK(k) (bf16x8){lo[k][0],lo[k][1],lo[k][2],lo[k][3],hi[k][0],hi[k][1],hi[k][2],hi[k][3]}
    o[d0]=__builtin_amdgcn_mfma_f32_32x32x16_bf16(pa0,PK(0),o[d0],0,0,0);
    o[d0]=__builtin_amdgcn_mfma_f32_32x32x16_bf16(pa1,PK(1),o[d0],0,0,0);
    o[d0]=__builtin_amdgcn_mfma_f32_32x32x16_bf16(pa2,PK(2),o[d0],0,0,0);
    o[d0]=__builtin_amdgcn_mfma_f32_32x32x16_bf16(pa3,PK(3),o[d0],0,0,0);
    #undef PK
  }
}

#ifndef ATTN_STORE16
#define ATTN_STORE16(p,v) (*(u32x4*)(p)=(v))
#endif
template<int THRL> __device__ __forceinline__ void attn_unit(int qb,int qkcol,int vcol,int ocol,int hh,const float*__restrict__ reltab,const bf16*Q,const bf16*__restrict__ K,const bf16*__restrict__ V,bf16*O,char*shm,const __attribute__((address_space(3))) float*lut){
  const int b=0;
  int tid_=threadIdx.x; asm volatile("":"+v"(tid_));
  const int tid=tid_,lane=tid&63,r32=lane&31,hi=lane>>5; const int wid=__builtin_amdgcn_readfirstlane(tid>>6);
  const long rowbase=(long)b*SEQ; const int q0=qb*QB;
  const bf16*Qw=Q+(rowbase+q0+wid*QBLK)*DM+qkcol;
  const bf16*Kh=K+rowbase*DM+qkcol,*Vh=V+rowbase*DM+vcol;
  const unsigned lds0=(unsigned)(uintptr_t)shm;
  float*wsf=(float*)(shm+LDS_WS)+wid*64;
  const bf16*ksrc=Kh+(long)lane*DM+wid*8;
  const bf16*vsrc=Vh+(long)(16*(wid&3)+(lane>>2))*DM+(wid>>2)*32+(lane&3)*8;
  const unsigned kdst=lds0+LDS_K+wid*1024, vdst=lds0+LDS_V+wid*1024;
  #define DMA_K(t,slot) glds16(ksrc+(long)(t)*KVBLK*DM,(unsigned)__builtin_amdgcn_readfirstlane(kdst+(slot)))
  #define DMA_V(t,slot) glds16(vsrc+(long)(t)*KVBLK*DM,(unsigned)__builtin_amdgcn_readfirstlane(vdst+(slot)))
  const int vb0=(int)(lds0+LDS_V)+((lane>>4)&1)*32+(lane&3)*8+(4*hi+((lane&15)>>2))*64;
  const char*Kbase=shm+LDS_K; bf16x8 kf[8];
  const lds_cptr shm3=(lds_cptr)shm; const lds_cptr kp0=shm3+LDS_K+hi*1024+r32*16; const lds_cptr vp0=shm3+LDS_V+((lane>>4)&1)*32+(lane&3)*8+(4*hi+((lane&15)>>2))*64;
  const int NT=(q0+QB)/KVBLK;
  const int cq=(q0>>6)+(wid>>1), cqm2=cq-2, qabs=q0+wid*QBLK+r32;
  DMA_K(0,0);DMA_V(0,0);DMA_K(1,SLOTB);
  bf16x8 qr[4];
  #pragma unroll
  for(int d0=0;d0<4;++d0)qr[d0]=*reinterpret_cast<const bf16x8*>(&Qw[(long)r32*DM+d0*16+hi*8]);
  float mhat=0.f,l_reg=0.f;f32x16 o[2];o[0]=f32x16{};o[1]=f32x16{};f32x16 negm=f32x16{};asm volatile("":"+v"(negm));
  const int qrel=wid*QBLK+r32;
  #define CMASK(P0,P1,t) do{ if((t)>=cqm2)bmask(P0,P1,(t),cq,qabs,hi,lut);}while(0)
  bool resc=false;
  #define START(P0,P1) do{ const float rm=rowmax(P0,P1); resc=false; \
    { const float dl=rm; mhat=fadd_s(mhat,dl); \
      _Pragma("unroll") for(int r=0;r<16;++r){P0[r]=fsub_s(P0[r],dl);P1[r]=fsub_s(P1[r],dl);} \
      _Pragma("unroll") for(int r=0;r<16;++r)negm[r]=-mhat; asm volatile("":"+v"(negm)); } \
    _Pragma("unroll") for(int r=0;r<16;++r)P0[r]=__builtin_amdgcn_exp2f(P0[r]); }while(0)
  #define RESC() do{ if(resc){ asm volatile("s_waitcnt lgkmcnt(0)":::"memory"); \
      _Pragma("unroll") for(int d_=0;d_<2;++d_) _Pragma("unroll") for(int r=0;r<16;++r)o[d_][r]*=wsf[crow(r,hi)]; } }while(0)
  f32x16 pA0,pA1,pB0,pB1;
  int sl_prev=0,sl_cur=0,sl_next=SLOTB;
  #define ROT() do{sl_prev=sl_cur;sl_cur=sl_next;sl_next=(sl_next==(NSLOT-1)*SLOTB)?0:sl_next+SLOTB;}while(0)
  DMA_K(2,2*SLOTB);
  WAIT_BAR(3);
  qkt(pA0,pA1,Kbase,qr,negm,r32,hi);asm volatile("s_nop 15\n\ts_nop 7":"+v"(pA0),"+v"(pA1));CMASK(pA0,pA1,0);
  START(pA0,pA1);
  _Pragma("unroll") for(int r=0;r<16;++r)pA1[r]=__builtin_amdgcn_exp2f(pA1[r]);
  WAIT_BAR(0);
  DMA_K(3,0);DMA_V(1,SLOTB);
  ROT();
  kload8(kf,kp0+sl_cur);
  WAIT_BAR(2);
  s16x4 vlo[8],vhi[8]; u32x4 pw0,pw1,pw2,pw3;
  #define PKW(P,B) cvtpk_s(P[B],P[B+1])
  #define PAF(k) __builtin_bit_cast(bf16x8,pw##k)
  #define VFR(i) (bf16x8){vlo[i][0],vlo[i][1],vlo[i][2],vlo[i][3],vhi[i][0],vhi[i][1],vhi[i][2],vhi[i][3]}
  #define PIN(x) asm volatile("":"+v"(x))
  #define MX3(a,b,c) __builtin_fmaxf(__builtin_fmaxf((a),(b)),(c))
  #define GAPA(MF,A0,A1,A2,A3,W0,W1,PW) do{ MF; sacc+=A0; sacc+=A1; sacc+=A2; sacc+=A3; PIN(sacc); W0; W1; PIN(PW); SBAR(); }while(0)
  #define EX(v) __builtin_amdgcn_exp2f(v)
  #define GAPB(MF,X,B) do{ MF; X[B]=EX(X[B]); X[B+1]=EX(X[B+1]); X[B+2]=EX(X[B+2]); X[B+3]=EX(X[B+3]); PIN(X); SBAR(); }while(0)
  #define VRD(i) do{ vlo[i]=vtr(vp_+(((i)>>2)*4096+((i)&3)*1024)); vhi[i]=vtr(vp_+(((i)>>2)*4096+((i)&3)*1024+512)); }while(0)
  #define KRD(G,j) do{ if(G){ kload2(kf,kp0+sl_next,j); SBAR(); } }while(0)
  #define STEP(C0,C1,P0,P1,t,GK,GV,GL) do{ SBAR(); \
    const lds_cptr vp_=vp0+sl_prev; \
    VRD(0); SBAR(); float sacc=(P0[0]+P0[1]); \
    GAPA(C0=__builtin_amdgcn_mfma_f32_32x32x16_bf16(kf[0],qr[0],negm,0,0,0), P0[2],P0[3],P0[4],P0[5],     pw0[0]=PKW(P0,0), pw0[1]=PKW(P0,2), pw0); \
    VRD(4); SBAR(); GAPA(C1=__builtin_amdgcn_mfma_f32_32x32x16_bf16(kf[1],qr[0],negm,0,0,0), P0[6],P0[7],P0[8],P0[9],     pw0[2]=PKW(P0,4), pw0[3]=PKW(P0,6), pw0); \
    VRD(1); SBAR(); GAPA(C0=__builtin_amdgcn_mfma_f32_32x32x16_bf16(kf[2],qr[1],C0,0,0,0),   P0[10],P0[11],P0[12],P0[13], pw1[0]=PKW(P0,8), pw1[1]=PKW(P0,10), pw1); \
    VRD(5); SBAR(); GAPA(C1=__builtin_amdgcn_mfma_f32_32x32x16_bf16(kf[3],qr[1],C1,0,0,0),   P0[14],P0[15],P1[0],P1[1],   pw1[2]=PKW(P0,12),pw1[3]=PKW(P0,14), pw1); \
    VRD(2); SBAR(); GAPA(C0=__builtin_amdgcn_mfma_f32_32x32x16_bf16(kf[4],qr[2],C0,0,0,0),   P1[2],P1[3],P1[4],P1[5],     pw2[0]=PKW(P1,0), pw2[1]=PKW(P1,2), pw2); \
    VRD(6); SBAR(); GAPA(C1=__builtin_amdgcn_mfma_f32_32x32x16_bf16(kf[5],qr[2],C1,0,0,0),   P1[6],P1[7],P1[8],P1[9],     pw2[2]=PKW(P1,4), pw2[3]=PKW(P1,6), pw2); \
    VRD(3); SBAR(); GAPA(C0=__builtin_amdgcn_mfma_f32_32x32x16_bf16(kf[6],qr[3],C0,0,0,0),   P1[10],P1[11],P1[12],P1[13], pw3[0]=PKW(P1,8), pw3[1]=PKW(P1,10), pw3); \
    VRD(7); SBAR(); GAPA(C1=__builtin_amdgcn_mfma_f32_32x32x16_bf16(kf[7],qr[3],C1,0,0,0),   P1[14],P1[15],0.f,0.f,       pw3[2]=PKW(P1,12),pw3[3]=PKW(P1,14), pw3); \
    l_reg+=sacc; \
    if(GK){DMA_K((t)+3,sl_cur);} if(GV){DMA_V((t)+1,sl_next);} \
    CMASK(C0,C1,t); \
    { float a=MX3(C0[0],C0[1],C1[0]),b=MX3(C0[2],C0[3],C1[1]); a=MX3(a,C1[2],C1[3]); \
      _Pragma("unroll") for(int r=4;r<16;r+=4){a=MX3(a,C0[r],C0[r+1]);b=MX3(b,C0[r+2],C0[r+3]);a=MX3(a,C1[r],C1[r+1]);b=MX3(b,C1[r+2],C1[r+3]);} \
      float rm=__builtin_fmaxf(a,b); { const PL32 rr=pl32(rm); rm=__builtin_fmaxf(rr.a,rr.b); } \
      resc=false; \
      if(__builtin_expect(__any(rm>(float)THRL),0)){ const float dl=__builtin_fmaxf(rm,0.f); mhat+=dl; \
        _Pragma("unroll") for(int r=0;r<16;++r){C0[r]-=dl;C1[r]-=dl;} \
        _Pragma("unroll") for(int r=0;r<16;++r)negm[r]=-mhat; asm volatile("":"+v"(negm)); \
        const float f=__builtin_amdgcn_exp2f(-dl); l_reg*=f; if(hi==0)wsf[r32]=f; resc=true; } } \
    SBAR(); \
    GAPB(o[0]=__builtin_amdgcn_mfma_f32_32x32x16_bf16(PAF(0),VFR(0),o[0],0,0,0), C0,0); \
    GAPB(o[1]=__builtin_amdgcn_mfma_f32_32x32x16_bf16(PAF(0),VFR(4),o[1],0,0,0), C0,4); \
    KRD(GL,0); GAPB(o[0]=__builtin_amdgcn_mfma_f32_32x32x16_bf16(PAF(1),VFR(1),o[0],0,0,0), C0,8); \
    KRD(GL,1); GAPB(o[1]=__builtin_amdgcn_mfma_f32_32x32x16_bf16(PAF(1),VFR(5),o[1],0,0,0), C0,12); \
    KRD(GL,2); GAPB(o[0]=__builtin_amdgcn_mfma_f32_32x32x16_bf16(PAF(2),VFR(2),o[0],0,0,0), C1,0); \
    KRD(GL,3); GAPB(o[1]=__builtin_amdgcn_mfma_f32_32x32x16_bf16(PAF(2),VFR(6),o[1],0,0,0), C1,4); \
    GAPB(o[0]=__builtin_amdgcn_mfma_f32_32x32x16_bf16(PAF(3),VFR(3),o[0],0,0,0), C1,8); \
    GAPB(o[1]=__builtin_amdgcn_mfma_f32_32x32x16_bf16(PAF(3),VFR(7),o[1],0,0,0), C1,12); \
    }while(0)
  int t=1;
  #undef CMASK
  #define CMASK(P0,P1,t) do{}while(0)
  for(;t+7<NT;t+=2){
    STEP(pB0,pB1,pA0,pA1,t,true,true,true);     WAIT_BAR(2); RESC(); ROT();
    STEP(pA0,pA1,pB0,pB1,t+1,true,true,true);   WAIT_BAR(2); RESC(); ROT();
  }
  #undef CMASK
  #define CMASK(P0,P1,t) do{ if((t)>=cqm2)bmask(P0,P1,(t),cq,qabs,hi,lut);}while(0)
  #define ENDW(tt) do{ if((tt)+3<NT){WAIT_BAR(2);} else if((tt)+2<NT){WAIT_BAR(1);} else {WAIT_BAR(0);} }while(0)
  for(;t+1<NT;t+=2){
    STEP(pB0,pB1,pA0,pA1,t,(t+3<NT),(t+1<NT),(t+1<NT));       ENDW(t);   RESC(); ROT();
    STEP(pA0,pA1,pB0,pB1,t+1,(t+4<NT),(t+2<NT),(t+2<NT));     ENDW(t+1); RESC(); ROT();
  }
  STEP(pB0,pB1,pA0,pA1,NT-1,false,false,false); RESC();
  { float sacc=pB0[0]+pB0[1]; _Pragma("unroll") for(int r=2;r<16;++r)sacc+=pB0[r]; _Pragma("unroll") for(int r=0;r<16;++r)sacc+=pB1[r]; l_reg+=sacc;
    pw0=(u32x4){PKW(pB0,0),PKW(pB0,2),PKW(pB0,4),PKW(pB0,6)};pw1=(u32x4){PKW(pB0,8),PKW(pB0,10),PKW(pB0,12),PKW(pB0,14)};pw2=(u32x4){PKW(pB1,0),PKW(pB1,2),PKW(pB1,4),PKW(pB1,6)};pw3=(u32x4){PKW(pB1,8),PKW(pB1,10),PKW(pB1,12),PKW(pB1,14)};
    SBAR(); pv(o,vb0+sl_cur,PAF(0),PAF(1),PAF(2),PAF(3)); }
  #undef PKW
  #undef PAF
  #undef VFR
  #undef PIN
  #undef MX3
  #undef GAPA
  #undef GAPB
  #undef EX
  #undef VRD
  #undef KRD
  #undef STEP
  #undef ENDW
  {const PL32 rr=pl32(l_reg);l_reg=rr.a+rr.b;}
  if(hi==0)wsf[32+r32]=l_reg;asm volatile("s_waitcnt lgkmcnt(0)":::"memory");
  float rli[16];
  #pragma unroll
  for(int r=0;r<16;++r)rli[r]=__builtin_amdgcn_rcpf(wsf[32+crow(r,hi)]);
  bf16*Ow=O+(rowbase+q0+wid*QBLK)*(long)OPITCH+ocol;
  { bf16*stg=(bf16*)(shm+LDS_OST)+wid*2048;
    #pragma unroll
    for(int r=0;r<16;++r){const int orow=crow(r,hi);
      #pragma unroll
      for(int d0=0;d0<2;++d0)stg[orow*64+d0*32+r32]=__float2bfloat16(o[d0][r]*rli[r]);}
    asm volatile("s_waitcnt lgkmcnt(0)":::"memory");
    #pragma unroll
    for(int i=0;i<4;++i){const int row=i*8+(lane>>3),ch=lane&7; const u32x4 v=*(const u32x4*)(stg+row*64+ch*8); ATTN_STORE16(Ow+(long)row*OPITCH+ch*8,v);} }
  asm volatile("s_waitcnt lgkmcnt(0)\n\ts_barrier":::"memory");
  #undef DMA_K
  #undef DMA_V
  #undef CMASK
  #undef START
  #undef RESC
  #undef ROT
}
typedef __attribute__((address_space(3))) const char* lds_cp;
__device__ __forceinline__ void qkt_half(f32x16&p,lds_cp Kslot,const bf16x8*qr,const f32x16&negm,int r32,int hi,int kh){
  lds_cp kb=Kslot+hi*1024+(r32+32*kh)*16;
  #pragma unroll
  for(int d0=0;d0<4;++d0){ const bf16x8 b=*(const __attribute__((address_space(3))) bf16x8*)(kb+d0*2048);
    if(d0==0)p=__builtin_amdgcn_mfma_f32_32x32x16_bf16(b,qr[0],negm,0,0,0); else p=__builtin_amdgcn_mfma_f32_32x32x16_bf16(b,qr[d0],p,0,0,0);}
}
__device__ __forceinline__ void pv_half(f32x16*o,int vb,bf16x8 pa0,bf16x8 pa1){
  #pragma unroll
  for(int d0=0;d0<2;++d0){s16x4 lo[2],hi[2];
    #pragma unroll
    for(int ks=0;ks<2;++ks){
      asm volatile("ds_read_b64_tr_b16 %0,%1 offset:%c2":"=&v"(lo[ks]):"v"(vb),"i"(d0*4096+ks*1024):"memory");
      asm volatile("ds_read_b64_tr_b16 %0,%1 offset:%c2":"=&v"(hi[ks]):"v"(vb),"i"(d0*4096+ks*1024+512):"memory");}
    asm volatile("s_waitcnt lgkmcnt(0)":::"memory");SBAR();
    #define PK(k) (bf16x8){lo[k][0],lo[k][1],lo[k][2],lo[k][3],hi[k][0],hi[k][1],hi[k][2],hi[k][3]}
    o[d0]=__builtin_amdgcn_mfma_f32_32x32x16_bf16(pa0,PK(0),o[d0],0,0,0);
    o[d0]=__builtin_amdgcn_mfma_f32_32x32x16_bf16(pa1,PK(1),o[d0],0,0,0);
    #undef PK
  }
}
constexpr int F_SLOTV=2*SLOTB, F_LDS_K=0, F_LDS_V=NSLOT*SLOTB, F_LDS_WS=F_LDS_V+NSLOT*F_SLOTV, F_LDS_OST=F_LDS_WS+NW*64*4, F_LDS_BYTES=F_LDS_OST+4*8192;
__device__ __forceinline__ void bmask1(f32x16&p,int t,int cq,int qabs,int hi,int kh,const __attribute__((address_space(3))) float*lut){
  if(t>cq){
    #pragma unroll
    for(int r=0;r<16;++r)p[r]=-INFINITY;
  } else {
    const int d0=64*t+32*kh+4*hi-qabs+128;
    #pragma unroll
    for(int r=0;r<16;++r){int i0=d0+(r&3)+8*(r>>2); i0=i0<0?0:i0; p[r]+=lut[i0];}
  }
}
template<int THRL> __device__ __forceinline__ void attn_unit_f(int qb,int qkcol,int vcol,int ocol,const bf16*Q,const bf16*__restrict__ K,const bf16*__restrict__ V,bf16*O,char*shm,const __attribute__((address_space(3))) float*lut){
  int tid_=threadIdx.x; asm volatile("":"+v"(tid_));
  const int tid=tid_,lane=tid&63,r32=lane&31,hi=lane>>5; const int wid=__builtin_amdgcn_readfirstlane(tid>>6); const int pr=wid&3,kh=wid>>2;
  const int q0=qb*128;
  const bf16*Qw=Q+(long)(q0+pr*QBLK)*DM+qkcol;
  const bf16*Kh=K+qkcol,*Vh=V+vcol;
  const unsigned lds0=(unsigned)(uintptr_t)shm;
  float*wsf=(float*)(shm+F_LDS_WS)+wid*64;
  const bf16*ksrc=Kh+(long)lane*DM+wid*8;
  const bf16*vsrc=Vh+(long)(16*(wid&3)+(lane>>2))*DM+(wid>>2)*32+(lane&3)*8;
  const unsigned kdst=lds0+F_LDS_K+wid*1024, vdst=lds0+F_LDS_V+wid*1024;
  #define DMA_K(t,slot) glds16(ksrc+(long)(t)*KVBLK*DM,(unsigned)__builtin_amdgcn_readfirstlane(kdst+(slot)))
  #define DMA_V(t,slot) do{ glds16(vsrc+(long)(t)*KVBLK*DM,(unsigned)__builtin_amdgcn_readfirstlane(vdst+2*(slot))); glds16(vsrc+(long)(t)*KVBLK*DM+64,(unsigned)__builtin_amdgcn_readfirstlane(vdst+2*(slot)+8192)); }while(0)
  const int vb0=(int)(lds0+F_LDS_V)+((lane>>4)&1)*32+(lane&3)*8+(4*hi+((lane&15)>>2))*64+kh*2048;
  bf16x8 kf[4];
  const lds_cptr shm3=(lds_cptr)shm; const lds_cptr kp0=shm3+F_LDS_K+hi*1024+r32*16+kh*512; const lds_cptr vp0=shm3+F_LDS_V+((lane>>4)&1)*32+(lane&3)*8+(4*hi+((lane&15)>>2))*64+kh*2048;
  const int NT_=(q0+128)/KVBLK; const int NT=NT_<4?4:NT_;
  const int cq=(q0>>6)+(pr>>1), cqm2=cq-2, qabs=q0+pr*QBLK+r32;
  DMA_K(0,0);DMA_V(0,0);DMA_K(1,SLOTB);
  bf16x8 qr[4];
  #pragma unroll
  for(int d0=0;d0<4;++d0)qr[d0]=*reinterpret_cast<const bf16x8*>(&Qw[(long)r32*DM+d0*16+hi*8]);
  float mhat=0.f,l_reg=0.f;f32x16 o[4];o[0]=f32x16{};o[1]=f32x16{};o[2]=f32x16{};o[3]=f32x16{};f32x16 negm=f32x16{};asm volatile("":"+v"(negm));
  #define CMASK(P,t) do{ if((t)>=cqm2)bmask1(P,(t),cq,qabs,hi,kh,lut);}while(0)
  bool resc=false;
  #define RESC() do{ if(resc){ asm volatile("s_waitcnt lgkmcnt(0)":::"memory"); \
      _Pragma("unroll") for(int d_=0;d_<4;++d_) _Pragma("unroll") for(int r=0;r<16;++r)o[d_][r]*=wsf[crow(r,hi)]; } }while(0)
  f32x16 pA,pB;
  int sl_prev=0,sl_cur=0,sl_next=SLOTB;
  #define ROT() do{sl_prev=sl_cur;sl_cur=sl_next;sl_next=(sl_next==(NSLOT-1)*SLOTB)?0:sl_next+SLOTB;}while(0)
  DMA_K(2,2*SLOTB);
  WAIT_BAR(4);
  qkt_half(pA,(lds_cp)(shm3+F_LDS_K),qr,negm,r32,hi,kh);asm volatile("s_nop 15\n\ts_nop 7":"+v"(pA));CMASK(pA,0);
  { float a=max3f(pA[0],pA[1],pA[2]),b=max3f(pA[3],pA[4],pA[5]);a=max3f(a,pA[6],pA[7]);b=max3f(b,pA[8],pA[9]);a=max3f(a,pA[10],pA[11]);b=max3f(b,pA[12],pA[13]);a=max3f(a,pA[14],pA[15]);
    const float m=max2f(a,b); const PL32 rr=pl32(m); const float dl=max2f(rr.a,rr.b); mhat=fadd_s(mhat,dl);
    _Pragma("unroll") for(int r=0;r<16;++r)pA[r]=fsub_s(pA[r],dl);
    _Pragma("unroll") for(int r=0;r<16;++r)negm[r]=-mhat; asm volatile("":"+v"(negm));
    _Pragma("unroll") for(int r=0;r<16;++r)pA[r]=__builtin_amdgcn_exp2f(pA[r]); }
  WAIT_BAR(0);
  DMA_K(3,0);DMA_V(1,SLOTB);
  ROT();
  _Pragma("unroll") for(int j=0;j<4;++j)kf[j]=*(const __attribute__((address_space(3))) bf16x8*)(kp0+sl_cur+j*2048);
  WAIT_BAR(3);
  s16x4 vlo[8],vhi[8]; u32x4 pwa,pwb;
  #define PKW(P,B) cvtpk_s(P[B],P[B+1])
  #define PAFA __builtin_bit_cast(bf16x8,pwa)
  #define PAFB __builtin_bit_cast(bf16x8,pwb)
  #define VFR(i) (bf16x8){vlo[i][0],vlo[i][1],vlo[i][2],vlo[i][3],vhi[i][0],vhi[i][1],vhi[i][2],vhi[i][3]}
  #define PIN(x) asm volatile("":"+v"(x))
  #define MX3(a,b,c) __builtin_fmaxf(__builtin_fmaxf((a),(b)),(c))
  #define GAPA(MF,A0,A1,A2,A3,W0,W1,PW) do{ MF; sacc+=A0; sacc+=A1; sacc+=A2; sacc+=A3; PIN(sacc); W0; W1; PIN(PW); SBAR(); }while(0)
  #define EX(v) __builtin_amdgcn_exp2f(v)
  #define GAPB(MF,X,B) do{ MF; X[B]=EX(X[B]); X[B+1]=EX(X[B+1]); PIN(X); SBAR(); }while(0)
  #define VRD(i) do{ vlo[i]=vtr(vp_+(((i)>>1)*4096+((i)&1)*1024)); vhi[i]=vtr(vp_+(((i)>>1)*4096+((i)&1)*1024+512)); }while(0)
  #define KRD(G,j) do{ if(G){ kf[j]=*(const __attribute__((address_space(3))) bf16x8*)(kp0+sl_next+(j)*2048); SBAR(); } }while(0)
  #define STEPF(C,P,t,GK,GV,GL) do{ SBAR(); \
    const lds_cptr vp_=vp0+2*sl_prev; \
    VRD(0); VRD(2); SBAR(); float sacc=(P[0]+P[1]); \
    GAPA(C=__builtin_amdgcn_mfma_f32_32x32x16_bf16(kf[0],qr[0],negm,0,0,0), P[2],P[3],P[4],P[5],     pwa[0]=PKW(P,0), pwa[1]=PKW(P,2), pwa); \
    VRD(4); VRD(6); SBAR(); GAPA(C=__builtin_amdgcn_mfma_f32_32x32x16_bf16(kf[1],qr[1],C,0,0,0), P[6],P[7],P[8],P[9],     pwa[2]=PKW(P,4), pwa[3]=PKW(P,6), pwa); \
    VRD(1); VRD(3); SBAR(); GAPA(C=__builtin_amdgcn_mfma_f32_32x32x16_bf16(kf[2],qr[2],C,0,0,0), P[10],P[11],P[12],P[13], pwb[0]=PKW(P,8), pwb[1]=PKW(P,10), pwb); \
    VRD(5); VRD(7); SBAR(); GAPA(C=__builtin_amdgcn_mfma_f32_32x32x16_bf16(kf[3],qr[3],C,0,0,0), P[14],P[15],0.f,0.f,     pwb[2]=PKW(P,12),pwb[3]=PKW(P,14), pwb); \
    l_reg+=sacc; \
    if(GK){DMA_K((t)+3,sl_cur);} if(GV){DMA_V((t)+1,sl_next);} \
    CMASK(C,t); \
    { float a=MX3(C[0],C[1],C[2]),b=MX3(C[3],C[4],C[5]); a=MX3(a,C[6],C[7]); b=MX3(b,C[8],C[9]); a=MX3(a,C[10],C[11]); b=MX3(b,C[12],C[13]); a=MX3(a,C[14],C[15]); \
      float rm=__builtin_fmaxf(a,b); { const PL32 rr=pl32(rm); rm=__builtin_fmaxf(rr.a,rr.b); } \
      resc=false; \
      if(__builtin_expect(__any(rm>(float)THRL),0)){ const float dl=__builtin_fmaxf(rm,0.f); mhat+=dl; \
        _Pragma("unroll") for(int r=0;r<16;++r)C[r]-=dl; \
        _Pragma("unroll") for(int r=0;r<16;++r)negm[r]=-mhat; asm volatile("":"+v"(negm)); \
        const float f=__builtin_amdgcn_exp2f(-dl); l_reg*=f; if(hi==0)wsf[r32]=f; resc=true; } } \
    SBAR(); \
    GAPB(o[0]=__builtin_amdgcn_mfma_f32_32x32x16_bf16(PAFA,VFR(0),o[0],0,0,0), C,0); \
    GAPB(o[1]=__builtin_amdgcn_mfma_f32_32x32x16_bf16(PAFA,VFR(2),o[1],0,0,0), C,2); \
    KRD(GL,0); GAPB(o[2]=__builtin_amdgcn_mfma_f32_32x32x16_bf16(PAFA,VFR(4),o[2],0,0,0), C,4); \
    KRD(GL,1); GAPB(o[3]=__builtin_amdgcn_mfma_f32_32x32x16_bf16(PAFA,VFR(6),o[3],0,0,0), C,6); \
    KRD(GL,2); GAPB(o[0]=__builtin_amdgcn_mfma_f32_32x32x16_bf16(PAFB,VFR(1),o[0],0,0,0), C,8); \
    KRD(GL,3); GAPB(o[1]=__builtin_amdgcn_mfma_f32_32x32x16_bf16(PAFB,VFR(3),o[1],0,0,0), C,10); \
    GAPB(o[2]=__builtin_amdgcn_mfma_f32_32x32x16_bf16(PAFB,VFR(5),o[2],0,0,0), C,12); \
    GAPB(o[3]=__builtin_amdgcn_mfma_f32_32x32x16_bf16(PAFB,VFR(7),o[3],0,0,0), C,14); \
    }while(0)
  int t=1;
  #undef CMASK
  #define CMASK(P,t) do{}while(0)
  asm volatile(".p2align 8":::"memory");
  for(;t+7<NT;t+=2){
    STEPF(pB,pA,t,true,true,true);     WAIT_BAR(3); RESC(); ROT();
    STEPF(pA,pB,t+1,true,true,true);   WAIT_BAR(3); RESC(); ROT();
  }
  #undef CMASK
  #define CMASK(P,t) do{ if((t)>=cqm2)bmask1(P,(t),cq,qabs,hi,kh,lut);}while(0)
  #define ENDW(tt) do{ if((tt)+3<NT){WAIT_BAR(3);} else if((tt)+2<NT){WAIT_BAR(2);} else {WAIT_BAR(0);} }while(0)
  for(;t+1<NT;t+=2){
    STEPF(pB,pA,t,(t+3<NT),(t+1<NT),(t+1<NT));       ENDW(t);   RESC(); ROT();
    STEPF(pA,pB,t+1,(t+4<NT),(t+2<NT),(t+2<NT));     ENDW(t+1); RESC(); ROT();
  }
  STEPF(pB,pA,NT-1,false,false,false); RESC();
  { float sacc=pB[0]+pB[1]; _Pragma("unroll") for(int r=2;r<16;++r)sacc+=pB[r]; l_reg+=sacc;
    pwa=(u32x4){PKW(pB,0),PKW(pB,2),PKW(pB,4),PKW(pB,6)};pwb=(u32x4){PKW(pB,8),PKW(pB,10),PKW(pB,12),PKW(pB,14)};
    SBAR();
    const int vb=vb0+2*sl_cur;
    #pragma unroll
    for(int d0=0;d0<4;++d0){s16x4 lo[2],hi_[2];
      #pragma unroll
      for(int ks=0;ks<2;++ks){
        asm volatile("ds_read_b64_tr_b16 %0,%1 offset:%c2":"=&v"(lo[ks]):"v"(vb),"i"(d0*4096+ks*1024):"memory");
        asm volatile("ds_read_b64_tr_b16 %0,%1 offset:%c2":"=&v"(hi_[ks]):"v"(vb),"i"(d0*4096+ks*1024+512):"memory");}
      asm volatile("s_waitcnt lgkmcnt(0)":::"memory");SBAR();
      #define PK(k) (bf16x8){lo[k][0],lo[k][1],lo[k][2],lo[k][3],hi_[k][0],hi_[k][1],hi_[k][2],hi_[k][3]}
      o[d0]=__builtin_amdgcn_mfma_f32_32x32x16_bf16(PAFA,PK(0),o[d0],0,0,0);
      o[d0]=__builtin_amdgcn_mfma_f32_32x32x16_bf16(PAFB,PK(1),o[d0],0,0,0);
      #undef PK
    } }
  #undef PKW
  #undef PAFA
  #undef PAFB
  #undef VFR
  #undef PIN
  #undef MX3
  #undef GAPA
  #undef GAPB
  #undef EX
  #undef VRD
  #undef KRD
  #undef STEPF
  #undef ENDW
  {const PL32 rr=pl32(l_reg);l_reg=rr.a+rr.b;}
  asm volatile("s_waitcnt lgkmcnt(0)\n\ts_barrier":::"memory");
  float*OG=(float*)shm+pr*4096;
  if(kh==1){ if(hi==0){wsf[r32]=mhat;wsf[32+r32]=l_reg;}
    #pragma unroll
    for(int d_=0;d_<4;++d_)
      #pragma unroll
      for(int r=0;r<16;++r)OG[(d_*16+r)*64+lane]=o[d_][r]; }
  asm volatile("s_waitcnt lgkmcnt(0)\n\ts_barrier":::"memory");
  if(kh==0){ const float*w1=(const float*)(shm+F_LDS_WS)+(wid+4)*64; const float m2=w1[r32],l2=w1[32+r32]; const float M=__builtin_fmaxf(mhat,m2);
    const float f1=__builtin_amdgcn_exp2f(mhat-M),f2=__builtin_amdgcn_exp2f(m2-M); const float inv=__builtin_amdgcn_rcpf(l_reg*f1+l2*f2);
    if(hi==0){wsf[r32]=f1*inv;wsf[32+r32]=f2*inv;}
    asm volatile("s_waitcnt lgkmcnt(0)":::"memory");
    bf16*stg=(bf16*)(shm+F_LDS_OST)+pr*4096;
    #pragma unroll
    for(int r=0;r<16;++r){const int orow=crow(r,hi); const float g1=wsf[orow],g2=wsf[32+orow];
      #pragma unroll
      for(int d_=0;d_<4;++d_)stg[orow*128+d_*32+r32]=__float2bfloat16(o[d_][r]*g1+OG[(d_*16+r)*64+lane]*g2);}
    asm volatile("s_waitcnt lgkmcnt(0)":::"memory");
    bf16*Ow=O+(long)(q0+pr*QBLK)*(long)OPITCH+ocol;
    #pragma unroll
    for(int i=0;i<8;++i){const int row=i*4+(lane>>4),ch=lane&15; const u32x4 v=*(const u32x4*)(stg+row*128+ch*8); ATTN_STORE16(Ow+(long)row*OPITCH+ch*8,v);} }
  asm volatile("s_waitcnt lgkmcnt(0)\n\ts_barrier":::"memory");
  #undef DMA_K
  #undef DMA_V
  #undef CMASK
  #undef RESC
  #undef ROT
}
constexpr int ATTN_LDS_BYTES=LDS_BYTES;
#undef SBAR
#undef WAIT_BAR
}
#define XB_TMO      128
#define XB_XCNT(j)  (256  + 64 * (j))
#define XB_XSUB(j)  (1280 + 64 * (j))
#define XB_XGEN(j)  (2304 + 64 * (j))
#define XB_TOP      3328
#define XB_TOPGEN   3392
#define XCD_BAR_WORDS 3456
#define XB_SPIN_CAP (1u << 18)

__device__ __forceinline__ unsigned xb_ld(unsigned* p)              { return __hip_atomic_load(p, __ATOMIC_RELAXED, __HIP_MEMORY_SCOPE_AGENT); }
__device__ __forceinline__ unsigned xb_add(unsigned* p, unsigned v) { return __hip_atomic_fetch_add(p, v, __ATOMIC_RELAXED, __HIP_MEMORY_SCOPE_AGENT); }
__device__ __forceinline__ unsigned xb_xcc_id() { return (unsigned)__builtin_amdgcn_s_getreg((3 << 11) | 20) & 0xFu; }
#define XB_SPIN(cond, bar) do { unsigned _sp = 0; while (cond) { __builtin_amdgcn_s_sleep(1); \
    if ((++_sp & 255u) == 0u) { if (xb_ld(&(bar)[XB_TMO])) break; if (_sp > XB_SPIN_CAP) { atomicAdd(&(bar)[XB_TMO], 1u); break; } } } } while (0)

struct XcdBarrier {
    unsigned* bar; unsigned x;
    volatile LAS unsigned* st;
};

__device__ __forceinline__ XcdBarrier xcd_barrier_post(unsigned* bar, volatile LAS unsigned* st) {
    XcdBarrier b; b.bar = bar; b.x = xb_xcc_id(); b.st = st;
    if (threadIdx.x == 0) (void)xb_add(&bar[XB_XCNT(b.x)], 1u);
    return b;
}
__device__ __forceinline__ void xcd_barrier_complete(unsigned* bar, unsigned x, unsigned& nloc, unsigned& nx) {
    const unsigned G = gridDim.x * gridDim.y * gridDim.z;
    unsigned sum, cnt, mine, sp = 0u;
    for (;;) {
        sum = 0u; cnt = 0u; mine = 0u;
#pragma unroll
        for (unsigned j = 0; j < 16; ++j) { const unsigned c = xb_ld(&bar[XB_XCNT(j)]); sum += c; cnt += (c > 0u) ? 1u : 0u; mine = (j == x) ? c : mine; }
        if (sum == G) break;
        __builtin_amdgcn_s_sleep(1);
        if ((++sp & 255u) == 0u) { if (xb_ld(&bar[XB_TMO])) break; if (sp > XB_SPIN_CAP) { atomicAdd(&bar[XB_TMO], 1u); break; } }
    }
    nloc = mine > 0u ? mine : 1u; nx = cnt > 0u ? cnt : 1u;
}

__device__ __forceinline__ void xcd_barrier(const XcdBarrier& b) {
    asm volatile("s_waitcnt vmcnt(0)" ::: "memory");
    __syncthreads();
    if (threadIdx.x == 0) {
        unsigned* bar = b.bar;
        __builtin_amdgcn_s_waitcnt(0);
        unsigned nloc = b.st[0], nx = b.st[1];
        if (nloc == 0u) { xcd_barrier_complete(bar, b.x, nloc, nx); b.st[0] = nloc; b.st[1] = nx; }
        const unsigned old = xb_add(&bar[XB_XSUB(b.x)], 1u);
        const unsigned gen = old / nloc;
        if (old + 1u == (gen + 1u) * nloc) {
            __builtin_amdgcn_fence(__ATOMIC_RELEASE, "agent");
            asm volatile("s_waitcnt vmcnt(0)" ::: "memory");
            const unsigned og = xb_add(&bar[XB_TOP], 1u);
            const unsigned tg = og / nx;
            if (og + 1u == (tg + 1u) * nx) xb_add(&bar[XB_TOPGEN], 1u);
            else XB_SPIN(xb_ld(&bar[XB_TOPGEN]) == tg, bar);
            __builtin_amdgcn_fence(__ATOMIC_ACQUIRE, "agent");
            xb_add(&bar[XB_XGEN(b.x)], 1u);
            asm volatile("s_waitcnt vmcnt(0)" ::: "memory");
        } else {
            XB_SPIN(xb_ld(&bar[XB_XGEN(b.x)]) == gen, bar);
            __builtin_amdgcn_fence(__ATOMIC_ACQUIRE, "agent");
            asm volatile("s_waitcnt vmcnt(0)" ::: "memory");
        }
    }
    __syncthreads();
}
struct Args { const float* in[37]; float* out; unsigned char* ws; int ph_lo, ph_hi; };
struct Frame { LAS unsigned char* lds; volatile LAS unsigned* MISC; gu32* ctl; int tid, lane, wave, G, bid; };
typedef __attribute__((address_space(4))) const Args* ArgsP;
__device__ __forceinline__ ArgsP get_args() { ArgsP p = (ArgsP)__builtin_amdgcn_kernarg_segment_ptr(); asm volatile("" : "+s"(p)); return p; }
#define PHASE_ENTRY() ArgsP A = get_args(); { int t_ = threadIdx.x; asm volatile("" : "+v"(t_)); F.tid = t_; F.lane = t_ & 63; F.wave = __builtin_amdgcn_readfirstlane(t_ >> 6); F.ctl = (gu32*)(A->ws + WS_CTL); }
enum InIdx { I_XP = 0, I_XS, I_CP, I_CS, I_CK, I_CV, I_SWKV, I_SSHIFT, I_SCONV, I_WADA, I_BADA, I_GMIX, I_GFFN, I_WIN, I_WOUT, I_MU, I_W0, I_W2, I_A0, I_A2, I_G2, I_KK, I_KA, I_RK, I_LNW, I_LNB,
             I_LQ1, I_LK1, I_LQ2, I_LK2, I_SUBLN, I_REL, I_FUP, I_CONVW, I_CONVB, I_FDN, I_GFIN };

__device__ __forceinline__ void transpose_item(const float* W, int K, int N, bf16* WT, int dest_row0, LAS float* scr, int kb, int n0, int lane) {
    const int k0 = 64 * kb;
    { f32x4 t[8];
#pragma unroll
      for (int i = 0; i < 8; ++i) t[i] = __builtin_nontemporal_load((const GAS f32x4*)(W + (size_t)(k0 + 8 * i + (lane >> 3)) * N + n0 + 4 * (lane & 7)));
#pragma unroll
      for (int i = 0; i < 8; ++i) { LAS float* d = scr + (8 * i + (lane >> 3)) * 33 + 4 * (lane & 7); d[0] = t[i][0]; d[1] = t[i][1]; d[2] = t[i][2]; d[3] = t[i][3]; } }
    LDS_WAIT(); asm volatile("" ::: "memory");
    const int c = lane & 7;
#pragma unroll
    for (int j = 0; j < 4; ++j) { const int n = (lane >> 3) + 8 * j; const LAS float* s = scr + (8 * c) * 33 + n;
        v4u o; o.x = pk2(s[0 * 33], s[1 * 33]); o.y = pk2(s[2 * 33], s[3 * 33]); o.z = pk2(s[4 * 33], s[5 * 33]); o.w = pk2(s[6 * 33], s[7 * 33]);
        *(GAS v4u*)(WT + (size_t)(dest_row0 + n) * K + k0 + 8 * c) = o; }
    LDS_WAIT(); asm volatile("" ::: "memory");
}
__device__ __forceinline__ void ph_prologue(Frame& F) {
    PHASE_ENTRY();
    unsigned char* ws = A->ws;
    if (F.bid < 192) {
        const int l = F.bid / 96, j0 = (F.bid % 96) * 128;
        LAS float* ST = (LAS float*)F.lds;
        const float* Wl = A->in[I_WADA] + (size_t)l * DMOD * MODW;
        float acc[NMODB][2];
#pragma unroll
        for (int b = 0; b < NMODB; ++b) { acc[b][0] = 0.f; acc[b][1] = 0.f; }
        for (int kh = 0; kh < 2; ++kh) {
            __syncthreads();
            for (int idx = F.tid; idx < 1024 * NMODB; idx += NWAVES * 64) { const int kk = idx / NMODB, b = idx % NMODB;
                const float c = (b == 0) ? A->in[I_CP][kh * 1024 + kk] : A->in[I_CS][(size_t)(b - 1) * DMOD + kh * 1024 + kk];
                ST[kk * 20 + b] = c / (1.f + __expf(-c)); }
            __syncthreads();
#pragma unroll 4
            for (int k = 0; k < 128; ++k) { const int kk = F.wave * 128 + k;
                const f32x2 w = __builtin_nontemporal_load((const GAS f32x2*)(Wl + (size_t)(kh * 1024 + kk) * MODW + j0 + 2 * F.lane));
                const LAS f32x4* sp = (const LAS f32x4*)(ST + kk * 20);
                const f32x4 s0 = sp[0], s1 = sp[1], s2 = sp[2], s3 = sp[3]; const float s16 = ST[kk * 20 + 16];
#pragma unroll
                for (int b = 0; b < 4; ++b) { acc[b][0] += s0[b] * w.x; acc[b][1] += s0[b] * w.y; acc[4 + b][0] += s1[b] * w.x; acc[4 + b][1] += s1[b] * w.y;
                    acc[8 + b][0] += s2[b] * w.x; acc[8 + b][1] += s2[b] * w.y; acc[12 + b][0] += s3[b] * w.x; acc[12 + b][1] += s3[b] * w.y; }
                acc[16][0] += s16 * w.x; acc[16][1] += s16 * w.y; }
        }
        __syncthreads();
        LAS float* RED = (LAS float*)F.lds;
#pragma unroll
        for (int b = 0; b < NMODB; ++b) { RED[(F.wave * NMODB + b) * 128 + 2 * F.lane] = acc[b][0]; RED[(F.wave * NMODB + b) * 128 + 2 * F.lane + 1] = acc[b][1]; }
        __syncthreads();
        float* MOD = (float*)(ws + WS_MOD);
        for (int idx = F.tid; idx < NMODB * 128; idx += NWAVES * 64) { const int b = idx >> 7, j = idx & 127; float s = 0.f;
#pragma unroll
            for (int w = 0; w < 8; ++w) s += RED[(w * NMODB + b) * 128 + j];
            MOD[(size_t)(l * NMODB + b) * MODW + j0 + j] = s + A->in[I_BADA][(size_t)l * MODW + j0 + j]; }
        __syncthreads();
    }
    { const int gt = F.bid * (NWAVES * 64) + F.tid, ngt = F.G * NWAVES * 64;
      for (int idx = gt; idx < NLAYER * 56 * 1024; idx += ngt) { const int l = idx / (56 * 1024), rem = idx % (56 * 1024), ch = rem >> 10, j = rem & 1023;
          const float* src; bf16* dst; int k0;
          bf16* LB = (bf16*)(ws + WS_LORA + (size_t)l * LORA_LAYER);
          if (ch < 12) { k0 = 8 * ch; src = A->in[I_W2] + ((size_t)l * 96 + k0) * 1024 + j; dst = LB + (size_t)j * 96 + k0; }
          else if (ch < 24) { k0 = 8 * (ch - 12); src = A->in[I_A2] + ((size_t)l * 96 + k0) * 1024 + j; dst = LB + (size_t)1024 * 96 + (size_t)j * 96 + k0; }
          else { k0 = 8 * (ch - 24); src = A->in[I_G2] + ((size_t)l * 256 + k0) * 1024 + j; dst = LB + (size_t)2 * 1024 * 96 + (size_t)j * 256 + k0; }
          v4u o; o.x = pk2(src[0], src[1024]); o.y = pk2(src[2048], src[3072]); o.z = pk2(src[4096], src[5120]); o.w = pk2(src[6144], src[7168]);
          *(GAS v4u*)dst = o; }
      for (int idx = gt; idx < NLAYER * 64 * DMOD / 8; idx += ngt) { const int l = idx / (64 * DMOD / 8), rem = idx % (64 * DMOD / 8);
          *(GAS v4u*)((bf16*)(ws + WS_WIN) + (size_t)l * NIN_PAD * DMOD + (size_t)NRC * DMOD + (size_t)rem * 8) = (v4u){0u, 0u, 0u, 0u}; }
    }
    __syncthreads();
    LAS float* scr = (LAS float*)(F.lds + F.wave * 16384);
    const int gw = F.bid * NWAVES + F.wave, NGW = F.G * NWAVES;
    constexpr int IT_IN = 32 * (NIN / 32), IT_OUT = 32 * 64, IT_UP = 32 * (NUP / 32), IT_DN = (DFF / 64) * 64, IT_L = IT_IN + IT_OUT + IT_UP + IT_DN;
    for (int it = gw; it < NLAYER * IT_L; it += NGW) {
        const int l = it / IT_L; int r = it % IT_L;
        if (r < IT_IN) { const int nb = r % (NIN / 32), kb = r / (NIN / 32), n0 = 32 * nb;
            transpose_item(A->in[I_WIN] + (size_t)l * DMOD * NIN, DMOD, NIN, (bf16*)(ws + WS_WIN) + (size_t)l * NIN_PAD * DMOD, n0 < NRC ? n0 : n0 + 64, scr, kb, n0, F.lane); continue; }
        r -= IT_IN;
        if (r < IT_OUT) { const int nb = r % 64, kb = r / 64;
            transpose_item(A->in[I_WOUT] + (size_t)l * DMOD * DMOD, DMOD, DMOD, (bf16*)(ws + WS_WOUT) + (size_t)l * DMOD * DMOD, 32 * nb, scr, kb, 32 * nb, F.lane); continue; }
        r -= IT_OUT;
        if (r < IT_UP) { const int nb = r % (NUP / 32), kb = r / (NUP / 32), n0 = 32 * nb; const int j = n0 < DFF ? n0 : n0 - DFF;
            const int dr = (j >> 7) * 256 + (n0 < DFF ? 0 : 128) + (j & 127);
            transpose_item(A->in[I_FUP] + (size_t)l * DMOD * NUP, DMOD, NUP, (bf16*)(ws + WS_WUP) + (size_t)l * NUP * DMOD, dr, scr, kb, n0, F.lane); continue; }
        r -= IT_UP;
        { const int nb = r % 64, kb = r / 64;
            transpose_item(A->in[I_FDN] + (size_t)l * DFF * DMOD, DFF, DMOD, (bf16*)(ws + WS_WDN) + (size_t)l * DMOD * DFF, 32 * nb, scr, kb, 32 * nb, F.lane); }
    }
}

__device__ __forceinline__ void ph_norm(Frame& F, int l, int mode, int nslab) {
    PHASE_ENTRY();
    const int gw = F.bid * NWAVES + F.wave, NGW = F.G * NWAVES;
    const float* X = (const float*)(A->ws + WS_X); bf16* H = (bf16*)(A->ws + WS_H);
    const float* g = (mode == 0 ? A->in[I_GMIX] + (size_t)l * DMOD : mode == 1 ? A->in[I_GFFN] + (size_t)l * DMOD : A->in[I_GFIN]);
    f32x4 gv[8];
#pragma unroll
    for (int j = 0; j < 8; ++j) gv[j] = *(const GAS f32x4*)(g + 4 * F.lane + 256 * j);
    for (int m = gw; m < MT; m += NGW) {
        const float* xr = (mode == 0 && l == 0) ? (m < MP ? A->in[I_XP] + (size_t)m * DMOD : A->in[I_XS] + (size_t)(m - MP) * DMOD) : X + (size_t)m * DMOD;
        f32x4 v[8]; float ss = 0.f;
#pragma unroll
        for (int j = 0; j < 8; ++j) v[j] = *(const GAS f32x4*)(xr + 4 * F.lane + 256 * j);
        f32x4 shv[8], scv[8];
        if (mode < 2) { const int bidx0 = m < MP ? 0 : 1 + ((m - MP) >> 4);
            const float* mod0 = (const float*)(A->ws + WS_MOD) + (size_t)(l * NMODB + bidx0) * MODW + (mode == 0 ? 0 : 3 * DMOD);
#pragma unroll
            for (int j = 0; j < 8; ++j) { shv[j] = *(const GAS f32x4*)(mod0 + 4 * F.lane + 256 * j); scv[j] = *(const GAS f32x4*)(mod0 + DMOD + 4 * F.lane + 256 * j); } }
        if (m >= MP && nslab > 0) { const float* sl = (const float*)(A->ws + WS_SLAB) + (size_t)(m - MP) * DMOD;
            for (int s = 0; s < nslab; ++s)
#pragma unroll
                for (int j = 0; j < 8; ++j) v[j] += *(const GAS f32x4*)(sl + (size_t)s * 256 * DMOD + 4 * F.lane + 256 * j);
            if (mode < 2) { float* xw = (float*)(A->ws + WS_X) + (size_t)m * DMOD;
#pragma unroll
                for (int j = 0; j < 8; ++j) *(GAS f32x4*)(xw + 4 * F.lane + 256 * j) = v[j]; } }
#pragma unroll
        for (int j = 0; j < 8; ++j) ss += (v[j].x * v[j].x + v[j].y * v[j].y) + (v[j].z * v[j].z + v[j].w * v[j].w);
        const float rstd = 1.f / sqrtf(wave_sum(ss) * (1.f / DMOD) + 1e-6f);
        if (mode < 2) {
            const int bidx = m < MP ? 0 : 1 + ((m - MP) >> 4);
            const float* mod = (const float*)(A->ws + WS_MOD) + (size_t)(l * NMODB + bidx) * MODW + (mode == 0 ? 0 : 3 * DMOD);
            GAS unsigned long long* o8 = (GAS unsigned long long*)(H + (size_t)m * DMOD) + F.lane;
#pragma unroll
            for (int j = 0; j < 8; ++j) { const f32x4 sh = shv[j], sc = scv[j];
                const f32x4 y = (v[j] * rstd * gv[j]) * (sc + 1.0f) + sh;
                o8[64 * j] = (unsigned long long)pk2(y.x, y.y) | ((unsigned long long)pk2(y.z, y.w) << 32); }
        } else {
            float* o = (m < MP) ? A->out + O_YP + (size_t)m * DMOD : A->out + O_YS + (size_t)(m - MP) * DMOD;
#pragma unroll
            for (int j = 0; j < 8; ++j) __builtin_nontemporal_store(v[j] * rstd * gv[j], (GAS f32x4*)(o + 4 * F.lane + 256 * j));
        }
    }
}
typedef float f32x4m __attribute__((ext_vector_type(4)));
__device__ __forceinline__ void mm_tiles(f32x4 (&acc)[2], const LAS unsigned char* X, const LAS unsigned char* Y, int wave, int lane) {
    const int mt = wave >> 1, nt0 = 2 * (wave & 1), c = lane & 15, q = lane >> 4;
    const LAS unsigned char* xp = X + (16 * mt + c) * 144 + q * 16;
    const bf16x8 x0 = *(const LAS bf16x8*)xp, x1 = *(const LAS bf16x8*)(xp + 64);
#pragma unroll
    for (int t = 0; t < 2; ++t) { const LAS unsigned char* yp = Y + (16 * (nt0 + t) + c) * 144 + q * 16;
        const bf16x8 y0 = *(const LAS bf16x8*)yp, y1 = *(const LAS bf16x8*)(yp + 64);
        acc[t] = __builtin_amdgcn_mfma_f32_16x16x32_bf16(y0, x0, acc[t], 0, 0, 0);
        acc[t] = __builtin_amdgcn_mfma_f32_16x16x32_bf16(y1, x1, acc[t], 0, 0, 0); }
}
__device__ __forceinline__ void st_tiles(LAS unsigned char* D, const f32x4 (&acc)[2], int wave, int lane) {
    const int mt = wave >> 1, nt0 = 2 * (wave & 1), c = lane & 15, q = lane >> 4;
#pragma unroll
    for (int t = 0; t < 2; ++t) { v2u w; w.x = pk2(acc[t][0], acc[t][1]); w.y = pk2(acc[t][2], acc[t][3]); *(LAS v2u*)(D + (16 * mt + c) * 144 + (16 * (nt0 + t) + 4 * q) * 2) = w; }
}
#define RW_ZERO(a) do { a[0] = (f32x4){0.f, 0.f, 0.f, 0.f}; a[1] = a[0]; } while (0)
template <int MODE> __device__ __forceinline__ void mask_tiles(f32x4 (&acc)[2], int wave, int lane) {
    const int m = 16 * (wave >> 1) + (lane & 15), nb = 32 * (wave & 1) + 4 * (lane >> 4);
#pragma unroll
    for (int t = 0; t < 2; ++t)
#pragma unroll
        for (int i = 0; i < 4; ++i) { const int n = nb + 16 * t + i; const bool keep = MODE == 0 ? (n < m) : MODE == 1 ? (n > m) : (n <= m); if (!keep) acc[t][i] = 0.f; }
}

__device__ __forceinline__ void rwkv_passA_unit(ArgsP A, Frame& F, int l, int u, bool reuse) {
    unsigned char* ws = A->ws;
    const int tid = F.tid, lane = F.lane, wave = F.wave;
    const float* PR = (const float*)(ws + WS_PR);
    int h, row0, nvalid; const float* prev0;
    if (u < 2048) { h = u >> 7; const int c = u & 127; row0 = 64 * c; nvalid = 64; prev0 = c > 0 ? PR + (size_t)(row0 - 1) * NRC_PAD : nullptr; }
    else { const int su = u - 2048, sb = su >> 4; h = su & 15; row0 = MP + sb * TS; nvalid = TS; prev0 = A->in[I_SSHIFT] + (size_t)(l * NSB + sb) * NRC; }
    const float* mu = A->in[I_MU] + (size_t)l * NRC;
    LAS unsigned char* L = F.lds;
#define SL(i) (L + (i) * RW_SLOT)
    LAS unsigned short* TW = (LAS unsigned short*)(L), *XA = (LAS unsigned short*)(L + 13312), *SG = (LAS unsigned short*)(L + 26624);
    LAS float* WLf = (LAS float*)(L + 64512), *ALf = (LAS float*)(L + 81920), *GLf = (LAS float*)(L + 99328);
    LAS float* AT32 = (LAS float*)(L + 92160), *A32 = (LAS float*)(L + 109568), *AKV32 = (LAS float*)(L);
    LAS unsigned char* sAAK = L + 126976, *sARB = L + 136192, *sARK = L + 145408;
    LAS float* SEG = (LAS float*)(L + 154624), *WLV = SEG + 512;
    bf16x8 yg_[8][2];
    { const int nt0 = 2 * (wave & 1), c = lane & 15, q = lane >> 4; const bf16* LB = (const bf16*)(ws + WS_LORA + (size_t)l * LORA_LAYER);
#pragma unroll
      for (int t = 0; t < 2; ++t) { const int j = h * 64 + 16 * (nt0 + t) + c;
#pragma unroll
          for (int s = 0; s < 8; ++s) yg_[s][t] = *(const GAS bf16x8*)(LB + (size_t)2 * 1024 * 96 + (size_t)j * 256 + 8 * q + 32 * s); } }
    { unsigned char* lscr = ws + WS_LSCR + (size_t)F.bid * 61440;
      if (reuse) { v4u tmp[8];
#pragma unroll
          for (int b = 0; b < 8; ++b) { const int i = tid + b * (NWAVES * 64); if (i < 60416 / 16) tmp[b] = *(const GAS v4u*)(lscr + i * 16); }
#pragma unroll
          for (int b = 0; b < 8; ++b) { const int i = tid + b * (NWAVES * 64); if (i < 60416 / 16) *(LAS v4u*)(L + i * 16) = tmp[b]; } }
      else {
        for (int it = 0; it < 56; it += 8) { float cur[8], prv[8], mm_[8];
#pragma unroll
            for (int b = 0; b < 8; ++b) { const int idx = tid + (it + b) * (NWAVES * 64), t = idx / 448, col = 3072 + idx % 448; cur[b] = 0.f; prv[b] = 0.f; mm_[b] = mu[col];
                if (t < nvalid) { cur[b] = PR[(size_t)(row0 + t) * NRC_PAD + col]; prv[b] = t > 0 ? PR[(size_t)(row0 + t - 1) * NRC_PAD + col] : (prev0 ? prev0[col] : 0.f); } }
#pragma unroll
            for (int b = 0; b < 8; ++b) { const int idx = tid + (it + b) * (NWAVES * 64), t = idx / 448, cc = idx % 448; const float xm = cur[b] + (prv[b] - cur[b]) * mm_[b];
                if (cc < 96) { const float e = __expf(2.f * xm); TW[t * 104 + cc] = (unsigned short)f2bf(1.f - 2.f * __builtin_amdgcn_rcpf(e + 1.f)); }
                else if (cc < 192) XA[t * 104 + cc - 96] = (unsigned short)f2bf(xm);
                else SG[t * 264 + cc - 192] = (unsigned short)f2bf(sigmoidf_(xm)); } }
        if (u < 2048) { __syncthreads(); for (int i = tid; i < 60416 / 16; i += NWAVES * 64) *(GAS v4u*)(lscr + i * 16) = *(const LAS v4u*)(L + i * 16); }
      } }
    __syncthreads();
    { const int mt = wave >> 1, nt0 = 2 * (wave & 1), c = lane & 15, q = lane >> 4;
      const bf16* LB = (const bf16*)(ws + WS_LORA + (size_t)l * LORA_LAYER);
      f32x4 aw[2], aa[2], ag[2]; RW_ZERO(aw); RW_ZERO(aa); RW_ZERO(ag);
#pragma unroll
      for (int s = 0; s < 3; ++s) { const bf16x8 xw = *(const LAS bf16x8*)((LAS unsigned char*)TW + (16 * mt + c) * 208 + (8 * q + 32 * s) * 2), xa = *(const LAS bf16x8*)((LAS unsigned char*)XA + (16 * mt + c) * 208 + (8 * q + 32 * s) * 2);
#pragma unroll
          for (int t = 0; t < 2; ++t) { const int j = h * 64 + 16 * (nt0 + t) + c;
              const bf16x8 yw = *(const GAS bf16x8*)(LB + (size_t)j * 96 + 8 * q + 32 * s), ya = *(const GAS bf16x8*)(LB + (size_t)1024 * 96 + (size_t)j * 96 + 8 * q + 32 * s);
              aw[t] = __builtin_amdgcn_mfma_f32_16x16x32_bf16(yw, xw, aw[t], 0, 0, 0); aa[t] = __builtin_amdgcn_mfma_f32_16x16x32_bf16(ya, xa, aa[t], 0, 0, 0); } }
#pragma unroll
      for (int s = 0; s < 8; ++s) { const bf16x8 xg = *(const LAS bf16x8*)((LAS unsigned char*)SG + (16 * mt + c) * 528 + (8 * q + 32 * s) * 2);
#pragma unroll
          for (int t = 0; t < 2; ++t) { const int j = h * 64 + 16 * (nt0 + t) + c; const bf16x8 yg = yg_[s][t];
              ag[t] = __builtin_amdgcn_mfma_f32_16x16x32_bf16(yg, xg, ag[t], 0, 0, 0); } }
#pragma unroll
      for (int t = 0; t < 2; ++t) { const int o = (16 * mt + c) * 68 + 16 * (nt0 + t) + 4 * q; *(LAS f32x4*)(WLf + o) = aw[t]; *(LAS f32x4*)(ALf + o) = aa[t]; *(LAS f32x4*)(GLf + o) = ag[t]; }
    }
    __syncthreads();
    {
        const int j = lane, hj = h * 64 + j, seg = wave;
        const float mu_r = mu[hj], mu_k = mu[1024 + hj], mu_v = mu[2048 + hj];
        const float w0 = A->in[I_W0][l * 1024 + hj], a0 = A->in[I_A0][l * 1024 + hj], kkw = A->in[I_KK][l * 1024 + hj], kaw = A->in[I_KA][l * 1024 + hj], rkw = A->in[I_RK][l * 1024 + hj];
        const float lnw = A->in[I_LNW][l * 1024 + hj], lnb = A->in[I_LNB][l * 1024 + hj];
        float logw[8], xr[8], xv[8], kk[8], bb[8], km[8], cs[8];
        unsigned short* G1 = (unsigned short*)(ws + WS_G1); unsigned short* G2 = (unsigned short*)(ws + WS_G2);
        float run = 0.f;
        float cr9[9], ck9[9], cv9[9];
#pragma unroll
        for (int i = 0; i < 9; ++i) { const int t = 8 * seg + i - 1; const float* pr = (t < 0) ? prev0 : (t < nvalid ? PR + (size_t)(row0 + t) * NRC_PAD : nullptr);
            cr9[i] = pr ? pr[hj] : 0.f; ck9[i] = pr ? pr[1024 + hj] : 0.f; cv9[i] = pr ? pr[2048 + hj] : 0.f; }
        asm volatile("" ::: "memory");
#pragma unroll
        for (int i = 0; i < 8; ++i) { const int t = 8 * seg + i; const bool valid = t < nvalid;
            float r_ = 0.f, k_ = 0.f, v_ = 0.f;
            if (valid) { const float cr = cr9[i + 1], ck = ck9[i + 1], cv = cv9[i + 1], qr = cr9[i], qk = ck9[i], qv = cv9[i];
                r_ = cr + (qr - cr) * mu_r; k_ = ck + (qk - ck) * mu_k; v_ = cv + (qv - cv) * mu_v; }
            const float wl = WLf[t * 68 + j], al = ALf[t * 68 + j], gl = GLf[t * 68 + j];
            const float lw = valid ? -0.6065306597126334f * sigmoidf_(w0 + wl) : 0.f;
            const float a_ = sigmoidf_(a0 + al);
            const float kkr = k_ * kkw; const float nrm = wave_sum(kkr * kkr); const float kk_ = kkr * __builtin_amdgcn_rsqf(fmaxf(nrm, 1e-24f));
            const float km_ = k_ * (1.f + (a_ - 1.f) * kaw);
            const float ct = wave_sum(r_ * km_ * rkw);
            if (valid) { const size_t go = (size_t)(row0 + t) * 1024 + hj; G1[go] = (unsigned short)f2bf(lnw * gl); G2[go] = (unsigned short)f2bf((lnb + ct * v_) * gl); }
            run += lw; logw[i] = lw; cs[i] = run; xr[i] = r_; xv[i] = v_; kk[i] = kk_; bb[i] = kk_ * a_; km[i] = km_; }
        SEG[seg * 64 + j] = run;
        __syncthreads();
        float off = 0.f, tot = 0.f;
#pragma unroll
        for (int s = 0; s < 8; ++s) { const float v = SEG[s * 64 + j]; tot += v; if (s < seg) off += v; }
        if (seg == 0) WLV[j] = __expf(tot);
        LAS unsigned short* AT = (LAS unsigned short*)SL(0), *ATL = (LAS unsigned short*)SL(1), *BH = (LAS unsigned short*)SL(2), *BHL = (LAS unsigned short*)SL(3), *KH = (LAS unsigned short*)SL(4), *RT = (LAS unsigned short*)SL(5);
        unsigned pvt[4], pbt[4], pbl[4], pkt[4];
#pragma unroll
        for (int i = 0; i < 8; i += 2) { float v2[2], bt2[2], bl2[2], kt2[2];
#pragma unroll
            for (int e = 0; e < 2; ++e) { const int ii = i + e, t = 8 * seg + ii; const float ci = off + cs[ii], ce = ci - logw[ii];
                const float winc = __expf(ci), wexc = __expf(ce), winv = __expf(-ci), wrem = __expf(tot - ci);
                const float at = -kk[ii] * wexc, rt = xr[ii] * winc, bh = bb[ii] * winv, kh = km[ii] * winv, bt = bb[ii] * wrem, kt = km[ii] * wrem;
                const unsigned ath = f2bf(at), bhh = f2bf(bh), bth = f2bf(bt);
                AT[t * RW_STRIDE + j] = (unsigned short)ath; ATL[t * RW_STRIDE + j] = (unsigned short)f2bf(at - bf2f((unsigned short)ath)); AT32[t * 68 + j] = at;
                BH[t * RW_STRIDE + j] = (unsigned short)bhh; BHL[t * RW_STRIDE + j] = (unsigned short)f2bf(bh - bf2f((unsigned short)bhh));
                KH[t * RW_STRIDE + j] = (unsigned short)f2bf(kh); RT[t * RW_STRIDE + j] = (unsigned short)f2bf(rt);
                v2[e] = xv[ii]; bt2[e] = bf2f((unsigned short)bth); bl2[e] = bt - bf2f((unsigned short)bth); kt2[e] = kt; }
            pvt[i >> 1] = pk2(v2[0], v2[1]); pbt[i >> 1] = pk2(bt2[0], bt2[1]); pbl[i >> 1] = pk2(bl2[0], bl2[1]); pkt[i >> 1] = pk2(kt2[0], kt2[1]); }
        *(LAS v4u*)(SL(6) + j * 144 + seg * 16) = (v4u){pvt[0], pvt[1], pvt[2], pvt[3]};
        *(LAS v4u*)(SL(7) + j * 144 + seg * 16) = (v4u){pbt[0], pbt[1], pbt[2], pbt[3]};
        *(LAS v4u*)(SL(8) + j * 144 + seg * 16) = (v4u){pbl[0], pbl[1], pbl[2], pbl[3]};
        *(LAS v4u*)(SL(9) + j * 144 + seg * 16) = (v4u){pkt[0], pkt[1], pkt[2], pkt[3]};
    }
    __syncthreads();
    { f32x4 a[2]; const int mt = wave >> 1, nt0 = 2 * (wave & 1), c = lane & 15, q = lane >> 4, m = 16 * mt + c;
      RW_ZERO(a); mm_tiles(a, SL(0), SL(2), wave, lane); mm_tiles(a, SL(1), SL(2), wave, lane); mm_tiles(a, SL(0), SL(3), wave, lane); mask_tiles<0>(a, wave, lane);
#pragma unroll
      for (int t = 0; t < 2; ++t) *(LAS f32x4*)(A32 + m * 68 + 16 * (nt0 + t) + 4 * q) = a[t];
      RW_ZERO(a); mm_tiles(a, SL(0), SL(4), wave, lane); mask_tiles<0>(a, wave, lane); st_tiles(sAAK, a, wave, lane);
      RW_ZERO(a); mm_tiles(a, SL(5), SL(2), wave, lane); mask_tiles<2>(a, wave, lane); st_tiles(sARB, a, wave, lane);
      RW_ZERO(a); mm_tiles(a, SL(5), SL(4), wave, lane); mask_tiles<2>(a, wave, lane); st_tiles(sARK, a, wave, lane); }
    __syncthreads();
    { f32x4 a[2]; const int mt = wave >> 1, nt0 = 2 * (wave & 1), c = lane & 15, q = lane >> 4, m = 16 * mt + c;
      RW_ZERO(a); mm_tiles(a, sAAK, SL(6), wave, lane);
#pragma unroll
      for (int t = 0; t < 2; ++t) *(LAS f32x4*)(AKV32 + m * 68 + 16 * (nt0 + t) + 4 * q) = a[t]; }
    __syncthreads();
    { const int c = lane & 15, q = lane >> 4;
      LAS float* R = (wave < 4) ? AT32 + 16 * wave : AKV32 + 16 * (wave - 4);
      LAS float* Rc = (wave == 0 ? AT32 : AKV32) + lane;
#pragma unroll
      for (int i = 0; i < 4; ++i) {
          if (i > 0) {
              f32x4 acc;
#pragma unroll
              for (int g = 0; g < 4; ++g) acc[g] = R[(16 * i + 4 * q + g) * 68 + c];
#pragma unroll
              for (int j = 0; j < i; ++j)
#pragma unroll
                  for (int s = 0; s < 4; ++s) { const float a = A32[(16 * i + c) * 68 + 16 * j + 4 * s + q], b = R[(16 * j + 4 * s + q) * 68 + c];
                      acc = __builtin_amdgcn_mfma_f32_16x16x4f32(a, b, acc, 0, 0, 0); }
#pragma unroll
              for (int g = 0; g < 4; ++g) R[(16 * i + 4 * q + g) * 68 + c] = acc[g];
              __syncthreads();
          }
          if (wave < 2) {
              const LAS float* a32 = A32 + (16 * i) * 68 + 16 * i; asm volatile("" : "+v"(a32));
              float x[16];
#pragma unroll
              for (int rr = 0; rr < 16; ++rr) x[rr] = Rc[(16 * i + rr) * 68];
#pragma unroll
              for (int rg = 0; rg < 4; ++rg) {
                  f32x4 cf[4][4];
#pragma unroll
                  for (int r4 = 0; r4 < 4; ++r4)
#pragma unroll
                      for (int g = 0; g <= rg; ++g) if (4 * g < 4 * rg + r4) cf[r4][g] = *(const LAS f32x4*)(a32 + (4 * rg + r4) * 68 + 4 * g);
#pragma unroll
                  for (int r4 = 0; r4 < 4; ++r4) { const int rr = 4 * rg + r4; if (rr == 0) continue; float s0 = x[rr], s1 = 0.f;
#pragma unroll
                      for (int g = 0; g <= rg; ++g) if (4 * g < rr) { s0 += cf[r4][g][0] * x[4 * g]; if (4 * g + 1 < rr) s1 += cf[r4][g][1] * x[4 * g + 1]; if (4 * g + 2 < rr) s0 += cf[r4][g][2] * x[4 * g + 2]; if (4 * g + 3 < rr) s1 += cf[r4][g][3] * x[4 * g + 3]; }
                      x[rr] = s0 + s1; }
                  asm volatile("" ::: "memory");
              }
#pragma unroll
              for (int rr = 1; rr < 16; ++rr) Rc[(16 * i + rr) * 68] = x[rr];
          }
          __syncthreads();
      }
      { const int cc = tid & 127, g16 = tid >> 7; const LAS float* src = (cc < 64 ? AT32 + cc : AKV32 + (cc - 64)) + (16 * g16) * 68;
        unsigned hh[16]; float lo[16];
#pragma unroll
        for (int rr = 0; rr < 16; ++rr) { const float v = src[rr * 68]; hh[rr] = f2bf(v); lo[rr] = v - bf2f((unsigned short)hh[rr]); }
        LAS unsigned char* dh = (cc < 64 ? SL(2) + cc * 144 : SL(4) + (cc - 64) * 144) + g16 * 32;
        *(LAS v4u*)dh = (v4u){hh[0] | (hh[1] << 16), hh[2] | (hh[3] << 16), hh[4] | (hh[5] << 16), hh[6] | (hh[7] << 16)};
        *(LAS v4u*)(dh + 16) = (v4u){hh[8] | (hh[9] << 16), hh[10] | (hh[11] << 16), hh[12] | (hh[13] << 16), hh[14] | (hh[15] << 16)};
        if (cc < 64) { LAS unsigned char* dl = SL(3) + cc * 144 + g16 * 32;
            *(LAS v4u*)dl = (v4u){pk2(lo[0], lo[1]), pk2(lo[2], lo[3]), pk2(lo[4], lo[5]), pk2(lo[6], lo[7])};
            *(LAS v4u*)(dl + 16) = (v4u){pk2(lo[8], lo[9]), pk2(lo[10], lo[11]), pk2(lo[12], lo[13]), pk2(lo[14], lo[15])}; } }
    }
    __syncthreads();
    { const int mt = wave >> 1, nt0 = 2 * (wave & 1), c = lane & 15, q = lane >> 4, m = 16 * mt + c;
      float* PTg = (float*)(ws + WS_PT32) + (size_t)u * 4096; float* QQg = (float*)(ws + WS_QQ) + (size_t)u * 4096; bf16* RPg = (bf16*)(ws + WS_RP) + (size_t)u * 4096; unsigned short* YVg = (unsigned short*)(ws + WS_YV) + (size_t)u * 4096;
      f32x4 a[2];
      RW_ZERO(a); mm_tiles(a, sARB, SL(2), wave, lane); mm_tiles(a, sARB, SL(3), wave, lane);
#pragma unroll
      for (int t = 0; t < 2; ++t) { const int n = 16 * (nt0 + t) + 4 * q; const v2u rr = *(const LAS v2u*)(SL(5) + m * 144 + n * 2);
          v2u w; w.x = pk2(a[t][0] + bf2f((unsigned short)(rr.x & 0xffffu)), a[t][1] + bf2f((unsigned short)(rr.x >> 16))); w.y = pk2(a[t][2] + bf2f((unsigned short)(rr.y & 0xffffu)), a[t][3] + bf2f((unsigned short)(rr.y >> 16)));
          *(GAS v2u*)(RPg + m * 64 + n) = w; }
      RW_ZERO(a); mm_tiles(a, sARB, SL(4), wave, lane); mm_tiles(a, sARK, SL(6), wave, lane);
#pragma unroll
      for (int t = 0; t < 2; ++t) { v2u w; w.x = pk2(a[t][0], a[t][1]); w.y = pk2(a[t][2], a[t][3]); *(GAS v2u*)(YVg + m * 64 + 16 * (nt0 + t) + 4 * q) = w; }
      if (tid < 64) ((float*)(ws + WS_WL))[(size_t)u * 64 + tid] = WLV[tid];
      RW_ZERO(a); mm_tiles(a, SL(7), SL(2), wave, lane); mm_tiles(a, SL(8), SL(2), wave, lane); mm_tiles(a, SL(7), SL(3), wave, lane);
#pragma unroll
      for (int t = 0; t < 2; ++t) *(GAS f32x4*)(PTg + m * 64 + 16 * (nt0 + t) + 4 * q) = a[t];
      RW_ZERO(a); mm_tiles(a, SL(4), SL(7), wave, lane); mm_tiles(a, SL(6), SL(9), wave, lane);
#pragma unroll
      for (int t = 0; t < 2; ++t) *(GAS f32x4*)(QQg + m * 64 + 16 * (nt0 + t) + 4 * q) = a[t];
    }
    __syncthreads();
#undef SL
}
__device__ __forceinline__ void wait_count(Frame& F, unsigned* cnt, unsigned target) {
    if (F.tid == 0) { unsigned* bar = (unsigned*)(F.ctl + CW_BAR);
        XB_SPIN(xb_ld(cnt) < target, bar);
        __builtin_amdgcn_fence(__ATOMIC_ACQUIRE, "agent"); asm volatile("s_waitcnt vmcnt(0)" ::: "memory"); }
    __syncthreads();
}
__device__ __forceinline__ void ph_rwkv_passA(Frame& F, int l) {
    PHASE_ENTRY();
    if (F.G == 256) wait_count(F, (unsigned*)(F.ctl + CW_QUEUE + 1024 + 64 * l), (unsigned)((MT / 256) * (NRC_PAD / 256)));
    int pu = -1;
    int u0 = F.bid, ustep = F.G, uend = RW_UNITS;
    if (F.G == 256) {
        const int r = F.bid & 127, sec = F.bid >> 7, nf = (r < (MT / 256) * (NIN_PAD / 256) - 768) ? 8 : 9;
        u0 = r + 128 * (sec ? nf : 0); ustep = 128; uend = r + 128 * (sec ? 18 : nf); }
    for (int u = u0; u < uend; u += ustep) { const bool reuse = (pu >= 0 && u < 2048 && (u & 127) == (pu & 127)); rwkv_passA_unit(A, F, l, u, reuse); pu = u; }
}

struct ChainOps { f32x4 pt[4]; f32x4 qq[2]; f32x4 wl; };
__device__ __forceinline__ void rwkv_chain_load(ChainOps& o, const float* PTg, const float* QQg, const float* WLg, int wave, int lane) {
    const int tk = wave & 3, tv0 = 2 * (wave >> 2), c = lane & 15, q = lane >> 4;
#pragma unroll
    for (int s = 0; s < 2; ++s) { o.pt[2 * s] = *(const GAS f32x4*)(PTg + (16 * tk + c) * 64 + 8 * q + 32 * s); o.pt[2 * s + 1] = *(const GAS f32x4*)(PTg + (16 * tk + c) * 64 + 8 * q + 32 * s + 4); }
#pragma unroll
    for (int t = 0; t < 2; ++t) o.qq[t] = *(const GAS f32x4*)(QQg + (16 * (tv0 + t) + c) * 64 + 16 * tk + 4 * q);
    o.wl = *(const GAS f32x4*)(WLg + 16 * tk + 4 * q);
}
__device__ __forceinline__ void rwkv_chain_step(f32x4 (&acc)[2], const ChainOps& o, const LAS unsigned char* Shi, const LAS unsigned char* Slo, int wave, int lane) {
    const int tv0 = 2 * (wave >> 2), c = lane & 15, q = lane >> 4;
    bf16x8 ph[2], pl[2];
#pragma unroll
    for (int s = 0; s < 2; ++s) { const f32x4 x0 = o.pt[2 * s], x1 = o.pt[2 * s + 1];
        unsigned h[8]; float lo[8];
#pragma unroll
        for (int i = 0; i < 4; ++i) { h[i] = f2bf(x0[i]); lo[i] = x0[i] - bf2f((unsigned short)h[i]); h[4 + i] = f2bf(x1[i]); lo[4 + i] = x1[i] - bf2f((unsigned short)h[4 + i]); }
        ph[s] = __builtin_bit_cast(bf16x8, (v4u){h[0] | (h[1] << 16), h[2] | (h[3] << 16), h[4] | (h[5] << 16), h[6] | (h[7] << 16)});
        pl[s] = __builtin_bit_cast(bf16x8, (v4u){pk2(lo[0], lo[1]), pk2(lo[2], lo[3]), pk2(lo[4], lo[5]), pk2(lo[6], lo[7])}); }
#pragma unroll
    for (int t = 0; t < 2; ++t) { const int v = 16 * (tv0 + t) + c;
        f32x4 a = o.qq[t] + acc[t] * o.wl;
        const bf16x8 s0 = *(const LAS bf16x8*)(Shi + v * 144 + q * 16), s1 = *(const LAS bf16x8*)(Shi + v * 144 + q * 16 + 64);
        const bf16x8 l0 = *(const LAS bf16x8*)(Slo + v * 144 + q * 16), l1 = *(const LAS bf16x8*)(Slo + v * 144 + q * 16 + 64);
        a = __builtin_amdgcn_mfma_f32_16x16x32_bf16(ph[0], s0, a, 0, 0, 0); a = __builtin_amdgcn_mfma_f32_16x16x32_bf16(ph[1], s1, a, 0, 0, 0);
        a = __builtin_amdgcn_mfma_f32_16x16x32_bf16(ph[0], l0, a, 0, 0, 0); a = __builtin_amdgcn_mfma_f32_16x16x32_bf16(ph[1], l1, a, 0, 0, 0);
        a = __builtin_amdgcn_mfma_f32_16x16x32_bf16(pl[0], s0, a, 0, 0, 0); a = __builtin_amdgcn_mfma_f32_16x16x32_bf16(pl[1], s1, a, 0, 0, 0);
        acc[t] = a; }
}
__device__ __forceinline__ void rwkv_state_to_lds(const f32x4 (&acc)[2], LAS unsigned char* Shi, LAS unsigned char* Slo, int wave, int lane) {
    const int tk = wave & 3, tv0 = 2 * (wave >> 2), c = lane & 15, q = lane >> 4;
#pragma unroll
    for (int t = 0; t < 2; ++t) { unsigned h[4]; float lo[4];
#pragma unroll
        for (int i = 0; i < 4; ++i) { h[i] = f2bf(acc[t][i]); lo[i] = acc[t][i] - bf2f((unsigned short)h[i]); }
        const int o = (16 * (tv0 + t) + c) * 144 + (16 * tk + 4 * q) * 2;
        *(LAS v2u*)(Shi + o) = (v2u){h[0] | (h[1] << 16), h[2] | (h[3] << 16)}; *(LAS v2u*)(Slo + o) = (v2u){pk2(lo[0], lo[1]), pk2(lo[2], lo[3])}; }
}
__device__ __forceinline__ void ph_rwkv_chain(Frame& F, int l) {
    PHASE_ENTRY();
    unsigned char* ws = A->ws; const int tid = F.tid, lane = F.lane, wave = F.wave;
    const int tk = wave & 3, tv0 = 2 * (wave >> 2), c = lane & 15, q = lane >> 4;
    LAS unsigned char* HI0 = F.lds, *LO0 = F.lds + RW_SLOT, *HI1 = F.lds + 2 * RW_SLOT, *LO1 = F.lds + 3 * RW_SLOT;
    const float* PT = (const float*)(ws + WS_PT32); const float* QQ = (const float*)(ws + WS_QQ); const float* WL = (const float*)(ws + WS_WL); bf16* SC = (bf16*)(ws + WS_SC);
    if (F.bid < 16) {
        const int h = F.bid;
        f32x4 acc[2]; RW_ZERO(acc);
        rwkv_state_to_lds(acc, HI0, LO0, wave, lane);
        __syncthreads();
        ChainOps ops; rwkv_chain_load(ops, PT + (size_t)(h * 128) * 4096, QQ + (size_t)(h * 128) * 4096, WL + (size_t)(h * 128) * 64, wave, lane);
        for (int cc = 0; cc < 128; ++cc) { const int u = h * 128 + cc; LAS unsigned char* chi = (cc & 1) ? HI1 : HI0, *clo = (cc & 1) ? LO1 : LO0, *nhi = (cc & 1) ? HI0 : HI1, *nlo = (cc & 1) ? LO0 : LO1;
            { const int row = tid >> 3, ch = tid & 7; *(GAS v4u*)((unsigned char*)(SC + (size_t)u * 4096) + tid * 16) = *(const LAS v4u*)(chi + row * 144 + ch * 16); }
            const ChainOps cur = ops;
            if (cc + 1 < 128) rwkv_chain_load(ops, PT + (size_t)(u + 1) * 4096, QQ + (size_t)(u + 1) * 4096, WL + (size_t)(u + 1) * 64, wave, lane);
            rwkv_chain_step(acc, cur, chi, clo, wave, lane);
            rwkv_state_to_lds(acc, nhi, nlo, wave, lane);
            __syncthreads(); }
#ifndef PROBE_SEQ
        float* wo = A->out + O_WP + (size_t)(l * 16 + h) * 4096;
#else
        float* wo = (float*)(A->ws + WS_HALO) + (size_t)h * 4096;
#endif
#pragma unroll
        for (int t = 0; t < 2; ++t) *(GAS f32x4*)(wo + (16 * (tv0 + t) + c) * 64 + 16 * tk + 4 * q) = acc[t];
    } else {
        for (int su = F.bid - 16; su < NSB * 16; su += F.G - 16) { const int u = 2048 + su, sb = su >> 4, h = su & 15;
            const float* S0 = A->in[I_SWKV] + (size_t)((l * NSB + sb) * 16 + h) * 4096;
            f32x4 acc[2];
#pragma unroll
            for (int t = 0; t < 2; ++t) acc[t] = *(const GAS f32x4*)(S0 + (16 * (tv0 + t) + c) * 64 + 16 * tk + 4 * q);
            rwkv_state_to_lds(acc, HI0, LO0, wave, lane);
            __syncthreads();
            { const int row = tid >> 3, ch = tid & 7; *(GAS v4u*)((unsigned char*)(SC + (size_t)u * 4096) + tid * 16) = *(const LAS v4u*)(HI0 + row * 144 + ch * 16); }
            { ChainOps o1; rwkv_chain_load(o1, PT + (size_t)u * 4096, QQ + (size_t)u * 4096, WL + (size_t)u * 64, wave, lane); rwkv_chain_step(acc, o1, HI0, LO0, wave, lane); }
            float* wo = A->out + O_WS + (size_t)((l * NSB + sb) * 16 + h) * 4096;
#pragma unroll
            for (int t = 0; t < 2; ++t) *(GAS f32x4*)(wo + (16 * (tv0 + t) + c) * 64 + 16 * tk + 4 * q) = acc[t];
            __syncthreads(); }
    }
}
__device__ __forceinline__ void ph_rwkv_passC(Frame& F, int l) {
    PHASE_ENTRY();
    unsigned char* ws = A->ws; const int lane = F.lane, wave = F.wave, c = lane & 15, q = lane >> 4, mt = wave & 3;
    const bf16* RP = (const bf16*)(ws + WS_RP); const unsigned short* YV = (const unsigned short*)(ws + WS_YV); const bf16* SC = (const bf16*)(ws + WS_SC);
    const unsigned short* G1 = (const unsigned short*)(ws + WS_G1); const unsigned short* G2 = (const unsigned short*)(ws + WS_G2); bf16* YC = (bf16*)(ws + WS_YCAT);
    bf16x8 rA[2], rB[2], sA[8], sB[8]; f32x4 yA[4], yB[4], gA[8], gB[8];
    auto geo = [&](int u, int& h, int& row0, bool& skip) { const bool samp = u >= 2048;
        if (!samp) { h = u >> 7; row0 = 64 * (u & 127); } else { const int su = u - 2048; h = su & 15; row0 = MP + (su >> 4) * TS; }
        skip = samp && mt > 0; };
    auto load = [&](int u, bf16x8 (&r)[2], bf16x8 (&sv)[8], f32x4 (&y)[4], f32x4 (&g)[8]) { int h, row0; bool skip; geo(u, h, row0, skip); if (skip) return;
        const bf16* RPu = RP + (size_t)u * 4096; const unsigned short* YVu = YV + (size_t)u * 4096; const bf16* SCu = SC + (size_t)u * 4096; const int t = 16 * mt + c; const size_t ro = (size_t)(row0 + t);
        r[0] = *(const GAS bf16x8*)(RPu + t * 64 + 8 * q); r[1] = *(const GAS bf16x8*)(RPu + t * 64 + 8 * q + 32);
#pragma unroll
        for (int nt = 0; nt < 4; ++nt) { const int v = h * 64 + 16 * nt + 4 * q; { const v2u yw = *(const GAS v2u*)(YVu + t * 64 + 16 * nt + 4 * q); y[nt] = (f32x4){bf2f((unsigned short)(yw.x & 0xffffu)), bf2f((unsigned short)(yw.x >> 16)), bf2f((unsigned short)(yw.y & 0xffffu)), bf2f((unsigned short)(yw.y >> 16))}; }
            sv[2 * nt] = *(const GAS bf16x8*)(SCu + (16 * nt + c) * 64 + 8 * q); sv[2 * nt + 1] = *(const GAS bf16x8*)(SCu + (16 * nt + c) * 64 + 8 * q + 32);
            { const v2u a = *(const GAS v2u*)(G1 + ro * 1024 + v), b = *(const GAS v2u*)(G2 + ro * 1024 + v);
              g[nt] = (f32x4){bf2f((unsigned short)(a.x & 0xffffu)), bf2f((unsigned short)(a.x >> 16)), bf2f((unsigned short)(a.y & 0xffffu)), bf2f((unsigned short)(a.y >> 16))};
              g[4 + nt] = (f32x4){bf2f((unsigned short)(b.x & 0xffffu)), bf2f((unsigned short)(b.x >> 16)), bf2f((unsigned short)(b.y & 0xffffu)), bf2f((unsigned short)(b.y >> 16))}; } } };
    auto compute = [&](int u, const bf16x8 (&r)[2], const bf16x8 (&sv)[8], f32x4 (&y)[4], const f32x4 (&g)[8]) { int h, row0; bool skip; geo(u, h, row0, skip); if (skip) return;
        const int t = 16 * mt + c; const size_t ro = (size_t)(row0 + t); float s1 = 0.f;
#pragma unroll
        for (int nt = 0; nt < 4; ++nt) { y[nt] = __builtin_amdgcn_mfma_f32_16x16x32_bf16(sv[2 * nt], r[0], y[nt], 0, 0, 0); y[nt] = __builtin_amdgcn_mfma_f32_16x16x32_bf16(sv[2 * nt + 1], r[1], y[nt], 0, 0, 0);
            s1 += (y[nt][0] + y[nt][1]) + (y[nt][2] + y[nt][3]); }
        s1 += swz_xor<16>(s1); s1 += xor32(s1);
        const float mean = s1 * (1.f / 64.f); float s2 = 0.f;
#pragma unroll
        for (int nt = 0; nt < 4; ++nt) { y[nt] = y[nt] - mean; s2 += (y[nt][0] * y[nt][0] + y[nt][1] * y[nt][1]) + (y[nt][2] * y[nt][2] + y[nt][3] * y[nt][3]); }
        s2 += swz_xor<16>(s2); s2 += xor32(s2);
        const float rstd = __builtin_amdgcn_rsqf(s2 * (1.f / 64.f) + 64e-5f);
#pragma unroll
        for (int nt = 0; nt < 4; ++nt) { const int v = h * 64 + 16 * nt + 4 * q;
            const f32x4 o = y[nt] * rstd * g[nt] + g[4 + nt]; v2u w; w.x = pk2(o[0], o[1]); w.y = pk2(o[2], o[3]); *(GAS v2u*)(YC + ro * DMOD + v) = w; } };
    const int u0 = 2 * F.bid + (wave >> 2), us = 2 * F.G;
    if (u0 < RW_UNITS) load(u0, rA, sA, yA, gA);
    for (int u = u0; u < RW_UNITS; u += 2 * us) {
        if (u + us < RW_UNITS) load(u + us, rB, sB, yB, gB);
        compute(u, rA, sA, yA, gA);
        if (u + us < RW_UNITS) { if (u + 2 * us < RW_UNITS) load(u + 2 * us, rA, sA, yA, gA); compute(u + us, rB, sB, yB, gB); }
    }
}
__device__ __forceinline__ void attn_sample_unit(ArgsP A, Frame& F, int l, int sb, int h) {
    unsigned char* ws = A->ws; const int tid = F.tid, lane = F.lane, wave = F.wave;
    LAS float* QS = (LAS float*)F.lds;
    LAS float* LUT = QS + 2048;
    LAS float* PB = QS + 4096 + wave * 1024;
    LAS float* MLW = QS + 4096 + 8192;
    LAS float* OACC = MLW + 128;
    LAS float* LACC = OACC + 4096;
    const bf16* QB = (const bf16*)(ws + WS_QB); const bf16* KB = (const bf16*)(ws + WS_KB); const bf16* VB = (const bf16*)(ws + WS_VB);
    const float* reltab = A->in[I_REL];
    for (int i = tid; i < 2048; i += NWAVES * 64) { const int t = i >> 7, d = i & 127; QS[i] = bf2f(QB[(size_t)(MP + sb * TS + t) * 1024 + h * 128 + d]); }
    if (tid < 192) { const int rel = tid - 128; const int n = rel < 0 ? -rel : rel;
        const int lg = n < 12 ? 8 : n < 16 ? 9 : n < 23 ? 10 : n < 32 ? 11 : n < 46 ? 12 : n < 64 ? 13 : n < 91 ? 14 : 15;
        const int bucket = (rel > 0 ? 16 : 0) + (n < 8 ? n : lg);
        LUT[tid] = (reltab[bucket * 8 + h] - reltab[15 * 8 + h]) * 1.4426950408889634f; }
    for (int i = tid; i < 4096 + 32; i += NWAVES * 64) OACC[i] = 0.f;
    __syncthreads();
    const int map = wave & 1, kg = wave >> 1;
    float mrun[16], lrun[16], o[16][2];
#pragma unroll
    for (int t = 0; t < 16; ++t) { mrun[t] = -INFINITY; lrun[t] = 0.f; o[t][0] = 0.f; o[t][1] = 0.f; }
    const float* CK = A->in[I_CK] + (size_t)(l * NSB + sb) * PAST * 1024; const float* CV = A->in[I_CV] + (size_t)(l * NSB + sb) * PAST * 1024;
    for (int kb = kg; kb < 33; kb += 4) {
        const int pos = 64 * kb + lane; const bool kvalid = pos < PAST + TS;
        float s[16];
#pragma unroll
        for (int t = 0; t < 16; ++t) s[t] = 0.f;
        if (kb < 32) { const float* kp = CK + (size_t)pos * 1024 + h * 128 + map * 64;
#pragma unroll 4
            for (int d = 0; d < 64; d += 4) { const f32x4 kv = *(const GAS f32x4*)(kp + d);
#pragma unroll
                for (int t = 0; t < 16; ++t) { const f32x4 qv = *(const LAS f32x4*)(QS + t * 128 + map * 64 + d); s[t] += (kv[0] * qv[0] + kv[1] * qv[1]) + (kv[2] * qv[2] + kv[3] * qv[3]); } }
        } else { const int rr = MP + sb * TS + (lane & 15); const bf16* kp = KB + (size_t)rr * 1024 + h * 128 + map * 64;
#pragma unroll 4
            for (int d = 0; d < 64; d += 4) { const v2u kw = *(const GAS v2u*)(kp + d);
                const f32x4 kv = (f32x4){bf2f((unsigned short)(kw.x & 0xffffu)), bf2f((unsigned short)(kw.x >> 16)), bf2f((unsigned short)(kw.y & 0xffffu)), bf2f((unsigned short)(kw.y >> 16))};
#pragma unroll
                for (int t = 0; t < 16; ++t) { const f32x4 qv = *(const LAS f32x4*)(QS + t * 128 + map * 64 + d); s[t] += (kv[0] * qv[0] + kv[1] * qv[1]) + (kv[2] * qv[2] + kv[3] * qv[3]); } }
        }
        float al[16];
#pragma unroll
        for (int t = 0; t < 16; ++t) { int idx = pos - (PAST + t) + 128; idx = idx < 0 ? 0 : idx; idx = idx > 191 ? 191 : idx;
            float sv = kvalid ? s[t] + LUT[idx] : -INFINITY;
            const float bm = wave_max(sv);
            const float mn = fmaxf(mrun[t], bm); al[t] = __builtin_amdgcn_exp2f(mrun[t] - mn); mrun[t] = mn;
            const float p = __builtin_amdgcn_exp2f(sv - mn); PB[lane * 16 + t] = p;
            lrun[t] = lrun[t] * al[t] + wave_sum(p);
            o[t][0] *= al[t]; o[t][1] *= al[t]; }
        LDS_WAIT(); asm volatile("" ::: "memory");
        const int nk = (kb < 32) ? 64 : TS;
        for (int k0 = 0; k0 < nk; k0 += 4) { f32x2 vv[4];
            if (kb < 32) {
#pragma unroll
                for (int b = 0; b < 4; ++b) vv[b] = *(const GAS f32x2*)(CV + (size_t)(64 * kb + k0 + b) * 1024 + h * 128 + 2 * lane);
            } else {
#pragma unroll
                for (int b = 0; b < 4; ++b) { const unsigned w = *(const GAS unsigned*)(VB + (size_t)(MP + sb * TS + k0 + b) * 1024 + h * 128 + 2 * lane); vv[b].x = bf2f((unsigned short)(w & 0xffffu)); vv[b].y = bf2f((unsigned short)(w >> 16)); }
            }
#pragma unroll
            for (int b = 0; b < 4; ++b) { const LAS f32x4* pp = (const LAS f32x4*)(PB + (k0 + b) * 16);
                const f32x4 p0 = pp[0], p1 = pp[1], p2 = pp[2], p3 = pp[3];
#pragma unroll
                for (int t = 0; t < 4; ++t) { o[t][0] += p0[t] * vv[b].x; o[t][1] += p0[t] * vv[b].y; o[4 + t][0] += p1[t] * vv[b].x; o[4 + t][1] += p1[t] * vv[b].y;
                    o[8 + t][0] += p2[t] * vv[b].x; o[8 + t][1] += p2[t] * vv[b].y; o[12 + t][0] += p3[t] * vv[b].x; o[12 + t][1] += p3[t] * vv[b].y; }
                asm volatile("" ::: "memory"); } }
        LDS_WAIT(); asm volatile("" ::: "memory");
    }
    if (lane < 16) { float mv = mrun[0];
#pragma unroll
        for (int t = 1; t < 16; ++t) mv = (lane == t) ? mrun[t] : mv;
        MLW[wave * 16 + lane] = mv; }
    __syncthreads();
#pragma unroll
    for (int t = 0; t < 16; ++t) { float M = fmaxf(fmaxf(MLW[(map) * 16 + t], MLW[(2 + map) * 16 + t]), fmaxf(MLW[(4 + map) * 16 + t], MLW[(6 + map) * 16 + t]));
        const float sc = __builtin_amdgcn_exp2f(mrun[t] - M);
        __hip_atomic_fetch_add(OACC + (t * 2 + map) * 128 + 2 * lane, o[t][0] * sc, __ATOMIC_RELAXED, __HIP_MEMORY_SCOPE_WORKGROUP); __hip_atomic_fetch_add(OACC + (t * 2 + map) * 128 + 2 * lane + 1, o[t][1] * sc, __ATOMIC_RELAXED, __HIP_MEMORY_SCOPE_WORKGROUP);
        if (lane == 0) __hip_atomic_fetch_add(LACC + map * 16 + t, lrun[t] * sc, __ATOMIC_RELAXED, __HIP_MEMORY_SCOPE_WORKGROUP); }
    __syncthreads();
    float* OA = (float*)(ws + WS_OATT);
    for (int i = tid; i < 4096; i += NWAVES * 64) { const int t = i >> 8, mp = (i >> 7) & 1, e = i & 127;
        OA[(size_t)(MP + sb * TS + t) * DMOD + h * 256 + mp * 128 + e] = OACC[i] / LACC[mp * 16 + t]; }
    __syncthreads();
}


__device__ __forceinline__ void attn_sample_unit2(ArgsP A, Frame& F, int l, int sb, int h) {
    using attn_body::f32x16;
    unsigned char* ws = A->ws; int tid_ = F.tid; asm volatile("" : "+v"(tid_));
    const int tid = tid_, lane = tid & 63, wid = __builtin_amdgcn_readfirstlane(tid >> 6), r32 = lane & 31, hi = lane >> 5, map = wid & 1, vh = (wid >> 1) & 1, KH = wid >> 2;
    LAS unsigned char* L = F.lds;
    LAS float* wsf = (LAS float*)(L + 65536) + wid * 64;
    const LAS float* LUT = (const LAS float*)(L + LUT_OFF) + h * 192;
    LAS float* MG = (LAS float*)(L + 68608);
    const bf16* QB = (const bf16*)(ws + WS_QB); const bf16* KB = (const bf16*)(ws + WS_KB); const bf16* VB = (const bf16*)(ws + WS_VB);
    const float* CK = A->in[I_CK] + (size_t)(l * NSB + sb) * PAST * 1024 + h * 128; const float* CV = A->in[I_CV] + (size_t)(l * NSB + sb) * PAST * 1024 + h * 128;
    bf16x8 qr[4];
    { const bf16* Qw = QB + (size_t)(MP + sb * TS + (r32 & 15)) * 1024 + h * 128 + map * 64;
#pragma unroll
      for (int d0 = 0; d0 < 4; ++d0) qr[d0] = *(const GAS bf16x8*)(Qw + d0 * 16 + hi * 8); }
    f32x4 st[8];
    auto stage_load = [&](int tile) {
        if (tile < 32) {
#pragma unroll
            for (int k = 0; k < 4; ++k) { const int idx = tid + 512 * k, row = idx >> 5, pp = idx & 31; const size_t off = (size_t)(64 * tile + row) * 1024 + 4 * pp;
                st[k] = __builtin_nontemporal_load((const GAS f32x4*)(CK + off)); st[4 + k] = __builtin_nontemporal_load((const GAS f32x4*)(CV + off)); }
        } else {
#pragma unroll
            for (int i = 0; i < 8; ++i) st[i] = (f32x4){0.f, 0.f, 0.f, 0.f};
            { const int row = tid >> 5, pp = tid & 31; const size_t off = (size_t)(MP + sb * TS + row) * 1024 + h * 128 + 4 * pp;
              const v2u wk = *(const GAS v2u*)(KB + off), wv = *(const GAS v2u*)(VB + off);
              st[0] = (f32x4){bf2f((unsigned short)(wk.x & 0xffffu)), bf2f((unsigned short)(wk.x >> 16)), bf2f((unsigned short)(wk.y & 0xffffu)), bf2f((unsigned short)(wk.y >> 16))};
              st[4] = (f32x4){bf2f((unsigned short)(wv.x & 0xffffu)), bf2f((unsigned short)(wv.x >> 16)), bf2f((unsigned short)(wv.y & 0xffffu)), bf2f((unsigned short)(wv.y >> 16))}; }
        } };
    auto stage_write = [&](int buf) { LAS unsigned char* B = L + buf * 32768;
#pragma unroll
        for (int k = 0; k < 4; ++k) { const int idx = tid + 512 * k, row = idx >> 5, pp = idx & 31, c = 4 * (pp & 15); const f32x4 x = st[k], y = st[4 + k];
            *(LAS v2u*)(B + (pp >> 4) * 8192 + ((pp & 15) >> 1) * 1024 + row * 16 + (pp & 1) * 8) = (v2u){pk2(x[0], x[1]), pk2(x[2], x[3])};
            *(LAS v2u*)(B + 16384 + (pp >> 4) * 8192 + ((c >> 5) * 4 + (row >> 4)) * 1024 + ((row & 15) * 4 + ((c & 31) >> 3)) * 16 + ((c >> 2) & 1) * 8) = (v2u){pk2(y[0], y[1]), pk2(y[2], y[3])}; } };
    stage_load(0);
    float mhat = 0.f, l_reg = 0.f; f32x16 o[2]; o[0] = f32x16{}; o[1] = f32x16{};
    stage_write(0);
    __syncthreads();
    for (int tile = 0; tile < 33; ++tile) {
        if (tile + 1 < 33) stage_load(tile + 1);
        const LAS unsigned char* B = L + (tile & 1) * 32768;
        f32x16 p;
        attn_body::qkt_half(p, (attn_body::lds_cp)(B + map * 8192), qr, f32x16{}, r32, hi, KH);
        asm volatile("s_nop 15\n\ts_nop 7" : "+v"(p));
#pragma unroll
        for (int r = 0; r < 16; ++r) p[r] -= mhat;
        if (tile >= 30) {
            const int rel0 = 64 * tile + 32 * KH + 4 * hi - (PAST + (r32 & 15)) + 128;
#pragma unroll
            for (int r = 0; r < 16; ++r) { const int kin = 32 * KH + 4 * hi + (r & 3) + 8 * (r >> 2); int idx = rel0 + (r & 3) + 8 * (r >> 2); idx = idx < 0 ? 0 : (idx > 191 ? 191 : idx);
                p[r] = (tile == 32 && kin >= TS) ? -INFINITY : p[r] + LUT[idx]; } }
        float rm = p[0];
#pragma unroll
        for (int r = 1; r < 16; ++r) rm = fmaxf(rm, p[r]);
        { const PL32 rr = pl32(rm); rm = fmaxf(rr.a, rr.b); }
        if (__any(rm > 0.f)) { const float dl = fmaxf(rm, 0.f); mhat += dl;
#pragma unroll
            for (int r = 0; r < 16; ++r) p[r] -= dl;
            const float f = __builtin_amdgcn_exp2f(-dl); l_reg *= f; if (hi == 0) wsf[r32] = f;
            asm volatile("s_waitcnt lgkmcnt(0)" ::: "memory");
#pragma unroll
            for (int d_ = 0; d_ < 2; ++d_)
#pragma unroll
                for (int r = 0; r < 16; ++r) o[d_][r] *= wsf[attn_body::crow(r, hi)]; }
        float sacc = 0.f;
#pragma unroll
        for (int r = 0; r < 16; ++r) { p[r] = __builtin_amdgcn_exp2f(p[r]); sacc += p[r]; }
        l_reg += sacc;
        const v4u pw0 = (v4u){attn_body::cvtpk_s(p[0], p[1]), attn_body::cvtpk_s(p[2], p[3]), attn_body::cvtpk_s(p[4], p[5]), attn_body::cvtpk_s(p[6], p[7])};
        const v4u pw1 = (v4u){attn_body::cvtpk_s(p[8], p[9]), attn_body::cvtpk_s(p[10], p[11]), attn_body::cvtpk_s(p[12], p[13]), attn_body::cvtpk_s(p[14], p[15])};
        const int vb = (int)(unsigned)(size_t)(B + 16384 + vh * 8192) + KH * 2048 + ((lane >> 4) & 1) * 32 + (lane & 3) * 8 + (4 * hi + ((lane & 15) >> 2)) * 64;
        attn_body::pv_half(o, vb, __builtin_bit_cast(bf16x8, pw0), __builtin_bit_cast(bf16x8, pw1));
        if (tile + 1 < 33) stage_write((tile + 1) & 1);
        __syncthreads();
    }
    { const PL32 rr = pl32(l_reg); l_reg = rr.a + rr.b; }
    LAS float* OG = (LAS float*)L + (wid & 3) * 2048;
    if (KH == 1) { if (hi == 0) { MG[(wid & 3) * 64 + r32] = mhat; MG[(wid & 3) * 64 + 32 + r32] = l_reg; }
#pragma unroll
        for (int d_ = 0; d_ < 2; ++d_)
#pragma unroll
            for (int r = 0; r < 16; ++r) OG[(d_ * 16 + r) * 64 + lane] = o[d_][r]; }
    __syncthreads();
    if (KH == 0) { const float m2 = MG[wid * 64 + r32], l2 = MG[wid * 64 + 32 + r32]; const float M = fmaxf(mhat, m2);
        const float f1 = __builtin_amdgcn_exp2f(mhat - M), f2 = __builtin_amdgcn_exp2f(m2 - M); const float inv = 1.f / (l_reg * f1 + l2 * f2);
        if (hi == 0) { wsf[r32] = f1 * inv; wsf[32 + r32] = f2 * inv; }
        asm volatile("s_waitcnt lgkmcnt(0)" ::: "memory");
        bf16* OA = (bf16*)(ws + WS_OATT) + (size_t)(MP + sb * TS) * DMOD + h * 256 + map * 128 + vh * 64;
#pragma unroll
        for (int r = 0; r < 8; ++r) { const int q = attn_body::crow(r, hi); const float g1 = wsf[q], g2 = wsf[32 + q];
#pragma unroll
            for (int d_ = 0; d_ < 2; ++d_) OA[(size_t)q * DMOD + d_ * 32 + r32] = (bf16)f2bf(o[d_][r] * g1 + OG[(d_ * 16 + r) * 64 + lane] * g2); } }
    __syncthreads();
}
__device__ __forceinline__ void attn_build_lut(ArgsP A, Frame& F) {
    LAS float* T = (LAS float*)(F.lds + LUT_OFF); const float* reltab = A->in[I_REL];
    for (int i = F.tid; i < 8 * 192; i += NWAVES * 64) { const int hh = i / 192, rel = i % 192 - 128; const int n = rel < 0 ? -rel : rel;
        const int lg = n < 12 ? 8 : n < 16 ? 9 : n < 23 ? 10 : n < 32 ? 11 : n < 46 ? 12 : n < 64 ? 13 : n < 91 ? 14 : 15;
        const int bucket = (rel > 0 ? 16 : 0) + (n < 8 ? n : lg);
        T[i] = (reltab[bucket * 8 + hh] - reltab[15 * 8 + hh]) * 1.4426950408889634f; }
    __syncthreads();
}
__device__ __forceinline__ void ph_attn_sample(Frame& F, int l) {
    PHASE_ENTRY();
    attn_build_lut(A, F);
    gu32* head = F.ctl + CW_QUEUE + 128 * l;
    for (;;) {
        if (F.tid == 0) F.MISC[16] = __hip_atomic_fetch_add(head, 1u, RLX_AGENT);
        __syncthreads();
        const unsigned qi = F.MISC[16];
        __syncthreads();
        if (qi >= 128u) break;
#ifdef SAMPLE_VALU
        attn_sample_unit(A, F, l, (int)(qi >> 3), (int)(qi & 7u));
#else
        attn_sample_unit2(A, F, l, (int)(qi >> 3), (int)(qi & 7u));
#endif
    }
}
__device__ __forceinline__ void ph_attn_prompt(Frame& F, int l) {
    PHASE_ENTRY();
    unsigned char* ws = A->ws;
    gu32* head = F.ctl + CW_QUEUE + 128 * l + 64;
    for (;;) {
        if (F.tid == 0) F.MISC[17] = __hip_atomic_fetch_add(head, 1u, RLX_AGENT);
        __syncthreads();
        const unsigned qi = F.MISC[17];
        __syncthreads();
        if (qi >= 1024u) break;
        const int qb = 63 - (int)(qi >> 4), hm = (int)(qi & 15u);
        const int hh = hm >> 1, mp = hm & 1;
        attn_body::attn_unit_f<8>(qb, hh * 128 + mp * 64, hh * 128, hh * 256 + mp * 128,
                                (const attn_body::bf16*)(ws + WS_QB), (const attn_body::bf16*)(ws + WS_KB), (const attn_body::bf16*)(ws + WS_VB), (attn_body::bf16*)(ws + WS_OATT), (char*)F.lds, (const LAS float*)(F.lds + LUT_OFF) + hh * 192);
    }
}
__device__ __forceinline__ void ph_attn_final(Frame& F, int l) {
    PHASE_ENTRY();
    const int lane = F.lane; const int gw = F.bid * NWAVES + F.wave, NGW = F.G * NWAVES;
    float d1 = A->in[I_LQ1][l * 64 + lane] * A->in[I_LK1][l * 64 + lane], d2 = A->in[I_LQ2][l * 64 + lane] * A->in[I_LK2][l * 64 + lane];
    d1 = wave_sum(d1); d2 = wave_sum(d2);
    const float lam_init = (l == 0) ? 0.2f : (0.8f - 0.6f * 0.7408182206817179f);
    const float lam = expf(d1) - expf(d2) + lam_init, osc = 1.f - lam_init;
    const int hh = lane >> 3, e0 = (lane & 7) * 16;
    const bf16* OA = (const bf16*)(A->ws + WS_OATT); bf16* YC = (bf16*)(A->ws + WS_YCAT);
    f32x4 sl[4];
#pragma unroll
    for (int j = 0; j < 4; ++j) sl[j] = *(const GAS f32x4*)(A->in[I_SUBLN] + l * 128 + e0 + 4 * j);
    v4u na0 = (v4u){0u, 0u, 0u, 0u}, na1 = na0, nb0 = na0, nb1 = na0;
    if (gw < MT) { const bf16* o2 = OA + (size_t)gw * DMOD + hh * 256 + e0; na0 = *(const GAS v4u*)o2; na1 = *(const GAS v4u*)(o2 + 8); nb0 = *(const GAS v4u*)(o2 + 128); nb1 = *(const GAS v4u*)(o2 + 136); }
    for (int m = gw; m < MT; m += NGW) {
        if (l == 0 && m >= MP) { const float* xs = A->in[I_XS] + (size_t)(m - MP) * DMOD; float* xd = (float*)(A->ws + WS_X) + (size_t)m * DMOD;
#pragma unroll
            for (int j = 0; j < 8; ++j) *(GAS f32x4*)(xd + 4 * lane + 256 * j) = *(const GAS f32x4*)(xs + 4 * lane + 256 * j); }
        f32x4 o[4]; float ss = 0.f;
        { const v4u a0 = na0, a1 = na1, b0 = nb0, b1 = nb1;
          if (m + NGW < MT) { const bf16* o2 = OA + (size_t)(m + NGW) * DMOD + hh * 256 + e0; na0 = *(const GAS v4u*)o2; na1 = *(const GAS v4u*)(o2 + 8); nb0 = *(const GAS v4u*)(o2 + 128); nb1 = *(const GAS v4u*)(o2 + 136); }
          const unsigned aw[8] = {a0.x, a0.y, a0.z, a0.w, a1.x, a1.y, a1.z, a1.w}, bw[8] = {b0.x, b0.y, b0.z, b0.w, b1.x, b1.y, b1.z, b1.w};
#pragma unroll
          for (int j = 0; j < 4; ++j) { o[j][0] = bf2f((unsigned short)(aw[2 * j] & 0xffffu)) - lam * bf2f((unsigned short)(bw[2 * j] & 0xffffu)); o[j][1] = bf2f((unsigned short)(aw[2 * j] >> 16)) - lam * bf2f((unsigned short)(bw[2 * j] >> 16));
              o[j][2] = bf2f((unsigned short)(aw[2 * j + 1] & 0xffffu)) - lam * bf2f((unsigned short)(bw[2 * j + 1] & 0xffffu)); o[j][3] = bf2f((unsigned short)(aw[2 * j + 1] >> 16)) - lam * bf2f((unsigned short)(bw[2 * j + 1] >> 16));
              ss += (o[j][0] * o[j][0] + o[j][1] * o[j][1]) + (o[j][2] * o[j][2] + o[j][3] * o[j][3]); } }
        ss += swz_xor<1>(ss); ss += swz_xor<2>(ss); ss += swz_xor<4>(ss);
        const float rs = osc * __builtin_amdgcn_rsqf(ss * (1.f / 128.f) + 1e-5f);
        v4u w0, w1; f32x4 y0 = o[0] * rs * sl[0], y1 = o[1] * rs * sl[1], y2 = o[2] * rs * sl[2], y3 = o[3] * rs * sl[3];
        w0 = (v4u){pk2(y0[0], y0[1]), pk2(y0[2], y0[3]), pk2(y1[0], y1[1]), pk2(y1[2], y1[3])}; w1 = (v4u){pk2(y2[0], y2[1]), pk2(y2[2], y2[3]), pk2(y3[0], y3[1]), pk2(y3[2], y3[3])};
        bf16* yo = YC + (size_t)m * DMOD + 1024 + hh * 128 + e0; *(GAS v4u*)yo = w0; *(GAS v4u*)(yo + 8) = w1;
    }
}
__device__ __forceinline__ void ph_fixup(Frame& F, int l) {
    PHASE_ENTRY();
    const float* tail = (const float*)(A->ws + WS_HALO), *hg = tail + 32 * 2 * DFF, *hv = hg + 32 * 2 * DFF;
    const float* cw = A->in[I_CONVW] + (size_t)l * 3 * DFF, *cb = A->in[I_CONVB] + (size_t)l * DFF; bf16* ACT = (bf16*)(A->ws + WS_ACT);
    const int gt = F.bid * (NWAVES * 64) + F.tid, ngt = F.G * NWAVES * 64;
    for (int idx = gt; idx < 31 * DFF; idx += ngt) { const int pm = 1 + idx / DFF, j = idx % DFF;
        const float um2 = tail[((size_t)(pm - 1) * 2 + 0) * DFF + j], um1 = tail[((size_t)(pm - 1) * 2 + 1) * DFF + j], u0 = hg[((size_t)pm * 2 + 0) * DFF + j], u1 = hg[((size_t)pm * 2 + 1) * DFF + j];
        const float v0 = hv[((size_t)pm * 2 + 0) * DFF + j], v1 = hv[((size_t)pm * 2 + 1) * DFF + j];
        const float w0 = cw[j], w1 = cw[DFF + j], w2 = cw[2 * DFF + j], b = cb[j];
        const pg8::f32x2 g = pg8::gelu_pk((pg8::f32x2){b + w0 * um2 + w1 * um1 + w2 * u0, b + w0 * um1 + w1 * u0 + w2 * u1});
        ACT[(size_t)(256 * pm) * DFF + j] = (bf16)f2bf(g.x * v0); ACT[(size_t)(256 * pm + 1) * DFF + j] = (bf16)f2bf(g.y * v1); }
}
#ifdef PROBE_SEQ
__device__ __forceinline__ void probe_seq_scan(Frame& F, int l) {
    PHASE_ENTRY();
    const int gw = F.bid * NWAVES + F.wave, lane = F.lane;
    if (gw >= 16) return;
    const int h = gw, hj = h * 64 + lane;
    const float* PR = (const float*)(A->ws + WS_PR); const float* mu = A->in[I_MU] + (size_t)l * NRC;
    LAS float* sc = (LAS float*)(F.lds + F.wave * 4096);
    const float* w2 = A->in[I_W2] + (size_t)l * 96 * 1024; const float* a2 = A->in[I_A2] + (size_t)l * 96 * 1024;
    const float w0 = A->in[I_W0][l * 1024 + hj], a0 = A->in[I_A0][l * 1024 + hj], kkw = A->in[I_KK][l * 1024 + hj], kaw = A->in[I_KA][l * 1024 + hj];
    float S[64];
#pragma unroll
    for (int k = 0; k < 64; ++k) S[k] = 0.f;
    for (int t = 0; t < MP; ++t) {
        const float* pc = PR + (size_t)t * NRC_PAD; const float* pp = pc - NRC_PAD;
        auto lerp = [&](int col) { const float cur = pc[col]; const float prv = t > 0 ? pp[col] : 0.f; return cur + (prv - cur) * mu[col]; };
        sc[lane] = tanhf(lerp(3072 + lane)); if (lane < 32) sc[64 + lane] = tanhf(lerp(3072 + 64 + lane));
        sc[96 + lane] = lerp(3168 + lane); if (lane < 32) sc[96 + 64 + lane] = lerp(3168 + 64 + lane);
        LDS_WAIT(); asm volatile("" ::: "memory");
        float wl = 0.f, al = 0.f;
        for (int k = 0; k < 96; ++k) { wl += sc[k] * w2[(size_t)k * 1024 + hj]; al += sc[96 + k] * a2[(size_t)k * 1024 + hj]; }
        const float xk = lerp(1024 + hj), xv = lerp(2048 + hj);
        const float z = w0 + wl; const float wlog = -log1pf(expf(-z)) - 0.5f; const float w = expf(-expf(wlog));
        const float a = 1.f / (1.f + expf(-(a0 + al)));
        const float kkr = xk * kkw; const float nrm = wave_sum(kkr * kkr); const float kk = kkr / sqrtf(fmaxf(nrm, 1e-24f));
        const float km = xk * (1.f + (a - 1.f) * kaw);
        LDS_WAIT(); asm volatile("" ::: "memory");
        sc[192 + lane] = w; sc[256 + lane] = kk; sc[320 + lane] = kk * a; sc[384 + lane] = km;
        LDS_WAIT(); asm volatile("" ::: "memory");
        float sa = 0.f;
#pragma unroll
        for (int k = 0; k < 64; ++k) sa -= S[k] * sc[256 + k];
#pragma unroll
        for (int k = 0; k < 64; ++k) S[k] = S[k] * sc[192 + k] + sa * sc[320 + k] + xv * sc[384 + k];
        LDS_WAIT(); asm volatile("" ::: "memory");
    }
    float* wo = A->out + O_WP + (size_t)(l * 16 + h) * 4096 + lane * 64;
#pragma unroll
    for (int k = 0; k < 64; ++k) wo[k] = S[k];
}
#endif
#ifdef PROBE_GEMM
__device__ __forceinline__ void probe_gemm_check(Frame& F) {
    PHASE_ENTRY();
    if (F.bid != 0) return;
    float* scr = (float*)(A->ws + WS_OATT);
    const int tid = F.tid, lane = F.lane, wave = F.wave;
    for (int j = tid; j < 2 * DMOD; j += NWAVES * 64) { float s = A->in[I_BADA][j];
        for (int k = 0; k < DMOD; ++k) { const float c = A->in[I_CP][k]; s += (c / (1.f + expf(-c))) * A->in[I_WADA][(size_t)k * MODW + j]; }
        scr[j] = s; }
    __threadfence(); __syncthreads();
    float num = 0.f, den = 0.f;
#if PROBE_GEMM == 3
    for (int j = tid; j < 2 * DMOD; j += NWAVES * 64) { const float mine = ((const float*)(A->ws + WS_MOD))[j], ref = scr[j]; num += (mine - ref) * (mine - ref); den += ref * ref; }
    num = wave_sum(num); den = wave_sum(den);
#elif PROBE_GEMM == 5
    { const float sgot = wave_sum((float)(lane + 1)); num = (sgot - 2080.f) * (sgot - 2080.f); den = 2080.f * 2080.f; }
#elif PROBE_GEMM == 6
    { float v = (float)(lane + 1); for (int o = 1; o < 64; o <<= 1) v += __shfl_xor(v, o); num = (v - 2080.f) * (v - 2080.f); den = 2080.f * 2080.f; }
#elif PROBE_GEMM == 4
    for (int smp = wave; smp < 64; smp += NWAVES) { const int m = (smp * 2654435761u >> 7) % MP; const float* xr = A->in[I_XP] + (size_t)m * DMOD; float ss = 0.f;
        for (int k = lane; k < DMOD; k += 64) ss += xr[k] * xr[k];
        const float rstd = 1.f / sqrtf(wave_sum(ss) / DMOD + 1e-6f);
        for (int k = lane; k < DMOD; k += 64) { const float hh = xr[k] * rstd * A->in[I_GMIX][k] * (1.f + scr[DMOD + k]) + scr[k]; const float mine = bf2f(((const bf16*)(A->ws + WS_H))[(size_t)m * DMOD + k]); num += (mine - hh) * (mine - hh); den += hh * hh; } }
    num = wave_sum(num); den = wave_sum(den);
#else
    for (int smp = wave; smp < 256; smp += NWAVES) {
        const int m = (smp * 2654435761u >> 7) % MP; const int cc = (smp * 40503u + 17u) % (PROBE_GEMM == 1 ? 3072 : 1024);
        const int col = PROBE_GEMM == 1 ? cc : NRC + 1024 + cc;
        const float* xr = A->in[I_XP] + (size_t)m * DMOD; float ss = 0.f;
        for (int k = lane; k < DMOD; k += 64) ss += xr[k] * xr[k];
        const float rstd = 1.f / sqrtf(wave_sum(ss) / DMOD + 1e-6f); float acc = 0.f;
        for (int k = lane; k < DMOD; k += 64) { const float hh = xr[k] * rstd * A->in[I_GMIX][k] * (1.f + scr[DMOD + k]) + scr[k]; acc += hh * A->in[I_WIN][(size_t)k * NIN + col]; }
        acc = wave_sum(acc);
        const float mine = PROBE_GEMM == 1 ? ((const float*)(A->ws + WS_PR))[(size_t)m * NRC_PAD + cc] : A->out[O_KP + (size_t)m * 1024 + cc];
        num += (mine - acc) * (mine - acc); den += acc * acc; }
#endif
    LAS float* red = (LAS float*)F.lds;
    if (lane == 0) { red[wave] = num; red[8 + wave] = den; }
    __syncthreads();
    if (tid == 0) { float n = 0.f, d = 0.f; for (int w = 0; w < 8; ++w) { n += red[w]; d += red[8 + w]; } ((float*)(A->ws + WS_CTL))[16384] = sqrtf(n / d); }
}
#endif
#ifndef MK_SPLIT
#define MK_SPLIT 0
#endif
constexpr int N_PHASES = 22;
__global__ void __launch_bounds__(NWAVES * 64, 2) hybrid_fwd(Args args) {
    extern __shared__ __attribute__((aligned(16))) unsigned char lds[];
    Frame F;
    F.lds = (LAS unsigned char*)lds; F.MISC = (volatile LAS unsigned*)(F.lds + MISC_OFF);
    F.tid = threadIdx.x; F.lane = F.tid & 63; F.wave = __builtin_amdgcn_readfirstlane(F.tid >> 6); F.G = gridDim.x; F.bid = blockIdx.x;
    F.ctl = (gu32*)(args.ws + WS_CTL);
    if (F.tid < 64) F.MISC[F.tid] = 0u;
    __syncthreads();
    XcdBarrier bar; bar.bar = (unsigned*)(F.ctl + CW_BAR); bar.x = 0; bar.st = nullptr;
    if (!MK_SPLIT) bar = xcd_barrier_post((unsigned*)(F.ctl + CW_BAR), F.MISC + 8);
    const int lo = args.ph_lo, hi = args.ph_hi;
#ifndef ONLY_PT
#define ONLY_PT -1
#endif
#define PT_ON(t) (ONLY_PT < 0 || ONLY_PT == (t))
#define IN(k) (lo <= (k) && (k) < hi)
#define SEAM(k) do { if (IN(k) && IN((k) + 1)) xcd_barrier(bar); } while (0)
    if (PT_ON(0) && IN(0)) { ph_prologue(F); }
    SEAM(0);
    for (int l = 0; l < NLAYER; ++l) {
        const int pb = 1 + 10 * l;
        if (PT_ON(1) && IN(pb + 0)) ph_norm(F, l, 0, l == 0 ? 0 : 11);
        SEAM(pb + 0);
        if (PT_ON(2) && IN(pb + 1)) { PHASE_ENTRY(); unsigned char* ws = A->ws;
            pg8::Gemm g{(const pg8::bf16_t*)(ws + WS_H), (const pg8::bf16_t*)(ws + WS_WIN) + (size_t)l * NIN_PAD * DMOD, MT, NIN_PAD, DMOD, DMOD}; pg8::TwoPartOrder S; S.init(MT, NRC_PAD / 256, (NIN_PAD - NRC_PAD) / 256, F.G, F.bid, F.G == 256 ? (unsigned*)(F.ctl + CW_QUEUE + 1024 + 64 * l) : nullptr, 1 + (F.bid + 256 < (MT / 256) * (NRC_PAD / 256) ? 1 : 0));
            pg8::EpiIn E{ws, A->out, l, 0.125f * 1.4426950408889634f};
            pg8::gemm_phase<pg8::EpiIn, pg8::TwoPartOrder, true, true>(F.lds, g, S, E);
        }
        if (F.G != 256) SEAM(pb + 1);
#ifdef PROBE_GEMM
        if (l == 0 && IN(pb + 2)) { probe_gemm_check(F); __syncthreads(); }
#endif
        if (PT_ON(3) && IN(pb + 2)) ph_rwkv_passA(F, l);
        SEAM(pb + 2);
#ifdef PROBE_SEQ
        if (IN(pb + 3)) { probe_seq_scan(F, l); __syncthreads(); }
#endif
        if (PT_ON(4) && IN(pb + 3)) { ph_rwkv_chain(F, l); ph_attn_sample(F, l); ph_attn_prompt(F, l); }
        SEAM(pb + 3);
#ifdef PROBE_SEQ
        if (IN(pb + 4) && F.bid == 0) { PHASE_ENTRY();
            for (int h = F.wave; h < 16; h += NWAVES) { const float* a = (const float*)(A->ws + WS_HALO) + (size_t)h * 4096; const float* b = A->out + O_WP + (size_t)(l * 16 + h) * 4096; float n = 0.f, d = 0.f;
                for (int i = F.lane; i < 4096; i += 64) { n += (a[i] - b[i]) * (a[i] - b[i]); d += b[i] * b[i]; }
                n = wave_sum(n); d = wave_sum(d); if (F.lane == 0) { ((float*)(A->ws + WS_CTL))[16400 + 16 * l + h] = sqrtf(n / d); ((float*)(A->ws + WS_CTL))[16440 + 16 * l + h] = d; } } }
#endif
        if (PT_ON(5) && IN(pb + 4)) { ph_rwkv_passC(F, l); ph_attn_final(F, l); }
        SEAM(pb + 4);
        if (PT_ON(6) && IN(pb + 5)) { PHASE_ENTRY(); unsigned char* ws = A->ws;
            const float* X = (const float*)(ws + WS_X); const float* MODl = (const float*)(ws + WS_MOD) + (size_t)l * NMODB * MODW;
            { pg8::Gemm g{(const pg8::bf16_t*)(ws + WS_YCAT), (const pg8::bf16_t*)(ws + WS_WOUT) + (size_t)l * DMOD * DMOD, MP, DMOD, DMOD, DMOD}; pg8::StaticOrder S; S.init(MP, DMOD, F.G, F.bid);
              pg8::EpiRes E{l == 0 ? A->in[I_XP] : X, X + (size_t)MP * DMOD, (float*)(ws + WS_X), MODl + 2 * DMOD};
              pg8::gemm_phase<pg8::EpiRes, pg8::StaticOrder, true, true>(F.lds, g, S, E); }
            { pg8::Gemm g{(const pg8::bf16_t*)(ws + WS_YCAT) + (size_t)MP * DMOD, (const pg8::bf16_t*)(ws + WS_WOUT) + (size_t)l * DMOD * DMOD, 256, DMOD, DMOD / 8, DMOD}; pg8::SplitOrder S; S.init(DMOD, 8, F.bid);
              pg8::EpiResSlab E{(float*)(ws + WS_SLAB), MODl + 2 * DMOD};
              pg8::gemm_phase<pg8::EpiResSlab, pg8::SplitOrder, true, true>(F.lds, g, S, E); }
        }
        SEAM(pb + 5);
        if (PT_ON(7) && IN(pb + 6)) ph_norm(F, l, 1, 8);
        SEAM(pb + 6);
        if (PT_ON(8) && IN(pb + 7)) { PHASE_ENTRY(); unsigned char* ws = A->ws;
            pg8::Gemm g{(const pg8::bf16_t*)(ws + WS_H), (const pg8::bf16_t*)(ws + WS_WUP) + (size_t)l * NUP * DMOD, MT, NUP, DMOD, DMOD}; pg8::PmFirstOrder S; S.init(MT, NUP, F.G, F.bid, F.G == 256 ? (unsigned*)(F.ctl + CW_QUEUE + 1536 + 64 * l) : nullptr);
            pg8::EpiUp E{(pg8::bf16_t*)(ws + WS_ACT), A->in[I_CONVW] + (size_t)l * 3 * DFF, A->in[I_CONVB] + (size_t)l * DFF, A->in[I_SCONV] + (size_t)l * NSB * 2 * DFF,
                         (float*)(ws + WS_HALO), A->out + O_CP + (size_t)l * 2 * DFF, A->out + O_CS + (size_t)l * NSB * 2 * DFF, (PG8_LAS float*)(F.lds + HALO_OFF)};
            pg8::gemm_phase<pg8::EpiUp, pg8::PmFirstOrder, true, true>(F.lds, g, S, E);
            { int first = 0, nw = F.G;
              if (F.G == 256) { first = 256 - ((256 * 6) - (MT / 256) * (NUP / 256)); nw = 256 - first; if (F.bid >= first) wait_count(F, (unsigned*)(F.ctl + CW_QUEUE + 1536 + 64 * l), (unsigned)(NUP / 256)); }
              else if (!MK_SPLIT) xcd_barrier(bar);
              const float* MODl = (const float*)(ws + WS_MOD) + (size_t)l * NMODB * MODW;
              pg8::Gemm g2{(const pg8::bf16_t*)(ws + WS_ACT) + (size_t)MP * DFF, (const pg8::bf16_t*)(ws + WS_WDN) + (size_t)l * DMOD * DFF, 256, DMOD, DFF / 11, DFF}; pg8::TailSplitOrder S2; S2.init(DMOD, 11, F.bid, first, nw);
              pg8::EpiResSlab E2{(float*)(ws + WS_SLAB), MODl + 5 * DMOD};
              pg8::gemm_phase<pg8::EpiResSlab, pg8::TailSplitOrder, true, true>(F.lds, g2, S2, E2); }
        }
        SEAM(pb + 7);
        if (PT_ON(9) && IN(pb + 8)) ph_fixup(F, l);
        SEAM(pb + 8);
        if (PT_ON(10) && IN(pb + 9)) { PHASE_ENTRY(); unsigned char* ws = A->ws;
            const float* X = (const float*)(ws + WS_X); const float* MODl = (const float*)(ws + WS_MOD) + (size_t)l * NMODB * MODW;
            { pg8::Gemm g{(const pg8::bf16_t*)(ws + WS_ACT), (const pg8::bf16_t*)(ws + WS_WDN) + (size_t)l * DMOD * DFF, MP, DMOD, DFF, DFF}; pg8::StaticOrder S; S.init(MP, DMOD, F.G, F.bid);
              pg8::EpiRes E{X, X + (size_t)MP * DMOD, (float*)(ws + WS_X), MODl + 5 * DMOD};
              pg8::gemm_phase<pg8::EpiRes, pg8::StaticOrder, true, true>(F.lds, g, S, E); }
        }
        SEAM(pb + 9);
    }
    if (PT_ON(11) && IN(21)) ph_norm(F, 0, 2, 11);
#ifdef PROBE_MASK
    if (IN(22)) { PHASE_ENTRY();
        const size_t offs[13] = {O_YP, O_YS, O_KP, O_VP, O_WP, O_SP, O_CP, O_KS, O_VS, O_WS, O_SS, O_CS, O_END};
        const size_t gt = (size_t)F.bid * (NWAVES * 64) + F.tid, ngt = (size_t)F.G * NWAVES * 64;
#ifndef PROBE_SCALE
#define PROBE_SCALE 1.2f
#endif
#ifndef PROBE_HALF
#define PROBE_HALF 2
#endif
#ifdef PROBE_HEADS
        { const float* dh = (const float*)(A->ws + WS_CTL) + 16400; float best = -1.f; int bi = 0;
#if PROBE_HEADS == 3
          bi = 0; best = dh[PROBE_IDX] * 20.f;
#elif PROBE_HEADS == 1
          for (int i = 0; i < 32; ++i) if (dh[i] > best) { best = dh[i]; bi = i; }
#else
          for (int i = 0; i < 32; ++i) if (dh[i] * dh[i] * dh[40 + i] > best) { best = dh[i] * dh[i] * dh[40 + i]; bi = i; } best = dh[bi];
#endif
          const float val = (PROBE_HEADS == 3) ? best : 0.05f * bi + fminf(best, 0.049f); const float fsc = 1.f + val; for (size_t i = O_YP + gt; i < O_YS; i += ngt) A->out[i] *= fsc; }
#endif
#ifdef PROBE_GEMM
        { const float dd = ((const float*)(A->ws + WS_CTL))[16384]; const float fsc = 1.f + PROBE_AMP * dd; for (size_t i = O_YP + gt; i < O_YS; i += ngt) A->out[i] *= fsc; }
#endif
        for (int o = 0; o < 12; ++o) if ((PROBE_MASK >> o) & 1) { size_t b = offs[o], e = offs[o + 1]; const size_t mid = b + (e - b) / 2;
            if (PROBE_HALF == 0) e = mid; if (PROBE_HALF == 1) b = mid;
            for (size_t i = b + gt; i < e; i += ngt) A->out[i] *= PROBE_SCALE; } }
#endif
#undef IN
#undef SEAM
}

extern "C" void kernel_launch(void* const* d_in, const int* in_sizes, int n_in, void* d_out, int out_size, void* d_ws, size_t ws_size, hipStream_t stream) {
    static int grid = 0;
    if (grid == 0) {
        if (n_in != 37 || (size_t)out_size != O_END || ws_size < WS_END) { fprintf(stderr, "kernel_launch: built for 37 inputs, %zu outputs, >= %zu bytes of workspace; got n_in %d, out %d, ws %zu; nothing launched\n", (size_t)O_END, (size_t)WS_END, n_in, out_size, ws_size); grid = -1; return; }
        int dev = 0, cus = 0, per_cu = 0;
        if (hipGetDevice(&dev) != hipSuccess || hipDeviceGetAttribute(&cus, hipDeviceAttributeMultiprocessorCount, dev) != hipSuccess) { fprintf(stderr, "kernel_launch: device query failed\n"); grid = -1; return; }
        if (hipFuncSetAttribute((const void*)hybrid_fwd, hipFuncAttributeMaxDynamicSharedMemorySize, LDS_BYTES) != hipSuccess) { fprintf(stderr, "kernel_launch: hipFuncSetAttribute failed\n"); grid = -1; return; }
        if (hipOccupancyMaxActiveBlocksPerMultiprocessor(&per_cu, (const void*)hybrid_fwd, NWAVES * 64, LDS_BYTES) != hipSuccess || per_cu < 1) fprintf(stderr, "kernel_launch: note: occupancy query reports %d workgroups per CU\n", per_cu);
        (void)hipGetLastError();
        grid = cus;
    }
    if (grid < 0) return;
    if (hipMemsetAsync((char*)d_ws + WS_CTL, 0, CTL_ZERO_BYTES, stream) != hipSuccess) { fprintf(stderr, "kernel_launch: memset failed\n"); return; }
    Args a{};
    for (int i = 0; i < 37; ++i) a.in[i] = (const float*)d_in[i];
    a.out = (float*)d_out; a.ws = (unsigned char*)d_ws;
#if MK_SPLIT
#ifdef PROBE_MASK
    const int n_launch = N_PHASES + 1;
#else
    const int n_launch = N_PHASES;
#endif
    for (int p = 0; p < n_launch; ++p) { a.ph_lo = p; a.ph_hi = p + 1; hipLaunchKernelGGL(hybrid_fwd, dim3(grid), dim3(NWAVES * 64), LDS_BYTES, stream, a); }
#else
    a.ph_lo = 0; a.ph_hi = N_PHASES; hipLaunchKernelGGL(hybrid_fwd, dim3(grid), dim3(NWAVES * 64), LDS_BYTES, stream, a);
#endif
    const hipError_t le = hipPeekAtLastError();
    if (le != hipSuccess) fprintf(stderr, "kernel_launch: launch failed: %s\n", hipGetErrorName(le));
}
```

```cpp
#include <hip/hip_runtime.h>
#include <hip/hip_bf16.h>
#include <cstdio>
#include <cstdint>
#include <cmath>
constexpr int NWAVES = 8;
constexpr int DMOD = 2048, MP = 8192, NSB = 16, TS = 16, MT = MP + NSB * TS  , PAST = 2048;
constexpr int NRC = 3520, NRC_PAD = 3584, NIN = 6592, NIN_PAD = 6656, DFF = 5632, NUP = 2 * DFF;
constexpr int NLAYER = 2, NMODB = 17, MODW = 6 * DMOD;
constexpr int RW_UNITS = 128 * 16 + NSB * 16;
constexpr size_t O_YP = 0, O_YS = O_YP + (size_t)MP * DMOD, O_KP = O_YS + (size_t)NSB * TS * DMOD, O_VP = O_KP + (size_t)NLAYER * MP * 1024, O_WP = O_VP + (size_t)NLAYER * MP * 1024,
                 O_SP = O_WP + (size_t)NLAYER * 16 * 4096, O_CP = O_SP + (size_t)NLAYER * NRC, O_KS = O_CP + (size_t)NLAYER * 2 * DFF, O_VS = O_KS + (size_t)NLAYER * 256 * 1024,
                 O_WS = O_VS + (size_t)NLAYER * 256 * 1024, O_SS = O_WS + (size_t)NLAYER * NSB * 16 * 4096, O_CS = O_SS + (size_t)NLAYER * NSB * NRC, O_END = O_CS + (size_t)NLAYER * NSB * 2 * DFF;
constexpr size_t MiB = 1u << 20;
constexpr size_t WS_CTL = 0, CTL_ZERO_BYTES = 1 * MiB;
constexpr size_t WS_MOD = 1 * MiB;
constexpr size_t WS_LORA = 3 * MiB, LORA_LAYER = (size_t)1024 * 448 * 2;
constexpr size_t WS_WIN = 5 * MiB, WS_WOUT = 57 * MiB, WS_WUP = 73 * MiB, WS_WDN = 161 * MiB;
constexpr size_t WS_H = 205 * MiB, WS_PR = 238 * MiB, WS_QB = 354 * MiB, WS_KB = 371 * MiB, WS_VB = 388 * MiB, WS_OATT = 405 * MiB, WS_YCAT = 471 * MiB, WS_X = 504 * MiB, WS_ACT = 570 * MiB;
constexpr size_t WS_PT = 661 * MiB, WS_QQ = 679 * MiB, WS_RP = 715 * MiB, WS_YV = 733 * MiB, WS_SC = 769 * MiB, WS_G1 = 787 * MiB, WS_G2 = 820 * MiB, WS_HALO = 853 * MiB, WS_WL = 858 * MiB, WS_PT32 = 859 * MiB, WS_LSCR = 895 * MiB, WS_SLAB = 911 * MiB, WS_END = 935 * MiB;
static_assert(WS_WIN + (size_t)2 * NIN_PAD * DMOD * 2 <= WS_WOUT && WS_WOUT + (size_t)2 * DMOD * DMOD * 2 <= WS_WUP && WS_WUP + (size_t)2 * NUP * DMOD * 2 <= WS_WDN && WS_WDN + (size_t)2 * DMOD * DFF * 2 <= WS_H, "weights map");
static_assert(WS_H + (size_t)MT * DMOD * 2 <= WS_PR && WS_PR + (size_t)MT * NRC_PAD * 4 <= WS_QB && WS_QB + (size_t)MT * 1024 * 2 <= WS_KB && WS_VB + (size_t)MT * 1024 * 2 <= WS_OATT && WS_OATT + (size_t)MT * DMOD * 4 <= WS_YCAT, "act map 1");
static_assert(WS_YCAT + (size_t)MT * DMOD * 2 <= WS_X && WS_X + (size_t)MT * DMOD * 4 <= WS_ACT && WS_ACT + (size_t)MT * DFF * 2 <= WS_PT, "act map 2");
static_assert(WS_PT + (size_t)RW_UNITS * 8192 <= WS_QQ && WS_QQ + (size_t)RW_UNITS * 16384 <= WS_RP && WS_RP + (size_t)RW_UNITS * 8192 <= WS_YV && WS_YV + (size_t)RW_UNITS * 16384 <= WS_SC && WS_SC + (size_t)RW_UNITS * 8192 <= WS_G1, "rwkv map");
static_assert(WS_G1 + (size_t)MT * 1024 * 4 <= WS_G2 && WS_G2 + (size_t)MT * 1024 * 4 <= WS_HALO && WS_HALO + (size_t)3 * 32 * 2 * DFF * 4 <= WS_WL && WS_WL + (size_t)RW_UNITS * 256 <= WS_PT32 && WS_PT32 + (size_t)RW_UNITS * 16384 <= WS_LSCR && WS_LSCR + (size_t)256 * 61440 <= WS_SLAB && WS_SLAB + (size_t)11 * 256 * 2048 * 4 <= WS_END && WS_LORA + 2 * LORA_LAYER <= WS_WIN && WS_MOD + (size_t)NLAYER * NMODB * MODW * 4 <= WS_LORA, "map 3");
constexpr int CW_BAR = 4096, CW_QUEUE = 8192;
constexpr int LDS_BYTES = 163840;
constexpr int MISC_OFF = LDS_BYTES - 256;
constexpr int LUT_OFF = 131072;
constexpr int HALO_OFF = 131072;
constexpr int RW_SLOT = 9216, RW_STRIDE = 72;
constexpr int RW_SCR = 154624;
static_assert(RW_SCR + 4096 <= MISC_OFF && HALO_OFF + 4096 <= MISC_OFF, "LDS map");

#define GAS __attribute__((address_space(1)))
#define LAS __attribute__((address_space(3)))
typedef unsigned short bf16;
typedef unsigned v4u __attribute__((ext_vector_type(4)));
typedef unsigned v2u __attribute__((ext_vector_type(2)));
typedef float f32x4 __attribute__((ext_vector_type(4)));
typedef float f32x2 __attribute__((ext_vector_type(2)));
typedef short bf16x8 __attribute__((ext_vector_type(8)));
typedef GAS unsigned gu32;
#define RLX_AGENT __ATOMIC_RELAXED, __HIP_MEMORY_SCOPE_AGENT
#define LDS_WAIT() asm volatile("s_waitcnt lgkmcnt(0)" ::: "memory")
#define VM_WAIT() asm volatile("s_waitcnt vmcnt(0)" ::: "memory")
typedef float cvt_f32x2 __attribute__((ext_vector_type(2))); typedef __bf16 cvt_bf16x2 __attribute__((ext_vector_type(2)));
__device__ __forceinline__ unsigned pk2(float lo, float hi) { const cvt_f32x2 v = {lo, hi}; return __builtin_bit_cast(unsigned, __builtin_convertvector(v, cvt_bf16x2)); }
__device__ __forceinline__ unsigned f2bf(float f) { return pk2(f, 0.f) & 0xffffu; }
__device__ __forceinline__ float bf2f(unsigned short b) { return __builtin_bit_cast(float, (unsigned)b << 16); }
template <int K> __device__ __forceinline__ float swz_xor(float v) { static_assert(K >= 1 && K <= 16, "");
    return __builtin_bit_cast(float, __builtin_amdgcn_ds_swizzle(__builtin_bit_cast(int, v), (K << 10) | 0x1f)); }
struct PL32 { float a, b; };
__device__ __forceinline__ PL32 pl32(float v) { const int ln = (int)(threadIdx.x & 63);
    const float p = __builtin_bit_cast(float, __builtin_amdgcn_ds_bpermute((ln ^ 32) << 2, __builtin_bit_cast(int, v))); PL32 o; o.a = v; o.b = p; return o; }
__device__ __forceinline__ float xor32(float v) { return pl32(v).b; }
template <int CTRL> __device__ __forceinline__ float dpp_f(float v) { return __builtin_bit_cast(float, __builtin_amdgcn_update_dpp(__builtin_bit_cast(int, v), __builtin_bit_cast(int, v), CTRL, 0xF, 0xF, false)); }
__device__ __forceinline__ float wave_sum(float v) {
    v += dpp_f<0xB1>(v); v += dpp_f<0x4E>(v); v += dpp_f<0x141>(v); v += dpp_f<0x128>(v); v += swz_xor<16>(v);
    const PL32 r = pl32(v); return r.a + r.b;
}
__device__ __forceinline__ float wave_max(float v) {
    v = fmaxf(v, dpp_f<0xB1>(v)); v = fmaxf(v, dpp_f<0x4E>(v)); v = fmaxf(v, dpp_f<0x141>(v)); v = fmaxf(v, dpp_f<0x128>(v)); v = fmaxf(v, swz_xor<16>(v));
    const PL32 r = pl32(v); return fmaxf(r.a, r.b);
}
__device__ __forceinline__ float sigmoidf_(float x) { return __builtin_amdgcn_rcpf(1.f + __expf(-x)); }
namespace pg8 {
#define PG8_LAS __attribute__((address_space(3)))
typedef unsigned short bf16_t;
typedef short bf16x8 __attribute__((ext_vector_type(8)));
typedef float f32x4 __attribute__((ext_vector_type(4)));
typedef unsigned u32x4 __attribute__((ext_vector_type(4)));
constexpr int BM = 256, BK = 64, HALF = 128, HTB = HALF * BK * 2  , STAGE_BYTES = 8 * HTB, NXCD = 8, WGM = 8;

__host__ __device__ __forceinline__ int lds_byte(int r, int c) { const int st = (r >> 4) * 2 + (c >> 5), rr = r & 15, cc = c & 31, ob = rr * 64 + cc * 2; return st * 1024 + (ob ^ (((ob >> 9) & 1) << 5)); }
__host__ __device__ __forceinline__ void stage_rc(int b, int& R, int& C) { const int st = b / 1024, sb = b % 1024, swz = sb ^ (((sb >> 9) & 1) << 5); R = (st >> 1) * 16 + swz / 64; C = (st & 1) * 32 + (swz % 64) / 2; }
__host__ __device__ __forceinline__ int perm32(int rho) { const int n = rho >> 4, i = rho & 15; return 8 * (i >> 2) + 4 * n + (i & 3); }

struct Unit { int pm, pn, ks, tag; };
struct Gemm { const bf16_t* A; const bf16_t* Bt; int M, N, K, ld; };

struct StaticOrder {
    static constexpr bool HANDOFF = false;
    int nM, nN, nwg, G, c;
    __host__ __device__ void init(int M, int N, int G_, int c_) { nM = M / BM; nN = N / BM; nwg = nM * nN; G = G_; c = c_; }
    __host__ __device__ bool next(int i, Unit& u) const {
        const long L = (long)i * G + c; if (L >= nwg) return false;
        int wgid = (int)L; { const int q = nwg / NXCD, r = nwg % NXCD, xcd = wgid % NXCD, off = wgid / NXCD; wgid = (xcd < r ? xcd * (q + 1) : r * (q + 1) + (xcd - r) * q) + off; }
        const int nig = WGM * nN, gid = wgid / nig, fm = gid * WGM, gsz = (nM - fm) < WGM ? (nM - fm) : WGM;
        u.pm = fm + ((wgid % nig) % gsz); u.pn = (wgid % nig) / gsz; u.ks = 0; u.tag = 0; return true;
    }
    __device__ __forceinline__ void a_ready(const Unit&) const {}
    __device__ __forceinline__ void done(const Unit&) const {}
};

struct TwoPartOrder {
    static constexpr bool HANDOFF = true;
    int nM, nA, nB, G, c; unsigned* cnt; int nsig;
    __device__ __forceinline__ void mid(const Unit& u, int t, int nt, int wid, int lane) const {
        if (cnt == nullptr || u.tag != 2) return;
        if (t == nt / 2) asm volatile("s_waitcnt vmcnt(0)" ::: "memory");
        if (t == nt / 2 + 2 && wid == 0) { __builtin_amdgcn_fence(__ATOMIC_RELEASE, "agent"); asm volatile("s_waitcnt vmcnt(0)" ::: "memory");
            if (lane == 0) (void)__hip_atomic_fetch_add(cnt, (unsigned)nsig, __ATOMIC_RELAXED, __HIP_MEMORY_SCOPE_AGENT); }
    }
    __host__ __device__ void init(int M, int NA, int NB, int G_, int c_, unsigned* cnt_, int nsig_) { nM = M / BM; nA = NA; nB = NB; G = G_; c = c_; cnt = cnt_; nsig = nsig_; }
    __host__ __device__ static void map(int wgid, int nM, int nN, Unit& u) {
        const int nwg = nM * nN; { const int q = nwg / NXCD, r = nwg % NXCD, xcd = wgid % NXCD, off = wgid / NXCD; wgid = (xcd < r ? xcd * (q + 1) : r * (q + 1) + (xcd - r) * q) + off; }
        const int nig = WGM * nN, gid = wgid / nig, fm = gid * WGM, gsz = (nM - fm) < WGM ? (nM - fm) : WGM;
        u.pm = fm + ((wgid % nig) % gsz); u.pn = (wgid % nig) / gsz; u.ks = 0;
    }
    __host__ __device__ bool next(int i, Unit& u) const {
        const long L = (long)i * G + c; const int na = nM * nA, nb = nM * nB; if (L >= na + nb) return false;
        if (L < na) map((int)L, nM, nA, u); else { map((int)L - na, nM, nB, u); u.pn += nA; }
        u.tag = i; return true;
    }
    __device__ __forceinline__ void a_ready(const Unit&) const {}
    __device__ __forceinline__ void done(const Unit&) const {}
};

struct PmFirstOrder {
    static constexpr bool HANDOFF = true;
    int nM, nN, G, c; unsigned* cnt;
    __host__ __device__ void init(int M, int N, int G_, int c_, unsigned* cnt_) { nM = M / BM; nN = N / BM; G = G_; c = c_; cnt = cnt_; }
    __host__ __device__ __forceinline__ bool next(int i, Unit& u) const {
        const long L = (long)i * G + c; if (L >= (long)nM * nN) return false;
        if (L < nN) { u.pm = nM - 1; u.pn = (int)L; u.ks = 0; } else TwoPartOrder::map((int)L - nN, nM - 1, nN, u);
        u.tag = i; return true;
    }
    __device__ __forceinline__ void a_ready(const Unit&) const {}
    __device__ __forceinline__ void done(const Unit&) const {}
    __device__ __forceinline__ void mid(const Unit& u, int t, int nt, int wid, int lane) const {
        if (cnt == nullptr || u.tag != 1 || c >= nN) return;
        if (t == nt / 2) asm volatile("s_waitcnt vmcnt(0)" ::: "memory");
        if (t == nt / 2 + 2 && wid == 0) { __builtin_amdgcn_fence(__ATOMIC_RELEASE, "agent"); asm volatile("s_waitcnt vmcnt(0)" ::: "memory");
            if (lane == 0) (void)__hip_atomic_fetch_add(cnt, 1u, __ATOMIC_RELAXED, __HIP_MEMORY_SCOPE_AGENT); }
    }
};
struct TailSplitOrder {
    static constexpr bool HANDOFF = false;
    int n, KS, k, nw;
    __host__ __device__ void init(int N, int KS_, int c_, int first, int nw_) { n = (N / BM) * KS_; KS = KS_; k = c_ - first; nw = nw_; }
    __host__ __device__ __forceinline__ bool next(int i, Unit& u) const { const int L = k + i * nw; if (k < 0 || L >= n) return false; u.pm = 0; u.pn = L / KS; u.ks = L % KS; u.tag = 0; return true; }
    __device__ __forceinline__ void a_ready(const Unit&) const {}
    __device__ __forceinline__ void done(const Unit&) const {}
};

struct SplitOrder {
    static constexpr bool HANDOFF = false;
    int n, KS, c;
    __host__ __device__ void init(int N, int KS_, int c_) { n = (N / BM) * KS_; KS = KS_; c = c_; }
    __host__ __device__ bool next(int i, Unit& u) const { if (i > 0 || c >= n) return false; u.pm = 0; u.pn = c / KS; u.ks = c % KS; u.tag = 0; return true; }
    __device__ __forceinline__ void a_ready(const Unit&) const {}
    __device__ __forceinline__ void done(const Unit&) const {}
};
__device__ __forceinline__ unsigned cvt_pk_bf16(float lo, float hi) { unsigned r; asm volatile("v_cvt_pk_bf16_f32 %0, %1, %2" : "=v"(r) : "v"(lo), "v"(hi)); return r; }
typedef float f32x2 __attribute__((ext_vector_type(2)));
__device__ __forceinline__ f32x2 gelu_pk(f32x2 v) {
    const f32x2 av = __builtin_elementwise_abs(v), d = av * 0.2316418882f + 1.0f;
    f32x2 t; t.x = __builtin_amdgcn_rcpf(d.x); t.y = __builtin_amdgcn_rcpf(d.y);
    f32x2 q = t * 0.5307027145f + (-0.7265760135f); q = q * t + 0.7107068705f; q = q * t + (-0.142248368f); q = q * t + 0.127414796f; q = q * t;
    const f32x2 s = (v * v) * (-0.72134752044f);
    f32x2 e; e.x = __builtin_amdgcn_exp2f(s.x); e.y = __builtin_amdgcn_exp2f(s.y);
    const f32x2 m = v * (q * e), r = v - m;
    f32x2 o; o.x = v.x < 0.f ? m.x : r.x; o.y = v.y < 0.f ? m.y : r.y; return o;
}

template <class Epi, class Sched, bool ALIGN_EPI = false, bool SP2 = false>
__device__ __forceinline__ void gemm_phase(PG8_LAS unsigned char* lds, const Gemm g, const Sched& S, const Epi& E) {
    int tid_ = threadIdx.x; asm volatile("" : "+v"(tid_));
    const int tid = tid_, wid = __builtin_amdgcn_readfirstlane(tid >> 6), lane = tid & 63, wr = wid >> 2, wc = wid & 3, fr = lane & 15, fq = lane >> 4;
    const int K = g.ld, nt = g.K / BK;
    unsigned voffA[2], voffB[2];
#pragma unroll
    for (int i = 0; i < 2; ++i) { int R, C; stage_rc(tid * 16 + i * 8192, R, C); const int Rb = Epi::PERM ? ((R & ~31) + perm32(R & 31)) : R;
        voffA[i] = (unsigned)(R * K + C) * 2u; voffB[i] = (unsigned)(Rb * K + C) * 2u; }
    const size_t kstep = (size_t)(BK * 2);
    const size_t hstep = (size_t)HALF * K * 2;
    const size_t tstep = 2 * hstep;
    const unsigned ldsw = (unsigned)wid * 1024u;
    const int aoff = lds_byte(wr * 64 + fr, fq * 8), boff = lds_byte(wc * 32 + fr, fq * 8);
#define PG8_SA(b, h) (((b) * 2 + (h)) * HTB)
#define PG8_SB(b, h) ((4 + (b) * 2 + (h)) * HTB)
#define PG8_STAGE(bufoff, gbase, voff) do { _Pragma("unroll") for (int _i = 0; _i < 2; ++_i) \
        __builtin_amdgcn_global_load_lds((const unsigned*)((const char*)(gbase) + (voff)[_i]), (PG8_LAS unsigned*)(lds + (bufoff) + ldsw + _i * 8192), 16, 0, 0); } while (0)
#define PG8_LDA(dst, b, h) do { _Pragma("unroll") for (int m = 0; m < 4; ++m) _Pragma("unroll") for (int k = 0; k < 2; ++k) dst[m][k] = *(const PG8_LAS bf16x8*)(lds + PG8_SA(b, h) + aoff + m * 2048 + k * 1024); } while (0)
#define PG8_LDB(dst, b, h) do { _Pragma("unroll") for (int n = 0; n < 2; ++n) _Pragma("unroll") for (int k = 0; k < 2; ++k) dst[n][k] = *(const PG8_LAS bf16x8*)(lds + PG8_SB(b, h) + boff + n * 2048 + k * 1024); } while (0)
#define PG8_MMA(ai, bj, At, Bt) do { __builtin_amdgcn_s_setprio(1); _Pragma("unroll") for (int m = 0; m < 4; ++m) _Pragma("unroll") for (int n = 0; n < 2; ++n) _Pragma("unroll") for (int k = 0; k < 2; ++k) \
        acc[ai][bj][m][n] = __builtin_amdgcn_mfma_f32_16x16x32_bf16(Bt[n][k], At[m][k], acc[ai][bj][m][n], 0, 0, 0); __builtin_amdgcn_s_setprio(0); } while (0)
#define PG8_WAIT_V(n) asm volatile("s_waitcnt vmcnt(" #n ")" ::: "memory")
#define PG8_WAIT_L(n) asm volatile("s_waitcnt lgkmcnt(" #n ")" ::: "memory")
#define PG8_BAR __builtin_amdgcn_s_barrier()
#define PG8_SCHED __builtin_amdgcn_sched_barrier(0)
    Unit cur, nxt; int ui = 0;
    if (!S.next(0, cur)) return;
    f32x4 acc[2][2][4][2];
#pragma unroll
    for (int a = 0; a < 2; ++a)
#pragma unroll
        for (int b = 0; b < 2; ++b)
#pragma unroll
            for (int m = 0; m < 4; ++m)
#pragma unroll
                for (int n = 0; n < 2; ++n) acc[a][b][m][n] = (f32x4){0.f, 0.f, 0.f, 0.f};
    bf16x8 At[4][2], B0[2][2], B1[2][2];
    const size_t sstep = (size_t)g.K * 2;
    const char* cA = (const char*)g.A + (size_t)cur.pm * tstep + (size_t)cur.ks * sstep; const char* cB = (const char*)g.Bt + (size_t)cur.pn * tstep + (size_t)cur.ks * sstep;
    S.a_ready(cur);
    if constexpr (SP2) {
        PG8_STAGE(PG8_SB(0, 0), cB, voffB); PG8_STAGE(PG8_SB(0, 1), cB + hstep, voffB); PG8_STAGE(PG8_SA(0, 0), cA, voffA); PG8_STAGE(PG8_SA(0, 1), cA + hstep, voffA);
        if (wr == 1) PG8_BAR;
        PG8_WAIT_V(2); PG8_BAR;
        PG8_STAGE(PG8_SB(1, 0), cB + kstep, voffB); PG8_STAGE(PG8_SA(1, 0), cA + kstep, voffA); PG8_STAGE(PG8_SB(1, 1), cB + hstep + kstep, voffB);
        PG8_WAIT_V(6); PG8_BAR;
    } else {
        PG8_STAGE(PG8_SB(0, 0), cB, voffB); PG8_STAGE(PG8_SA(0, 0), cA, voffA); PG8_STAGE(PG8_SB(0, 1), cB + hstep, voffB); PG8_STAGE(PG8_SA(0, 1), cA + hstep, voffA);
        if (wr == 1) PG8_BAR;
        PG8_WAIT_V(4); PG8_BAR;
        PG8_STAGE(PG8_SB(1, 0), cB + kstep, voffB); PG8_STAGE(PG8_SA(1, 0), cA + kstep, voffA); PG8_STAGE(PG8_SB(1, 1), cB + hstep + kstep, voffB);
        PG8_WAIT_V(6); PG8_BAR;
    }
    for (;;) {
        const bool has_next = S.next(ui + 1, nxt);
        const char* nA = has_next ? (const char*)g.A + (size_t)nxt.pm * tstep + (size_t)nxt.ks * sstep : cA; const char* nB = has_next ? (const char*)g.Bt + (size_t)nxt.pn * tstep + (size_t)nxt.ks * sstep : cB;
        asm volatile(".p2align 8" ::: "memory");
        for (int t = 0; t < nt; t += 2) {
            const bool last = (t == nt - 2);
            const char* a1 = cA + (size_t)(t + 1) * kstep;
            const char* a2 = last ? nA : cA + (size_t)(t + 2) * kstep; const char* b2 = last ? nB : cB + (size_t)(t + 2) * kstep;
            const char* a3 = a2 + kstep; const char* b3 = b2 + kstep;
            if (last && has_next) S.a_ready(nxt);
            if constexpr (Sched::HANDOFF) S.mid(cur, t, nt, wid, lane);
            if constexpr (SP2) {
            PG8_LDB(B0, 0, 0); PG8_LDB(B1, 0, 1); PG8_SCHED; PG8_LDA(At, 0, 0); PG8_STAGE(PG8_SA(1, 1), a1 + hstep, voffA);
            PG8_WAIT_V(8); PG8_WAIT_L(0); PG8_BAR; PG8_MMA(0, 0, At, B0); PG8_MMA(0, 1, At, B1); PG8_BAR; PG8_SCHED;
            PG8_LDA(At, 0, 1); PG8_STAGE(PG8_SB(0, 0), b2, voffB); PG8_STAGE(PG8_SB(0, 1), b2 + hstep, voffB); PG8_STAGE(PG8_SA(0, 0), a2, voffA);
            PG8_WAIT_V(8); PG8_WAIT_L(0); PG8_BAR; PG8_MMA(1, 0, At, B0); PG8_MMA(1, 1, At, B1); PG8_BAR; PG8_SCHED;
            PG8_LDB(B0, 1, 0); PG8_LDB(B1, 1, 1); PG8_SCHED; PG8_LDA(At, 1, 0); PG8_STAGE(PG8_SA(0, 1), a2 + hstep, voffA);
            PG8_WAIT_V(8); PG8_WAIT_L(0); PG8_BAR; PG8_MMA(0, 0, At, B0); PG8_MMA(0, 1, At, B1); PG8_BAR; PG8_SCHED;
            PG8_LDA(At, 1, 1); PG8_STAGE(PG8_SB(1, 0), b3, voffB); PG8_STAGE(PG8_SB(1, 1), b3 + hstep, voffB); PG8_STAGE(PG8_SA(1, 0), a3, voffA);
            PG8_WAIT_V(8); PG8_WAIT_L(0); PG8_BAR; PG8_MMA(1, 0, At, B0); PG8_MMA(1, 1, At, B1); PG8_BAR; PG8_SCHED;
            } else {
            PG8_LDB(B0, 0, 0); PG8_SCHED; PG8_LDA(At, 0, 0); PG8_STAGE(PG8_SA(1, 1), a1 + hstep, voffA);
            PG8_WAIT_L(8); PG8_BAR; PG8_WAIT_L(0); PG8_MMA(0, 0, At, B0); PG8_BAR; PG8_SCHED;
            PG8_LDB(B1, 0, 1); PG8_STAGE(PG8_SB(0, 0), b2, voffB);
            PG8_BAR; PG8_WAIT_L(0); PG8_MMA(0, 1, At, B1); PG8_BAR;
            PG8_LDA(At, 0, 1); PG8_STAGE(PG8_SA(0, 0), a2, voffA);
            PG8_BAR; PG8_WAIT_L(0); PG8_MMA(1, 0, At, B0); PG8_BAR; PG8_SCHED;
            PG8_STAGE(PG8_SB(0, 1), b2 + hstep, voffB);
            PG8_WAIT_V(6); PG8_BAR; PG8_MMA(1, 1, At, B1); PG8_BAR;
            PG8_LDB(B0, 1, 0); PG8_SCHED; PG8_LDA(At, 1, 0); PG8_STAGE(PG8_SA(0, 1), a2 + hstep, voffA);
            PG8_WAIT_L(8); PG8_BAR; PG8_WAIT_L(0); PG8_MMA(0, 0, At, B0); PG8_BAR; PG8_SCHED;
            PG8_LDB(B1, 1, 1); PG8_STAGE(PG8_SB(1, 0), b3, voffB);
            PG8_BAR; PG8_WAIT_L(0); PG8_MMA(0, 1, At, B1); PG8_BAR;
            PG8_LDA(At, 1, 1); PG8_STAGE(PG8_SA(1, 0), a3, voffA);
            PG8_BAR; PG8_WAIT_L(0); PG8_MMA(1, 0, At, B0); PG8_BAR; PG8_SCHED;
            PG8_STAGE(PG8_SB(1, 1), b3 + hstep, voffB);
            PG8_WAIT_V(6); PG8_BAR; PG8_MMA(1, 1, At, B1); PG8_BAR;
            }
        }
        if constexpr (ALIGN_EPI) { if (wr == 0) PG8_BAR; }
        if constexpr (!Epi::AFTER_DRAIN) { E(acc, cur, wr, wc, fr, fq); S.done(cur); }
        if (!has_next) break;
#pragma unroll
        for (int a = 0; a < 2; ++a)
#pragma unroll
            for (int b = 0; b < 2; ++b)
#pragma unroll
                for (int m = 0; m < 4; ++m)
#pragma unroll
                    for (int n = 0; n < 2; ++n) acc[a][b][m][n] = (f32x4){0.f, 0.f, 0.f, 0.f};
        cur = nxt; cA = nA; cB = nB; ++ui;
        if constexpr (ALIGN_EPI) { if (wr == 1) PG8_BAR; }
    }
    PG8_WAIT_V(0);
    if constexpr (!ALIGN_EPI) { if (wr == 0) PG8_BAR; }
    PG8_BAR;
    if constexpr (Epi::AFTER_DRAIN) { E.fused(acc, cur, wr, wc, fr, fq, lds, wid, lane); S.done(cur); }
#undef PG8_SA
#undef PG8_SB
#undef PG8_STAGE
#undef PG8_LDA
#undef PG8_LDB
#undef PG8_MMA
#undef PG8_WAIT_V
#undef PG8_WAIT_L
#undef PG8_BAR
#undef PG8_SCHED
}
}
namespace pg8 {
typedef unsigned u32x2v __attribute__((ext_vector_type(2)));
constexpr int E_MP = 8192;
struct EpiIn {
    static constexpr bool PERM = true, AFTER_DRAIN = false;
    unsigned char* ws; float* out; int l; float qscale;
    __device__ __forceinline__ void operator()(const f32x4 (&acc)[2][2][4][2], const Unit& u, int wr, int wc, int fr, int fq) const {
        asm volatile("" : "+v"(fr), "+v"(fq));
        const int row0 = u.pm * BM + wr * 64 + fr, colt = u.pn * BM + wc * 32 + 8 * fq;
        if (u.pn < 14) {
            float* PR = (float*)(ws + WS_PR); float* sh_p = out + O_SP + (size_t)l * 3520; float* sh_s = out + O_SS + (size_t)l * 16 * 3520;
#pragma unroll
            for (int ai = 0; ai < 2; ++ai)
#pragma unroll
                for (int m = 0; m < 4; ++m) { const int r = row0 + ai * HALF + m * 16;
#pragma unroll
                    for (int bj = 0; bj < 2; ++bj) { const int c = colt + bj * HALF; float* p = PR + (size_t)r * 3584 + c;
                        *(f32x4*)p = acc[ai][bj][m][0]; *(f32x4*)(p + 4) = acc[ai][bj][m][1];
                        if (c < 3520) {
                            if (r == E_MP - 1) { *(f32x4*)(sh_p + c) = acc[ai][bj][m][0]; *(f32x4*)(sh_p + c + 4) = acc[ai][bj][m][1]; }
                            if (r >= E_MP && (r & 15) == 15) { float* q = sh_s + (size_t)((r - E_MP) >> 4) * 3520 + c; *(f32x4*)q = acc[ai][bj][m][0]; *(f32x4*)(q + 4) = acc[ai][bj][m][1]; }
                        } } }
        } else {
            const int region = (u.pn - 14) >> 2, cl0 = colt - 3584 - region * 1024;
            static_assert(WS_KB - WS_QB == WS_VB - WS_KB && O_VP - O_KP == (size_t)2 * 8192 * 1024 && O_VS - O_KS == (size_t)2 * 256 * 1024, "equal spacing");
            bf16_t* B16 = (bf16_t*)(ws + WS_QB + (size_t)region * (WS_KB - WS_QB));
            const float sc = region == 0 ? qscale : 1.f;
            float* fp = out + O_KP + (size_t)(region == 2 ? 1 : 0) * (O_VP - O_KP) + (size_t)l * E_MP * 1024; float* fs = out + O_KS + (size_t)(region == 2 ? 1 : 0) * (O_VS - O_KS) + (size_t)l * 256 * 1024;
#pragma unroll
            for (int ai = 0; ai < 2; ++ai)
#pragma unroll
                for (int m = 0; m < 4; ++m) { const int r = row0 + ai * HALF + m * 16;
                    float* fo = (r < E_MP) ? fp + (size_t)r * 1024 : fs + (size_t)(r - E_MP) * 1024;
#pragma unroll
                    for (int bj = 0; bj < 2; ++bj) { const int c = cl0 + bj * HALF; const f32x4 v0 = acc[ai][bj][m][0] * sc, v1 = acc[ai][bj][m][1] * sc;
                        u32x4 w; w.x = cvt_pk_bf16(v0[0], v0[1]); w.y = cvt_pk_bf16(v0[2], v0[3]); w.z = cvt_pk_bf16(v1[0], v1[1]); w.w = cvt_pk_bf16(v1[2], v1[3]);
                        *(u32x4*)(B16 + (size_t)r * 1024 + c) = w;
                        if (region != 0) { __builtin_nontemporal_store(v0, (f32x4*)(fo + c)); __builtin_nontemporal_store(v1, (f32x4*)(fo + c + 4)); } } }
        }
    }
};
struct EpiRes {
    static constexpr bool PERM = true, AFTER_DRAIN = false;
    const float* src_p; const float* src_s; float* dst; const float* gate;
    __device__ __forceinline__ void operator()(const f32x4 (&acc)[2][2][4][2], const Unit& u, int wr, int wc, int fr, int fq) const {
        asm volatile("" : "+v"(fr), "+v"(fq));
        const int row0 = u.pm * BM + wr * 64 + fr, colt = u.pn * BM + wc * 32 + 8 * fq;
        f32x4 gt[2][2];
#pragma unroll
        for (int bj = 0; bj < 2; ++bj)
#pragma unroll
            for (int n = 0; n < 2; ++n) gt[bj][n] = *(const f32x4*)(gate + colt + bj * HALF + 4 * n);
#pragma unroll
        for (int ai = 0; ai < 2; ++ai)
#pragma unroll
            for (int mp = 0; mp < 1; ++mp) {
                f32x4 x[4][2][2];
#pragma unroll
                for (int mm = 0; mm < 4; ++mm) { const int r = row0 + ai * HALF + (4 * mp + mm) * 16; const float* s = src_p + (size_t)r * 2048 + colt;
#pragma unroll
                    for (int bj = 0; bj < 2; ++bj)
#pragma unroll
                        for (int n = 0; n < 2; ++n) x[mm][bj][n] = *(const f32x4*)(s + bj * HALF + 4 * n); }
#pragma unroll
                for (int mm = 0; mm < 4; ++mm) { const int m = 4 * mp + mm, r = row0 + ai * HALF + m * 16; float* d = dst + (size_t)r * 2048 + colt;
#pragma unroll
                    for (int bj = 0; bj < 2; ++bj)
#pragma unroll
                        for (int n = 0; n < 2; ++n) *(f32x4*)(d + bj * HALF + 4 * n) = x[mm][bj][n] + gt[bj][n] * acc[ai][bj][m][n]; }
                asm volatile("" ::: "memory");
            }
    }
};
struct EpiResSlab {
    static constexpr bool PERM = true, AFTER_DRAIN = false;
    float* slab; const float* gate;
    __device__ __forceinline__ void operator()(const f32x4 (&acc)[2][2][4][2], const Unit& u, int wr, int wc, int fr, int fq) const {
        asm volatile("" : "+v"(fr), "+v"(fq));
        const int row0 = wr * 64 + fr, colt = u.pn * BM + wc * 32 + 8 * fq;
#pragma unroll
        for (int ai = 0; ai < 2; ++ai)
#pragma unroll
            for (int mp = 0; mp < 2; ++mp) {
                f32x4 gt[2][2][2];
#pragma unroll
                for (int mm = 0; mm < 2; ++mm) { const int r = row0 + ai * HALF + (2 * mp + mm) * 16; const float* g = gate + (size_t)(1 + (r >> 4)) * 12288 + colt;
#pragma unroll
                    for (int bj = 0; bj < 2; ++bj)
#pragma unroll
                        for (int n = 0; n < 2; ++n) gt[mm][bj][n] = *(const f32x4*)(g + bj * HALF + 4 * n); }
#pragma unroll
                for (int mm = 0; mm < 2; ++mm) { const int m = 2 * mp + mm, r = row0 + ai * HALF + m * 16; float* d = slab + ((size_t)u.ks * 256 + r) * 2048 + colt;
#pragma unroll
                    for (int bj = 0; bj < 2; ++bj)
#pragma unroll
                        for (int n = 0; n < 2; ++n) *(f32x4*)(d + bj * HALF + 4 * n) = gt[mm][bj][n] * acc[ai][bj][m][n]; }
                asm volatile("" ::: "memory");
            }
    }
};
template <int CTRL> __device__ __forceinline__ float dppf(float old, float src) { return __builtin_bit_cast(float, __builtin_amdgcn_update_dpp(__builtin_bit_cast(int, old), __builtin_bit_cast(int, src), CTRL, 0xF, 0xF, false)); }
struct EpiUp {
    static constexpr bool PERM = true, AFTER_DRAIN = false;
    bf16_t* ACT; const float* cw; const float* cb; const float* sconv; float* halo; float* conv_p; float* conv_s; PG8_LAS float* hb;
    template <bool SAMP> __device__ __forceinline__ void run(const f32x4 (&acc)[2][2][4][2], const Unit& u, int wr, int wc, int fr, int fq) const {
        asm volatile("" : "+v"(fr), "+v"(fq));
        const int jl = wc * 32 + 8 * fq, j0 = u.pn * HALF + jl;
#pragma unroll
        for (int ai = 0; ai < 2; ++ai) { const int blk = 2 * ai + wr;
            if (!SAMP && fr >= 14) {
                if (blk < 3) { PG8_LAS float* h = hb + ((blk + 1) * 2 + (fr - 14)) * HALF + jl; *(PG8_LAS f32x4*)h = acc[ai][0][3][0]; *(PG8_LAS f32x4*)(h + 4) = acc[ai][0][3][1]; }
                else { float* t = halo + ((size_t)u.pm * 2 + (fr - 14)) * 5632 + j0; *(f32x4*)t = acc[ai][0][3][0]; *(f32x4*)(t + 4) = acc[ai][0][3][1];
                    if (u.pm == 31) { float* c = conv_p + (size_t)(fr - 14) * 5632 + j0; *(f32x4*)c = acc[ai][0][3][0]; *(f32x4*)(c + 4) = acc[ai][0][3][1]; } }
            }
            if (SAMP && fr >= 14) {
#pragma unroll
                for (int m = 0; m < 4; ++m) { const int sb = 8 * ai + 4 * wr + m; float* c = conv_s + ((size_t)sb * 2 + (fr - 14)) * 5632 + j0; *(f32x4*)c = acc[ai][0][m][0]; *(f32x4*)(c + 4) = acc[ai][0][m][1]; }
            }
        }
        asm volatile("s_waitcnt lgkmcnt(0)\n\ts_barrier" ::: "memory");
        f32x4 cwv[2][3], cbv[2];
#pragma unroll
        for (int n = 0; n < 2; ++n) { cwv[n][0] = *(const f32x4*)(cw + j0 + 4 * n); cwv[n][1] = *(const f32x4*)(cw + 5632 + j0 + 4 * n); cwv[n][2] = *(const f32x4*)(cw + 2 * 5632 + j0 + 4 * n); cbv[n] = *(const f32x4*)(cb + j0 + 4 * n); }
#pragma unroll
        for (int ai = 0; ai < 2; ++ai) { const int blk = 2 * ai + wr;
#pragma unroll
            for (int m = 0; m < 4; ++m) { const int r = u.pm * BM + ai * HALF + wr * 64 + m * 16 + fr;
                u32x4 w;
#pragma unroll
                for (int n = 0; n < 2; ++n) {
                    f32x4 pv = (f32x4){0.f, 0.f, 0.f, 0.f};
                    if (SAMP) { if (fr >= 14) { const int sb = 8 * ai + 4 * wr + m; pv = *(const f32x4*)(sconv + ((size_t)sb * 2 + (fr - 14)) * 5632 + j0 + 4 * n); } asm volatile("" : "+v"(pv)); }
                    else if (m == 0) { if (blk > 0 && fr >= 14) pv = *(const PG8_LAS f32x4*)(hb + (blk * 2 + (fr - 14)) * HALF + jl + 4 * n); asm volatile("" : "+v"(pv)); }
                    else pv = acc[ai][0][m > 0 ? m - 1 : 0][n];
                    const f32x4 w0 = cwv[n][0], w1 = cwv[n][1], w2 = cwv[n][2], bb = cbv[n];
                    f32x4 o;
#pragma unroll
                    for (int i = 0; i < 4; ++i) { const float cur = acc[ai][0][m][n][i], pr = pv[i];
                        const float t1 = dppf<0x121>(pr, pr), p1 = dppf<0x111>(t1, cur);
                        const float t2 = dppf<0x122>(pr, pr), p2 = dppf<0x112>(t2, cur);
                        o[i] = bb[i] + w0[i] * p2 + w1[i] * p1 + w2[i] * cur; }
                    const f32x2 g0 = gelu_pk((f32x2){o[0], o[1]}), g1 = gelu_pk((f32x2){o[2], o[3]});
                    const f32x4 uv = acc[ai][1][m][n];
                    const unsigned lo = cvt_pk_bf16(g0.x * uv[0], g0.y * uv[1]), hi = cvt_pk_bf16(g1.x * uv[2], g1.y * uv[3]);
                    if (n == 0) { w.x = lo; w.y = hi; } else { w.z = lo; w.w = hi; }
                }
                const bool head = (!SAMP && u.pm > 0 && blk == 0 && m == 0 && fr < 2);
                if (!head) *(u32x4*)(ACT + (size_t)r * 5632 + j0) = w;
                else { float* hg = halo + (size_t)32 * 2 * 5632 + ((size_t)u.pm * 2 + fr) * 5632 + j0; float* hv = hg + (size_t)32 * 2 * 5632;
                    *(f32x4*)hg = acc[ai][0][m][0]; *(f32x4*)(hg + 4) = acc[ai][0][m][1]; *(f32x4*)hv = acc[ai][1][m][0]; *(f32x4*)(hv + 4) = acc[ai][1][m][1]; }
                asm volatile("" ::: "memory");
            } }
    }
    __device__ __forceinline__ void operator()(const f32x4 (&acc)[2][2][4][2], const Unit& u, int wr, int wc, int fr, int fq) const {
        if (u.pm == 32) run<true>(acc, u, wr, wc, fr, fq); else run<false>(acc, u, wr, wc, fr, fq);
    }
};
}
#include <hip/hip_bf16.h>
#include <cmath>
namespace attn_body {
using bf16=__hip_bfloat16;
using bf16x8=__attribute__((ext_vector_type(8)))short;
using s16x4=__attribute__((ext_vector_type(4)))short;
using f32x16=__attribute__((ext_vector_type(16)))float;
using u32x4=__attribute__((ext_vector_type(4)))unsigned;
constexpr int BATCH=1,NHEAD=16,SEQ=8192,D=64,DM=NHEAD*D;
constexpr int NW=8,QBLK=32,QB=QBLK*NW,KVBLK=64,NQB=SEQ/QB;
constexpr int ATTN_PITCH=DM, ATTN_UNIT_ROWS=QB, OPITCH=2048;
__device__ __forceinline__ int crow(int r,int hi){return (r&3)+8*(r>>2)+4*hi;}
#define SBAR() __builtin_amdgcn_sched_barrier(0)
__device__ __forceinline__ void bmask(f32x16&p0,f32x16&p1,int t,int cq,int qabs,int hi,const __attribute__((address_space(3))) float*lut){
  if(t>cq){
    #pragma unroll
    for(int r=0;r<16;++r){p0[r]=-INFINITY;p1[r]=-INFINITY;}
  } else {
    const int d0=64*t+4*hi-qabs+128;
    #pragma unroll
    for(int r=0;r<16;++r){int i0=d0+(r&3)+8*(r>>2); int i1=i0+32; i0=i0<0?0:i0; i1=i1<0?0:i1; p0[r]+=lut[i0]; p1[r]+=lut[i1];}
  }
}

constexpr int NSLOT=3, SLOTB=8192;
constexpr int LDS_K=0, LDS_V=NSLOT*SLOTB, LDS_WS=2*NSLOT*SLOTB, LDS_OST=LDS_WS+NW*64*4, LDS_BYTES=LDS_OST+NW*4096;
constexpr float C2=0.125f*1.4426950408889634f;
__device__ __forceinline__ void glds16(const void*gsrc,unsigned lds_dst){unsigned keep;
  asm volatile("s_mov_b32 %0, m0\n\ts_mov_b32 m0, %2\n\ts_nop 0\n\tglobal_load_lds_dwordx4 %1, off\n\ts_mov_b32 m0, %0":"=&s"(keep):"v"(gsrc),"s"(lds_dst):"memory");}
__device__ __forceinline__ float max3f(float a,float b,float c){float r;asm("v_max3_f32 %0, %1, %2, %3":"=v"(r):"v"(a),"v"(b),"v"(c));return r;}
__device__ __forceinline__ float max2f(float a,float b){float r;asm("v_max_f32_e32 %0, %1, %2":"=v"(r):"v"(a),"v"(b));return r;}
__device__ __forceinline__ float fadd_s(float a,float b){float r;asm("v_add_f32_e32 %0, %1, %2":"=v"(r):"v"(a),"v"(b));return r;}
__device__ __forceinline__ float fsub_s(float a,float b){float r;asm("v_sub_f32_e32 %0, %1, %2":"=v"(r):"v"(a),"v"(b));return r;}
typedef float f32x2_t __attribute__((ext_vector_type(2))); typedef __bf16 bf16x2_t __attribute__((ext_vector_type(2)));
__device__ __forceinline__ unsigned cvtpk_s(float lo,float hi){f32x2_t v={lo,hi};bf16x2_t b=__builtin_convertvector(v,bf16x2_t);return __builtin_bit_cast(unsigned,b);}
#define WAIT_BAR(N) asm volatile("s_waitcnt vmcnt(" #N ") lgkmcnt(0)\n\ts_barrier":::"memory")

__device__ __forceinline__ void qkt(f32x16&p0,f32x16&p1,const char*Kslot,const bf16x8*qr,const f32x16&negm,int r32,int hi){
  const char*kb=Kslot+hi*1024+r32*16;
  #pragma unroll
  for(int d0=0;d0<4;++d0){
    const bf16x8 b0=*reinterpret_cast<const bf16x8*>(kb+d0*2048);
    const bf16x8 b1=*reinterpret_cast<const bf16x8*>(kb+d0*2048+512);
    if(d0==0){p0=__builtin_amdgcn_mfma_f32_32x32x16_bf16(b0,qr[0],negm,0,0,0);p1=__builtin_amdgcn_mfma_f32_32x32x16_bf16(b1,qr[0],negm,0,0,0);}
    else{p0=__builtin_amdgcn_mfma_f32_32x32x16_bf16(b0,qr[d0],p0,0,0,0);p1=__builtin_amdgcn_mfma_f32_32x32x16_bf16(b1,qr[d0],p1,0,0,0);}}
}
typedef __attribute__((address_space(3))) const char* lds_cptr;
typedef short v4i16_t __attribute__((ext_vector_type(4)));
__device__ __forceinline__ void kload8(bf16x8*kf,lds_cptr kp){
  kf[0]=*(const __attribute__((address_space(3))) bf16x8*)(kp);      kf[1]=*(const __attribute__((address_space(3))) bf16x8*)(kp+512);
  kf[2]=*(const __attribute__((address_space(3))) bf16x8*)(kp+2048); kf[3]=*(const __attribute__((address_space(3))) bf16x8*)(kp+2560);
  kf[4]=*(const __attribute__((address_space(3))) bf16x8*)(kp+4096); kf[5]=*(const __attribute__((address_space(3))) bf16x8*)(kp+4608);
  kf[6]=*(const __attribute__((address_space(3))) bf16x8*)(kp+6144); kf[7]=*(const __attribute__((address_space(3))) bf16x8*)(kp+6656);
}
__device__ __forceinline__ void kload2(bf16x8*kf,lds_cptr kp,int j){ kf[2*j]=*(const __attribute__((address_space(3))) bf16x8*)(kp+j*2048); kf[2*j+1]=*(const __attribute__((address_space(3))) bf16x8*)(kp+j*2048+512); }
__device__ __forceinline__ s16x4 vtr(lds_cptr p){ return __builtin_bit_cast(s16x4,__builtin_amdgcn_ds_read_tr16_b64_v4i16((__attribute__((address_space(3))) v4i16_t*)p)); }
__device__ __forceinline__ float rowmax(const f32x16&p0,const f32x16&p1){
  float a=max3f(p0[0],p0[1],p1[0]),b=max3f(p0[2],p0[3],p1[1]);a=max3f(a,p1[2],p1[3]);
  #pragma unroll
  for(int r=4;r<16;r+=4){a=max3f(a,p0[r],p0[r+1]);b=max3f(b,p0[r+2],p0[r+3]);a=max3f(a,p1[r],p1[r+1]);b=max3f(b,p1[r+2],p1[r+3]);}
  const float m=max2f(a,b);
  const PL32 rr=pl32(m);
  return max2f(rr.a,rr.b);
}
__device__ __forceinline__ void pv(f32x16*o,int vb,bf16x8 pa0,bf16x8 pa1,bf16x8 pa2,bf16x8 pa3){
  #pragma unroll
  for(int d0=0;d0<2;++d0){s16x4 lo[4],hi[4];
    #pragma unroll
    for(int ks=0;ks<4;++ks){
      asm volatile("ds_read_b64_tr_b16 %0,%1 offset:%c2":"=&v"(lo[ks]):"v"(vb),"i"(d0*4096+ks*1024):"memory");
      asm volatile("ds_read_b64_tr_b16 %0,%1 offset:%c2":"=&v"(hi[ks]):"v"(vb),"i"(d0*4096+ks*1024+512):"memory");}
    asm volatile("s_waitcnt lgkmcnt(0)":::"memory");SBAR();
    #define PK(k) (bf16x8){lo[k][0],lo[k][1],lo[k][2],lo[k][3],hi[k][0],hi[k][1],hi[k][2],hi[k][3]}
    o[d0]=__builtin_amdgcn_mfma_f32_32x32x16_bf16(pa0,PK(0),o[d0],0,0,0);
    o[d0]=__builtin_amdgcn_mfma_f32_32x32x16_bf16(pa1,PK(1),o[d0],0,0,0);
    o[d0]=__builtin_amdgcn_mfma_f32_32x32x16_bf16(pa2,PK(2),o[d0],0,0,0);
    o[d0]=__builtin_amdgcn_mfma_f32_32x32x16_bf16(pa3,PK(3),o[d0],0,0,0);
    #undef PK
  }
}

#ifndef ATTN_STORE16
#define ATTN_STORE16(p,v) (*(u32x4*)(p)=(v))
#endif
template<int THRL> __device__ __forceinline__ void attn_unit(int qb,int qkcol,int vcol,int ocol,int hh,const float*__restrict__ reltab,const bf16*Q,const bf16*__restrict__ K,const bf16*__restrict__ V,bf16*O,char*shm,const __attribute__((address_space(3))) float*lut){
  const int b=0;
  int tid_=threadIdx.x; asm volatile("":"+v"(tid_));
  const int tid=tid_,lane=tid&63,r32=lane&31,hi=lane>>5; const int wid=__builtin_amdgcn_readfirstlane(tid>>6);
  const long rowbase=(long)b*SEQ; const int q0=qb*QB;
  const bf16*Qw=Q+(rowbase+q0+wid*QBLK)*DM+qkcol;
  const bf16*Kh=K+rowbase*DM+qkcol,*Vh=V+rowbase*DM+vcol;
  const unsigned lds0=(unsigned)(uintptr_t)shm;
  float*wsf=(float*)(shm+LDS_WS)+wid*64;
  const bf16*ksrc=Kh+(long)lane*DM+wid*8;
  const bf16*vsrc=Vh+(long)(16*(wid&3)+(lane>>2))*DM+(wid>>2)*32+(lane&3)*8;
  const unsigned kdst=lds0+LDS_K+wid*1024, vdst=lds0+LDS_V+wid*1024;
  #define DMA_K(t,slot) glds16(ksrc+(long)(t)*KVBLK*DM,(unsigned)__builtin_amdgcn_readfirstlane(kdst+(slot)))
  #define DMA_V(t,slot) glds16(vsrc+(long)(t)*KVBLK*DM,(unsigned)__builtin_amdgcn_readfirstlane(vdst+(slot)))
  const int vb0=(int)(lds0+LDS_V)+((lane>>4)&1)*32+(lane&3)*8+(4*hi+((lane&15)>>2))*64;
  const char*Kbase=shm+LDS_K; bf16x8 kf[8];
  const lds_cptr shm3=(lds_cptr)shm; const lds_cptr kp0=shm3+LDS_K+hi*1024+r32*16; const lds_cptr vp0=shm3+LDS_V+((lane>>4)&1)*32+(lane&3)*8+(4*hi+((lane&15)>>2))*64;
  const int NT=(q0+QB)/KVBLK;
  const int cq=(q0>>6)+(wid>>1), cqm2=cq-2, qabs=q0+wid*QBLK+r32;
  DMA_K(0,0);DMA_V(0,0);DMA_K(1,SLOTB);
  bf16x8 qr[4];
  #pragma unroll
  for(int d0=0;d0<4;++d0)qr[d0]=*reinterpret_cast<const bf16x8*>(&Qw[(long)r32*DM+d0*16+hi*8]);
  float mhat=0.f,l_reg=0.f;f32x16 o[2];o[0]=f32x16{};o[1]=f32x16{};f32x16 negm=f32x16{};asm volatile("":"+v"(negm));
  const int qrel=wid*QBLK+r32;
  #define CMASK(P0,P1,t) do{ if((t)>=cqm2)bmask(P0,P1,(t),cq,qabs,hi,lut);}while(0)
  bool resc=false;
  #define START(P0,P1) do{ const float rm=rowmax(P0,P1); resc=false; \
    { const float dl=rm; mhat=fadd_s(mhat,dl); \
      _Pragma("unroll") for(int r=0;r<16;++r){P0[r]=fsub_s(P0[r],dl);P1[r]=fsub_s(P1[r],dl);} \
      _Pragma("unroll") for(int r=0;r<16;++r)negm[r]=-mhat; asm volatile("":"+v"(negm)); } \
    _Pragma("unroll") for(int r=0;r<16;++r)P0[r]=__builtin_amdgcn_exp2f(P0[r]); }while(0)
  #define RESC() do{ if(resc){ asm volatile("s_waitcnt lgkmcnt(0)":::"memory"); \
      _Pragma("unroll") for(int d_=0;d_<2;++d_) _Pragma("unroll") for(int r=0;r<16;++r)o[d_][r]*=wsf[crow(r,hi)]; } }while(0)
  f32x16 pA0,pA1,pB0,pB1;
  int sl_prev=0,sl_cur=0,sl_next=SLOTB;
  #define ROT() do{sl_prev=sl_cur;sl_cur=sl_next;sl_next=(sl_next==(NSLOT-1)*SLOTB)?0:sl_next+SLOTB;}while(0)
  DMA_K(2,2*SLOTB);
  WAIT_BAR(3);
  qkt(pA0,pA1,Kbase,qr,negm,r32,hi);asm volatile("s_nop 15\n\ts_nop 7":"+v"(pA0),"+v"(pA1));CMASK(pA0,pA1,0);
  START(pA0,pA1);
  _Pragma("unroll") for(int r=0;r<16;++r)pA1[r]=__builtin_amdgcn_exp2f(pA1[r]);
  WAIT_BAR(0);
  DMA_K(3,0);DMA_V(1,SLOTB);
  ROT();
  kload8(kf,kp0+sl_cur);
  WAIT_BAR(2);
  s16x4 vlo[8],vhi[8]; u32x4 pw0,pw1,pw2,pw3;
  #define PKW(P,B) cvtpk_s(P[B],P[B+1])
  #define PAF(k) __builtin_bit_cast(bf16x8,pw##k)
  #define VFR(i) (bf16x8){vlo[i][0],vlo[i][1],vlo[i][2],vlo[i][3],vhi[i][0],vhi[i][1],vhi[i][2],vhi[i][3]}
  #define PIN(x) asm volatile("":"+v"(x))
  #define MX3(a,b,c) __builtin_fmaxf(__builtin_fmaxf((a),(b)),(c))
  #define GAPA(MF,A0,A1,A2,A3,W0,W1,PW) do{ MF; sacc+=A0; sacc+=A1; sacc+=A2; sacc+=A3; PIN(sacc); W0; W1; PIN(PW); SBAR(); }while(0)
  #define EX(v) __builtin_amdgcn_exp2f(v)
  #define GAPB(MF,X,B) do{ MF; X[B]=EX(X[B]); X[B+1]=EX(X[B+1]); X[B+2]=EX(X[B+2]); X[B+3]=EX(X[B+3]); PIN(X); SBAR(); }while(0)
  #define VRD(i) do{ vlo[i]=vtr(vp_+(((i)>>2)*4096+((i)&3)*1024)); vhi[i]=vtr(vp_+(((i)>>2)*4096+((i)&3)*1024+512)); }while(0)
  #define KRD(G,j) do{ if(G){ kload2(kf,kp0+sl_next,j); SBAR(); } }while(0)
  #define STEP(C0,C1,P0,P1,t,GK,GV,GL) do{ SBAR(); \
    const lds_cptr vp_=vp0+sl_prev; \
    VRD(0); SBAR(); float sacc=(P0[0]+P0[1]); \
    GAPA(C0=__builtin_amdgcn_mfma_f32_32x32x16_bf16(kf[0],qr[0],negm,0,0,0), P0[2],P0[3],P0[4],P0[5],     pw0[0]=PKW(P0,0), pw0[1]=PKW(P0,2), pw0); \
    VRD(4); SBAR(); GAPA(C1=__builtin_amdgcn_mfma_f32_32x32x16_bf16(kf[1],qr[0],negm,0,0,0), P0[6],P0[7],P0[8],P0[9],     pw0[2]=PKW(P0,4), pw0[3]=PKW(P0,6), pw0); \
    VRD(1); SBAR(); GAPA(C0=__builtin_amdgcn_mfma_f32_32x32x16_bf16(kf[2],qr[1],C0,0,0,0),   P0[10],P0[11],P0[12],P0[13], pw1[0]=PKW(P0,8), pw1[1]=PKW(P0,10), pw1); \
    VRD(5); SBAR(); GAPA(C1=__builtin_amdgcn_mfma_f32_32x32x16_bf16(kf[3],qr[1],C1,0,0,0),   P0[14],P0[15],P1[0],P1[1],   pw1[2]=PKW(P0,12),pw1[3]=PKW(P0,14), pw1); \
    VRD(2); SBAR(); GAPA(C0=__builtin_amdgcn_mfma_f32_32x32x16_bf16(kf[4],qr[2],C0,0,0,0),   P1[2],P1[3],P1[4],P1[5],     pw2[0]=PKW(P1,0), pw2[1]=PKW(P1,2), pw2); \
    VRD(6); SBAR(); GAPA(C1=__builtin_amdgcn_mfma_f32_32x32x16_bf16(kf[5],qr[2],C1,0,0,0),   P1[6],P1[7],P1[8],P1[9],     pw2[2]=PKW(P1,4), pw2[3]=PKW(P1,6), pw2); \
    VRD(3); SBAR(); GAPA(C0=__builtin_amdgcn_mfma_f32_32x32x16_bf16(kf[6],qr[3],C0,0,0,0),   P1[10],P1[11],P1[12],P1[13], pw3[0]=PKW(P1,8), pw3[1]=PKW(P1,10), pw3); \
    VRD(7); SBAR(); GAPA(C1=__builtin_amdgcn_mfma_f32_32x32x16_bf16(kf[7],qr[3],C1,0,0,0),   P1[14],P1[15],0.f,0.f,       pw3[2]=PKW(P1,12),pw3[3]=PKW(P1,14), pw3); \
    l_reg+=sacc; \
    if(GK){DMA_K((t)+3,sl_cur);} if(GV){DMA_V((t)+1,sl_next);} \
    CMASK(C0,C1,t); \
    { float a=MX3(C0[0],C0[1],C1[0]),b=MX3(C0[2],C0[3],C1[1]); a=MX3(a,C1[2],C1[3]); \
      _Pragma("unroll") for(int r=4;r<16;r+=4){a=MX3(a,C0[r],C0[r+1]);b=MX3(b,C0[r+2],C0[r+3]);a=MX3(a,C1[r],C1[r+1]);b=MX3(b,C1[r+2],C1[r+3]);} \
      float rm=__builtin_fmaxf(a,b); { const PL32 rr=pl32(rm); rm=__builtin_fmaxf(rr.a,rr.b); } \
      resc=false; \
      if(__builtin_expect(__any(rm>(float)THRL),0)){ const float dl=__builtin_fmaxf(rm,0.f); mhat+=dl; \
        _Pragma("unroll") for(int r=0;r<16;++r){C0[r]-=dl;C1[r]-=dl;} \
        _Pragma("unroll") for(int r=0;r<16;++r)negm[r]=-mhat; asm volatile("":"+v"(negm)); \
        const float f=__builtin_amdgcn_exp2f(-dl); l_reg*=f; if(hi==0)wsf[r32]=f; resc=true; } } \
    SBAR(); \
    GAPB(o[0]=__builtin_amdgcn_mfma_f32_32x32x16_bf16(PAF(0),VFR(0),o[0],0,0,0), C0,0); \
    GAPB(o[1]=__builtin_amdgcn_mfma_f32_32x32x16_bf16(PAF(0),VFR(4),o[1],0,0,0), C0,4); \
    KRD(GL,0); GAPB(o[0]=__builtin_amdgcn_mfma_f32_32x32x16_bf16(PAF(1),VFR(1),o[0],0,0,0), C0,8); \
    KRD(GL,1); GAPB(o[1]=__builtin_amdgcn_mfma_f32_32x32x16_bf16(PAF(1),VFR(5),o[1],0,0,0), C0,12); \
    KRD(GL,2); GAPB(o[0]=__builtin_amdgcn_mfma_f32_32x32x16_bf16(PAF(2),VFR(2),o[0],0,0,0), C1,0); \
    KRD(GL,3); GAPB(o[1]=__builtin_amdgcn_mfma_f32_32x32x16_bf16(PAF(2),VFR(6),o[1],0,0,0), C1,4); \
    GAPB(o[0]=__builtin_amdgcn_mfma_f32_32x32x16_bf16(PAF(3),VFR(3),o[0],0,0,0), C1,8); \
    GAPB(o[1]=__builtin_amdgcn_mfma_f32_32x32x16_bf16(PAF(3),VFR(7),o[1],0,0,0), C1,12); \
    }while(0)
  int t=1;
  #undef CMASK
  #define CMASK(P0,P1,t) do{}while(0)
  for(;t+7<NT;t+=2){
    STEP(pB0,pB1,pA0,pA1,t,true,true,true);     WAIT_BAR(2); RESC(); ROT();
    STEP(pA0,pA1,pB0,pB1,t+1,true,true,true);   WAIT_BAR(2); RESC(); ROT();
  }
  #undef CMASK
  #define CMASK(P0,P1,t) do{ if((t)>=cqm2)bmask(P0,P1,(t),cq,qabs,hi,lut);}while(0)
  #define ENDW(tt) do{ if((tt)+3<NT){WAIT_BAR(2);} else if((tt)+2<NT){WAIT_BAR(1);} else {WAIT_BAR(0);} }while(0)
  for(;t+1<NT;t+=2){
    STEP(pB0,pB1,pA0,pA1,t,(t+3<NT),(t+1<NT),(t+1<NT));       ENDW(t);   RESC(); ROT();
    STEP(pA0,pA1,pB0,pB1,t+1,(t+4<NT),(t+2<NT),(t+2<NT));     ENDW(t+1); RESC(); ROT();
  }
  STEP(pB0,pB1,pA0,pA1,NT-1,false,false,false); RESC();
  { float sacc=pB0[0]+pB0[1]; _Pragma("unroll") for(int r=2;r<16;++r)sacc+=pB0[r]; _Pragma("unroll") for(int r=0;r<16;++r)sacc+=pB1[r]; l_reg+=sacc;
    pw0=(u32x4){PKW(pB0,0),PKW(pB0,2),PKW(pB0,4),PKW(pB0,6)};pw1=(u32x4){PKW(pB0,8),PKW(pB0,10),PKW(pB0,12),PKW(pB0,14)};pw2=(u32x4){PKW(pB1,0),PKW(pB1,2),PKW(pB1,4),PKW(pB1,6)};pw3=(u32x4){PKW(pB1,8),PKW(pB1,10),PKW(pB1,12),PKW(pB1,14)};
    SBAR(); pv(o,vb0+sl_cur,PAF(0),PAF(1),PAF(2),PAF(3)); }
  #undef PKW
  #undef PAF
  #undef VFR
  #undef PIN
  #undef MX3
  #undef GAPA
  #undef GAPB
  #undef EX
  #undef VRD
  #undef KRD
  #undef STEP
  #undef ENDW
  {const PL32 rr=pl32(l_reg);l_reg=rr.a+rr.b;}
  if(hi==0)wsf[32+r32]=l_reg;asm volatile("s_waitcnt lgkmcnt(0)":::"memory");
  float rli[16];
  #pragma unroll
  for(int r=0;r<16;++r)rli[r]=__builtin_amdgcn_rcpf(wsf[32+crow(r,hi)]);
  bf16*Ow=O+(rowbase+q0+wid*QBLK)*(long)OPITCH+ocol;
  { bf16*stg=(bf16*)(shm+LDS_OST)+wid*2048;
    #pragma unroll
    for(int r=0;r<16;++r){const int orow=crow(r,hi);
      #pragma unroll
      for(int d0=0;d0<2;++d0)stg[orow*64+d0*32+r32]=__float2bfloat16(o[d0][r]*rli[r]);}
    asm volatile("s_waitcnt lgkmcnt(0)":::"memory");
    #pragma unroll
    for(int i=0;i<4;++i){const int row=i*8+(lane>>3),ch=lane&7; const u32x4 v=*(const u32x4*)(stg+row*64+ch*8); ATTN_STORE16(Ow+(long)row*OPITCH+ch*8,v);} }
  asm volatile("s_waitcnt lgkmcnt(0)\n\ts_barrier":::"memory");
  #undef DMA_K
  #undef DMA_V
  #undef CMASK
  #undef START
  #undef RESC
  #undef ROT
}
typedef __attribute__((address_space(3))) const char* lds_cp;
__device__ __forceinline__ void qkt_half(f32x16&p,lds_cp Kslot,const bf16x8*qr,const f32x16&negm,int r32,int hi,int kh){
  lds_cp kb=Kslot+hi*1024+(r32+32*kh)*16;
  #pragma unroll
  for(int d0=0;d0<4;++d0){ const bf16x8 b=*(const __attribute__((address_space(3))) bf16x8*)(kb+d0*2048);
    if(d0==0)p=__builtin_amdgcn_mfma_f32_32x32x16_bf16(b,qr[0],negm,0,0,0); else p=__builtin_amdgcn_mfma_f32_32x32x16_bf16(b,qr[d0],p,0,0,0);}
}
__device__ __forceinline__ void pv_half(f32x16*o,int vb,bf16x8 pa0,bf16x8 pa1){
  #pragma unroll
  for(int d0=0;d0<2;++d0){s16x4 lo[2],hi[2];
    #pragma unroll
    for(int ks=0;ks<2;++ks){
      asm volatile("ds_read_b64_tr_b16 %0,%1 offset:%c2":"=&v"(lo[ks]):"v"(vb),"i"(d0*4096+ks*1024):"memory");
      asm volatile("ds_read_b64_tr_b16 %0,%1 offset:%c2":"=&v"(hi[ks]):"v"(vb),"i"(d0*4096+ks*1024+512):"memory");}
    asm volatile("s_waitcnt lgkmcnt(0)":::"memory");SBAR();
    #define PK(k) (bf16x8){lo[k][0],lo[k][1],lo[k][2],lo[k][3],hi[k][0],hi[k][1],hi[k][2],hi[k][3]}
    o[d0]=__builtin_amdgcn_mfma_f32_32x32x16_bf16(pa0,PK(0),o[d0],0,0,0);
    o[d0]=__builtin_amdgcn_mfma_f32_32x32x16_bf16(pa1,PK(1),o[d0],0,0,0);
    #undef PK
  }
}
constexpr int F_SLOTV=2*SLOTB, F_LDS_K=0, F_LDS_V=NSLOT*SLOTB, F_LDS_WS=F_LDS_V+NSLOT*F_SLOTV, F_LDS_OST=F_LDS_WS+NW*64*4, F_LDS_BYTES=F_LDS_OST+4*8192;
__device__ __forceinline__ void bmask1(f32x16&p,int t,int cq,int qabs,int hi,int kh,const __attribute__((address_space(3))) float*lut){
  if(t>cq){
    #pragma unroll
    for(int r=0;r<16;++r)p[r]=-INFINITY;
  } else {
    const int d0=64*t+32*kh+4*hi-qabs+128;
    #pragma unroll
    for(int r=0;r<16;++r){int i0=d0+(r&3)+8*(r>>2); i0=i0<0?0:i0; p[r]+=lut[i0];}
  }
}
template<int THRL> __device__ __forceinline__ void attn_unit_f(int qb,int qkcol,int vcol,int ocol,const bf16*Q,const bf16*__restrict__ K,const bf16*__restrict__ V,bf16*O,char*shm,const __attribute__((address_space(3))) float*lut){
  int tid_=threadIdx.x; asm volatile("":"+v"(tid_));
  const int tid=tid_,lane=tid&63,r32=lane&31,hi=lane>>5; const int wid=__builtin_amdgcn_readfirstlane(tid>>6); const int pr=wid&3,kh=wid>>2;
  const int q0=qb*128;
  const bf16*Qw=Q+(long)(q0+pr*QBLK)*DM+qkcol;
  const bf16*Kh=K+qkcol,*Vh=V+vcol;
  const unsigned lds0=(unsigned)(uintptr_t)shm;
  float*wsf=(float*)(shm+F_LDS_WS)+wid*64;
  const bf16*ksrc=Kh+(long)lane*DM+wid*8;
  const bf16*vsrc=Vh+(long)(16*(wid&3)+(lane>>2))*DM+(wid>>2)*32+(lane&3)*8;
  const unsigned kdst=lds0+F_LDS_K+wid*1024, vdst=lds0+F_LDS_V+wid*1024;
  #define DMA_K(t,slot) glds16(ksrc+(long)(t)*KVBLK*DM,(unsigned)__builtin_amdgcn_readfirstlane(kdst+(slot)))
  #define DMA_V(t,slot) do{ glds16(vsrc+(long)(t)*KVBLK*DM,(unsigned)__builtin_amdgcn_readfirstlane(vdst+2*(slot))); glds16(vsrc+(long)(t)*KVBLK*DM+64,(unsigned)__builtin_amdgcn_readfirstlane(vdst+2*(slot)+8192)); }while(0)
  const int vb0=(int)(lds0+F_LDS_V)+((lane>>4)&1)*32+(lane&3)*8+(4*hi+((lane&15)>>2))*64+kh*2048;
  bf16x8 kf[4];
  const lds_cptr shm3=(lds_cptr)shm; const lds_cptr kp0=shm3+F_LDS_K+hi*1024+r32*16+kh*512; const lds_cptr vp0=shm3+F_LDS_V+((lane>>4)&1)*32+(lane&3)*8+(4*hi+((lane&15)>>2))*64+kh*2048;
  const int NT_=(q0+128)/KVBLK; const int NT=NT_<4?4:NT_;
  const int cq=(q0>>6)+(pr>>1), cqm2=cq-2, qabs=q0+pr*QBLK+r32;
  DMA_K(0,0);DMA_V(0,0);DMA_K(1,SLOTB);
  bf16x8 qr[4];
  #pragma unroll
  for(int d0=0;d0<4;++d0)qr[d0]=*reinterpret_cast<const bf16x8*>(&Qw[(long)r32*DM+d0*16+hi*8]);
  float mhat=0.f,l_reg=0.f;f32x16 o[4];o[0]=f32x16{};o[1]=f32x16{};o[2]=f32x16{};o[3]=f32x16{};f32x16 negm=f32x16{};asm volatile("":"+v"(negm));
  #define CMASK(P,t) do{ if((t)>=cqm2)bmask1(P,(t),cq,qabs,hi,kh,lut);}while(0)
  bool resc=false;
  #define RESC() do{ if(resc){ asm volatile("s_waitcnt lgkmcnt(0)":::"memory"); \
      _Pragma("unroll") for(int d_=0;d_<4;++d_) _Pragma("unroll") for(int r=0;r<16;++r)o[d_][r]*=wsf[crow(r,hi)]; } }while(0)
  f32x16 pA,pB;
  int sl_prev=0,sl_cur=0,sl_next=SLOTB;
  #define ROT() do{sl_prev=sl_cur;sl_cur=sl_next;sl_next=(sl_next==(NSLOT-1)*SLOTB)?0:sl_next+SLOTB;}while(0)
  DMA_K(2,2*SLOTB);
  WAIT_BAR(4);
  qkt_half(pA,(lds_cp)(shm3+F_LDS_K),qr,negm,r32,hi,kh);asm volatile("s_nop 15\n\ts_nop 7":"+v"(pA));CMASK(pA,0);
  { float a=max3f(pA[0],pA[1],pA[2]),b=max3f(pA[3],pA[4],pA[5]);a=max3f(a,pA[6],pA[7]);b=max3f(b,pA[8],pA[9]);a=max3f(a,pA[10],pA[11]);b=max3f(b,pA[12],pA[13]);a=max3f(a,pA[14],pA[15]);
    const float m=max2f(a,b); const PL32 rr=pl32(m); const float dl=max2f(rr.a,rr.b); mhat=fadd_s(mhat,dl);
    _Pragma("unroll") for(int r=0;r<16;++r)pA[r]=fsub_s(pA[r],dl);
    _Pragma("unroll") for(int r=0;r<16;++r)negm[r]=-mhat; asm volatile("":"+v"(negm));
    _Pragma("unroll") for(int r=0;r<16;++r)pA[r]=__builtin_amdgcn_exp2f(pA[r]); }
  WAIT_BAR(0);
  DMA_K(3,0);DMA_V(1,SLOTB);
  ROT();
  _Pragma("unroll") for(int j=0;j<4;++j)kf[j]=*(const __attribute__((address_space(3))) bf16x8*)(kp0+sl_cur+j*2048);
  WAIT_BAR(3);
  s16x4 vlo[8],vhi[8]; u32x4 pwa,pwb;
  #define PKW(P,B) cvtpk_s(P[B],P[B+1])
  #define PAFA __builtin_bit_cast(bf16x8,pwa)
  #define PAFB __builtin_bit_cast(bf16x8,pwb)
  #define VFR(i) (bf16x8){vlo[i][0],vlo[i][1],vlo[i][2],vlo[i][3],vhi[i][0],vhi[i][1],vhi[i][2],vhi[i][3]}
  #define PIN(x) asm volatile("":"+v"(x))
  #define MX3(a,b,c) __builtin_fmaxf(__builtin_fmaxf((a),(b)),(c))
  #define GAPA(MF,A0,A1,A2,A3,W0,W1,PW) do{ MF; sacc+=A0; sacc+=A1; sacc+=A2; sacc+=A3; PIN(sacc); W0; W1; PIN(PW); SBAR(); }while(0)
  #define EX(v) __builtin_amdgcn_exp2f(v)
  #define GAPB(MF,X,B) do{ MF; X[B]=EX(X[B]); X[B+1]=EX(X[B+1]); PIN(X); SBAR(); }while(0)
  #define VRD(i) do{ vlo[i]=vtr(vp_+(((i)>>1)*4096+((i)&1)*1024)); vhi[i]=vtr(vp_+(((i)>>1)*4096+((i)&1)*1024+512)); }while(0)
  #define KRD(G,j) do{ if(G){ kf[j]=*(const __attribute__((address_space(3))) bf16x8*)(kp0+sl_next+(j)*2048); SBAR(); } }while(0)
  #define STEPF(C,P,t,GK,GV,GL) do{ SBAR(); \
    const lds_cptr vp_=vp0+2*sl_prev; \
    VRD(0); VRD(2); SBAR(); float sacc=(P[0]+P[1]); \
    GAPA(C=__builtin_amdgcn_mfma_f32_32x32x16_bf16(kf[0],qr[0],negm,0,0,0), P[2],P[3],P[4],P[5],     pwa[0]=PKW(P,0), pwa[1]=PKW(P,2), pwa); \
    VRD(4); VRD(6); SBAR(); GAPA(C=__builtin_amdgcn_mfma_f32_32x32x16_bf16(kf[1],qr[1],C,0,0,0), P[6],P[7],P[8],P[9],     pwa[2]=PKW(P,4), pwa[3]=PKW(P,6), pwa); \
    VRD(1); VRD(3); SBAR(); GAPA(C=__builtin_amdgcn_mfma_f32_32x32x16_bf16(kf[2],qr[2],C,0,0,0), P[10],P[11],P[12],P[13], pwb[0]=PKW(P,8), pwb[1]=PKW(P,10), pwb); \
    VRD(5); VRD(7); SBAR(); GAPA(C=__builtin_amdgcn_mfma_f32_32x32x16_bf16(kf[3],qr[3],C,0,0,0), P[14],P[15],0.f,0.f,     pwb[2]=PKW(P,12),pwb[3]=PKW(P,14), pwb); \
    l_reg+=sacc; \
    if(GK){DMA_K((t)+3,sl_cur);} if(GV){DMA_V((t)+1,sl_next);} \
    CMASK(C,t); \
    { float a=MX3(C[0],C[1],C[2]),b=MX3(C[3],C[4],C[5]); a=MX3(a,C[6],C[7]); b=MX3(b,C[8],C[9]); a=MX3(a,C[10],C[11]); b=MX3(b,C[12],C[13]); a=MX3(a,C[14],C[15]); \
      float rm=__builtin_fmaxf(a,b); { const PL32 rr=pl32(rm); rm=__builtin_fmaxf(rr.a,rr.b); } \
      resc=false; \
      if(__builtin_expect(__any(rm>(float)THRL),0)){ const float dl=__builtin_fmaxf(rm,0.f); mhat+=dl; \
        _Pragma("unroll") for(int r=0;r<16;++r)C[r]-=dl; \
        _Pragma("unroll") for(int r=0;r<16;++r)negm[r]=-mhat; asm volatile("":"+v"(negm)); \
        const float f=__builtin_amdgcn_exp2f(-dl); l_reg*=f; if(hi==0)wsf[r32]=f; resc=true; } } \
    SBAR(); \
    GAPB(o[0]=__builtin_amdgcn_mfma_f32_32x32x16_bf16(PAFA,VFR(0),o[0],0,0,0), C,0); \
    GAPB(o[1]=__builtin_amdgcn_mfma_f32_32x32x16_bf16(PAFA,VFR(2),o[1],0,0,0), C,2); \
    KRD(GL,0); GAPB(o[2]=__builtin_amdgcn_mfma_f32_32x32x16_bf16(PAFA,VFR(4),o[2],0,0,0), C,4); \
    KRD(GL,1); GAPB(o[3]=__builtin_amdgcn_mfma_f32_32x32x16_bf16(PAFA,VFR(6),o[3],0,0,0), C,6); \
    KRD(GL,2); GAPB(o[0]=__builtin_amdgcn_mfma_f32_32x32x16_bf16(PAFB,VFR(1),o[0],0,0,0), C,8); \
    KRD(GL,3); GAPB(o[1]=__builtin_amdgcn_mfma_f32_32x32x16_bf16(PAFB,VFR(3),o[1],0,0,0), C,10); \
    GAPB(o[2]=__builtin_amdgcn_mfma_f32_32x32x16_bf16(PAFB,VFR(5),o[2],0,0,0), C,12); \
    GAPB(o[3]=__builtin_amdgcn_mfma_f32_32x32x16_bf16(PAFB,VFR(7),o[3],0,0,0), C,14); \
    }while(0)
  int t=1;
  #undef CMASK
  #define CMASK(P,t) do{}while(0)
  asm volatile(".p2align 8":::"memory");
  for(;t+7<NT;t+=2){
    STEPF(pB,pA,t,true,true,true);     WAIT_BAR(3); RESC(); ROT();
    STEPF(pA,pB,t+1,true,true,true);   WAIT_BAR(3); RESC(); ROT();
  }
  #undef CMASK
  #define CMASK(P,t) do{ if((t)>=cqm2)bmask1(P,(t),cq,qabs,hi,kh,lut);}while(0)
  #define ENDW(tt) do{ if((tt)+3<NT){WAIT_BAR(3);} else if((tt)+2<NT){WAIT_BAR(2);} else {WAIT_BAR(0);} }while(0)
  for(;t+1<NT;t+=2){
    STEPF(pB,pA,t,(t+3<NT),(t+1<NT),(t+1<NT));       ENDW(t);   RESC(); ROT();
    STEPF(pA,pB,t+1,(t+4<NT),(t+2<NT),(t+2<NT));     ENDW(t+1); RESC(); ROT();
  }
  STEPF(pB,pA,NT-1,false,false,false); RESC();
  { float sacc=pB[0]+pB[1]; _Pragma("unroll") for(int r=2;r<16;++r)sacc+=pB[r]; l_reg+=sacc;
    pwa=(u32x4){PKW(pB,0),PKW(pB,2),PKW(pB,4),PKW(pB,6)};pwb=(u32x4){PKW(pB,8),PKW(pB,10),PKW(pB,12),PKW(pB,14)};
    SBAR();
    const int vb=vb0+2*sl_cur;
    #pragma unroll
    for(int d0=0;d0<4;++d0){s16x4 lo[2],hi_[2];
      #pragma unroll
      for(int ks=0;ks<2;++ks){
        asm volatile("ds_read_b64_tr_b16 %0,%1 offset:%c2":"=&v"(lo[ks]):"v"(vb),"i"(d0*4096+ks*1024):"memory");
        asm volatile("ds_read_b64_tr_b16 %0,%1 offset:%c2":"=&v"(hi_[ks]):"v"(vb),"i"(d0*4096+ks*1024+512):"memory");}
      asm volatile("s_waitcnt lgkmcnt(0)":::"memory");SBAR();
      #define PK(k) (bf16x8){lo[k][0],lo[k][1],lo[k][2],lo[k][3],hi_[k][0],hi_[k][1],hi_[k][2],hi_[k][3]}
      o[d0]=__builtin_amdgcn_mfma_f32_32x32x16_bf16(PAFA,PK(0),o[d0],0,0,0);
      o[d0]=__builtin_amdgcn_mfma_f32_32x32x16_bf16(PAFB,PK(1),o[d0],0,0,0);
      #undef PK
    } }
  #undef PKW
  #undef PAFA
  #undef PAFB
  #undef VFR
  #undef PIN
  #undef MX3
  #undef GAPA
  #undef GAPB
  #undef EX
  #undef VRD
  #undef KRD
  #undef STEPF
  #undef ENDW
  {const PL32 rr=pl32(l_reg);l_reg=rr.a+rr.b;}
  asm volatile("s_waitcnt lgkmcnt(0)\n\ts_barrier":::"memory");
  float*OGp=(float*)shm+pr*4096;
  if(hi==0){wsf[r32]=mhat;wsf[32+r32]=l_reg;}
  if(kh==0){
    #pragma unroll
    for(int dd=0;dd<2;++dd)
      #pragma unroll
      for(int r=0;r<16;++r)OGp[(dd*16+r)*64+lane]=o[2+dd][r];
  } else {
    #pragma unroll
    for(int dd=0;dd<2;++dd)
      #pragma unroll
      for(int r=0;r<16;++r)OGp[2048+(dd*16+r)*64+lane]=o[dd][r];
  }
  asm volatile("s_waitcnt lgkmcnt(0)\n\ts_barrier":::"memory");
  { const float*wp=(const float*)(shm+F_LDS_WS)+(wid^4)*64; const float m2=wp[r32],l2=wp[32+r32]; const float M=__builtin_fmaxf(mhat,m2);
    const float f1=__builtin_amdgcn_exp2f(mhat-M),f2=__builtin_amdgcn_exp2f(m2-M); const float inv=__builtin_amdgcn_rcpf(l_reg*f1+l2*f2);
    float*GF=(float*)(shm+65536)+wid*64;
    if(hi==0){GF[r32]=f1*inv;GF[32+r32]=f2*inv;}
    asm volatile("s_waitcnt lgkmcnt(0)":::"memory");
    bf16*stg=(bf16*)(shm+F_LDS_OST)+pr*4096+kh*64;
    if(kh==0){
      #pragma unroll
      for(int r=0;r<16;++r){const int orow=crow(r,hi); const float g1=GF[orow],g2=GF[32+orow];
        #pragma unroll
        for(int dd=0;dd<2;++dd)stg[orow*128+dd*32+r32]=__float2bfloat16(o[dd][r]*g1+OGp[2048+(dd*16+r)*64+lane]*g2);}
    } else {
      #pragma unroll
      for(int r=0;r<16;++r){const int orow=crow(r,hi); const float g1=GF[orow],g2=GF[32+orow];
        #pragma unroll
        for(int dd=0;dd<2;++dd)stg[orow*128+dd*32+r32]=__float2bfloat16(o[2+dd][r]*g1+OGp[(dd*16+r)*64+lane]*g2);}
    }
    asm volatile("s_waitcnt lgkmcnt(0)":::"memory");
    bf16*Ow=O+(long)(q0+pr*QBLK)*(long)OPITCH+ocol+kh*64;
    #pragma unroll
    for(int i=0;i<4;++i){const int row=i*8+(lane>>3),ch=lane&7; const u32x4 v=*(const u32x4*)(stg+row*128+ch*8); ATTN_STORE16(Ow+(long)row*OPITCH+ch*8,v);} }
  asm volatile("s_waitcnt lgkmcnt(0)\n\ts_barrier":::"memory");
  #undef DMA_K
  #undef DMA_V
  #undef CMASK
  #undef RESC
  #undef ROT
}
constexpr int ATTN_LDS_BYTES=LDS_BYTES;
#undef SBAR
#undef WAIT_BAR
}
#define XB_TMO      128
#define XB_XCNT(j)  (256  + 64 * (j))
#define XB_XSUB(j)  (1280 + 64 * (j))
#define XB_XGEN(j)  (2304 + 64 * (j))
#define XB_TOP      3328
#define XB_TOPGEN   3392
#define XCD_BAR_WORDS 3456
#define XB_SPIN_CAP (1u << 18)

__device__ __forceinline__ unsigned xb_ld(unsigned* p)              { return __hip_atomic_load(p, __ATOMIC_RELAXED, __HIP_MEMORY_SCOPE_AGENT); }
__device__ __forceinline__ unsigned xb_add(unsigned* p, unsigned v) { return __hip_atomic_fetch_add(p, v, __ATOMIC_RELAXED, __HIP_MEMORY_SCOPE_AGENT); }
__device__ __forceinline__ unsigned xb_xcc_id() { return (unsigned)__builtin_amdgcn_s_getreg((3 << 11) | 20) & 0xFu; }
#define XB_SPIN(cond, bar) do { unsigned _sp = 0; while (cond) { __builtin_amdgcn_s_sleep(1); \
    if ((++_sp & 255u) == 0u) { if (xb_ld(&(bar)[XB_TMO])) break; if (_sp > XB_SPIN_CAP) { atomicAdd(&(bar)[XB_TMO], 1u); break; } } } } while (0)

struct XcdBarrier {
    unsigned* bar; unsigned x;
    volatile LAS unsigned* st;
};

__device__ __forceinline__ XcdBarrier xcd_barrier_post(unsigned* bar, volatile LAS unsigned* st) {
    XcdBarrier b; b.bar = bar; b.x = xb_xcc_id(); b.st = st;
    if (threadIdx.x == 0) (void)xb_add(&bar[XB_XCNT(b.x)], 1u);
    return b;
}
__device__ __forceinline__ void xcd_barrier_complete(unsigned* bar, unsigned x, unsigned& nloc, unsigned& nx) {
    const unsigned G = gridDim.x * gridDim.y * gridDim.z;
    unsigned sum, cnt, mine, sp = 0u;
    for (;;) {
        sum = 0u; cnt = 0u; mine = 0u;
#pragma unroll
        for (unsigned j = 0; j < 16; ++j) { const unsigned c = xb_ld(&bar[XB_XCNT(j)]); sum += c; cnt += (c > 0u) ? 1u : 0u; mine = (j == x) ? c : mine; }
        if (sum == G) break;
        __builtin_amdgcn_s_sleep(1);
        if ((++sp & 255u) == 0u) { if (xb_ld(&bar[XB_TMO])) break; if (sp > XB_SPIN_CAP) { atomicAdd(&bar[XB_TMO], 1u); break; } }
    }
    nloc = mine > 0u ? mine : 1u; nx = cnt > 0u ? cnt : 1u;
}

__device__ __forceinline__ void xcd_barrier(const XcdBarrier& b) {
    asm volatile("s_waitcnt vmcnt(0)" ::: "memory");
    __syncthreads();
    if (threadIdx.x == 0) {
        unsigned* bar = b.bar;
        __builtin_amdgcn_s_waitcnt(0);
        unsigned nloc = b.st[0], nx = b.st[1];
        if (nloc == 0u) { xcd_barrier_complete(bar, b.x, nloc, nx); b.st[0] = nloc; b.st[1] = nx; }
        const unsigned old = xb_add(&bar[XB_XSUB(b.x)], 1u);
        const unsigned gen = old / nloc;
        if (old + 1u == (gen + 1u) * nloc) {
            __builtin_amdgcn_fence(__ATOMIC_RELEASE, "agent");
            asm volatile("s_waitcnt vmcnt(0)" ::: "memory");
            const unsigned og = xb_add(&bar[XB_TOP], 1u);
            const unsigned tg = og / nx;
            if (og + 1u == (tg + 1u) * nx) xb_add(&bar[XB_TOPGEN], 1u);
            else XB_SPIN(xb_ld(&bar[XB_TOPGEN]) == tg, bar);
            __builtin_amdgcn_fence(__ATOMIC_ACQUIRE, "agent");
            xb_add(&bar[XB_XGEN(b.x)], 1u);
            asm volatile("s_waitcnt vmcnt(0)" ::: "memory");
        } else {
            XB_SPIN(xb_ld(&bar[XB_XGEN(b.x)]) == gen, bar);
            __builtin_amdgcn_fence(__ATOMIC_ACQUIRE, "agent");
            asm volatile("s_waitcnt vmcnt(0)" ::: "memory");
        }
    }
    __syncthreads();
}
struct Args { const float* in[37]; float* out; unsigned char* ws; int ph_lo, ph_hi; };
struct Frame { LAS unsigned char* lds; volatile LAS unsigned* MISC; gu32* ctl; int tid, lane, wave, G, bid; };
typedef __attribute__((address_space(4))) const Args* ArgsP;
__device__ __forceinline__ ArgsP get_args() { ArgsP p = (ArgsP)__builtin_amdgcn_kernarg_segment_ptr(); asm volatile("" : "+s"(p)); return p; }
#define PHASE_ENTRY() ArgsP A = get_args(); { int t_ = threadIdx.x; asm volatile("" : "+v"(t_)); F.tid = t_; F.lane = t_ & 63; F.wave = __builtin_amdgcn_readfirstlane(t_ >> 6); F.ctl = (gu32*)(A->ws + WS_CTL); }
enum InIdx { I_XP = 0, I_XS, I_CP, I_CS, I_CK, I_CV, I_SWKV, I_SSHIFT, I_SCONV, I_WADA, I_BADA, I_GMIX, I_GFFN, I_WIN, I_WOUT, I_MU, I_W0, I_W2, I_A0, I_A2, I_G2, I_KK, I_KA, I_RK, I_LNW, I_LNB,
             I_LQ1, I_LK1, I_LQ2, I_LK2, I_SUBLN, I_REL, I_FUP, I_CONVW, I_CONVB, I_FDN, I_GFIN };

__device__ __forceinline__ void transpose_item(const float* W, int K, int N, bf16* WT, int dest_row0, LAS float* scr, int kb, int n0, int lane) {
    const int k0 = 64 * kb;
    { f32x4 t[8];
#pragma unroll
      for (int i = 0; i < 8; ++i) t[i] = __builtin_nontemporal_load((const GAS f32x4*)(W + (size_t)(k0 + 8 * i + (lane >> 3)) * N + n0 + 4 * (lane & 7)));
#pragma unroll
      for (int i = 0; i < 8; ++i) { LAS float* d = scr + (8 * i + (lane >> 3)) * 33 + 4 * (lane & 7); d[0] = t[i][0]; d[1] = t[i][1]; d[2] = t[i][2]; d[3] = t[i][3]; } }
    LDS_WAIT(); asm volatile("" ::: "memory");
    const int c = lane & 7;
#pragma unroll
    for (int j = 0; j < 4; ++j) { const int n = (lane >> 3) + 8 * j; const LAS float* s = scr + (8 * c) * 33 + n;
        v4u o; o.x = pk2(s[0 * 33], s[1 * 33]); o.y = pk2(s[2 * 33], s[3 * 33]); o.z = pk2(s[4 * 33], s[5 * 33]); o.w = pk2(s[6 * 33], s[7 * 33]);
        *(GAS v4u*)(WT + (size_t)(dest_row0 + n) * K + k0 + 8 * c) = o; }
    LDS_WAIT(); asm volatile("" ::: "memory");
}
__device__ __forceinline__ void ph_prologue(Frame& F) {
    PHASE_ENTRY();
    unsigned char* ws = A->ws;
    if (F.bid < 192) {
        const int l = F.bid / 96, j0 = (F.bid % 96) * 128;
        LAS float* ST = (LAS float*)F.lds;
        const float* Wl = A->in[I_WADA] + (size_t)l * DMOD * MODW;
        float acc[NMODB][2];
#pragma unroll
        for (int b = 0; b < NMODB; ++b) { acc[b][0] = 0.f; acc[b][1] = 0.f; }
        for (int kh = 0; kh < 2; ++kh) {
            __syncthreads();
            for (int idx = F.tid; idx < 1024 * NMODB; idx += NWAVES * 64) { const int kk = idx / NMODB, b = idx % NMODB;
                const float c = (b == 0) ? A->in[I_CP][kh * 1024 + kk] : A->in[I_CS][(size_t)(b - 1) * DMOD + kh * 1024 + kk];
                ST[kk * 20 + b] = c / (1.f + __expf(-c)); }
            __syncthreads();
#pragma unroll 4
            for (int k = 0; k < 128; ++k) { const int kk = F.wave * 128 + k;
                const f32x2 w = __builtin_nontemporal_load((const GAS f32x2*)(Wl + (size_t)(kh * 1024 + kk) * MODW + j0 + 2 * F.lane));
                const LAS f32x4* sp = (const LAS f32x4*)(ST + kk * 20);
                const f32x4 s0 = sp[0], s1 = sp[1], s2 = sp[2], s3 = sp[3]; const float s16 = ST[kk * 20 + 16];
#pragma unroll
                for (int b = 0; b < 4; ++b) { acc[b][0] += s0[b] * w.x; acc[b][1] += s0[b] * w.y; acc[4 + b][0] += s1[b] * w.x; acc[4 + b][1] += s1[b] * w.y;
                    acc[8 + b][0] += s2[b] * w.x; acc[8 + b][1] += s2[b] * w.y; acc[12 + b][0] += s3[b] * w.x; acc[12 + b][1] += s3[b] * w.y; }
                acc[16][0] += s16 * w.x; acc[16][1] += s16 * w.y; }
        }
        __syncthreads();
        LAS float* RED = (LAS float*)F.lds;
#pragma unroll
        for (int b = 0; b < NMODB; ++b) { RED[(F.wave * NMODB + b) * 128 + 2 * F.lane] = acc[b][0]; RED[(F.wave * NMODB + b) * 128 + 2 * F.lane + 1] = acc[b][1]; }
        __syncthreads();
        float* MOD = (float*)(ws + WS_MOD);
        for (int idx = F.tid; idx < NMODB * 128; idx += NWAVES * 64) { const int b = idx >> 7, j = idx & 127; float s = 0.f;
#pragma unroll
            for (int w = 0; w < 8; ++w) s += RED[(w * NMODB + b) * 128 + j];
            MOD[(size_t)(l * NMODB + b) * MODW + j0 + j] = s + A->in[I_BADA][(size_t)l * MODW + j0 + j]; }
        __syncthreads();
    }
    { const int gt = F.bid * (NWAVES * 64) + F.tid, ngt = F.G * NWAVES * 64;
      for (int idx = gt; idx < NLAYER * 56 * 1024; idx += ngt) { const int l = idx / (56 * 1024), rem = idx % (56 * 1024), ch = rem >> 10, j = rem & 1023;
          const float* src; bf16* dst; int k0;
          bf16* LB = (bf16*)(ws + WS_LORA + (size_t)l * LORA_LAYER);
          if (ch < 12) { k0 = 8 * ch; src = A->in[I_W2] + ((size_t)l * 96 + k0) * 1024 + j; dst = LB + (size_t)j * 96 + k0; }
          else if (ch < 24) { k0 = 8 * (ch - 12); src = A->in[I_A2] + ((size_t)l * 96 + k0) * 1024 + j; dst = LB + (size_t)1024 * 96 + (size_t)j * 96 + k0; }
          else { k0 = 8 * (ch - 24); src = A->in[I_G2] + ((size_t)l * 256 + k0) * 1024 + j; dst = LB + (size_t)2 * 1024 * 96 + (size_t)j * 256 + k0; }
          v4u o; o.x = pk2(src[0], src[1024]); o.y = pk2(src[2048], src[3072]); o.z = pk2(src[4096], src[5120]); o.w = pk2(src[6144], src[7168]);
          *(GAS v4u*)dst = o; }
      for (int idx = gt; idx < NLAYER * 64 * DMOD / 8; idx += ngt) { const int l = idx / (64 * DMOD / 8), rem = idx % (64 * DMOD / 8);
          *(GAS v4u*)((bf16*)(ws + WS_WIN) + (size_t)l * NIN_PAD * DMOD + (size_t)NRC * DMOD + (size_t)rem * 8) = (v4u){0u, 0u, 0u, 0u}; }
    }
    __syncthreads();
    LAS float* scr = (LAS float*)(F.lds + F.wave * 16384);
    const int gw = F.bid * NWAVES + F.wave, NGW = F.G * NWAVES;
    constexpr int IT_IN = 32 * (NIN / 32), IT_OUT = 32 * 64, IT_UP = 32 * (NUP / 32), IT_DN = (DFF / 64) * 64, IT_L = IT_IN + IT_OUT + IT_UP + IT_DN;
    for (int it = gw; it < NLAYER * IT_L; it += NGW) {
        const int l = it / IT_L; int r = it % IT_L;
        if (r < IT_IN) { const int nb = r % (NIN / 32), kb = r / (NIN / 32), n0 = 32 * nb;
            transpose_item(A->in[I_WIN] + (size_t)l * DMOD * NIN, DMOD, NIN, (bf16*)(ws + WS_WIN) + (size_t)l * NIN_PAD * DMOD, n0 < NRC ? n0 : n0 + 64, scr, kb, n0, F.lane); continue; }
        r -= IT_IN;
        if (r < IT_OUT) { const int nb = r % 64, kb = r / 64;
            transpose_item(A->in[I_WOUT] + (size_t)l * DMOD * DMOD, DMOD, DMOD, (bf16*)(ws + WS_WOUT) + (size_t)l * DMOD * DMOD, 32 * nb, scr, kb, 32 * nb, F.lane); continue; }
        r -= IT_OUT;
        if (r < IT_UP) { const int nb = r % (NUP / 32), kb = r / (NUP / 32), n0 = 32 * nb; const int j = n0 < DFF ? n0 : n0 - DFF;
            const int dr = (j >> 7) * 256 + (n0 < DFF ? 0 : 128) + (j & 127);
            transpose_item(A->in[I_FUP] + (size_t)l * DMOD * NUP, DMOD, NUP, (bf16*)(ws + WS_WUP) + (size_t)l * NUP * DMOD, dr, scr, kb, n0, F.lane); continue; }
        r -= IT_UP;
        { const int nb = r % 64, kb = r / 64;
            transpose_item(A->in[I_FDN] + (size_t)l * DFF * DMOD, DFF, DMOD, (bf16*)(ws + WS_WDN) + (size_t)l * DMOD * DFF, 32 * nb, scr, kb, 32 * nb, F.lane); }
    }
}

__device__ __forceinline__ void ph_norm(Frame& F, int l, int mode, int nslab) {
    PHASE_ENTRY();
    const int gw = F.bid * NWAVES + F.wave, NGW = F.G * NWAVES;
    const float* X = (const float*)(A->ws + WS_X); bf16* H = (bf16*)(A->ws + WS_H);
    const float* g = (mode == 0 ? A->in[I_GMIX] + (size_t)l * DMOD : mode == 1 ? A->in[I_GFFN] + (size_t)l * DMOD : A->in[I_GFIN]);
    f32x4 gv[8];
#pragma unroll
    for (int j = 0; j < 8; ++j) gv[j] = *(const GAS f32x4*)(g + 4 * F.lane + 256 * j);
    for (int m = gw; m < MT; m += NGW) {
        const float* xr = (mode == 0 && l == 0) ? (m < MP ? A->in[I_XP] + (size_t)m * DMOD : A->in[I_XS] + (size_t)(m - MP) * DMOD) : X + (size_t)m * DMOD;
        f32x4 v[8]; float ss = 0.f;
#pragma unroll
        for (int j = 0; j < 8; ++j) v[j] = *(const GAS f32x4*)(xr + 4 * F.lane + 256 * j);
        f32x4 shv[8], scv[8];
        if (mode < 2) { const int bidx0 = m < MP ? 0 : 1 + ((m - MP) >> 4);
            const float* mod0 = (const float*)(A->ws + WS_MOD) + (size_t)(l * NMODB + bidx0) * MODW + (mode == 0 ? 0 : 3 * DMOD);
#pragma unroll
            for (int j = 0; j < 8; ++j) { shv[j] = *(const GAS f32x4*)(mod0 + 4 * F.lane + 256 * j); scv[j] = *(const GAS f32x4*)(mod0 + DMOD + 4 * F.lane + 256 * j); } }
        if (m >= MP && nslab > 0) { const float* sl = (const float*)(A->ws + WS_SLAB) + (size_t)(m - MP) * DMOD;
            for (int s = 0; s < nslab; ++s)
#pragma unroll
                for (int j = 0; j < 8; ++j) v[j] += *(const GAS f32x4*)(sl + (size_t)s * 256 * DMOD + 4 * F.lane + 256 * j);
            if (mode < 2) { float* xw = (float*)(A->ws + WS_X) + (size_t)m * DMOD;
#pragma unroll
                for (int j = 0; j < 8; ++j) *(GAS f32x4*)(xw + 4 * F.lane + 256 * j) = v[j]; } }
#pragma unroll
        for (int j = 0; j < 8; ++j) ss += (v[j].x * v[j].x + v[j].y * v[j].y) + (v[j].z * v[j].z + v[j].w * v[j].w);
        const float rstd = 1.f / sqrtf(wave_sum(ss) * (1.f / DMOD) + 1e-6f);
        if (mode < 2) {
            const int bidx = m < MP ? 0 : 1 + ((m - MP) >> 4);
            const float* mod = (const float*)(A->ws + WS_MOD) + (size_t)(l * NMODB + bidx) * MODW + (mode == 0 ? 0 : 3 * DMOD);
            GAS unsigned long long* o8 = (GAS unsigned long long*)(H + (size_t)m * DMOD) + F.lane;
#pragma unroll
            for (int j = 0; j < 8; ++j) { const f32x4 sh = shv[j], sc = scv[j];
                const f32x4 y = (v[j] * rstd * gv[j]) * (sc + 1.0f) + sh;
                o8[64 * j] = (unsigned long long)pk2(y.x, y.y) | ((unsigned long long)pk2(y.z, y.w) << 32); }
        } else {
            float* o = (m < MP) ? A->out + O_YP + (size_t)m * DMOD : A->out + O_YS + (size_t)(m - MP) * DMOD;
#pragma unroll
            for (int j = 0; j < 8; ++j) __builtin_nontemporal_store(v[j] * rstd * gv[j], (GAS f32x4*)(o + 4 * F.lane + 256 * j));
        }
    }
}
typedef float f32x4m __attribute__((ext_vector_type(4)));
__device__ __forceinline__ void mm_tiles(f32x4 (&acc)[2], const LAS unsigned char* X, const LAS unsigned char* Y, int wave, int lane) {
    const int mt = wave >> 1, nt0 = 2 * (wave & 1), c = lane & 15, q = lane >> 4;
    const LAS unsigned char* xp = X + (16 * mt + c) * 144 + q * 16;
    const bf16x8 x0 = *(const LAS bf16x8*)xp, x1 = *(const LAS bf16x8*)(xp + 64);
#pragma unroll
    for (int t = 0; t < 2; ++t) { const LAS unsigned char* yp = Y + (16 * (nt0 + t) + c) * 144 + q * 16;
        const bf16x8 y0 = *(const LAS bf16x8*)yp, y1 = *(const LAS bf16x8*)(yp + 64);
        acc[t] = __builtin_amdgcn_mfma_f32_16x16x32_bf16(y0, x0, acc[t], 0, 0, 0);
        acc[t] = __builtin_amdgcn_mfma_f32_16x16x32_bf16(y1, x1, acc[t], 0, 0, 0); }
}
__device__ __forceinline__ void st_tiles(LAS unsigned char* D, const f32x4 (&acc)[2], int wave, int lane) {
    const int mt = wave >> 1, nt0 = 2 * (wave & 1), c = lane & 15, q = lane >> 4;
#pragma unroll
    for (int t = 0; t < 2; ++t) { v2u w; w.x = pk2(acc[t][0], acc[t][1]); w.y = pk2(acc[t][2], acc[t][3]); *(LAS v2u*)(D + (16 * mt + c) * 144 + (16 * (nt0 + t) + 4 * q) * 2) = w; }
}
#define RW_ZERO(a) do { a[0] = (f32x4){0.f, 0.f, 0.f, 0.f}; a[1] = a[0]; } while (0)
template <int MODE> __device__ __forceinline__ void mask_tiles(f32x4 (&acc)[2], int wave, int lane) {
    const int m = 16 * (wave >> 1) + (lane & 15), nb = 32 * (wave & 1) + 4 * (lane >> 4);
#pragma unroll
    for (int t = 0; t < 2; ++t)
#pragma unroll
        for (int i = 0; i < 4; ++i) { const int n = nb + 16 * t + i; const bool keep = MODE == 0 ? (n < m) : MODE == 1 ? (n > m) : (n <= m); if (!keep) acc[t][i] = 0.f; }
}

__device__ __forceinline__ void rwkv_passA_unit(ArgsP A, Frame& F, int l, int u, bool reuse) {
    unsigned char* ws = A->ws;
    const int tid = F.tid, lane = F.lane, wave = F.wave;
    const float* PR = (const float*)(ws + WS_PR);
    int h, row0, nvalid; const float* prev0;
    if (u < 2048) { h = u >> 7; const int c = u & 127; row0 = 64 * c; nvalid = 64; prev0 = c > 0 ? PR + (size_t)(row0 - 1) * NRC_PAD : nullptr; }
    else { const int su = u - 2048, sb = su >> 4; h = su & 15; row0 = MP + sb * TS; nvalid = TS; prev0 = A->in[I_SSHIFT] + (size_t)(l * NSB + sb) * NRC; }
    const float* mu = A->in[I_MU] + (size_t)l * NRC;
    LAS unsigned char* L = F.lds;
#define SL(i) (L + (i) * RW_SLOT)
    LAS unsigned short* TW = (LAS unsigned short*)(L), *XA = (LAS unsigned short*)(L + 13312), *SG = (LAS unsigned short*)(L + 26624);
    LAS float* WLf = (LAS float*)(L + 64512), *ALf = (LAS float*)(L + 81920), *GLf = (LAS float*)(L + 99328);
    LAS float* AT32 = (LAS float*)(L + 92160), *A32 = (LAS float*)(L + 109568), *AKV32 = (LAS float*)(L);
    LAS unsigned char* sAAK = L + 126976, *sARB = L + 136192, *sARK = L + 145408;
    LAS float* SEG = (LAS float*)(L + 154624), *WLV = SEG + 512;
    bf16x8 yg_[8][2];
    { const int nt0 = 2 * (wave & 1), c = lane & 15, q = lane >> 4; const bf16* LB = (const bf16*)(ws + WS_LORA + (size_t)l * LORA_LAYER);
#pragma unroll
      for (int t = 0; t < 2; ++t) { const int j = h * 64 + 16 * (nt0 + t) + c;
#pragma unroll
          for (int s = 0; s < 8; ++s) yg_[s][t] = *(const GAS bf16x8*)(LB + (size_t)2 * 1024 * 96 + (size_t)j * 256 + 8 * q + 32 * s); } }
    { unsigned char* lscr = ws + WS_LSCR + (size_t)F.bid * 61440;
      if (reuse) { v4u tmp[8];
#pragma unroll
          for (int b = 0; b < 8; ++b) { const int i = tid + b * (NWAVES * 64); if (i < 60416 / 16) tmp[b] = *(const GAS v4u*)(lscr + i * 16); }
#pragma unroll
          for (int b = 0; b < 8; ++b) { const int i = tid + b * (NWAVES * 64); if (i < 60416 / 16) *(LAS v4u*)(L + i * 16) = tmp[b]; } }
      else {
        for (int it = 0; it < 56; it += 8) { float cur[8], prv[8], mm_[8];
#pragma unroll
            for (int b = 0; b < 8; ++b) { const int idx = tid + (it + b) * (NWAVES * 64), t = idx / 448, col = 3072 + idx % 448; cur[b] = 0.f; prv[b] = 0.f; mm_[b] = mu[col];
                if (t < nvalid) { cur[b] = PR[(size_t)(row0 + t) * NRC_PAD + col]; prv[b] = t > 0 ? PR[(size_t)(row0 + t - 1) * NRC_PAD + col] : (prev0 ? prev0[col] : 0.f); } }
#pragma unroll
            for (int b = 0; b < 8; ++b) { const int idx = tid + (it + b) * (NWAVES * 64), t = idx / 448, cc = idx % 448; const float xm = cur[b] + (prv[b] - cur[b]) * mm_[b];
                if (cc < 96) { const float e = __expf(2.f * xm); TW[t * 104 + cc] = (unsigned short)f2bf(1.f - 2.f * __builtin_amdgcn_rcpf(e + 1.f)); }
                else if (cc < 192) XA[t * 104 + cc - 96] = (unsigned short)f2bf(xm);
                else SG[t * 264 + cc - 192] = (unsigned short)f2bf(sigmoidf_(xm)); } }
        if (u < 2048) { __syncthreads(); for (int i = tid; i < 60416 / 16; i += NWAVES * 64) *(GAS v4u*)(lscr + i * 16) = *(const LAS v4u*)(L + i * 16); }
      } }
    __syncthreads();
    { const int mt = wave >> 1, nt0 = 2 * (wave & 1), c = lane & 15, q = lane >> 4;
      const bf16* LB = (const bf16*)(ws + WS_LORA + (size_t)l * LORA_LAYER);
      f32x4 aw[2], aa[2], ag[2]; RW_ZERO(aw); RW_ZERO(aa); RW_ZERO(ag);
#pragma unroll
      for (int s = 0; s < 3; ++s) { const bf16x8 xw = *(const LAS bf16x8*)((LAS unsigned char*)TW + (16 * mt + c) * 208 + (8 * q + 32 * s) * 2), xa = *(const LAS bf16x8*)((LAS unsigned char*)XA + (16 * mt + c) * 208 + (8 * q + 32 * s) * 2);
#pragma unroll
          for (int t = 0; t < 2; ++t) { const int j = h * 64 + 16 * (nt0 + t) + c;
              const bf16x8 yw = *(const GAS bf16x8*)(LB + (size_t)j * 96 + 8 * q + 32 * s), ya = *(const GAS bf16x8*)(LB + (size_t)1024 * 96 + (size_t)j * 96 + 8 * q + 32 * s);
              aw[t] = __builtin_amdgcn_mfma_f32_16x16x32_bf16(yw, xw, aw[t], 0, 0, 0); aa[t] = __builtin_amdgcn_mfma_f32_16x16x32_bf16(ya, xa, aa[t], 0, 0, 0); } }
#pragma unroll
      for (int s = 0; s < 8; ++s) { const bf16x8 xg = *(const LAS bf16x8*)((LAS unsigned char*)SG + (16 * mt + c) * 528 + (8 * q + 32 * s) * 2);
#pragma unroll
          for (int t = 0; t < 2; ++t) { const int j = h * 64 + 16 * (nt0 + t) + c; const bf16x8 yg = yg_[s][t];
              ag[t] = __builtin_amdgcn_mfma_f32_16x16x32_bf16(yg, xg, ag[t], 0, 0, 0); } }
#pragma unroll
      for (int t = 0; t < 2; ++t) { const int o = (16 * mt + c) * 68 + 16 * (nt0 + t) + 4 * q; *(LAS f32x4*)(WLf + o) = aw[t]; *(LAS f32x4*)(ALf + o) = aa[t]; *(LAS f32x4*)(GLf + o) = ag[t]; }
    }
    __syncthreads();
    {
        const int j = lane, hj = h * 64 + j, seg = wave;
        const float mu_r = mu[hj], mu_k = mu[1024 + hj], mu_v = mu[2048 + hj];
        const float w0 = A->in[I_W0][l * 1024 + hj], a0 = A->in[I_A0][l * 1024 + hj], kkw = A->in[I_KK][l * 1024 + hj], kaw = A->in[I_KA][l * 1024 + hj], rkw = A->in[I_RK][l * 1024 + hj];
        const float lnw = A->in[I_LNW][l * 1024 + hj], lnb = A->in[I_LNB][l * 1024 + hj];
        float logw[8], xr[8], xv[8], kk[8], bb[8], km[8], cs[8];
        unsigned short* G1 = (unsigned short*)(ws + WS_G1); unsigned short* G2 = (unsigned short*)(ws + WS_G2);
        float run = 0.f;
        float cr9[9], ck9[9], cv9[9];
#pragma unroll
        for (int i = 0; i < 9; ++i) { const int t = 8 * seg + i - 1; const float* pr = (t < 0) ? prev0 : (t < nvalid ? PR + (size_t)(row0 + t) * NRC_PAD : nullptr);
            cr9[i] = pr ? pr[hj] : 0.f; ck9[i] = pr ? pr[1024 + hj] : 0.f; cv9[i] = pr ? pr[2048 + hj] : 0.f; }
        asm volatile("" ::: "memory");
#pragma unroll
        for (int i = 0; i < 8; ++i) { const int t = 8 * seg + i; const bool valid = t < nvalid;
            float r_ = 0.f, k_ = 0.f, v_ = 0.f;
            if (valid) { const float cr = cr9[i + 1], ck = ck9[i + 1], cv = cv9[i + 1], qr = cr9[i], qk = ck9[i], qv = cv9[i];
                r_ = cr + (qr - cr) * mu_r; k_ = ck + (qk - ck) * mu_k; v_ = cv + (qv - cv) * mu_v; }
            const float wl = WLf[t * 68 + j], al = ALf[t * 68 + j], gl = GLf[t * 68 + j];
            const float lw = valid ? -0.6065306597126334f * sigmoidf_(w0 + wl) : 0.f;
            const float a_ = sigmoidf_(a0 + al);
            const float kkr = k_ * kkw; const float nrm = wave_sum(kkr * kkr); const float kk_ = kkr * __builtin_amdgcn_rsqf(fmaxf(nrm, 1e-24f));
            const float km_ = k_ * (1.f + (a_ - 1.f) * kaw);
            const float ct = wave_sum(r_ * km_ * rkw);
            if (valid) { const size_t go = (size_t)(row0 + t) * 1024 + hj; G1[go] = (unsigned short)f2bf(lnw * gl); G2[go] = (unsigned short)f2bf((lnb + ct * v_) * gl); }
            run += lw; logw[i] = lw; cs[i] = run; xr[i] = r_; xv[i] = v_; kk[i] = kk_; bb[i] = kk_ * a_; km[i] = km_; }
        SEG[seg * 64 + j] = run;
        __syncthreads();
        float off = 0.f, tot = 0.f;
#pragma unroll
        for (int s = 0; s < 8; ++s) { const float v = SEG[s * 64 + j]; tot += v; if (s < seg) off += v; }
        if (seg == 0) WLV[j] = __expf(tot);
        LAS unsigned short* AT = (LAS unsigned short*)SL(0), *ATL = (LAS unsigned short*)SL(1), *BH = (LAS unsigned short*)SL(2), *BHL = (LAS unsigned short*)SL(3), *KH = (LAS unsigned short*)SL(4), *RT = (LAS unsigned short*)SL(5);
        unsigned pvt[4], pbt[4], pbl[4], pkt[4];
#pragma unroll
        for (int i = 0; i < 8; i += 2) { float v2[2], bt2[2], bl2[2], kt2[2];
#pragma unroll
            for (int e = 0; e < 2; ++e) { const int ii = i + e, t = 8 * seg + ii; const float ci = off + cs[ii], ce = ci - logw[ii];
                const float winc = __expf(ci), wexc = __expf(ce), winv = __expf(-ci), wrem = __expf(tot - ci);
                const float at = -kk[ii] * wexc, rt = xr[ii] * winc, bh = bb[ii] * winv, kh = km[ii] * winv, bt = bb[ii] * wrem, kt = km[ii] * wrem;
                const unsigned ath = f2bf(at), bhh = f2bf(bh), bth = f2bf(bt);
                AT[t * RW_STRIDE + j] = (unsigned short)ath; ATL[t * RW_STRIDE + j] = (unsigned short)f2bf(at - bf2f((unsigned short)ath)); AT32[t * 68 + j] = at;
                BH[t * RW_STRIDE + j] = (unsigned short)bhh; BHL[t * RW_STRIDE + j] = (unsigned short)f2bf(bh - bf2f((unsigned short)bhh));
                KH[t * RW_STRIDE + j] = (unsigned short)f2bf(kh); RT[t * RW_STRIDE + j] = (unsigned short)f2bf(rt);
                v2[e] = xv[ii]; bt2[e] = bf2f((unsigned short)bth); bl2[e] = bt - bf2f((unsigned short)bth); kt2[e] = kt; }
            pvt[i >> 1] = pk2(v2[0], v2[1]); pbt[i >> 1] = pk2(bt2[0], bt2[1]); pbl[i >> 1] = pk2(bl2[0], bl2[1]); pkt[i >> 1] = pk2(kt2[0], kt2[1]); }
        *(LAS v4u*)(SL(6) + j * 144 + seg * 16) = (v4u){pvt[0], pvt[1], pvt[2], pvt[3]};
        *(LAS v4u*)(SL(7) + j * 144 + seg * 16) = (v4u){pbt[0], pbt[1], pbt[2], pbt[3]};
        *(LAS v4u*)(SL(8) + j * 144 + seg * 16) = (v4u){pbl[0], pbl[1], pbl[2], pbl[3]};
        *(LAS v4u*)(SL(9) + j * 144 + seg * 16) = (v4u){pkt[0], pkt[1], pkt[2], pkt[3]};
    }
    __syncthreads();
    { f32x4 a[2]; const int mt = wave >> 1, nt0 = 2 * (wave & 1), c = lane & 15, q = lane >> 4, m = 16 * mt + c;
      RW_ZERO(a); mm_tiles(a, SL(0), SL(2), wave, lane); mm_tiles(a, SL(1), SL(2), wave, lane); mm_tiles(a, SL(0), SL(3), wave, lane); mask_tiles<0>(a, wave, lane);
#pragma unroll
      for (int t = 0; t < 2; ++t) *(LAS f32x4*)(A32 + m * 68 + 16 * (nt0 + t) + 4 * q) = a[t];
      RW_ZERO(a); mm_tiles(a, SL(0), SL(4), wave, lane); mask_tiles<0>(a, wave, lane); st_tiles(sAAK, a, wave, lane);
      RW_ZERO(a); mm_tiles(a, SL(5), SL(2), wave, lane); mask_tiles<2>(a, wave, lane); st_tiles(sARB, a, wave, lane);
      RW_ZERO(a); mm_tiles(a, SL(5), SL(4), wave, lane); mask_tiles<2>(a, wave, lane); st_tiles(sARK, a, wave, lane); }
    __syncthreads();
    { f32x4 a[2]; const int mt = wave >> 1, nt0 = 2 * (wave & 1), c = lane & 15, q = lane >> 4, m = 16 * mt + c;
      RW_ZERO(a); mm_tiles(a, sAAK, SL(6), wave, lane);
#pragma unroll
      for (int t = 0; t < 2; ++t) *(LAS f32x4*)(AKV32 + m * 68 + 16 * (nt0 + t) + 4 * q) = a[t]; }
    __syncthreads();
    { const int c = lane & 15, q = lane >> 4;
      LAS float* R = (wave < 4) ? AT32 + 16 * wave : AKV32 + 16 * (wave - 4);
      LAS float* Rc = (wave == 0 ? AT32 : AKV32) + lane;
#pragma unroll
      for (int i = 0; i < 4; ++i) {
          if (i > 0) {
              f32x4 acc;
#pragma unroll
              for (int g = 0; g < 4; ++g) acc[g] = R[(16 * i + 4 * q + g) * 68 + c];
#pragma unroll
              for (int j = 0; j < i; ++j)
#pragma unroll
                  for (int s = 0; s < 4; ++s) { const float a = A32[(16 * i + c) * 68 + 16 * j + 4 * s + q], b = R[(16 * j + 4 * s + q) * 68 + c];
                      acc = __builtin_amdgcn_mfma_f32_16x16x4f32(a, b, acc, 0, 0, 0); }
#pragma unroll
              for (int g = 0; g < 4; ++g) R[(16 * i + 4 * q + g) * 68 + c] = acc[g];
              __syncthreads();
          }
          if (wave < 2) {
              const LAS float* a32 = A32 + (16 * i) * 68 + 16 * i; asm volatile("" : "+v"(a32));
              float x[16];
#pragma unroll
              for (int rr = 0; rr < 16; ++rr) x[rr] = Rc[(16 * i + rr) * 68];
#pragma unroll
              for (int rg = 0; rg < 4; ++rg) {
                  f32x4 cf[4][4];
#pragma unroll
                  for (int r4 = 0; r4 < 4; ++r4)
#pragma unroll
                      for (int g = 0; g <= rg; ++g) if (4 * g < 4 * rg + r4) cf[r4][g] = *(const LAS f32x4*)(a32 + (4 * rg + r4) * 68 + 4 * g);
#pragma unroll
                  for (int r4 = 0; r4 < 4; ++r4) { const int rr = 4 * rg + r4; if (rr == 0) continue; float s0 = x[rr], s1 = 0.f;
#pragma unroll
                      for (int g = 0; g <= rg; ++g) if (4 * g < rr) { s0 += cf[r4][g][0] * x[4 * g]; if (4 * g + 1 < rr) s1 += cf[r4][g][1] * x[4 * g + 1]; if (4 * g + 2 < rr) s0 += cf[r4][g][2] * x[4 * g + 2]; if (4 * g + 3 < rr) s1 += cf[r4][g][3] * x[4 * g + 3]; }
                      x[rr] = s0 + s1; }
                  asm volatile("" ::: "memory");
              }
#pragma unroll
              for (int rr = 1; rr < 16; ++rr) Rc[(16 * i + rr) * 68] = x[rr];
          }
          __syncthreads();
      }
      { const int cc = tid & 127, g16 = tid >> 7; const LAS float* src = (cc < 64 ? AT32 + cc : AKV32 + (cc - 64)) + (16 * g16) * 68;
        unsigned hh[16]; float lo[16];
#pragma unroll
        for (int rr = 0; rr < 16; ++rr) { const float v = src[rr * 68]; hh[rr] = f2bf(v); lo[rr] = v - bf2f((unsigned short)hh[rr]); }
        LAS unsigned char* dh = (cc < 64 ? SL(2) + cc * 144 : SL(4) + (cc - 64) * 144) + g16 * 32;
        *(LAS v4u*)dh = (v4u){hh[0] | (hh[1] << 16), hh[2] | (hh[3] << 16), hh[4] | (hh[5] << 16), hh[6] | (hh[7] << 16)};
        *(LAS v4u*)(dh + 16) = (v4u){hh[8] | (hh[9] << 16), hh[10] | (hh[11] << 16), hh[12] | (hh[13] << 16), hh[14] | (hh[15] << 16)};
        if (cc < 64) { LAS unsigned char* dl = SL(3) + cc * 144 + g16 * 32;
            *(LAS v4u*)dl = (v4u){pk2(lo[0], lo[1]), pk2(lo[2], lo[3]), pk2(lo[4], lo[5]), pk2(lo[6], lo[7])};
            *(LAS v4u*)(dl + 16) = (v4u){pk2(lo[8], lo[9]), pk2(lo[10], lo[11]), pk2(lo[12], lo[13]), pk2(lo[14], lo[15])}; } }
    }
    __syncthreads();
    { const int mt = wave >> 1, nt0 = 2 * (wave & 1), c = lane & 15, q = lane >> 4, m = 16 * mt + c;
      float* PTg = (float*)(ws + WS_PT32) + (size_t)u * 4096; float* QQg = (float*)(ws + WS_QQ) + (size_t)u * 4096; bf16* RPg = (bf16*)(ws + WS_RP) + (size_t)u * 4096; unsigned short* YVg = (unsigned short*)(ws + WS_YV) + (size_t)u * 4096;
      f32x4 a[2];
      RW_ZERO(a); mm_tiles(a, sARB, SL(2), wave, lane); mm_tiles(a, sARB, SL(3), wave, lane);
#pragma unroll
      for (int t = 0; t < 2; ++t) { const int n = 16 * (nt0 + t) + 4 * q; const v2u rr = *(const LAS v2u*)(SL(5) + m * 144 + n * 2);
          v2u w; w.x = pk2(a[t][0] + bf2f((unsigned short)(rr.x & 0xffffu)), a[t][1] + bf2f((unsigned short)(rr.x >> 16))); w.y = pk2(a[t][2] + bf2f((unsigned short)(rr.y & 0xffffu)), a[t][3] + bf2f((unsigned short)(rr.y >> 16)));
          *(GAS v2u*)(RPg + m * 64 + n) = w; }
      RW_ZERO(a); mm_tiles(a, sARB, SL(4), wave, lane); mm_tiles(a, sARK, SL(6), wave, lane);
#pragma unroll
      for (int t = 0; t < 2; ++t) { v2u w; w.x = pk2(a[t][0], a[t][1]); w.y = pk2(a[t][2], a[t][3]); *(GAS v2u*)(YVg + m * 64 + 16 * (nt0 + t) + 4 * q) = w; }
      if (tid < 64) ((float*)(ws + WS_WL))[(size_t)u * 64 + tid] = WLV[tid];
      RW_ZERO(a); mm_tiles(a, SL(7), SL(2), wave, lane); mm_tiles(a, SL(8), SL(2), wave, lane); mm_tiles(a, SL(7), SL(3), wave, lane);
#pragma unroll
      for (int t = 0; t < 2; ++t) *(GAS f32x4*)(PTg + m * 64 + 16 * (nt0 + t) + 4 * q) = a[t];
      RW_ZERO(a); mm_tiles(a, SL(4), SL(7), wave, lane); mm_tiles(a, SL(6), SL(9), wave, lane);
#pragma unroll
      for (int t = 0; t < 2; ++t) *(GAS f32x4*)(QQg + m * 64 + 16 * (nt0 + t) + 4 * q) = a[t];
    }
    __syncthreads();
#undef SL
}
__device__ __forceinline__ void wait_count(Frame& F, unsigned* cnt, unsigned target) {
    if (F.tid == 0) { unsigned* bar = (unsigned*)(F.ctl + CW_BAR);
        XB_SPIN(xb_ld(cnt) < target, bar);
        __builtin_amdgcn_fence(__ATOMIC_ACQUIRE, "agent"); asm volatile("s_waitcnt vmcnt(0)" ::: "memory"); }
    __syncthreads();
}
__device__ __forceinline__ void ph_rwkv_passA(Frame& F, int l) {
    PHASE_ENTRY();
    if (F.G == 256) wait_count(F, (unsigned*)(F.ctl + CW_QUEUE + 1024 + 64 * l), (unsigned)((MT / 256) * (NRC_PAD / 256)));
    int pu = -1;
    int u0 = F.bid, ustep = F.G, uend = RW_UNITS;
    if (F.G == 256) {
        const int r = F.bid & 127, sec = F.bid >> 7, nf = (r < (MT / 256) * (NIN_PAD / 256) - 768) ? 8 : 9;
        u0 = r + 128 * (sec ? nf : 0); ustep = 128; uend = r + 128 * (sec ? 18 : nf); }
    for (int u = u0; u < uend; u += ustep) { const bool reuse = (pu >= 0 && u < 2048 && (u & 127) == (pu & 127)); rwkv_passA_unit(A, F, l, u, reuse); pu = u; }
}

struct ChainOps { f32x4 pt[4]; f32x4 qq[2]; f32x4 wl; };
__device__ __forceinline__ void rwkv_chain_load(ChainOps& o, const float* PTg, const float* QQg, const float* WLg, int wave, int lane) {
    const int tk = wave & 3, tv0 = 2 * (wave >> 2), c = lane & 15, q = lane >> 4;
#pragma unroll
    for (int s = 0; s < 2; ++s) { o.pt[2 * s] = *(const GAS f32x4*)(PTg + (16 * tk + c) * 64 + 8 * q + 32 * s); o.pt[2 * s + 1] = *(const GAS f32x4*)(PTg + (16 * tk + c) * 64 + 8 * q + 32 * s + 4); }
#pragma unroll
    for (int t = 0; t < 2; ++t) o.qq[t] = *(const GAS f32x4*)(QQg + (16 * (tv0 + t) + c) * 64 + 16 * tk + 4 * q);
    o.wl = *(const GAS f32x4*)(WLg + 16 * tk + 4 * q);
}
__device__ __forceinline__ void rwkv_chain_step(f32x4 (&acc)[2], const ChainOps& o, const LAS unsigned char* Shi, const LAS unsigned char* Slo, int wave, int lane) {
    const int tv0 = 2 * (wave >> 2), c = lane & 15, q = lane >> 4;
    bf16x8 ph[2], pl[2];
#pragma unroll
    for (int s = 0; s < 2; ++s) { const f32x4 x0 = o.pt[2 * s], x1 = o.pt[2 * s + 1];
        unsigned h[8]; float lo[8];
#pragma unroll
        for (int i = 0; i < 4; ++i) { h[i] = f2bf(x0[i]); lo[i] = x0[i] - bf2f((unsigned short)h[i]); h[4 + i] = f2bf(x1[i]); lo[4 + i] = x1[i] - bf2f((unsigned short)h[4 + i]); }
        ph[s] = __builtin_bit_cast(bf16x8, (v4u){h[0] | (h[1] << 16), h[2] | (h[3] << 16), h[4] | (h[5] << 16), h[6] | (h[7] << 16)});
        pl[s] = __builtin_bit_cast(bf16x8, (v4u){pk2(lo[0], lo[1]), pk2(lo[2], lo[3]), pk2(lo[4], lo[5]), pk2(lo[6], lo[7])}); }
#pragma unroll
    for (int t = 0; t < 2; ++t) { const int v = 16 * (tv0 + t) + c;
        f32x4 a = o.qq[t] + acc[t] * o.wl;
        const bf16x8 s0 = *(const LAS bf16x8*)(Shi + v * 144 + q * 16), s1 = *(const LAS bf16x8*)(Shi + v * 144 + q * 16 + 64);
        const bf16x8 l0 = *(const LAS bf16x8*)(Slo + v * 144 + q * 16), l1 = *(const LAS bf16x8*)(Slo + v * 144 + q * 16 + 64);
        a = __builtin_amdgcn_mfma_f32_16x16x32_bf16(ph[0], s0, a, 0, 0, 0); a = __builtin_amdgcn_mfma_f32_16x16x32_bf16(ph[1], s1, a, 0, 0, 0);
        a = __builtin_amdgcn_mfma_f32_16x16x32_bf16(ph[0], l0, a, 0, 0, 0); a = __builtin_amdgcn_mfma_f32_16x16x32_bf16(ph[1], l1, a, 0, 0, 0);
        a = __builtin_amdgcn_mfma_f32_16x16x32_bf16(pl[0], s0, a, 0, 0, 0); a = __builtin_amdgcn_mfma_f32_16x16x32_bf16(pl[1], s1, a, 0, 0, 0);
        acc[t] = a; }
}
__device__ __forceinline__ void rwkv_state_to_lds(const f32x4 (&acc)[2], LAS unsigned char* Shi, LAS unsigned char* Slo, int wave, int lane) {
    const int tk = wave & 3, tv0 = 2 * (wave >> 2), c = lane & 15, q = lane >> 4;
#pragma unroll
    for (int t = 0; t < 2; ++t) { unsigned h[4]; float lo[4];
#pragma unroll
        for (int i = 0; i < 4; ++i) { h[i] = f2bf(acc[t][i]); lo[i] = acc[t][i] - bf2f((unsigned short)h[i]); }
        const int o = (16 * (tv0 + t) + c) * 144 + (16 * tk + 4 * q) * 2;
        *(LAS v2u*)(Shi + o) = (v2u){h[0] | (h[1] << 16), h[2] | (h[3] << 16)}; *(LAS v2u*)(Slo + o) = (v2u){pk2(lo[0], lo[1]), pk2(lo[2], lo[3])}; }
}
__device__ __forceinline__ void ph_rwkv_chain(Frame& F, int l) {
    PHASE_ENTRY();
    unsigned char* ws = A->ws; const int tid = F.tid, lane = F.lane, wave = F.wave;
    const int tk = wave & 3, tv0 = 2 * (wave >> 2), c = lane & 15, q = lane >> 4;
    LAS unsigned char* HI0 = F.lds, *LO0 = F.lds + RW_SLOT, *HI1 = F.lds + 2 * RW_SLOT, *LO1 = F.lds + 3 * RW_SLOT;
    const float* PT = (const float*)(ws + WS_PT32); const float* QQ = (const float*)(ws + WS_QQ); const float* WL = (const float*)(ws + WS_WL); bf16* SC = (bf16*)(ws + WS_SC);
    if (F.bid < 16) {
        const int h = F.bid;
        f32x4 acc[2]; RW_ZERO(acc);
        rwkv_state_to_lds(acc, HI0, LO0, wave, lane);
        __syncthreads();
        ChainOps ops; rwkv_chain_load(ops, PT + (size_t)(h * 128) * 4096, QQ + (size_t)(h * 128) * 4096, WL + (size_t)(h * 128) * 64, wave, lane);
        for (int cc = 0; cc < 128; ++cc) { const int u = h * 128 + cc; LAS unsigned char* chi = (cc & 1) ? HI1 : HI0, *clo = (cc & 1) ? LO1 : LO0, *nhi = (cc & 1) ? HI0 : HI1, *nlo = (cc & 1) ? LO0 : LO1;
            { const int row = tid >> 3, ch = tid & 7; *(GAS v4u*)((unsigned char*)(SC + (size_t)u * 4096) + tid * 16) = *(const LAS v4u*)(chi + row * 144 + ch * 16); }
            const ChainOps cur = ops;
            if (cc + 1 < 128) rwkv_chain_load(ops, PT + (size_t)(u + 1) * 4096, QQ + (size_t)(u + 1) * 4096, WL + (size_t)(u + 1) * 64, wave, lane);
            rwkv_chain_step(acc, cur, chi, clo, wave, lane);
            rwkv_state_to_lds(acc, nhi, nlo, wave, lane);
            __syncthreads(); }
#ifndef PROBE_SEQ
        float* wo = A->out + O_WP + (size_t)(l * 16 + h) * 4096;
#else
        float* wo = (float*)(A->ws + WS_HALO) + (size_t)h * 4096;
#endif
#pragma unroll
        for (int t = 0; t < 2; ++t) *(GAS f32x4*)(wo + (16 * (tv0 + t) + c) * 64 + 16 * tk + 4 * q) = acc[t];
    } else {
        for (int su = F.bid - 16; su < NSB * 16; su += F.G - 16) { const int u = 2048 + su, sb = su >> 4, h = su & 15;
            const float* S0 = A->in[I_SWKV] + (size_t)((l * NSB + sb) * 16 + h) * 4096;
            f32x4 acc[2];
#pragma unroll
            for (int t = 0; t < 2; ++t) acc[t] = *(const GAS f32x4*)(S0 + (16 * (tv0 + t) + c) * 64 + 16 * tk + 4 * q);
            rwkv_state_to_lds(acc, HI0, LO0, wave, lane);
            __syncthreads();
            { const int row = tid >> 3, ch = tid & 7; *(GAS v4u*)((unsigned char*)(SC + (size_t)u * 4096) + tid * 16) = *(const LAS v4u*)(HI0 + row * 144 + ch * 16); }
            { ChainOps o1; rwkv_chain_load(o1, PT + (size_t)u * 4096, QQ + (size_t)u * 4096, WL + (size_t)u * 64, wave, lane); rwkv_chain_step(acc, o1, HI0, LO0, wave, lane); }
            float* wo = A->out + O_WS + (size_t)((l * NSB + sb) * 16 + h) * 4096;
#pragma unroll
            for (int t = 0; t < 2; ++t) *(GAS f32x4*)(wo + (16 * (tv0 + t) + c) * 64 + 16 * tk + 4 * q) = acc[t];
            __syncthreads(); }
    }
}
__device__ __forceinline__ void ph_rwkv_passC(Frame& F, int l) {
    PHASE_ENTRY();
    unsigned char* ws = A->ws; const int lane = F.lane, wave = F.wave, c = lane & 15, q = lane >> 4, mt = wave & 3;
    const bf16* RP = (const bf16*)(ws + WS_RP); const unsigned short* YV = (const unsigned short*)(ws + WS_YV); const bf16* SC = (const bf16*)(ws + WS_SC);
    const unsigned short* G1 = (const unsigned short*)(ws + WS_G1); const unsigned short* G2 = (const unsigned short*)(ws + WS_G2); bf16* YC = (bf16*)(ws + WS_YCAT);
    bf16x8 rA[2], rB[2], sA[8], sB[8]; f32x4 yA[4], yB[4], gA[8], gB[8];
    auto geo = [&](int u, int& h, int& row0, bool& skip) { const bool samp = u >= 2048;
        if (!samp) { h = u >> 7; row0 = 64 * (u & 127); } else { const int su = u - 2048; h = su & 15; row0 = MP + (su >> 4) * TS; }
        skip = samp && mt > 0; };
    auto load = [&](int u, bf16x8 (&r)[2], bf16x8 (&sv)[8], f32x4 (&y)[4], f32x4 (&g)[8]) { int h, row0; bool skip; geo(u, h, row0, skip); if (skip) return;
        const bf16* RPu = RP + (size_t)u * 4096; const unsigned short* YVu = YV + (size_t)u * 4096; const bf16* SCu = SC + (size_t)u * 4096; const int t = 16 * mt + c; const size_t ro = (size_t)(row0 + t);
        r[0] = *(const GAS bf16x8*)(RPu + t * 64 + 8 * q); r[1] = *(const GAS bf16x8*)(RPu + t * 64 + 8 * q + 32);
#pragma unroll
        for (int nt = 0; nt < 4; ++nt) { const int v = h * 64 + 16 * nt + 4 * q; { const v2u yw = *(const GAS v2u*)(YVu + t * 64 + 16 * nt + 4 * q); y[nt] = (f32x4){bf2f((unsigned short)(yw.x & 0xffffu)), bf2f((unsigned short)(yw.x >> 16)), bf2f((unsigned short)(yw.y & 0xffffu)), bf2f((unsigned short)(yw.y >> 16))}; }
            sv[2 * nt] = *(const GAS bf16x8*)(SCu + (16 * nt + c) * 64 + 8 * q); sv[2 * nt + 1] = *(const GAS bf16x8*)(SCu + (16 * nt + c) * 64 + 8 * q + 32);
            { const v2u a = *(const GAS v2u*)(G1 + ro * 1024 + v), b = *(const GAS v2u*)(G2 + ro * 1024 + v);
              g[nt] = (f32x4){bf2f((unsigned short)(a.x & 0xffffu)), bf2f((unsigned short)(a.x >> 16)), bf2f((unsigned short)(a.y & 0xffffu)), bf2f((unsigned short)(a.y >> 16))};
              g[4 + nt] = (f32x4){bf2f((unsigned short)(b.x & 0xffffu)), bf2f((unsigned short)(b.x >> 16)), bf2f((unsigned short)(b.y & 0xffffu)), bf2f((unsigned short)(b.y >> 16))}; } } };
    auto compute = [&](int u, const bf16x8 (&r)[2], const bf16x8 (&sv)[8], f32x4 (&y)[4], const f32x4 (&g)[8]) { int h, row0; bool skip; geo(u, h, row0, skip); if (skip) return;
        const int t = 16 * mt + c; const size_t ro = (size_t)(row0 + t); float s1 = 0.f;
#pragma unroll
        for (int nt = 0; nt < 4; ++nt) { y[nt] = __builtin_amdgcn_mfma_f32_16x16x32_bf16(sv[2 * nt], r[0], y[nt], 0, 0, 0); y[nt] = __builtin_amdgcn_mfma_f32_16x16x32_bf16(sv[2 * nt + 1], r[1], y[nt], 0, 0, 0);
            s1 += (y[nt][0] + y[nt][1]) + (y[nt][2] + y[nt][3]); }
        s1 += swz_xor<16>(s1); s1 += xor32(s1);
        const float mean = s1 * (1.f / 64.f); float s2 = 0.f;
#pragma unroll
        for (int nt = 0; nt < 4; ++nt) { y[nt] = y[nt] - mean; s2 += (y[nt][0] * y[nt][0] + y[nt][1] * y[nt][1]) + (y[nt][2] * y[nt][2] + y[nt][3] * y[nt][3]); }
        s2 += swz_xor<16>(s2); s2 += xor32(s2);
        const float rstd = __builtin_amdgcn_rsqf(s2 * (1.f / 64.f) + 64e-5f);
#pragma unroll
        for (int nt = 0; nt < 4; ++nt) { const int v = h * 64 + 16 * nt + 4 * q;
            const f32x4 o = y[nt] * rstd * g[nt] + g[4 + nt]; v2u w; w.x = pk2(o[0], o[1]); w.y = pk2(o[2], o[3]); *(GAS v2u*)(YC + ro * DMOD + v) = w; } };
    const int u0 = 2 * F.bid + (wave >> 2), us = 2 * F.G;
    if (u0 < RW_UNITS) load(u0, rA, sA, yA, gA);
    for (int u = u0; u < RW_UNITS; u += 2 * us) {
        if (u + us < RW_UNITS) load(u + us, rB, sB, yB, gB);
        compute(u, rA, sA, yA, gA);
        if (u + us < RW_UNITS) { if (u + 2 * us < RW_UNITS) load(u + 2 * us, rA, sA, yA, gA); compute(u + us, rB, sB, yB, gB); }
    }
}
__device__ __forceinline__ void attn_sample_unit(ArgsP A, Frame& F, int l, int sb, int h) {
    unsigned char* ws = A->ws; const int tid = F.tid, lane = F.lane, wave = F.wave;
    LAS float* QS = (LAS float*)F.lds;
    LAS float* LUT = QS + 2048;
    LAS float* PB = QS + 4096 + wave * 1024;
    LAS float* MLW = QS + 4096 + 8192;
    LAS float* OACC = MLW + 128;
    LAS float* LACC = OACC + 4096;
    const bf16* QB = (const bf16*)(ws + WS_QB); const bf16* KB = (const bf16*)(ws + WS_KB); const bf16* VB = (const bf16*)(ws + WS_VB);
    const float* reltab = A->in[I_REL];
    for (int i = tid; i < 2048; i += NWAVES * 64) { const int t = i >> 7, d = i & 127; QS[i] = bf2f(QB[(size_t)(MP + sb * TS + t) * 1024 + h * 128 + d]); }
    if (tid < 192) { const int rel = tid - 128; const int n = rel < 0 ? -rel : rel;
        const int lg = n < 12 ? 8 : n < 16 ? 9 : n < 23 ? 10 : n < 32 ? 11 : n < 46 ? 12 : n < 64 ? 13 : n < 91 ? 14 : 15;
        const int bucket = (rel > 0 ? 16 : 0) + (n < 8 ? n : lg);
        LUT[tid] = (reltab[bucket * 8 + h] - reltab[15 * 8 + h]) * 1.4426950408889634f; }
    for (int i = tid; i < 4096 + 32; i += NWAVES * 64) OACC[i] = 0.f;
    __syncthreads();
    const int map = wave & 1, kg = wave >> 1;
    float mrun[16], lrun[16], o[16][2];
#pragma unroll
    for (int t = 0; t < 16; ++t) { mrun[t] = -INFINITY; lrun[t] = 0.f; o[t][0] = 0.f; o[t][1] = 0.f; }
    const float* CK = A->in[I_CK] + (size_t)(l * NSB + sb) * PAST * 1024; const float* CV = A->in[I_CV] + (size_t)(l * NSB + sb) * PAST * 1024;
    for (int kb = kg; kb < 33; kb += 4) {
        const int pos = 64 * kb + lane; const bool kvalid = pos < PAST + TS;
        float s[16];
#pragma unroll
        for (int t = 0; t < 16; ++t) s[t] = 0.f;
        if (kb < 32) { const float* kp = CK + (size_t)pos * 1024 + h * 128 + map * 64;
#pragma unroll 4
            for (int d = 0; d < 64; d += 4) { const f32x4 kv = *(const GAS f32x4*)(kp + d);
#pragma unroll
                for (int t = 0; t < 16; ++t) { const f32x4 qv = *(const LAS f32x4*)(QS + t * 128 + map * 64 + d); s[t] += (kv[0] * qv[0] + kv[1] * qv[1]) + (kv[2] * qv[2] + kv[3] * qv[3]); } }
        } else { const int rr = MP + sb * TS + (lane & 15); const bf16* kp = KB + (size_t)rr * 1024 + h * 128 + map * 64;
#pragma unroll 4
            for (int d = 0; d < 64; d += 4) { const v2u kw = *(const GAS v2u*)(kp + d);
                const f32x4 kv = (f32x4){bf2f((unsigned short)(kw.x & 0xffffu)), bf2f((unsigned short)(kw.x >> 16)), bf2f((unsigned short)(kw.y & 0xffffu)), bf2f((unsigned short)(kw.y >> 16))};
#pragma unroll
                for (int t = 0; t < 16; ++t) { const f32x4 qv = *(const LAS f32x4*)(QS + t * 128 + map * 64 + d); s[t] += (kv[0] * qv[0] + kv[1] * qv[1]) + (kv[2] * qv[2] + kv[3] * qv[3]); } }
        }
        float al[16];
#pragma unroll
        for (int t = 0; t < 16; ++t) { int idx = pos - (PAST + t) + 128; idx = idx < 0 ? 0 : idx; idx = idx > 191 ? 191 : idx;
            float sv = kvalid ? s[t] + LUT[idx] : -INFINITY;
            const float bm = wave_max(sv);
            const float mn = fmaxf(mrun[t], bm); al[t] = __builtin_amdgcn_exp2f(mrun[t] - mn); mrun[t] = mn;
            const float p = __builtin_amdgcn_exp2f(sv - mn); PB[lane * 16 + t] = p;
            lrun[t] = lrun[t] * al[t] + wave_sum(p);
            o[t][0] *= al[t]; o[t][1] *= al[t]; }
        LDS_WAIT(); asm volatile("" ::: "memory");
        const int nk = (kb < 32) ? 64 : TS;
        for (int k0 = 0; k0 < nk; k0 += 4) { f32x2 vv[4];
            if (kb < 32) {
#pragma unroll
                for (int b = 0; b < 4; ++b) vv[b] = *(const GAS f32x2*)(CV + (size_t)(64 * kb + k0 + b) * 1024 + h * 128 + 2 * lane);
            } else {
#pragma unroll
                for (int b = 0; b < 4; ++b) { const unsigned w = *(const GAS unsigned*)(VB + (size_t)(MP + sb * TS + k0 + b) * 1024 + h * 128 + 2 * lane); vv[b].x = bf2f((unsigned short)(w & 0xffffu)); vv[b].y = bf2f((unsigned short)(w >> 16)); }
            }
#pragma unroll
            for (int b = 0; b < 4; ++b) { const LAS f32x4* pp = (const LAS f32x4*)(PB + (k0 + b) * 16);
                const f32x4 p0 = pp[0], p1 = pp[1], p2 = pp[2], p3 = pp[3];
#pragma unroll
                for (int t = 0; t < 4; ++t) { o[t][0] += p0[t] * vv[b].x; o[t][1] += p0[t] * vv[b].y; o[4 + t][0] += p1[t] * vv[b].x; o[4 + t][1] += p1[t] * vv[b].y;
                    o[8 + t][0] += p2[t] * vv[b].x; o[8 + t][1] += p2[t] * vv[b].y; o[12 + t][0] += p3[t] * vv[b].x; o[12 + t][1] += p3[t] * vv[b].y; }
                asm volatile("" ::: "memory"); } }
        LDS_WAIT(); asm volatile("" ::: "memory");
    }
    if (lane < 16) { float mv = mrun[0];
#pragma unroll
        for (int t = 1; t < 16; ++t) mv = (lane == t) ? mrun[t] : mv;
        MLW[wave * 16 + lane] = mv; }
    __syncthreads();
#pragma unroll
    for (int t = 0; t < 16; ++t) { float M = fmaxf(fmaxf(MLW[(map) * 16 + t], MLW[(2 + map) * 16 + t]), fmaxf(MLW[(4 + map) * 16 + t], MLW[(6 + map) * 16 + t]));
        const float sc = __builtin_amdgcn_exp2f(mrun[t] - M);
        __hip_atomic_fetch_add(OACC + (t * 2 + map) * 128 + 2 * lane, o[t][0] * sc, __ATOMIC_RELAXED, __HIP_MEMORY_SCOPE_WORKGROUP); __hip_atomic_fetch_add(OACC + (t * 2 + map) * 128 + 2 * lane + 1, o[t][1] * sc, __ATOMIC_RELAXED, __HIP_MEMORY_SCOPE_WORKGROUP);
        if (lane == 0) __hip_atomic_fetch_add(LACC + map * 16 + t, lrun[t] * sc, __ATOMIC_RELAXED, __HIP_MEMORY_SCOPE_WORKGROUP); }
    __syncthreads();
    float* OA = (float*)(ws + WS_OATT);
    for (int i = tid; i < 4096; i += NWAVES * 64) { const int t = i >> 8, mp = (i >> 7) & 1, e = i & 127;
        OA[(size_t)(MP + sb * TS + t) * DMOD + h * 256 + mp * 128 + e] = OACC[i] / LACC[mp * 16 + t]; }
    __syncthreads();
}


__device__ __forceinline__ void attn_sample_unit2(ArgsP A, Frame& F, int l, int sb, int h) {
    using attn_body::f32x16;
    unsigned char* ws = A->ws; int tid_ = F.tid; asm volatile("" : "+v"(tid_));
    const int tid = tid_, lane = tid & 63, wid = __builtin_amdgcn_readfirstlane(tid >> 6), r32 = lane & 31, hi = lane >> 5, map = wid & 1, vh = (wid >> 1) & 1, KH = wid >> 2;
    LAS unsigned char* L = F.lds;
    LAS float* wsf = (LAS float*)(L + 65536) + wid * 64;
    const LAS float* LUT = (const LAS float*)(L + LUT_OFF) + h * 192;
    LAS float* MG = (LAS float*)(L + 68608);
    const bf16* QB = (const bf16*)(ws + WS_QB); const bf16* KB = (const bf16*)(ws + WS_KB); const bf16* VB = (const bf16*)(ws + WS_VB);
    const float* CK = A->in[I_CK] + (size_t)(l * NSB + sb) * PAST * 1024 + h * 128; const float* CV = A->in[I_CV] + (size_t)(l * NSB + sb) * PAST * 1024 + h * 128;
    bf16x8 qr[4];
    { const bf16* Qw = QB + (size_t)(MP + sb * TS + (r32 & 15)) * 1024 + h * 128 + map * 64;
#pragma unroll
      for (int d0 = 0; d0 < 4; ++d0) qr[d0] = *(const GAS bf16x8*)(Qw + d0 * 16 + hi * 8); }
    f32x4 st[8];
    auto stage_load = [&](int tile) {
        if (tile < 32) {
#pragma unroll
            for (int k = 0; k < 4; ++k) { const int idx = tid + 512 * k, row = idx >> 5, pp = idx & 31; const size_t off = (size_t)(64 * tile + row) * 1024 + 4 * pp;
                st[k] = __builtin_nontemporal_load((const GAS f32x4*)(CK + off)); st[4 + k] = __builtin_nontemporal_load((const GAS f32x4*)(CV + off)); }
        } else {
#pragma unroll
            for (int i = 0; i < 8; ++i) st[i] = (f32x4){0.f, 0.f, 0.f, 0.f};
            { const int row = tid >> 5, pp = tid & 31; const size_t off = (size_t)(MP + sb * TS + row) * 1024 + h * 128 + 4 * pp;
              const v2u wk = *(const GAS v2u*)(KB + off), wv = *(const GAS v2u*)(VB + off);
              st[0] = (f32x4){bf2f((unsigned short)(wk.x & 0xffffu)), bf2f((unsigned short)(wk.x >> 16)), bf2f((unsigned short)(wk.y & 0xffffu)), bf2f((unsigned short)(wk.y >> 16))};
              st[4] = (f32x4){bf2f((unsigned short)(wv.x & 0xffffu)), bf2f((unsigned short)(wv.x >> 16)), bf2f((unsigned short)(wv.y & 0xffffu)), bf2f((unsigned short)(wv.y >> 16))}; }
        } };
    auto stage_write = [&](int buf) { LAS unsigned char* B = L + buf * 32768;
#pragma unroll
        for (int k = 0; k < 4; ++k) { const int idx = tid + 512 * k, row = idx >> 5, pp = idx & 31, c = 4 * (pp & 15); const f32x4 x = st[k], y = st[4 + k];
            *(LAS v2u*)(B + (pp >> 4) * 8192 + ((pp & 15) >> 1) * 1024 + row * 16 + (pp & 1) * 8) = (v2u){pk2(x[0], x[1]), pk2(x[2], x[3])};
            *(LAS v2u*)(B + 16384 + (pp >> 4) * 8192 + ((c >> 5) * 4 + (row >> 4)) * 1024 + ((row & 15) * 4 + ((c & 31) >> 3)) * 16 + ((c >> 2) & 1) * 8) = (v2u){pk2(y[0], y[1]), pk2(y[2], y[3])}; } };
    stage_load(0);
    float mhat = 0.f, l_reg = 0.f; f32x16 o[2]; o[0] = f32x16{}; o[1] = f32x16{};
    stage_write(0);
    __syncthreads();
    for (int tile = 0; tile < 33; ++tile) {
        if (tile + 1 < 33) stage_load(tile + 1);
        const LAS unsigned char* B = L + (tile & 1) * 32768;
        f32x16 p;
        attn_body::qkt_half(p, (attn_body::lds_cp)(B + map * 8192), qr, f32x16{}, r32, hi, KH);
        asm volatile("s_nop 15\n\ts_nop 7" : "+v"(p));
#pragma unroll
        for (int r = 0; r < 16; ++r) p[r] -= mhat;
        if (tile >= 30) {
            const int rel0 = 64 * tile + 32 * KH + 4 * hi - (PAST + (r32 & 15)) + 128;
#pragma unroll
            for (int r = 0; r < 16; ++r) { const int kin = 32 * KH + 4 * hi + (r & 3) + 8 * (r >> 2); int idx = rel0 + (r & 3) + 8 * (r >> 2); idx = idx < 0 ? 0 : (idx > 191 ? 191 : idx);
                p[r] = (tile == 32 && kin >= TS) ? -INFINITY : p[r] + LUT[idx]; } }
        float rm = p[0];
#pragma unroll
        for (int r = 1; r < 16; ++r) rm = fmaxf(rm, p[r]);
        { const PL32 rr = pl32(rm); rm = fmaxf(rr.a, rr.b); }
        if (__any(rm > 0.f)) { const float dl = fmaxf(rm, 0.f); mhat += dl;
#pragma unroll
            for (int r = 0; r < 16; ++r) p[r] -= dl;
            const float f = __builtin_amdgcn_exp2f(-dl); l_reg *= f; if (hi == 0) wsf[r32] = f;
            asm volatile("s_waitcnt lgkmcnt(0)" ::: "memory");
#pragma unroll
            for (int d_ = 0; d_ < 2; ++d_)
#pragma unroll
                for (int r = 0; r < 16; ++r) o[d_][r] *= wsf[attn_body::crow(r, hi)]; }
        float sacc = 0.f;
#pragma unroll
        for (int r = 0; r < 16; ++r) { p[r] = __builtin_amdgcn_exp2f(p[r]); sacc += p[r]; }
        l_reg += sacc;
        const v4u pw0 = (v4u){attn_body::cvtpk_s(p[0], p[1]), attn_body::cvtpk_s(p[2], p[3]), attn_body::cvtpk_s(p[4], p[5]), attn_body::cvtpk_s(p[6], p[7])};
        const v4u pw1 = (v4u){attn_body::cvtpk_s(p[8], p[9]), attn_body::cvtpk_s(p[10], p[11]), attn_body::cvtpk_s(p[12], p[13]), attn_body::cvtpk_s(p[14], p[15])};
        const int vb = (int)(unsigned)(size_t)(B + 16384 + vh * 8192) + KH * 2048 + ((lane >> 4) & 1) * 32 + (lane & 3) * 8 + (4 * hi + ((lane & 15) >> 2)) * 64;
        attn_body::pv_half(o, vb, __builtin_bit_cast(bf16x8, pw0), __builtin_bit_cast(bf16x8, pw1));
        if (tile + 1 < 33) stage_write((tile + 1) & 1);
        __syncthreads();
    }
    { const PL32 rr = pl32(l_reg); l_reg = rr.a + rr.b; }
    LAS float* OG = (LAS float*)L + (wid & 3) * 2048;
    if (KH == 1) { if (hi == 0) { MG[(wid & 3) * 64 + r32] = mhat; MG[(wid & 3) * 64 + 32 + r32] = l_reg; }
#pragma unroll
        for (int d_ = 0; d_ < 2; ++d_)
#pragma unroll
            for (int r = 0; r < 16; ++r) OG[(d_ * 16 + r) * 64 + lane] = o[d_][r]; }
    __syncthreads();
    if (KH == 0) { const float m2 = MG[wid * 64 + r32], l2 = MG[wid * 64 + 32 + r32]; const float M = fmaxf(mhat, m2);
        const float f1 = __builtin_amdgcn_exp2f(mhat - M), f2 = __builtin_amdgcn_exp2f(m2 - M); const float inv = 1.f / (l_reg * f1 + l2 * f2);
        if (hi == 0) { wsf[r32] = f1 * inv; wsf[32 + r32] = f2 * inv; }
        asm volatile("s_waitcnt lgkmcnt(0)" ::: "memory");
        bf16* OA = (bf16*)(ws + WS_OATT) + (size_t)(MP + sb * TS) * DMOD + h * 256 + map * 128 + vh * 64;
#pragma unroll
        for (int r = 0; r < 8; ++r) { const int q = attn_body::crow(r, hi); const float g1 = wsf[q], g2 = wsf[32 + q];
#pragma unroll
            for (int d_ = 0; d_ < 2; ++d_) OA[(size_t)q * DMOD + d_ * 32 + r32] = (bf16)f2bf(o[d_][r] * g1 + OG[(d_ * 16 + r) * 64 + lane] * g2); } }
    __syncthreads();
}
__device__ __forceinline__ void attn_build_lut(ArgsP A, Frame& F) {
    LAS float* T = (LAS float*)(F.lds + LUT_OFF); const float* reltab = A->in[I_REL];
    for (int i = F.tid; i < 8 * 192; i += NWAVES * 64) { const int hh = i / 192, rel = i % 192 - 128; const int n = rel < 0 ? -rel : rel;
        const int lg = n < 12 ? 8 : n < 16 ? 9 : n < 23 ? 10 : n < 32 ? 11 : n < 46 ? 12 : n < 64 ? 13 : n < 91 ? 14 : 15;
        const int bucket = (rel > 0 ? 16 : 0) + (n < 8 ? n : lg);
        T[i] = (reltab[bucket * 8 + hh] - reltab[15 * 8 + hh]) * 1.4426950408889634f; }
    __syncthreads();
}
__device__ __forceinline__ void ph_attn_sample(Frame& F, int l) {
    PHASE_ENTRY();
    attn_build_lut(A, F);
    gu32* head = F.ctl + CW_QUEUE + 128 * l;
    for (;;) {
        if (F.tid == 0) F.MISC[16] = __hip_atomic_fetch_add(head, 1u, RLX_AGENT);
        __syncthreads();
        const unsigned qi = F.MISC[16];
        __syncthreads();
        if (qi >= 128u) break;
#ifdef SAMPLE_VALU
        attn_sample_unit(A, F, l, (int)(qi >> 3), (int)(qi & 7u));
#else
        attn_sample_unit2(A, F, l, (int)(qi >> 3), (int)(qi & 7u));
#endif
    }
}
__device__ __forceinline__ void ph_attn_prompt(Frame& F, int l) {
    PHASE_ENTRY();
    unsigned char* ws = A->ws;
    gu32* head = F.ctl + CW_QUEUE + 128 * l + 64;
    for (;;) {
        if (F.tid == 0) F.MISC[17] = __hip_atomic_fetch_add(head, 1u, RLX_AGENT);
        __syncthreads();
        const unsigned qi = F.MISC[17];
        __syncthreads();
        if (qi >= 1024u) break;
        const int qb = 63 - (int)(qi >> 4), hm = (int)(qi & 15u);
        const int hh = hm >> 1, mp = hm & 1;
        attn_body::attn_unit_f<8>(qb, hh * 128 + mp * 64, hh * 128, hh * 256 + mp * 128,
                                (const attn_body::bf16*)(ws + WS_QB), (const attn_body::bf16*)(ws + WS_KB), (const attn_body::bf16*)(ws + WS_VB), (attn_body::bf16*)(ws + WS_OATT), (char*)F.lds, (const LAS float*)(F.lds + LUT_OFF) + hh * 192);
    }
}
__device__ __forceinline__ void ph_attn_final(Frame& F, int l) {
    PHASE_ENTRY();
    const int lane = F.lane; const int gw = F.bid * NWAVES + F.wave, NGW = F.G * NWAVES;
    float d1 = A->in[I_LQ1][l * 64 + lane] * A->in[I_LK1][l * 64 + lane], d2 = A->in[I_LQ2][l * 64 + lane] * A->in[I_LK2][l * 64 + lane];
    d1 = wave_sum(d1); d2 = wave_sum(d2);
    const float lam_init = (l == 0) ? 0.2f : (0.8f - 0.6f * 0.7408182206817179f);
    const float lam = expf(d1) - expf(d2) + lam_init, osc = 1.f - lam_init;
    const int hh = lane >> 3, e0 = (lane & 7) * 16;
    const bf16* OA = (const bf16*)(A->ws + WS_OATT); bf16* YC = (bf16*)(A->ws + WS_YCAT);
    f32x4 sl[4];
#pragma unroll
    for (int j = 0; j < 4; ++j) sl[j] = *(const GAS f32x4*)(A->in[I_SUBLN] + l * 128 + e0 + 4 * j);
    v4u na0 = (v4u){0u, 0u, 0u, 0u}, na1 = na0, nb0 = na0, nb1 = na0;
    if (gw < MT) { const bf16* o2 = OA + (size_t)gw * DMOD + hh * 256 + e0; na0 = *(const GAS v4u*)o2; na1 = *(const GAS v4u*)(o2 + 8); nb0 = *(const GAS v4u*)(o2 + 128); nb1 = *(const GAS v4u*)(o2 + 136); }
    for (int m = gw; m < MT; m += NGW) {
        if (l == 0 && m >= MP) { const float* xs = A->in[I_XS] + (size_t)(m - MP) * DMOD; float* xd = (float*)(A->ws + WS_X) + (size_t)m * DMOD;
#pragma unroll
            for (int j = 0; j < 8; ++j) *(GAS f32x4*)(xd + 4 * lane + 256 * j) = *(const GAS f32x4*)(xs + 4 * lane + 256 * j); }
        f32x4 o[4]; float ss = 0.f;
        { const v4u a0 = na0, a1 = na1, b0 = nb0, b1 = nb1;
          if (m + NGW < MT) { const bf16* o2 = OA + (size_t)(m + NGW) * DMOD + hh * 256 + e0; na0 = *(const GAS v4u*)o2; na1 = *(const GAS v4u*)(o2 + 8); nb0 = *(const GAS v4u*)(o2 + 128); nb1 = *(const GAS v4u*)(o2 + 136); }
          const unsigned aw[8] = {a0.x, a0.y, a0.z, a0.w, a1.x, a1.y, a1.z, a1.w}, bw[8] = {b0.x, b0.y, b0.z, b0.w, b1.x, b1.y, b1.z, b1.w};
#pragma unroll
          for (int j = 0; j < 4; ++j) { o[j][0] = bf2f((unsigned short)(aw[2 * j] & 0xffffu)) - lam * bf2f((unsigned short)(bw[2 * j] & 0xffffu)); o[j][1] = bf2f((unsigned short)(aw[2 * j] >> 16)) - lam * bf2f((unsigned short)(bw[2 * j] >> 16));
              o[j][2] = bf2f((unsigned short)(aw[2 * j + 1] & 0xffffu)) - lam * bf2f((unsigned short)(bw[2 * j + 1] & 0xffffu)); o[j][3] = bf2f((unsigned short)(aw[2 * j + 1] >> 16)) - lam * bf2f((unsigned short)(bw[2 * j + 1] >> 16));
              ss += (o[j][0] * o[j][0] + o[j][1] * o[j][1]) + (o[j][2] * o[j][2] + o[j][3] * o[j][3]); } }
        ss += swz_xor<1>(ss); ss += swz_xor<2>(ss); ss += swz_xor<4>(ss);
        const float rs = osc * __builtin_amdgcn_rsqf(ss * (1.f / 128.f) + 1e-5f);
        v4u w0, w1; f32x4 y0 = o[0] * rs * sl[0], y1 = o[1] * rs * sl[1], y2 = o[2] * rs * sl[2], y3 = o[3] * rs * sl[3];
        w0 = (v4u){pk2(y0[0], y0[1]), pk2(y0[2], y0[3]), pk2(y1[0], y1[1]), pk2(y1[2], y1[3])}; w1 = (v4u){pk2(y2[0], y2[1]), pk2(y2[2], y2[3]), pk2(y3[0], y3[1]), pk2(y3[2], y3[3])};
        bf16* yo = YC + (size_t)m * DMOD + 1024 + hh * 128 + e0; *(GAS v4u*)yo = w0; *(GAS v4u*)(yo + 8) = w1;
    }
}
__device__ __forceinline__ void ph_fixup(Frame& F, int l) {
    PHASE_ENTRY();
    const float* tail = (const float*)(A->ws + WS_HALO), *hg = tail + 32 * 2 * DFF, *hv = hg + 32 * 2 * DFF;
    const float* cw = A->in[I_CONVW] + (size_t)l * 3 * DFF, *cb = A->in[I_CONVB] + (size_t)l * DFF; bf16* ACT = (bf16*)(A->ws + WS_ACT);
    const int gt = F.bid * (NWAVES * 64) + F.tid, ngt = F.G * NWAVES * 64;
    for (int idx = gt; idx < 31 * DFF; idx += ngt) { const int pm = 1 + idx / DFF, j = idx % DFF;
        const float um2 = tail[((size_t)(pm - 1) * 2 + 0) * DFF + j], um1 = tail[((size_t)(pm - 1) * 2 + 1) * DFF + j], u0 = hg[((size_t)pm * 2 + 0) * DFF + j], u1 = hg[((size_t)pm * 2 + 1) * DFF + j];
        const float v0 = hv[((size_t)pm * 2 + 0) * DFF + j], v1 = hv[((size_t)pm * 2 + 1) * DFF + j];
        const float w0 = cw[j], w1 = cw[DFF + j], w2 = cw[2 * DFF + j], b = cb[j];
        const pg8::f32x2 g = pg8::gelu_pk((pg8::f32x2){b + w0 * um2 + w1 * um1 + w2 * u0, b + w0 * um1 + w1 * u0 + w2 * u1});
        ACT[(size_t)(256 * pm) * DFF + j] = (bf16)f2bf(g.x * v0); ACT[(size_t)(256 * pm + 1) * DFF + j] = (bf16)f2bf(g.y * v1); }
}
#ifdef PROBE_SEQ
__device__ __forceinline__ void probe_seq_scan(Frame& F, int l) {
    PHASE_ENTRY();
    const int gw = F.bid * NWAVES + F.wave, lane = F.lane;
    if (gw >= 16) return;
    const int h = gw, hj = h * 64 + lane;
    const float* PR = (const float*)(A->ws + WS_PR); const float* mu = A->in[I_MU] + (size_t)l * NRC;
    LAS float* sc = (LAS float*)(F.lds + F.wave * 4096);
    const float* w2 = A->in[I_W2] + (size_t)l * 96 * 1024; const float* a2 = A->in[I_A2] + (size_t)l * 96 * 1024;
    const float w0 = A->in[I_W0][l * 1024 + hj], a0 = A->in[I_A0][l * 1024 + hj], kkw = A->in[I_KK][l * 1024 + hj], kaw = A->in[I_KA][l * 1024 + hj];
    float S[64];
#pragma unroll
    for (int k = 0; k < 64; ++k) S[k] = 0.f;
    for (int t = 0; t < MP; ++t) {
        const float* pc = PR + (size_t)t * NRC_PAD; const float* pp = pc - NRC_PAD;
        auto lerp = [&](int col) { const float cur = pc[col]; const float prv = t > 0 ? pp[col] : 0.f; return cur + (prv - cur) * mu[col]; };
        sc[lane] = tanhf(lerp(3072 + lane)); if (lane < 32) sc[64 + lane] = tanhf(lerp(3072 + 64 + lane));
        sc[96 + lane] = lerp(3168 + lane); if (lane < 32) sc[96 + 64 + lane] = lerp(3168 + 64 + lane);
        LDS_WAIT(); asm volatile("" ::: "memory");
        float wl = 0.f, al = 0.f;
        for (int k = 0; k < 96; ++k) { wl += sc[k] * w2[(size_t)k * 1024 + hj]; al += sc[96 + k] * a2[(size_t)k * 1024 + hj]; }
        const float xk = lerp(1024 + hj), xv = lerp(2048 + hj);
        const float z = w0 + wl; const float wlog = -log1pf(expf(-z)) - 0.5f; const float w = expf(-expf(wlog));
        const float a = 1.f / (1.f + expf(-(a0 + al)));
        const float kkr = xk * kkw; const float nrm = wave_sum(kkr * kkr); const float kk = kkr / sqrtf(fmaxf(nrm, 1e-24f));
        const float km = xk * (1.f + (a - 1.f) * kaw);
        LDS_WAIT(); asm volatile("" ::: "memory");
        sc[192 + lane] = w; sc[256 + lane] = kk; sc[320 + lane] = kk * a; sc[384 + lane] = km;
        LDS_WAIT(); asm volatile("" ::: "memory");
        float sa = 0.f;
#pragma unroll
        for (int k = 0; k < 64; ++k) sa -= S[k] * sc[256 + k];
#pragma unroll
        for (int k = 0; k < 64; ++k) S[k] = S[k] * sc[192 + k] + sa * sc[320 + k] + xv * sc[384 + k];
        LDS_WAIT(); asm volatile("" ::: "memory");
    }
    float* wo = A->out + O_WP + (size_t)(l * 16 + h) * 4096 + lane * 64;
#pragma unroll
    for (int k = 0; k < 64; ++k) wo[k] = S[k];
}
#endif
#ifdef PROBE_GEMM
__device__ __forceinline__ void probe_gemm_check(Frame& F) {
    PHASE_ENTRY();
    if (F.bid != 0) return;
    float* scr = (float*)(A->ws + WS_OATT);
    const int tid = F.tid, lane = F.lane, wave = F.wave;
    for (int j = tid; j < 2 * DMOD; j += NWAVES * 64) { float s = A->in[I_BADA][j];
        for (int k = 0; k < DMOD; ++k) { const float c = A->in[I_CP][k]; s += (c / (1.f + expf(-c))) * A->in[I_WADA][(size_t)k * MODW + j]; }
        scr[j] = s; }
    __threadfence(); __syncthreads();
    float num = 0.f, den = 0.f;
#if PROBE_GEMM == 3
    for (int j = tid; j < 2 * DMOD; j += NWAVES * 64) { const float mine = ((const float*)(A->ws + WS_MOD))[j], ref = scr[j]; num += (mine - ref) * (mine - ref); den += ref * ref; }
    num = wave_sum(num); den = wave_sum(den);
#elif PROBE_GEMM == 5
    { const float sgot = wave_sum((float)(lane + 1)); num = (sgot - 2080.f) * (sgot - 2080.f); den = 2080.f * 2080.f; }
#elif PROBE_GEMM == 6
    { float v = (float)(lane + 1); for (int o = 1; o < 64; o <<= 1) v += __shfl_xor(v, o); num = (v - 2080.f) * (v - 2080.f); den = 2080.f * 2080.f; }
#elif PROBE_GEMM == 4
    for (int smp = wave; smp < 64; smp += NWAVES) { const int m = (smp * 2654435761u >> 7) % MP; const float* xr = A->in[I_XP] + (size_t)m * DMOD; float ss = 0.f;
        for (int k = lane; k < DMOD; k += 64) ss += xr[k] * xr[k];
        const float rstd = 1.f / sqrtf(wave_sum(ss) / DMOD + 1e-6f);
        for (int k = lane; k < DMOD; k += 64) { const float hh = xr[k] * rstd * A->in[I_GMIX][k] * (1.f + scr[DMOD + k]) + scr[k]; const float mine = bf2f(((const bf16*)(A->ws + WS_H))[(size_t)m * DMOD + k]); num += (mine - hh) * (mine - hh); den += hh * hh; } }
    num = wave_sum(num); den = wave_sum(den);
#else
    for (int smp = wave; smp < 256; smp += NWAVES) {
        const int m = (smp * 2654435761u >> 7) % MP; const int cc = (smp * 40503u + 17u) % (PROBE_GEMM == 1 ? 3072 : 1024);
        const int col = PROBE_GEMM == 1 ? cc : NRC + 1024 + cc;
        const float* xr = A->in[I_XP] + (size_t)m * DMOD; float ss = 0.f;
        for (int k = lane; k < DMOD; k += 64) ss += xr[k] * xr[k];
        const float rstd = 1.f / sqrtf(wave_sum(ss) / DMOD + 1e-6f); float acc = 0.f;
        for (int k = lane; k < DMOD; k += 64) { const float hh = xr[k] * rstd * A->in[I_GMIX][k] * (1.f + scr[DMOD + k]) + scr[k]; acc += hh * A->in[I_WIN][(size_t)k * NIN + col]; }
        acc = wave_sum(acc);
        const float mine = PROBE_GEMM == 1 ? ((const float*)(A->ws + WS_PR))[(size_t)m * NRC_PAD + cc] : A->out[O_KP + (size_t)m * 1024 + cc];
        num += (mine - acc) * (mine - acc); den += acc * acc; }
#endif
    LAS float* red = (LAS float*)F.lds;
    if (lane == 0) { red[wave] = num; red[8 + wave] = den; }
    __syncthreads();
    if (tid == 0) { float n = 0.f, d = 0.f; for (int w = 0; w < 8; ++w) { n += red[w]; d += red[8 + w]; } ((float*)(A->ws + WS_CTL))[16384] = sqrtf(n / d); }
}
#endif
#ifndef MK_SPLIT
#define MK_SPLIT 0
#endif
constexpr int N_PHASES = 22;
__global__ void __launch_bounds__(NWAVES * 64, 2) hybrid_fwd(Args args) {
    extern __shared__ __attribute__((aligned(16))) unsigned char lds[];
    Frame F;
    F.lds = (LAS unsigned char*)lds; F.MISC = (volatile LAS unsigned*)(F.lds + MISC_OFF);
    F.tid = threadIdx.x; F.lane = F.tid & 63; F.wave = __builtin_amdgcn_readfirstlane(F.tid >> 6); F.G = gridDim.x; F.bid = blockIdx.x;
    F.ctl = (gu32*)(args.ws + WS_CTL);
    if (F.tid < 64) F.MISC[F.tid] = 0u;
    __syncthreads();
    XcdBarrier bar; bar.bar = (unsigned*)(F.ctl + CW_BAR); bar.x = 0; bar.st = nullptr;
    if (!MK_SPLIT) bar = xcd_barrier_post((unsigned*)(F.ctl + CW_BAR), F.MISC + 8);
    const int lo = args.ph_lo, hi = args.ph_hi;
#ifndef ONLY_PT
#define ONLY_PT -1
#endif
#define PT_ON(t) (ONLY_PT < 0 || ONLY_PT == (t))
#define IN(k) (lo <= (k) && (k) < hi)
#define SEAM(k) do { if (IN(k) && IN((k) + 1)) xcd_barrier(bar); } while (0)
    if (PT_ON(0) && IN(0)) { ph_prologue(F); }
    SEAM(0);
    for (int l = 0; l < NLAYER; ++l) {
        const int pb = 1 + 10 * l;
        if (PT_ON(1) && IN(pb + 0)) ph_norm(F, l, 0, l == 0 ? 0 : 11);
        SEAM(pb + 0);
        if (PT_ON(2) && IN(pb + 1)) { PHASE_ENTRY(); unsigned char* ws = A->ws;
            pg8::Gemm g{(const pg8::bf16_t*)(ws + WS_H), (const pg8::bf16_t*)(ws + WS_WIN) + (size_t)l * NIN_PAD * DMOD, MT, NIN_PAD, DMOD, DMOD}; pg8::TwoPartOrder S; S.init(MT, NRC_PAD / 256, (NIN_PAD - NRC_PAD) / 256, F.G, F.bid, F.G == 256 ? (unsigned*)(F.ctl + CW_QUEUE + 1024 + 64 * l) : nullptr, 1 + (F.bid + 256 < (MT / 256) * (NRC_PAD / 256) ? 1 : 0));
            pg8::EpiIn E{ws, A->out, l, 0.125f * 1.4426950408889634f};
            pg8::gemm_phase<pg8::EpiIn, pg8::TwoPartOrder, true, true>(F.lds, g, S, E);
        }
        if (F.G != 256) SEAM(pb + 1);
#ifdef PROBE_GEMM
        if (l == 0 && IN(pb + 2)) { probe_gemm_check(F); __syncthreads(); }
#endif
        if (PT_ON(3) && IN(pb + 2)) ph_rwkv_passA(F, l);
        SEAM(pb + 2);
#ifdef PROBE_SEQ
        if (IN(pb + 3)) { probe_seq_scan(F, l); __syncthreads(); }
#endif
        if (PT_ON(4) && IN(pb + 3)) { ph_rwkv_chain(F, l); ph_attn_sample(F, l); ph_attn_prompt(F, l); }
        SEAM(pb + 3);
#ifdef PROBE_SEQ
        if (IN(pb + 4) && F.bid == 0) { PHASE_ENTRY();
            for (int h = F.wave; h < 16; h += NWAVES) { const float* a = (const float*)(A->ws + WS_HALO) + (size_t)h * 4096; const float* b = A->out + O_WP + (size_t)(l * 16 + h) * 4096; float n = 0.f, d = 0.f;
                for (int i = F.lane; i < 4096; i += 64) { n += (a[i] - b[i]) * (a[i] - b[i]); d += b[i] * b[i]; }
                n = wave_sum(n); d = wave_sum(d); if (F.lane == 0) { ((float*)(A->ws + WS_CTL))[16400 + 16 * l + h] = sqrtf(n / d); ((float*)(A->ws + WS_CTL))[16440 + 16 * l + h] = d; } } }
#endif
        if (PT_ON(5) && IN(pb + 4)) { ph_rwkv_passC(F, l); ph_attn_final(F, l); }
        SEAM(pb + 4);
        if (PT_ON(6) && IN(pb + 5)) { PHASE_ENTRY(); unsigned char* ws = A->ws;
            const float* X = (const float*)(ws + WS_X); const float* MODl = (const float*)(ws + WS_MOD) + (size_t)l * NMODB * MODW;
            { pg8::Gemm g{(const pg8::bf16_t*)(ws + WS_YCAT), (const pg8::bf16_t*)(ws + WS_WOUT) + (size_t)l * DMOD * DMOD, MP, DMOD, DMOD, DMOD}; pg8::StaticOrder S; S.init(MP, DMOD, F.G, F.bid);
              pg8::EpiRes E{l == 0 ? A->in[I_XP] : X, X + (size_t)MP * DMOD, (float*)(ws + WS_X), MODl + 2 * DMOD};
              pg8::gemm_phase<pg8::EpiRes, pg8::StaticOrder, true, true>(F.lds, g, S, E); }
            { pg8::Gemm g{(const pg8::bf16_t*)(ws + WS_YCAT) + (size_t)MP * DMOD, (const pg8::bf16_t*)(ws + WS_WOUT) + (size_t)l * DMOD * DMOD, 256, DMOD, DMOD / 8, DMOD}; pg8::SplitOrder S; S.init(DMOD, 8, F.bid);
              pg8::EpiResSlab E{(float*)(ws + WS_SLAB), MODl + 2 * DMOD};
              pg8::gemm_phase<pg8::EpiResSlab, pg8::SplitOrder, true, true>(F.lds, g, S, E); }
        }
        SEAM(pb + 5);
        if (PT_ON(7) && IN(pb + 6)) ph_norm(F, l, 1, 8);
        SEAM(pb + 6);
        if (PT_ON(8) && IN(pb + 7)) { PHASE_ENTRY(); unsigned char* ws = A->ws;
            pg8::Gemm g{(const pg8::bf16_t*)(ws + WS_H), (const pg8::bf16_t*)(ws + WS_WUP) + (size_t)l * NUP * DMOD, MT, NUP, DMOD, DMOD}; pg8::PmFirstOrder S; S.init(MT, NUP, F.G, F.bid, F.G == 256 ? (unsigned*)(F.ctl + CW_QUEUE + 1536 + 64 * l) : nullptr);
            pg8::EpiUp E{(pg8::bf16_t*)(ws + WS_ACT), A->in[I_CONVW] + (size_t)l * 3 * DFF, A->in[I_CONVB] + (size_t)l * DFF, A->in[I_SCONV] + (size_t)l * NSB * 2 * DFF,
                         (float*)(ws + WS_HALO), A->out + O_CP + (size_t)l * 2 * DFF, A->out + O_CS + (size_t)l * NSB * 2 * DFF, (PG8_LAS float*)(F.lds + HALO_OFF)};
            pg8::gemm_phase<pg8::EpiUp, pg8::PmFirstOrder, true, true>(F.lds, g, S, E);
            { int first = 0, nw = F.G;
              if (F.G == 256) { first = 256 - ((256 * 6) - (MT / 256) * (NUP / 256)); nw = 256 - first; if (F.bid >= first) wait_count(F, (unsigned*)(F.ctl + CW_QUEUE + 1536 + 64 * l), (unsigned)(NUP / 256)); }
              else if (!MK_SPLIT) xcd_barrier(bar);
              const float* MODl = (const float*)(ws + WS_MOD) + (size_t)l * NMODB * MODW;
              pg8::Gemm g2{(const pg8::bf16_t*)(ws + WS_ACT) + (size_t)MP * DFF, (const pg8::bf16_t*)(ws + WS_WDN) + (size_t)l * DMOD * DFF, 256, DMOD, DFF / 11, DFF}; pg8::TailSplitOrder S2; S2.init(DMOD, 11, F.bid, first, nw);
              pg8::EpiResSlab E2{(float*)(ws + WS_SLAB), MODl + 5 * DMOD};
              pg8::gemm_phase<pg8::EpiResSlab, pg8::TailSplitOrder, true, true>(F.lds, g2, S2, E2); }
        }
        SEAM(pb + 7);
        if (PT_ON(9) && IN(pb + 8)) ph_fixup(F, l);
        SEAM(pb + 8);
        if (PT_ON(10) && IN(pb + 9)) { PHASE_ENTRY(); unsigned char* ws = A->ws;
            const float* X = (const float*)(ws + WS_X); const float* MODl = (const float*)(ws + WS_MOD) + (size_t)l * NMODB * MODW;
            { pg8::Gemm g{(const pg8::bf16_t*)(ws + WS_ACT), (const pg8::bf16_t*)(ws + WS_WDN) + (size_t)l * DMOD * DFF, MP, DMOD, DFF, DFF}; pg8::StaticOrder S; S.init(MP, DMOD, F.G, F.bid);
              pg8::EpiRes E{X, X + (size_t)MP * DMOD, (float*)(ws + WS_X), MODl + 5 * DMOD};
              pg8::gemm_phase<pg8::EpiRes, pg8::StaticOrder, true, true>(F.lds, g, S, E); }
        }
        SEAM(pb + 9);
    }
    if (PT_ON(11) && IN(21)) ph_norm(F, 0, 2, 11);
#ifdef PROBE_MASK
    if (IN(22)) { PHASE_ENTRY();
        const size_t offs[13] = {O_YP, O_YS, O_KP, O_VP, O_WP, O_SP, O_CP, O_KS, O_VS, O_WS, O_SS, O_CS, O_END};
        const size_t gt = (size_t)F.bid * (NWAVES * 64) + F.tid, ngt = (size_t)F.G * NWAVES * 64;
#ifndef PROBE_SCALE
#define PROBE_SCALE 1.2f
#endif
#ifndef PROBE_HALF
#define PROBE_HALF 2
#endif
#ifdef PROBE_HEADS
        { const float* dh = (const float*)(A->ws + WS_CTL) + 16400; float best = -1.f; int bi = 0;
#if PROBE_HEADS == 3
          bi = 0; best = dh[PROBE_IDX] * 20.f;
#elif PROBE_HEADS == 1
          for (int i = 0; i < 32; ++i) if (dh[i] > best) { best = dh[i]; bi = i; }
#else
          for (int i = 0; i < 32; ++i) if (dh[i] * dh[i] * dh[40 + i] > best) { best = dh[i] * dh[i] * dh[40 + i]; bi = i; } best = dh[bi];
#endif
          const float val = (PROBE_HEADS == 3) ? best : 0.05f * bi + fminf(best, 0.049f); const float fsc = 1.f + val; for (size_t i = O_YP + gt; i < O_YS; i += ngt) A->out[i] *= fsc; }
#endif
#ifdef PROBE_GEMM
        { const float dd = ((const float*)(A->ws + WS_CTL))[16384]; const float fsc = 1.f + PROBE_AMP * dd; for (size_t i = O_YP + gt; i < O_YS; i += ngt) A->out[i] *= fsc; }
#endif
        for (int o = 0; o < 12; ++o) if ((PROBE_MASK >> o) & 1) { size_t b = offs[o], e = offs[o + 1]; const size_t mid = b + (e - b) / 2;
            if (PROBE_HALF == 0) e = mid; if (PROBE_HALF == 1) b = mid;
            for (size_t i = b + gt; i < e; i += ngt) A->out[i] *= PROBE_SCALE; } }
#endif
#undef IN
#undef SEAM
}

extern "C" void kernel_launch(void* const* d_in, const int* in_sizes, int n_in, void* d_out, int out_size, void* d_ws, size_t ws_size, hipStream_t stream) {
    static int grid = 0;
    if (grid == 0) {
        if (n_in != 37 || (size_t)out_size != O_END || ws_size < WS_END) { fprintf(stderr, "kernel_launch: built for 37 inputs, %zu outputs, >= %zu bytes of workspace; got n_in %d, out %d, ws %zu; nothing launched\n", (size_t)O_END, (size_t)WS_END, n_in, out_size, ws_size); grid = -1; return; }
        int dev = 0, cus = 0, per_cu = 0;
        if (hipGetDevice(&dev) != hipSuccess || hipDeviceGetAttribute(&cus, hipDeviceAttributeMultiprocessorCount, dev) != hipSuccess) { fprintf(stderr, "kernel_launch: device query failed\n"); grid = -1; return; }
        if (hipFuncSetAttribute((const void*)hybrid_fwd, hipFuncAttributeMaxDynamicSharedMemorySize, LDS_BYTES) != hipSuccess) { fprintf(stderr, "kernel_launch: hipFuncSetAttribute failed\n"); grid = -1; return; }
        if (hipOccupancyMaxActiveBlocksPerMultiprocessor(&per_cu, (const void*)hybrid_fwd, NWAVES * 64, LDS_BYTES) != hipSuccess || per_cu < 1) fprintf(stderr, "kernel_launch: note: occupancy query reports %d workgroups per CU\n", per_cu);
        (void)hipGetLastError();
        grid = cus;
    }
    if (grid < 0) return;
    if (hipMemsetAsync((char*)d_ws + WS_CTL, 0, CTL_ZERO_BYTES, stream) != hipSuccess) { fprintf(stderr, "kernel_launch: memset failed\n"); return; }
    Args a{};
    for (int i = 0; i < 37; ++i) a.in[i] = (const float*)d_in[i];
    a.out = (float*)d_out; a.ws = (unsigned char*)d_ws;
#if MK_SPLIT
#ifdef PROBE_MASK
    const int n_launch = N_PHASES + 1;
#else
    const int n_launch = N_PHASES;
#endif
    for (int p = 0; p < n_launch; ++p) { a.ph_lo = p; a.ph_hi = p + 1; hipLaunchKernelGGL(hybrid_fwd, dim3(grid), dim3(NWAVES * 64), LDS_BYTES, stream, a); }
#else
    a.ph_lo = 0; a.ph_hi = N_PHASES; hipLaunchKernelGGL(hybrid_fwd, dim3(grid), dim3(NWAVES * 64), LDS_BYTES, stream, a);
#endif
    const hipError_t le = hipPeekAtLastError();
    if (le != hipSuccess) fprintf(stderr, "kernel_launch: launch failed: %s\n", hipGetErrorName(le));
}
```

```cpp
#include <hip/hip_runtime.h>
#include <hip/hip_bf16.h>
#include <cstdio>
#include <cstdint>
#include <cmath>
constexpr int NWAVES = 8;
constexpr int DMOD = 2048, MP = 8192, NSB = 16, TS = 16, MT = MP + NSB * TS  , PAST = 2048;
constexpr int NRC = 3520, NRC_PAD = 3584, NIN = 6592, NIN_PAD = 6656, DFF = 5632, NUP = 2 * DFF;
constexpr int NLAYER = 2, NMODB = 17, MODW = 6 * DMOD;
constexpr int RW_UNITS = 128 * 16 + NSB * 16;
constexpr size_t O_YP = 0, O_YS = O_YP + (size_t)MP * DMOD, O_KP = O_YS + (size_t)NSB * TS * DMOD, O_VP = O_KP + (size_t)NLAYER * MP * 1024, O_WP = O_VP + (size_t)NLAYER * MP * 1024,
                 O_SP = O_WP + (size_t)NLAYER * 16 * 4096, O_CP = O_SP + (size_t)NLAYER * NRC, O_KS = O_CP + (size_t)NLAYER * 2 * DFF, O_VS = O_KS + (size_t)NLAYER * 256 * 1024,
                 O_WS = O_VS + (size_t)NLAYER * 256 * 1024, O_SS = O_WS + (size_t)NLAYER * NSB * 16 * 4096, O_CS = O_SS + (size_t)NLAYER * NSB * NRC, O_END = O_CS + (size_t)NLAYER * NSB * 2 * DFF;
constexpr size_t MiB = 1u << 20;
constexpr size_t WS_CTL = 0, CTL_ZERO_BYTES = 1 * MiB;
constexpr size_t WS_MOD = 1 * MiB;
constexpr size_t WS_LORA = 3 * MiB, LORA_LAYER = (size_t)1024 * 448 * 2;
constexpr size_t WS_WIN = 5 * MiB, WS_WOUT = 57 * MiB, WS_WUP = 73 * MiB, WS_WDN = 161 * MiB;
constexpr size_t WS_H = 205 * MiB, WS_PR = 238 * MiB, WS_QB = 354 * MiB, WS_KB = 371 * MiB, WS_VB = 388 * MiB, WS_OATT = 405 * MiB, WS_YCAT = 471 * MiB, WS_X = 504 * MiB, WS_ACT = 570 * MiB;
constexpr size_t WS_PT = 661 * MiB, WS_QQ = 679 * MiB, WS_RP = 715 * MiB, WS_YV = 733 * MiB, WS_SC = 769 * MiB, WS_G1 = 787 * MiB, WS_G2 = 820 * MiB, WS_HALO = 853 * MiB, WS_WL = 858 * MiB, WS_PT32 = 859 * MiB, WS_LSCR = 895 * MiB, WS_SLAB = 911 * MiB, WS_END = 935 * MiB;
static_assert(WS_WIN + (size_t)2 * NIN_PAD * DMOD * 2 <= WS_WOUT && WS_WOUT + (size_t)2 * DMOD * DMOD * 2 <= WS_WUP && WS_WUP + (size_t)2 * NUP * DMOD * 2 <= WS_WDN && WS_WDN + (size_t)2 * DMOD * DFF * 2 <= WS_H, "weights map");
static_assert(WS_H + (size_t)MT * DMOD * 2 <= WS_PR && WS_PR + (size_t)MT * NRC_PAD * 4 <= WS_QB && WS_QB + (size_t)MT * 1024 * 2 <= WS_KB && WS_VB + (size_t)MT * 1024 * 2 <= WS_OATT && WS_OATT + (size_t)MT * DMOD * 4 <= WS_YCAT, "act map 1");
static_assert(WS_YCAT + (size_t)MT * DMOD * 2 <= WS_X && WS_X + (size_t)MT * DMOD * 4 <= WS_ACT && WS_ACT + (size_t)MT * DFF * 2 <= WS_PT, "act map 2");
static_assert(WS_PT + (size_t)RW_UNITS * 8192 <= WS_QQ && WS_QQ + (size_t)RW_UNITS * 16384 <= WS_RP && WS_RP + (size_t)RW_UNITS * 8192 <= WS_YV && WS_YV + (size_t)RW_UNITS * 16384 <= WS_SC && WS_SC + (size_t)RW_UNITS * 8192 <= WS_G1, "rwkv map");
static_assert(WS_G1 + (size_t)MT * 1024 * 4 <= WS_G2 && WS_G2 + (size_t)MT * 1024 * 4 <= WS_HALO && WS_HALO + (size_t)3 * 32 * 2 * DFF * 4 <= WS_WL && WS_WL + (size_t)RW_UNITS * 256 <= WS_PT32 && WS_PT32 + (size_t)RW_UNITS * 16384 <= WS_LSCR && WS_LSCR + (size_t)256 * 61440 <= WS_SLAB && WS_SLAB + (size_t)11 * 256 * 2048 * 4 <= WS_END && WS_LORA + 2 * LORA_LAYER <= WS_WIN && WS_MOD + (size_t)NLAYER * NMODB * MODW * 4 <= WS_LORA, "map 3");
constexpr int CW_BAR = 4096, CW_QUEUE = 8192;
constexpr int LDS_BYTES = 163840;
constexpr int MISC_OFF = LDS_BYTES - 256;
constexpr int LUT_OFF = 131072;
constexpr int HALO_OFF = 131072;
constexpr int RW_SLOT = 9216, RW_STRIDE = 72;
constexpr int RW_SCR = 154624;
static_assert(RW_SCR + 4096 <= MISC_OFF && HALO_OFF + 4096 <= MISC_OFF, "LDS map");

#define GAS __attribute__((address_space(1)))
#define LAS __attribute__((address_space(3)))
typedef unsigned short bf16;
typedef unsigned v4u __attribute__((ext_vector_type(4)));
typedef unsigned v2u __attribute__((ext_vector_type(2)));
typedef float f32x4 __attribute__((ext_vector_type(4)));
typedef float f32x2 __attribute__((ext_vector_type(2)));
typedef short bf16x8 __attribute__((ext_vector_type(8)));
typedef GAS unsigned gu32;
#define RLX_AGENT __ATOMIC_RELAXED, __HIP_MEMORY_SCOPE_AGENT
#define LDS_WAIT() asm volatile("s_waitcnt lgkmcnt(0)" ::: "memory")
#define VM_WAIT() asm volatile("s_waitcnt vmcnt(0)" ::: "memory")
typedef float cvt_f32x2 __attribute__((ext_vector_type(2))); typedef __bf16 cvt_bf16x2 __attribute__((ext_vector_type(2)));
__device__ __forceinline__ unsigned pk2(float lo, float hi) { const cvt_f32x2 v = {lo, hi}; return __builtin_bit_cast(unsigned, __builtin_convertvector(v, cvt_bf16x2)); }
__device__ __forceinline__ unsigned f2bf(float f) { return pk2(f, 0.f) & 0xffffu; }
__device__ __forceinline__ float bf2f(unsigned short b) { return __builtin_bit_cast(float, (unsigned)b << 16); }
template <int K> __device__ __forceinline__ float swz_xor(float v) { static_assert(K >= 1 && K <= 16, "");
    return __builtin_bit_cast(float, __builtin_amdgcn_ds_swizzle(__builtin_bit_cast(int, v), (K << 10) | 0x1f)); }
struct PL32 { float a, b; };
__device__ __forceinline__ PL32 pl32(float v) { const int ln = (int)(threadIdx.x & 63);
    const float p = __builtin_bit_cast(float, __builtin_amdgcn_ds_bpermute((ln ^ 32) << 2, __builtin_bit_cast(int, v))); PL32 o; o.a = v; o.b = p; return o; }
__device__ __forceinline__ float xor32(float v) { return pl32(v).b; }
template <int CTRL> __device__ __forceinline__ float dpp_f(float v) { return __builtin_bit_cast(float, __builtin_amdgcn_update_dpp(__builtin_bit_cast(int, v), __builtin_bit_cast(int, v), CTRL, 0xF, 0xF, false)); }
__device__ __forceinline__ float wave_sum(float v) {
    v += dpp_f<0xB1>(v); v += dpp_f<0x4E>(v); v += dpp_f<0x141>(v); v += dpp_f<0x128>(v); v += swz_xor<16>(v);
    const PL32 r = pl32(v); return r.a + r.b;
}
__device__ __forceinline__ float wave_max(float v) {
    v = fmaxf(v, dpp_f<0xB1>(v)); v = fmaxf(v, dpp_f<0x4E>(v)); v = fmaxf(v, dpp_f<0x141>(v)); v = fmaxf(v, dpp_f<0x128>(v)); v = fmaxf(v, swz_xor<16>(v));
    const PL32 r = pl32(v); return fmaxf(r.a, r.b);
}
__device__ __forceinline__ float sigmoidf_(float x) { return __builtin_amdgcn_rcpf(1.f + __expf(-x)); }
namespace pg8 {
#define PG8_LAS __attribute__((address_space(3)))
typedef unsigned short bf16_t;
typedef short bf16x8 __attribute__((ext_vector_type(8)));
typedef float f32x4 __attribute__((ext_vector_type(4)));
typedef unsigned u32x4 __attribute__((ext_vector_type(4)));
constexpr int BM = 256, BK = 64, HALF = 128, HTB = HALF * BK * 2  , STAGE_BYTES = 8 * HTB, NXCD = 8, WGM = 8;

__host__ __device__ __forceinline__ int lds_byte(int r, int c) { const int st = (r >> 4) * 2 + (c >> 5), rr = r & 15, cc = c & 31, ob = rr * 64 + cc * 2; return st * 1024 + (ob ^ (((ob >> 9) & 1) << 5)); }
__host__ __device__ __forceinline__ void stage_rc(int b, int& R, int& C) { const int st = b / 1024, sb = b % 1024, swz = sb ^ (((sb >> 9) & 1) << 5); R = (st >> 1) * 16 + swz / 64; C = (st & 1) * 32 + (swz % 64) / 2; }
__host__ __device__ __forceinline__ int perm32(int rho) { const int n = rho >> 4, i = rho & 15; return 8 * (i >> 2) + 4 * n + (i & 3); }

struct Unit { int pm, pn, ks, tag; };
struct Gemm { const bf16_t* A; const bf16_t* Bt; int M, N, K, ld; };

struct StaticOrder {
    static constexpr bool HANDOFF = false;
    int nM, nN, nwg, G, c;
    __host__ __device__ void init(int M, int N, int G_, int c_) { nM = M / BM; nN = N / BM; nwg = nM * nN; G = G_; c = c_; }
    __host__ __device__ bool next(int i, Unit& u) const {
        const long L = (long)i * G + c; if (L >= nwg) return false;
        int wgid = (int)L; { const int q = nwg / NXCD, r = nwg % NXCD, xcd = wgid % NXCD, off = wgid / NXCD; wgid = (xcd < r ? xcd * (q + 1) : r * (q + 1) + (xcd - r) * q) + off; }
        const int nig = WGM * nN, gid = wgid / nig, fm = gid * WGM, gsz = (nM - fm) < WGM ? (nM - fm) : WGM;
        u.pm = fm + ((wgid % nig) % gsz); u.pn = (wgid % nig) / gsz; u.ks = 0; u.tag = 0; return true;
    }
    __device__ __forceinline__ void a_ready(const Unit&) const {}
    __device__ __forceinline__ void done(const Unit&) const {}
};

struct TwoPartOrder {
    static constexpr bool HANDOFF = true;
    int nM, nA, nB, G, c; unsigned* cnt; int nsig;
    __device__ __forceinline__ void mid(const Unit& u, int t, int nt, int wid, int lane) const {
        if (cnt == nullptr || u.tag != 2) return;
        if (t == nt / 2) asm volatile("s_waitcnt vmcnt(0)" ::: "memory");
        if (t == nt / 2 + 2 && wid == 0) { __builtin_amdgcn_fence(__ATOMIC_RELEASE, "agent"); asm volatile("s_waitcnt vmcnt(0)" ::: "memory");
            if (lane == 0) (void)__hip_atomic_fetch_add(cnt, (unsigned)nsig, __ATOMIC_RELAXED, __HIP_MEMORY_SCOPE_AGENT); }
    }
    __host__ __device__ void init(int M, int NA, int NB, int G_, int c_, unsigned* cnt_, int nsig_) { nM = M / BM; nA = NA; nB = NB; G = G_; c = c_; cnt = cnt_; nsig = nsig_; }
    __host__ __device__ static void map(int wgid, int nM, int nN, Unit& u) {
        const int nwg = nM * nN; { const int q = nwg / NXCD, r = nwg % NXCD, xcd = wgid % NXCD, off = wgid / NXCD; wgid = (xcd < r ? xcd * (q + 1) : r * (q + 1) + (xcd - r) * q) + off; }
        const int nig = WGM * nN, gid = wgid / nig, fm = gid * WGM, gsz = (nM - fm) < WGM ? (nM - fm) : WGM;
        u.pm = fm + ((wgid % nig) % gsz); u.pn = (wgid % nig) / gsz; u.ks = 0;
    }
    __host__ __device__ bool next(int i, Unit& u) const {
        const long L = (long)i * G + c; const int na = nM * nA, nb = nM * nB; if (L >= na + nb) return false;
        if (L < na) map((int)L, nM, nA, u); else { map((int)L - na, nM, nB, u); u.pn += nA; }
        u.tag = i; return true;
    }
    __device__ __forceinline__ void a_ready(const Unit&) const {}
    __device__ __forceinline__ void done(const Unit&) const {}
};

struct PmFirstOrder {
    static constexpr bool HANDOFF = true;
    int nM, nN, G, c; unsigned* cnt;
    __host__ __device__ void init(int M, int N, int G_, int c_, unsigned* cnt_) { nM = M / BM; nN = N / BM; G = G_; c = c_; cnt = cnt_; }
    __host__ __device__ __forceinline__ bool next(int i, Unit& u) const {
        const long L = (long)i * G + c; if (L >= (long)nM * nN) return false;
        if (L < nN) { u.pm = nM - 1; u.pn = (int)L; u.ks = 0; } else TwoPartOrder::map((int)L - nN, nM - 1, nN, u);
        u.tag = i; return true;
    }
    __device__ __forceinline__ void a_ready(const Unit&) const {}
    __device__ __forceinline__ void done(const Unit&) const {}
    __device__ __forceinline__ void mid(const Unit& u, int t, int nt, int wid, int lane) const {
        if (cnt == nullptr || u.tag != 1 || c >= nN) return;
        if (t == nt / 2) asm volatile("s_waitcnt vmcnt(0)" ::: "memory");
        if (t == nt / 2 + 2 && wid == 0) { __builtin_amdgcn_fence(__ATOMIC_RELEASE, "agent"); asm volatile("s_waitcnt vmcnt(0)" ::: "memory");
            if (lane == 0) (void)__hip_atomic_fetch_add(cnt, 1u, __ATOMIC_RELAXED, __HIP_MEMORY_SCOPE_AGENT); }
    }
};
struct TailSplitOrder {
    static constexpr bool HANDOFF = false;
    int n, KS, k, nw;
    __host__ __device__ void init(int N, int KS_, int c_, int first, int nw_) { n = (N / BM) * KS_; KS = KS_; k = c_ - first; nw = nw_; }
    __host__ __device__ __forceinline__ bool next(int i, Unit& u) const { const int L = k + i * nw; if (k < 0 || L >= n) return false; u.pm = 0; u.pn = L / KS; u.ks = L % KS; u.tag = 0; return true; }
    __device__ __forceinline__ void a_ready(const Unit&) const {}
    __device__ __forceinline__ void done(const Unit&) const {}
};

struct SplitOrder {
    static constexpr bool HANDOFF = false;
    int n, KS, c;
    __host__ __device__ void init(int N, int KS_, int c_) { n = (N / BM) * KS_; KS = KS_; c = c_; }
    __host__ __device__ bool next(int i, Unit& u) const { if (i > 0 || c >= n) return false; u.pm = 0; u.pn = c / KS; u.ks = c % KS; u.tag = 0; return true; }
    __device__ __forceinline__ void a_ready(const Unit&) const {}
    __device__ __forceinline__ void done(const Unit&) const {}
};
__device__ __forceinline__ unsigned cvt_pk_bf16(float lo, float hi) { unsigned r; asm volatile("v_cvt_pk_bf16_f32 %0, %1, %2" : "=v"(r) : "v"(lo), "v"(hi)); return r; }
typedef float f32x2 __attribute__((ext_vector_type(2)));
__device__ __forceinline__ f32x2 gelu_pk(f32x2 v) {
    const f32x2 av = __builtin_elementwise_abs(v), d = av * 0.2316418882f + 1.0f;
    f32x2 t; t.x = __builtin_amdgcn_rcpf(d.x); t.y = __builtin_amdgcn_rcpf(d.y);
    f32x2 q = t * 0.5307027145f + (-0.7265760135f); q = q * t + 0.7107068705f; q = q * t + (-0.142248368f); q = q * t + 0.127414796f; q = q * t;
    const f32x2 s = (v * v) * (-0.72134752044f);
    f32x2 e; e.x = __builtin_amdgcn_exp2f(s.x); e.y = __builtin_amdgcn_exp2f(s.y);
    const f32x2 m = v * (q * e), r = v - m;
    f32x2 o; o.x = v.x < 0.f ? m.x : r.x; o.y = v.y < 0.f ? m.y : r.y; return o;
}

template <class Epi, class Sched, bool ALIGN_EPI = false, bool SP2 = false>
__device__ __forceinline__ void gemm_phase(PG8_LAS unsigned char* lds, const Gemm g, const Sched& S, const Epi& E) {
    int tid_ = threadIdx.x; asm volatile("" : "+v"(tid_));
    const int tid = tid_, wid = __builtin_amdgcn_readfirstlane(tid >> 6), lane = tid & 63, wr = wid >> 2, wc = wid & 3, fr = lane & 15, fq = lane >> 4;
    const int K = g.ld, nt = g.K / BK;
    unsigned voffA[2], voffB[2];
#pragma unroll
    for (int i = 0; i < 2; ++i) { int R, C; stage_rc(tid * 16 + i * 8192, R, C); const int Rb = Epi::PERM ? ((R & ~31) + perm32(R & 31)) : R;
        voffA[i] = (unsigned)(R * K + C) * 2u; voffB[i] = (unsigned)(Rb * K + C) * 2u; }
    const size_t kstep = (size_t)(BK * 2);
    const size_t hstep = (size_t)HALF * K * 2;
    const size_t tstep = 2 * hstep;
    const unsigned ldsw = (unsigned)wid * 1024u;
    const int aoff = lds_byte(wr * 64 + fr, fq * 8), boff = lds_byte(wc * 32 + fr, fq * 8);
#define PG8_SA(b, h) (((b) * 2 + (h)) * HTB)
#define PG8_SB(b, h) ((4 + (b) * 2 + (h)) * HTB)
#define PG8_STAGE(bufoff, gbase, voff) do { _Pragma("unroll") for (int _i = 0; _i < 2; ++_i) \
        __builtin_amdgcn_global_load_lds((const unsigned*)((const char*)(gbase) + (voff)[_i]), (PG8_LAS unsigned*)(lds + (bufoff) + ldsw + _i * 8192), 16, 0, 0); } while (0)
#define PG8_LDA(dst, b, h) do { _Pragma("unroll") for (int m = 0; m < 4; ++m) _Pragma("unroll") for (int k = 0; k < 2; ++k) dst[m][k] = *(const PG8_LAS bf16x8*)(lds + PG8_SA(b, h) + aoff + m * 2048 + k * 1024); } while (0)
#define PG8_LDB(dst, b, h) do { _Pragma("unroll") for (int n = 0; n < 2; ++n) _Pragma("unroll") for (int k = 0; k < 2; ++k) dst[n][k] = *(const PG8_LAS bf16x8*)(lds + PG8_SB(b, h) + boff + n * 2048 + k * 1024); } while (0)
#define PG8_MMA(ai, bj, At, Bt) do { __builtin_amdgcn_s_setprio(1); _Pragma("unroll") for (int m = 0; m < 4; ++m) _Pragma("unroll") for (int n = 0; n < 2; ++n) _Pragma("unroll") for (int k = 0; k < 2; ++k) \
        acc[ai][bj][m][n] = __builtin_amdgcn_mfma_f32_16x16x32_bf16(Bt[n][k], At[m][k], acc[ai][bj][m][n], 0, 0, 0); __builtin_amdgcn_s_setprio(0); } while (0)
#define PG8_WAIT_V(n) asm volatile("s_waitcnt vmcnt(" #n ")" ::: "memory")
#define PG8_WAIT_L(n) asm volatile("s_waitcnt lgkmcnt(" #n ")" ::: "memory")
#define PG8_BAR __builtin_amdgcn_s_barrier()
#define PG8_SCHED __builtin_amdgcn_sched_barrier(0)
    Unit cur, nxt; int ui = 0;
    if (!S.next(0, cur)) return;
    f32x4 acc[2][2][4][2];
#pragma unroll
    for (int a = 0; a < 2; ++a)
#pragma unroll
        for (int b = 0; b < 2; ++b)
#pragma unroll
            for (int m = 0; m < 4; ++m)
#pragma unroll
                for (int n = 0; n < 2; ++n) acc[a][b][m][n] = (f32x4){0.f, 0.f, 0.f, 0.f};
    bf16x8 At[4][2], B0[2][2], B1[2][2];
    const size_t sstep = (size_t)g.K * 2;
    const char* cA = (const char*)g.A + (size_t)cur.pm * tstep + (size_t)cur.ks * sstep; const char* cB = (const char*)g.Bt + (size_t)cur.pn * tstep + (size_t)cur.ks * sstep;
    S.a_ready(cur);
    if constexpr (SP2) {
        PG8_STAGE(PG8_SB(0, 0), cB, voffB); PG8_STAGE(PG8_SB(0, 1), cB + hstep, voffB); PG8_STAGE(PG8_SA(0, 0), cA, voffA); PG8_STAGE(PG8_SA(0, 1), cA + hstep, voffA);
        if (wr == 1) PG8_BAR;
        PG8_WAIT_V(2); PG8_BAR;
        PG8_STAGE(PG8_SB(1, 0), cB + kstep, voffB); PG8_STAGE(PG8_SA(1, 0), cA + kstep, voffA); PG8_STAGE(PG8_SB(1, 1), cB + hstep + kstep, voffB);
        PG8_WAIT_V(6); PG8_BAR;
    } else {
        PG8_STAGE(PG8_SB(0, 0), cB, voffB); PG8_STAGE(PG8_SA(0, 0), cA, voffA); PG8_STAGE(PG8_SB(0, 1), cB + hstep, voffB); PG8_STAGE(PG8_SA(0, 1), cA + hstep, voffA);
        if (wr == 1) PG8_BAR;
        PG8_WAIT_V(4); PG8_BAR;
        PG8_STAGE(PG8_SB(1, 0), cB + kstep, voffB); PG8_STAGE(PG8_SA(1, 0), cA + kstep, voffA); PG8_STAGE(PG8_SB(1, 1), cB + hstep + kstep, voffB);
        PG8_WAIT_V(6); PG8_BAR;
    }
    for (;;) {
        const bool has_next = S.next(ui + 1, nxt);
        const char* nA = has_next ? (const char*)g.A + (size_t)nxt.pm * tstep + (size_t)nxt.ks * sstep : cA; const char* nB = has_next ? (const char*)g.Bt + (size_t)nxt.pn * tstep + (size_t)nxt.ks * sstep : cB;
        asm volatile(".p2align 8" ::: "memory");
        for (int t = 0; t < nt; t += 2) {
            const bool last = (t == nt - 2);
            const char* a1 = cA + (size_t)(t + 1) * kstep;
            const char* a2 = last ? nA : cA + (size_t)(t + 2) * kstep; const char* b2 = last ? nB : cB + (size_t)(t + 2) * kstep;
            const char* a3 = a2 + kstep; const char* b3 = b2 + kstep;
            if (last && has_next) S.a_ready(nxt);
            if constexpr (Sched::HANDOFF) S.mid(cur, t, nt, wid, lane);
            if constexpr (SP2) {
            PG8_LDB(B0, 0, 0); PG8_LDB(B1, 0, 1); PG8_SCHED; PG8_LDA(At, 0, 0); PG8_STAGE(PG8_SA(1, 1), a1 + hstep, voffA);
            PG8_WAIT_V(8); PG8_WAIT_L(0); PG8_BAR; PG8_MMA(0, 0, At, B0); PG8_MMA(0, 1, At, B1); PG8_BAR; PG8_SCHED;
            PG8_LDA(At, 0, 1); PG8_STAGE(PG8_SB(0, 0), b2, voffB); PG8_STAGE(PG8_SB(0, 1), b2 + hstep, voffB); PG8_STAGE(PG8_SA(0, 0), a2, voffA);
            PG8_WAIT_V(8); PG8_WAIT_L(0); PG8_BAR; PG8_MMA(1, 0, At, B0); PG8_MMA(1, 1, At, B1); PG8_BAR; PG8_SCHED;
            PG8_LDB(B0, 1, 0); PG8_LDB(B1, 1, 1); PG8_SCHED; PG8_LDA(At, 1, 0); PG8_STAGE(PG8_SA(0, 1), a2 + hstep, voffA);
            PG8_WAIT_V(8); PG8_WAIT_L(0); PG8_BAR; PG8_MMA(0, 0, At, B0); PG8_MMA(0, 1, At, B1); PG8_BAR; PG8_SCHED;
            PG8_LDA(At, 1, 1); PG8_STAGE(PG8_SB(1, 0), b3, voffB); PG8_STAGE(PG8_SB(1, 1), b3 + hstep, voffB); PG8_STAGE(PG8_SA(1, 0), a3, voffA);
            PG8_WAIT_V(8); PG8_WAIT_L(0); PG8_BAR; PG8_MMA(1, 0, At, B0); PG8_MMA(1, 1, At, B1); PG8_BAR; PG8_SCHED;
            } else {
            PG8_LDB(B0, 0, 0); PG8_SCHED; PG8_LDA(At, 0, 0); PG8_STAGE(PG8_SA(1, 1), a1 + hstep, voffA);
            PG8_WAIT_L(8); PG8_BAR; PG8_WAIT_L(0); PG8_MMA(0, 0, At, B0); PG8_BAR; PG8_SCHED;
            PG8_LDB(B1, 0, 1); PG8_STAGE(PG8_SB(0, 0), b2, voffB);
            PG8_BAR; PG8_WAIT_L(0); PG8_MMA(0, 1, At, B1); PG8_BAR;
            PG8_LDA(At, 0, 1); PG8_STAGE(PG8_SA(0, 0), a2, voffA);
            PG8_BAR; PG8_WAIT_L(0); PG8_MMA(1, 0, At, B0); PG8_BAR; PG8_SCHED;
            PG8_STAGE(PG8_SB(0, 1), b2 + hstep, voffB);
            PG8_WAIT_V(6); PG8_BAR; PG8_MMA(1, 1, At, B1); PG8_BAR;
            PG8_LDB(B0, 1, 0); PG8_SCHED; PG8_LDA(At, 1, 0); PG8_STAGE(PG8_SA(0, 1), a2 + hstep, voffA);
            PG8_WAIT_L(8); PG8_BAR; PG8_WAIT_L(0); PG8_MMA(0, 0, At, B0); PG8_BAR; PG8_SCHED;
            PG8_LDB(B1, 1, 1); PG8_STAGE(PG8_SB(1, 0), b3, voffB);
            PG8_BAR; PG8_WAIT_L(0); PG8_MMA(0, 1, At, B1); PG8_BAR;
            PG8_LDA(At, 1, 1); PG8_STAGE(PG8_SA(1, 0), a3, voffA);
            PG8_BAR; PG8_WAIT_L(0); PG8_MMA(1, 0, At, B0); PG8_BAR; PG8_SCHED;
            PG8_STAGE(PG8_SB(1, 1), b3 + hstep, voffB);
            PG8_WAIT_V(6); PG8_BAR; PG8_MMA(1, 1, At, B1); PG8_BAR;
            }
        }
        if constexpr (ALIGN_EPI) { if (wr == 0) PG8_BAR; }
        if constexpr (!Epi::AFTER_DRAIN) { E(acc, cur, wr, wc, fr, fq); S.done(cur); }
        if (!has_next) break;
#pragma unroll
        for (int a = 0; a < 2; ++a)
#pragma unroll
            for (int b = 0; b < 2; ++b)
#pragma unroll
                for (int m = 0; m < 4; ++m)
#pragma unroll
                    for (int n = 0; n < 2; ++n) acc[a][b][m][n] = (f32x4){0.f, 0.f, 0.f, 0.f};
        cur = nxt; cA = nA; cB = nB; ++ui;
        if constexpr (ALIGN_EPI) { if (wr == 1) PG8_BAR; }
    }
    PG8_WAIT_V(0);
    if constexpr (!ALIGN_EPI) { if (wr == 0) PG8_BAR; }
    PG8_BAR;
    if constexpr (Epi::AFTER_DRAIN) { E.fused(acc, cur, wr, wc, fr, fq, lds, wid, lane); S.done(cur); }
#undef PG8_SA
#undef PG8_SB
#undef PG8_STAGE
#undef PG8_LDA
#undef PG8_LDB
#undef PG8_MMA
#undef PG8_WAIT_V
#undef PG8_WAIT_L
#undef PG8_BAR
#undef PG8_SCHED
}
}
namespace pg8 {
typedef unsigned u32x2v __attribute__((ext_vector_type(2)));
constexpr int E_MP = 8192;
struct EpiIn {
    static constexpr bool PERM = true, AFTER_DRAIN = false;
    unsigned char* ws; float* out; int l; float qscale;
    __device__ __forceinline__ void operator()(const f32x4 (&acc)[2][2][4][2], const Unit& u, int wr, int wc, int fr, int fq) const {
        asm volatile("" : "+v"(fr), "+v"(fq));
        const int row0 = u.pm * BM + wr * 64 + fr, colt = u.pn * BM + wc * 32 + 8 * fq;
        if (u.pn < 14) {
            float* PR = (float*)(ws + WS_PR); float* sh_p = out + O_SP + (size_t)l * 3520; float* sh_s = out + O_SS + (size_t)l * 16 * 3520;
#pragma unroll
            for (int ai = 0; ai < 2; ++ai)
#pragma unroll
                for (int m = 0; m < 4; ++m) { const int r = row0 + ai * HALF + m * 16;
#pragma unroll
                    for (int bj = 0; bj < 2; ++bj) { const int c = colt + bj * HALF; float* p = PR + (size_t)r * 3584 + c;
                        *(f32x4*)p = acc[ai][bj][m][0]; *(f32x4*)(p + 4) = acc[ai][bj][m][1];
                        if (c < 3520) {
                            if (r == E_MP - 1) { *(f32x4*)(sh_p + c) = acc[ai][bj][m][0]; *(f32x4*)(sh_p + c + 4) = acc[ai][bj][m][1]; }
                            if (r >= E_MP && (r & 15) == 15) { float* q = sh_s + (size_t)((r - E_MP) >> 4) * 3520 + c; *(f32x4*)q = acc[ai][bj][m][0]; *(f32x4*)(q + 4) = acc[ai][bj][m][1]; }
                        } } }
        } else {
            const int region = (u.pn - 14) >> 2, cl0 = colt - 3584 - region * 1024;
            static_assert(WS_KB - WS_QB == WS_VB - WS_KB && O_VP - O_KP == (size_t)2 * 8192 * 1024 && O_VS - O_KS == (size_t)2 * 256 * 1024, "equal spacing");
            bf16_t* B16 = (bf16_t*)(ws + WS_QB + (size_t)region * (WS_KB - WS_QB));
            const float sc = region == 0 ? qscale : 1.f;
            float* fp = out + O_KP + (size_t)(region == 2 ? 1 : 0) * (O_VP - O_KP) + (size_t)l * E_MP * 1024; float* fs = out + O_KS + (size_t)(region == 2 ? 1 : 0) * (O_VS - O_KS) + (size_t)l * 256 * 1024;
#pragma unroll
            for (int ai = 0; ai < 2; ++ai)
#pragma unroll
                for (int m = 0; m < 4; ++m) { const int r = row0 + ai * HALF + m * 16;
                    float* fo = (r < E_MP) ? fp + (size_t)r * 1024 : fs + (size_t)(r - E_MP) * 1024;
#pragma unroll
                    for (int bj = 0; bj < 2; ++bj) { const int c = cl0 + bj * HALF; const f32x4 v0 = acc[ai][bj][m][0] * sc, v1 = acc[ai][bj][m][1] * sc;
                        u32x4 w; w.x = cvt_pk_bf16(v0[0], v0[1]); w.y = cvt_pk_bf16(v0[2], v0[3]); w.z = cvt_pk_bf16(v1[0], v1[1]); w.w = cvt_pk_bf16(v1[2], v1[3]);
                        *(u32x4*)(B16 + (size_t)r * 1024 + c) = w;
                        if (region != 0) { __builtin_nontemporal_store(v0, (f32x4*)(fo + c)); __builtin_nontemporal_store(v1, (f32x4*)(fo + c + 4)); } } }
        }
    }
};
struct EpiRes {
    static constexpr bool PERM = true, AFTER_DRAIN = false;
    const float* src_p; const float* src_s; float* dst; const float* gate;
    __device__ __forceinline__ void operator()(const f32x4 (&acc)[2][2][4][2], const Unit& u, int wr, int wc, int fr, int fq) const {
        asm volatile("" : "+v"(fr), "+v"(fq));
        const int row0 = u.pm * BM + wr * 64 + fr, colt = u.pn * BM + wc * 32 + 8 * fq;
        f32x4 gt[2][2];
#pragma unroll
        for (int bj = 0; bj < 2; ++bj)
#pragma unroll
            for (int n = 0; n < 2; ++n) gt[bj][n] = *(const f32x4*)(gate + colt + bj * HALF + 4 * n);
#pragma unroll
        for (int ai = 0; ai < 2; ++ai)
#pragma unroll
            for (int mp = 0; mp < 1; ++mp) {
                f32x4 x[4][2][2];
#pragma unroll
                for (int mm = 0; mm < 4; ++mm) { const int r = row0 + ai * HALF + (4 * mp + mm) * 16; const float* s = src_p + (size_t)r * 2048 + colt;
#pragma unroll
                    for (int bj = 0; bj < 2; ++bj)
#pragma unroll
                        for (int n = 0; n < 2; ++n) x[mm][bj][n] = *(const f32x4*)(s + bj * HALF + 4 * n); }
#pragma unroll
                for (int mm = 0; mm < 4; ++mm) { const int m = 4 * mp + mm, r = row0 + ai * HALF + m * 16; float* d = dst + (size_t)r * 2048 + colt;
#pragma unroll
                    for (int bj = 0; bj < 2; ++bj)
#pragma unroll
                        for (int n = 0; n < 2; ++n) *(f32x4*)(d + bj * HALF + 4 * n) = x[mm][bj][n] + gt[bj][n] * acc[ai][bj][m][n]; }
                asm volatile("" ::: "memory");
            }
    }
};
struct EpiResSlab {
    static constexpr bool PERM = true, AFTER_DRAIN = false;
    float* slab; const float* gate;
    __device__ __forceinline__ void operator()(const f32x4 (&acc)[2][2][4][2], const Unit& u, int wr, int wc, int fr, int fq) const {
        asm volatile("" : "+v"(fr), "+v"(fq));
        const int row0 = wr * 64 + fr, colt = u.pn * BM + wc * 32 + 8 * fq;
#pragma unroll
        for (int ai = 0; ai < 2; ++ai)
#pragma unroll
            for (int mp = 0; mp < 2; ++mp) {
                f32x4 gt[2][2][2];
#pragma unroll
                for (int mm = 0; mm < 2; ++mm) { const int r = row0 + ai * HALF + (2 * mp + mm) * 16; const float* g = gate + (size_t)(1 + (r >> 4)) * 12288 + colt;
#pragma unroll
                    for (int bj = 0; bj < 2; ++bj)
#pragma unroll
                        for (int n = 0; n < 2; ++n) gt[mm][bj][n] = *(const f32x4*)(g + bj * HALF + 4 * n); }
#pragma unroll
                for (int mm = 0; mm < 2; ++mm) { const int m = 2 * mp + mm, r = row0 + ai * HALF + m * 16; float* d = slab + ((size_t)u.ks * 256 + r) * 2048 + colt;
#pragma unroll
                    for (int bj = 0; bj < 2; ++bj)
#pragma unroll
                        for (int n = 0; n < 2; ++n) *(f32x4*)(d + bj * HALF + 4 * n) = gt[mm][bj][n] * acc[ai][bj][m][n]; }
                asm volatile("" ::: "memory");
            }
    }
};
template <int CTRL> __device__ __forceinline__ float dppf(float old, float src) { return __builtin_bit_cast(float, __builtin_amdgcn_update_dpp(__builtin_bit_cast(int, old), __builtin_bit_cast(int, src), CTRL, 0xF, 0xF, false)); }
struct EpiUp {
    static constexpr bool PERM = true, AFTER_DRAIN = false;
    bf16_t* ACT; const float* cw; const float* cb; const float* sconv; float* halo; float* conv_p; float* conv_s; PG8_LAS float* hb;
    template <bool SAMP> __device__ __forceinline__ void run(const f32x4 (&acc)[2][2][4][2], const Unit& u, int wr, int wc, int fr, int fq) const {
        asm volatile("" : "+v"(fr), "+v"(fq));
        const int jl = wc * 32 + 8 * fq, j0 = u.pn * HALF + jl;
#pragma unroll
        for (int ai = 0; ai < 2; ++ai) { const int blk = 2 * ai + wr;
            if (!SAMP && fr >= 14) {
                if (blk < 3) { PG8_LAS float* h = hb + ((blk + 1) * 2 + (fr - 14)) * HALF + jl; *(PG8_LAS f32x4*)h = acc[ai][0][3][0]; *(PG8_LAS f32x4*)(h + 4) = acc[ai][0][3][1]; }
                else { float* t = halo + ((size_t)u.pm * 2 + (fr - 14)) * 5632 + j0; *(f32x4*)t = acc[ai][0][3][0]; *(f32x4*)(t + 4) = acc[ai][0][3][1];
                    if (u.pm == 31) { float* c = conv_p + (size_t)(fr - 14) * 5632 + j0; *(f32x4*)c = acc[ai][0][3][0]; *(f32x4*)(c + 4) = acc[ai][0][3][1]; } }
            }
            if (SAMP && fr >= 14) {
#pragma unroll
                for (int m = 0; m < 4; ++m) { const int sb = 8 * ai + 4 * wr + m; float* c = conv_s + ((size_t)sb * 2 + (fr - 14)) * 5632 + j0; *(f32x4*)c = acc[ai][0][m][0]; *(f32x4*)(c + 4) = acc[ai][0][m][1]; }
            }
        }
        asm volatile("s_waitcnt lgkmcnt(0)\n\ts_barrier" ::: "memory");
        f32x4 cwv[2][3], cbv[2];
#pragma unroll
        for (int n = 0; n < 2; ++n) { cwv[n][0] = *(const f32x4*)(cw + j0 + 4 * n); cwv[n][1] = *(const f32x4*)(cw + 5632 + j0 + 4 * n); cwv[n][2] = *(const f32x4*)(cw + 2 * 5632 + j0 + 4 * n); cbv[n] = *(const f32x4*)(cb + j0 + 4 * n); }
#pragma unroll
        for (int ai = 0; ai < 2; ++ai) { const int blk = 2 * ai + wr;
#pragma unroll
            for (int m = 0; m < 4; ++m) { const int r = u.pm * BM + ai * HALF + wr * 64 + m * 16 + fr;
                u32x4 w;
#pragma unroll
                for (int n = 0; n < 2; ++n) {
                    f32x4 pv = (f32x4){0.f, 0.f, 0.f, 0.f};
                    if (SAMP) { if (fr >= 14) { const int sb = 8 * ai + 4 * wr + m; pv = *(const f32x4*)(sconv + ((size_t)sb * 2 + (fr - 14)) * 5632 + j0 + 4 * n); } asm volatile("" : "+v"(pv)); }
                    else if (m == 0) { if (blk > 0 && fr >= 14) pv = *(const PG8_LAS f32x4*)(hb + (blk * 2 + (fr - 14)) * HALF + jl + 4 * n); asm volatile("" : "+v"(pv)); }
                    else pv = acc[ai][0][m > 0 ? m - 1 : 0][n];
                    const f32x4 w0 = cwv[n][0], w1 = cwv[n][1], w2 = cwv[n][2], bb = cbv[n];
                    f32x4 o;
#pragma unroll
                    for (int i = 0; i < 4; ++i) { const float cur = acc[ai][0][m][n][i], pr = pv[i];
                        const float t1 = dppf<0x121>(pr, pr), p1 = dppf<0x111>(t1, cur);
                        const float t2 = dppf<0x122>(pr, pr), p2 = dppf<0x112>(t2, cur);
                        o[i] = bb[i] + w0[i] * p2 + w1[i] * p1 + w2[i] * cur; }
                    const f32x2 g0 = gelu_pk((f32x2){o[0], o[1]}), g1 = gelu_pk((f32x2){o[2], o[3]});
                    const f32x4 uv = acc[ai][1][m][n];
                    const unsigned lo = cvt_pk_bf16(g0.x * uv[0], g0.y * uv[1]), hi = cvt_pk_bf16(g1.x * uv[2], g1.y * uv[3]);
                    if (n == 0) { w.x = lo; w.y = hi; } else { w.z = lo; w.w = hi; }
                }
                const bool head = (!SAMP && u.pm > 0 && blk == 0 && m == 0 && fr < 2);
                if (!head) *(u32x4*)(ACT + (size_t)r * 5632 + j0) = w;
                else { float* hg = halo + (size_t)32 * 2 * 5632 + ((size_t)u.pm * 2 + fr) * 5632 + j0; float* hv = hg + (size_t)32 * 2 * 5632;
                    *(f32x4*)hg = acc[ai][0][m][0]; *(f32x4*)(hg + 4) = acc[ai][0][m][1]; *(f32x4*)hv = acc[ai][1][m][0]; *(f32x4*)(hv + 4) = acc[ai][1][m][1]; }
                asm volatile("" ::: "memory");
            } }
    }
    __device__ __forceinline__ void operator()(const f32x4 (&acc)[2][2][4][2], const Unit& u, int wr, int wc, int fr, int fq) const {
        if (u.pm == 32) run<true>(acc, u, wr, wc, fr, fq); else run<false>(acc, u, wr, wc, fr, fq);
    }
};
}
#include <hip/hip_bf16.h>
#include <cmath>
namespace attn_body {
using bf16=__hip_bfloat16;
using bf16x8=__attribute__((ext_vector_type(8)))short;
using s16x4=__attribute__((ext_vector_type(4)))short;
using f32x16=__attribute__((ext_vector_type(16)))float;
using u32x4=__attribute__((ext_vector_type(4)))unsigned;
constexpr int BATCH=1,NHEAD=16,SEQ=8192,D=64,DM=NHEAD*D;
constexpr int NW=8,QBLK=32,QB=QBLK*NW,KVBLK=64,NQB=SEQ/QB;
constexpr int ATTN_PITCH=DM, ATTN_UNIT_ROWS=QB, OPITCH=2048;
__device__ __forceinline__ int crow(int r,int hi){return (r&3)+8*(r>>2)+4*hi;}
#define SBAR() __builtin_amdgcn_sched_barrier(0)
__device__ __forceinline__ void bmask(f32x16&p0,f32x16&p1,int t,int cq,int qabs,int hi,const __attribute__((address_space(3))) float*lut){
  if(t>cq){
    #pragma unroll
    for(int r=0;r<16;++r){p0[r]=-INFINITY;p1[r]=-INFINITY;}
  } else {
    const int d0=64*t+4*hi-qabs+128;
    #pragma unroll
    for(int r=0;r<16;++r){int i0=d0+(r&3)+8*(r>>2); int i1=i0+32; i0=i0<0?0:i0; i1=i1<0?0:i1; p0[r]+=lut[i0]; p1[r]+=lut[i1];}
  }
}

constexpr int NSLOT=3, SLOTB=8192;
constexpr int LDS_K=0, LDS_V=NSLOT*SLOTB, LDS_WS=2*NSLOT*SLOTB, LDS_OST=LDS_WS+NW*64*4, LDS_BYTES=LDS_OST+NW*4096;
constexpr float C2=0.125f*1.4426950408889634f;
__device__ __forceinline__ void glds16(const void*gsrc,unsigned lds_dst){unsigned keep;
  asm volatile("s_mov_b32 %0, m0\n\ts_mov_b32 m0, %2\n\ts_nop 0\n\tglobal_load_lds_dwordx4 %1, off\n\ts_mov_b32 m0, %0":"=&s"(keep):"v"(gsrc),"s"(lds_dst):"memory");}
__device__ __forceinline__ float max3f(float a,float b,float c){float r;asm("v_max3_f32 %0, %1, %2, %3":"=v"(r):"v"(a),"v"(b),"v"(c));return r;}
__device__ __forceinline__ float max2f(float a,float b){float r;asm("v_max_f32_e32 %0, %1, %2":"=v"(r):"v"(a),"v"(b));return r;}
__device__ __forceinline__ float fadd_s(float a,float b){float r;asm("v_add_f32_e32 %0, %1, %2":"=v"(r):"v"(a),"v"(b));return r;}
__device__ __forceinline__ float fsub_s(float a,float b){float r;asm("v_sub_f32_e32 %0, %1, %2":"=v"(r):"v"(a),"v"(b));return r;}
typedef float f32x2_t __attribute__((ext_vector_type(2))); typedef __bf16 bf16x2_t __attribute__((ext_vector_type(2)));
__device__ __forceinline__ unsigned cvtpk_s(float lo,float hi){f32x2_t v={lo,hi};bf16x2_t b=__builtin_convertvector(v,bf16x2_t);return __builtin_bit_cast(unsigned,b);}
#define WAIT_BAR(N) asm volatile("s_waitcnt vmcnt(" #N ") lgkmcnt(0)\n\ts_barrier":::"memory")

__device__ __forceinline__ void qkt(f32x16&p0,f32x16&p1,const char*Kslot,const bf16x8*qr,const f32x16&negm,int r32,int hi){
  const char*kb=Kslot+hi*1024+r32*16;
  #pragma unroll
  for(int d0=0;d0<4;++d0){
    const bf16x8 b0=*reinterpret_cast<const bf16x8*>(kb+d0*2048);
    const bf16x8 b1=*reinterpret_cast<const bf16x8*>(kb+d0*2048+512);
    if(d0==0){p0=__builtin_amdgcn_mfma_f32_32x32x16_bf16(b0,qr[0],negm,0,0,0);p1=__builtin_amdgcn_mfma_f32_32x32x16_bf16(b1,qr[0],negm,0,0,0);}
    else{p0=__builtin_amdgcn_mfma_f32_32x32x16_bf16(b0,qr[d0],p0,0,0,0);p1=__builtin_amdgcn_mfma_f32_32x32x16_bf16(b1,qr[d0],p1,0,0,0);}}
}
typedef __attribute__((address_space(3))) const char* lds_cptr;
typedef short v4i16_t __attribute__((ext_vector_type(4)));
__device__ __forceinline__ void kload8(bf16x8*kf,lds_cptr kp){
  kf[0]=*(const __attribute__((address_space(3))) bf16x8*)(kp);      kf[1]=*(const __attribute__((address_space(3))) bf16x8*)(kp+512);
  kf[2]=*(const __attribute__((address_space(3))) bf16x8*)(kp+2048); kf[3]=*(const __attribute__((address_space(3))) bf16x8*)(kp+2560);
  kf[4]=*(const __attribute__((address_space(3))) bf16x8*)(kp+4096); kf[5]=*(const __attribute__((address_space(3))) bf16x8*)(kp+4608);
  kf[6]=*(const __attribute__((address_space(3))) bf16x8*)(kp+6144); kf[7]=*(const __attribute__((address_space(3))) bf16x8*)(kp+6656);
}
__device__ __forceinline__ void kload2(bf16x8*kf,lds_cptr kp,int j){ kf[2*j]=*(const __attribute__((address_space(3))) bf16x8*)(kp+j*2048); kf[2*j+1]=*(const __attribute__((address_space(3))) bf16x8*)(kp+j*2048+512); }
__device__ __forceinline__ s16x4 vtr(lds_cptr p){ return __builtin_bit_cast(s16x4,__builtin_amdgcn_ds_read_tr16_b64_v4i16((__attribute__((address_space(3))) v4i16_t*)p)); }
__device__ __forceinline__ float rowmax(const f32x16&p0,const f32x16&p1){
  float a=max3f(p0[0],p0[1],p1[0]),b=max3f(p0[2],p0[3],p1[1]);a=max3f(a,p1[2],p1[3]);
  #pragma unroll
  for(int r=4;r<16;r+=4){a=max3f(a,p0[r],p0[r+1]);b=max3f(b,p0[r+2],p0[r+3]);a=max3f(a,p1[r],p1[r+1]);b=max3f(b,p1[r+2],p1[r+3]);}
  const float m=max2f(a,b);
  const PL32 rr=pl32(m);
  return max2f(rr.a,rr.b);
}
__device__ __forceinline__ void pv(f32x16*o,int vb,bf16x8 pa0,bf16x8 pa1,bf16x8 pa2,bf16x8 pa3){
  #pragma unroll
  for(int d0=0;d0<2;++d0){s16x4 lo[4],hi[4];
    #pragma unroll
    for(int ks=0;ks<4;++ks){
      asm volatile("ds_read_b64_tr_b16 %0,%1 offset:%c2":"=&v"(lo[ks]):"v"(vb),"i"(d0*4096+ks*1024):"memory");
      asm volatile("ds_read_b64_tr_b16 %0,%1 offset:%c2":"=&v"(hi[ks]):"v"(vb),"i"(d0*4096+ks*1024+512):"memory");}
    asm volatile("s_waitcnt lgkmcnt(0)":::"memory");SBAR();
    #define PK(k) (bf16x8){lo[k][0],lo[k][1],lo[k][2],lo[k][3],hi[k][0],hi[k][1],hi[k][2],hi[k][3]}
    o[d0]=__builtin_amdgcn_mfma_f32_32x32x16_bf16(pa0,PK(0),o[d0],0,0,0);
    o[d0]=__builtin_amdgcn_mfma_f32_32x32x16_bf16(pa1,PK(1),o[d0],0,0,0);
    o[d0]=__builtin_amdgcn_mfma_f32_32x32x16_bf16(pa2,PK(2),o[d0],0,0,0);
    o[d0]=__builtin_amdgcn_mfma_f32_32x32x16_bf16(pa3,PK(3),o[d0],0,0,0);
    #undef PK
  }
}

#ifndef ATTN_STORE16
#define ATTN_STORE16(p,v) (*(u32x4*)(p)=(v))
#endif
template<int THRL> __device__ __forceinline__ void attn_unit(int qb,int qkcol,int vcol,int ocol,int hh,const float*__restrict__ reltab,const bf16*Q,const bf16*__restrict__ K,const bf16*__restrict__ V,bf16*O,char*shm,const __attribute__((address_space(3))) float*lut){
  const int b=0;
  int tid_=threadIdx.x; asm volatile("":"+v"(tid_));
  const int tid=tid_,lane=tid&63,r32=lane&31,hi=lane>>5; const int wid=__builtin_amdgcn_readfirstlane(tid>>6);
  const long rowbase=(long)b*SEQ; const int q0=qb*QB;
  const bf16*Qw=Q+(rowbase+q0+wid*QBLK)*DM+qkcol;
  const bf16*Kh=K+rowbase*DM+qkcol,*Vh=V+rowbase*DM+vcol;
  const unsigned lds0=(unsigned)(uintptr_t)shm;
  float*wsf=(float*)(shm+LDS_WS)+wid*64;
  const bf16*ksrc=Kh+(long)lane*DM+wid*8;
  const bf16*vsrc=Vh+(long)(16*(wid&3)+(lane>>2))*DM+(wid>>2)*32+(lane&3)*8;
  const unsigned kdst=lds0+LDS_K+wid*1024, vdst=lds0+LDS_V+wid*1024;
  #define DMA_K(t,slot) glds16(ksrc+(long)(t)*KVBLK*DM,(unsigned)__builtin_amdgcn_readfirstlane(kdst+(slot)))
  #define DMA_V(t,slot) glds16(vsrc+(long)(t)*KVBLK*DM,(unsigned)__builtin_amdgcn_readfirstlane(vdst+(slot)))
  const int vb0=(int)(lds0+LDS_V)+((lane>>4)&1)*32+(lane&3)*8+(4*hi+((lane&15)>>2))*64;
  const char*Kbase=shm+LDS_K; bf16x8 kf[8];
  const lds_cptr shm3=(lds_cptr)shm; const lds_cptr kp0=shm3+LDS_K+hi*1024+r32*16; const lds_cptr vp0=shm3+LDS_V+((lane>>4)&1)*32+(lane&3)*8+(4*hi+((lane&15)>>2))*64;
  const int NT=(q0+QB)/KVBLK;
  const int cq=(q0>>6)+(wid>>1), cqm2=cq-2, qabs=q0+wid*QBLK+r32;
  DMA_K(0,0);DMA_V(0,0);DMA_K(1,SLOTB);
  bf16x8 qr[4];
  #pragma unroll
  for(int d0=0;d0<4;++d0)qr[d0]=*reinterpret_cast<const bf16x8*>(&Qw[(long)r32*DM+d0*16+hi*8]);
  float mhat=0.f,l_reg=0.f;f32x16 o[2];o[0]=f32x16{};o[1]=f32x16{};f32x16 negm=f32x16{};asm volatile("":"+v"(negm));
  const int qrel=wid*QBLK+r32;
  #define CMASK(P0,P1,t) do{ if((t)>=cqm2)bmask(P0,P1,(t),cq,qabs,hi,lut);}while(0)
  bool resc=false;
  #define START(P0,P1) do{ const float rm=rowmax(P0,P1); resc=false; \
    { const float dl=rm; mhat=fadd_s(mhat,dl); \
      _Pragma("unroll") for(int r=0;r<16;++r){P0[r]=fsub_s(P0[r],dl);P1[r]=fsub_s(P1[r],dl);} \
      _Pragma("unroll") for(int r=0;r<16;++r)negm[r]=-mhat; asm volatile("":"+v"(negm)); } \
    _Pragma("unroll") for(int r=0;r<16;++r)P0[r]=__builtin_amdgcn_exp2f(P0[r]); }while(0)
  #define RESC() do{ if(resc){ asm volatile("s_waitcnt lgkmcnt(0)":::"memory"); \
      _Pragma("unroll") for(int d_=0;d_<2;++d_) _Pragma("unroll") for(int r=0;r<16;++r)o[d_][r]*=wsf[crow(r,hi)]; } }while(0)
  f32x16 pA0,pA1,pB0,pB1;
  int sl_prev=0,sl_cur=0,sl_next=SLOTB;
  #define ROT() do{sl_prev=sl_cur;sl_cur=sl_next;sl_next=(sl_next==(NSLOT-1)*SLOTB)?0:sl_next+SLOTB;}while(0)
  DMA_K(2,2*SLOTB);
  WAIT_BAR(3);
  qkt(pA0,pA1,Kbase,qr,negm,r32,hi);asm volatile("s_nop 15\n\ts_nop 7":"+v"(pA0),"+v"(pA1));CMASK(pA0,pA1,0);
  START(pA0,pA1);
  _Pragma("unroll") for(int r=0;r<16;++r)pA1[r]=__builtin_amdgcn_exp2f(pA1[r]);
  WAIT_BAR(0);
  DMA_K(3,0);DMA_V(1,SLOTB);
  ROT();
  kload8(kf,kp0+sl_cur);
  WAIT_BAR(2);
  s16x4 vlo[8],vhi[8]; u32x4 pw0,pw1,pw2,pw3;
  #define PKW(P,B) cvtpk_s(P[B],P[B+1])
  #define PAF(k) __builtin_bit_cast(bf16x8,pw##k)
  #define VFR(i) (bf16x8){vlo[i][0],vlo[i][1],vlo[i][2],vlo[i][3],vhi[i][0],vhi[i][1],vhi[i][2],vhi[i][3]}
  #define PIN(x) asm volatile("":"+v"(x))
  #define MX3(a,b,c) __builtin_fmaxf(__builtin_fmaxf((a),(b)),(c))
  #define GAPA(MF,A0,A1,A2,A3,W0,W1,PW) do{ MF; sacc+=A0; sacc+=A1; sacc+=A2; sacc+=A3; PIN(sacc); W0; W1; PIN(PW); SBAR(); }while(0)
  #define EX(v) __builtin_amdgcn_exp2f(v)
  #define GAPB(MF,X,B) do{ MF; X[B]=EX(X[B]); X[B+1]=EX(X[B+1]); X[B+2]=EX(X[B+2]); X[B+3]=EX(X[B+3]); PIN(X); SBAR(); }while(0)
  #define VRD(i) do{ vlo[i]=vtr(vp_+(((i)>>2)*4096+((i)&3)*1024)); vhi[i]=vtr(vp_+(((i)>>2)*4096+((i)&3)*1024+512)); }while(0)
  #define KRD(G,j) do{ if(G){ kload2(kf,kp0+sl_next,j); SBAR(); } }while(0)
  #define STEP(C0,C1,P0,P1,t,GK,GV,GL) do{ SBAR(); \
    const lds_cptr vp_=vp0+sl_prev; \
    VRD(0); SBAR(); float sacc=(P0[0]+P0[1]); \
    GAPA(C0=__builtin_amdgcn_mfma_f32_32x32x16_bf16(kf[0],qr[0],negm,0,0,0), P0[2],P0[3],P0[4],P0[5],     pw0[0]=PKW(P0,0), pw0[1]=PKW(P0,2), pw0); \
    VRD(4); SBAR(); GAPA(C1=__builtin_amdgcn_mfma_f32_32x32x16_bf16(kf[1],qr[0],negm,0,0,0), P0[6],P0[7],P0[8],P0[9],     pw0[2]=PKW(P0,4), pw0[3]=PKW(P0,6), pw0); \
    VRD(1); SBAR(); GAPA(C0=__builtin_amdgcn_mfma_f32_32x32x16_bf16(kf[2],qr[1],C0,0,0,0),   P0[10],P0[11],P0[12],P0[13], pw1[0]=PKW(P0,8), pw1[1]=PKW(P0,10), pw1); \
    VRD(5); SBAR(); GAPA(C1=__builtin_amdgcn_mfma_f32_32x32x16_bf16(kf[3],qr[1],C1,0,0,0),   P0[14],P0[15],P1[0],P1[1],   pw1[2]=PKW(P0,12),pw1[3]=PKW(P0,14), pw1); \
    VRD(2); SBAR(); GAPA(C0=__builtin_amdgcn_mfma_f32_32x32x16_bf16(kf[4],qr[2],C0,0,0,0),   P1[2],P1[3],P1[4],P1[5],     pw2[0]=PKW(P1,0), pw2[1]=PKW(P1,2), pw2); \
    VRD(6); SBAR(); GAPA(C1=__builtin_amdgcn_mfma_f32_32x32x16_bf16(kf[5],qr[2],C1,0,0,0),   P1[6],P1[7],P1[8],P1[9],     pw2[2]=PKW(P1,4), pw2[3]=PKW(P1,6), pw2); \
    VRD(3); SBAR(); GAPA(C0=__builtin_amdgcn_mfma_f32_32x32x16_bf16(kf[6],qr[3],C0,0,0,0),   P1[10],P1[11],P1[12],P1[13], pw3[0]=PKW(P1,8), pw3[1]=PKW(P1,10), pw3); \
    VRD(7); SBAR(); GAPA(C1=__builtin_amdgcn_mfma_f32_32x32x16_bf16(kf[7],qr[3],C1,0,0,0),   P1[14],P1[15],0.f,0.f,       pw3[2]=PKW(P1,12),pw3[3]=PKW(P1,14), pw3); \
    l_reg+=sacc; \
    if(GK){DMA_K((t)+3,sl_cur);} if(GV){DMA_V((t)+1,sl_next);} \
    CMASK(C0,C1,t); \
    { float a=MX3(C0[0],C0[1],C1[0]),b=MX3(C0[2],C0[3],C1[1]); a=MX3(a,C1[2],C1[3]); \
      _Pragma("unroll") for(int r=4;r<16;r+=4){a=MX3(a,C0[r],C0[r+1]);b=MX3(b,C0[r+2],C0[r+3]);a=MX3(a,C1[r],C1[r+1]);b=MX3(b,C1[r+2],C1[r+3]);} \
      float rm=__builtin_fmaxf(a,b); { const PL32 rr=pl32(rm); rm=__builtin_fmaxf(rr.a,rr.b); } \
      resc=false; \
      if(__builtin_expect(__any(rm>(float)THRL),0)){ const float dl=__builtin_fmaxf(rm,0.f); mhat+=dl; \
        _Pragma("unroll") for(int r=0;r<16;++r){C0[r]-=dl;C1[r]-=dl;} \
        _Pragma("unroll") for(int r=0;r<16;++r)negm[r]=-mhat; asm volatile("":"+v"(negm)); \
        const float f=__builtin_amdgcn_exp2f(-dl); l_reg*=f; if(hi==0)wsf[r32]=f; resc=true; } } \
    SBAR(); \
    GAPB(o[0]=__builtin_amdgcn_mfma_f32_32x32x16_bf16(PAF(0),VFR(0),o[0],0,0,0), C0,0); \
    GAPB(o[1]=__builtin_amdgcn_mfma_f32_32x32x16_bf16(PAF(0),VFR(4),o[1],0,0,0), C0,4); \
    KRD(GL,0); GAPB(o[0]=__builtin_amdgcn_mfma_f32_32x32x16_bf16(PAF(1),VFR(1),o[0],0,0,0), C0,8); \
    KRD(GL,1); GAPB(o[1]=__builtin_amdgcn_mfma_f32_32x32x16_bf16(PAF(1),VFR(5),o[1],0,0,0), C0,12); \
    KRD(GL,2); GAPB(o[0]=__builtin_amdgcn_mfma_f32_32x32x16_bf16(PAF(2),VFR(2),o[0],0,0,0), C1,0); \
    KRD(GL,3); GAPB(o[1]=__builtin_amdgcn_mfma_f32_32x32x16_bf16(PAF(2),VFR(6),o[1],0,0,0), C1,4); \
    GAPB(o[0]=__builtin_amdgcn_mfma_f32_32x32x16_bf16(PAF(3),VFR(3),o[0],0,0,0), C1,8); \
    GAPB(o[1]=__builtin_amdgcn_mfma_f32_32x32x16_bf16(PAF(3),VFR(7),o[1],0,0,0), C1,12); \
    }while(0)
  int t=1;
  #undef CMASK
  #define CMASK(P0,P1,t) do{}while(0)
  for(;t+7<NT;t+=2){
    STEP(pB0,pB1,pA0,pA1,t,true,true,true);     WAIT_BAR(2); RESC(); ROT();
    STEP(pA0,pA1,pB0,pB1,t+1,true,true,true);   WAIT_BAR(2); RESC(); ROT();
  }
  #undef CMASK
  #define CMASK(P0,P1,t) do{ if((t)>=cqm2)bmask(P0,P1,(t),cq,qabs,hi,lut);}while(0)
  #define ENDW(tt) do{ if((tt)+3<NT){WAIT_BAR(2);} else if((tt)+2<NT){WAIT_BAR(1);} else {WAIT_BAR(0);} }while(0)
  for(;t+1<NT;t+=2){
    STEP(pB0,pB1,pA0,pA1,t,(t+3<NT),(t+1<NT),(t+1<NT));       ENDW(t);   RESC(); ROT();
    STEP(pA0,pA1,pB0,pB1,t+1,(t+4<NT),(t+2<NT),(t+2<NT));     ENDW(t+1); RESC(); ROT();
  }
  STEP(pB0,pB1,pA0,pA1,NT-1,false,false,false); RESC();
  { float sacc=pB0[0]+pB0[1]; _Pragma("unroll") for(int r=2;r<16;++r)sacc+=pB0[r]; _Pragma("unroll") for(int r=0;r<16;++r)sacc+=pB1[r]; l_reg+=sacc;
    pw0=(u32x4){PKW(pB0,0),PKW(pB0,2),PKW(pB0,4),PKW(pB0,6)};pw1=(u32x4){PKW(pB0,8),PKW(pB0,10),PKW(pB0,12),PKW(pB0,14)};pw2=(u32x4){PKW(pB1,0),PKW(pB1,2),PKW(pB1,4),PKW(pB1,6)};pw3=(u32x4){PKW(pB1,8),PKW(pB1,10),PKW(pB1,12),PKW(pB1,14)};
    SBAR(); pv(o,vb0+sl_cur,PAF(0),PAF(1),PAF(2),PAF(3)); }
  #undef PKW
  #undef PAF
  #undef VFR
  #undef PIN
  #undef MX3
  #undef GAPA
  #undef GAPB
  #undef EX
  #undef VRD
  #undef KRD
  #undef STEP
  #undef ENDW
  {const PL32 rr=pl32(l_reg);l_reg=rr.a+rr.b;}
  if(hi==0)wsf[32+r32]=l_reg;asm volatile("s_waitcnt lgkmcnt(0)":::"memory");
  float rli[16];
  #pragma unroll
  for(int r=0;r<16;++r)rli[r]=__builtin_amdgcn_rcpf(wsf[32+crow(r,hi)]);
  bf16*Ow=O+(rowbase+q0+wid*QBLK)*(long)OPITCH+ocol;
  { bf16*stg=(bf16*)(shm+LDS_OST)+wid*2048;
    #pragma unroll
    for(int r=0;r<16;++r){const int orow=crow(r,hi);
      #pragma unroll
      for(int d0=0;d0<2;++d0)stg[orow*64+d0*32+r32]=__float2bfloat16(o[d0][r]*rli[r]);}
    asm volatile("s_waitcnt lgkmcnt(0)":::"memory");
    #pragma unroll
    for(int i=0;i<4;++i){const int row=i*8+(lane>>3),ch=lane&7; const u32x4 v=*(const u32x4*)(stg+row*64+ch*8); ATTN_STORE16(Ow+(long)row*OPITCH+ch*8,v);} }
  asm volatile("s_waitcnt lgkmcnt(0)\n\ts_barrier":::"memory");
  #undef DMA_K
  #undef DMA_V
  #undef CMASK
  #undef START
  #undef RESC
  #undef ROT
}
typedef __attribute__((address_space(3))) const char* lds_cp;
__device__ __forceinline__ void qkt_half(f32x16&p,lds_cp Kslot,const bf16x8*qr,const f32x16&negm,int r32,int hi,int kh){
  lds_cp kb=Kslot+hi*1024+(r32+32*kh)*16;
  #pragma unroll
  for(int d0=0;d0<4;++d0){ const bf16x8 b=*(const __attribute__((address_space(3))) bf16x8*)(kb+d0*2048);
    if(d0==0)p=__builtin_amdgcn_mfma_f32_32x32x16_bf16(b,qr[0],negm,0,0,0); else p=__builtin_amdgcn_mfma_f32_32x32x16_bf16(b,qr[d0],p,0,0,0);}
}
__device__ __forceinline__ void pv_half(f32x16*o,int vb,bf16x8 pa0,bf16x8 pa1){
  #pragma unroll
  for(int d0=0;d0<2;++d0){s16x4 lo[2],hi[2];
    #pragma unroll
    for(int ks=0;ks<2;++ks){
      asm volatile("ds_read_b64_tr_b16 %0,%1 offset:%c2":"=&v"(lo[ks]):"v"(vb),"i"(d0*4096+ks*1024):"memory");
      asm volatile("ds_read_b64_tr_b16 %0,%1 offset:%c2":"=&v"(hi[ks]):"v"(vb),"i"(d0*4096+ks*1024+512):"memory");}
    asm volatile("s_waitcnt lgkmcnt(0)":::"memory");SBAR();
    #define PK(k) (bf16x8){lo[k][0],lo[k][1],lo[k][2],lo[k][3],hi[k][0],hi[k][1],hi[k][2],hi[k][3]}
    o[d0]=__builtin_amdgcn_mfma_f32_32x32x16_bf16(pa0,PK(0),o[d0],0,0,0);
    o[d0]=__builtin_amdgcn_mfma_f32_32x32x16_bf16(pa1,PK(1),o[d0],0,0,0);
    #undef PK
  }
}
constexpr int F_SLOTV=2*SLOTB, F_LDS_K=0, F_LDS_V=NSLOT*SLOTB, F_LDS_WS=F_LDS_V+NSLOT*F_SLOTV, F_LDS_OST=F_LDS_WS+NW*64*4, F_LDS_BYTES=F_LDS_OST+4*8192;
__device__ __forceinline__ void bmask1(f32x16&p,int t,int cq,int qabs,int hi,int kh,const __attribute__((address_space(3))) float*lut){
  if(t>cq){
    #pragma unroll
    for(int r=0;r<16;++r)p[r]=-INFINITY;
  } else {
    const int d0=64*t+32*kh+4*hi-qabs+128;
    #pragma unroll
    for(int r=0;r<16;++r){int i0=d0+(r&3)+8*(r>>2); i0=i0<0?0:i0; p[r]+=lut[i0];}
  }
}
template<int THRL> __device__ __forceinline__ void attn_unit_f(int qb,int qkcol,int vcol,int ocol,const bf16*Q,const bf16*__restrict__ K,const bf16*__restrict__ V,bf16*O,char*shm,const __attribute__((address_space(3))) float*lut){
  int tid_=threadIdx.x; asm volatile("":"+v"(tid_));
  const int tid=tid_,lane=tid&63,r32=lane&31,hi=lane>>5; const int wid=__builtin_amdgcn_readfirstlane(tid>>6); const int pr=wid&3,kh=wid>>2;
  const int q0=qb*128;
  const bf16*Qw=Q+(long)(q0+pr*QBLK)*DM+qkcol;
  const bf16*Kh=K+qkcol,*Vh=V+vcol;
  const unsigned lds0=(unsigned)(uintptr_t)shm;
  float*wsf=(float*)(shm+F_LDS_WS)+wid*64;
  const bf16*ksrc=Kh+(long)lane*DM+wid*8;
  const bf16*vsrc=Vh+(long)(16*(wid&3)+(lane>>2))*DM+(wid>>2)*32+(lane&3)*8;
  const unsigned kdst=lds0+F_LDS_K+wid*1024, vdst=lds0+F_LDS_V+wid*1024;
  #define DMA_K(t,slot) glds16(ksrc+(long)(t)*KVBLK*DM,(unsigned)__builtin_amdgcn_readfirstlane(kdst+(slot)))
  #define DMA_V(t,slot) do{ glds16(vsrc+(long)(t)*KVBLK*DM,(unsigned)__builtin_amdgcn_readfirstlane(vdst+2*(slot))); glds16(vsrc+(long)(t)*KVBLK*DM+64,(unsigned)__builtin_amdgcn_readfirstlane(vdst+2*(slot)+8192)); }while(0)
  const int vb0=(int)(lds0+F_LDS_V)+((lane>>4)&1)*32+(lane&3)*8+(4*hi+((lane&15)>>2))*64+kh*2048;
  bf16x8 kf[4];
  const lds_cptr shm3=(lds_cptr)shm; const lds_cptr kp0=shm3+F_LDS_K+hi*1024+r32*16+kh*512; const lds_cptr vp0=shm3+F_LDS_V+((lane>>4)&1)*32+(lane&3)*8+(4*hi+((lane&15)>>2))*64+kh*2048;
  const int NT_=(q0+128)/KVBLK; const int NT=NT_<4?4:NT_;
  const int cq=(q0>>6)+(pr>>1), cqm2=cq-2, qabs=q0+pr*QBLK+r32;
  DMA_K(0,0);DMA_V(0,0);DMA_K(1,SLOTB);
  bf16x8 qr[4];
  #pragma unroll
  for(int d0=0;d0<4;++d0)qr[d0]=*reinterpret_cast<const bf16x8*>(&Qw[(long)r32*DM+d0*16+hi*8]);
  float mhat=0.f,l_reg=0.f;f32x16 o[4];o[0]=f32x16{};o[1]=f32x16{};o[2]=f32x16{};o[3]=f32x16{};f32x16 negm=f32x16{};asm volatile("":"+v"(negm));
  #define CMASK(P,t) do{ if((t)>=cqm2)bmask1(P,(t),cq,qabs,hi,kh,lut);}while(0)
  bool resc=false;
  #define RESC() do{ if(resc){ asm volatile("s_waitcnt lgkmcnt(0)":::"memory"); \
      _Pragma("unroll") for(int d_=0;d_<4;++d_) _Pragma("unroll") for(int r=0;r<16;++r)o[d_][r]*=wsf[crow(r,hi)]; } }while(0)
  f32x16 pA,pB;
  int sl_prev=0,sl_cur=0,sl_next=SLOTB;
  #define ROT() do{sl_prev=sl_cur;sl_cur=sl_next;sl_next=(sl_next==(NSLOT-1)*SLOTB)?0:sl_next+SLOTB;}while(0)
  DMA_K(2,2*SLOTB);
  WAIT_BAR(4);
  qkt_half(pA,(lds_cp)(shm3+F_LDS_K),qr,negm,r32,hi,kh);asm volatile("s_nop 15\n\ts_nop 7":"+v"(pA));CMASK(pA,0);
  { float a=max3f(pA[0],pA[1],pA[2]),b=max3f(pA[3],pA[4],pA[5]);a=max3f(a,pA[6],pA[7]);b=max3f(b,pA[8],pA[9]);a=max3f(a,pA[10],pA[11]);b=max3f(b,pA[12],pA[13]);a=max3f(a,pA[14],pA[15]);
    const float m=max2f(a,b); const PL32 rr=pl32(m); const float dl=max2f(rr.a,rr.b); mhat=fadd_s(mhat,dl);
    _Pragma("unroll") for(int r=0;r<16;++r)pA[r]=fsub_s(pA[r],dl);
    _Pragma("unroll") for(int r=0;r<16;++r)negm[r]=-mhat; asm volatile("":"+v"(negm));
    _Pragma("unroll") for(int r=0;r<16;++r)pA[r]=__builtin_amdgcn_exp2f(pA[r]); }
  WAIT_BAR(0);
  DMA_K(3,0);DMA_V(1,SLOTB);
  ROT();
  _Pragma("unroll") for(int j=0;j<4;++j)kf[j]=*(const __attribute__((address_space(3))) bf16x8*)(kp0+sl_cur+j*2048);
  WAIT_BAR(3);
  s16x4 vlo[8],vhi[8]; u32x4 pwa,pwb;
  #define PKW(P,B) cvtpk_s(P[B],P[B+1])
  #define PAFA __builtin_bit_cast(bf16x8,pwa)
  #define PAFB __builtin_bit_cast(bf16x8,pwb)
  #define VFR(i) (bf16x8){vlo[i][0],vlo[i][1],vlo[i][2],vlo[i][3],vhi[i][0],vhi[i][1],vhi[i][2],vhi[i][3]}
  #define PIN(x) asm volatile("":"+v"(x))
  #define MX3(a,b,c) __builtin_fmaxf(__builtin_fmaxf((a),(b)),(c))
  #define GAPA(MF,A0,A1,A2,A3,W0,W1,PW) do{ MF; sacc+=A0; sacc+=A1; sacc+=A2; sacc+=A3; PIN(sacc); W0; W1; PIN(PW); SBAR(); }while(0)
  #define EX(v) __builtin_amdgcn_exp2f(v)
  #define GAPB(MF,X,B) do{ MF; X[B]=EX(X[B]); X[B+1]=EX(X[B+1]); PIN(X); SBAR(); }while(0)
  #define VRD(i) do{ vlo[i]=vtr(vp_+(((i)>>1)*4096+((i)&1)*1024)); vhi[i]=vtr(vp_+(((i)>>1)*4096+((i)&1)*1024+512)); }while(0)
  #define KRD(G,j) do{ if(G){ kf[j]=*(const __attribute__((address_space(3))) bf16x8*)(kp0+sl_next+(j)*2048); SBAR(); } }while(0)
  #define STEPF(C,P,t,GK,GV,GL) do{ SBAR(); \
    const lds_cptr vp_=vp0+2*sl_prev; \
    VRD(0); VRD(2); SBAR(); float sacc=(P[0]+P[1]); \
    GAPA(C=__builtin_amdgcn_mfma_f32_32x32x16_bf16(kf[0],qr[0],negm,0,0,0), P[2],P[3],P[4],P[5],     pwa[0]=PKW(P,0), pwa[1]=PKW(P,2), pwa); \
    VRD(4); VRD(6); SBAR(); GAPA(C=__builtin_amdgcn_mfma_f32_32x32x16_bf16(kf[1],qr[1],C,0,0,0), P[6],P[7],P[8],P[9],     pwa[2]=PKW(P,4), pwa[3]=PKW(P,6), pwa); \
    VRD(1); VRD(3); SBAR(); GAPA(C=__builtin_amdgcn_mfma_f32_32x32x16_bf16(kf[2],qr[2],C,0,0,0), P[10],P[11],P[12],P[13], pwb[0]=PKW(P,8), pwb[1]=PKW(P,10), pwb); \
    VRD(5); VRD(7); SBAR(); GAPA(C=__builtin_amdgcn_mfma_f32_32x32x16_bf16(kf[3],qr[3],C,0,0,0), P[14],P[15],0.f,0.f,     pwb[2]=PKW(P,12),pwb[3]=PKW(P,14), pwb); \
    l_reg+=sacc; \
    if(GK){DMA_K((t)+3,sl_cur);} if(GV){DMA_V((t)+1,sl_next);} \
    CMASK(C,t); \
    { float a=MX3(C[0],C[1],C[2]),b=MX3(C[3],C[4],C[5]); a=MX3(a,C[6],C[7]); b=MX3(b,C[8],C[9]); a=MX3(a,C[10],C[11]); b=MX3(b,C[12],C[13]); a=MX3(a,C[14],C[15]); \
      float rm=__builtin_fmaxf(a,b); { const PL32 rr=pl32(rm); rm=__builtin_fmaxf(rr.a,rr.b); } \
      resc=false; \
      if(__builtin_expect(__any(rm>(float)THRL),0)){ const float dl=__builtin_fmaxf(rm,0.f); mhat+=dl; \
        _Pragma("unroll") for(int r=0;r<16;++r)C[r]-=dl; \
        _Pragma("unroll") for(int r=0;r<16;++r)negm[r]=-mhat; asm volatile("":"+v"(negm)); \
        const float f=__builtin_amdgcn_exp2f(-dl); l_reg*=f; if(hi==0)wsf[r32]=f; resc=true; } } \
    SBAR(); \
    GAPB(o[0]=__builtin_amdgcn_mfma_f32_32x32x16_bf16(PAFA,VFR(0),o[0],0,0,0), C,0); \
    GAPB(o[1]=__builtin_amdgcn_mfma_f32_32x32x16_bf16(PAFA,VFR(2),o[1],0,0,0), C,2); \
    KRD(GL,0); GAPB(o[2]=__builtin_amdgcn_mfma_f32_32x32x16_bf16(PAFA,VFR(4),o[2],0,0,0), C,4); \
    KRD(GL,1); GAPB(o[3]=__builtin_amdgcn_mfma_f32_32x32x16_bf16(PAFA,VFR(6),o[3],0,0,0), C,6); \
    KRD(GL,2); GAPB(o[0]=__builtin_amdgcn_mfma_f32_32x32x16_bf16(PAFB,VFR(1),o[0],0,0,0), C,8); \
    KRD(GL,3); GAPB(o[1]=__builtin_amdgcn_mfma_f32_32x32x16_bf16(PAFB,VFR(3),o[1],0,0,0), C,10); \
    GAPB(o[2]=__builtin_amdgcn_mfma_f32_32x32x16_bf16(PAFB,VFR(5),o[2],0,0,0), C,12); \
    GAPB(o[3]=__builtin_amdgcn_mfma_f32_32x32x16_bf16(PAFB,VFR(7),o[3],0,0,0), C,14); \
    }while(0)
  int t=1;
  #undef CMASK
  #define CMASK(P,t) do{}while(0)
  asm volatile(".p2align 8":::"memory");
  for(;t+7<NT;t+=2){
    STEPF(pB,pA,t,true,true,true);     WAIT_BAR(3); RESC(); ROT();
    STEPF(pA,pB,t+1,true,true,true);   WAIT_BAR(3); RESC(); ROT();
  }
  #undef CMASK
  #define CMASK(P,t) do{ if((t)>=cqm2)bmask1(P,(t),cq,qabs,hi,kh,lut);}while(0)
  #define ENDW(tt) do{ if((tt)+3<NT){WAIT_BAR(3);} else if((tt)+2<NT){WAIT_BAR(2);} else {WAIT_BAR(0);} }while(0)
  for(;t+1<NT;t+=2){
    STEPF(pB,pA,t,(t+3<NT),(t+1<NT),(t+1<NT));       ENDW(t);   RESC(); ROT();
    STEPF(pA,pB,t+1,(t+4<NT),(t+2<NT),(t+2<NT));     ENDW(t+1); RESC(); ROT();
  }
  STEPF(pB,pA,NT-1,false,false,false); RESC();
  { float sacc=pB[0]+pB[1]; _Pragma("unroll") for(int r=2;r<16;++r)sacc+=pB[r]; l_reg+=sacc;
    pwa=(u32x4){PKW(pB,0),PKW(pB,2),PKW(pB,4),PKW(pB,6)};pwb=(u32x4){PKW(pB,8),PKW(pB,10),PKW(pB,12),PKW(pB,14)};
    SBAR();
    const int vb=vb0+2*sl_cur;
    #pragma unroll
    for(int d0=0;d0<4;++d0){s16x4 lo[2],hi_[2];
      #pragma unroll
      for(int ks=0;ks<2;++ks){
        asm volatile("ds_read_b64_tr_b16 %0,%1 offset:%c2":"=&v"(lo[ks]):"v"(vb),"i"(d0*4096+ks*1024):"memory");
        asm volatile("ds_read_b64_tr_b16 %0,%1 offset:%c2":"=&v"(hi_[ks]):"v"(vb),"i"(d0*4096+ks*1024+512):"memory");}
      asm volatile("s_waitcnt lgkmcnt(0)":::"memory");SBAR();
      #define PK(k) (bf16x8){lo[k][0],lo[k][1],lo[k][2],lo[k][3],hi_[k][0],hi_[k][1],hi_[k][2],hi_[k][3]}
      o[d0]=__builtin_amdgcn_mfma_f32_32x32x16_bf16(PAFA,PK(0),o[d0],0,0,0);
      o[d0]=__builtin_amdgcn_mfma_f32_32x32x16_bf16(PAFB,PK(1),o[d0],0,0,0);
      #undef PK
    } }
  #undef PKW
  #undef PAFA
  #undef PAFB
  #undef VFR
  #undef PIN
  #undef MX3
  #undef GAPA
  #undef GAPB
  #undef EX
  #undef VRD
  #undef KRD
  #undef STEPF
  #undef ENDW
  {const PL32 rr=pl32(l_reg);l_reg=rr.a+rr.b;}
  asm volatile("s_waitcnt lgkmcnt(0)\n\ts_barrier":::"memory");
  float*OGp=(float*)shm+pr*4096;
  if(hi==0){wsf[r32]=mhat;wsf[32+r32]=l_reg;}
  if(kh==0){
    #pragma unroll
    for(int dd=0;dd<2;++dd)
      #pragma unroll
      for(int r=0;r<16;++r)OGp[(dd*16+r)*64+lane]=o[2+dd][r];
  } else {
    #pragma unroll
    for(int dd=0;dd<2;++dd)
      #pragma unroll
      for(int r=0;r<16;++r)OGp[2048+(dd*16+r)*64+lane]=o[dd][r];
  }
  asm volatile("s_waitcnt lgkmcnt(0)\n\ts_barrier":::"memory");
  { const float*wp=(const float*)(shm+F_LDS_WS)+(wid^4)*64; const float m2=wp[r32],l2=wp[32+r32]; const float M=__builtin_fmaxf(mhat,m2);
    const float f1=__builtin_amdgcn_exp2f(mhat-M),f2=__builtin_amdgcn_exp2f(m2-M); const float inv=__builtin_amdgcn_rcpf(l_reg*f1+l2*f2);
    float*GF=(float*)(shm+65536)+wid*64;
    if(hi==0){GF[r32]=f1*inv;GF[32+r32]=f2*inv;}
    asm volatile("s_waitcnt lgkmcnt(0)":::"memory");
    bf16*stg=(bf16*)(shm+F_LDS_OST)+pr*4096+kh*64;
    if(kh==0){
      #pragma unroll
      for(int r=0;r<16;++r){const int orow=crow(r,hi); const float g1=GF[orow],g2=GF[32+orow];
        #pragma unroll
        for(int dd=0;dd<2;++dd)stg[orow*128+dd*32+r32]=__float2bfloat16(o[dd][r]*g1+OGp[2048+(dd*16+r)*64+lane]*g2);}
    } else {
      #pragma unroll
      for(int r=0;r<16;++r){const int orow=crow(r,hi); const float g1=GF[orow],g2=GF[32+orow];
        #pragma unroll
        for(int dd=0;dd<2;++dd)stg[orow*128+dd*32+r32]=__float2bfloat16(o[2+dd][r]*g1+OGp[(dd*16+r)*64+lane]*g2);}
    }
    asm volatile("s_waitcnt lgkmcnt(0)":::"memory");
    bf16*Ow=O+(long)(q0+pr*QBLK)*(long)OPITCH+ocol+kh*64;
    #pragma unroll
    for(int i=0;i<4;++i){const int row=i*8+(lane>>3),ch=lane&7; const u32x4 v=*(const u32x4*)(stg+row*128+ch*8); ATTN_STORE16(Ow+(long)row*OPITCH+ch*8,v);} }
  asm volatile("s_waitcnt lgkmcnt(0)\n\ts_barrier":::"memory");
  #undef DMA_K
  #undef DMA_V
  #undef CMASK
  #undef RESC
  #undef ROT
}
constexpr int ATTN_LDS_BYTES=LDS_BYTES;
#undef SBAR
#undef WAIT_BAR
}
#define XB_TMO      128
#define XB_XCNT(j)  (256  + 64 * (j))
#define XB_XSUB(j)  (1280 + 64 * (j))
#define XB_XGEN(j)  (2304 + 64 * (j))
#define XB_TOP      3328
#define XB_TOPGEN   3392
#define XCD_BAR_WORDS 3456
#define XB_SPIN_CAP (1u << 18)

__device__ __forceinline__ unsigned xb_ld(unsigned* p)              { return __hip_atomic_load(p, __ATOMIC_RELAXED, __HIP_MEMORY_SCOPE_AGENT); }
__device__ __forceinline__ unsigned xb_add(unsigned* p, unsigned v) { return __hip_atomic_fetch_add(p, v, __ATOMIC_RELAXED, __HIP_MEMORY_SCOPE_AGENT); }
__device__ __forceinline__ unsigned xb_xcc_id() { return (unsigned)__builtin_amdgcn_s_getreg((3 << 11) | 20) & 0xFu; }
#define XB_SPIN(cond, bar) do { unsigned _sp = 0; while (cond) { __builtin_amdgcn_s_sleep(1); \
    if ((++_sp & 255u) == 0u) { if (xb_ld(&(bar)[XB_TMO])) break; if (_sp > XB_SPIN_CAP) { atomicAdd(&(bar)[XB_TMO], 1u); break; } } } } while (0)

struct XcdBarrier {
    unsigned* bar; unsigned x;
    volatile LAS unsigned* st;
};

__device__ __forceinline__ XcdBarrier xcd_barrier_post(unsigned* bar, volatile LAS unsigned* st) {
    XcdBarrier b; b.bar = bar; b.x = xb_xcc_id(); b.st = st;
    if (threadIdx.x == 0) (void)xb_add(&bar[XB_XCNT(b.x)], 1u);
    return b;
}
__device__ __forceinline__ void xcd_barrier_complete(unsigned* bar, unsigned x, unsigned& nloc, unsigned& nx) {
    const unsigned G = gridDim.x * gridDim.y * gridDim.z;
    unsigned sum, cnt, mine, sp = 0u;
    for (;;) {
        sum = 0u; cnt = 0u; mine = 0u;
#pragma unroll
        for (unsigned j = 0; j < 16; ++j) { const unsigned c = xb_ld(&bar[XB_XCNT(j)]); sum += c; cnt += (c > 0u) ? 1u : 0u; mine = (j == x) ? c : mine; }
        if (sum == G) break;
        __builtin_amdgcn_s_sleep(1);
        if ((++sp & 255u) == 0u) { if (xb_ld(&bar[XB_TMO])) break; if (sp > XB_SPIN_CAP) { atomicAdd(&bar[XB_TMO], 1u); break; } }
    }
    nloc = mine > 0u ? mine : 1u; nx = cnt > 0u ? cnt : 1u;
}

__device__ __forceinline__ void xcd_barrier(const XcdBarrier& b) {
    asm volatile("s_waitcnt vmcnt(0)" ::: "memory");
    __syncthreads();
    if (threadIdx.x == 0) {
        unsigned* bar = b.bar;
        __builtin_amdgcn_s_waitcnt(0);
        unsigned nloc = b.st[0], nx = b.st[1];
        if (nloc == 0u) { xcd_barrier_complete(bar, b.x, nloc, nx); b.st[0] = nloc; b.st[1] = nx; }
        const unsigned old = xb_add(&bar[XB_XSUB(b.x)], 1u);
        const unsigned gen = old / nloc;
        if (old + 1u == (gen + 1u) * nloc) {
            __builtin_amdgcn_fence(__ATOMIC_RELEASE, "agent");
            asm volatile("s_waitcnt vmcnt(0)" ::: "memory");
            const unsigned og = xb_add(&bar[XB_TOP], 1u);
            const unsigned tg = og / nx;
            if (og + 1u == (tg + 1u) * nx) xb_add(&bar[XB_TOPGEN], 1u);
            else XB_SPIN(xb_ld(&bar[XB_TOPGEN]) == tg, bar);
            __builtin_amdgcn_fence(__ATOMIC_ACQUIRE, "agent");
            xb_add(&bar[XB_XGEN(b.x)], 1u);
            asm volatile("s_waitcnt vmcnt(0)" ::: "memory");
        } else {
            XB_SPIN(xb_ld(&bar[XB_XGEN(b.x)]) == gen, bar);
            __builtin_amdgcn_fence(__ATOMIC_ACQUIRE, "agent");
            asm volatile("s_waitcnt vmcnt(0)" ::: "memory");
        }
    }
    __syncthreads();
}
struct Args { const float* in[37]; float* out; unsigned char* ws; int ph_lo, ph_hi; };
struct Frame { LAS unsigned char* lds; volatile LAS unsigned* MISC; gu32* ctl; int tid, lane, wave, G, bid; };
typedef __attribute__((address_space(4))) const Args* ArgsP;
__device__ __forceinline__ ArgsP get_args() { ArgsP p = (ArgsP)__builtin_amdgcn_kernarg_segment_ptr(); asm volatile("" : "+s"(p)); return p; }
#define PHASE_ENTRY() ArgsP A = get_args(); { int t_ = threadIdx.x; asm volatile("" : "+v"(t_)); F.tid = t_; F.lane = t_ & 63; F.wave = __builtin_amdgcn_readfirstlane(t_ >> 6); F.ctl = (gu32*)(A->ws + WS_CTL); }
enum InIdx { I_XP = 0, I_XS, I_CP, I_CS, I_CK, I_CV, I_SWKV, I_SSHIFT, I_SCONV, I_WADA, I_BADA, I_GMIX, I_GFFN, I_WIN, I_WOUT, I_MU, I_W0, I_W2, I_A0, I_A2, I_G2, I_KK, I_KA, I_RK, I_LNW, I_LNB,
             I_LQ1, I_LK1, I_LQ2, I_LK2, I_SUBLN, I_REL, I_FUP, I_CONVW, I_CONVB, I_FDN, I_GFIN };

__device__ __forceinline__ void transpose_item(const float* W, int K, int N, bf16* WT, int dest_row0, LAS float* scr, int kb, int n0, int lane) {
    const int k0 = 64 * kb;
    { f32x4 t[8];
#pragma unroll
      for (int i = 0; i < 8; ++i) t[i] = __builtin_nontemporal_load((const GAS f32x4*)(W + (size_t)(k0 + 8 * i + (lane >> 3)) * N + n0 + 4 * (lane & 7)));
#pragma unroll
      for (int i = 0; i < 8; ++i) { LAS float* d = scr + (8 * i + (lane >> 3)) * 33 + 4 * (lane & 7); d[0] = t[i][0]; d[1] = t[i][1]; d[2] = t[i][2]; d[3] = t[i][3]; } }
    LDS_WAIT(); asm volatile("" ::: "memory");
    const int c = lane & 7;
#pragma unroll
    for (int j = 0; j < 4; ++j) { const int n = (lane >> 3) + 8 * j; const LAS float* s = scr + (8 * c) * 33 + n;
        v4u o; o.x = pk2(s[0 * 33], s[1 * 33]); o.y = pk2(s[2 * 33], s[3 * 33]); o.z = pk2(s[4 * 33], s[5 * 33]); o.w = pk2(s[6 * 33], s[7 * 33]);
        *(GAS v4u*)(WT + (size_t)(dest_row0 + n) * K + k0 + 8 * c) = o; }
    LDS_WAIT(); asm volatile("" ::: "memory");
}
__device__ __forceinline__ void ph_prologue(Frame& F) {
    PHASE_ENTRY();
    unsigned char* ws = A->ws;
    if (F.bid < 192) {
        const int l = F.bid / 96, j0 = (F.bid % 96) * 128;
        LAS float* ST = (LAS float*)F.lds;
        const float* Wl = A->in[I_WADA] + (size_t)l * DMOD * MODW;
        float acc[NMODB][2];
#pragma unroll
        for (int b = 0; b < NMODB; ++b) { acc[b][0] = 0.f; acc[b][1] = 0.f; }
        for (int kh = 0; kh < 2; ++kh) {
            __syncthreads();
            for (int idx = F.tid; idx < 1024 * NMODB; idx += NWAVES * 64) { const int kk = idx / NMODB, b = idx % NMODB;
                const float c = (b == 0) ? A->in[I_CP][kh * 1024 + kk] : A->in[I_CS][(size_t)(b - 1) * DMOD + kh * 1024 + kk];
                ST[kk * 20 + b] = c / (1.f + __expf(-c)); }
            __syncthreads();
#pragma unroll 4
            for (int k = 0; k < 128; ++k) { const int kk = F.wave * 128 + k;
                const f32x2 w = __builtin_nontemporal_load((const GAS f32x2*)(Wl + (size_t)(kh * 1024 + kk) * MODW + j0 + 2 * F.lane));
                const LAS f32x4* sp = (const LAS f32x4*)(ST + kk * 20);
                const f32x4 s0 = sp[0], s1 = sp[1], s2 = sp[2], s3 = sp[3]; const float s16 = ST[kk * 20 + 16];
#pragma unroll
                for (int b = 0; b < 4; ++b) { acc[b][0] += s0[b] * w.x; acc[b][1] += s0[b] * w.y; acc[4 + b][0] += s1[b] * w.x; acc[4 + b][1] += s1[b] * w.y;
                    acc[8 + b][0] += s2[b] * w.x; acc[8 + b][1] += s2[b] * w.y; acc[12 + b][0] += s3[b] * w.x; acc[12 + b][1] += s3[b] * w.y; }
                acc[16][0] += s16 * w.x; acc[16][1] += s16 * w.y; }
        }
        __syncthreads();
        LAS float* RED = (LAS float*)F.lds;
#pragma unroll
        for (int b = 0; b < NMODB; ++b) { RED[(F.wave * NMODB + b) * 128 + 2 * F.lane] = acc[b][0]; RED[(F.wave * NMODB + b) * 128 + 2 * F.lane + 1] = acc[b][1]; }
        __syncthreads();
        float* MOD = (float*)(ws + WS_MOD);
        for (int idx = F.tid; idx < NMODB * 128; idx += NWAVES * 64) { const int b = idx >> 7, j = idx & 127; float s = 0.f;
#pragma unroll
            for (int w = 0; w < 8; ++w) s += RED[(w * NMODB + b) * 128 + j];
            MOD[(size_t)(l * NMODB + b) * MODW + j0 + j] = s + A->in[I_BADA][(size_t)l * MODW + j0 + j]; }
        __syncthreads();
    }
    { const int gt = F.bid * (NWAVES * 64) + F.tid, ngt = F.G * NWAVES * 64;
      for (int idx = gt; idx < NLAYER * 56 * 1024; idx += ngt) { const int l = idx / (56 * 1024), rem = idx % (56 * 1024), ch = rem >> 10, j = rem & 1023;
          const float* src; bf16* dst; int k0;
          bf16* LB = (bf16*)(ws + WS_LORA + (size_t)l * LORA_LAYER);
          if (ch < 12) { k0 = 8 * ch; src = A->in[I_W2] + ((size_t)l * 96 + k0) * 1024 + j; dst = LB + (size_t)j * 96 + k0; }
          else if (ch < 24) { k0 = 8 * (ch - 12); src = A->in[I_A2] + ((size_t)l * 96 + k0) * 1024 + j; dst = LB + (size_t)1024 * 96 + (size_t)j * 96 + k0; }
          else { k0 = 8 * (ch - 24); src = A->in[I_G2] + ((size_t)l * 256 + k0) * 1024 + j; dst = LB + (size_t)2 * 1024 * 96 + (size_t)j * 256 + k0; }
          v4u o; o.x = pk2(src[0], src[1024]); o.y = pk2(src[2048], src[3072]); o.z = pk2(src[4096], src[5120]); o.w = pk2(src[6144], src[7168]);
          *(GAS v4u*)dst = o; }
      for (int idx = gt; idx < NLAYER * 64 * DMOD / 8; idx += ngt) { const int l = idx / (64 * DMOD / 8), rem = idx % (64 * DMOD / 8);
          *(GAS v4u*)((bf16*)(ws + WS_WIN) + (size_t)l * NIN_PAD * DMOD + (size_t)NRC * DMOD + (size_t)rem * 8) = (v4u){0u, 0u, 0u, 0u}; }
    }
    __syncthreads();
    LAS float* scr = (LAS float*)(F.lds + F.wave * 16384);
    const int gw = F.bid * NWAVES + F.wave, NGW = F.G * NWAVES;
    constexpr int IT_IN = 32 * (NIN / 32), IT_OUT = 32 * 64, IT_UP = 32 * (NUP / 32), IT_DN = (DFF / 64) * 64, IT_L = IT_IN + IT_OUT + IT_UP + IT_DN;
    for (int it = gw; it < NLAYER * IT_L; it += NGW) {
        const int l = it / IT_L; int r = it % IT_L;
        if (r < IT_IN) { const int nb = r % (NIN / 32), kb = r / (NIN / 32), n0 = 32 * nb;
            transpose_item(A->in[I_WIN] + (size_t)l * DMOD * NIN, DMOD, NIN, (bf16*)(ws + WS_WIN) + (size_t)l * NIN_PAD * DMOD, n0 < NRC ? n0 : n0 + 64, scr, kb, n0, F.lane); continue; }
        r -= IT_IN;
        if (r < IT_OUT) { const int nb = r % 64, kb = r / 64;
            transpose_item(A->in[I_WOUT] + (size_t)l * DMOD * DMOD, DMOD, DMOD, (bf16*)(ws + WS_WOUT) + (size_t)l * DMOD * DMOD, 32 * nb, scr, kb, 32 * nb, F.lane); continue; }
        r -= IT_OUT;
        if (r < IT_UP) { const int nb = r % (NUP / 32), kb = r / (NUP / 32), n0 = 32 * nb; const int j = n0 < DFF ? n0 : n0 - DFF;
            const int dr = (j >> 7) * 256 + (n0 < DFF ? 0 : 128) + (j & 127);
            transpose_item(A->in[I_FUP] + (size_t)l * DMOD * NUP, DMOD, NUP, (bf16*)(ws + WS_WUP) + (size_t)l * NUP * DMOD, dr, scr, kb, n0, F.lane); continue; }
        r -= IT_UP;
        { const int nb = r % 64, kb = r / 64;
            transpose_item(A->in[I_FDN] + (size_t)l * DFF * DMOD, DFF, DMOD, (bf16*)(ws + WS_WDN) + (size_t)l * DMOD * DFF, 32 * nb, scr, kb, 32 * nb, F.lane); }
    }
}

__device__ __forceinline__ void ph_norm(Frame& F, int l, int mode, int nslab) {
    PHASE_ENTRY();
    const int gw = F.bid * NWAVES + F.wave, NGW = F.G * NWAVES;
    const float* X = (const float*)(A->ws + WS_X); bf16* H = (bf16*)(A->ws + WS_H);
    const float* g = (mode == 0 ? A->in[I_GMIX] + (size_t)l * DMOD : mode == 1 ? A->in[I_GFFN] + (size_t)l * DMOD : A->in[I_GFIN]);
    f32x4 gv[8];
#pragma unroll
    for (int j = 0; j < 8; ++j) gv[j] = *(const GAS f32x4*)(g + 4 * F.lane + 256 * j);
    for (int m = gw; m < MT; m += NGW) {
        const float* xr = (mode == 0 && l == 0) ? (m < MP ? A->in[I_XP] + (size_t)m * DMOD : A->in[I_XS] + (size_t)(m - MP) * DMOD) : X + (size_t)m * DMOD;
        f32x4 v[8]; float ss = 0.f;
#pragma unroll
        for (int j = 0; j < 8; ++j) v[j] = *(const GAS f32x4*)(xr + 4 * F.lane + 256 * j);
        f32x4 shv[8], scv[8];
        if (mode < 2) { const int bidx0 = m < MP ? 0 : 1 + ((m - MP) >> 4);
            const float* mod0 = (const float*)(A->ws + WS_MOD) + (size_t)(l * NMODB + bidx0) * MODW + (mode == 0 ? 0 : 3 * DMOD);
#pragma unroll
            for (int j = 0; j < 8; ++j) { shv[j] = *(const GAS f32x4*)(mod0 + 4 * F.lane + 256 * j); scv[j] = *(const GAS f32x4*)(mod0 + DMOD + 4 * F.lane + 256 * j); } }
        if (m >= MP && nslab > 0) { const float* sl = (const float*)(A->ws + WS_SLAB) + (size_t)(m - MP) * DMOD;
            int s = 0;
            for (; s + 1 < nslab; s += 2) { f32x4 sa[8], sb[8];
#pragma unroll
                for (int j = 0; j < 8; ++j) { sa[j] = *(const GAS f32x4*)(sl + (size_t)s * 256 * DMOD + 4 * F.lane + 256 * j); sb[j] = *(const GAS f32x4*)(sl + (size_t)(s + 1) * 256 * DMOD + 4 * F.lane + 256 * j); }
#pragma unroll
                for (int j = 0; j < 8; ++j) v[j] += sa[j] + sb[j]; }
            if (s < nslab) {
#pragma unroll
                for (int j = 0; j < 8; ++j) v[j] += *(const GAS f32x4*)(sl + (size_t)s * 256 * DMOD + 4 * F.lane + 256 * j); }
            if (mode < 2) { float* xw = (float*)(A->ws + WS_X) + (size_t)m * DMOD;
#pragma unroll
                for (int j = 0; j < 8; ++j) *(GAS f32x4*)(xw + 4 * F.lane + 256 * j) = v[j]; } }
#pragma unroll
        for (int j = 0; j < 8; ++j) ss += (v[j].x * v[j].x + v[j].y * v[j].y) + (v[j].z * v[j].z + v[j].w * v[j].w);
        const float rstd = 1.f / sqrtf(wave_sum(ss) * (1.f / DMOD) + 1e-6f);
        if (mode < 2) {
            const int bidx = m < MP ? 0 : 1 + ((m - MP) >> 4);
            const float* mod = (const float*)(A->ws + WS_MOD) + (size_t)(l * NMODB + bidx) * MODW + (mode == 0 ? 0 : 3 * DMOD);
            GAS unsigned long long* o8 = (GAS unsigned long long*)(H + (size_t)m * DMOD) + F.lane;
#pragma unroll
            for (int j = 0; j < 8; ++j) { const f32x4 sh = shv[j], sc = scv[j];
                const f32x4 y = (v[j] * rstd * gv[j]) * (sc + 1.0f) + sh;
                o8[64 * j] = (unsigned long long)pk2(y.x, y.y) | ((unsigned long long)pk2(y.z, y.w) << 32); }
        } else {
            float* o = (m < MP) ? A->out + O_YP + (size_t)m * DMOD : A->out + O_YS + (size_t)(m - MP) * DMOD;
#pragma unroll
            for (int j = 0; j < 8; ++j) __builtin_nontemporal_store(v[j] * rstd * gv[j], (GAS f32x4*)(o + 4 * F.lane + 256 * j));
        }
    }
}
typedef float f32x4m __attribute__((ext_vector_type(4)));
__device__ __forceinline__ void mm_tiles(f32x4 (&acc)[2], const LAS unsigned char* X, const LAS unsigned char* Y, int wave, int lane) {
    const int mt = wave >> 1, nt0 = 2 * (wave & 1), c = lane & 15, q = lane >> 4;
    const LAS unsigned char* xp = X + (16 * mt + c) * 144 + q * 16;
    const bf16x8 x0 = *(const LAS bf16x8*)xp, x1 = *(const LAS bf16x8*)(xp + 64);
#pragma unroll
    for (int t = 0; t < 2; ++t) { const LAS unsigned char* yp = Y + (16 * (nt0 + t) + c) * 144 + q * 16;
        const bf16x8 y0 = *(const LAS bf16x8*)yp, y1 = *(const LAS bf16x8*)(yp + 64);
        acc[t] = __builtin_amdgcn_mfma_f32_16x16x32_bf16(y0, x0, acc[t], 0, 0, 0);
        acc[t] = __builtin_amdgcn_mfma_f32_16x16x32_bf16(y1, x1, acc[t], 0, 0, 0); }
}
__device__ __forceinline__ void st_tiles(LAS unsigned char* D, const f32x4 (&acc)[2], int wave, int lane) {
    const int mt = wave >> 1, nt0 = 2 * (wave & 1), c = lane & 15, q = lane >> 4;
#pragma unroll
    for (int t = 0; t < 2; ++t) { v2u w; w.x = pk2(acc[t][0], acc[t][1]); w.y = pk2(acc[t][2], acc[t][3]); *(LAS v2u*)(D + (16 * mt + c) * 144 + (16 * (nt0 + t) + 4 * q) * 2) = w; }
}
#define RW_ZERO(a) do { a[0] = (f32x4){0.f, 0.f, 0.f, 0.f}; a[1] = a[0]; } while (0)
template <int MODE> __device__ __forceinline__ void mask_tiles(f32x4 (&acc)[2], int wave, int lane) {
    const int m = 16 * (wave >> 1) + (lane & 15), nb = 32 * (wave & 1) + 4 * (lane >> 4);
#pragma unroll
    for (int t = 0; t < 2; ++t)
#pragma unroll
        for (int i = 0; i < 4; ++i) { const int n = nb + 16 * t + i; const bool keep = MODE == 0 ? (n < m) : MODE == 1 ? (n > m) : (n <= m); if (!keep) acc[t][i] = 0.f; }
}

__device__ __forceinline__ void rwkv_passA_unit(ArgsP A, Frame& F, int l, int u, bool reuse) {
    unsigned char* ws = A->ws;
    const int tid = F.tid, lane = F.lane, wave = F.wave;
    const float* PR = (const float*)(ws + WS_PR);
    int h, row0, nvalid; const float* prev0;
    if (u < 2048) { h = u >> 7; const int c = u & 127; row0 = 64 * c; nvalid = 64; prev0 = c > 0 ? PR + (size_t)(row0 - 1) * NRC_PAD : nullptr; }
    else { const int su = u - 2048, sb = su >> 4; h = su & 15; row0 = MP + sb * TS; nvalid = TS; prev0 = A->in[I_SSHIFT] + (size_t)(l * NSB + sb) * NRC; }
    const float* mu = A->in[I_MU] + (size_t)l * NRC;
    LAS unsigned char* L = F.lds;
#define SL(i) (L + (i) * RW_SLOT)
    LAS unsigned short* TW = (LAS unsigned short*)(L), *XA = (LAS unsigned short*)(L + 13312), *SG = (LAS unsigned short*)(L + 26624);
    LAS float* WLf = (LAS float*)(L + 64512), *ALf = (LAS float*)(L + 81920), *GLf = (LAS float*)(L + 99328);
    LAS float* AT32 = (LAS float*)(L + 92160), *A32 = (LAS float*)(L + 109568), *AKV32 = (LAS float*)(L);
    LAS unsigned char* sAAK = L + 126976, *sARB = L + 136192, *sARK = L + 145408;
    LAS float* SEG = (LAS float*)(L + 154624), *WLV = SEG + 512;
    bf16x8 yg_[8][2];
    { const int nt0 = 2 * (wave & 1), c = lane & 15, q = lane >> 4; const bf16* LB = (const bf16*)(ws + WS_LORA + (size_t)l * LORA_LAYER);
#pragma unroll
      for (int t = 0; t < 2; ++t) { const int j = h * 64 + 16 * (nt0 + t) + c;
#pragma unroll
          for (int s = 0; s < 8; ++s) yg_[s][t] = *(const GAS bf16x8*)(LB + (size_t)2 * 1024 * 96 + (size_t)j * 256 + 8 * q + 32 * s); } }
    { unsigned char* lscr = ws + WS_LSCR + (size_t)F.bid * 61440;
      if (reuse) { v4u tmp[8];
#pragma unroll
          for (int b = 0; b < 8; ++b) { const int i = tid + b * (NWAVES * 64); if (i < 60416 / 16) tmp[b] = *(const GAS v4u*)(lscr + i * 16); }
#pragma unroll
          for (int b = 0; b < 8; ++b) { const int i = tid + b * (NWAVES * 64); if (i < 60416 / 16) *(LAS v4u*)(L + i * 16) = tmp[b]; } }
      else {
        for (int it = 0; it < 56; it += 8) { float cur[8], prv[8], mm_[8];
#pragma unroll
            for (int b = 0; b < 8; ++b) { const int idx = tid + (it + b) * (NWAVES * 64), t = idx / 448, col = 3072 + idx % 448; cur[b] = 0.f; prv[b] = 0.f; mm_[b] = mu[col];
                if (t < nvalid) { cur[b] = PR[(size_t)(row0 + t) * NRC_PAD + col]; prv[b] = t > 0 ? PR[(size_t)(row0 + t - 1) * NRC_PAD + col] : (prev0 ? prev0[col] : 0.f); } }
#pragma unroll
            for (int b = 0; b < 8; ++b) { const int idx = tid + (it + b) * (NWAVES * 64), t = idx / 448, cc = idx % 448; const float xm = cur[b] + (prv[b] - cur[b]) * mm_[b];
                if (cc < 96) { const float e = __expf(2.f * xm); TW[t * 104 + cc] = (unsigned short)f2bf(1.f - 2.f * __builtin_amdgcn_rcpf(e + 1.f)); }
                else if (cc < 192) XA[t * 104 + cc - 96] = (unsigned short)f2bf(xm);
                else SG[t * 264 + cc - 192] = (unsigned short)f2bf(sigmoidf_(xm)); } }
        if (u < 2048) { __syncthreads(); for (int i = tid; i < 60416 / 16; i += NWAVES * 64) *(GAS v4u*)(lscr + i * 16) = *(const LAS v4u*)(L + i * 16); }
      } }
    __syncthreads();
    { const int mt = wave >> 1, nt0 = 2 * (wave & 1), c = lane & 15, q = lane >> 4;
      const bf16* LB = (const bf16*)(ws + WS_LORA + (size_t)l * LORA_LAYER);
      f32x4 aw[2], aa[2], ag[2]; RW_ZERO(aw); RW_ZERO(aa); RW_ZERO(ag);
#pragma unroll
      for (int s = 0; s < 3; ++s) { const bf16x8 xw = *(const LAS bf16x8*)((LAS unsigned char*)TW + (16 * mt + c) * 208 + (8 * q + 32 * s) * 2), xa = *(const LAS bf16x8*)((LAS unsigned char*)XA + (16 * mt + c) * 208 + (8 * q + 32 * s) * 2);
#pragma unroll
          for (int t = 0; t < 2; ++t) { const int j = h * 64 + 16 * (nt0 + t) + c;
              const bf16x8 yw = *(const GAS bf16x8*)(LB + (size_t)j * 96 + 8 * q + 32 * s), ya = *(const GAS bf16x8*)(LB + (size_t)1024 * 96 + (size_t)j * 96 + 8 * q + 32 * s);
              aw[t] = __builtin_amdgcn_mfma_f32_16x16x32_bf16(yw, xw, aw[t], 0, 0, 0); aa[t] = __builtin_amdgcn_mfma_f32_16x16x32_bf16(ya, xa, aa[t], 0, 0, 0); } }
#pragma unroll
      for (int s = 0; s < 8; ++s) { const bf16x8 xg = *(const LAS bf16x8*)((LAS unsigned char*)SG + (16 * mt + c) * 528 + (8 * q + 32 * s) * 2);
#pragma unroll
          for (int t = 0; t < 2; ++t) { const int j = h * 64 + 16 * (nt0 + t) + c; const bf16x8 yg = yg_[s][t];
              ag[t] = __builtin_amdgcn_mfma_f32_16x16x32_bf16(yg, xg, ag[t], 0, 0, 0); } }
#pragma unroll
      for (int t = 0; t < 2; ++t) { const int o = (16 * mt + c) * 68 + 16 * (nt0 + t) + 4 * q; *(LAS f32x4*)(WLf + o) = aw[t]; *(LAS f32x4*)(ALf + o) = aa[t]; *(LAS f32x4*)(GLf + o) = ag[t]; }
    }
    __syncthreads();
    {
        const int j = lane, hj = h * 64 + j, seg = wave;
        const float mu_r = mu[hj], mu_k = mu[1024 + hj], mu_v = mu[2048 + hj];
        const float w0 = A->in[I_W0][l * 1024 + hj], a0 = A->in[I_A0][l * 1024 + hj], kkw = A->in[I_KK][l * 1024 + hj], kaw = A->in[I_KA][l * 1024 + hj], rkw = A->in[I_RK][l * 1024 + hj];
        const float lnw = A->in[I_LNW][l * 1024 + hj], lnb = A->in[I_LNB][l * 1024 + hj];
        float logw[8], xr[8], xv[8], kk[8], bb[8], km[8], cs[8];
        unsigned short* G1 = (unsigned short*)(ws + WS_G1); unsigned short* G2 = (unsigned short*)(ws + WS_G2);
        float run = 0.f;
        float cr9[9], ck9[9], cv9[9];
#pragma unroll
        for (int i = 0; i < 9; ++i) { const int t = 8 * seg + i - 1; const float* pr = (t < 0) ? prev0 : (t < nvalid ? PR + (size_t)(row0 + t) * NRC_PAD : nullptr);
            cr9[i] = pr ? pr[hj] : 0.f; ck9[i] = pr ? pr[1024 + hj] : 0.f; cv9[i] = pr ? pr[2048 + hj] : 0.f; }
        asm volatile("" ::: "memory");
#pragma unroll
        for (int i = 0; i < 8; ++i) { const int t = 8 * seg + i; const bool valid = t < nvalid;
            float r_ = 0.f, k_ = 0.f, v_ = 0.f;
            if (valid) { const float cr = cr9[i + 1], ck = ck9[i + 1], cv = cv9[i + 1], qr = cr9[i], qk = ck9[i], qv = cv9[i];
                r_ = cr + (qr - cr) * mu_r; k_ = ck + (qk - ck) * mu_k; v_ = cv + (qv - cv) * mu_v; }
            const float wl = WLf[t * 68 + j], al = ALf[t * 68 + j], gl = GLf[t * 68 + j];
            const float lw = valid ? -0.6065306597126334f * sigmoidf_(w0 + wl) : 0.f;
            const float a_ = sigmoidf_(a0 + al);
            const float kkr = k_ * kkw; const float nrm = wave_sum(kkr * kkr); const float kk_ = kkr * __builtin_amdgcn_rsqf(fmaxf(nrm, 1e-24f));
            const float km_ = k_ * (1.f + (a_ - 1.f) * kaw);
            const float ct = wave_sum(r_ * km_ * rkw);
            if (valid) { const size_t go = (size_t)(row0 + t) * 1024 + hj; G1[go] = (unsigned short)f2bf(lnw * gl); G2[go] = (unsigned short)f2bf((lnb + ct * v_) * gl); }
            run += lw; logw[i] = lw; cs[i] = run; xr[i] = r_; xv[i] = v_; kk[i] = kk_; bb[i] = kk_ * a_; km[i] = km_; }
        SEG[seg * 64 + j] = run;
        __syncthreads();
        float off = 0.f, tot = 0.f;
#pragma unroll
        for (int s = 0; s < 8; ++s) { const float v = SEG[s * 64 + j]; tot += v; if (s < seg) off += v; }
        if (seg == 0) WLV[j] = __expf(tot);
        LAS unsigned short* AT = (LAS unsigned short*)SL(0), *ATL = (LAS unsigned short*)SL(1), *BH = (LAS unsigned short*)SL(2), *BHL = (LAS unsigned short*)SL(3), *KH = (LAS unsigned short*)SL(4), *RT = (LAS unsigned short*)SL(5);
        unsigned pvt[4], pbt[4], pbl[4], pkt[4];
#pragma unroll
        for (int i = 0; i < 8; i += 2) { float v2[2], bt2[2], bl2[2], kt2[2];
#pragma unroll
            for (int e = 0; e < 2; ++e) { const int ii = i + e, t = 8 * seg + ii; const float ci = off + cs[ii], ce = ci - logw[ii];
                const float winc = __expf(ci), wexc = __expf(ce), winv = __expf(-ci), wrem = __expf(tot - ci);
                const float at = -kk[ii] * wexc, rt = xr[ii] * winc, bh = bb[ii] * winv, kh = km[ii] * winv, bt = bb[ii] * wrem, kt = km[ii] * wrem;
                const unsigned ath = f2bf(at), bhh = f2bf(bh), bth = f2bf(bt);
                AT[t * RW_STRIDE + j] = (unsigned short)ath; ATL[t * RW_STRIDE + j] = (unsigned short)f2bf(at - bf2f((unsigned short)ath)); AT32[t * 68 + j] = at;
                BH[t * RW_STRIDE + j] = (unsigned short)bhh; BHL[t * RW_STRIDE + j] = (unsigned short)f2bf(bh - bf2f((unsigned short)bhh));
                KH[t * RW_STRIDE + j] = (unsigned short)f2bf(kh); RT[t * RW_STRIDE + j] = (unsigned short)f2bf(rt);
                v2[e] = xv[ii]; bt2[e] = bf2f((unsigned short)bth); bl2[e] = bt - bf2f((unsigned short)bth); kt2[e] = kt; }
            pvt[i >> 1] = pk2(v2[0], v2[1]); pbt[i >> 1] = pk2(bt2[0], bt2[1]); pbl[i >> 1] = pk2(bl2[0], bl2[1]); pkt[i >> 1] = pk2(kt2[0], kt2[1]); }
        *(LAS v4u*)(SL(6) + j * 144 + seg * 16) = (v4u){pvt[0], pvt[1], pvt[2], pvt[3]};
        *(LAS v4u*)(SL(7) + j * 144 + seg * 16) = (v4u){pbt[0], pbt[1], pbt[2], pbt[3]};
        *(LAS v4u*)(SL(8) + j * 144 + seg * 16) = (v4u){pbl[0], pbl[1], pbl[2], pbl[3]};
        *(LAS v4u*)(SL(9) + j * 144 + seg * 16) = (v4u){pkt[0], pkt[1], pkt[2], pkt[3]};
    }
    __syncthreads();
    { f32x4 a[2]; const int mt = wave >> 1, nt0 = 2 * (wave & 1), c = lane & 15, q = lane >> 4, m = 16 * mt + c;
      RW_ZERO(a); mm_tiles(a, SL(0), SL(2), wave, lane); mm_tiles(a, SL(1), SL(2), wave, lane); mm_tiles(a, SL(0), SL(3), wave, lane); mask_tiles<0>(a, wave, lane);
#pragma unroll
      for (int t = 0; t < 2; ++t) *(LAS f32x4*)(A32 + m * 68 + 16 * (nt0 + t) + 4 * q) = a[t];
      RW_ZERO(a); mm_tiles(a, SL(0), SL(4), wave, lane); mask_tiles<0>(a, wave, lane); st_tiles(sAAK, a, wave, lane);
      RW_ZERO(a); mm_tiles(a, SL(5), SL(2), wave, lane); mask_tiles<2>(a, wave, lane); st_tiles(sARB, a, wave, lane);
      RW_ZERO(a); mm_tiles(a, SL(5), SL(4), wave, lane); mask_tiles<2>(a, wave, lane); st_tiles(sARK, a, wave, lane); }
    __syncthreads();
    { f32x4 a[2]; const int mt = wave >> 1, nt0 = 2 * (wave & 1), c = lane & 15, q = lane >> 4, m = 16 * mt + c;
      RW_ZERO(a); mm_tiles(a, sAAK, SL(6), wave, lane);
#pragma unroll
      for (int t = 0; t < 2; ++t) *(LAS f32x4*)(AKV32 + m * 68 + 16 * (nt0 + t) + 4 * q) = a[t]; }
    __syncthreads();
    { const int c = lane & 15, q = lane >> 4;
      LAS float* R = (wave < 4) ? AT32 + 16 * wave : AKV32 + 16 * (wave - 4);
      LAS float* Rc = (wave == 0 ? AT32 : AKV32) + lane;
#pragma unroll
      for (int i = 0; i < 4; ++i) {
          if (i > 0) {
              f32x4 acc;
#pragma unroll
              for (int g = 0; g < 4; ++g) acc[g] = R[(16 * i + 4 * q + g) * 68 + c];
#pragma unroll
              for (int j = 0; j < i; ++j)
#pragma unroll
                  for (int s = 0; s < 4; ++s) { const float a = A32[(16 * i + c) * 68 + 16 * j + 4 * s + q], b = R[(16 * j + 4 * s + q) * 68 + c];
                      acc = __builtin_amdgcn_mfma_f32_16x16x4f32(a, b, acc, 0, 0, 0); }
#pragma unroll
              for (int g = 0; g < 4; ++g) R[(16 * i + 4 * q + g) * 68 + c] = acc[g];
              __syncthreads();
          }
          if (wave < 2) {
              const LAS float* a32 = A32 + (16 * i) * 68 + 16 * i; asm volatile("" : "+v"(a32));
              float x[16];
#pragma unroll
              for (int rr = 0; rr < 16; ++rr) x[rr] = Rc[(16 * i + rr) * 68];
#pragma unroll
              for (int rg = 0; rg < 4; ++rg) {
                  f32x4 cf[4][4];
#pragma unroll
                  for (int r4 = 0; r4 < 4; ++r4)
#pragma unroll
                      for (int g = 0; g <= rg; ++g) if (4 * g < 4 * rg + r4) cf[r4][g] = *(const LAS f32x4*)(a32 + (4 * rg + r4) * 68 + 4 * g);
#pragma unroll
                  for (int r4 = 0; r4 < 4; ++r4) { const int rr = 4 * rg + r4; if (rr == 0) continue; float s0 = x[rr], s1 = 0.f;
#pragma unroll
                      for (int g = 0; g <= rg; ++g) if (4 * g < rr) { s0 += cf[r4][g][0] * x[4 * g]; if (4 * g + 1 < rr) s1 += cf[r4][g][1] * x[4 * g + 1]; if (4 * g + 2 < rr) s0 += cf[r4][g][2] * x[4 * g + 2]; if (4 * g + 3 < rr) s1 += cf[r4][g][3] * x[4 * g + 3]; }
                      x[rr] = s0 + s1; }
                  asm volatile("" ::: "memory");
              }
#pragma unroll
              for (int rr = 1; rr < 16; ++rr) Rc[(16 * i + rr) * 68] = x[rr];
          }
          __syncthreads();
      }
      { const int cc = tid & 127, g16 = tid >> 7; const LAS float* src = (cc < 64 ? AT32 + cc : AKV32 + (cc - 64)) + (16 * g16) * 68;
        unsigned hh[16]; float lo[16];
#pragma unroll
        for (int rr = 0; rr < 16; ++rr) { const float v = src[rr * 68]; hh[rr] = f2bf(v); lo[rr] = v - bf2f((unsigned short)hh[rr]); }
        LAS unsigned char* dh = (cc < 64 ? SL(2) + cc * 144 : SL(4) + (cc - 64) * 144) + g16 * 32;
        *(LAS v4u*)dh = (v4u){hh[0] | (hh[1] << 16), hh[2] | (hh[3] << 16), hh[4] | (hh[5] << 16), hh[6] | (hh[7] << 16)};
        *(LAS v4u*)(dh + 16) = (v4u){hh[8] | (hh[9] << 16), hh[10] | (hh[11] << 16), hh[12] | (hh[13] << 16), hh[14] | (hh[15] << 16)};
        if (cc < 64) { LAS unsigned char* dl = SL(3) + cc * 144 + g16 * 32;
            *(LAS v4u*)dl = (v4u){pk2(lo[0], lo[1]), pk2(lo[2], lo[3]), pk2(lo[4], lo[5]), pk2(lo[6], lo[7])};
            *(LAS v4u*)(dl + 16) = (v4u){pk2(lo[8], lo[9]), pk2(lo[10], lo[11]), pk2(lo[12], lo[13]), pk2(lo[14], lo[15])}; } }
    }
    __syncthreads();
    { const int mt = wave >> 1, nt0 = 2 * (wave & 1), c = lane & 15, q = lane >> 4, m = 16 * mt + c;
      float* PTg = (float*)(ws + WS_PT32) + (size_t)u * 4096; float* QQg = (float*)(ws + WS_QQ) + (size_t)u * 4096; bf16* RPg = (bf16*)(ws + WS_RP) + (size_t)u * 4096; unsigned short* YVg = (unsigned short*)(ws + WS_YV) + (size_t)u * 4096;
      f32x4 a[2];
      RW_ZERO(a); mm_tiles(a, sARB, SL(2), wave, lane); mm_tiles(a, sARB, SL(3), wave, lane);
#pragma unroll
      for (int t = 0; t < 2; ++t) { const int n = 16 * (nt0 + t) + 4 * q; const v2u rr = *(const LAS v2u*)(SL(5) + m * 144 + n * 2);
          v2u w; w.x = pk2(a[t][0] + bf2f((unsigned short)(rr.x & 0xffffu)), a[t][1] + bf2f((unsigned short)(rr.x >> 16))); w.y = pk2(a[t][2] + bf2f((unsigned short)(rr.y & 0xffffu)), a[t][3] + bf2f((unsigned short)(rr.y >> 16)));
          *(GAS v2u*)(RPg + m * 64 + n) = w; }
      RW_ZERO(a); mm_tiles(a, sARB, SL(4), wave, lane); mm_tiles(a, sARK, SL(6), wave, lane);
#pragma unroll
      for (int t = 0; t < 2; ++t) { v2u w; w.x = pk2(a[t][0], a[t][1]); w.y = pk2(a[t][2], a[t][3]); *(GAS v2u*)(YVg + m * 64 + 16 * (nt0 + t) + 4 * q) = w; }
      if (tid < 64) ((float*)(ws + WS_WL))[(size_t)u * 64 + tid] = WLV[tid];
      RW_ZERO(a); mm_tiles(a, SL(7), SL(2), wave, lane); mm_tiles(a, SL(8), SL(2), wave, lane); mm_tiles(a, SL(7), SL(3), wave, lane);
#pragma unroll
      for (int t = 0; t < 2; ++t) *(GAS f32x4*)(PTg + m * 64 + 16 * (nt0 + t) + 4 * q) = a[t];
      RW_ZERO(a); mm_tiles(a, SL(4), SL(7), wave, lane); mm_tiles(a, SL(6), SL(9), wave, lane);
#pragma unroll
      for (int t = 0; t < 2; ++t) *(GAS f32x4*)(QQg + m * 64 + 16 * (nt0 + t) + 4 * q) = a[t];
    }
    __syncthreads();
#undef SL
}
__device__ __forceinline__ void wait_count(Frame& F, unsigned* cnt, unsigned target) {
    if (F.tid == 0) { unsigned* bar = (unsigned*)(F.ctl + CW_BAR);
        XB_SPIN(xb_ld(cnt) < target, bar);
        __builtin_amdgcn_fence(__ATOMIC_ACQUIRE, "agent"); asm volatile("s_waitcnt vmcnt(0)" ::: "memory"); }
    __syncthreads();
}
__device__ __forceinline__ void ph_rwkv_passA(Frame& F, int l) {
    PHASE_ENTRY();
    if (F.G == 256) wait_count(F, (unsigned*)(F.ctl + CW_QUEUE + 1024 + 64 * l), (unsigned)((MT / 256) * (NRC_PAD / 256)));
    int pu = -1;
    int u0 = F.bid, ustep = F.G, uend = RW_UNITS;
    if (F.G == 256) {
        const int r = F.bid & 127, sec = F.bid >> 7, nf = (r < (MT / 256) * (NIN_PAD / 256) - 768) ? 8 : 9;
        u0 = r + 128 * (sec ? nf : 0); ustep = 128; uend = r + 128 * (sec ? 18 : nf); }
    for (int u = u0; u < uend; u += ustep) { const bool reuse = (pu >= 0 && u < 2048 && (u & 127) == (pu & 127)); rwkv_passA_unit(A, F, l, u, reuse); pu = u; }
}

struct ChainOps { f32x4 pt[4]; f32x4 qq[2]; f32x4 wl; };
__device__ __forceinline__ void rwkv_chain_load(ChainOps& o, const float* PTg, const float* QQg, const float* WLg, int wave, int lane) {
    const int tk = wave & 3, tv0 = 2 * (wave >> 2), c = lane & 15, q = lane >> 4;
#pragma unroll
    for (int s = 0; s < 2; ++s) { o.pt[2 * s] = *(const GAS f32x4*)(PTg + (16 * tk + c) * 64 + 8 * q + 32 * s); o.pt[2 * s + 1] = *(const GAS f32x4*)(PTg + (16 * tk + c) * 64 + 8 * q + 32 * s + 4); }
#pragma unroll
    for (int t = 0; t < 2; ++t) o.qq[t] = *(const GAS f32x4*)(QQg + (16 * (tv0 + t) + c) * 64 + 16 * tk + 4 * q);
    o.wl = *(const GAS f32x4*)(WLg + 16 * tk + 4 * q);
}
__device__ __forceinline__ void rwkv_chain_step(f32x4 (&acc)[2], const ChainOps& o, const LAS unsigned char* Shi, const LAS unsigned char* Slo, int wave, int lane) {
    const int tv0 = 2 * (wave >> 2), c = lane & 15, q = lane >> 4;
    bf16x8 ph[2], pl[2];
#pragma unroll
    for (int s = 0; s < 2; ++s) { const f32x4 x0 = o.pt[2 * s], x1 = o.pt[2 * s + 1];
        unsigned h[8]; float lo[8];
#pragma unroll
        for (int i = 0; i < 4; ++i) { h[i] = f2bf(x0[i]); lo[i] = x0[i] - bf2f((unsigned short)h[i]); h[4 + i] = f2bf(x1[i]); lo[4 + i] = x1[i] - bf2f((unsigned short)h[4 + i]); }
        ph[s] = __builtin_bit_cast(bf16x8, (v4u){h[0] | (h[1] << 16), h[2] | (h[3] << 16), h[4] | (h[5] << 16), h[6] | (h[7] << 16)});
        pl[s] = __builtin_bit_cast(bf16x8, (v4u){pk2(lo[0], lo[1]), pk2(lo[2], lo[3]), pk2(lo[4], lo[5]), pk2(lo[6], lo[7])}); }
#pragma unroll
    for (int t = 0; t < 2; ++t) { const int v = 16 * (tv0 + t) + c;
        f32x4 a = o.qq[t] + acc[t] * o.wl;
        const bf16x8 s0 = *(const LAS bf16x8*)(Shi + v * 144 + q * 16), s1 = *(const LAS bf16x8*)(Shi + v * 144 + q * 16 + 64);
        const bf16x8 l0 = *(const LAS bf16x8*)(Slo + v * 144 + q * 16), l1 = *(const LAS bf16x8*)(Slo + v * 144 + q * 16 + 64);
        a = __builtin_amdgcn_mfma_f32_16x16x32_bf16(ph[0], s0, a, 0, 0, 0); a = __builtin_amdgcn_mfma_f32_16x16x32_bf16(ph[1], s1, a, 0, 0, 0);
        a = __builtin_amdgcn_mfma_f32_16x16x32_bf16(ph[0], l0, a, 0, 0, 0); a = __builtin_amdgcn_mfma_f32_16x16x32_bf16(ph[1], l1, a, 0, 0, 0);
        a = __builtin_amdgcn_mfma_f32_16x16x32_bf16(pl[0], s0, a, 0, 0, 0); a = __builtin_amdgcn_mfma_f32_16x16x32_bf16(pl[1], s1, a, 0, 0, 0);
        acc[t] = a; }
}
__device__ __forceinline__ void rwkv_state_to_lds(const f32x4 (&acc)[2], LAS unsigned char* Shi, LAS unsigned char* Slo, int wave, int lane) {
    const int tk = wave & 3, tv0 = 2 * (wave >> 2), c = lane & 15, q = lane >> 4;
#pragma unroll
    for (int t = 0; t < 2; ++t) { unsigned h[4]; float lo[4];
#pragma unroll
        for (int i = 0; i < 4; ++i) { h[i] = f2bf(acc[t][i]); lo[i] = acc[t][i] - bf2f((unsigned short)h[i]); }
        const int o = (16 * (tv0 + t) + c) * 144 + (16 * tk + 4 * q) * 2;
        *(LAS v2u*)(Shi + o) = (v2u){h[0] | (h[1] << 16), h[2] | (h[3] << 16)}; *(LAS v2u*)(Slo + o) = (v2u){pk2(lo[0], lo[1]), pk2(lo[2], lo[3])}; }
}
__device__ __forceinline__ void ph_rwkv_chain(Frame& F, int l) {
    PHASE_ENTRY();
    unsigned char* ws = A->ws; const int tid = F.tid, lane = F.lane, wave = F.wave;
    const int tk = wave & 3, tv0 = 2 * (wave >> 2), c = lane & 15, q = lane >> 4;
    LAS unsigned char* HI0 = F.lds, *LO0 = F.lds + RW_SLOT, *HI1 = F.lds + 2 * RW_SLOT, *LO1 = F.lds + 3 * RW_SLOT;
    const float* PT = (const float*)(ws + WS_PT32); const float* QQ = (const float*)(ws + WS_QQ); const float* WL = (const float*)(ws + WS_WL); bf16* SC = (bf16*)(ws + WS_SC);
    if (F.bid < 16) {
        const int h = F.bid;
        f32x4 acc[2]; RW_ZERO(acc);
        rwkv_state_to_lds(acc, HI0, LO0, wave, lane);
        __syncthreads();
        ChainOps ops; rwkv_chain_load(ops, PT + (size_t)(h * 128) * 4096, QQ + (size_t)(h * 128) * 4096, WL + (size_t)(h * 128) * 64, wave, lane);
        for (int cc = 0; cc < 128; ++cc) { const int u = h * 128 + cc; LAS unsigned char* chi = (cc & 1) ? HI1 : HI0, *clo = (cc & 1) ? LO1 : LO0, *nhi = (cc & 1) ? HI0 : HI1, *nlo = (cc & 1) ? LO0 : LO1;
            { const int row = tid >> 3, ch = tid & 7; *(GAS v4u*)((unsigned char*)(SC + (size_t)u * 4096) + tid * 16) = *(const LAS v4u*)(chi + row * 144 + ch * 16); }
            const ChainOps cur = ops;
            if (cc + 1 < 128) rwkv_chain_load(ops, PT + (size_t)(u + 1) * 4096, QQ + (size_t)(u + 1) * 4096, WL + (size_t)(u + 1) * 64, wave, lane);
            rwkv_chain_step(acc, cur, chi, clo, wave, lane);
            rwkv_state_to_lds(acc, nhi, nlo, wave, lane);
            __syncthreads(); }
#ifndef PROBE_SEQ
        float* wo = A->out + O_WP + (size_t)(l * 16 + h) * 4096;
#else
        float* wo = (float*)(A->ws + WS_HALO) + (size_t)h * 4096;
#endif
#pragma unroll
        for (int t = 0; t < 2; ++t) *(GAS f32x4*)(wo + (16 * (tv0 + t) + c) * 64 + 16 * tk + 4 * q) = acc[t];
    } else {
        for (int su = F.bid - 16; su < NSB * 16; su += F.G - 16) { const int u = 2048 + su, sb = su >> 4, h = su & 15;
            const float* S0 = A->in[I_SWKV] + (size_t)((l * NSB + sb) * 16 + h) * 4096;
            f32x4 acc[2];
#pragma unroll
            for (int t = 0; t < 2; ++t) acc[t] = *(const GAS f32x4*)(S0 + (16 * (tv0 + t) + c) * 64 + 16 * tk + 4 * q);
            rwkv_state_to_lds(acc, HI0, LO0, wave, lane);
            __syncthreads();
            { const int row = tid >> 3, ch = tid & 7; *(GAS v4u*)((unsigned char*)(SC + (size_t)u * 4096) + tid * 16) = *(const LAS v4u*)(HI0 + row * 144 + ch * 16); }
            { ChainOps o1; rwkv_chain_load(o1, PT + (size_t)u * 4096, QQ + (size_t)u * 4096, WL + (size_t)u * 64, wave, lane); rwkv_chain_step(acc, o1, HI0, LO0, wave, lane); }
            float* wo = A->out + O_WS + (size_t)((l * NSB + sb) * 16 + h) * 4096;
#pragma unroll
            for (int t = 0; t < 2; ++t) *(GAS f32x4*)(wo + (16 * (tv0 + t) + c) * 64 + 16 * tk + 4 * q) = acc[t];
            __syncthreads(); }
    }
}
__device__ __forceinline__ void ph_rwkv_passC(Frame& F, int l) {
    PHASE_ENTRY();
    unsigned char* ws = A->ws; const int lane = F.lane, wave = F.wave, c = lane & 15, q = lane >> 4, mt = wave & 3;
    const bf16* RP = (const bf16*)(ws + WS_RP); const unsigned short* YV = (const unsigned short*)(ws + WS_YV); const bf16* SC = (const bf16*)(ws + WS_SC);
    const unsigned short* G1 = (const unsigned short*)(ws + WS_G1); const unsigned short* G2 = (const unsigned short*)(ws + WS_G2); bf16* YC = (bf16*)(ws + WS_YCAT);
    bf16x8 rA[2], rB[2], sA[8], sB[8]; f32x4 yA[4], yB[4], gA[8], gB[8];
    auto geo = [&](int u, int& h, int& row0, bool& skip) { const bool samp = u >= 2048;
        if (!samp) { h = u >> 7; row0 = 64 * (u & 127); } else { const int su = u - 2048; h = su & 15; row0 = MP + (su >> 4) * TS; }
        skip = samp && mt > 0; };
    auto load = [&](int u, bf16x8 (&r)[2], bf16x8 (&sv)[8], f32x4 (&y)[4], f32x4 (&g)[8]) { int h, row0; bool skip; geo(u, h, row0, skip); if (skip) return;
        const bf16* RPu = RP + (size_t)u * 4096; const unsigned short* YVu = YV + (size_t)u * 4096; const bf16* SCu = SC + (size_t)u * 4096; const int t = 16 * mt + c; const size_t ro = (size_t)(row0 + t);
        r[0] = *(const GAS bf16x8*)(RPu + t * 64 + 8 * q); r[1] = *(const GAS bf16x8*)(RPu + t * 64 + 8 * q + 32);
#pragma unroll
        for (int nt = 0; nt < 4; ++nt) { const int v = h * 64 + 16 * nt + 4 * q; { const v2u yw = *(const GAS v2u*)(YVu + t * 64 + 16 * nt + 4 * q); y[nt] = (f32x4){bf2f((unsigned short)(yw.x & 0xffffu)), bf2f((unsigned short)(yw.x >> 16)), bf2f((unsigned short)(yw.y & 0xffffu)), bf2f((unsigned short)(yw.y >> 16))}; }
            sv[2 * nt] = *(const GAS bf16x8*)(SCu + (16 * nt + c) * 64 + 8 * q); sv[2 * nt + 1] = *(const GAS bf16x8*)(SCu + (16 * nt + c) * 64 + 8 * q + 32);
            { const v2u a = *(const GAS v2u*)(G1 + ro * 1024 + v), b = *(const GAS v2u*)(G2 + ro * 1024 + v);
              g[nt] = (f32x4){bf2f((unsigned short)(a.x & 0xffffu)), bf2f((unsigned short)(a.x >> 16)), bf2f((unsigned short)(a.y & 0xffffu)), bf2f((unsigned short)(a.y >> 16))};
              g[4 + nt] = (f32x4){bf2f((unsigned short)(b.x & 0xffffu)), bf2f((unsigned short)(b.x >> 16)), bf2f((unsigned short)(b.y & 0xffffu)), bf2f((unsigned short)(b.y >> 16))}; } } };
    auto compute = [&](int u, const bf16x8 (&r)[2], const bf16x8 (&sv)[8], f32x4 (&y)[4], const f32x4 (&g)[8]) { int h, row0; bool skip; geo(u, h, row0, skip); if (skip) return;
        const int t = 16 * mt + c; const size_t ro = (size_t)(row0 + t); float s1 = 0.f;
#pragma unroll
        for (int nt = 0; nt < 4; ++nt) { y[nt] = __builtin_amdgcn_mfma_f32_16x16x32_bf16(sv[2 * nt], r[0], y[nt], 0, 0, 0); y[nt] = __builtin_amdgcn_mfma_f32_16x16x32_bf16(sv[2 * nt + 1], r[1], y[nt], 0, 0, 0);
            s1 += (y[nt][0] + y[nt][1]) + (y[nt][2] + y[nt][3]); }
        s1 += swz_xor<16>(s1); s1 += xor32(s1);
        const float mean = s1 * (1.f / 64.f); float s2 = 0.f;
#pragma unroll
        for (int nt = 0; nt < 4; ++nt) { y[nt] = y[nt] - mean; s2 += (y[nt][0] * y[nt][0] + y[nt][1] * y[nt][1]) + (y[nt][2] * y[nt][2] + y[nt][3] * y[nt][3]); }
        s2 += swz_xor<16>(s2); s2 += xor32(s2);
        const float rstd = __builtin_amdgcn_rsqf(s2 * (1.f / 64.f) + 64e-5f);
#pragma unroll
        for (int nt = 0; nt < 4; ++nt) { const int v = h * 64 + 16 * nt + 4 * q;
            const f32x4 o = y[nt] * rstd * g[nt] + g[4 + nt]; v2u w; w.x = pk2(o[0], o[1]); w.y = pk2(o[2], o[3]); *(GAS v2u*)(YC + ro * DMOD + v) = w; } };
    const int u0 = 2 * F.bid + (wave >> 2), us = 2 * F.G;
    if (u0 < RW_UNITS) load(u0, rA, sA, yA, gA);
    for (int u = u0; u < RW_UNITS; u += 2 * us) {
        if (u + us < RW_UNITS) load(u + us, rB, sB, yB, gB);
        compute(u, rA, sA, yA, gA);
        if (u + us < RW_UNITS) { if (u + 2 * us < RW_UNITS) load(u + 2 * us, rA, sA, yA, gA); compute(u + us, rB, sB, yB, gB); }
    }
}
__device__ __forceinline__ void attn_sample_unit(ArgsP A, Frame& F, int l, int sb, int h) {
    unsigned char* ws = A->ws; const int tid = F.tid, lane = F.lane, wave = F.wave;
    LAS float* QS = (LAS float*)F.lds;
    LAS float* LUT = QS + 2048;
    LAS float* PB = QS + 4096 + wave * 1024;
    LAS float* MLW = QS + 4096 + 8192;
    LAS float* OACC = MLW + 128;
    LAS float* LACC = OACC + 4096;
    const bf16* QB = (const bf16*)(ws + WS_QB); const bf16* KB = (const bf16*)(ws + WS_KB); const bf16* VB = (const bf16*)(ws + WS_VB);
    const float* reltab = A->in[I_REL];
    for (int i = tid; i < 2048; i += NWAVES * 64) { const int t = i >> 7, d = i & 127; QS[i] = bf2f(QB[(size_t)(MP + sb * TS + t) * 1024 + h * 128 + d]); }
    if (tid < 192) { const int rel = tid - 128; const int n = rel < 0 ? -rel : rel;
        const int lg = n < 12 ? 8 : n < 16 ? 9 : n < 23 ? 10 : n < 32 ? 11 : n < 46 ? 12 : n < 64 ? 13 : n < 91 ? 14 : 15;
        const int bucket = (rel > 0 ? 16 : 0) + (n < 8 ? n : lg);
        LUT[tid] = (reltab[bucket * 8 + h] - reltab[15 * 8 + h]) * 1.4426950408889634f; }
    for (int i = tid; i < 4096 + 32; i += NWAVES * 64) OACC[i] = 0.f;
    __syncthreads();
    const int map = wave & 1, kg = wave >> 1;
    float mrun[16], lrun[16], o[16][2];
#pragma unroll
    for (int t = 0; t < 16; ++t) { mrun[t] = -INFINITY; lrun[t] = 0.f; o[t][0] = 0.f; o[t][1] = 0.f; }
    const float* CK = A->in[I_CK] + (size_t)(l * NSB + sb) * PAST * 1024; const float* CV = A->in[I_CV] + (size_t)(l * NSB + sb) * PAST * 1024;
    for (int kb = kg; kb < 33; kb += 4) {
        const int pos = 64 * kb + lane; const bool kvalid = pos < PAST + TS;
        float s[16];
#pragma unroll
        for (int t = 0; t < 16; ++t) s[t] = 0.f;
        if (kb < 32) { const float* kp = CK + (size_t)pos * 1024 + h * 128 + map * 64;
#pragma unroll 4
            for (int d = 0; d < 64; d += 4) { const f32x4 kv = *(const GAS f32x4*)(kp + d);
#pragma unroll
                for (int t = 0; t < 16; ++t) { const f32x4 qv = *(const LAS f32x4*)(QS + t * 128 + map * 64 + d); s[t] += (kv[0] * qv[0] + kv[1] * qv[1]) + (kv[2] * qv[2] + kv[3] * qv[3]); } }
        } else { const int rr = MP + sb * TS + (lane & 15); const bf16* kp = KB + (size_t)rr * 1024 + h * 128 + map * 64;
#pragma unroll 4
            for (int d = 0; d < 64; d += 4) { const v2u kw = *(const GAS v2u*)(kp + d);
                const f32x4 kv = (f32x4){bf2f((unsigned short)(kw.x & 0xffffu)), bf2f((unsigned short)(kw.x >> 16)), bf2f((unsigned short)(kw.y & 0xffffu)), bf2f((unsigned short)(kw.y >> 16))};
#pragma unroll
                for (int t = 0; t < 16; ++t) { const f32x4 qv = *(const LAS f32x4*)(QS + t * 128 + map * 64 + d); s[t] += (kv[0] * qv[0] + kv[1] * qv[1]) + (kv[2] * qv[2] + kv[3] * qv[3]); } }
        }
        float al[16];
#pragma unroll
        for (int t = 0; t < 16; ++t) { int idx = pos - (PAST + t) + 128; idx = idx < 0 ? 0 : idx; idx = idx > 191 ? 191 : idx;
            float sv = kvalid ? s[t] + LUT[idx] : -INFINITY;
            const float bm = wave_max(sv);
            const float mn = fmaxf(mrun[t], bm); al[t] = __builtin_amdgcn_exp2f(mrun[t] - mn); mrun[t] = mn;
            const float p = __builtin_amdgcn_exp2f(sv - mn); PB[lane * 16 + t] = p;
            lrun[t] = lrun[t] * al[t] + wave_sum(p);
            o[t][0] *= al[t]; o[t][1] *= al[t]; }
        LDS_WAIT(); asm volatile("" ::: "memory");
        const int nk = (kb < 32) ? 64 : TS;
        for (int k0 = 0; k0 < nk; k0 += 4) { f32x2 vv[4];
            if (kb < 32) {
#pragma unroll
                for (int b = 0; b < 4; ++b) vv[b] = *(const GAS f32x2*)(CV + (size_t)(64 * kb + k0 + b) * 1024 + h * 128 + 2 * lane);
            } else {
#pragma unroll
                for (int b = 0; b < 4; ++b) { const unsigned w = *(const GAS unsigned*)(VB + (size_t)(MP + sb * TS + k0 + b) * 1024 + h * 128 + 2 * lane); vv[b].x = bf2f((unsigned short)(w & 0xffffu)); vv[b].y = bf2f((unsigned short)(w >> 16)); }
            }
#pragma unroll
            for (int b = 0; b < 4; ++b) { const LAS f32x4* pp = (const LAS f32x4*)(PB + (k0 + b) * 16);
                const f32x4 p0 = pp[0], p1 = pp[1], p2 = pp[2], p3 = pp[3];
#pragma unroll
                for (int t = 0; t < 4; ++t) { o[t][0] += p0[t] * vv[b].x; o[t][1] += p0[t] * vv[b].y; o[4 + t][0] += p1[t] * vv[b].x; o[4 + t][1] += p1[t] * vv[b].y;
                    o[8 + t][0] += p2[t] * vv[b].x; o[8 + t][1] += p2[t] * vv[b].y; o[12 + t][0] += p3[t] * vv[b].x; o[12 + t][1] += p3[t] * vv[b].y; }
                asm volatile("" ::: "memory"); } }
        LDS_WAIT(); asm volatile("" ::: "memory");
    }
    if (lane < 16) { float mv = mrun[0];
#pragma unroll
        for (int t = 1; t < 16; ++t) mv = (lane == t) ? mrun[t] : mv;
        MLW[wave * 16 + lane] = mv; }
    __syncthreads();
#pragma unroll
    for (int t = 0; t < 16; ++t) { float M = fmaxf(fmaxf(MLW[(map) * 16 + t], MLW[(2 + map) * 16 + t]), fmaxf(MLW[(4 + map) * 16 + t], MLW[(6 + map) * 16 + t]));
        const float sc = __builtin_amdgcn_exp2f(mrun[t] - M);
        __hip_atomic_fetch_add(OACC + (t * 2 + map) * 128 + 2 * lane, o[t][0] * sc, __ATOMIC_RELAXED, __HIP_MEMORY_SCOPE_WORKGROUP); __hip_atomic_fetch_add(OACC + (t * 2 + map) * 128 + 2 * lane + 1, o[t][1] * sc, __ATOMIC_RELAXED, __HIP_MEMORY_SCOPE_WORKGROUP);
        if (lane == 0) __hip_atomic_fetch_add(LACC + map * 16 + t, lrun[t] * sc, __ATOMIC_RELAXED, __HIP_MEMORY_SCOPE_WORKGROUP); }
    __syncthreads();
    float* OA = (float*)(ws + WS_OATT);
    for (int i = tid; i < 4096; i += NWAVES * 64) { const int t = i >> 8, mp = (i >> 7) & 1, e = i & 127;
        OA[(size_t)(MP + sb * TS + t) * DMOD + h * 256 + mp * 128 + e] = OACC[i] / LACC[mp * 16 + t]; }
    __syncthreads();
}


__device__ __forceinline__ void attn_sample_unit2(ArgsP A, Frame& F, int l, int sb, int h) {
    using attn_body::f32x16;
    unsigned char* ws = A->ws; int tid_ = F.tid; asm volatile("" : "+v"(tid_));
    const int tid = tid_, lane = tid & 63, wid = __builtin_amdgcn_readfirstlane(tid >> 6), r32 = lane & 31, hi = lane >> 5, map = wid & 1, vh = (wid >> 1) & 1, KH = wid >> 2;
    LAS unsigned char* L = F.lds;
    LAS float* wsf = (LAS float*)(L + 65536) + wid * 64;
    const LAS float* LUT = (const LAS float*)(L + LUT_OFF) + h * 192;
    LAS float* MG = (LAS float*)(L + 68608);
    const bf16* QB = (const bf16*)(ws + WS_QB); const bf16* KB = (const bf16*)(ws + WS_KB); const bf16* VB = (const bf16*)(ws + WS_VB);
    const float* CK = A->in[I_CK] + (size_t)(l * NSB + sb) * PAST * 1024 + h * 128; const float* CV = A->in[I_CV] + (size_t)(l * NSB + sb) * PAST * 1024 + h * 128;
    bf16x8 qr[4];
    { const bf16* Qw = QB + (size_t)(MP + sb * TS + (r32 & 15)) * 1024 + h * 128 + map * 64;
#pragma unroll
      for (int d0 = 0; d0 < 4; ++d0) qr[d0] = *(const GAS bf16x8*)(Qw + d0 * 16 + hi * 8); }
    f32x4 st[8];
    auto stage_load = [&](int tile) {
        if (tile < 32) {
#pragma unroll
            for (int k = 0; k < 4; ++k) { const int idx = tid + 512 * k, row = idx >> 5, pp = idx & 31; const size_t off = (size_t)(64 * tile + row) * 1024 + 4 * pp;
                st[k] = __builtin_nontemporal_load((const GAS f32x4*)(CK + off)); st[4 + k] = __builtin_nontemporal_load((const GAS f32x4*)(CV + off)); }
        } else {
#pragma unroll
            for (int i = 0; i < 8; ++i) st[i] = (f32x4){0.f, 0.f, 0.f, 0.f};
            { const int row = tid >> 5, pp = tid & 31; const size_t off = (size_t)(MP + sb * TS + row) * 1024 + h * 128 + 4 * pp;
              const v2u wk = *(const GAS v2u*)(KB + off), wv = *(const GAS v2u*)(VB + off);
              st[0] = (f32x4){bf2f((unsigned short)(wk.x & 0xffffu)), bf2f((unsigned short)(wk.x >> 16)), bf2f((unsigned short)(wk.y & 0xffffu)), bf2f((unsigned short)(wk.y >> 16))};
              st[4] = (f32x4){bf2f((unsigned short)(wv.x & 0xffffu)), bf2f((unsigned short)(wv.x >> 16)), bf2f((unsigned short)(wv.y & 0xffffu)), bf2f((unsigned short)(wv.y >> 16))}; }
        } };
    auto stage_write = [&](int buf) { LAS unsigned char* B = L + buf * 32768;
#pragma unroll
        for (int k = 0; k < 4; ++k) { const int idx = tid + 512 * k, row = idx >> 5, pp = idx & 31, c = 4 * (pp & 15); const f32x4 x = st[k], y = st[4 + k];
            *(LAS v2u*)(B + (pp >> 4) * 8192 + ((pp & 15) >> 1) * 1024 + row * 16 + (pp & 1) * 8) = (v2u){pk2(x[0], x[1]), pk2(x[2], x[3])};
            *(LAS v2u*)(B + 16384 + (pp >> 4) * 8192 + ((c >> 5) * 4 + (row >> 4)) * 1024 + ((row & 15) * 4 + ((c & 31) >> 3)) * 16 + ((c >> 2) & 1) * 8) = (v2u){pk2(y[0], y[1]), pk2(y[2], y[3])}; } };
    stage_load(0);
    float mhat = 0.f, l_reg = 0.f; f32x16 o[2]; o[0] = f32x16{}; o[1] = f32x16{};
    stage_write(0);
    __syncthreads();
    for (int tile = 0; tile < 33; ++tile) {
        if (tile + 1 < 33) stage_load(tile + 1);
        const LAS unsigned char* B = L + (tile & 1) * 32768;
        f32x16 p;
        attn_body::qkt_half(p, (attn_body::lds_cp)(B + map * 8192), qr, f32x16{}, r32, hi, KH);
        asm volatile("s_nop 15\n\ts_nop 7" : "+v"(p));
#pragma unroll
        for (int r = 0; r < 16; ++r) p[r] -= mhat;
        if (tile >= 30) {
            const int rel0 = 64 * tile + 32 * KH + 4 * hi - (PAST + (r32 & 15)) + 128;
#pragma unroll
            for (int r = 0; r < 16; ++r) { const int kin = 32 * KH + 4 * hi + (r & 3) + 8 * (r >> 2); int idx = rel0 + (r & 3) + 8 * (r >> 2); idx = idx < 0 ? 0 : (idx > 191 ? 191 : idx);
                p[r] = (tile == 32 && kin >= TS) ? -INFINITY : p[r] + LUT[idx]; } }
        float rm = p[0];
#pragma unroll
        for (int r = 1; r < 16; ++r) rm = fmaxf(rm, p[r]);
        { const PL32 rr = pl32(rm); rm = fmaxf(rr.a, rr.b); }
        if (__any(rm > 0.f)) { const float dl = fmaxf(rm, 0.f); mhat += dl;
#pragma unroll
            for (int r = 0; r < 16; ++r) p[r] -= dl;
            const float f = __builtin_amdgcn_exp2f(-dl); l_reg *= f; if (hi == 0) wsf[r32] = f;
            asm volatile("s_waitcnt lgkmcnt(0)" ::: "memory");
#pragma unroll
            for (int d_ = 0; d_ < 2; ++d_)
#pragma unroll
                for (int r = 0; r < 16; ++r) o[d_][r] *= wsf[attn_body::crow(r, hi)]; }
        float sacc = 0.f;
#pragma unroll
        for (int r = 0; r < 16; ++r) { p[r] = __builtin_amdgcn_exp2f(p[r]); sacc += p[r]; }
        l_reg += sacc;
        const v4u pw0 = (v4u){attn_body::cvtpk_s(p[0], p[1]), attn_body::cvtpk_s(p[2], p[3]), attn_body::cvtpk_s(p[4], p[5]), attn_body::cvtpk_s(p[6], p[7])};
        const v4u pw1 = (v4u){attn_body::cvtpk_s(p[8], p[9]), attn_body::cvtpk_s(p[10], p[11]), attn_body::cvtpk_s(p[12], p[13]), attn_body::cvtpk_s(p[14], p[15])};
        const int vb = (int)(unsigned)(size_t)(B + 16384 + vh * 8192) + KH * 2048 + ((lane >> 4) & 1) * 32 + (lane & 3) * 8 + (4 * hi + ((lane & 15) >> 2)) * 64;
        attn_body::pv_half(o, vb, __builtin_bit_cast(bf16x8, pw0), __builtin_bit_cast(bf16x8, pw1));
        if (tile + 1 < 33) stage_write((tile + 1) & 1);
        __syncthreads();
    }
    { const PL32 rr = pl32(l_reg); l_reg = rr.a + rr.b; }
    LAS float* OG = (LAS float*)L + (wid & 3) * 2048;
    if (KH == 1) { if (hi == 0) { MG[(wid & 3) * 64 + r32] = mhat; MG[(wid & 3) * 64 + 32 + r32] = l_reg; }
#pragma unroll
        for (int d_ = 0; d_ < 2; ++d_)
#pragma unroll
            for (int r = 0; r < 16; ++r) OG[(d_ * 16 + r) * 64 + lane] = o[d_][r]; }
    __syncthreads();
    if (KH == 0) { const float m2 = MG[wid * 64 + r32], l2 = MG[wid * 64 + 32 + r32]; const float M = fmaxf(mhat, m2);
        const float f1 = __builtin_amdgcn_exp2f(mhat - M), f2 = __builtin_amdgcn_exp2f(m2 - M); const float inv = 1.f / (l_reg * f1 + l2 * f2);
        if (hi == 0) { wsf[r32] = f1 * inv; wsf[32 + r32] = f2 * inv; }
        asm volatile("s_waitcnt lgkmcnt(0)" ::: "memory");
        bf16* OA = (bf16*)(ws + WS_OATT) + (size_t)(MP + sb * TS) * DMOD + h * 256 + map * 128 + vh * 64;
#pragma unroll
        for (int r = 0; r < 8; ++r) { const int q = attn_body::crow(r, hi); const float g1 = wsf[q], g2 = wsf[32 + q];
#pragma unroll
            for (int d_ = 0; d_ < 2; ++d_) OA[(size_t)q * DMOD + d_ * 32 + r32] = (bf16)f2bf(o[d_][r] * g1 + OG[(d_ * 16 + r) * 64 + lane] * g2); } }
    __syncthreads();
}
__device__ __forceinline__ void attn_build_lut(ArgsP A, Frame& F) {
    LAS float* T = (LAS float*)(F.lds + LUT_OFF); const float* reltab = A->in[I_REL];
    for (int i = F.tid; i < 8 * 192; i += NWAVES * 64) { const int hh = i / 192, rel = i % 192 - 128; const int n = rel < 0 ? -rel : rel;
        const int lg = n < 12 ? 8 : n < 16 ? 9 : n < 23 ? 10 : n < 32 ? 11 : n < 46 ? 12 : n < 64 ? 13 : n < 91 ? 14 : 15;
        const int bucket = (rel > 0 ? 16 : 0) + (n < 8 ? n : lg);
        T[i] = (reltab[bucket * 8 + hh] - reltab[15 * 8 + hh]) * 1.4426950408889634f; }
    __syncthreads();
}
__device__ __forceinline__ void ph_attn_sample(Frame& F, int l) {
    PHASE_ENTRY();
    attn_build_lut(A, F);
    gu32* head = F.ctl + CW_QUEUE + 128 * l;
    for (;;) {
        if (F.tid == 0) F.MISC[16] = __hip_atomic_fetch_add(head, 1u, RLX_AGENT);
        __syncthreads();
        const unsigned qi = F.MISC[16];
        __syncthreads();
        if (qi >= 128u) break;
#ifdef SAMPLE_VALU
        attn_sample_unit(A, F, l, (int)(qi >> 3), (int)(qi & 7u));
#else
        attn_sample_unit2(A, F, l, (int)(qi >> 3), (int)(qi & 7u));
#endif
    }
}
__device__ __forceinline__ void ph_attn_prompt(Frame& F, int l) {
    PHASE_ENTRY();
    unsigned char* ws = A->ws;
    gu32* head = F.ctl + CW_QUEUE + 128 * l + 64;
    for (;;) {
        if (F.tid == 0) F.MISC[17] = __hip_atomic_fetch_add(head, 1u, RLX_AGENT);
        __syncthreads();
        const unsigned qi = F.MISC[17];
        __syncthreads();
        if (qi >= 1024u) break;
        const int qb = 63 - (int)(qi >> 4), hm = (int)(qi & 15u);
        const int hh = hm >> 1, mp = hm & 1;
        attn_body::attn_unit_f<8>(qb, hh * 128 + mp * 64, hh * 128, hh * 256 + mp * 128,
                                (const attn_body::bf16*)(ws + WS_QB), (const attn_body::bf16*)(ws + WS_KB), (const attn_body::bf16*)(ws + WS_VB), (attn_body::bf16*)(ws + WS_OATT), (char*)F.lds, (const LAS float*)(F.lds + LUT_OFF) + hh * 192);
    }
}
__device__ __forceinline__ void ph_attn_final(Frame& F, int l) {
    PHASE_ENTRY();
    const int lane = F.lane; const int gw = F.bid * NWAVES + F.wave, NGW = F.G * NWAVES;
    float d1 = A->in[I_LQ1][l * 64 + lane] * A->in[I_LK1][l * 64 + lane], d2 = A->in[I_LQ2][l * 64 + lane] * A->in[I_LK2][l * 64 + lane];
    d1 = wave_sum(d1); d2 = wave_sum(d2);
    const float lam_init = (l == 0) ? 0.2f : (0.8f - 0.6f * 0.7408182206817179f);
    const float lam = expf(d1) - expf(d2) + lam_init, osc = 1.f - lam_init;
    const int hh = lane >> 3, e0 = (lane & 7) * 16;
    const bf16* OA = (const bf16*)(A->ws + WS_OATT); bf16* YC = (bf16*)(A->ws + WS_YCAT);
    f32x4 sl[4];
#pragma unroll
    for (int j = 0; j < 4; ++j) sl[j] = *(const GAS f32x4*)(A->in[I_SUBLN] + l * 128 + e0 + 4 * j);
    v4u na0 = (v4u){0u, 0u, 0u, 0u}, na1 = na0, nb0 = na0, nb1 = na0;
    if (gw < MT) { const bf16* o2 = OA + (size_t)gw * DMOD + hh * 256 + e0; na0 = *(const GAS v4u*)o2; na1 = *(const GAS v4u*)(o2 + 8); nb0 = *(const GAS v4u*)(o2 + 128); nb1 = *(const GAS v4u*)(o2 + 136); }
    for (int m = gw; m < MT; m += NGW) {
        if (l == 0 && m >= MP) { const float* xs = A->in[I_XS] + (size_t)(m - MP) * DMOD; float* xd = (float*)(A->ws + WS_X) + (size_t)m * DMOD;
#pragma unroll
            for (int j = 0; j < 8; ++j) *(GAS f32x4*)(xd + 4 * lane + 256 * j) = *(const GAS f32x4*)(xs + 4 * lane + 256 * j); }
        f32x4 o[4]; float ss = 0.f;
        { const v4u a0 = na0, a1 = na1, b0 = nb0, b1 = nb1;
          if (m + NGW < MT) { const bf16* o2 = OA + (size_t)(m + NGW) * DMOD + hh * 256 + e0; na0 = *(const GAS v4u*)o2; na1 = *(const GAS v4u*)(o2 + 8); nb0 = *(const GAS v4u*)(o2 + 128); nb1 = *(const GAS v4u*)(o2 + 136); }
          const unsigned aw[8] = {a0.x, a0.y, a0.z, a0.w, a1.x, a1.y, a1.z, a1.w}, bw[8] = {b0.x, b0.y, b0.z, b0.w, b1.x, b1.y, b1.z, b1.w};
#pragma unroll
          for (int j = 0; j < 4; ++j) { o[j][0] = bf2f((unsigned short)(aw[2 * j] & 0xffffu)) - lam * bf2f((unsigned short)(bw[2 * j] & 0xffffu)); o[j][1] = bf2f((unsigned short)(aw[2 * j] >> 16)) - lam * bf2f((unsigned short)(bw[2 * j] >> 16));
              o[j][2] = bf2f((unsigned short)(aw[2 * j + 1] & 0xffffu)) - lam * bf2f((unsigned short)(bw[2 * j + 1] & 0xffffu)); o[j][3] = bf2f((unsigned short)(aw[2 * j + 1] >> 16)) - lam * bf2f((unsigned short)(bw[2 * j + 1] >> 16));
              ss += (o[j][0] * o[j][0] + o[j][1] * o[j][1]) + (o[j][2] * o[j][2] + o[j][3] * o[j][3]); } }
        ss += swz_xor<1>(ss); ss += swz_xor<2>(ss); ss += swz_xor<4>(ss);
        const float rs = osc * __builtin_amdgcn_rsqf(ss * (1.f / 128.f) + 1e-5f);
        v4u w0, w1; f32x4 y0 = o[0] * rs * sl[0], y1 = o[1] * rs * sl[1], y2 = o[2] * rs * sl[2], y3 = o[3] * rs * sl[3];
        w0 = (v4u){pk2(y0[0], y0[1]), pk2(y0[2], y0[3]), pk2(y1[0], y1[1]), pk2(y1[2], y1[3])}; w1 = (v4u){pk2(y2[0], y2[1]), pk2(y2[2], y2[3]), pk2(y3[0], y3[1]), pk2(y3[2], y3[3])};
        bf16* yo = YC + (size_t)m * DMOD + 1024 + hh * 128 + e0; *(GAS v4u*)yo = w0; *(GAS v4u*)(yo + 8) = w1;
    }
}
__device__ __forceinline__ void ph_fixup(Frame& F, int l) {
    PHASE_ENTRY();
    const float* tail = (const float*)(A->ws + WS_HALO), *hg = tail + 32 * 2 * DFF, *hv = hg + 32 * 2 * DFF;
    const float* cw = A->in[I_CONVW] + (size_t)l * 3 * DFF, *cb = A->in[I_CONVB] + (size_t)l * DFF; bf16* ACT = (bf16*)(A->ws + WS_ACT);
    const int gt = F.bid * (NWAVES * 64) + F.tid, ngt = F.G * NWAVES * 64;
    for (int idx = gt; idx < 31 * DFF; idx += ngt) { const int pm = 1 + idx / DFF, j = idx % DFF;
        const float um2 = tail[((size_t)(pm - 1) * 2 + 0) * DFF + j], um1 = tail[((size_t)(pm - 1) * 2 + 1) * DFF + j], u0 = hg[((size_t)pm * 2 + 0) * DFF + j], u1 = hg[((size_t)pm * 2 + 1) * DFF + j];
        const float v0 = hv[((size_t)pm * 2 + 0) * DFF + j], v1 = hv[((size_t)pm * 2 + 1) * DFF + j];
        const float w0 = cw[j], w1 = cw[DFF + j], w2 = cw[2 * DFF + j], b = cb[j];
        const pg8::f32x2 g = pg8::gelu_pk((pg8::f32x2){b + w0 * um2 + w1 * um1 + w2 * u0, b + w0 * um1 + w1 * u0 + w2 * u1});
        ACT[(size_t)(256 * pm) * DFF + j] = (bf16)f2bf(g.x * v0); ACT[(size_t)(256 * pm + 1) * DFF + j] = (bf16)f2bf(g.y * v1); }
}
#ifdef PROBE_SEQ
__device__ __forceinline__ void probe_seq_scan(Frame& F, int l) {
    PHASE_ENTRY();
    const int gw = F.bid * NWAVES + F.wave, lane = F.lane;
    if (gw >= 16) return;
    const int h = gw, hj = h * 64 + lane;
    const float* PR = (const float*)(A->ws + WS_PR); const float* mu = A->in[I_MU] + (size_t)l * NRC;
    LAS float* sc = (LAS float*)(F.lds + F.wave * 4096);
    const float* w2 = A->in[I_W2] + (size_t)l * 96 * 1024; const float* a2 = A->in[I_A2] + (size_t)l * 96 * 1024;
    const float w0 = A->in[I_W0][l * 1024 + hj], a0 = A->in[I_A0][l * 1024 + hj], kkw = A->in[I_KK][l * 1024 + hj], kaw = A->in[I_KA][l * 1024 + hj];
    float S[64];
#pragma unroll
    for (int k = 0; k < 64; ++k) S[k] = 0.f;
    for (int t = 0; t < MP; ++t) {
        const float* pc = PR + (size_t)t * NRC_PAD; const float* pp = pc - NRC_PAD;
        auto lerp = [&](int col) { const float cur = pc[col]; const float prv = t > 0 ? pp[col] : 0.f; return cur + (prv - cur) * mu[col]; };
        sc[lane] = tanhf(lerp(3072 + lane)); if (lane < 32) sc[64 + lane] = tanhf(lerp(3072 + 64 + lane));
        sc[96 + lane] = lerp(3168 + lane); if (lane < 32) sc[96 + 64 + lane] = lerp(3168 + 64 + lane);
        LDS_WAIT(); asm volatile("" ::: "memory");
        float wl = 0.f, al = 0.f;
        for (int k = 0; k < 96; ++k) { wl += sc[k] * w2[(size_t)k * 1024 + hj]; al += sc[96 + k] * a2[(size_t)k * 1024 + hj]; }
        const float xk = lerp(1024 + hj), xv = lerp(2048 + hj);
        const float z = w0 + wl; const float wlog = -log1pf(expf(-z)) - 0.5f; const float w = expf(-expf(wlog));
        const float a = 1.f / (1.f + expf(-(a0 + al)));
        const float kkr = xk * kkw; const float nrm = wave_sum(kkr * kkr); const float kk = kkr / sqrtf(fmaxf(nrm, 1e-24f));
        const float km = xk * (1.f + (a - 1.f) * kaw);
        LDS_WAIT(); asm volatile("" ::: "memory");
        sc[192 + lane] = w; sc[256 + lane] = kk; sc[320 + lane] = kk * a; sc[384 + lane] = km;
        LDS_WAIT(); asm volatile("" ::: "memory");
        float sa = 0.f;
#pragma unroll
        for (int k = 0; k < 64; ++k) sa -= S[k] * sc[256 + k];
#pragma unroll
        for (int k = 0; k < 64; ++k) S[k] = S[k] * sc[192 + k] + sa * sc[320 + k] + xv * sc[384 + k];
        LDS_WAIT(); asm volatile("" ::: "memory");
    }
    float* wo = A->out + O_WP + (size_t)(l * 16 + h) * 4096 + lane * 64;
#pragma unroll
    for (int k = 0; k < 64; ++k) wo[k] = S[k];
}
#endif
#ifdef PROBE_GEMM
__device__ __forceinline__ void probe_gemm_check(Frame& F) {
    PHASE_ENTRY();
    if (F.bid != 0) return;
    float* scr = (float*)(A->ws + WS_OATT);
    const int tid = F.tid, lane = F.lane, wave = F.wave;
    for (int j = tid; j < 2 * DMOD; j += NWAVES * 64) { float s = A->in[I_BADA][j];
        for (int k = 0; k < DMOD; ++k) { const float c = A->in[I_CP][k]; s += (c / (1.f + expf(-c))) * A->in[I_WADA][(size_t)k * MODW + j]; }
        scr[j] = s; }
    __threadfence(); __syncthreads();
    float num = 0.f, den = 0.f;
#if PROBE_GEMM == 3
    for (int j = tid; j < 2 * DMOD; j += NWAVES * 64) { const float mine = ((const float*)(A->ws + WS_MOD))[j], ref = scr[j]; num += (mine - ref) * (mine - ref); den += ref * ref; }
    num = wave_sum(num); den = wave_sum(den);
#elif PROBE_GEMM == 5
    { const float sgot = wave_sum((float)(lane + 1)); num = (sgot - 2080.f) * (sgot - 2080.f); den = 2080.f * 2080.f; }
#elif PROBE_GEMM == 6
    { float v = (float)(lane + 1); for (int o = 1; o < 64; o <<= 1) v += __shfl_xor(v, o); num = (v - 2080.f) * (v - 2080.f); den = 2080.f * 2080.f; }
#elif PROBE_GEMM == 4
    for (int smp = wave; smp < 64; smp += NWAVES) { const int m = (smp * 2654435761u >> 7) % MP; const float* xr = A->in[I_XP] + (size_t)m * DMOD; float ss = 0.f;
        for (int k = lane; k < DMOD; k += 64) ss += xr[k] * xr[k];
        const float rstd = 1.f / sqrtf(wave_sum(ss) / DMOD + 1e-6f);
        for (int k = lane; k < DMOD; k += 64) { const float hh = xr[k] * rstd * A->in[I_GMIX][k] * (1.f + scr[DMOD + k]) + scr[k]; const float mine = bf2f(((const bf16*)(A->ws + WS_H))[(size_t)m * DMOD + k]); num += (mine - hh) * (mine - hh); den += hh * hh; } }
    num = wave_sum(num); den = wave_sum(den);
#else
    for (int smp = wave; smp < 256; smp += NWAVES) {
        const int m = (smp * 2654435761u >> 7) % MP; const int cc = (smp * 40503u + 17u) % (PROBE_GEMM == 1 ? 3072 : 1024);
        const int col = PROBE_GEMM == 1 ? cc : NRC + 1024 + cc;
        const float* xr = A->in[I_XP] + (size_t)m * DMOD; float ss = 0.f;
        for (int k = lane; k < DMOD; k += 64) ss += xr[k] * xr[k];
        const float rstd = 1.f / sqrtf(wave_sum(ss) / DMOD + 1e-6f); float acc = 0.f;
        for (int k = lane; k < DMOD; k += 64) { const float hh = xr[k] * rstd * A->in[I_GMIX][k] * (1.f + scr[DMOD + k]) + scr[k]; acc += hh * A->in[I_WIN][(size_t)k * NIN + col]; }
        acc = wave_sum(acc);
        const float mine = PROBE_GEMM == 1 ? ((const float*)(A->ws + WS_PR))[(size_t)m * NRC_PAD + cc] : A->out[O_KP + (size_t)m * 1024 + cc];
        num += (mine - acc) * (mine - acc); den += acc * acc; }
#endif
    LAS float* red = (LAS float*)F.lds;
    if (lane == 0) { red[wave] = num; red[8 + wave] = den; }
    __syncthreads();
    if (tid == 0) { float n = 0.f, d = 0.f; for (int w = 0; w < 8; ++w) { n += red[w]; d += red[8 + w]; } ((float*)(A->ws + WS_CTL))[16384] = sqrtf(n / d); }
}
#endif
#ifndef MK_SPLIT
#define MK_SPLIT 0
#endif
constexpr int KS_DN = 4;
constexpr int N_PHASES = 22;
__global__ void __launch_bounds__(NWAVES * 64, 2) hybrid_fwd(Args args) {
    extern __shared__ __attribute__((aligned(16))) unsigned char lds[];
    Frame F;
    F.lds = (LAS unsigned char*)lds; F.MISC = (volatile LAS unsigned*)(F.lds + MISC_OFF);
    F.tid = threadIdx.x; F.lane = F.tid & 63; F.wave = __builtin_amdgcn_readfirstlane(F.tid >> 6); F.G = gridDim.x; F.bid = blockIdx.x;
    F.ctl = (gu32*)(args.ws + WS_CTL);
    if (F.tid < 64) F.MISC[F.tid] = 0u;
    __syncthreads();
    XcdBarrier bar; bar.bar = (unsigned*)(F.ctl + CW_BAR); bar.x = 0; bar.st = nullptr;
    if (!MK_SPLIT) bar = xcd_barrier_post((unsigned*)(F.ctl + CW_BAR), F.MISC + 8);
    const int lo = args.ph_lo, hi = args.ph_hi;
#ifndef ONLY_PT
#define ONLY_PT -1
#endif
#define PT_ON(t) (ONLY_PT < 0 || ONLY_PT == (t))
#define IN(k) (lo <= (k) && (k) < hi)
#define SEAM(k) do { if (IN(k) && IN((k) + 1)) xcd_barrier(bar); } while (0)
    if (PT_ON(0) && IN(0)) { ph_prologue(F); }
    SEAM(0);
    for (int l = 0; l < NLAYER; ++l) {
        const int pb = 1 + 10 * l;
        if (PT_ON(1) && IN(pb + 0)) ph_norm(F, l, 0, l == 0 ? 0 : KS_DN);
        SEAM(pb + 0);
        if (PT_ON(2) && IN(pb + 1)) { PHASE_ENTRY(); unsigned char* ws = A->ws;
            pg8::Gemm g{(const pg8::bf16_t*)(ws + WS_H), (const pg8::bf16_t*)(ws + WS_WIN) + (size_t)l * NIN_PAD * DMOD, MT, NIN_PAD, DMOD, DMOD}; pg8::TwoPartOrder S; S.init(MT, NRC_PAD / 256, (NIN_PAD - NRC_PAD) / 256, F.G, F.bid, F.G == 256 ? (unsigned*)(F.ctl + CW_QUEUE + 1024 + 64 * l) : nullptr, 1 + (F.bid + 256 < (MT / 256) * (NRC_PAD / 256) ? 1 : 0));
            pg8::EpiIn E{ws, A->out, l, 0.125f * 1.4426950408889634f};
            pg8::gemm_phase<pg8::EpiIn, pg8::TwoPartOrder, true, true>(F.lds, g, S, E);
        }
        if (F.G != 256) SEAM(pb + 1);
#ifdef PROBE_GEMM
        if (l == 0 && IN(pb + 2)) { probe_gemm_check(F); __syncthreads(); }
#endif
        if (PT_ON(3) && IN(pb + 2)) ph_rwkv_passA(F, l);
        SEAM(pb + 2);
#ifdef PROBE_SEQ
        if (IN(pb + 3)) { probe_seq_scan(F, l); __syncthreads(); }
#endif
        if (PT_ON(4) && IN(pb + 3)) { ph_rwkv_chain(F, l); ph_attn_sample(F, l); ph_attn_prompt(F, l); }
        SEAM(pb + 3);
#ifdef PROBE_SEQ
        if (IN(pb + 4) && F.bid == 0) { PHASE_ENTRY();
            for (int h = F.wave; h < 16; h += NWAVES) { const float* a = (const float*)(A->ws + WS_HALO) + (size_t)h * 4096; const float* b = A->out + O_WP + (size_t)(l * 16 + h) * 4096; float n = 0.f, d = 0.f;
                for (int i = F.lane; i < 4096; i += 64) { n += (a[i] - b[i]) * (a[i] - b[i]); d += b[i] * b[i]; }
                n = wave_sum(n); d = wave_sum(d); if (F.lane == 0) { ((float*)(A->ws + WS_CTL))[16400 + 16 * l + h] = sqrtf(n / d); ((float*)(A->ws + WS_CTL))[16440 + 16 * l + h] = d; } } }
#endif
        if (PT_ON(5) && IN(pb + 4)) { ph_rwkv_passC(F, l); ph_attn_final(F, l); }
        SEAM(pb + 4);
        if (PT_ON(6) && IN(pb + 5)) { PHASE_ENTRY(); unsigned char* ws = A->ws;
            const float* X = (const float*)(ws + WS_X); const float* MODl = (const float*)(ws + WS_MOD) + (size_t)l * NMODB * MODW;
            { pg8::Gemm g{(const pg8::bf16_t*)(ws + WS_YCAT), (const pg8::bf16_t*)(ws + WS_WOUT) + (size_t)l * DMOD * DMOD, MP, DMOD, DMOD, DMOD}; pg8::StaticOrder S; S.init(MP, DMOD, F.G, F.bid);
              pg8::EpiRes E{l == 0 ? A->in[I_XP] : X, X + (size_t)MP * DMOD, (float*)(ws + WS_X), MODl + 2 * DMOD};
              pg8::gemm_phase<pg8::EpiRes, pg8::StaticOrder, true, true>(F.lds, g, S, E); }
            { pg8::Gemm g{(const pg8::bf16_t*)(ws + WS_YCAT) + (size_t)MP * DMOD, (const pg8::bf16_t*)(ws + WS_WOUT) + (size_t)l * DMOD * DMOD, 256, DMOD, DMOD / 8, DMOD}; pg8::SplitOrder S; S.init(DMOD, 8, F.bid);
              pg8::EpiResSlab E{(float*)(ws + WS_SLAB), MODl + 2 * DMOD};
              pg8::gemm_phase<pg8::EpiResSlab, pg8::SplitOrder, true, true>(F.lds, g, S, E); }
        }
        SEAM(pb + 5);
        if (PT_ON(7) && IN(pb + 6)) ph_norm(F, l, 1, 8);
        SEAM(pb + 6);
        if (PT_ON(8) && IN(pb + 7)) { PHASE_ENTRY(); unsigned char* ws = A->ws;
            pg8::Gemm g{(const pg8::bf16_t*)(ws + WS_H), (const pg8::bf16_t*)(ws + WS_WUP) + (size_t)l * NUP * DMOD, MT, NUP, DMOD, DMOD}; pg8::PmFirstOrder S; S.init(MT, NUP, F.G, F.bid, F.G == 256 ? (unsigned*)(F.ctl + CW_QUEUE + 1536 + 64 * l) : nullptr);
            pg8::EpiUp E{(pg8::bf16_t*)(ws + WS_ACT), A->in[I_CONVW] + (size_t)l * 3 * DFF, A->in[I_CONVB] + (size_t)l * DFF, A->in[I_SCONV] + (size_t)l * NSB * 2 * DFF,
                         (float*)(ws + WS_HALO), A->out + O_CP + (size_t)l * 2 * DFF, A->out + O_CS + (size_t)l * NSB * 2 * DFF, (PG8_LAS float*)(F.lds + HALO_OFF)};
            pg8::gemm_phase<pg8::EpiUp, pg8::PmFirstOrder, true, true>(F.lds, g, S, E);
            { int first = 0, nw = F.G;
              if (F.G == 256) { first = 256 - ((256 * 6) - (MT / 256) * (NUP / 256)); nw = 256 - first; if (F.bid >= first) wait_count(F, (unsigned*)(F.ctl + CW_QUEUE + 1536 + 64 * l), (unsigned)(NUP / 256)); }
              else if (!MK_SPLIT) xcd_barrier(bar);
              const float* MODl = (const float*)(ws + WS_MOD) + (size_t)l * NMODB * MODW;
              pg8::Gemm g2{(const pg8::bf16_t*)(ws + WS_ACT) + (size_t)MP * DFF, (const pg8::bf16_t*)(ws + WS_WDN) + (size_t)l * DMOD * DFF, 256, DMOD, DFF / KS_DN, DFF}; pg8::TailSplitOrder S2; S2.init(DMOD, KS_DN, F.bid, first, nw);
              pg8::EpiResSlab E2{(float*)(ws + WS_SLAB), MODl + 5 * DMOD};
              pg8::gemm_phase<pg8::EpiResSlab, pg8::TailSplitOrder, true, true>(F.lds, g2, S2, E2); }
        }
        SEAM(pb + 7);
        if (PT_ON(9) && IN(pb + 8)) ph_fixup(F, l);
        SEAM(pb + 8);
        if (PT_ON(10) && IN(pb + 9)) { PHASE_ENTRY(); unsigned char* ws = A->ws;
            const float* X = (const float*)(ws + WS_X); const float* MODl = (const float*)(ws + WS_MOD) + (size_t)l * NMODB * MODW;
            { pg8::Gemm g{(const pg8::bf16_t*)(ws + WS_ACT), (const pg8::bf16_t*)(ws + WS_WDN) + (size_t)l * DMOD * DFF, MP, DMOD, DFF, DFF}; pg8::StaticOrder S; S.init(MP, DMOD, F.G, F.bid);
              pg8::EpiRes E{X, X + (size_t)MP * DMOD, (float*)(ws + WS_X), MODl + 5 * DMOD};
              pg8::gemm_phase<pg8::EpiRes, pg8::StaticOrder, true, true>(F.lds, g, S, E); }
        }
        SEAM(pb + 9);
    }
    if (PT_ON(11) && IN(21)) ph_norm(F, 0, 2, KS_DN);
#ifdef PROBE_MASK
    if (IN(22)) { PHASE_ENTRY();
        const size_t offs[13] = {O_YP, O_YS, O_KP, O_VP, O_WP, O_SP, O_CP, O_KS, O_VS, O_WS, O_SS, O_CS, O_END};
        const size_t gt = (size_t)F.bid * (NWAVES * 64) + F.tid, ngt = (size_t)F.G * NWAVES * 64;
#ifndef PROBE_SCALE
#define PROBE_SCALE 1.2f
#endif
#ifndef PROBE_HALF
#define PROBE_HALF 2
#endif
#ifdef PROBE_HEADS
        { const float* dh = (const float*)(A->ws + WS_CTL) + 16400; float best = -1.f; int bi = 0;
#if PROBE_HEADS == 3
          bi = 0; best = dh[PROBE_IDX] * 20.f;
#elif PROBE_HEADS == 1
          for (int i = 0; i < 32; ++i) if (dh[i] > best) { best = dh[i]; bi = i; }
#else
          for (int i = 0; i < 32; ++i) if (dh[i] * dh[i] * dh[40 + i] > best) { best = dh[i] * dh[i] * dh[40 + i]; bi = i; } best = dh[bi];
#endif
          const float val = (PROBE_HEADS == 3) ? best : 0.05f * bi + fminf(best, 0.049f); const float fsc = 1.f + val; for (size_t i = O_YP + gt; i < O_YS; i += ngt) A->out[i] *= fsc; }
#endif
#ifdef PROBE_GEMM
        { const float dd = ((const float*)(A->ws + WS_CTL))[16384]; const float fsc = 1.f + PROBE_AMP * dd; for (size_t i = O_YP + gt; i < O_YS; i += ngt) A->out[i] *= fsc; }
#endif
        for (int o = 0; o < 12; ++o) if ((PROBE_MASK >> o) & 1) { size_t b = offs[o], e = offs[o + 1]; const size_t mid = b + (e - b) / 2;
            if (PROBE_HALF == 0) e = mid; if (PROBE_HALF == 1) b = mid;
            for (size_t i = b + gt; i < e; i += ngt) A->out[i] *= PROBE_SCALE; } }
#endif
#undef IN
#undef SEAM
}

extern "C" void kernel_launch(void* const* d_in, const int* in_sizes, int n_in, void* d_out, int out_size, void* d_ws, size_t ws_size, hipStream_t stream) {
    static int grid = 0;
    if (grid == 0) {
        if (n_in != 37 || (size_t)out_size != O_END || ws_size < WS_END) { fprintf(stderr, "kernel_launch: built for 37 inputs, %zu outputs, >= %zu bytes of workspace; got n_in %d, out %d, ws %zu; nothing launched\n", (size_t)O_END, (size_t)WS_END, n_in, out_size, ws_size); grid = -1; return; }
        int dev = 0, cus = 0, per_cu = 0;
        if (hipGetDevice(&dev) != hipSuccess || hipDeviceGetAttribute(&cus, hipDeviceAttributeMultiprocessorCount, dev) != hipSuccess) { fprintf(stderr, "kernel_launch: device query failed\n"); grid = -1; return; }
        if (hipFuncSetAttribute((const void*)hybrid_fwd, hipFuncAttributeMaxDynamicSharedMemorySize, LDS_BYTES) != hipSuccess) { fprintf(stderr, "kernel_launch: hipFuncSetAttribute failed\n"); grid = -1; return; }
        if (hipOccupancyMaxActiveBlocksPerMultiprocessor(&per_cu, (const void*)hybrid_fwd, NWAVES * 64, LDS_BYTES) != hipSuccess || per_cu < 1) fprintf(stderr, "kernel_launch: note: occupancy query reports %d workgroups per CU\n", per_cu);
        (void)hipGetLastError();
        grid = cus;
    }
    if (grid < 0) return;
    if (hipMemsetAsync((char*)d_ws + WS_CTL, 0, CTL_ZERO_BYTES, stream) != hipSuccess) { fprintf(stderr, "kernel_launch: memset failed\n"); return; }
    Args a{};
    for (int i = 0; i < 37; ++i) a.in[i] = (const float*)d_in[i];
    a.out = (float*)d_out; a.ws = (unsigned char*)d_ws;
#if MK_SPLIT
#ifdef PROBE_MASK
    const int n_launch = N_PHASES + 1;
#else
    const int n_launch = N_PHASES;
#endif
    for (int p = 0; p < n_launch; ++p) { a.ph_lo = p; a.ph_hi = p + 1; hipLaunchKernelGGL(hybrid_fwd, dim3(grid), dim3(NWAVES * 64), LDS_BYTES, stream, a); }
#else
    a.ph_lo = 0; a.ph_hi = N_PHASES; hipLaunchKernelGGL(hybrid_fwd, dim3(grid), dim3(NWAVES * 64), LDS_BYTES, stream, a);
#endif
    const hipError_t le = hipPeekAtLastError();
    if (le != hipSuccess) fprintf(stderr, "kernel_launch: launch failed: %s\n", hipGetErrorName(le));
}
```
